# Optimizing an MI355X kernel written in HIP

```python
import math
import jax
import jax.numpy as jnp
from jax import lax
import numpy as np

D_MODEL = 1024
BATCH = 8
SEQ = 2048
DEPTH = 2

EPS = 1e-6
S5_CH = 512
S5_GROUP = 16
S5_GROUPS = S5_CH // S5_GROUP
S5_STATE = 64
S5_DT_MIN = 1e-3
S5_DT_MAX = 1e-1
FOX_HEADS = 8
FOX_DH = 64
FOX_W = FOX_HEADS * FOX_DH
Q_BLOCK = 128
FOX_BIAS_INIT = 3.0
RET_HEADS = 4
RET_DK = 128
RET_DV = 128
RET_QK_W = RET_HEADS * RET_DK
RET_V_W = RET_HEADS * RET_DV
ROPE_BASE = 10000.0
GLA_HEADS = 4
GLA_DK = 64
GLA_DV = 128
GLA_QK_W = GLA_HEADS * GLA_DK
GLA_V_W = GLA_HEADS * GLA_DV
GLA_RANK = 16
GLA_TAU = 16.0
CHUNK = 64
EVEN_IN = S5_CH + 3 * FOX_W + FOX_HEADS
ODD_IN = 2 * RET_QK_W + 2 * RET_V_W + 2 * GLA_QK_W + 2 * GLA_V_W + GLA_RANK
MIX_W_EVEN = S5_CH + FOX_W
MIX_W_ODD = RET_V_W + GLA_V_W
N_EXPERTS = 32
TOP_K = 4
D_EXPERT = 1024
SWIGLU_LIMIT = 7.0
SWIGLU_ALPHA = 1.702
MOE_BLOCK = 256
N_EVEN = (DEPTH + 1) // 2
N_ODD = DEPTH // 2

kernel_name = 'hybrid_s5_fox_retnet_gla_moe'


def rms_norm(x, g):
    xf = x.astype(jnp.float32)
    y = xf * lax.rsqrt(jnp.mean(xf * xf, axis=-1, keepdims=True) + EPS)
    return (y * g.astype(jnp.float32)).astype(x.dtype)


def head_rms(x):
    xf = x.astype(jnp.float32)
    return xf * lax.rsqrt(jnp.mean(xf * xf, axis=-1, keepdims=True) + EPS)


def split_cols(z, widths):
    outs, start = [], 0
    for w in widths:
        outs.append(z[..., start:start + w])
        start += w
    return outs


def rotary(x, pos):
    half = x.shape[-1] // 2
    inv = ROPE_BASE ** (-jnp.arange(half, dtype=jnp.float32) / half)
    ang = pos.astype(jnp.float32)[:, None] * inv[None, :]
    cos = jnp.cos(ang)[None, :, None, :]
    sin = jnp.sin(ang)[None, :, None, :]
    xf = x.astype(jnp.float32)
    x1, x2 = xf[..., :half], xf[..., half:]
    return jnp.concatenate([x1 * cos - x2 * sin, x1 * sin + x2 * cos], axis=-1)


def to_chunks(t):
    bsz, seq, nh, d = t.shape
    return t.reshape(bsz, seq // CHUNK, CHUNK, nh, d).transpose(1, 0, 3, 2, 4)


def from_chunks(t):
    n, bsz, nh, cl, d = t.shape
    return t.transpose(1, 0, 3, 2, 4).reshape(bsz, n * cl, nh, d)


def _complex_affine_combine(left, right):
    ar1, ai1, br1, bi1 = left
    ar2, ai2, br2, bi2 = right
    return (ar2 * ar1 - ai2 * ai1,
            ar2 * ai1 + ai2 * ar1,
            ar2 * br1 - ai2 * bi1 + br2,
            ar2 * bi1 + ai2 * br1 + bi2)


def s5_mixer(u, lam_re, lam_im, log_dt, b_re, b_im, c_re, c_im, d_skip, glu_w, glu_b):
    f32 = jnp.float32
    bsz, seq, _ = u.shape
    uf = u.astype(f32)
    ug = uf.reshape(bsz, seq, S5_GROUPS, S5_GROUP)
    lr, li = lam_re.astype(f32), lam_im.astype(f32)
    dt = jnp.exp(log_dt.astype(f32))[:, None]
    mag = jnp.exp(lr * dt)
    a_re, a_im = mag * jnp.cos(li * dt), mag * jnp.sin(li * dt)
    den = lr * lr + li * li
    n_re, n_im = a_re - 1.0, a_im
    z_re = (n_re * lr + n_im * li) / den
    z_im = (n_im * lr - n_re * li) / den
    br, bi = b_re.astype(f32), b_im.astype(f32)
    bb_re = z_re[..., None] * br - z_im[..., None] * bi
    bb_im = z_re[..., None] * bi + z_im[..., None] * br
    drive_re = jnp.einsum('bsgc,gpc->bsgp', ug, bb_re)
    drive_im = jnp.einsum('bsgc,gpc->bsgp', ug, bb_im)
    shape_a = (1, seq, S5_GROUPS, S5_STATE)
    a_re_s = jnp.broadcast_to(a_re[None, None], shape_a)
    a_im_s = jnp.broadcast_to(a_im[None, None], shape_a)
    _, _, h_re, h_im = lax.associative_scan(
        _complex_affine_combine, (a_re_s, a_im_s, drive_re, drive_im), axis=1)
    y = (jnp.einsum('bsgp,gcp->bsgc', h_re, c_re.astype(f32))
         - jnp.einsum('bsgp,gcp->bsgc', h_im, c_im.astype(f32)))
    y = y.reshape(bsz, seq, S5_CH) + d_skip.astype(f32) * uf
    g = jax.nn.gelu(y)
    out = g * jax.nn.sigmoid(g @ glu_w.astype(f32) + glu_b.astype(f32))
    return out.astype(u.dtype)


def fox_attention(q, k, v, f_logit):
    seq = q.shape[1]
    cum = jnp.cumsum(jax.nn.log_sigmoid(f_logit.astype(jnp.float32)), axis=1).transpose(0, 2, 1)
    scale = FOX_DH ** -0.5
    outs = []
    for blk in range(seq // Q_BLOCK):
        q0, q1 = blk * Q_BLOCK, (blk + 1) * Q_BLOCK
        s = jnp.einsum('bqhd,bkhd->bhqk', q[:, q0:q1], k[:, :q1]).astype(jnp.float32) * scale
        s = s + cum[:, :, q0:q1, None] - cum[:, :, None, :q1]
        mask = (q0 + jnp.arange(Q_BLOCK))[:, None] >= jnp.arange(q1)[None, :]
        p = jax.nn.softmax(jnp.where(mask, s, -jnp.inf), axis=-1)
        outs.append(jnp.einsum('bhqk,bkhd->bqhd', p.astype(v.dtype), v[:, :q1]))
    return jnp.concatenate(outs, axis=1)


def retention(q, k, v):
    f32 = jnp.float32
    bsz, seq, nh, dk = q.shape
    log_g = jnp.log(1.0 - jnp.exp2(-5.0 - jnp.arange(nh, dtype=f32)))
    idx = jnp.arange(CHUNK, dtype=f32)
    rel = idx[:, None] - idx[None, :]
    dmat = jnp.where(rel >= 0, jnp.exp(log_g[:, None, None] * jnp.maximum(rel, 0.0)), 0.0)
    xi = jnp.exp(log_g[:, None] * (idx + 1.0))[..., None]
    zeta = jnp.exp(log_g[:, None] * (CHUNK - 1.0 - idx))[..., None]
    g_chunk = jnp.exp(log_g * CHUNK)[:, None, None]
    qc = to_chunks(q.astype(f32))
    kc = to_chunks(k.astype(f32) * dk ** -0.5)
    vc = to_chunks(v.astype(f32))

    def step(state, inp):
        qi, ki, vi = inp
        scores = jnp.einsum('bhqd,bhkd->bhqk', qi, ki) * dmat
        o = (jnp.einsum('bhqk,bhkv->bhqv', scores, vi)
             + jnp.einsum('bhqd,bhdv->bhqv', qi * xi, state))
        state = g_chunk * state + jnp.einsum('bhkd,bhkv->bhdv', ki, vi * zeta)
        return state, o

    state0 = jnp.zeros((bsz, nh, dk, v.shape[-1]), f32)
    _, o = lax.scan(step, state0, (qc, kc, vc))
    return from_chunks(o)


def gla(q, k, v, log_a):
    f32 = jnp.float32
    bsz, seq, nh, dk = q.shape
    qc = to_chunks(q.astype(f32) * dk ** -0.5)
    kc = to_chunks(k.astype(f32))
    vc = to_chunks(v.astype(f32))
    ac = to_chunks(log_a.astype(f32))
    causal = jnp.tril(jnp.ones((CHUNK, CHUNK), dtype=bool))[:, :, None]

    def step(state, inp):
        qi, ki, vi, ai = inp
        b = jnp.cumsum(ai, axis=2)
        o_inter = jnp.einsum('bhqd,bhdv->bhqv', qi * jnp.exp(b), state)
        decay = jnp.exp(jnp.where(causal, b[:, :, :, None, :] - b[:, :, None, :, :], -jnp.inf))
        scores = jnp.einsum('bhqd,bhkd,bhqkd->bhqk', qi, ki, decay)
        o = o_inter + jnp.einsum('bhqk,bhkv->bhqv', scores, vi)
        b_last = b[:, :, -1:, :]
        state = (jnp.exp(b_last)[:, :, 0, :, None] * state
                 + jnp.einsum('bhkd,bhkv->bhdv', ki * jnp.exp(b_last - b), vi))
        return state, o

    state0 = jnp.zeros((bsz, nh, dk, v.shape[-1]), f32)
    _, o = lax.scan(step, state0, (qc, kc, vc, ac))
    return from_chunks(o)


def even_mixer(h, w_in, b_f, lam_re, lam_im, log_dt, b_re, b_im, c_re, c_im, d_skip,
               glu_w, glu_b, w_out):
    bsz, seq, _ = h.shape
    z = h @ w_in
    u, q, k, v, f = split_cols(z, (S5_CH, FOX_W, FOX_W, FOX_W, FOX_HEADS))
    y_a = s5_mixer(u, lam_re, lam_im, log_dt, b_re, b_im, c_re, c_im, d_skip, glu_w, glu_b)
    hs = (bsz, seq, FOX_HEADS, FOX_DH)
    y_b = fox_attention(q.reshape(hs), k.reshape(hs), v.reshape(hs), f + b_f).reshape(bsz, seq, FOX_W)
    return jnp.concatenate([y_a, y_b.astype(y_a.dtype)], axis=-1) @ w_out


def odd_mixer(h, w_in, gla_w_up, gla_b_gate, w_out):
    f32 = jnp.float32
    bsz, seq, _ = h.shape
    z = h @ w_in
    rq, rk, rv, rg, gq, gk, gv, glr, gr = split_cols(
        z, (RET_QK_W, RET_QK_W, RET_V_W, RET_V_W, GLA_QK_W, GLA_QK_W, GLA_V_W, GLA_RANK, GLA_V_W))
    pos = jnp.arange(seq)
    rq = rotary(rq.reshape(bsz, seq, RET_HEADS, RET_DK), pos)
    rk = rotary(rk.reshape(bsz, seq, RET_HEADS, RET_DK), pos)
    ret = retention(rq, rk, rv.reshape(bsz, seq, RET_HEADS, RET_DV))
    y_c = jax.nn.silu(rg.astype(f32)) * head_rms(ret).reshape(bsz, seq, RET_V_W)
    log_a = jax.nn.log_sigmoid((glr @ gla_w_up + gla_b_gate).astype(f32)) / GLA_TAU
    o = gla(gq.reshape(bsz, seq, GLA_HEADS, GLA_DK), gk.reshape(bsz, seq, GLA_HEADS, GLA_DK),
            gv.reshape(bsz, seq, GLA_HEADS, GLA_DV), log_a.reshape(bsz, seq, GLA_HEADS, GLA_DK))
    y_d = jax.nn.silu(gr.astype(f32)) * head_rms(o).reshape(bsz, seq, GLA_V_W)
    y = jnp.concatenate([y_c, y_d], axis=-1).astype(h.dtype)
    return y @ w_out


def clamped_swiglu(gu):
    x_glu, x_lin = gu[..., :D_EXPERT], gu[..., D_EXPERT:]
    x_glu = jnp.minimum(x_glu, SWIGLU_LIMIT)
    x_lin = jnp.clip(x_lin, -SWIGLU_LIMIT, SWIGLU_LIMIT)
    return x_glu * jax.nn.sigmoid(SWIGLU_ALPHA * x_glu) * (x_lin + 1.0)


def moe_ffn(h, router_w, router_b, w_gu, b_gu, w_down, b_down):
    bsz, seq, d = h.shape
    n_tok = bsz * seq
    n_assign = n_tok * TOP_K
    ht = h.reshape(n_tok, d)
    logits = (ht @ router_w + router_b).astype(jnp.float32)
    top_v, top_i = lax.top_k(logits, TOP_K)
    gates = jax.nn.softmax(top_v, axis=-1)
    flat_e = top_i.reshape(-1)
    flat_tok = jnp.arange(n_assign, dtype=jnp.int32) // TOP_K
    flat_w = gates.reshape(-1)
    order = jnp.argsort(flat_e)
    se, st, sw = flat_e[order], flat_tok[order], flat_w[order]
    counts = jnp.bincount(flat_e, length=N_EXPERTS)
    padded = (counts + MOE_BLOCK - 1) // MOE_BLOCK * MOE_BLOCK
    pad_end = jnp.cumsum(padded)
    pad_start = pad_end - padded
    grp_start = jnp.cumsum(counts) - counts
    dest = pad_start[se] + jnp.arange(n_assign, dtype=jnp.int32) - grp_start[se]
    n_blocks = n_assign // MOE_BLOCK + N_EXPERTS
    slot_tok = jnp.full((n_blocks * MOE_BLOCK,), n_tok, dtype=jnp.int32).at[dest].set(st)
    block_expert = jnp.minimum(
        jnp.searchsorted(pad_end, jnp.arange(n_blocks) * MOE_BLOCK, side='right'), N_EXPERTS - 1)
    h_pad = jnp.concatenate([ht, jnp.zeros((1, d), ht.dtype)], axis=0)
    xb = h_pad[slot_tok].reshape(n_blocks, MOE_BLOCK, d)

    def expert_block(args):
        xblk, e = args
        gu = xblk @ w_gu[e] + b_gu[e]
        return clamped_swiglu(gu) @ w_down[e] + b_down[e]

    yb = lax.map(expert_block, (xb, block_expert)).reshape(n_blocks * MOE_BLOCK, d)
    y = yb[dest] * sw[:, None].astype(yb.dtype)
    out = jnp.zeros((n_tok, d), yb.dtype).at[st].add(y)
    return out.reshape(bsz, seq, d)


def setup_inputs(seed: int = 0) -> dict:
    key = jax.random.key(seed)
    keys = iter(jax.random.split(key, 48))

    def normal(shape, scale):
        return jax.random.normal(next(keys), shape, jnp.float32) * scale

    def gain(shape):
        return 1.0 + normal(shape, 0.01)

    d = D_MODEL
    x = normal((BATCH, SEQ, d), 1.0)
    c = normal((BATCH, d), 1.0)
    ada_w = normal((DEPTH, d, 6 * d), 0.5 * d ** -0.5)
    ada_b = normal((DEPTH, 6 * d), 0.01)
    norm_pre_mix = gain((DEPTH, d))
    norm_post_mix = gain((DEPTH, d))
    norm_pre_ffn = gain((DEPTH, d))
    norm_post_ffn = gain((DEPTH, d))
    ev_w_in = normal((N_EVEN, d, EVEN_IN), d ** -0.5)
    fox_b_f = FOX_BIAS_INIT + normal((N_EVEN, FOX_HEADS), 0.5)
    s5_lam_re = -0.5 + normal((N_EVEN, S5_GROUPS, S5_STATE), 0.01)
    s5_lam_im = jnp.pi * jnp.arange(S5_STATE, dtype=jnp.float32) + normal((N_EVEN, S5_GROUPS, S5_STATE), 0.01)
    s5_log_dt = jax.random.uniform(next(keys), (N_EVEN, S5_GROUPS), jnp.float32,
                                   math.log(S5_DT_MIN), math.log(S5_DT_MAX))
    s5_b_re = normal((N_EVEN, S5_GROUPS, S5_STATE, S5_GROUP), (2 * S5_GROUP) ** -0.5)
    s5_b_im = normal((N_EVEN, S5_GROUPS, S5_STATE, S5_GROUP), (2 * S5_GROUP) ** -0.5)
    s5_c_re = normal((N_EVEN, S5_GROUPS, S5_GROUP, S5_STATE), 1.0)
    s5_c_im = normal((N_EVEN, S5_GROUPS, S5_GROUP, S5_STATE), 1.0)
    s5_d = normal((N_EVEN, S5_CH), 1.0)
    s5_glu_w = normal((N_EVEN, S5_CH, S5_CH), S5_CH ** -0.5)
    s5_glu_b = normal((N_EVEN, S5_CH), 0.01)
    ev_w_out = normal((N_EVEN, MIX_W_EVEN, d), MIX_W_EVEN ** -0.5)
    od_w_in = normal((N_ODD, d, ODD_IN), d ** -0.5)
    gla_w_up = normal((N_ODD, GLA_RANK, GLA_QK_W), GLA_RANK ** -0.5)
    gla_b_gate = normal((N_ODD, GLA_QK_W), 0.1)
    od_w_out = normal((N_ODD, MIX_W_ODD, d), MIX_W_ODD ** -0.5)
    router_w = normal((DEPTH, d, N_EXPERTS), d ** -0.5)
    router_b = normal((DEPTH, N_EXPERTS), 0.01)
    exp_w_gu = normal((DEPTH, N_EXPERTS, d, 2 * D_EXPERT), d ** -0.5)
    exp_b_gu = normal((DEPTH, N_EXPERTS, 2 * D_EXPERT), 0.01)
    exp_w_down = normal((DEPTH, N_EXPERTS, D_EXPERT, d), D_EXPERT ** -0.5)
    exp_b_down = normal((DEPTH, N_EXPERTS, d), 0.01)
    return {'x': x, 'c': c, 'ada_w': ada_w, 'ada_b': ada_b,
            'norm_pre_mix': norm_pre_mix, 'norm_post_mix': norm_post_mix,
            'norm_pre_ffn': norm_pre_ffn, 'norm_post_ffn': norm_post_ffn,
            'ev_w_in': ev_w_in, 'fox_b_f': fox_b_f,
            's5_lam_re': s5_lam_re, 's5_lam_im': s5_lam_im, 's5_log_dt': s5_log_dt,
            's5_b_re': s5_b_re, 's5_b_im': s5_b_im, 's5_c_re': s5_c_re, 's5_c_im': s5_c_im,
            's5_d': s5_d, 's5_glu_w': s5_glu_w, 's5_glu_b': s5_glu_b, 'ev_w_out': ev_w_out,
            'od_w_in': od_w_in, 'gla_w_up': gla_w_up, 'gla_b_gate': gla_b_gate, 'od_w_out': od_w_out,
            'router_w': router_w, 'router_b': router_b,
            'exp_w_gu': exp_w_gu, 'exp_b_gu': exp_b_gu, 'exp_w_down': exp_w_down, 'exp_b_down': exp_b_down}


def reference(x, c, ada_w, ada_b, norm_pre_mix, norm_post_mix, norm_pre_ffn, norm_post_ffn,
              ev_w_in, fox_b_f, s5_lam_re, s5_lam_im, s5_log_dt, s5_b_re, s5_b_im, s5_c_re, s5_c_im,
              s5_d, s5_glu_w, s5_glu_b, ev_w_out, od_w_in, gla_w_up, gla_b_gate, od_w_out,
              router_w, router_b, exp_w_gu, exp_b_gu, exp_w_down, exp_b_down):
    for l in range(DEPTH):
        mod = (jax.nn.silu(c) @ ada_w[l] + ada_b[l])[:, None, :]
        sh1, sc1, g1, sh2, sc2, g2 = jnp.split(mod, 6, axis=-1)
        h = rms_norm(x, norm_pre_mix[l]) * (1.0 + sc1) + sh1
        i = l // 2
        if l % 2 == 0:
            m = even_mixer(h, ev_w_in[i], fox_b_f[i], s5_lam_re[i], s5_lam_im[i], s5_log_dt[i],
                           s5_b_re[i], s5_b_im[i], s5_c_re[i], s5_c_im[i], s5_d[i],
                           s5_glu_w[i], s5_glu_b[i], ev_w_out[i])
        else:
            m = odd_mixer(h, od_w_in[i], gla_w_up[i], gla_b_gate[i], od_w_out[i])
        x = x + g1 * rms_norm(m, norm_post_mix[l])
        h = rms_norm(x, norm_pre_ffn[l]) * (1.0 + sc2) + sh2
        f = moe_ffn(h, router_w[l], router_b[l], exp_w_gu[l], exp_b_gu[l], exp_w_down[l], exp_b_down[l])
        x = x + g2 * rms_norm(f, norm_post_ffn[l])
    return x
```

```cpp
#include <hip/hip_runtime.h>
#include <hip/hip_cooperative_groups.h>
#include <cstdio>
#include <cstdint>
namespace cg = cooperative_groups;

#define LAS __attribute__((address_space(3)))
typedef unsigned short bf16_t;
typedef short bf16x8 __attribute__((ext_vector_type(8)));
typedef float f32x4 __attribute__((ext_vector_type(4)));
typedef float f32x2 __attribute__((ext_vector_type(2)));
typedef unsigned u32x4 __attribute__((ext_vector_type(4)));
typedef unsigned u32x2 __attribute__((ext_vector_type(2)));

constexpr int NTOK = 16384, DM = 1024, SEQ = 2048, NB = 8;
constexpr int NEXP = 32, LISTCAP = 16384;
constexpr float EPS = 1e-6f;
constexpr float LOG2E = 1.4426950408889634f;
constexpr float C2 = 0.125f * LOG2E;
constexpr int ZP0 = 2048, ZP1 = 3584;

constexpr size_t MiB = 1u << 20;
constexpr size_t WS_CTL = 0, CTL_ZERO_BYTES = 65536;
constexpr size_t WS_MOD = 1 * MiB;
constexpr size_t WS_WSIDE = 1 * MiB + 512 * 1024;
constexpr size_t WS_S5A = 2 * MiB;
constexpr size_t WS_S5BB = 2 * MiB + 65536;
constexpr size_t WS_S5CK = 2 * MiB + 512 * 1024;
constexpr size_t WS_ROPE = 3 * MiB;
constexpr size_t WS_LTK = 4 * MiB;
constexpr size_t WS_LG = 8 * MiB;
constexpr size_t WS_WINE = 16 * MiB, WS_WGLU = 20 * MiB, WS_WOUTE = 21 * MiB, WS_WINO = 23 * MiB, WS_WOUTO = 30 * MiB;
constexpr size_t WS_W1 = 32 * MiB;
constexpr size_t WS_W2 = 288 * MiB;
constexpr size_t WS_HB = 416 * MiB;
constexpr size_t WS_Z = 448 * MiB;
constexpr size_t WS_LSIG = 560 * MiB;
constexpr size_t WS_LOGA = 562 * MiB;
constexpr size_t WS_G5 = 578 * MiB;
constexpr size_t WS_YCAT = 594 * MiB;
constexpr size_t WS_MBUF = 626 * MiB;
constexpr size_t WS_ACT = 690 * MiB;
constexpr size_t WS_Y = 834 * MiB;
constexpr size_t WS_RST = 962 * MiB;
constexpr size_t WS_GST = 994 * MiB;
constexpr size_t WS_XB = 1010 * MiB;
constexpr size_t WS_END = 1042 * MiB;
constexpr int CW_CNT = 1024;

constexpr int RING_BYTES = 131072;
constexpr int MISC_OFF = RING_BYTES;
constexpr int LDS_BYTES = 147456;

__device__ __forceinline__ unsigned f2bf(float f) { unsigned u = __builtin_bit_cast(unsigned, f); return (u + 0x7fffu + ((u >> 16) & 1u)) >> 16; }
typedef __bf16 bf16x2_hw __attribute__((ext_vector_type(2)));
__device__ __forceinline__ unsigned pk2(float lo, float hi) { const f32x2 v = {lo, hi}; return __builtin_bit_cast(unsigned, __builtin_convertvector(v, bf16x2_hw)); }
__device__ __forceinline__ float bflo(unsigned w) { return __builtin_bit_cast(float, w << 16); }
__device__ __forceinline__ float bfhi(unsigned w) { return __builtin_bit_cast(float, w & 0xffff0000u); }
__device__ __forceinline__ float bf1(bf16_t b) { return __builtin_bit_cast(float, ((unsigned)b) << 16); }
__device__ __forceinline__ int lane_id() { int l; asm volatile("v_mbcnt_lo_u32_b32 %0, -1, 0\n\tv_mbcnt_hi_u32_b32 %0, -1, %0" : "=v"(l)); return l; }
template <int CTRL> __device__ __forceinline__ float dppf(float v) { return __builtin_bit_cast(float, __builtin_amdgcn_update_dpp(0, __builtin_bit_cast(int, v), CTRL, 0xf, 0xf, true)); }
__device__ __forceinline__ float row16_sum(float v) {
    v += dppf<0xB1>(v); v += dppf<0x4E>(v); v += dppf<0x141>(v); v += dppf<0x140>(v); return v;
}
__device__ __forceinline__ float rdlane(float v, int l) { return __builtin_bit_cast(float, __builtin_amdgcn_readlane(__builtin_bit_cast(int, v), l)); }
__device__ __forceinline__ float wave_sum(float v) {
    v = row16_sum(v); return (rdlane(v, 0) + rdlane(v, 16)) + (rdlane(v, 32) + rdlane(v, 48));
}
__device__ __forceinline__ float half_sum(float v) {
    v = row16_sum(v); const float a = rdlane(v, 0) + rdlane(v, 16), b = rdlane(v, 32) + rdlane(v, 48); return (lane_id() < 32) ? a : b;
}
__device__ __forceinline__ float sigmoidf_(float x) { return __builtin_amdgcn_rcpf(1.f + __expf(-x)); }
__device__ __forceinline__ float log_sigmoidf_(float x) { return fminf(x, 0.f) - log1pf(__expf(-fabsf(x))); }
__device__ __forceinline__ float siluf_(float x) { return x * sigmoidf_(x); }
__device__ __forceinline__ float gelu_tanh(float x) { const float u2 = 1.5957691216057308f * (x + 0.044715f * x * x * x); return x * sigmoidf_(u2); }
#define LDS_WAIT() asm volatile("s_waitcnt lgkmcnt(0)" ::: "memory")

struct Args { const float* in[31]; float* out; unsigned char* ws; long long pad; };
typedef const __attribute__((address_space(4))) Args CArgs;
enum { I_X = 0, I_C, I_ADAW, I_ADAB, I_NPM, I_NQM, I_NPF, I_NQF, I_EVWIN, I_FOXB, I_LAMRE, I_LAMIM, I_LOGDT, I_BRE, I_BIM, I_CRE, I_CIM, I_S5D, I_GLUW, I_GLUB, I_EVWOUT,
       I_ODWIN, I_GLAWUP, I_GLABG, I_ODWOUT, I_RW, I_RB, I_WGU, I_BGU, I_WDN, I_BDN };

namespace pg8 {
constexpr int BM = 256, BK = 64, HALF = 128, HTB = HALF * BK * 2, STAGE_BYTES = 8 * HTB, NXCD = 8, WGM = 8;
__device__ __forceinline__ int lds_byte(int r, int c) { const int st = (r >> 4) * 2 + (c >> 5), rr = r & 15, cc = c & 31, ob = rr * 64 + cc * 2; return st * 1024 + (ob ^ (((ob >> 9) & 1) << 5)); }
__device__ __forceinline__ void stage_rc(int b, int& R, int& C) { const int st = b / 1024, sb = b % 1024, swz = sb ^ (((sb >> 9) & 1) << 5); R = (st >> 1) * 16 + swz / 64; C = (st & 1) * 32 + (swz % 64) / 2; }
__device__ __forceinline__ int perm32(int rho) { const int n = rho >> 4, i = rho & 15; return 8 * (i >> 2) + 4 * n + (i & 3); }
__device__ __forceinline__ unsigned cvt_pk_bf16(float lo, float hi) { unsigned r; asm volatile("v_cvt_pk_bf16_f32 %0, %1, %2" : "=v"(r) : "v"(lo), "v"(hi)); return r; }

struct Unit { int pm, pn, e, mb, nrows, kind; };
__device__ __forceinline__ int xcd_remap(int L, int nwg) { const int q = nwg / NXCD, r = nwg % NXCD, xcd = L % NXCD, off = L / NXCD; return (xcd < r ? xcd * (q + 1) : r * (q + 1) + (xcd - r) * q) + off; }

struct DenseOrder {
    const char* Ap; const char* Bt; int K, nM, nN, nwg, G, c;
    __device__ __forceinline__ void init(const void* A_, const void* Bt_, int M, int N, int K_, int G_, int c_) { Ap = (const char*)A_; Bt = (const char*)Bt_; K = K_; nM = M / BM; nN = N / BM; nwg = nM * nN; G = G_; c = c_; }
    __device__ __forceinline__ bool next(int i, Unit& u) const {
        const long L = (long)i * G + c; if (L >= nwg) return false;
        const int wgid = xcd_remap((int)L, nwg);
        const int nig = WGM * nN, gid = wgid / nig, fm = gid * WGM, gsz = (nM - fm) < WGM ? (nM - fm) : WGM;
        u.pm = fm + ((wgid % nig) % gsz); u.pn = (wgid % nig) / gsz; u.e = 0; u.mb = u.pm; u.nrows = BM; u.kind = 0; return true;
    }
    __device__ __forceinline__ const char* a_base(const Unit& u) const { return Ap + (size_t)u.pm * ((size_t)BM * K * 2); }
    __device__ __forceinline__ const char* b_base(const Unit& u) const { return Bt + (size_t)u.pn * ((size_t)BM * K * 2); }
    __device__ __forceinline__ void a_raw(const Unit&, const int (&)[2], int (&raw)[2][2]) const { raw[0][0] = raw[0][1] = raw[1][0] = raw[1][1] = 0; }
    __device__ __forceinline__ void a_offs(const Unit&, const int (&R)[2], const int (&C)[2], const int (&)[2][2], unsigned (&v)[2][2]) const {
#pragma unroll
        for (int h = 0; h < 2; ++h)
#pragma unroll
            for (int i = 0; i < 2; ++i) v[h][i] = (unsigned)((h * HALF + R[i]) * K + C[i]) * 2u;
    }
};
struct MoeTables { int cnt[NEXP]; int mtstart[NEXP + 1]; unsigned char tile_e[320]; };
template <bool GATHER> struct MoeOrder {
    const char* Ap; const char* Bt; size_t estride; int K, NP, nwg, G, c, mt0; const int* list_tk; const LAS MoeTables* tb;
    __device__ __forceinline__ bool next(int i, Unit& u) const {
        const long L = (long)i * G + c; if (L >= nwg) return false;
        const int w = xcd_remap((int)L, nwg);
        const int mq = w / NP, mt = mt0 + mq; u.pn = w - mq * NP; u.pm = mt; u.e = tb->tile_e[mt]; u.mb = mt - tb->mtstart[u.e];
        const int left = tb->cnt[u.e] - u.mb * BM; u.nrows = left < BM ? left : BM; u.kind = GATHER ? 0 : 1; return true;
    }
    __device__ __forceinline__ const char* a_base(const Unit& u) const { return GATHER ? Ap : Ap + (size_t)u.pm * ((size_t)BM * K * 2); }
    __device__ __forceinline__ const char* b_base(const Unit& u) const { return Bt + (size_t)u.e * estride + (size_t)u.pn * ((size_t)BM * K * 2); }
    __device__ __forceinline__ void a_raw(const Unit& u, const int (&R)[2], int (&raw)[2][2]) const {
#pragma unroll
        for (int h = 0; h < 2; ++h)
#pragma unroll
            for (int i = 0; i < 2; ++i) { if (GATHER) { const int r = h * HALF + R[i], rc = r < u.nrows ? r : 0; raw[h][i] = list_tk[u.e * LISTCAP + u.mb * BM + rc]; } else raw[h][i] = 0; }
    }
    __device__ __forceinline__ void a_offs(const Unit&, const int (&R)[2], const int (&C)[2], const int (&raw)[2][2], unsigned (&v)[2][2]) const {
#pragma unroll
        for (int h = 0; h < 2; ++h)
#pragma unroll
            for (int i = 0; i < 2; ++i) {
                if (GATHER) v[h][i] = (unsigned)((raw[h][i] >> 2) * K + C[i]) * 2u;
                else v[h][i] = (unsigned)((h * HALF + R[i]) * K + C[i]) * 2u;
            }
    }
};

struct MoeMixOrder {
    const char* ws; int l, a0, nA, b0, nB, nwg, G, c; const LAS MoeTables* tb;
    static constexpr int K = 1024;
    __device__ __forceinline__ bool next(int i, Unit& u) const {
        const long L = (long)i * G + c; if (L >= nwg) return false;
        int w = xcd_remap((int)L, nwg), mt;
        if (w < nA) { u.kind = 0; mt = a0 + (w >> 3); u.pn = w & 7; } else { w -= nA; u.kind = 1; mt = b0 + (w >> 2); u.pn = w & 3; }
        u.pm = mt; u.e = tb->tile_e[mt]; u.mb = mt - tb->mtstart[u.e];
        const int left = tb->cnt[u.e] - u.mb * BM; u.nrows = left < BM ? left : BM; return true;
    }
    __device__ __forceinline__ const char* a_base(const Unit& u) const { return u.kind ? ws + WS_ACT : ws + WS_HB; }
    __device__ __forceinline__ const char* b_base(const Unit& u) const { return u.kind ? ws + WS_W2 + (size_t)(l * 32 + u.e) * ((size_t)1024 * K * 2) + (size_t)u.pn * ((size_t)BM * K * 2) : ws + WS_W1 + (size_t)(l * 32 + u.e) * ((size_t)2048 * K * 2) + (size_t)u.pn * ((size_t)BM * K * 2); }
    __device__ __forceinline__ void a_raw(const Unit& u, const int (&R)[2], int (&raw)[2][2]) const {
#pragma unroll
        for (int h = 0; h < 2; ++h)
#pragma unroll
            for (int i = 0; i < 2; ++i) { const int r = h * HALF + R[i], rc = r < u.nrows ? r : 0; raw[h][i] = u.kind ? 4 * (u.pm * BM + r) : ((const int*)(ws + WS_LTK))[(l * 32 + u.e) * LISTCAP + u.mb * BM + rc]; }
    }
    __device__ __forceinline__ void a_offs(const Unit& u, const int (&R)[2], const int (&C)[2], const int (&raw)[2][2], unsigned (&v)[2][2]) const {
#pragma unroll
        for (int h = 0; h < 2; ++h)
#pragma unroll
            for (int i = 0; i < 2; ++i) v[h][i] = (unsigned)((raw[h][i] >> 2) * K + C[i]) * 2u;
    }
};

template <class Epi, class Sched, bool ALIGN_EPI>
__device__ __forceinline__ void gemm_phase(LAS unsigned char* lds, const int wave_, const int K, const Sched& S, const Epi& E) {
    int tid_ = wave_ * 64 + lane_id(); asm volatile("" : "+v"(tid_));
    const int tid = tid_, wid = wave_, lane = tid & 63, wr = wid >> 2, wc = wid & 3, fr = lane & 15, fq = lane >> 4;
    const int nt = K / BK;
    int Rr[2], Cc[2]; unsigned voffB[2];
#pragma unroll
    for (int i = 0; i < 2; ++i) { stage_rc(tid * 16 + i * 8192, Rr[i], Cc[i]); const int Rb = Epi::PERM ? ((Rr[i] & ~31) + perm32(Rr[i] & 31)) : Rr[i]; voffB[i] = (unsigned)(Rb * K + Cc[i]) * 2u; }
    const size_t kstep = (size_t)(BK * 2);
    const size_t hstep = (size_t)HALF * K * 2;
    const unsigned ldsw = (unsigned)wid * 1024u;
    const int aoff = lds_byte(wr * 64 + fr, fq * 8), boff = lds_byte(wc * 32 + fr, fq * 8);
#define PG8_SA(b, h) (((b) * 2 + (h)) * HTB)
#define PG8_SB(b, h) ((4 + (b) * 2 + (h)) * HTB)
#define PG8_STAGE(bufoff, gbase, voff) do { _Pragma("unroll") for (int _i = 0; _i < 2; ++_i) \
        __builtin_amdgcn_global_load_lds((const unsigned*)((const char*)(gbase) + (voff)[_i]), (LAS unsigned*)(lds + (bufoff) + ldsw + _i * 8192), 16, 0, 0); } while (0)
#define PG8_LDA(dst, b, h) do { _Pragma("unroll") for (int m = 0; m < 4; ++m) _Pragma("unroll") for (int k = 0; k < 2; ++k) dst[m][k] = *(const LAS bf16x8*)(lds + PG8_SA(b, h) + aoff + m * 2048 + k * 1024); } while (0)
#define PG8_LDB(dst, b, h) do { _Pragma("unroll") for (int n = 0; n < 2; ++n) _Pragma("unroll") for (int k = 0; k < 2; ++k) dst[n][k] = *(const LAS bf16x8*)(lds + PG8_SB(b, h) + boff + n * 2048 + k * 1024); } while (0)
#define PG8_MMA(ai, bj, At, Bt) do { __builtin_amdgcn_s_setprio(1); _Pragma("unroll") for (int m = 0; m < 4; ++m) _Pragma("unroll") for (int n = 0; n < 2; ++n) _Pragma("unroll") for (int k = 0; k < 2; ++k) \
        acc[ai][bj][m][n] = __builtin_amdgcn_mfma_f32_16x16x32_bf16(Bt[n][k], At[m][k], acc[ai][bj][m][n], 0, 0, 0); __builtin_amdgcn_s_setprio(0); } while (0)
#define PG8_WAIT_V(n) asm volatile("s_waitcnt vmcnt(" #n ")" ::: "memory")
#define PG8_WAIT_L(n) asm volatile("s_waitcnt lgkmcnt(" #n ")" ::: "memory")
#define PG8_BAR __builtin_amdgcn_s_barrier()
#define PG8_SCHED __builtin_amdgcn_sched_barrier(0)
    Unit cur, nxt; int ui = 0;
    if (!S.next(0, cur)) return;
    f32x4 acc[2][2][4][2];
#pragma unroll
    for (int a = 0; a < 2; ++a)
#pragma unroll
        for (int b = 0; b < 2; ++b)
#pragma unroll
            for (int m = 0; m < 4; ++m)
#pragma unroll
                for (int n = 0; n < 2; ++n) acc[a][b][m][n] = (f32x4){0.f, 0.f, 0.f, 0.f};
    bf16x8 At[4][2], B0[2][2], B1[2][2];
    const char* cA = S.a_base(cur); const char* cB = S.b_base(cur);
    unsigned cv[2][2], nv[2][2]; int raw[2][2];
    S.a_raw(cur, Rr, raw); S.a_offs(cur, Rr, Cc, raw, cv);
    PG8_STAGE(PG8_SB(0, 0), cB, voffB); PG8_STAGE(PG8_SB(0, 1), cB + hstep, voffB); PG8_STAGE(PG8_SA(0, 0), cA, cv[0]); PG8_STAGE(PG8_SA(0, 1), cA, cv[1]);
    if (wr == 1) PG8_BAR;
    PG8_WAIT_V(2); PG8_BAR;
    PG8_STAGE(PG8_SB(1, 0), cB + kstep, voffB); PG8_STAGE(PG8_SA(1, 0), cA + kstep, cv[0]); PG8_STAGE(PG8_SB(1, 1), cB + hstep + kstep, voffB);
    PG8_WAIT_V(6); PG8_BAR;
    for (;;) {
        const bool has_next = S.next(ui + 1, nxt);
        const char* nA = has_next ? S.a_base(nxt) : cA; const char* nB = has_next ? S.b_base(nxt) : cB;
        if (has_next) S.a_raw(nxt, Rr, raw);
#pragma unroll
        for (int h = 0; h < 2; ++h)
#pragma unroll
            for (int i = 0; i < 2; ++i) nv[h][i] = cv[h][i];
        for (int t = 0; t < nt; t += 2) {
            const bool last = (t == nt - 2);
            if (last && has_next) S.a_offs(nxt, Rr, Cc, raw, nv);
            const char* a1 = cA + (size_t)(t + 1) * kstep;
            const char* a2 = last ? nA : cA + (size_t)(t + 2) * kstep; const char* b2 = last ? nB : cB + (size_t)(t + 2) * kstep;
            const char* a3 = a2 + kstep; const char* b3 = b2 + kstep;
            unsigned v2[2][2];
#pragma unroll
            for (int h = 0; h < 2; ++h)
#pragma unroll
                for (int i = 0; i < 2; ++i) v2[h][i] = last ? nv[h][i] : cv[h][i];
            PG8_LDB(B0, 0, 0); PG8_LDB(B1, 0, 1); PG8_SCHED; PG8_LDA(At, 0, 0); PG8_STAGE(PG8_SA(1, 1), a1, cv[1]);
            PG8_WAIT_V(8); PG8_WAIT_L(0); PG8_BAR; PG8_MMA(0, 0, At, B0); PG8_MMA(0, 1, At, B1); PG8_BAR; PG8_SCHED;
            PG8_LDA(At, 0, 1); PG8_STAGE(PG8_SB(0, 0), b2, voffB); PG8_STAGE(PG8_SB(0, 1), b2 + hstep, voffB); PG8_STAGE(PG8_SA(0, 0), a2, v2[0]);
            PG8_WAIT_V(8); PG8_WAIT_L(0); PG8_BAR; PG8_MMA(1, 0, At, B0); PG8_MMA(1, 1, At, B1); PG8_BAR; PG8_SCHED;
            PG8_LDB(B0, 1, 0); PG8_LDB(B1, 1, 1); PG8_SCHED; PG8_LDA(At, 1, 0); PG8_STAGE(PG8_SA(0, 1), a2, v2[1]);
            PG8_WAIT_V(8); PG8_WAIT_L(0); PG8_BAR; PG8_MMA(0, 0, At, B0); PG8_MMA(0, 1, At, B1); PG8_BAR; PG8_SCHED;
            PG8_LDA(At, 1, 1); PG8_STAGE(PG8_SB(1, 0), b3, voffB); PG8_STAGE(PG8_SB(1, 1), b3 + hstep, voffB); PG8_STAGE(PG8_SA(1, 0), a3, v2[0]);
            PG8_WAIT_V(8); PG8_WAIT_L(0); PG8_BAR; PG8_MMA(1, 0, At, B0); PG8_MMA(1, 1, At, B1); PG8_BAR; PG8_SCHED;
        }
        if constexpr (ALIGN_EPI) { if (wr == 0) PG8_BAR; }
        E(acc, cur, wr, wc, fr, fq);
        if (!has_next) break;
#pragma unroll
        for (int a = 0; a < 2; ++a)
#pragma unroll
            for (int b = 0; b < 2; ++b)
#pragma unroll
                for (int m = 0; m < 4; ++m)
#pragma unroll
                    for (int n = 0; n < 2; ++n) acc[a][b][m][n] = (f32x4){0.f, 0.f, 0.f, 0.f};
        cur = nxt; cA = nA; cB = nB; ++ui;
#pragma unroll
        for (int h = 0; h < 2; ++h)
#pragma unroll
            for (int i = 0; i < 2; ++i) cv[h][i] = nv[h][i];
        if constexpr (ALIGN_EPI) { if (wr == 1) PG8_BAR; }
    }
    PG8_WAIT_V(0);
    if constexpr (!ALIGN_EPI) { if (wr == 0) PG8_BAR; }
    PG8_BAR;
#undef PG8_SA
#undef PG8_SB
#undef PG8_STAGE
#undef PG8_LDA
#undef PG8_LDB
#undef PG8_MMA
#undef PG8_WAIT_V
#undef PG8_WAIT_L
#undef PG8_BAR
#undef PG8_SCHED
}
}
namespace pg8 {
typedef f32x4 Acc[2][2][4][2];
struct EpiZ0 {
    static constexpr bool PERM = true;
    bf16_t* Z;
    __device__ __forceinline__ void operator()(const Acc& acc, const Unit& u, int wr, int wc, int fr, int fq) const {
        const float sc = (u.pn == 2 || u.pn == 3) ? C2 : 1.f;
        const int row0 = u.pm * BM + wr * 64 + fr, col0 = u.pn * BM + wc * 32 + 8 * fq;
#pragma unroll
        for (int ai = 0; ai < 2; ++ai)
#pragma unroll
            for (int m = 0; m < 4; ++m) { bf16_t* rowp = Z + (size_t)(row0 + ai * HALF + m * 16) * ZP0 + col0;
#pragma unroll
                for (int bj = 0; bj < 2; ++bj) { const f32x4 v0 = acc[ai][bj][m][0] * sc, v1 = acc[ai][bj][m][1] * sc;
                    u32x4 w; w.x = cvt_pk_bf16(v0[0], v0[1]); w.y = cvt_pk_bf16(v0[2], v0[3]); w.z = cvt_pk_bf16(v1[0], v1[1]); w.w = cvt_pk_bf16(v1[2], v1[3]);
                    *(u32x4*)(rowp + bj * HALF) = w; } }
    }
};
struct EpiZ1 {
    static constexpr bool PERM = true;
    bf16_t* Z; const float* rope;
    __device__ __forceinline__ void operator()(const Acc& acc, const Unit& u, int wr, int wc, int fr, int fq) const {
        const int row0 = u.pm * BM + wr * 64 + fr;
        if (u.pn < 4) {
            const float sc = (u.pn >= 2) ? 0.08838834764831845f : 1.f;
            const int hl = wc >> 1, jj0 = 32 * (wc & 1) + 8 * fq;
#pragma unroll
            for (int ai = 0; ai < 2; ++ai)
#pragma unroll
                for (int m = 0; m < 4; ++m) { const int row = row0 + ai * HALF + m * 16, pos = row & (SEQ - 1);
                    const f32x4 c0 = *(const f32x4*)(rope + pos * 64 + jj0), c1 = *(const f32x4*)(rope + pos * 64 + jj0 + 4);
                    const f32x4 s0 = *(const f32x4*)(rope + SEQ * 64 + pos * 64 + jj0), s1 = *(const f32x4*)(rope + SEQ * 64 + pos * 64 + jj0 + 4);
                    const f32x4 x10 = acc[ai][0][m][0] * sc, x11 = acc[ai][0][m][1] * sc, x20 = acc[ai][1][m][0] * sc, x21 = acc[ai][1][m][1] * sc;
                    const f32x4 a0 = x10 * c0 - x20 * s0, a1 = x11 * c1 - x21 * s1, b0 = x10 * s0 + x20 * c0, b1 = x11 * s1 + x21 * c1;
                    bf16_t* rowp = Z + (size_t)row * ZP1 + u.pn * BM + 128 * hl + jj0;
                    u32x4 w; w.x = cvt_pk_bf16(a0[0], a0[1]); w.y = cvt_pk_bf16(a0[2], a0[3]); w.z = cvt_pk_bf16(a1[0], a1[1]); w.w = cvt_pk_bf16(a1[2], a1[3]);
                    *(u32x4*)(rowp) = w;
                    w.x = cvt_pk_bf16(b0[0], b0[1]); w.y = cvt_pk_bf16(b0[2], b0[3]); w.z = cvt_pk_bf16(b1[0], b1[1]); w.w = cvt_pk_bf16(b1[2], b1[3]);
                    *(u32x4*)(rowp + 64) = w; }
        } else {
            const float sc = (u.pn == 8) ? 0.125f : 1.f;
            const int col0 = u.pn * BM + wc * 32 + 8 * fq;
#pragma unroll
            for (int ai = 0; ai < 2; ++ai)
#pragma unroll
                for (int m = 0; m < 4; ++m) { bf16_t* rowp = Z + (size_t)(row0 + ai * HALF + m * 16) * ZP1 + col0;
#pragma unroll
                    for (int bj = 0; bj < 2; ++bj) { const f32x4 v0 = acc[ai][bj][m][0] * sc, v1 = acc[ai][bj][m][1] * sc;
                        u32x4 w; w.x = cvt_pk_bf16(v0[0], v0[1]); w.y = cvt_pk_bf16(v0[2], v0[3]); w.z = cvt_pk_bf16(v1[0], v1[1]); w.w = cvt_pk_bf16(v1[2], v1[3]);
                        *(u32x4*)(rowp + bj * HALF) = w; } }
        }
    }
};
struct EpiGlu {
    static constexpr bool PERM = true;
    const bf16_t* G5; const float* bias; bf16_t* Y;
    __device__ __forceinline__ void operator()(const Acc& acc, const Unit& u, int wr, int wc, int fr, int fq) const {
        const int row0 = u.pm * BM + wr * 64 + fr, col0 = u.pn * BM + wc * 32 + 8 * fq;
        f32x4 bv[2][2];
#pragma unroll
        for (int bj = 0; bj < 2; ++bj)
#pragma unroll
            for (int n = 0; n < 2; ++n) bv[bj][n] = *(const f32x4*)(bias + col0 + bj * HALF + 4 * n);
#pragma unroll
        for (int ai = 0; ai < 2; ++ai)
#pragma unroll
            for (int m = 0; m < 4; ++m) { const size_t row = (size_t)(row0 + ai * HALF + m * 16);
#pragma unroll
                for (int bj = 0; bj < 2; ++bj) { const u32x4 gw = *(const u32x4*)(G5 + row * 512 + col0 + bj * HALF);
                    const f32x4 v0 = acc[ai][bj][m][0] + bv[bj][0], v1 = acc[ai][bj][m][1] + bv[bj][1];
                    float o[8]; o[0] = bflo(gw.x) * sigmoidf_(v0[0]); o[1] = bfhi(gw.x) * sigmoidf_(v0[1]); o[2] = bflo(gw.y) * sigmoidf_(v0[2]); o[3] = bfhi(gw.y) * sigmoidf_(v0[3]);
                    o[4] = bflo(gw.z) * sigmoidf_(v1[0]); o[5] = bfhi(gw.z) * sigmoidf_(v1[1]); o[6] = bflo(gw.w) * sigmoidf_(v1[2]); o[7] = bfhi(gw.w) * sigmoidf_(v1[3]);
                    u32x4 w; w.x = cvt_pk_bf16(o[0], o[1]); w.y = cvt_pk_bf16(o[2], o[3]); w.z = cvt_pk_bf16(o[4], o[5]); w.w = cvt_pk_bf16(o[6], o[7]);
                    *(u32x4*)(Y + row * DM + col0 + bj * HALF) = w; } }
    }
};
struct EpiF32 {
    static constexpr bool PERM = false;
    float* Cp; int ldc;
    __device__ __forceinline__ void operator()(const Acc& acc, const Unit& u, int wr, int wc, int fr, int fq) const {
        const int row0 = u.pm * BM + wr * 64 + fr, col0 = u.pn * BM + wc * 32 + 4 * fq;
#pragma unroll
        for (int ai = 0; ai < 2; ++ai)
#pragma unroll
            for (int m = 0; m < 4; ++m) { float* rowp = Cp + (size_t)(row0 + ai * HALF + m * 16) * ldc + col0;
#pragma unroll
                for (int bj = 0; bj < 2; ++bj)
#pragma unroll
                    for (int n = 0; n < 2; ++n) *(f32x4*)(rowp + bj * HALF + n * 16) = acc[ai][bj][m][n]; }
    }
};
struct EpiBf16Plain {
    static constexpr bool PERM = true;
    bf16_t* Cp; int ldc;
    __device__ __forceinline__ void operator()(const Acc& acc, const Unit& u, int wr, int wc, int fr, int fq) const {
        const int row0 = u.pm * BM + wr * 64 + fr, col0 = u.pn * BM + wc * 32 + 8 * fq;
#pragma unroll
        for (int ai = 0; ai < 2; ++ai)
#pragma unroll
            for (int m = 0; m < 4; ++m) { bf16_t* rowp = Cp + (size_t)(row0 + ai * HALF + m * 16) * ldc + col0;
#pragma unroll
                for (int bj = 0; bj < 2; ++bj) { const f32x4 v0 = acc[ai][bj][m][0], v1 = acc[ai][bj][m][1];
                    u32x4 w; w.x = cvt_pk_bf16(v0[0], v0[1]); w.y = cvt_pk_bf16(v0[2], v0[3]); w.z = cvt_pk_bf16(v1[0], v1[1]); w.w = cvt_pk_bf16(v1[2], v1[3]);
                    *(u32x4*)(rowp + bj * HALF) = w; } }
    }
};
struct EpiSwiglu {
    static constexpr bool PERM = true;
    bf16_t* ACT; const float* bgu;
    __device__ __forceinline__ void operator()(const Acc& acc, const Unit& u, int wr, int wc, int fr, int fq) const {
        const int row0 = u.pm * BM + wr * 64 + fr, j0 = wc * 32 + 8 * fq, colg = u.pn * 128 + j0;
        const float* bp = bgu + (size_t)u.e * 2048 + colg;
        const f32x4 bg0 = *(const f32x4*)(bp), bg1 = *(const f32x4*)(bp + 4), bl0 = *(const f32x4*)(bp + 1024), bl1 = *(const f32x4*)(bp + 1028);
#pragma unroll
        for (int ai = 0; ai < 2; ++ai)
#pragma unroll
            for (int m = 0; m < 4; ++m) {
                const f32x4 g0 = acc[ai][0][m][0] + bg0, g1 = acc[ai][0][m][1] + bg1, l0 = acc[ai][1][m][0] + bl0, l1 = acc[ai][1][m][1] + bl1;
                float o[8];
#pragma unroll
                for (int i = 0; i < 4; ++i) { const float a = fminf(g0[i], 7.f), b = fminf(fmaxf(l0[i], -7.f), 7.f); o[i] = a * sigmoidf_(1.702f * a) * (b + 1.f);
                                              const float a2 = fminf(g1[i], 7.f), b2 = fminf(fmaxf(l1[i], -7.f), 7.f); o[4 + i] = a2 * sigmoidf_(1.702f * a2) * (b2 + 1.f); }
                u32x4 w; w.x = cvt_pk_bf16(o[0], o[1]); w.y = cvt_pk_bf16(o[2], o[3]); w.z = cvt_pk_bf16(o[4], o[5]); w.w = cvt_pk_bf16(o[6], o[7]);
                *(u32x4*)(ACT + (size_t)(row0 + ai * HALF + m * 16) * DM + colg) = w; }
    }
};
struct EpiDown {
    static constexpr bool PERM = true;
    bf16_t* Y; const float* bdn; const int* list_tk; const float* list_g;
    __device__ __forceinline__ void operator()(const Acc& acc, const Unit& u, int wr, int wc, int fr, int fq) const {
        const int r0 = wr * 64 + fr, col0 = u.pn * BM + wc * 32 + 8 * fq;
        const float* bp = bdn + (size_t)u.e * DM + col0;
        f32x4 bv[2][2];
#pragma unroll
        for (int bj = 0; bj < 2; ++bj)
#pragma unroll
            for (int n = 0; n < 2; ++n) bv[bj][n] = *(const f32x4*)(bp + bj * HALF + 4 * n);
        const size_t lbase = (size_t)u.e * LISTCAP + (size_t)u.mb * BM;
        int tkv[2][4]; float gtv[2][4];
#pragma unroll
        for (int ai = 0; ai < 2; ++ai)
#pragma unroll
            for (int m = 0; m < 4; ++m) { const int r = r0 + ai * HALF + m * 16, rc = r < u.nrows ? r : 0; tkv[ai][m] = list_tk[lbase + rc]; gtv[ai][m] = list_g[lbase + rc]; }
#pragma unroll
        for (int ai = 0; ai < 2; ++ai)
#pragma unroll
            for (int m = 0; m < 4; ++m) { const int r = r0 + ai * HALF + m * 16;
                if (r < u.nrows) { const float gt = gtv[ai][m];
                    bf16_t* rowp = Y + (size_t)tkv[ai][m] * DM + col0;
#pragma unroll
                    for (int bj = 0; bj < 2; ++bj) { const f32x4 v0 = (acc[ai][bj][m][0] + bv[bj][0]) * gt, v1 = (acc[ai][bj][m][1] + bv[bj][1]) * gt;
                        u32x4 w; w.x = cvt_pk_bf16(v0[0], v0[1]); w.y = cvt_pk_bf16(v0[2], v0[3]); w.z = cvt_pk_bf16(v1[0], v1[1]); w.w = cvt_pk_bf16(v1[2], v1[3]);
                        *(u32x4*)(rowp + bj * HALF) = w; } } }
    }
};
struct EpiMoeMix {
    static constexpr bool PERM = true;
    CArgs* ap; int l;
    __device__ __forceinline__ void operator()(const Acc& acc, const Unit& u, int wr, int wc, int fr, int fq) const {
        CArgs& A = *ap; unsigned char* ws = A.ws;
        if (u.kind == 0) { const EpiSwiglu sw{(bf16_t*)(ws + WS_ACT), A.in[I_BGU] + (size_t)l * 32 * 2048}; sw(acc, u, wr, wc, fr, fq); }
        else { const EpiDown dn{(bf16_t*)(ws + WS_Y), A.in[I_BDN] + (size_t)l * 32 * 1024, (const int*)(ws + WS_LTK) + (size_t)l * 32 * LISTCAP, (const float*)(ws + WS_LG) + (size_t)l * 32 * LISTCAP}; dn(acc, u, wr, wc, fr, fq); }
    }
};
}
struct Frame { unsigned char* lds; int tid, lane, wave, bid, G; };
#define P_MOD   ((float*)(A.ws + WS_MOD))
#define P_S5A   ((float*)(A.ws + WS_S5A))
#define P_S5BB  ((float*)(A.ws + WS_S5BB))
#define P_ROPE  ((float*)(A.ws + WS_ROPE))
#define P_WSIDE ((float*)(A.ws + WS_WSIDE))
#define P_S5CK  ((bf16_t*)(A.ws + WS_S5CK))
#define P_LTK   ((int*)(A.ws + WS_LTK))
#define P_LG    ((float*)(A.ws + WS_LG))
#define P_CNT   ((unsigned*)(A.ws + WS_CTL) + CW_CNT)
#define P_WINE  ((bf16_t*)(A.ws + WS_WINE))
#define P_WGLU  ((bf16_t*)(A.ws + WS_WGLU))
#define P_WOUTE ((bf16_t*)(A.ws + WS_WOUTE))
#define P_WINO  ((bf16_t*)(A.ws + WS_WINO))
#define P_WOUTO ((bf16_t*)(A.ws + WS_WOUTO))
#define P_W1    ((bf16_t*)(A.ws + WS_W1))
#define P_W2    ((bf16_t*)(A.ws + WS_W2))
#define P_HB    ((bf16_t*)(A.ws + WS_HB))
#define P_Z     ((bf16_t*)(A.ws + WS_Z))
#define P_G5    ((bf16_t*)(A.ws + WS_G5))
#define P_YCAT  ((bf16_t*)(A.ws + WS_YCAT))
#define P_ACT   ((bf16_t*)(A.ws + WS_ACT))
#define P_Y     ((bf16_t*)(A.ws + WS_Y))
#define P_LSIG  ((float*)(A.ws + WS_LSIG))
#define P_LOGA  ((float*)(A.ws + WS_LOGA))
#define P_MBUF  ((float*)(A.ws + WS_MBUF))
#define P_XB    ((bf16_t*)(A.ws + WS_XB))
#define P_RST   ((bf16_t*)(A.ws + WS_RST))
#define P_GST   ((bf16_t*)(A.ws + WS_GST))

__device__ __forceinline__ void tr_tile(const float* __restrict__ src, int pitch, int k0, int c0, bf16_t* dst, int Kd, int r0, float* scr, int lane) {
#pragma unroll
    for (int i = 0; i < 16; ++i) {
        const int kk = 4 * i + (lane >> 4), cc = 4 * (lane & 15);
        const f32x4 v = __builtin_nontemporal_load((const f32x4*)(src + (size_t)(k0 + kk) * pitch + c0 + cc));
        float* s = scr + kk * 65 + cc; s[0] = v.x; s[1] = v.y; s[2] = v.z; s[3] = v.w;
    }
    LDS_WAIT();
    const int c = lane & 7;
#pragma unroll
    for (int j = 0; j < 8; ++j) { const int n = (lane >> 3) + 8 * j; const float* s = scr + (8 * c) * 65 + n;
        u32x4 o; o.x = pk2(s[0], s[65]); o.y = pk2(s[130], s[195]); o.z = pk2(s[260], s[325]); o.w = pk2(s[390], s[455]);
        __builtin_nontemporal_store(o, (u32x4*)(dst + (size_t)(r0 + n) * Kd + k0 + 8 * c)); }
    LDS_WAIT();
}
__device__ __forceinline__ void p0_prep(CArgs& A, const Frame& F) {
    float* scr = (float*)(F.lds) + F.wave * (64 * 65);
    const int gw = F.bid * 8 + F.wave, NGW = F.G * 8;
    constexpr int T0 = 16 * 32, T1 = 8 * 8, T2 = 16 * 16, T3 = 16 * 56, T4 = 16 * 16, T5 = 64 * 16 * 32, T6 = 64 * 16 * 16;
    constexpr int NTILES = T0 + T1 + T2 + T3 + T4 + T5 + T6;
    for (int it = gw; it < NTILES; it += NGW) {
        int r = it;
        if (r < T0) { const int kb = r / 32, nb = r % 32; tr_tile(A.in[I_EVWIN], 2056, kb * 64, nb * 64, P_WINE, 1024, nb * 64, scr, F.lane); continue; } r -= T0;
        if (r < T1) { const int kb = r / 8, nb = r % 8; tr_tile(A.in[I_GLUW], 512, kb * 64, nb * 64, P_WGLU, 512, nb * 64, scr, F.lane); continue; } r -= T1;
        if (r < T2) { const int kb = r / 16, nb = r % 16; tr_tile(A.in[I_EVWOUT], 1024, kb * 64, nb * 64, P_WOUTE, 1024, nb * 64, scr, F.lane); continue; } r -= T2;
        if (r < T3) { const int kb = r / 56, nb = r % 56; const int n0 = nb * 64; int c0;
            if (n0 < 1024) { const int pn = n0 >> 8, rem = n0 & 255, bj = rem >> 7, hl = (rem & 127) >> 6; c0 = 256 * pn + 128 * hl + 64 * bj; }
            else if (n0 < 3072) c0 = n0; else c0 = n0 + 16;
            tr_tile(A.in[I_ODWIN], 3600, kb * 64, c0, P_WINO, 1024, n0, scr, F.lane); continue; } r -= T3;
        if (r < T4) { const int kb = r / 16, nb = r % 16; tr_tile(A.in[I_ODWOUT], 1024, kb * 64, nb * 64, P_WOUTO, 1024, nb * 64, scr, F.lane); continue; } r -= T4;
        if (r < T5) { const int mat = r / 512, q = r % 512, kb = q / 32, nb = q % 32; const int n0 = nb * 64, pn = n0 >> 8, half = (n0 & 255) >> 7, j0 = n0 & 127;
            tr_tile(A.in[I_WGU] + (size_t)mat * 1024 * 2048, 2048, kb * 64, half * 1024 + 128 * pn + j0, P_W1 + (size_t)mat * 2048 * 1024, 1024, n0, scr, F.lane); continue; } r -= T5;
        { const int mat = r / 256, q = r % 256, kb = q / 16, nb = q % 16;
            tr_tile(A.in[I_WDN] + (size_t)mat * 1024 * 1024, 1024, kb * 64, nb * 64, P_W2 + (size_t)mat * 1024 * 1024, 1024, nb * 64, scr, F.lane); }
    }
    __syncthreads();
    {
        const int gt = F.bid * 512 + F.tid;
        if (gt < 32 * 64) {
            const int g = gt >> 6;
            const float lr = A.in[I_LAMRE][gt], li = A.in[I_LAMIM][gt], dt = expf(A.in[I_LOGDT][g]);
            const float mag = expf(lr * dt); float sn, cs; sincosf(li * dt, &sn, &cs);
            const float are = mag * cs, aim = mag * sn, den = lr * lr + li * li, nre = are - 1.f, nim = aim;
            const float zre = (nre * lr + nim * li) / den, zim = (nim * lr - nre * li) / den;
            P_S5A[gt * 2] = are; P_S5A[gt * 2 + 1] = aim;
            for (int c = 0; c < 16; ++c) { const float br = A.in[I_BRE][gt * 16 + c], bi = A.in[I_BIM][gt * 16 + c];
                P_S5BB[gt * 32 + c] = zre * br - zim * bi; P_S5BB[gt * 32 + 16 + c] = zre * bi + zim * br; }
        }
        for (int i = gt; i < 32 * 16 * 128; i += F.G * 512) { const int k = i & 127, gc = i >> 7, pp = k >> 1; const float v = (k & 1) ? -A.in[I_CIM][gc * 64 + pp] : A.in[I_CRE][gc * 64 + pp]; P_S5CK[i] = (bf16_t)f2bf(v); }
        for (int i = gt; i < 24 * 1024; i += F.G * 512) { const int o = i >> 10, k = i & 1023; P_WSIDE[i] = o < 8 ? A.in[I_EVWIN][(size_t)k * 2056 + 2048 + o] : A.in[I_ODWIN][(size_t)k * 3600 + 3072 + (o - 8)]; }
        for (int i = gt; i < SEQ * 64; i += F.G * 512) { const int pos = i >> 6, j = i & 63;
            const float inv = exp2f(-(float)j * (13.287712379549449f / 64.f)); const float ang = (float)pos * inv; float sn, cs; sincosf(ang, &sn, &cs);
            P_ROPE[i] = cs; P_ROPE[SEQ * 64 + i] = sn; }
    }
    if (F.bid < 192) {
        float* sc = (float*)F.lds;
        float* red = sc + 8192;
        for (int i = F.tid; i < 8192; i += 512) sc[i] = siluf_(A.in[I_C][i]);
        __syncthreads();
        const int l = F.bid / 96, n = (F.bid % 96) * 64 + F.lane;
        const float* w = A.in[I_ADAW] + (size_t)l * 1024 * 6144 + n;
        float a[8];
#pragma unroll
        for (int b = 0; b < 8; ++b) a[b] = 0.f;
        for (int k = 128 * F.wave; k < 128 * F.wave + 128; ++k) { const float wv = w[(size_t)k * 6144];
#pragma unroll
            for (int b = 0; b < 8; ++b) a[b] += sc[b * 1024 + k] * wv; }
#pragma unroll
        for (int b = 0; b < 8; ++b) red[(F.wave * 8 + b) * 64 + F.lane] = a[b];
        __syncthreads();
        { const int b = F.tid >> 6, ln = F.tid & 63; float s = 0.f;
#pragma unroll
          for (int w8 = 0; w8 < 8; ++w8) s += red[(w8 * 8 + b) * 64 + ln];
          const int nn = (F.bid % 96) * 64 + ln; P_MOD[(size_t)(l * 8 + b) * 6144 + nn] = s + A.in[I_ADAB][l * 6144 + nn]; }
    }
}

struct Row { f32x4 v[4]; };
__device__ __forceinline__ void row_load(Row& r, const float* p, int lane) {
#pragma unroll
    for (int j = 0; j < 4; ++j) r.v[j] = __builtin_nontemporal_load((const f32x4*)(p + 4 * lane + 256 * j));
}
__device__ __forceinline__ void row_load_bf16(Row& r, const bf16_t* p, int lane) {
#pragma unroll
    for (int j = 0; j < 4; ++j) { const u32x2 w = __builtin_nontemporal_load((const u32x2*)(p + 4 * lane + 256 * j)); r.v[j] = (f32x4){bflo(w.x), bfhi(w.x), bflo(w.y), bfhi(w.y)}; }
}
__device__ __forceinline__ void row_store(const Row& r, float* p, int lane) {
#pragma unroll
    for (int j = 0; j < 4; ++j) __builtin_nontemporal_store(r.v[j], (f32x4*)(p + 4 * lane + 256 * j));
}
__device__ __forceinline__ void row_store_bf16(const Row& r, bf16_t* p, int lane) {
#pragma unroll
    for (int j = 0; j < 4; ++j) { u32x2 w; w.x = pk2(r.v[j].x, r.v[j].y); w.y = pk2(r.v[j].z, r.v[j].w); *(u32x2*)(p + 4 * lane + 256 * j) = w; }
}
__device__ __forceinline__ void row_store_bf16_nt(const Row& r, bf16_t* p, int lane) {
#pragma unroll
    for (int j = 0; j < 4; ++j) { u32x2 w; w.x = pk2(r.v[j].x, r.v[j].y); w.y = pk2(r.v[j].z, r.v[j].w); __builtin_nontemporal_store(w, (u32x2*)(p + 4 * lane + 256 * j)); }
}
__device__ __forceinline__ float row_rstd(const Row& r) {
    float s = 0.f;
#pragma unroll
    for (int j = 0; j < 4; ++j) s += (r.v[j].x * r.v[j].x + r.v[j].y * r.v[j].y) + (r.v[j].z * r.v[j].z + r.v[j].w * r.v[j].w);
    return rsqrtf(wave_sum(s) * (1.f / DM) + EPS);
}
__device__ __forceinline__ void row_modnorm(Row& h, const Row& x, const float* gain, const float* sh, const float* sc, int lane) {
    const float r = row_rstd(x);
#pragma unroll
    for (int j = 0; j < 4; ++j) { const int k = 4 * lane + 256 * j; const f32x4 g = *(const f32x4*)(gain + k), a = *(const f32x4*)(sc + k), b = *(const f32x4*)(sh + k);
        h.v[j] = x.v[j] * r * g * (a + 1.f) + b; }
}
__device__ __forceinline__ void hprep_row(CArgs& A, const Frame& F, const Row& x, int l, int row, const float* wl) {
    const int b = row >> 11, lane = F.lane; const float* mod = P_MOD + (size_t)(l * 8 + b) * 6144;
    Row h; row_modnorm(h, x, A.in[I_NPM] + l * DM, mod, mod + 1024, lane);
    row_store_bf16(h, P_HB + (size_t)row * DM, lane);
    if (l == 0) {
        float mine = 0.f;
#pragma unroll
        for (int i = 0; i < 8; ++i) { float p = 0.f;
#pragma unroll
            for (int j = 0; j < 4; ++j) { const f32x4 w = *(const f32x4*)(wl + i * 1024 + 4 * lane + 256 * j); p += (h.v[j].x * w.x + h.v[j].y * w.y) + (h.v[j].z * w.z + h.v[j].w * w.w); }
            const float s = wave_sum(p); if (lane == i) mine = s; if ((i & 3) == 3) asm volatile("" ::: "memory"); }
        if (lane < 8) P_LSIG[(size_t)row * 8 + lane] = log_sigmoidf_(mine + A.in[I_FOXB][lane]);
    } else {
        float p[16];
#pragma unroll
        for (int i = 0; i < 16; ++i) { float q = 0.f;
#pragma unroll
            for (int j = 0; j < 4; ++j) { const f32x4 w = *(const f32x4*)(wl + i * 1024 + 4 * lane + 256 * j); q += (h.v[j].x * w.x + h.v[j].y * w.y) + (h.v[j].z * w.z + h.v[j].w * w.w); }
            p[i] = wave_sum(q); if ((i & 1) == 1) asm volatile("" ::: "memory"); }
        const float* wup = wl + 16 * 1024;
#pragma unroll
        for (int q = 0; q < 4; ++q) { const int jcol = lane + 64 * q; float s = wup[16 * 256 + jcol];
#pragma unroll
            for (int i = 0; i < 16; ++i) s += p[i] * wup[i * 256 + jcol];
            P_LOGA[(size_t)row * 256 + jcol] = log_sigmoidf_(s) * (1.f / 16.f); }
    }
}
__device__ __forceinline__ void stage_side(CArgs& A, const Frame& F, int l, float* wl) {
    __syncthreads();
    if (l == 0) { for (int i = F.tid; i < 8 * 256; i += 512) *(f32x4*)(wl + 4 * i) = *(const f32x4*)(P_WSIDE + 4 * i); }
    else { for (int i = F.tid; i < 16 * 256; i += 512) *(f32x4*)(wl + 4 * i) = *(const f32x4*)(P_WSIDE + 8192 + 4 * i);
           for (int i = F.tid; i < 16 * 64; i += 512) *(f32x4*)(wl + 16384 + 4 * i) = *(const f32x4*)(A.in[I_GLAWUP] + 4 * i);
           if (F.tid < 64) *(f32x4*)(wl + 16384 + 4096 + 4 * F.tid) = *(const f32x4*)(A.in[I_GLABG] + 4 * F.tid); }
    __syncthreads();
}
__device__ __forceinline__ void p1_hprep0(CArgs& A, const Frame& F) {
    float* wl = (float*)F.lds; stage_side(A, F, 0, wl);
    const int gw = F.bid * 8 + F.wave, NGW = F.G * 8;
    Row xn; if (gw < NTOK) row_load(xn, A.in[I_X] + (size_t)gw * DM, F.lane);
#pragma unroll 1
    for (int row = gw; row < NTOK; row += NGW) { Row x;
#pragma unroll
        for (int j = 0; j < 4; ++j) x.v[j] = xn.v[j];
        if (row + NGW < NTOK) row_load(xn, A.in[I_X] + (size_t)(row + NGW) * DM, F.lane); hprep_row(A, F, x, 0, row, wl); }
}

__device__ __forceinline__ void p_postmix(CArgs& A, const Frame& F, int l) {
    float* h2s = (float*)F.lds;
    float* red = h2s + 16 * 1028;
    float* lg = red + 8 * 16 * 32;
    float* tv = lg + 16 * 32;
    int* lcnt = (int*)(tv + 64);
    int* ent = lcnt + 64;
    if (F.tid < 32) lcnt[F.tid] = 0;
    int nent = 0;
    float rb0[32], rb1[32];
    { const float* rw = A.in[I_RW] + (size_t)l * 1024 * 32 + (size_t)(128 * F.wave + (F.lane >> 4)) * 32 + (F.lane & 15);
#pragma unroll
      for (int ks = 0; ks < 32; ++ks) { rb0[ks] = rw[ks * 128]; rb1[ks] = rw[ks * 128 + 16]; } }
    u32x2 pm[2][4]; f32x4 pxf[2][4]; u32x2 pxb[2][4];
#define PM_LOAD(tile_) do { const int r0_ = (tile_) * 16 + 2 * F.wave; _Pragma("unroll") for (int rr = 0; rr < 2; ++rr) _Pragma("unroll") for (int j = 0; j < 4; ++j) { \
        pm[rr][j] = __builtin_nontemporal_load((const u32x2*)((const bf16_t*)P_MBUF + (size_t)(r0_ + rr) * DM + 4 * F.lane + 256 * j)); \
        if (l == 0) pxf[rr][j] = __builtin_nontemporal_load((const f32x4*)(A.in[I_X] + (size_t)(r0_ + rr) * DM + 4 * F.lane + 256 * j)); \
        else pxb[rr][j] = __builtin_nontemporal_load((const u32x2*)(P_XB + (size_t)(r0_ + rr) * DM + 4 * F.lane + 256 * j)); } } while (0)
    if (F.bid < NTOK / 16) PM_LOAD(F.bid);
#pragma unroll 1
    for (int tile = F.bid; tile < NTOK / 16; tile += F.G) {
        const int row0 = tile * 16 + 2 * F.wave;
        Row m0, x0, m1, x1;
#pragma unroll
        for (int j = 0; j < 4; ++j) { m0.v[j] = (f32x4){bflo(pm[0][j].x), bfhi(pm[0][j].x), bflo(pm[0][j].y), bfhi(pm[0][j].y)}; m1.v[j] = (f32x4){bflo(pm[1][j].x), bfhi(pm[1][j].x), bflo(pm[1][j].y), bfhi(pm[1][j].y)};
            if (l == 0) { x0.v[j] = pxf[0][j]; x1.v[j] = pxf[1][j]; }
            else { x0.v[j] = (f32x4){bflo(pxb[0][j].x), bfhi(pxb[0][j].x), bflo(pxb[0][j].y), bfhi(pxb[0][j].y)}; x1.v[j] = (f32x4){bflo(pxb[1][j].x), bfhi(pxb[1][j].x), bflo(pxb[1][j].y), bfhi(pxb[1][j].y)}; } }
        if (tile + F.G < NTOK / 16) PM_LOAD(tile + F.G);
#pragma unroll
        for (int rr = 0; rr < 2; ++rr) {
            const int lr = 2 * F.wave + rr, row = row0 + rr, b = row >> 11; const float* mod = P_MOD + (size_t)(l * 8 + b) * 6144;
            const Row& m = rr ? m1 : m0; Row x = rr ? x1 : x0;
            const float r1 = row_rstd(m);
#pragma unroll
            for (int j = 0; j < 4; ++j) { const int k = 4 * F.lane + 256 * j; const f32x4 gp = *(const f32x4*)(A.in[I_NQM] + l * DM + k), g1 = *(const f32x4*)(mod + 2048 + k);
                x.v[j] = x.v[j] + g1 * (m.v[j] * r1 * gp); }
            row_store_bf16_nt(x, P_XB + (size_t)row * DM, F.lane);
            Row h; row_modnorm(h, x, A.in[I_NPF] + l * DM, mod + 3072, mod + 4096, F.lane);
            row_store_bf16(h, P_HB + (size_t)row * DM, F.lane);
#pragma unroll
            for (int j = 0; j < 4; ++j) *(f32x4*)(h2s + lr * 1028 + 4 * F.lane + 256 * j) = h.v[j];
        }
        __syncthreads();
        {
            f32x4 d0 = {0.f, 0.f, 0.f, 0.f}, d1 = {0.f, 0.f, 0.f, 0.f};
            const int r16 = F.lane & 15, kq = F.lane >> 4;
#pragma unroll
            for (int ks = 0; ks < 32; ++ks) { const float a = h2s[r16 * 1028 + 128 * F.wave + 4 * ks + kq];
                d0 = __builtin_amdgcn_mfma_f32_16x16x4f32(a, rb0[ks], d0, 0, 0, 0); d1 = __builtin_amdgcn_mfma_f32_16x16x4f32(a, rb1[ks], d1, 0, 0, 0); }
#pragma unroll
            for (int q = 0; q < 4; ++q) { red[(F.wave * 16 + 4 * kq + q) * 32 + r16] = d0[q]; red[(F.wave * 16 + 4 * kq + q) * 32 + 16 + r16] = d1[q]; }
        }
        __syncthreads();
        const int r = F.tid >> 5, e = F.tid & 31;
        { float s = A.in[I_RB][l * 32 + e];
#pragma unroll
          for (int w8 = 0; w8 < 8; ++w8) s += red[(w8 * 16 + r) * 32 + e];
          lg[r * 32 + e] = s; }
        __syncthreads();
        const float v = lg[r * 32 + e]; int rank = 0;
#pragma unroll 8
        for (int q = 0; q < 32; ++q) { const float u = lg[r * 32 + q]; rank += (u > v || (u == v && q < e)) ? 1 : 0; }
        if (rank < 4) tv[r * 4 + rank] = v;
        __syncthreads();
        if (rank < 4) { const f32x4 t4 = *(const f32x4*)(tv + r * 4);
            const float wsum = 1.f + __expf(t4.y - t4.x) + __expf(t4.z - t4.x) + __expf(t4.w - t4.x), wk = __expf(v - t4.x);
            const int token = tile * 16 + r, lpos = atomicAdd(lcnt + e, 1), slot = nent + r * 4 + rank;
            ent[slot * 4] = e; ent[slot * 4 + 1] = lpos; ent[slot * 4 + 2] = token * 4 + rank; ent[slot * 4 + 3] = __float_as_int(wk / wsum); }
        nent += 64;
        __syncthreads();
    }
#undef PM_LOAD
    unsigned* cntp = P_CNT; int* ltk = P_LTK; float* lgp = P_LG;
    if (F.tid < 32) { const int n = lcnt[F.tid]; lcnt[32 + F.tid] = n > 0 ? (int)atomicAdd(cntp + 64 * (l * 32 + F.tid), (unsigned)n) : 0; }
    __syncthreads();
    if (F.tid < nent) { const int e = ent[F.tid * 4], pos = lcnt[32 + e] + ent[F.tid * 4 + 1];
        ltk[(size_t)(l * 32 + e) * LISTCAP + pos] = ent[F.tid * 4 + 2]; lgp[(size_t)(l * 32 + e) * LISTCAP + pos] = __int_as_float(ent[F.tid * 4 + 3]); }
    __syncthreads();
}
__device__ __forceinline__ void p_combine(CArgs& A, const Frame& F, int l) {
    float* wl = (float*)F.lds; if (l == 0) stage_side(A, F, 1, wl);
    const int gw = F.bid * 8 + F.wave, NGW = F.G * 8;
    u32x2 y[4][4]; Row xr;
#define COMB_LOAD(row_) do { _Pragma("unroll") for (int k = 0; k < 4; ++k) _Pragma("unroll") for (int j = 0; j < 4; ++j) y[k][j] = __builtin_nontemporal_load((const u32x2*)(P_Y + (size_t)((row_) * 4 + k) * DM + 4 * F.lane + 256 * j)); \
        row_load_bf16(xr, P_XB + (size_t)(row_) * DM, F.lane); } while (0)
    if (gw < NTOK) COMB_LOAD(gw);
#pragma unroll 1
    for (int row = gw; row < NTOK; row += NGW) {
        const int b = row >> 11; const float* mod = P_MOD + (size_t)(l * 8 + b) * 6144;
        Row f;
#pragma unroll
        for (int j = 0; j < 4; ++j) { f.v[j] = (f32x4){0.f, 0.f, 0.f, 0.f};
#pragma unroll
            for (int k = 0; k < 4; ++k) { const u32x2 w = y[k][j]; f.v[j].x += bflo(w.x); f.v[j].y += bfhi(w.x); f.v[j].z += bflo(w.y); f.v[j].w += bfhi(w.y); } }
        Row x = xr;
        if (row + NGW < NTOK) COMB_LOAD(row + NGW);
        const float r = row_rstd(f);
#pragma unroll
        for (int j = 0; j < 4; ++j) { const int k = 4 * F.lane + 256 * j; const f32x4 gp = *(const f32x4*)(A.in[I_NQF] + l * DM + k), g2 = *(const f32x4*)(mod + 5120 + k);
            x.v[j] = x.v[j] + g2 * (f.v[j] * r * gp); }
        if (l == 0) row_store_bf16_nt(x, P_XB + (size_t)row * DM, F.lane); else row_store(x, A.out + (size_t)row * DM, F.lane);
        if (l == 0) hprep_row(A, F, x, 1, row, wl);
    }
#undef COMB_LOAD
}
__device__ __forceinline__ int moe_tables(CArgs& A, const Frame& F, int l, LAS pg8::MoeTables* tb) {
    __syncthreads();
    if (F.tid < 32) tb->cnt[F.tid] = (int)__hip_atomic_load(P_CNT + 64 * (l * 32 + F.tid), __ATOMIC_RELAXED, __HIP_MEMORY_SCOPE_AGENT);
    __syncthreads();
    if (F.tid == 0) { int s = 0;
#pragma nounroll
        for (int e = 0; e < 32; ++e) { tb->mtstart[e] = s; s += (tb->cnt[e] + 255) >> 8; }
        tb->mtstart[32] = s; }
    __syncthreads();
    if (F.tid < 320) { int e = 0;
#pragma nounroll
        for (int q = 1; q < 32; ++q) if (tb->mtstart[q] <= F.tid) e = q;
        tb->tile_e[F.tid] = (unsigned char)e; }
    __syncthreads();
    return tb->mtstart[32];
}
__device__ __forceinline__ void fox_kbias(CArgs& A, const Frame& F, int b, int h, float* kb, float* wtot  ) {
    const int t0 = 4 * F.tid; float e[4];
#pragma unroll
    for (int i = 0; i < 4; ++i) e[i] = P_LSIG[(size_t)(b * SEQ + t0 + i) * 8 + h];
    const float s4 = (e[0] + e[1]) + (e[2] + e[3]); float v = s4;
#pragma unroll
    for (int o = 1; o < 64; o <<= 1) { const float tt = __shfl_up(v, o); if (F.lane >= o) v += tt; }
    if (F.lane == 63) wtot[F.wave] = v;
    __syncthreads();
    float off = 0.f;
#pragma unroll
    for (int w = 0; w < 8; ++w) if (w < F.wave) off += wtot[w];
    float c = off + v - s4;
#pragma unroll
    for (int i = 0; i < 4; ++i) { c += e[i]; kb[t0 + i] = -LOG2E * c; }
    __syncthreads();
}
#include <hip/hip_bf16.h>
namespace attn_body {
using bf16=__hip_bfloat16;
using bf16x8=__attribute__((ext_vector_type(8)))short;
using s16x4=__attribute__((ext_vector_type(4)))short;
using f32x16=__attribute__((ext_vector_type(16)))float;
using u32x4=__attribute__((ext_vector_type(4)))unsigned;
constexpr int BATCH=8,NHEAD=8,SEQ=2048,D=64,QP=2048,OP=1024;
constexpr int NW=8,QBLK=32,QB=QBLK*NW,KVBLK=64,NQB=SEQ/QB;
constexpr int ATTN_UNIT_ROWS=QB;
__device__ __forceinline__ int crow(int r,int hi){return (r&3)+8*(r>>2)+4*hi;}
#define SBAR() __builtin_amdgcn_sched_barrier(0)
__device__ __forceinline__ void cmask(f32x16&p0,f32x16&p1,int jb,int qrel,int hi){
  const float NEG=-INFINITY; int kb=64*jb+4*hi;
  #pragma unroll
  for(int r=0;r<16;++r){int kv=kb+(r&3)+8*(r>>2); if(kv>qrel)p0[r]=NEG; if(kv+32>qrel)p1[r]=NEG;}
}

constexpr int NSLOT=3, SLOTB=8192;
constexpr int LDS_K=0, LDS_V=NSLOT*SLOTB, LDS_WS=2*NSLOT*SLOTB, LDS_OST=LDS_WS+NW*64*4, LDS_BYTES=LDS_OST+NW*4096;
constexpr float C2=0.125f*1.4426950408889634f;
__device__ __forceinline__ void glds16(const void*gsrc,unsigned lds_dst){unsigned keep;
  asm volatile("s_mov_b32 %0, m0\n\ts_mov_b32 m0, %2\n\ts_nop 0\n\tglobal_load_lds_dwordx4 %1, off\n\ts_mov_b32 m0, %0":"=&s"(keep):"v"(gsrc),"s"(lds_dst):"memory");}
__device__ __forceinline__ float max3f(float a,float b,float c){float r;asm("v_max3_f32 %0, %1, %2, %3":"=v"(r):"v"(a),"v"(b),"v"(c));return r;}
__device__ __forceinline__ float max2f(float a,float b){float r;asm("v_max_f32_e32 %0, %1, %2":"=v"(r):"v"(a),"v"(b));return r;}
__device__ __forceinline__ float fadd_s(float a,float b){float r;asm("v_add_f32_e32 %0, %1, %2":"=v"(r):"v"(a),"v"(b));return r;}
__device__ __forceinline__ float fsub_s(float a,float b){float r;asm("v_sub_f32_e32 %0, %1, %2":"=v"(r):"v"(a),"v"(b));return r;}
typedef float f32x2_t __attribute__((ext_vector_type(2))); typedef float f32x4_t __attribute__((ext_vector_type(4))); typedef __bf16 bf16x2_t __attribute__((ext_vector_type(2)));
__device__ __forceinline__ unsigned cvtpk_s(float lo,float hi){f32x2_t v={lo,hi};bf16x2_t b=__builtin_convertvector(v,bf16x2_t);return __builtin_bit_cast(unsigned,b);}
#define WAIT_BAR(N) asm volatile("s_waitcnt vmcnt(" #N ") lgkmcnt(0)\n\ts_barrier":::"memory")

__device__ __forceinline__ void qkt(f32x16&p0,f32x16&p1,const char*Kslot,const bf16x8*qr,const f32x16&c0i,const f32x16&c1i,int r32,int hi){
  const char*kb=Kslot+hi*1024+r32*16;
  #pragma unroll
  for(int d0=0;d0<4;++d0){
    const bf16x8 b0=*reinterpret_cast<const bf16x8*>(kb+d0*2048);
    const bf16x8 b1=*reinterpret_cast<const bf16x8*>(kb+d0*2048+512);
    if(d0==0){p0=__builtin_amdgcn_mfma_f32_32x32x16_bf16(b0,qr[0],c0i,0,0,0);p1=__builtin_amdgcn_mfma_f32_32x32x16_bf16(b1,qr[0],c1i,0,0,0);}
    else{p0=__builtin_amdgcn_mfma_f32_32x32x16_bf16(b0,qr[d0],p0,0,0,0);p1=__builtin_amdgcn_mfma_f32_32x32x16_bf16(b1,qr[d0],p1,0,0,0);}}
}
typedef __attribute__((address_space(3))) const char* lds_cptr;
typedef short v4i16_t __attribute__((ext_vector_type(4)));
__device__ __forceinline__ void kload8(bf16x8*kf,lds_cptr kp){
  kf[0]=*(const __attribute__((address_space(3))) bf16x8*)(kp);      kf[1]=*(const __attribute__((address_space(3))) bf16x8*)(kp+512);
  kf[2]=*(const __attribute__((address_space(3))) bf16x8*)(kp+2048); kf[3]=*(const __attribute__((address_space(3))) bf16x8*)(kp+2560);
  kf[4]=*(const __attribute__((address_space(3))) bf16x8*)(kp+4096); kf[5]=*(const __attribute__((address_space(3))) bf16x8*)(kp+4608);
  kf[6]=*(const __attribute__((address_space(3))) bf16x8*)(kp+6144); kf[7]=*(const __attribute__((address_space(3))) bf16x8*)(kp+6656);
}
__device__ __forceinline__ void kload2(bf16x8*kf,lds_cptr kp,int j){ kf[2*j]=*(const __attribute__((address_space(3))) bf16x8*)(kp+j*2048); kf[2*j+1]=*(const __attribute__((address_space(3))) bf16x8*)(kp+j*2048+512); }
__device__ __forceinline__ s16x4 vtr(lds_cptr p){ return __builtin_bit_cast(s16x4,__builtin_amdgcn_ds_read_tr16_b64_v4i16((__attribute__((address_space(3))) v4i16_t*)p)); }
__device__ __forceinline__ float rowmax(const f32x16&p0,const f32x16&p1){
  float a=max3f(p0[0],p0[1],p1[0]),b=max3f(p0[2],p0[3],p1[1]);a=max3f(a,p1[2],p1[3]);
  #pragma unroll
  for(int r=4;r<16;r+=4){a=max3f(a,p0[r],p0[r+1]);b=max3f(b,p0[r+2],p0[r+3]);a=max3f(a,p1[r],p1[r+1]);b=max3f(b,p1[r+2],p1[r+3]);}
  const float m=max2f(a,b);
  auto rr=__builtin_amdgcn_permlane32_swap(__float_as_uint(m),__float_as_uint(m),false,false);
  return max2f(__uint_as_float(rr[0]),__uint_as_float(rr[1]));
}
__device__ __forceinline__ void pv(f32x16*o,int vb,bf16x8 pa0,bf16x8 pa1,bf16x8 pa2,bf16x8 pa3){
  #pragma unroll
  for(int d0=0;d0<2;++d0){s16x4 lo[4],hi[4];
    #pragma unroll
    for(int ks=0;ks<4;++ks){
      asm volatile("ds_read_b64_tr_b16 %0,%1 offset:%c2":"=&v"(lo[ks]):"v"(vb),"i"(d0*4096+ks*1024):"memory");
      asm volatile("ds_read_b64_tr_b16 %0,%1 offset:%c2":"=&v"(hi[ks]):"v"(vb),"i"(d0*4096+ks*1024+512):"memory");}
    asm volatile("s_waitcnt lgkmcnt(0)":::"memory");SBAR();
    #define PK(k) (bf16x8){lo[k][0],lo[k][1],lo[k][2],lo[k][3],hi[k][0],hi[k][1],hi[k][2],hi[k][3]}
    o[d0]=__builtin_amdgcn_mfma_f32_32x32x16_bf16(pa0,PK(0),o[d0],0,0,0);
    o[d0]=__builtin_amdgcn_mfma_f32_32x32x16_bf16(pa1,PK(1),o[d0],0,0,0);
    o[d0]=__builtin_amdgcn_mfma_f32_32x32x16_bf16(pa2,PK(2),o[d0],0,0,0);
    o[d0]=__builtin_amdgcn_mfma_f32_32x32x16_bf16(pa3,PK(3),o[d0],0,0,0);
    #undef PK
  }
}

#ifndef ATTN_STORE16
#define ATTN_STORE16(p,v) (*(u32x4*)(p)=(v))
#endif
typedef const __attribute__((address_space(3))) float* lds_fptr;
template<int THRL> __device__ __forceinline__ void attn_unit(int b,int h,int qb,const bf16*Q,const bf16*__restrict__ K,const bf16*__restrict__ V,bf16*O,char*shm,lds_fptr kb,int tid,int wid){
  const int lane=tid&63,r32=lane&31,hi=lane>>5;
  const long rowbase=(long)b*SEQ; const int q0=qb*QB;
  const bf16*Qw=Q+(rowbase+q0+wid*QBLK)*QP+h*D;
  const bf16*Kh=K+rowbase*QP+h*D,*Vh=V+rowbase*QP+h*D;
  const unsigned lds0=(unsigned)(uintptr_t)shm;
  float*wsf=(float*)(shm+LDS_WS)+wid*64;
  const bf16*ksrc=Kh+(long)lane*QP+wid*8;
  const bf16*vsrc=Vh+(long)(16*(wid&3)+(lane>>2))*QP+(wid>>2)*32+(lane&3)*8;
  const unsigned kdst=lds0+LDS_K+wid*1024, vdst=lds0+LDS_V+wid*1024;
  #define DMA_K(t,slot) glds16(ksrc+(long)(t)*KVBLK*QP,(unsigned)__builtin_amdgcn_readfirstlane(kdst+(slot)))
  #define DMA_V(t,slot) glds16(vsrc+(long)(t)*KVBLK*QP,(unsigned)__builtin_amdgcn_readfirstlane(vdst+(slot)))
  const int vb0=(int)(lds0+LDS_V)+((lane>>4)&1)*32+(lane&3)*8+(4*hi+((lane&15)>>2))*64;
  const char*Kbase=shm+LDS_K; bf16x8 kf[8];
  const lds_cptr shm3=(lds_cptr)shm; const lds_cptr kp0=shm3+LDS_K+hi*1024+r32*16; const lds_cptr vp0=shm3+LDS_V+((lane>>4)&1)*32+(lane&3)*8+(4*hi+((lane&15)>>2))*64;
  const int NT=(q0+QB)/KVBLK;
  DMA_K(0,0);DMA_V(0,0);DMA_K(1,SLOTB);
  bf16x8 qr[4];
  #pragma unroll
  for(int d0=0;d0<4;++d0)qr[d0]=*reinterpret_cast<const bf16x8*>(&Qw[(long)r32*QP+d0*16+hi*8]);
  float mhat=0.f,l_reg=0.f;f32x16 o[2];o[0]=f32x16{};o[1]=f32x16{};float nm=0.f;
  #define BIASFILL(C0,C1,t) do{ const lds_fptr kbt_=kb+64*(t)+4*hi; _Pragma("unroll") for(int g_=0;g_<4;++g_){ const f32x4_t v0_=*(const __attribute__((address_space(3))) f32x4_t*)(kbt_+8*g_), v1_=*(const __attribute__((address_space(3))) f32x4_t*)(kbt_+32+8*g_); \
      _Pragma("unroll") for(int i_=0;i_<4;++i_){ C0[4*g_+i_]=v0_[i_]+nm; C1[4*g_+i_]=v1_[i_]+nm; } } }while(0)
  const int qrel=wid*QBLK+r32;
  #define CMASK(P0,P1,t) do{int jb_=(t)-(NT-4); if(jb_>=0)cmask(P0,P1,jb_,qrel,hi);}while(0)
  bool resc=false;
  #define START(P0,P1) do{ const float rm=rowmax(P0,P1); resc=false; \
    { const float dl=rm; mhat=fadd_s(mhat,dl); \
      _Pragma("unroll") for(int r=0;r<16;++r){P0[r]=fsub_s(P0[r],dl);P1[r]=fsub_s(P1[r],dl);} \
      nm=-mhat; } \
    _Pragma("unroll") for(int r=0;r<16;++r)P0[r]=__builtin_amdgcn_exp2f(P0[r]); }while(0)
  #define RESC() do{ if(resc){ asm volatile("s_waitcnt lgkmcnt(0)":::"memory"); \
      _Pragma("unroll") for(int d_=0;d_<2;++d_) _Pragma("unroll") for(int r=0;r<16;++r)o[d_][r]*=wsf[crow(r,hi)]; } }while(0)
  f32x16 pA0,pA1,pB0,pB1;
  int sl_prev=0,sl_cur=0,sl_next=SLOTB;
  #define ROT() do{sl_prev=sl_cur;sl_cur=sl_next;sl_next=(sl_next==(NSLOT-1)*SLOTB)?0:sl_next+SLOTB;}while(0)
  DMA_K(2,2*SLOTB);
  WAIT_BAR(3);
  { f32x16 c0i,c1i; BIASFILL(c0i,c1i,0); qkt(pA0,pA1,Kbase,qr,c0i,c1i,r32,hi); }asm volatile("s_nop 15\n\ts_nop 7":"+v"(pA0),"+v"(pA1));CMASK(pA0,pA1,0);
  START(pA0,pA1);
  _Pragma("unroll") for(int r=0;r<16;++r)pA1[r]=__builtin_amdgcn_exp2f(pA1[r]);
  WAIT_BAR(0);
  DMA_K(3,0);DMA_V(1,SLOTB);
  ROT();
  kload8(kf,kp0+sl_cur);
  WAIT_BAR(2);
  s16x4 vlo[8],vhi[8]; u32x4 pw0,pw1,pw2,pw3;
  #define PKW(P,B) cvtpk_s(P[B],P[B+1])
  #define PAF(k) __builtin_bit_cast(bf16x8,pw##k)
  #define VFR(i) (bf16x8){vlo[i][0],vlo[i][1],vlo[i][2],vlo[i][3],vhi[i][0],vhi[i][1],vhi[i][2],vhi[i][3]}
  #define PIN(x) asm volatile("":"+v"(x))
  #define MX3(a,b,c) __builtin_fmaxf(__builtin_fmaxf((a),(b)),(c))
  #define GAPA(MF,A0,A1,A2,A3,W0,W1,PW) do{ MF; sacc+=A0; sacc+=A1; sacc+=A2; sacc+=A3; PIN(sacc); W0; W1; PIN(PW); SBAR(); }while(0)
  #define EX(v) __builtin_amdgcn_exp2f(v)
  #define GAPB(MF,X,B) do{ MF; X[B]=EX(X[B]); X[B+1]=EX(X[B+1]); X[B+2]=EX(X[B+2]); X[B+3]=EX(X[B+3]); PIN(X); SBAR(); }while(0)
  #define VRD(i) do{ vlo[i]=vtr(vp_+(((i)>>2)*4096+((i)&3)*1024)); vhi[i]=vtr(vp_+(((i)>>2)*4096+((i)&3)*1024+512)); }while(0)
  #define KRD(G,j) do{ if(G){ kload2(kf,kp0+sl_next,j); SBAR(); } }while(0)
  #define STEP(C0,C1,P0,P1,t,GK,GV,GL) do{ SBAR(); BIASFILL(C0,C1,t); SBAR(); \
    const lds_cptr vp_=vp0+sl_prev; \
    VRD(0); SBAR(); float sacc=(P0[0]+P0[1]); \
    GAPA(C0=__builtin_amdgcn_mfma_f32_32x32x16_bf16(kf[0],qr[0],C0,0,0,0), P0[2],P0[3],P0[4],P0[5],     pw0[0]=PKW(P0,0), pw0[1]=PKW(P0,2), pw0); \
    VRD(4); SBAR(); GAPA(C1=__builtin_amdgcn_mfma_f32_32x32x16_bf16(kf[1],qr[0],C1,0,0,0), P0[6],P0[7],P0[8],P0[9],     pw0[2]=PKW(P0,4), pw0[3]=PKW(P0,6), pw0); \
    VRD(1); SBAR(); GAPA(C0=__builtin_amdgcn_mfma_f32_32x32x16_bf16(kf[2],qr[1],C0,0,0,0),   P0[10],P0[11],P0[12],P0[13], pw1[0]=PKW(P0,8), pw1[1]=PKW(P0,10), pw1); \
    VRD(5); SBAR(); GAPA(C1=__builtin_amdgcn_mfma_f32_32x32x16_bf16(kf[3],qr[1],C1,0,0,0),   P0[14],P0[15],P1[0],P1[1],   pw1[2]=PKW(P0,12),pw1[3]=PKW(P0,14), pw1); \
    VRD(2); SBAR(); GAPA(C0=__builtin_amdgcn_mfma_f32_32x32x16_bf16(kf[4],qr[2],C0,0,0,0),   P1[2],P1[3],P1[4],P1[5],     pw2[0]=PKW(P1,0), pw2[1]=PKW(P1,2), pw2); \
    VRD(6); SBAR(); GAPA(C1=__builtin_amdgcn_mfma_f32_32x32x16_bf16(kf[5],qr[2],C1,0,0,0),   P1[6],P1[7],P1[8],P1[9],     pw2[2]=PKW(P1,4), pw2[3]=PKW(P1,6), pw2); \
    VRD(3); SBAR(); GAPA(C0=__builtin_amdgcn_mfma_f32_32x32x16_bf16(kf[6],qr[3],C0,0,0,0),   P1[10],P1[11],P1[12],P1[13], pw3[0]=PKW(P1,8), pw3[1]=PKW(P1,10), pw3); \
    VRD(7); SBAR(); GAPA(C1=__builtin_amdgcn_mfma_f32_32x32x16_bf16(kf[7],qr[3],C1,0,0,0),   P1[14],P1[15],0.f,0.f,       pw3[2]=PKW(P1,12),pw3[3]=PKW(P1,14), pw3); \
    l_reg+=sacc; \
    if(GK){DMA_K((t)+3,sl_cur);} if(GV){DMA_V((t)+1,sl_next);} \
    CMASK(C0,C1,t); \
    { float a=MX3(C0[0],C0[1],C1[0]),b=MX3(C0[2],C0[3],C1[1]); a=MX3(a,C1[2],C1[3]); \
      _Pragma("unroll") for(int r=4;r<16;r+=4){a=MX3(a,C0[r],C0[r+1]);b=MX3(b,C0[r+2],C0[r+3]);a=MX3(a,C1[r],C1[r+1]);b=MX3(b,C1[r+2],C1[r+3]);} \
      float rm=__builtin_fmaxf(a,b); { auto rr=__builtin_amdgcn_permlane32_swap(__float_as_uint(rm),__float_as_uint(rm),false,false); rm=__builtin_fmaxf(__uint_as_float(rr[0]),__uint_as_float(rr[1])); } \
      resc=false; \
      if(__builtin_expect(__any(rm>(float)THRL),0)){ const float dl=__builtin_fmaxf(rm,0.f); mhat+=dl; \
        _Pragma("unroll") for(int r=0;r<16;++r){C0[r]-=dl;C1[r]-=dl;} \
        nm=-mhat; \
        const float f=__builtin_amdgcn_exp2f(-dl); l_reg*=f; if(hi==0)wsf[r32]=f; resc=true; } } \
    SBAR(); \
    GAPB(o[0]=__builtin_amdgcn_mfma_f32_32x32x16_bf16(PAF(0),VFR(0),o[0],0,0,0), C0,0); \
    GAPB(o[1]=__builtin_amdgcn_mfma_f32_32x32x16_bf16(PAF(0),VFR(4),o[1],0,0,0), C0,4); \
    KRD(GL,0); GAPB(o[0]=__builtin_amdgcn_mfma_f32_32x32x16_bf16(PAF(1),VFR(1),o[0],0,0,0), C0,8); \
    KRD(GL,1); GAPB(o[1]=__builtin_amdgcn_mfma_f32_32x32x16_bf16(PAF(1),VFR(5),o[1],0,0,0), C0,12); \
    KRD(GL,2); GAPB(o[0]=__builtin_amdgcn_mfma_f32_32x32x16_bf16(PAF(2),VFR(2),o[0],0,0,0), C1,0); \
    KRD(GL,3); GAPB(o[1]=__builtin_amdgcn_mfma_f32_32x32x16_bf16(PAF(2),VFR(6),o[1],0,0,0), C1,4); \
    GAPB(o[0]=__builtin_amdgcn_mfma_f32_32x32x16_bf16(PAF(3),VFR(3),o[0],0,0,0), C1,8); \
    GAPB(o[1]=__builtin_amdgcn_mfma_f32_32x32x16_bf16(PAF(3),VFR(7),o[1],0,0,0), C1,12); \
    }while(0)
  int t=1;
  #undef CMASK
  #define CMASK(P0,P1,t) do{}while(0)
  for(;t+5<NT;t+=2){
    STEP(pB0,pB1,pA0,pA1,t,true,true,true);     WAIT_BAR(2); RESC(); ROT();
    STEP(pA0,pA1,pB0,pB1,t+1,true,true,true);   WAIT_BAR(2); RESC(); ROT();
  }
  #undef CMASK
  #define CMASK(P0,P1,t) do{int jb_=(t)-(NT-4); if(jb_>=0)cmask(P0,P1,jb_,qrel,hi);}while(0)
  #define ENDW(tt) do{ if((tt)+3<NT){WAIT_BAR(2);} else if((tt)+2<NT){WAIT_BAR(1);} else {WAIT_BAR(0);} }while(0)
  for(;t+1<NT;t+=2){
    STEP(pB0,pB1,pA0,pA1,t,(t+3<NT),(t+1<NT),(t+1<NT));       ENDW(t);   RESC(); ROT();
    STEP(pA0,pA1,pB0,pB1,t+1,(t+4<NT),(t+2<NT),(t+2<NT));     ENDW(t+1); RESC(); ROT();
  }
  STEP(pB0,pB1,pA0,pA1,NT-1,false,false,false); RESC();
  { float sacc=pB0[0]+pB0[1]; _Pragma("unroll") for(int r=2;r<16;++r)sacc+=pB0[r]; _Pragma("unroll") for(int r=0;r<16;++r)sacc+=pB1[r]; l_reg+=sacc;
    pw0=(u32x4){PKW(pB0,0),PKW(pB0,2),PKW(pB0,4),PKW(pB0,6)};pw1=(u32x4){PKW(pB0,8),PKW(pB0,10),PKW(pB0,12),PKW(pB0,14)};pw2=(u32x4){PKW(pB1,0),PKW(pB1,2),PKW(pB1,4),PKW(pB1,6)};pw3=(u32x4){PKW(pB1,8),PKW(pB1,10),PKW(pB1,12),PKW(pB1,14)};
    SBAR(); pv(o,vb0+sl_cur,PAF(0),PAF(1),PAF(2),PAF(3)); }
  #undef PKW
  #undef PAF
  #undef VFR
  #undef PIN
  #undef MX3
  #undef GAPA
  #undef GAPB
  #undef EX
  #undef VRD
  #undef KRD
  #undef STEP
  #undef ENDW
  {auto rr=__builtin_amdgcn_permlane32_swap(__float_as_uint(l_reg),__float_as_uint(l_reg),false,false);l_reg=__uint_as_float(rr[0])+__uint_as_float(rr[1]);}
  if(hi==0)wsf[32+r32]=l_reg;asm volatile("s_waitcnt lgkmcnt(0)":::"memory");
  float rli[16];
  #pragma unroll
  for(int r=0;r<16;++r)rli[r]=__builtin_amdgcn_rcpf(wsf[32+crow(r,hi)]);
  bf16*Ow=O+(rowbase+q0+wid*QBLK)*OP+h*D;
  { bf16*stg=(bf16*)(shm+LDS_OST)+wid*2048;
    #pragma unroll
    for(int r=0;r<16;++r){const int orow=crow(r,hi);
      #pragma unroll
      for(int d0=0;d0<2;++d0)stg[orow*64+d0*32+r32]=__float2bfloat16(o[d0][r]*rli[r]);}
    asm volatile("s_waitcnt lgkmcnt(0)":::"memory");
    #pragma unroll
    for(int i=0;i<4;++i){const int row=i*8+(lane>>3),ch=lane&7; const u32x4 v=*(const u32x4*)(stg+row*64+ch*8); ATTN_STORE16(Ow+(long)row*OP+ch*8,v);} }
  asm volatile("s_waitcnt lgkmcnt(0)\n\ts_barrier":::"memory");
  #undef DMA_K
  #undef DMA_V
  #undef CMASK
  #undef START
  #undef RESC
  #undef ROT
  #undef BIASFILL
}
constexpr int ATTN_LDS_BYTES=LDS_BYTES;
#undef SBAR
#undef WAIT_BAR
}
__device__ __forceinline__ void fox_fast(CArgs& A, const Frame& F) {
    float* kb = (float*)(F.lds + 86016); float* wtot = kb + 2048;
    const int v = (F.bid & 7) * 32 + (F.bid >> 3), bh = v >> 2, s = v & 3, b = bh >> 3, h = bh & 7;
    fox_kbias(A, F, b, h, kb, wtot);
    const attn_body::bf16* Zb = (const attn_body::bf16*)P_Z;
    const attn_body::lds_fptr kb3 = (attn_body::lds_fptr)(const __attribute__((address_space(3))) unsigned char*)((LAS unsigned char*)F.lds + 86016);
    attn_body::attn_unit<8>(b, h, 7 - s, Zb + 512, Zb + 1024, Zb + 1536, (attn_body::bf16*)P_YCAT + 512, (char*)F.lds, kb3, F.tid, F.wave);
    attn_body::attn_unit<8>(b, h, s, Zb + 512, Zb + 1024, Zb + 1536, (attn_body::bf16*)P_YCAT + 512, (char*)F.lds, kb3, F.tid, F.wave);
}
typedef float f32x16 __attribute__((ext_vector_type(16)));
__device__ __forceinline__ bf16x8 pack8(const f32x4& a, const f32x4& b) { u32x4 w; w.x = pk2(a.x, a.y); w.y = pk2(a.z, a.w); w.z = pk2(b.x, b.y); w.w = pk2(b.z, b.w); return __builtin_bit_cast(bf16x8, w); }
__device__ __forceinline__ void s5_fast(CArgs& A, const Frame& F, int item) {
    const int b = item >> 5, g = item & 31, lane = F.lane, w = F.wave, p = lane & 31, hh = lane >> 5, l15 = lane & 15, l4 = lane >> 4;
    float* Eseg = (float*)F.lds; float* Hin = Eseg + 2048;
    bf16_t* Hs = (bf16_t*)(F.lds + 16384) + w * 4352;
    bf16x8 bbr[2], bbi[2]; float are[2], aim[2];
#pragma unroll
    for (int nt = 0; nt < 2; ++nt) { const float* q = P_S5BB + (size_t)(g * 64 + 32 * nt + p) * 32 + 8 * hh;
        bbr[nt] = pack8(*(const f32x4*)q, *(const f32x4*)(q + 4)); bbi[nt] = pack8(*(const f32x4*)(q + 16), *(const f32x4*)(q + 20));
        are[nt] = P_S5A[(g * 64 + 32 * nt + p) * 2]; aim[nt] = P_S5A[(g * 64 + 32 * nt + p) * 2 + 1]; }
    const int rr = lane & 31, ahalf = (rr >> 2) & 1, atau = (rr & 3) + 4 * (rr >> 3);
    const bf16_t* usrc = P_Z + (size_t)(b * SEQ + 128 * (2 * w + ahalf) + atau) * ZP0 + g * 16 + 8 * hh;
    const f32x16 zero16 = {0.f, 0.f, 0.f, 0.f, 0.f, 0.f, 0.f, 0.f, 0.f, 0.f, 0.f, 0.f, 0.f, 0.f, 0.f, 0.f};
    float hr[2] = {0.f, 0.f}, hi[2] = {0.f, 0.f};
#define S5_ALOAD(blk_) (*(const bf16x8*)(usrc + (size_t)(blk_) * 16 * ZP0))
    { bf16x8 a0 = S5_ALOAD(0), a1 = S5_ALOAD(1), a2 = S5_ALOAD(2);
#pragma unroll 1
      for (int blk = 0; blk < 8; ++blk) {
        const bf16x8 a = a0; a0 = a1; a1 = a2; if (blk + 3 < 8) a2 = S5_ALOAD(blk + 3);
#pragma unroll
        for (int nt = 0; nt < 2; ++nt) {
            const f32x16 dre = __builtin_amdgcn_mfma_f32_32x32x16_bf16(a, bbr[nt], zero16, 0, 0, 0), dim = __builtin_amdgcn_mfma_f32_32x32x16_bf16(a, bbi[nt], zero16, 0, 0, 0);
#pragma unroll
            for (int i = 0; i < 16; ++i) { const float nr = are[nt] * hr[nt] - aim[nt] * hi[nt] + dre[i], ni = are[nt] * hi[nt] + aim[nt] * hr[nt] + dim[i]; hr[nt] = nr; hi[nt] = ni; }
        }
      } }
#pragma unroll
    for (int nt = 0; nt < 2; ++nt) { Eseg[((2 * w + hh) * 64 + 32 * nt + p) * 2] = hr[nt]; Eseg[((2 * w + hh) * 64 + 32 * nt + p) * 2 + 1] = hi[nt]; }
    __syncthreads();
    if (w == 0) {
        float xr = P_S5A[(g * 64 + lane) * 2], xi = P_S5A[(g * 64 + lane) * 2 + 1];
#pragma unroll
        for (int q = 0; q < 7; ++q) { const float nr = xr * xr - xi * xi, ni = 2.f * xr * xi; xr = nr; xi = ni; }
        float Hr = 0.f, Hi = 0.f;
#pragma unroll 1
        for (int s = 0; s < 16; ++s) { Hin[(s * 64 + lane) * 2] = Hr; Hin[(s * 64 + lane) * 2 + 1] = Hi;
            const float er = Eseg[(s * 64 + lane) * 2], ei = Eseg[(s * 64 + lane) * 2 + 1]; const float nr = xr * Hr - xi * Hi + er, ni = xr * Hi + xi * Hr + ei; Hr = nr; Hi = ni; }
    }
    __syncthreads();
#pragma unroll
    for (int nt = 0; nt < 2; ++nt) { hr[nt] = Hin[((2 * w + hh) * 64 + 32 * nt + p) * 2]; hi[nt] = Hin[((2 * w + hh) * 64 + 32 * nt + p) * 2 + 1]; }
    bf16x8 ck[4];
#pragma unroll
    for (int ks = 0; ks < 4; ++ks) ck[ks] = *(const bf16x8*)(P_S5CK + (size_t)(g * 16 + l15) * 128 + 32 * ks + 8 * l4);
    const int er = lane >> 1, eh = lane & 1;
    float* Ys = (float*)(F.lds + 86016) + w * 640;
    f32x4 dk0 = *(const f32x4*)(A.in[I_S5D] + g * 16 + 8 * eh), dk1 = *(const f32x4*)(A.in[I_S5D] + g * 16 + 8 * eh + 4);
#define S5_EROW(blk_) ((size_t)(b * SEQ + 128 * (2 * w + (er >> 4)) + 16 * (blk_) + (er & 15)))
    bf16x8 a0 = S5_ALOAD(0), a1 = S5_ALOAD(1), a2 = S5_ALOAD(2);
    u32x4 un = *(const u32x4*)(P_Z + S5_EROW(0) * ZP0 + g * 16 + 8 * eh);
#pragma unroll 1
    for (int blk = 0; blk < 8; ++blk) {
        const bf16x8 a = a0; a0 = a1; a1 = a2; if (blk + 3 < 8) a2 = S5_ALOAD(blk + 3);
        const u32x4 us = un; if (blk + 1 < 8) un = *(const u32x4*)(P_Z + S5_EROW(blk + 1) * ZP0 + g * 16 + 8 * eh);
#pragma unroll
        for (int nt = 0; nt < 2; ++nt) {
            const f32x16 dre = __builtin_amdgcn_mfma_f32_32x32x16_bf16(a, bbr[nt], zero16, 0, 0, 0), dim = __builtin_amdgcn_mfma_f32_32x32x16_bf16(a, bbi[nt], zero16, 0, 0, 0);
#pragma unroll
            for (int i = 0; i < 16; ++i) { const float nr = are[nt] * hr[nt] - aim[nt] * hi[nt] + dre[i], ni = are[nt] * hi[nt] + aim[nt] * hr[nt] + dim[i]; hr[nt] = nr; hi[nt] = ni;
                *(unsigned*)(Hs + (hh * 16 + i) * 136 + 2 * (32 * nt + p)) = pk2(nr, ni); }
        }
        LDS_WAIT();
#pragma unroll
        for (int sg = 0; sg < 2; ++sg) {
            f32x4 y = {0.f, 0.f, 0.f, 0.f};
#pragma unroll
            for (int ks = 0; ks < 4; ++ks) { const bf16x8 af = *(const bf16x8*)(Hs + (sg * 16 + l15) * 136 + 32 * ks + 8 * l4); y = __builtin_amdgcn_mfma_f32_16x16x32_bf16(af, ck[ks], y, 0, 0, 0); }
#pragma unroll
            for (int q = 0; q < 4; ++q) Ys[(sg * 16 + 4 * l4 + q) * 20 + l15] = y[q];
        }
        LDS_WAIT();
        { const f32x4 y0 = *(const f32x4*)(Ys + er * 20 + 8 * eh), y1 = *(const f32x4*)(Ys + er * 20 + 8 * eh + 4);
          float o[8]; o[0] = y0.x + dk0.x * bflo(us.x); o[1] = y0.y + dk0.y * bfhi(us.x); o[2] = y0.z + dk0.z * bflo(us.y); o[3] = y0.w + dk0.w * bfhi(us.y);
          o[4] = y1.x + dk1.x * bflo(us.z); o[5] = y1.y + dk1.y * bfhi(us.z); o[6] = y1.z + dk1.z * bflo(us.w); o[7] = y1.w + dk1.w * bfhi(us.w);
          u32x4 ov; ov.x = pk2(gelu_tanh(o[0]), gelu_tanh(o[1])); ov.y = pk2(gelu_tanh(o[2]), gelu_tanh(o[3])); ov.z = pk2(gelu_tanh(o[4]), gelu_tanh(o[5])); ov.w = pk2(gelu_tanh(o[6]), gelu_tanh(o[7]));
          *(u32x4*)(P_G5 + S5_EROW(blk) * 512 + g * 16 + 8 * eh) = ov; }
        LDS_WAIT();
    }
#undef S5_ALOAD
#undef S5_EROW
}
namespace lin {
typedef const LAS char* lptr;
typedef short s16x4 __attribute__((ext_vector_type(4)));
typedef short v4i16_t __attribute__((ext_vector_type(4)));
__device__ __forceinline__ s16x4 vtr(lptr p) { return __builtin_bit_cast(s16x4, __builtin_amdgcn_ds_read_tr16_b64_v4i16((LAS v4i16_t*)p)); }
__device__ __forceinline__ bf16x8 tr_frag(lptr sub, int ks, int lane) {
    const lptr p = sub + ((lane >> 4) & 1) * 32 + (lane & 3) * 8 + (4 * (lane >> 5) + ((lane & 15) >> 2)) * 64 + ks * 1024;
    const s16x4 lo = vtr(p), hi = vtr(p + 512);
    return (bf16x8){lo[0], lo[1], lo[2], lo[3], hi[0], hi[1], hi[2], hi[3]};
}
__device__ __forceinline__ bf16x8 nat_frag(lptr base, int ldb, int row0, int k0, int lane) { return *(const LAS bf16x8*)(base + (row0 + (lane & 31)) * ldb + (k0 + 8 * (lane >> 5)) * 2); }
__device__ __forceinline__ int crow(int r, int hh) { return (r & 3) + 8 * (r >> 2) + 4 * hh; }
__device__ __forceinline__ void unpack8(const u32x4& w, float (&f)[8]) { f[0] = bflo(w.x); f[1] = bfhi(w.x); f[2] = bflo(w.y); f[3] = bfhi(w.y); f[4] = bflo(w.z); f[5] = bfhi(w.z); f[6] = bflo(w.w); f[7] = bfhi(w.w); }
__device__ __forceinline__ u32x4 repack8(const float (&f)[8]) { u32x4 w; w.x = pk2(f[0], f[1]); w.y = pk2(f[2], f[3]); w.z = pk2(f[4], f[5]); w.w = pk2(f[6], f[7]); return w; }

__device__ __forceinline__ void gla_prefix(CArgs& A, const Frame& F, int item) {
    const int b = item >> 5, c = item & 31, half = F.tid >> 8, col = F.tid & 255;
    float* p = P_LOGA + (size_t)(b * SEQ + c * 64 + 32 * half) * 256 + col; float* tot = (float*)F.lds;
    float v[32];
#pragma unroll
    for (int i = 0; i < 32; ++i) v[i] = p[(size_t)i * 256];
#pragma unroll
    for (int i = 1; i < 32; ++i) v[i] += v[i - 1];
    if (half == 0) tot[col] = v[31];
    __syncthreads();
    const float off = half ? tot[col] : 0.f;
#pragma unroll
    for (int i = 0; i < 32; ++i) p[(size_t)i * 256] = v[i] + off;
    __syncthreads();
}
template <int KIND> __device__ __forceinline__ void r1_item(CArgs& A, const Frame& F, int bh, int vs) {
    constexpr int DK = KIND ? 64 : 128, ND = DK / 32;
    constexpr int KCOL = KIND ? 2304 : 512, VCOL = KIND ? 2560 : 1024;
    const int b = bh >> 2, h = bh & 3, tid = F.tid, lane = F.lane, w = F.wave, hh = lane >> 5;
    unsigned char* bufV = F.lds; unsigned char* bufK = F.lds + 4096;
    bf16_t* ST = (KIND ? P_GST : P_RST) + (size_t)bh * 32 * 128 * DK;
    const float log2g = KIND ? 0.f : log2f(1.f - exp2f(-5.f - (float)h));
    const float g64 = exp2f(64.f * log2g);
    f32x16 acc = {0.f, 0.f, 0.f, 0.f, 0.f, 0.f, 0.f, 0.f, 0.f, 0.f, 0.f, 0.f, 0.f, 0.f, 0.f, 0.f};
    const bf16_t* zb = P_Z + (size_t)(b * SEQ) * ZP1;
    const int vj = tid >> 2, vc = tid & 3;
    const int kj0 = KIND ? (tid >> 3) : (tid >> 4), kd0 = KIND ? (tid & 7) : (tid & 15);
#define R1_DECL(S) u32x4 rv##S = {0u, 0u, 0u, 0u}, rk0##S = {0u, 0u, 0u, 0u}, rk1##S = {0u, 0u, 0u, 0u}; f32x4 bj0##S = {0.f, 0.f, 0.f, 0.f}, bj1##S = bj0##S, bl0##S = bj0##S, bl1##S = bj0##S; float bd##S = 0.f;
#define R1_LOAD(S, c) do { const bf16_t* zc = zb + (size_t)((c) * 64) * ZP1; \
        if (tid < 256) rv##S = *(const u32x4*)(zc + (size_t)vj * ZP1 + VCOL + h * 128 + vs * 32 + vc * 8); \
        rk0##S = *(const u32x4*)(zc + (size_t)kj0 * ZP1 + KCOL + h * DK + kd0 * 8); \
        if (!KIND) rk1##S = *(const u32x4*)(zc + (size_t)(kj0 + 32) * ZP1 + KCOL + h * DK + kd0 * 8); \
        if (KIND) { const float* bp = P_LOGA + (size_t)(b * SEQ + (c) * 64) * 256 + h * 64; \
            bj0##S = *(const f32x4*)(bp + (size_t)kj0 * 256 + kd0 * 8); bj1##S = *(const f32x4*)(bp + (size_t)kj0 * 256 + kd0 * 8 + 4); \
            bl0##S = *(const f32x4*)(bp + 63 * 256 + kd0 * 8); bl1##S = *(const f32x4*)(bp + 63 * 256 + kd0 * 8 + 4); \
            if (w < ND) bd##S = bp[63 * 256 + 32 * w + (lane & 31)]; } } while (0)
#define R1_STEP(S, c) do { \
        if (tid < 256) { u32x4 o = rv##S; \
            if (!KIND) { float f[8]; unpack8(rv##S, f); const float z = exp2f((float)(63 - vj) * log2g); _Pragma("unroll") for (int e = 0; e < 8; ++e) f[e] *= z; o = repack8(f); } \
            *(u32x4*)(bufV + vj * 64 + vc * 16) = o; } \
        if (KIND) { float f[8]; unpack8(rk0##S, f); \
            f[0] *= __expf(bl0##S.x - bj0##S.x); f[1] *= __expf(bl0##S.y - bj0##S.y); f[2] *= __expf(bl0##S.z - bj0##S.z); f[3] *= __expf(bl0##S.w - bj0##S.w); \
            f[4] *= __expf(bl1##S.x - bj1##S.x); f[5] *= __expf(bl1##S.y - bj1##S.y); f[6] *= __expf(bl1##S.z - bj1##S.z); f[7] *= __expf(bl1##S.w - bj1##S.w); \
            *(u32x4*)(bufK + (kd0 >> 2) * 4096 + kj0 * 64 + (kd0 & 3) * 16) = repack8(f); \
        } else { \
            *(u32x4*)(bufK + (kd0 >> 2) * 4096 + kj0 * 64 + (kd0 & 3) * 16) = rk0##S; \
            *(u32x4*)(bufK + (kd0 >> 2) * 4096 + (kj0 + 32) * 64 + (kd0 & 3) * 16) = rk1##S; } \
        __syncthreads(); \
        const float decn = KIND ? __expf(bd##S) : 0.f; \
        if ((c) + 4 < 32) R1_LOAD(S, (c) + 4); \
        if (w < ND) { \
            bf16_t* sp = ST + ((size_t)(c) * 128 + vs * 32) * DK + 32 * w + (lane & 31); \
            const float dec = KIND ? decn : g64; \
            _Pragma("unroll") for (int r = 0; r < 16; ++r) { sp[(size_t)crow(r, hh) * DK] = (bf16_t)f2bf(acc[r]); acc[r] *= dec; } \
            _Pragma("unroll") for (int ks = 0; ks < 4; ++ks) acc = __builtin_amdgcn_mfma_f32_32x32x16_bf16(tr_frag((lptr)(LAS unsigned char*)bufV, ks, lane), tr_frag((lptr)(LAS unsigned char*)bufK + w * 4096, ks, lane), acc, 0, 0, 0); \
        } \
        __syncthreads(); } while (0)
    R1_DECL(0) R1_DECL(1) R1_DECL(2) R1_DECL(3)
    R1_LOAD(0, 0); R1_LOAD(1, 1); R1_LOAD(2, 2); R1_LOAD(3, 3);
#pragma unroll 1
    for (int c = 0; c < 32; c += 4) { R1_STEP(0, c); R1_STEP(1, c + 1); R1_STEP(2, c + 2); R1_STEP(3, c + 3); }
#undef R1_DECL
#undef R1_LOAD
#undef R1_STEP
}
__device__ __forceinline__ void p_lin_r1(CArgs& A, const Frame& F) {
    const int v = F.bid, r = v & 127;
    if (v < 128) r1_item<0>(A, F, r >> 2, r & 3); else r1_item<1>(A, F, r >> 2, r & 3);
}

template <int KIND> struct R2Regs {
    static constexpr int DK = KIND ? 64 : 128, NQP = 64 * DK / 8 / 512, NSP = 128 * DK / 8 / 512;
    u32x4 q[NQP], k[NQP], v[2], s[NSP], g[2]; f32x4 bq[NQP][2];
};
template <int KIND> __device__ __forceinline__ void r2_load(CArgs& A, const Frame& F, R2Regs<KIND>& R, int bh, int c) {
    constexpr int DK = KIND ? 64 : 128;
    constexpr int QCOL = KIND ? 2048 : 0, KCOL = KIND ? 2304 : 512, VCOL = KIND ? 2560 : 1024, GCOL = KIND ? 3072 : 1536;
    const int b = bh >> 2, h = bh & 3, tid = F.tid, lane = F.lane, w = F.wave, hh = lane >> 5, l31 = lane & 31, rb = w >> 2, cb = w & 3;
    const bf16_t* zc = P_Z + (size_t)(b * SEQ + c * 64) * ZP1;
    const bf16_t* ST = (KIND ? P_GST : P_RST) + ((size_t)bh * 32 + c) * 128 * DK;
#pragma unroll
    for (int r = 0; r < R2Regs<KIND>::NQP; ++r) { const int q = tid + 512 * r, i = q / (DK / 8), d8 = q % (DK / 8);
        R.q[r] = *(const u32x4*)(zc + (size_t)i * ZP1 + QCOL + h * DK + d8 * 8); R.k[r] = *(const u32x4*)(zc + (size_t)i * ZP1 + KCOL + h * DK + d8 * 8);
        if (KIND) { const float* bp = P_LOGA + (size_t)(b * SEQ + c * 64 + i) * 256 + h * 64 + d8 * 8; R.bq[r][0] = *(const f32x4*)bp; R.bq[r][1] = *(const f32x4*)(bp + 4); } }
#pragma unroll
    for (int r = 0; r < 2; ++r) { const int q = tid + 512 * r, j = q >> 4, v8 = q & 15; R.v[r] = *(const u32x4*)(zc + (size_t)j * ZP1 + VCOL + h * 128 + v8 * 8); }
#pragma unroll
    for (int r = 0; r < R2Regs<KIND>::NSP; ++r) { const int q = tid + 512 * r, vr = q / (DK / 8), d8 = q % (DK / 8); R.s[r] = *(const u32x4*)(ST + (size_t)vr * DK + d8 * 8); }
#pragma unroll
    for (int k2 = 0; k2 < 2; ++k2) { const int pp = lane + 64 * k2; R.g[k2] = *(const u32x4*)(zc + (size_t)(32 * rb + (pp >> 2)) * ZP1 + GCOL + h * 128 + 32 * cb + 8 * (pp & 3)); }
}
template <int KIND> struct R2Lds { static constexpr int DK = KIND ? 64 : 128, LDQ = (DK + 8) * 2, OFF_K = 64 * LDQ, OFF_V = 2 * 64 * LDQ, OFF_S = OFF_V + 16384, OFF_SSQ = OFF_S + 128 * LDQ, OFF_BC = OFF_SSQ + 1024; };
template <int KIND> __device__ __forceinline__ void r2_stage(const Frame& F, const R2Regs<KIND>& R, u32x4 (&gc)[2]) {
    typedef R2Lds<KIND> LL; constexpr int DK = LL::DK, LDQ = LL::LDQ;
    const int tid = F.tid; unsigned char* L = F.lds;
#pragma unroll
    for (int r = 0; r < R2Regs<KIND>::NQP; ++r) { const int q = tid + 512 * r, i = q / (DK / 8), d8 = q % (DK / 8);
        u32x4 qw = R.q[r], kw = R.k[r];
        if (KIND) { float fq[8], fk[8]; unpack8(qw, fq); unpack8(kw, fk);
#pragma unroll
            for (int e = 0; e < 8; ++e) { const float bb = R.bq[r][e >> 2][e & 3]; fq[e] *= __expf(bb); fk[e] *= __expf(-bb); }
            qw = repack8(fq); kw = repack8(fk); }
        *(u32x4*)(L + i * LDQ + d8 * 16) = qw; *(u32x4*)(L + LL::OFF_K + i * LDQ + d8 * 16) = kw; }
#pragma unroll
    for (int r = 0; r < 2; ++r) { const int q = tid + 512 * r, j = q >> 4, v8 = q & 15; *(u32x4*)(L + LL::OFF_V + (v8 >> 2) * 4096 + j * 64 + (v8 & 3) * 16) = R.v[r]; }
#pragma unroll
    for (int r = 0; r < R2Regs<KIND>::NSP; ++r) { const int q = tid + 512 * r, vr = q / (DK / 8), d8 = q % (DK / 8); *(u32x4*)(L + LL::OFF_S + vr * LDQ + d8 * 16) = R.s[r]; }
    gc[0] = R.g[0]; gc[1] = R.g[1];
    __syncthreads();
}
template <int KIND> __device__ __forceinline__ void r2_compute(CArgs& A, const Frame& F, int bh, int c, const u32x4 (&gc)[2]) {
    typedef R2Lds<KIND> LL; constexpr int DK = LL::DK, LDQ = LL::LDQ, OFF_K = LL::OFF_K, OFF_V = LL::OFF_V, OFF_S = LL::OFF_S;
    constexpr int OCOL = KIND ? 512 : 0;
    const int b = bh >> 2, h = bh & 3, lane = F.lane, w = F.wave, hh = lane >> 5, l31 = lane & 31, rb = w >> 2, cb = w & 3;
    unsigned char* L = F.lds; float* ssq = (float*)(L + LL::OFF_SSQ);
    const float log2g = KIND ? 0.f : log2f(1.f - exp2f(-5.f - (float)h));
    const lptr L3 = (lptr)(LAS unsigned char*)L;
    bf16x8 pa[2][2];
#pragma unroll
    for (int jt = 0; jt < 2; ++jt) {
        f32x16 p = {0.f, 0.f, 0.f, 0.f, 0.f, 0.f, 0.f, 0.f, 0.f, 0.f, 0.f, 0.f, 0.f, 0.f, 0.f, 0.f};
        if (jt <= rb) {
#pragma unroll
            for (int ks = 0; ks < DK / 16; ++ks) p = __builtin_amdgcn_mfma_f32_32x32x16_bf16(nat_frag(L3 + OFF_K, LDQ, 32 * jt, 16 * ks, lane), nat_frag(L3, LDQ, 32 * rb, 16 * ks, lane), p, 0, 0, 0);
        }
        const int i = 32 * rb + l31;
        float f[16];
#pragma unroll
        for (int r = 0; r < 16; ++r) { const int j = 32 * jt + crow(r, hh); float x = (i >= j) ? p[r] : 0.f; if (!KIND) x *= exp2f((float)(i - j) * log2g); f[r] = (i >= j) ? x : 0.f; }
#pragma unroll
        for (int s = 0; s < 2; ++s) { u32x4 wv; wv.x = pk2(f[8 * s], f[8 * s + 1]); wv.y = pk2(f[8 * s + 2], f[8 * s + 3]); wv.z = pk2(f[8 * s + 4], f[8 * s + 5]); wv.w = pk2(f[8 * s + 6], f[8 * s + 7]); pa[jt][s] = __builtin_bit_cast(bf16x8, wv); }
    }
    f32x16 o1 = {0.f, 0.f, 0.f, 0.f, 0.f, 0.f, 0.f, 0.f, 0.f, 0.f, 0.f, 0.f, 0.f, 0.f, 0.f, 0.f}, o2 = o1;
#pragma unroll
    for (int jt = 0; jt < 2; ++jt)
#pragma unroll
        for (int s = 0; s < 2; ++s) o1 = __builtin_amdgcn_mfma_f32_32x32x16_bf16(pa[jt][s], tr_frag(L3 + OFF_V + cb * 4096, 2 * jt + s, lane), o1, 0, 0, 0);
#pragma unroll
    for (int ks = 0; ks < DK / 16; ++ks) o2 = __builtin_amdgcn_mfma_f32_32x32x16_bf16(nat_frag(L3, LDQ, 32 * rb, 16 * ks, lane), nat_frag(L3 + OFF_S, LDQ, 32 * cb, 16 * ks, lane), o2, 0, 0, 0);
    float o[16];
#pragma unroll
    for (int r = 0; r < 16; ++r) { const int i = 32 * rb + crow(r, hh); const float xi = KIND ? 1.f : exp2f((float)(i + 1) * log2g); o[r] = o1[r] + xi * o2[r];
        const float sq = half_sum(o[r] * o[r]); if (l31 == 0) ssq[i * 4 + cb] = sq; }
    __syncthreads();
    float* Os = (float*)L + w * (32 * 33);
#pragma unroll
    for (int r = 0; r < 16; ++r) Os[crow(r, hh) * 33 + l31] = o[r];
    LDS_WAIT();
#pragma unroll
    for (int k2 = 0; k2 < 2; ++k2) { const int pp = lane + 64 * k2, rw = pp >> 2, ch = pp & 3, i = 32 * rb + rw;
        const f32x4 s4 = *(const f32x4*)(ssq + i * 4);
        const float rn = rsqrtf(((s4.x + s4.y) + (s4.z + s4.w)) * (1.f / 128.f) + EPS);
        float gv[8]; unpack8(gc[k2], gv); float y[8];
#pragma unroll
        for (int e = 0; e < 8; ++e) y[e] = siluf_(gv[e]) * Os[rw * 33 + 8 * ch + e] * rn;
        *(u32x4*)(P_YCAT + (size_t)(b * SEQ + c * 64 + i) * DM + OCOL + h * 128 + 32 * cb + 8 * ch) = repack8(y); }
    __syncthreads();
}
template <int KIND> __device__ __forceinline__ void r2_run(CArgs& A, const Frame& F0, int first, int n, int stride) {
    R2Regs<KIND> R; u32x4 gc[2];
    { Frame G2 = F0; int t_ = F0.tid; asm volatile("" : "+v"(t_)); G2.tid = t_; G2.lane = t_ & 63; r2_load<KIND>(A, G2, R, (first & 1023) >> 5, first & 31); }
#pragma unroll 1
    for (int i = 0; i < n; ++i) {
        Frame G2 = F0; { int t_ = F0.tid; asm volatile("" : "+v"(t_)); G2.tid = t_; G2.lane = t_ & 63; }
        const int r = (first + i * stride) & 1023;
        r2_stage<KIND>(G2, R, gc);
        if (i + 1 < n) { const int rn = (first + (i + 1) * stride) & 1023; r2_load<KIND>(A, G2, R, rn >> 5, rn & 31); }
        r2_compute<KIND>(A, G2, r >> 5, r & 31, gc);
    }
}
__device__ __forceinline__ void p_lin_r2(CArgs& A, const Frame& F) {
    r2_run<0>(A, F, F.bid, 4, F.G);
    r2_run<1>(A, F, 1024 + F.bid, 4, F.G);
}
}
#define XB_TMO      128
#define XB_XCNT(j)  (256  + 64 * (j))
#define XB_XSUB(j)  (1280 + 64 * (j))
#define XB_XGEN(j)  (2304 + 64 * (j))
#define XB_TOP      3328
#define XB_TOPGEN   3392
#define XCD_BAR_WORDS 3456
#define XB_SPIN_CAP (1u << 18)
__device__ __forceinline__ unsigned xb_ld(unsigned* p)              { return __hip_atomic_load(p, __ATOMIC_RELAXED, __HIP_MEMORY_SCOPE_AGENT); }
__device__ __forceinline__ unsigned xb_add(unsigned* p, unsigned v) { return __hip_atomic_fetch_add(p, v, __ATOMIC_RELAXED, __HIP_MEMORY_SCOPE_AGENT); }
__device__ __forceinline__ unsigned xb_xcc_id() { return (unsigned)__builtin_amdgcn_s_getreg((3 << 11) | 20) & 0xFu; }
#define XB_SPIN(cond, bar) do { unsigned _sp = 0; while (cond) { __builtin_amdgcn_s_sleep(1); \
    if ((++_sp & 255u) == 0u) { if (xb_ld(&(bar)[XB_TMO])) break; if (_sp > XB_SPIN_CAP) { atomicAdd(&(bar)[XB_TMO], 1u); break; } } } } while (0)
struct XcdBarrier { unsigned* bar; unsigned x; volatile LAS unsigned* st; };
__device__ __forceinline__ XcdBarrier xcd_barrier_post(unsigned* bar, volatile LAS unsigned* st, int tid) {
    XcdBarrier b; b.bar = bar; b.x = xb_xcc_id(); b.st = st;
    if (tid == 0) (void)xb_add(&bar[XB_XCNT(b.x)], 1u);
    return b;
}
__device__ __forceinline__ void xcd_barrier_complete(unsigned* bar, unsigned x, unsigned& nloc, unsigned& nx) {
    const unsigned G = gridDim.x * gridDim.y * gridDim.z;
    unsigned sum, cnt, mine, sp = 0u;
    for (;;) {
        sum = 0u; cnt = 0u; mine = 0u;
#pragma unroll
        for (unsigned j = 0; j < 16; ++j) { const unsigned c = xb_ld(&bar[XB_XCNT(j)]); sum += c; cnt += (c > 0u) ? 1u : 0u; mine = (j == x) ? c : mine; }
        if (sum == G) break;
        __builtin_amdgcn_s_sleep(1);
        if ((++sp & 255u) == 0u) { if (xb_ld(&bar[XB_TMO])) break; if (sp > XB_SPIN_CAP) { atomicAdd(&bar[XB_TMO], 1u); break; } }
    }
    nloc = mine > 0u ? mine : 1u; nx = cnt > 0u ? cnt : 1u;
}
__device__ __forceinline__ void xcd_barrier(const XcdBarrier& b, int tid) {
    asm volatile("s_waitcnt vmcnt(0)" ::: "memory");
    __syncthreads();
    if (tid == 0) {
        unsigned* bar = b.bar;
        __builtin_amdgcn_s_waitcnt(0);
        unsigned nloc = b.st[0], nx = b.st[1];
        if (nloc == 0u) { xcd_barrier_complete(bar, b.x, nloc, nx); b.st[0] = nloc; b.st[1] = nx; }
        const unsigned old = xb_add(&bar[XB_XSUB(b.x)], 1u);
        const unsigned gen = old / nloc;
        if (old + 1u == (gen + 1u) * nloc) {
            __builtin_amdgcn_fence(__ATOMIC_RELEASE, "agent");
            asm volatile("s_waitcnt vmcnt(0)" ::: "memory");
            const unsigned og = xb_add(&bar[XB_TOP], 1u);
            const unsigned tg = og / nx;
            if (og + 1u == (tg + 1u) * nx) xb_add(&bar[XB_TOPGEN], 1u);
            else XB_SPIN(xb_ld(&bar[XB_TOPGEN]) == tg, bar);
            __builtin_amdgcn_fence(__ATOMIC_ACQUIRE, "agent");
            xb_add(&bar[XB_XGEN(b.x)], 1u);
            asm volatile("s_waitcnt vmcnt(0)" ::: "memory");
        } else {
            XB_SPIN(xb_ld(&bar[XB_XGEN(b.x)]) == gen, bar);
            __builtin_amdgcn_fence(__ATOMIC_ACQUIRE, "agent");
            asm volatile("s_waitcnt vmcnt(0)" ::: "memory");
        }
    }
    __syncthreads();
}
#define REFRESH() do { int t_ = F.wave * 64 + lane_id(); asm volatile("" : "+v"(t_)); F.tid = t_; F.lane = t_ & 63; asm volatile("" : "+s"(ap)); int b_ = blockIdx.x; asm volatile("" : "+s"(b_)); F.bid = b_; } while (0)
#define A (*ap)
#define GSYNC() do { REFRESH(); xcd_barrier(xb, F.tid); } while (0)
template <int l> __device__ __forceinline__ void layer_fwd(CArgs*& ap, Frame& F, const XcdBarrier& xb, unsigned char* lds, LAS unsigned char* lds3, LAS pg8::MoeTables* tb) {
    if (l == 0) {
        { REFRESH(); pg8::DenseOrder S; S.init(P_HB, P_WINE, NTOK, 2048, 1024, F.G, F.bid); pg8::EpiZ0 E{P_Z};
          pg8::gemm_phase<pg8::EpiZ0, pg8::DenseOrder, true>(lds3, F.wave, 1024, S, E); }
        GSYNC();
        REFRESH(); fox_fast(A, F);
        __syncthreads();
        REFRESH(); s5_fast(A, F, F.bid);
        GSYNC();
        { REFRESH(); pg8::DenseOrder S; S.init(P_G5, P_WGLU, NTOK, 512, 512, F.G, F.bid); pg8::EpiGlu E{P_G5, A.in[I_GLUB], P_YCAT};
          pg8::gemm_phase<pg8::EpiGlu, pg8::DenseOrder, true>(lds3, F.wave, 512, S, E); }
        GSYNC();
    } else {
        REFRESH(); lin::gla_prefix(A, F, F.bid);
        { REFRESH(); pg8::DenseOrder S; S.init(P_HB, P_WINO, NTOK, 3584, 1024, F.G, F.bid); pg8::EpiZ1 E{P_Z, P_ROPE};
          pg8::gemm_phase<pg8::EpiZ1, pg8::DenseOrder, true>(lds3, F.wave, 1024, S, E); }
        GSYNC();
        REFRESH(); lin::p_lin_r1(A, F);
        GSYNC();
        REFRESH(); lin::p_lin_r2(A, F);
        GSYNC();
    }
    { REFRESH(); pg8::DenseOrder S; S.init(P_YCAT, l == 0 ? P_WOUTE : P_WOUTO, NTOK, 1024, 1024, F.G, F.bid); pg8::EpiBf16Plain E{(bf16_t*)P_MBUF, DM};
      pg8::gemm_phase<pg8::EpiBf16Plain, pg8::DenseOrder, true>(lds3, F.wave, 1024, S, E); }
    GSYNC();
    REFRESH(); p_postmix(A, F, l);
    GSYNC();
    REFRESH(); const int MT = moe_tables(A, F, l, tb);
    {
        const int mX = (MT >> 5) << 5, kk = MT - mX, rr = (64 - ((2 * kk) & 63)) & 63;
        const int mY = mX >= rr ? rr + (((mX - rr) >> 6) << 6) : 0;
        if (mX > 0) {
            { REFRESH(); pg8::MoeOrder<true> S; S.Ap = (const char*)P_HB; S.Bt = (const char*)(P_W1 + (size_t)l * 32 * 2048 * 1024); S.estride = (size_t)2048 * 1024 * 2; S.K = 1024; S.NP = 8; S.nwg = mX * 8; S.G = F.G; S.c = F.bid; S.mt0 = 0;
              S.list_tk = P_LTK + (size_t)l * 32 * LISTCAP; S.tb = tb;
              pg8::EpiSwiglu E{P_ACT, A.in[I_BGU] + (size_t)l * 32 * 2048};
              pg8::gemm_phase<pg8::EpiSwiglu, pg8::MoeOrder<true>, true>(lds3, F.wave, 1024, S, E); }
            GSYNC();
        }
        if (8 * (MT - mX) + 4 * mY > 0) {
            { REFRESH(); pg8::MoeMixOrder S; S.ws = (const char*)A.ws; S.l = l;
              S.a0 = mX; S.nA = 8 * (MT - mX); S.b0 = 0; S.nB = 4 * mY; S.nwg = S.nA + S.nB; S.G = F.G; S.c = F.bid; S.tb = tb;
              pg8::EpiMoeMix E{ap, l};
              pg8::gemm_phase<pg8::EpiMoeMix, pg8::MoeMixOrder, true>(lds3, F.wave, 1024, S, E); }
            GSYNC();
        }
        if (MT > mY) {
            { REFRESH(); pg8::MoeOrder<false> S; S.Ap = (const char*)P_ACT; S.Bt = (const char*)(P_W2 + (size_t)l * 32 * 1024 * 1024); S.estride = (size_t)1024 * 1024 * 2; S.K = 1024; S.NP = 4; S.nwg = (MT - mY) * 4; S.G = F.G; S.c = F.bid; S.mt0 = mY;
              S.list_tk = P_LTK + (size_t)l * 32 * LISTCAP; S.tb = tb;
              pg8::EpiDown E{P_Y, A.in[I_BDN] + (size_t)l * 32 * 1024, P_LTK + (size_t)l * 32 * LISTCAP, P_LG + (size_t)l * 32 * LISTCAP};
              pg8::gemm_phase<pg8::EpiDown, pg8::MoeOrder<false>, true>(lds3, F.wave, 1024, S, E); }
            GSYNC();
        }
    }
    REFRESH(); p_combine(A, F, l);
}

__global__ void __launch_bounds__(512, 2) mk_fwd(Args A_) {
    extern __shared__ __attribute__((aligned(16))) unsigned char lds[];
    cg::grid_group grid = cg::this_grid();
    CArgs* ap = (CArgs*)__builtin_amdgcn_kernarg_segment_ptr();
    Frame F;
    F.lds = lds; F.wave = __builtin_amdgcn_readfirstlane((int)threadIdx.x >> 6); F.tid = 0; F.lane = 0; F.bid = blockIdx.x; F.G = gridDim.x;
    LAS unsigned char* lds3 = (LAS unsigned char*)lds;
    LAS pg8::MoeTables* tb = (LAS pg8::MoeTables*)(lds3 + 133632);
    { volatile LAS unsigned* st = (volatile LAS unsigned*)(lds3 + (LDS_BYTES - 64)); REFRESH(); if (F.tid < 2) st[F.tid] = 0u; __syncthreads(); }
    XcdBarrier xb = xcd_barrier_post((unsigned*)(A.ws + WS_CTL) + 10240, (volatile LAS unsigned*)(lds3 + (LDS_BYTES - 64)), F.tid);
    REFRESH(); p0_prep(A, F);
    if (A.pad != 0) grid.sync();
    GSYNC();
    REFRESH(); p1_hprep0(A, F);
    GSYNC();
    layer_fwd<0>(ap, F, xb, lds, lds3, tb);
    GSYNC();
    layer_fwd<1>(ap, F, xb, lds, lds3, tb);
}
#undef A

extern "C" void kernel_launch(void* const* d_in, const int* in_sizes, int n_in, void* d_out, int out_size, void* d_ws, size_t ws_size, hipStream_t stream) {
    static int grid = 0;
    if (grid == 0) {
        if (n_in != 31 || out_size != NTOK * DM || ws_size < WS_END) { fprintf(stderr, "kernel_launch: unexpected problem (n_in %d out %d ws %zu)\n", n_in, out_size, ws_size); grid = -1; return; }
        int dev = 0, cus = 0, per_cu = 0;
        if (hipGetDevice(&dev) != hipSuccess || hipDeviceGetAttribute(&cus, hipDeviceAttributeMultiprocessorCount, dev) != hipSuccess) { grid = -1; return; }
        if (hipFuncSetAttribute((const void*)mk_fwd, hipFuncAttributeMaxDynamicSharedMemorySize, LDS_BYTES) != hipSuccess) { fprintf(stderr, "kernel_launch: hipFuncSetAttribute failed\n"); grid = -1; return; }
        if (hipOccupancyMaxActiveBlocksPerMultiprocessor(&per_cu, (const void*)mk_fwd, 512, LDS_BYTES) != hipSuccess || per_cu < 1) { fprintf(stderr, "kernel_launch: occupancy query says %d blocks per CU\n", per_cu); (void)hipGetLastError(); }
        grid = cus;
        if (grid != 256) fprintf(stderr, "kernel_launch: %d CUs; this kernel is built for a 256-CU grid\n", grid);
    }
    if (grid < 0) return;
    if (hipMemsetAsync((char*)d_ws + WS_CTL, 0, CTL_ZERO_BYTES, stream) != hipSuccess) { fprintf(stderr, "kernel_launch: memset failed\n"); return; }
    Args a{};
    for (int i = 0; i < 31; ++i) a.in[i] = (const float*)d_in[i];
    a.out = (float*)d_out; a.ws = (unsigned char*)d_ws;
    void* kargs[] = {&a};
    const hipError_t e = hipLaunchCooperativeKernel((const void*)mk_fwd, dim3(grid), dim3(512), kargs, LDS_BYTES, stream);
    if (e != hipSuccess) fprintf(stderr, "kernel_launch: cooperative launch failed: %s (grid %d)\n", hipGetErrorString(e), grid);
}
```

```cpp
#include <hip/hip_runtime.h>
#include <hip/hip_cooperative_groups.h>
#include <cstdio>
#include <cstdint>
namespace cg = cooperative_groups;

#define LAS __attribute__((address_space(3)))
typedef unsigned short bf16_t;
typedef short bf16x8 __attribute__((ext_vector_type(8)));
typedef float f32x4 __attribute__((ext_vector_type(4)));
typedef float f32x2 __attribute__((ext_vector_type(2)));
typedef unsigned u32x4 __attribute__((ext_vector_type(4)));
typedef unsigned u32x2 __attribute__((ext_vector_type(2)));
typedef int i32x4 __attribute__((ext_vector_type(4)));
typedef int i32x8 __attribute__((ext_vector_type(8)));

constexpr int NTOK = 16384, DM = 1024, SEQ = 2048, NB = 8;
constexpr int NEXP = 32, LISTCAP = 16384;
constexpr float EPS = 1e-6f;
constexpr float LOG2E = 1.4426950408889634f;
constexpr float C2 = 0.125f * LOG2E;
constexpr int ZP0 = 2048, ZP1 = 3584;

constexpr size_t MiB = 1u << 20;
constexpr size_t WS_CTL = 0, CTL_ZERO_BYTES = 65536;
constexpr size_t WS_MOD = 1 * MiB;
constexpr size_t WS_WSIDE = 1 * MiB + 512 * 1024;
constexpr size_t WS_S5A = 2 * MiB;
constexpr size_t WS_S5BB = 2 * MiB + 65536;
constexpr size_t WS_S5CK = 2 * MiB + 512 * 1024;
constexpr size_t WS_ROPE = 3 * MiB;
constexpr size_t WS_LTK = 4 * MiB;
constexpr size_t WS_LG = 8 * MiB;
constexpr size_t WS_WINE = 16 * MiB, WS_WGLU = 20 * MiB, WS_WOUTE = 21 * MiB, WS_WINO = 23 * MiB, WS_WOUTO = 30 * MiB;
constexpr size_t WS_W1 = 32 * MiB;
constexpr size_t WS_HB8 = 160 * MiB;
constexpr size_t WS_W2 = 288 * MiB;
constexpr size_t WS_HB = 416 * MiB;
constexpr size_t WS_Z = 448 * MiB;
constexpr size_t WS_LSIG = 560 * MiB;
constexpr size_t WS_LOGA = 562 * MiB;
constexpr size_t WS_G5 = 578 * MiB;
constexpr size_t WS_YCAT = 594 * MiB;
constexpr size_t WS_MBUF = 626 * MiB;
constexpr size_t WS_ACT = 690 * MiB;
constexpr size_t WS_Y = 834 * MiB;
constexpr size_t WS_RST = 962 * MiB;
constexpr size_t WS_GST = 994 * MiB;
constexpr size_t WS_XB = 1010 * MiB;
constexpr size_t WS_END = 1042 * MiB;
constexpr int CW_CNT = 1024;

constexpr int RING_BYTES = 131072;
constexpr int MISC_OFF = RING_BYTES;
constexpr int LDS_BYTES = 147456;

__device__ __forceinline__ unsigned f2bf(float f) { unsigned u = __builtin_bit_cast(unsigned, f); return (u + 0x7fffu + ((u >> 16) & 1u)) >> 16; }
typedef __bf16 bf16x2_hw __attribute__((ext_vector_type(2)));
__device__ __forceinline__ unsigned pk2(float lo, float hi) { const f32x2 v = {lo, hi}; return __builtin_bit_cast(unsigned, __builtin_convertvector(v, bf16x2_hw)); }
__device__ __forceinline__ float bflo(unsigned w) { return __builtin_bit_cast(float, w << 16); }
__device__ __forceinline__ float bfhi(unsigned w) { return __builtin_bit_cast(float, w & 0xffff0000u); }
__device__ __forceinline__ float bf1(bf16_t b) { return __builtin_bit_cast(float, ((unsigned)b) << 16); }
__device__ __forceinline__ int lane_id() { int l; asm volatile("v_mbcnt_lo_u32_b32 %0, -1, 0\n\tv_mbcnt_hi_u32_b32 %0, -1, %0" : "=v"(l)); return l; }
template <int CTRL> __device__ __forceinline__ float dppf(float v) { return __builtin_bit_cast(float, __builtin_amdgcn_update_dpp(0, __builtin_bit_cast(int, v), CTRL, 0xf, 0xf, true)); }
__device__ __forceinline__ float row16_sum(float v) {
    v += dppf<0xB1>(v); v += dppf<0x4E>(v); v += dppf<0x141>(v); v += dppf<0x140>(v); return v;
}
__device__ __forceinline__ float rdlane(float v, int l) { return __builtin_bit_cast(float, __builtin_amdgcn_readlane(__builtin_bit_cast(int, v), l)); }
__device__ __forceinline__ float wave_sum(float v) {
    v = row16_sum(v); return (rdlane(v, 0) + rdlane(v, 16)) + (rdlane(v, 32) + rdlane(v, 48));
}
__device__ __forceinline__ float half_sum(float v) {
    v = row16_sum(v); const float a = rdlane(v, 0) + rdlane(v, 16), b = rdlane(v, 32) + rdlane(v, 48); return (lane_id() < 32) ? a : b;
}
__device__ __forceinline__ float sigmoidf_(float x) { return __builtin_amdgcn_rcpf(1.f + __expf(-x)); }
__device__ __forceinline__ float log_sigmoidf_(float x) { return fminf(x, 0.f) - log1pf(__expf(-fabsf(x))); }
__device__ __forceinline__ float siluf_(float x) { return x * sigmoidf_(x); }
__device__ __forceinline__ float gelu_tanh(float x) { const float u2 = 1.5957691216057308f * (x + 0.044715f * x * x * x); return x * sigmoidf_(u2); }
constexpr float SC_H = 16.f, SC_W1 = 512.f, SC_A = 8.f, SC_W2 = 512.f;
__device__ __forceinline__ unsigned pk8(float a, float b, float c, float d) {
    a = __builtin_amdgcn_fmed3f(a, -448.f, 448.f); b = __builtin_amdgcn_fmed3f(b, -448.f, 448.f); c = __builtin_amdgcn_fmed3f(c, -448.f, 448.f); d = __builtin_amdgcn_fmed3f(d, -448.f, 448.f);
    int r = __builtin_amdgcn_cvt_pk_fp8_f32(a, b, 0, false); r = __builtin_amdgcn_cvt_pk_fp8_f32(c, d, r, true); return (unsigned)r;
}
#define LDS_WAIT() asm volatile("s_waitcnt lgkmcnt(0)" ::: "memory")

struct Args { const float* in[31]; float* out; unsigned char* ws; long long pad; };
typedef const __attribute__((address_space(4))) Args CArgs;
enum { I_X = 0, I_C, I_ADAW, I_ADAB, I_NPM, I_NQM, I_NPF, I_NQF, I_EVWIN, I_FOXB, I_LAMRE, I_LAMIM, I_LOGDT, I_BRE, I_BIM, I_CRE, I_CIM, I_S5D, I_GLUW, I_GLUB, I_EVWOUT,
       I_ODWIN, I_GLAWUP, I_GLABG, I_ODWOUT, I_RW, I_RB, I_WGU, I_BGU, I_WDN, I_BDN };

namespace pg8 {
constexpr int BM = 256, BK = 64, HALF = 128, HTB = HALF * BK * 2, STAGE_BYTES = 8 * HTB, NXCD = 8, WGM = 8;
__device__ __forceinline__ int lds_byte(int r, int c) { const int st = (r >> 4) * 2 + (c >> 5), rr = r & 15, cc = c & 31, ob = rr * 64 + cc * 2; return st * 1024 + (ob ^ (((ob >> 9) & 1) << 5)); }
__device__ __forceinline__ void stage_rc(int b, int& R, int& C) { const int st = b / 1024, sb = b % 1024, swz = sb ^ (((sb >> 9) & 1) << 5); R = (st >> 1) * 16 + swz / 64; C = (st & 1) * 32 + (swz % 64) / 2; }
__device__ __forceinline__ int perm32(int rho) { const int n = rho >> 4, i = rho & 15; return 8 * (i >> 2) + 4 * n + (i & 3); }
__device__ __forceinline__ unsigned cvt_pk_bf16(float lo, float hi) { unsigned r; asm volatile("v_cvt_pk_bf16_f32 %0, %1, %2" : "=v"(r) : "v"(lo), "v"(hi)); return r; }

struct Unit { int pm, pn, e, mb, nrows, kind; };
__device__ __forceinline__ int xcd_remap(int L, int nwg) { const int q = nwg / NXCD, r = nwg % NXCD, xcd = L % NXCD, off = L / NXCD; return (xcd < r ? xcd * (q + 1) : r * (q + 1) + (xcd - r) * q) + off; }

struct DenseOrder {
    const char* Ap; const char* Bt; int K, nM, nN, nwg, G, c;
    __device__ __forceinline__ void init(const void* A_, const void* Bt_, int M, int N, int K_, int G_, int c_) { Ap = (const char*)A_; Bt = (const char*)Bt_; K = K_; nM = M / BM; nN = N / BM; nwg = nM * nN; G = G_; c = c_; }
    __device__ __forceinline__ bool next(int i, Unit& u) const {
        const long L = (long)i * G + c; if (L >= nwg) return false;
        const int wgid = xcd_remap((int)L, nwg);
        const int nig = WGM * nN, gid = wgid / nig, fm = gid * WGM, gsz = (nM - fm) < WGM ? (nM - fm) : WGM;
        u.pm = fm + ((wgid % nig) % gsz); u.pn = (wgid % nig) / gsz; u.e = 0; u.mb = u.pm; u.nrows = BM; u.kind = 0; return true;
    }
    __device__ __forceinline__ const char* a_base(const Unit& u) const { return Ap + (size_t)u.pm * ((size_t)BM * K * 2); }
    __device__ __forceinline__ const char* b_base(const Unit& u) const { return Bt + (size_t)u.pn * ((size_t)BM * K * 2); }
    __device__ __forceinline__ void a_raw(const Unit&, const int (&)[2], int (&raw)[2][2]) const { raw[0][0] = raw[0][1] = raw[1][0] = raw[1][1] = 0; }
    __device__ __forceinline__ void a_offs(const Unit&, const int (&R)[2], const int (&C)[2], const int (&)[2][2], unsigned (&v)[2][2]) const {
#pragma unroll
        for (int h = 0; h < 2; ++h)
#pragma unroll
            for (int i = 0; i < 2; ++i) v[h][i] = (unsigned)((h * HALF + R[i]) * K + C[i]) * 2u;
    }
};
struct MoeTables { int cnt[NEXP]; int mtstart[NEXP + 1]; unsigned char tile_e[320]; };
template <bool GATHER> struct MoeOrder {
    const char* Ap; const char* Bt; size_t estride; int K, NP, nwg, G, c, mt0; const int* list_tk; const LAS MoeTables* tb;
    __device__ __forceinline__ bool next(int i, Unit& u) const {
        const long L = (long)i * G + c; if (L >= nwg) return false;
        const int w = xcd_remap((int)L, nwg);
        const int mq = w / NP, mt = mt0 + mq; u.pn = w - mq * NP; u.pm = mt; u.e = tb->tile_e[mt]; u.mb = mt - tb->mtstart[u.e];
        const int left = tb->cnt[u.e] - u.mb * BM; u.nrows = left < BM ? left : BM; u.kind = GATHER ? 0 : 1; return true;
    }
    __device__ __forceinline__ const char* a_base(const Unit& u) const { return GATHER ? Ap : Ap + (size_t)u.pm * ((size_t)BM * K * 2); }
    __device__ __forceinline__ const char* b_base(const Unit& u) const { return Bt + (size_t)u.e * estride + (size_t)u.pn * ((size_t)BM * K * 2); }
    __device__ __forceinline__ void a_raw(const Unit& u, const int (&R)[2], int (&raw)[2][2]) const {
#pragma unroll
        for (int h = 0; h < 2; ++h)
#pragma unroll
            for (int i = 0; i < 2; ++i) { if (GATHER) { const int r = h * HALF + R[i], rc = r < u.nrows ? r : 0; raw[h][i] = list_tk[u.e * LISTCAP + u.mb * BM + rc]; } else raw[h][i] = 0; }
    }
    __device__ __forceinline__ void a_offs(const Unit&, const int (&R)[2], const int (&C)[2], const int (&raw)[2][2], unsigned (&v)[2][2]) const {
#pragma unroll
        for (int h = 0; h < 2; ++h)
#pragma unroll
            for (int i = 0; i < 2; ++i) {
                if (GATHER) v[h][i] = (unsigned)((raw[h][i] >> 2) * K + C[i]) * 2u;
                else v[h][i] = (unsigned)((h * HALF + R[i]) * K + C[i]) * 2u;
            }
    }
};

struct MoeMixOrder {
    const char* ws; int l, a0, nA, b0, nB, nwg, G, c; const LAS MoeTables* tb;
    static constexpr int K = 512;
    __device__ __forceinline__ bool next(int i, Unit& u) const {
        const long L = (long)i * G + c; if (L >= nwg) return false;
        int w = xcd_remap((int)L, nwg), mt;
        if (w < nA) { u.kind = 0; mt = a0 + (w >> 3); u.pn = w & 7; } else { w -= nA; u.kind = 1; mt = b0 + (w >> 2); u.pn = w & 3; }
        u.pm = mt; u.e = tb->tile_e[mt]; u.mb = mt - tb->mtstart[u.e];
        const int left = tb->cnt[u.e] - u.mb * BM; u.nrows = left < BM ? left : BM; return true;
    }
    __device__ __forceinline__ const char* a_base(const Unit& u) const { return u.kind ? ws + WS_ACT : ws + WS_HB8; }
    __device__ __forceinline__ const char* b_base(const Unit& u) const { return u.kind ? ws + WS_W2 + (size_t)(l * 32 + u.e) * ((size_t)1024 * K * 2) + (size_t)u.pn * ((size_t)BM * K * 2) : ws + WS_W1 + (size_t)(l * 32 + u.e) * ((size_t)2048 * K * 2) + (size_t)u.pn * ((size_t)BM * K * 2); }
    __device__ __forceinline__ void a_raw(const Unit& u, const int (&R)[2], int (&raw)[2][2]) const {
#pragma unroll
        for (int h = 0; h < 2; ++h)
#pragma unroll
            for (int i = 0; i < 2; ++i) { const int r = h * HALF + R[i], rc = r < u.nrows ? r : 0; raw[h][i] = u.kind ? 4 * (u.pm * BM + r) : ((const int*)(ws + WS_LTK))[(l * 32 + u.e) * LISTCAP + u.mb * BM + rc]; }
    }
    __device__ __forceinline__ void a_offs(const Unit& u, const int (&R)[2], const int (&C)[2], const int (&raw)[2][2], unsigned (&v)[2][2]) const {
#pragma unroll
        for (int h = 0; h < 2; ++h)
#pragma unroll
            for (int i = 0; i < 2; ++i) v[h][i] = (unsigned)((raw[h][i] >> 2) * K + C[i]) * 2u;
    }
};

template <class Epi, class Sched, bool ALIGN_EPI, bool FP8 = false>
__device__ __forceinline__ void gemm_phase(LAS unsigned char* lds, const int wave_, const int K, const Sched& S, const Epi& E) {
    int tid_ = wave_ * 64 + lane_id(); asm volatile("" : "+v"(tid_));
    const int tid = tid_, wid = wave_, lane = tid & 63, wr = wid >> 2, wc = wid & 3, fr = lane & 15, fq = lane >> 4;
    int nt_ = K / BK; if constexpr (FP8) asm volatile("" : "+s"(nt_));
    const int nt = nt_;
    int Rr[2], Cc[2]; unsigned voffB[2];
#pragma unroll
    for (int i = 0; i < 2; ++i) { stage_rc(tid * 16 + i * 8192, Rr[i], Cc[i]); const int Rb = Epi::PERM ? ((Rr[i] & ~31) + perm32(Rr[i] & 31)) : Rr[i]; voffB[i] = (unsigned)(Rb * K + Cc[i]) * 2u; }
    const size_t kstep = (size_t)(BK * 2);
    const size_t hstep = (size_t)HALF * K * 2;
    const unsigned ldsw = (unsigned)wid * 1024u;
    const int aoff = lds_byte(wr * 64 + fr, fq * 8), boff = lds_byte(wc * 32 + fr, fq * 8);
#define PG8_SA(b, h) (((b) * 2 + (h)) * HTB)
#define PG8_SB(b, h) ((4 + (b) * 2 + (h)) * HTB)
#define PG8_STAGE(bufoff, gbase, voff) do { _Pragma("unroll") for (int _i = 0; _i < 2; ++_i) { unsigned vo_ = (voff)[_i]; if constexpr (FP8) asm volatile("" : "+v"(vo_));   \
        __builtin_amdgcn_global_load_lds((const unsigned*)((const char*)(gbase) + vo_), (LAS unsigned*)(lds + (bufoff) + ldsw + _i * 8192), 16, 0, 0); } } while (0)
#define PG8_LDA(dst, b, h) do { _Pragma("unroll") for (int m = 0; m < 4; ++m) { \
        if constexpr (FP8) { const i32x4 lo_ = *(const LAS i32x4*)(lds + PG8_SA(b, h) + aoff + m * 2048), hi_ = *(const LAS i32x4*)(lds + PG8_SA(b, h) + aoff + m * 2048 + 1024); dst##8[m] = __builtin_shufflevector(lo_, hi_, 0, 1, 2, 3, 4, 5, 6, 7); } \
        else { _Pragma("unroll") for (int k = 0; k < 2; ++k) dst[m][k] = *(const LAS bf16x8*)(lds + PG8_SA(b, h) + aoff + m * 2048 + k * 1024); } } } while (0)
#define PG8_LDB(dst, b, h) do { _Pragma("unroll") for (int n = 0; n < 2; ++n) { \
        if constexpr (FP8) { const i32x4 lo_ = *(const LAS i32x4*)(lds + PG8_SB(b, h) + boff + n * 2048), hi_ = *(const LAS i32x4*)(lds + PG8_SB(b, h) + boff + n * 2048 + 1024); dst##8[n] = __builtin_shufflevector(lo_, hi_, 0, 1, 2, 3, 4, 5, 6, 7); } \
        else { _Pragma("unroll") for (int k = 0; k < 2; ++k) dst[n][k] = *(const LAS bf16x8*)(lds + PG8_SB(b, h) + boff + n * 2048 + k * 1024); } } } while (0)
#define PG8_MMA(ai, bj, At, Bt) do { __builtin_amdgcn_s_setprio(1); _Pragma("unroll") for (int m = 0; m < 4; ++m) _Pragma("unroll") for (int n = 0; n < 2; ++n) { \
        if constexpr (FP8) asm volatile("v_mfma_f32_16x16x128_f8f6f4 %0, %1, %2, %0" : "+v"(acc[ai][bj][m][n]) : "v"(Bt##8[n]), "v"(At##8[m]));   \
        else { _Pragma("unroll") for (int k = 0; k < 2; ++k) acc[ai][bj][m][n] = __builtin_amdgcn_mfma_f32_16x16x32_bf16(Bt[n][k], At[m][k], acc[ai][bj][m][n], 0, 0, 0); } } \
        __builtin_amdgcn_s_setprio(0); } while (0)
#define PG8_WAIT_V(n) asm volatile("s_waitcnt vmcnt(" #n ")" ::: "memory")
#define PG8_WAIT_L(n) asm volatile("s_waitcnt lgkmcnt(" #n ")" ::: "memory")
#define PG8_BAR __builtin_amdgcn_s_barrier()
#define PG8_SCHED __builtin_amdgcn_sched_barrier(0)
    Unit cur, nxt; int ui = 0;
    if (!S.next(0, cur)) return;
    f32x4 acc[2][2][4][2];
#pragma unroll
    for (int a = 0; a < 2; ++a)
#pragma unroll
        for (int b = 0; b < 2; ++b)
#pragma unroll
            for (int m = 0; m < 4; ++m)
#pragma unroll
                for (int n = 0; n < 2; ++n) acc[a][b][m][n] = (f32x4){0.f, 0.f, 0.f, 0.f};
    bf16x8 At[4][2], B0[2][2], B1[2][2]; i32x8 At8[4], B08[2], B18[2];
    const char* cA = S.a_base(cur); const char* cB = S.b_base(cur);
    unsigned cv[2][2], nv[2][2]; int raw[2][2];
    S.a_raw(cur, Rr, raw); S.a_offs(cur, Rr, Cc, raw, cv);
    PG8_STAGE(PG8_SB(0, 0), cB, voffB); PG8_STAGE(PG8_SB(0, 1), cB + hstep, voffB); PG8_STAGE(PG8_SA(0, 0), cA, cv[0]); PG8_STAGE(PG8_SA(0, 1), cA, cv[1]);
    if (wr == 1) PG8_BAR;
    PG8_WAIT_V(2); PG8_BAR;
    PG8_STAGE(PG8_SB(1, 0), cB + kstep, voffB); PG8_STAGE(PG8_SA(1, 0), cA + kstep, cv[0]); PG8_STAGE(PG8_SB(1, 1), cB + hstep + kstep, voffB);
    PG8_WAIT_V(6); PG8_BAR;
    for (;;) {
        const bool has_next = S.next(ui + 1, nxt);
        const char* nA = has_next ? S.a_base(nxt) : cA; const char* nB = has_next ? S.b_base(nxt) : cB;
        if (has_next) S.a_raw(nxt, Rr, raw);
#pragma unroll
        for (int h = 0; h < 2; ++h)
#pragma unroll
            for (int i = 0; i < 2; ++i) nv[h][i] = cv[h][i];
        for (int t = 0; t < nt; t += 2) {
            const bool last = (t == nt - 2);
            if (last && has_next) S.a_offs(nxt, Rr, Cc, raw, nv);
            const char* a1 = cA + (size_t)(t + 1) * kstep;
            const char* a2 = last ? nA : cA + (size_t)(t + 2) * kstep; const char* b2 = last ? nB : cB + (size_t)(t + 2) * kstep;
            const char* a3 = a2 + kstep; const char* b3 = b2 + kstep;
            unsigned v2[2][2];
#pragma unroll
            for (int h = 0; h < 2; ++h)
#pragma unroll
                for (int i = 0; i < 2; ++i) v2[h][i] = last ? nv[h][i] : cv[h][i];
            PG8_LDB(B0, 0, 0); PG8_LDB(B1, 0, 1); PG8_SCHED; PG8_LDA(At, 0, 0); PG8_STAGE(PG8_SA(1, 1), a1, cv[1]);
            PG8_WAIT_V(8); PG8_WAIT_L(0); PG8_BAR; PG8_MMA(0, 0, At, B0); PG8_MMA(0, 1, At, B1); PG8_BAR; PG8_SCHED;
            PG8_LDA(At, 0, 1); PG8_STAGE(PG8_SB(0, 0), b2, voffB); PG8_STAGE(PG8_SB(0, 1), b2 + hstep, voffB); PG8_STAGE(PG8_SA(0, 0), a2, v2[0]);
            PG8_WAIT_V(8); PG8_WAIT_L(0); PG8_BAR; PG8_MMA(1, 0, At, B0); PG8_MMA(1, 1, At, B1); PG8_BAR; PG8_SCHED;
            PG8_LDB(B0, 1, 0); PG8_LDB(B1, 1, 1); PG8_SCHED; PG8_LDA(At, 1, 0); PG8_STAGE(PG8_SA(0, 1), a2, v2[1]);
            PG8_WAIT_V(8); PG8_WAIT_L(0); PG8_BAR; PG8_MMA(0, 0, At, B0); PG8_MMA(0, 1, At, B1); PG8_BAR; PG8_SCHED;
            PG8_LDA(At, 1, 1); PG8_STAGE(PG8_SB(1, 0), b3, voffB); PG8_STAGE(PG8_SB(1, 1), b3 + hstep, voffB); PG8_STAGE(PG8_SA(1, 0), a3, v2[0]);
            PG8_WAIT_V(8); PG8_WAIT_L(0); PG8_BAR; PG8_MMA(1, 0, At, B0); PG8_MMA(1, 1, At, B1); PG8_BAR; PG8_SCHED;
        }
        if constexpr (ALIGN_EPI) { if (wr == 0) PG8_BAR; }
        if constexpr (FP8) asm volatile("s_nop 15\n\ts_nop 15" ::: "memory");
        E(acc, cur, wr, wc, fr, fq);
        if (!has_next) break;
#pragma unroll
        for (int a = 0; a < 2; ++a)
#pragma unroll
            for (int b = 0; b < 2; ++b)
#pragma unroll
                for (int m = 0; m < 4; ++m)
#pragma unroll
                    for (int n = 0; n < 2; ++n) acc[a][b][m][n] = (f32x4){0.f, 0.f, 0.f, 0.f};
        cur = nxt; cA = nA; cB = nB; ++ui;
#pragma unroll
        for (int h = 0; h < 2; ++h)
#pragma unroll
            for (int i = 0; i < 2; ++i) cv[h][i] = nv[h][i];
        if constexpr (ALIGN_EPI) { if (wr == 1) PG8_BAR; }
    }
    PG8_WAIT_V(0);
    if constexpr (!ALIGN_EPI) { if (wr == 0) PG8_BAR; }
    PG8_BAR;
#undef PG8_SA
#undef PG8_SB
#undef PG8_STAGE
#undef PG8_LDA
#undef PG8_LDB
#undef PG8_MMA
#undef PG8_WAIT_V
#undef PG8_WAIT_L
#undef PG8_BAR
#undef PG8_SCHED
}
}
namespace pg8 {
typedef f32x4 Acc[2][2][4][2];
struct EpiZ0 {
    static constexpr bool PERM = true;
    bf16_t* Z;
    __device__ __forceinline__ void operator()(const Acc& acc, const Unit& u, int wr, int wc, int fr, int fq) const {
        const float sc = (u.pn == 2 || u.pn == 3) ? C2 : 1.f;
        const int row0 = u.pm * BM + wr * 64 + fr, col0 = u.pn * BM + wc * 32 + 8 * fq;
#pragma unroll
        for (int ai = 0; ai < 2; ++ai)
#pragma unroll
            for (int m = 0; m < 4; ++m) { bf16_t* rowp = Z + (size_t)(row0 + ai * HALF + m * 16) * ZP0 + col0;
#pragma unroll
                for (int bj = 0; bj < 2; ++bj) { const f32x4 v0 = acc[ai][bj][m][0] * sc, v1 = acc[ai][bj][m][1] * sc;
                    u32x4 w; w.x = cvt_pk_bf16(v0[0], v0[1]); w.y = cvt_pk_bf16(v0[2], v0[3]); w.z = cvt_pk_bf16(v1[0], v1[1]); w.w = cvt_pk_bf16(v1[2], v1[3]);
                    *(u32x4*)(rowp + bj * HALF) = w; } }
    }
};
struct EpiZ1 {
    static constexpr bool PERM = true;
    bf16_t* Z; const float* rope;
    __device__ __forceinline__ void operator()(const Acc& acc, const Unit& u, int wr, int wc, int fr, int fq) const {
        const int row0 = u.pm * BM + wr * 64 + fr;
        if (u.pn < 4) {
            const float sc = (u.pn >= 2) ? 0.08838834764831845f : 1.f;
            const int hl = wc >> 1, jj0 = 32 * (wc & 1) + 8 * fq;
#pragma unroll
            for (int ai = 0; ai < 2; ++ai)
#pragma unroll
                for (int m = 0; m < 4; ++m) { const int row = row0 + ai * HALF + m * 16, pos = row & (SEQ - 1);
                    const f32x4 c0 = *(const f32x4*)(rope + pos * 64 + jj0), c1 = *(const f32x4*)(rope + pos * 64 + jj0 + 4);
                    const f32x4 s0 = *(const f32x4*)(rope + SEQ * 64 + pos * 64 + jj0), s1 = *(const f32x4*)(rope + SEQ * 64 + pos * 64 + jj0 + 4);
                    const f32x4 x10 = acc[ai][0][m][0] * sc, x11 = acc[ai][0][m][1] * sc, x20 = acc[ai][1][m][0] * sc, x21 = acc[ai][1][m][1] * sc;
                    const f32x4 a0 = x10 * c0 - x20 * s0, a1 = x11 * c1 - x21 * s1, b0 = x10 * s0 + x20 * c0, b1 = x11 * s1 + x21 * c1;
                    bf16_t* rowp = Z + (size_t)row * ZP1 + u.pn * BM + 128 * hl + jj0;
                    u32x4 w; w.x = cvt_pk_bf16(a0[0], a0[1]); w.y = cvt_pk_bf16(a0[2], a0[3]); w.z = cvt_pk_bf16(a1[0], a1[1]); w.w = cvt_pk_bf16(a1[2], a1[3]);
                    *(u32x4*)(rowp) = w;
                    w.x = cvt_pk_bf16(b0[0], b0[1]); w.y = cvt_pk_bf16(b0[2], b0[3]); w.z = cvt_pk_bf16(b1[0], b1[1]); w.w = cvt_pk_bf16(b1[2], b1[3]);
                    *(u32x4*)(rowp + 64) = w; }
        } else {
            const float sc = (u.pn == 8) ? 0.125f : 1.f;
            const int col0 = u.pn * BM + wc * 32 + 8 * fq;
#pragma unroll
            for (int ai = 0; ai < 2; ++ai)
#pragma unroll
                for (int m = 0; m < 4; ++m) { bf16_t* rowp = Z + (size_t)(row0 + ai * HALF + m * 16) * ZP1 + col0;
#pragma unroll
                    for (int bj = 0; bj < 2; ++bj) { const f32x4 v0 = acc[ai][bj][m][0] * sc, v1 = acc[ai][bj][m][1] * sc;
                        u32x4 w; w.x = cvt_pk_bf16(v0[0], v0[1]); w.y = cvt_pk_bf16(v0[2], v0[3]); w.z = cvt_pk_bf16(v1[0], v1[1]); w.w = cvt_pk_bf16(v1[2], v1[3]);
                        *(u32x4*)(rowp + bj * HALF) = w; } }
        }
    }
};
struct EpiGlu {
    static constexpr bool PERM = true;
    const bf16_t* G5; const float* bias; bf16_t* Y;
    __device__ __forceinline__ void operator()(const Acc& acc, const Unit& u, int wr, int wc, int fr, int fq) const {
        const int row0 = u.pm * BM + wr * 64 + fr, col0 = u.pn * BM + wc * 32 + 8 * fq;
        f32x4 bv[2][2];
#pragma unroll
        for (int bj = 0; bj < 2; ++bj)
#pragma unroll
            for (int n = 0; n < 2; ++n) bv[bj][n] = *(const f32x4*)(bias + col0 + bj * HALF + 4 * n);
#pragma unroll
        for (int ai = 0; ai < 2; ++ai)
#pragma unroll
            for (int m = 0; m < 4; ++m) { const size_t row = (size_t)(row0 + ai * HALF + m * 16);
#pragma unroll
                for (int bj = 0; bj < 2; ++bj) { const u32x4 gw = *(const u32x4*)(G5 + row * 512 + col0 + bj * HALF);
                    const f32x4 v0 = acc[ai][bj][m][0] + bv[bj][0], v1 = acc[ai][bj][m][1] + bv[bj][1];
                    float o[8]; o[0] = bflo(gw.x) * sigmoidf_(v0[0]); o[1] = bfhi(gw.x) * sigmoidf_(v0[1]); o[2] = bflo(gw.y) * sigmoidf_(v0[2]); o[3] = bfhi(gw.y) * sigmoidf_(v0[3]);
                    o[4] = bflo(gw.z) * sigmoidf_(v1[0]); o[5] = bfhi(gw.z) * sigmoidf_(v1[1]); o[6] = bflo(gw.w) * sigmoidf_(v1[2]); o[7] = bfhi(gw.w) * sigmoidf_(v1[3]);
                    u32x4 w; w.x = cvt_pk_bf16(o[0], o[1]); w.y = cvt_pk_bf16(o[2], o[3]); w.z = cvt_pk_bf16(o[4], o[5]); w.w = cvt_pk_bf16(o[6], o[7]);
                    *(u32x4*)(Y + row * DM + col0 + bj * HALF) = w; } }
    }
};
struct EpiF32 {
    static constexpr bool PERM = false;
    float* Cp; int ldc;
    __device__ __forceinline__ void operator()(const Acc& acc, const Unit& u, int wr, int wc, int fr, int fq) const {
        const int row0 = u.pm * BM + wr * 64 + fr, col0 = u.pn * BM + wc * 32 + 4 * fq;
#pragma unroll
        for (int ai = 0; ai < 2; ++ai)
#pragma unroll
            for (int m = 0; m < 4; ++m) { float* rowp = Cp + (size_t)(row0 + ai * HALF + m * 16) * ldc + col0;
#pragma unroll
                for (int bj = 0; bj < 2; ++bj)
#pragma unroll
                    for (int n = 0; n < 2; ++n) *(f32x4*)(rowp + bj * HALF + n * 16) = acc[ai][bj][m][n]; }
    }
};
struct EpiBf16Plain {
    static constexpr bool PERM = true;
    bf16_t* Cp; int ldc;
    __device__ __forceinline__ void operator()(const Acc& acc, const Unit& u, int wr, int wc, int fr, int fq) const {
        const int row0 = u.pm * BM + wr * 64 + fr, col0 = u.pn * BM + wc * 32 + 8 * fq;
#pragma unroll
        for (int ai = 0; ai < 2; ++ai)
#pragma unroll
            for (int m = 0; m < 4; ++m) { bf16_t* rowp = Cp + (size_t)(row0 + ai * HALF + m * 16) * ldc + col0;
#pragma unroll
                for (int bj = 0; bj < 2; ++bj) { const f32x4 v0 = acc[ai][bj][m][0], v1 = acc[ai][bj][m][1];
                    u32x4 w; w.x = cvt_pk_bf16(v0[0], v0[1]); w.y = cvt_pk_bf16(v0[2], v0[3]); w.z = cvt_pk_bf16(v1[0], v1[1]); w.w = cvt_pk_bf16(v1[2], v1[3]);
                    *(u32x4*)(rowp + bj * HALF) = w; } }
    }
};
struct EpiSwiglu {
    static constexpr bool PERM = true;
    unsigned char* ACT; const float* bgu;
    __device__ __forceinline__ void operator()(const Acc& acc, const Unit& u, int wr, int wc, int fr, int fq) const {
        constexpr float INV = 1.f / (SC_H * SC_W1);
        const int row0 = u.pm * BM + wr * 64 + fr, j0 = wc * 32 + 8 * fq, colg = u.pn * 128 + j0;
        const float* bp = bgu + (size_t)u.e * 2048 + colg;
        const f32x4 bg0 = *(const f32x4*)(bp), bg1 = *(const f32x4*)(bp + 4), bl0 = *(const f32x4*)(bp + 1024), bl1 = *(const f32x4*)(bp + 1028);
#pragma unroll
        for (int ai = 0; ai < 2; ++ai)
#pragma unroll
            for (int m = 0; m < 4; ++m) {
                const f32x4 g0 = acc[ai][0][m][0] * INV + bg0, g1 = acc[ai][0][m][1] * INV + bg1, l0 = acc[ai][1][m][0] * INV + bl0, l1 = acc[ai][1][m][1] * INV + bl1;
                float o[8];
#pragma unroll
                for (int i = 0; i < 4; ++i) { const float a = fminf(g0[i], 7.f), b = fminf(fmaxf(l0[i], -7.f), 7.f); o[i] = (SC_A * a) * sigmoidf_(1.702f * a) * (b + 1.f);
                                              const float a2 = fminf(g1[i], 7.f), b2 = fminf(fmaxf(l1[i], -7.f), 7.f); o[4 + i] = (SC_A * a2) * sigmoidf_(1.702f * a2) * (b2 + 1.f); }
                u32x2 w; w.x = pk8(o[0], o[1], o[2], o[3]); w.y = pk8(o[4], o[5], o[6], o[7]);
                *(u32x2*)(ACT + (size_t)(row0 + ai * HALF + m * 16) * DM + colg) = w; }
    }
};
struct EpiDown {
    static constexpr bool PERM = true;
    bf16_t* Y; const float* bdn; const int* list_tk; const float* list_g;
    __device__ __forceinline__ void operator()(const Acc& acc, const Unit& u, int wr, int wc, int fr, int fq) const {
        constexpr float INV = 1.f / (SC_A * SC_W2);
        const int r0 = wr * 64 + fr, col0 = u.pn * BM + wc * 32 + 8 * fq;
        const float* bp = bdn + (size_t)u.e * DM + col0;
        f32x4 bv[2][2];
#pragma unroll
        for (int bj = 0; bj < 2; ++bj)
#pragma unroll
            for (int n = 0; n < 2; ++n) bv[bj][n] = *(const f32x4*)(bp + bj * HALF + 4 * n);
        const size_t lbase = (size_t)u.e * LISTCAP + (size_t)u.mb * BM;
        int tkv[2][4]; float gtv[2][4];
#pragma unroll
        for (int ai = 0; ai < 2; ++ai)
#pragma unroll
            for (int m = 0; m < 4; ++m) { const int r = r0 + ai * HALF + m * 16, rc = r < u.nrows ? r : 0; tkv[ai][m] = list_tk[lbase + rc]; gtv[ai][m] = list_g[lbase + rc]; }
#pragma unroll
        for (int ai = 0; ai < 2; ++ai)
#pragma unroll
            for (int m = 0; m < 4; ++m) { const int r = r0 + ai * HALF + m * 16;
                if (r < u.nrows) { const float gt = gtv[ai][m];
                    bf16_t* rowp = Y + (size_t)tkv[ai][m] * DM + col0;
#pragma unroll
                    for (int bj = 0; bj < 2; ++bj) { const f32x4 v0 = (acc[ai][bj][m][0] * INV + bv[bj][0]) * gt, v1 = (acc[ai][bj][m][1] * INV + bv[bj][1]) * gt;
                        u32x4 w; w.x = cvt_pk_bf16(v0[0], v0[1]); w.y = cvt_pk_bf16(v0[2], v0[3]); w.z = cvt_pk_bf16(v1[0], v1[1]); w.w = cvt_pk_bf16(v1[2], v1[3]);
                        *(u32x4*)(rowp + bj * HALF) = w; } } }
    }
};
struct EpiMoeMix {
    static constexpr bool PERM = true;
    CArgs* ap; int l;
    __device__ __forceinline__ void operator()(const Acc& acc, const Unit& u, int wr, int wc, int fr, int fq) const {
        CArgs& A = *ap; unsigned char* ws = A.ws;
        if (u.kind == 0) { const EpiSwiglu sw{ws + WS_ACT, A.in[I_BGU] + (size_t)l * 32 * 2048}; sw(acc, u, wr, wc, fr, fq); }
        else { const EpiDown dn{(bf16_t*)(ws + WS_Y), A.in[I_BDN] + (size_t)l * 32 * 1024, (const int*)(ws + WS_LTK) + (size_t)l * 32 * LISTCAP, (const float*)(ws + WS_LG) + (size_t)l * 32 * LISTCAP}; dn(acc, u, wr, wc, fr, fq); }
    }
};
}
struct Frame { unsigned char* lds; int tid, lane, wave, bid, G; };
#define P_MOD   ((float*)(A.ws + WS_MOD))
#define P_S5A   ((float*)(A.ws + WS_S5A))
#define P_S5BB  ((float*)(A.ws + WS_S5BB))
#define P_ROPE  ((float*)(A.ws + WS_ROPE))
#define P_WSIDE ((float*)(A.ws + WS_WSIDE))
#define P_S5CK  ((bf16_t*)(A.ws + WS_S5CK))
#define P_LTK   ((int*)(A.ws + WS_LTK))
#define P_LG    ((float*)(A.ws + WS_LG))
#define P_CNT   ((unsigned*)(A.ws + WS_CTL) + CW_CNT)
#define P_WINE  ((bf16_t*)(A.ws + WS_WINE))
#define P_WGLU  ((bf16_t*)(A.ws + WS_WGLU))
#define P_WOUTE ((bf16_t*)(A.ws + WS_WOUTE))
#define P_WINO  ((bf16_t*)(A.ws + WS_WINO))
#define P_WOUTO ((bf16_t*)(A.ws + WS_WOUTO))
#define P_W1    (A.ws + WS_W1)
#define P_W2    (A.ws + WS_W2)
#define P_HB8   (A.ws + WS_HB8)
#define P_HB    ((bf16_t*)(A.ws + WS_HB))
#define P_Z     ((bf16_t*)(A.ws + WS_Z))
#define P_G5    ((bf16_t*)(A.ws + WS_G5))
#define P_YCAT  ((bf16_t*)(A.ws + WS_YCAT))
#define P_ACT   (A.ws + WS_ACT)
#define P_Y     ((bf16_t*)(A.ws + WS_Y))
#define P_LSIG  ((float*)(A.ws + WS_LSIG))
#define P_LOGA  ((float*)(A.ws + WS_LOGA))
#define P_MBUF  ((float*)(A.ws + WS_MBUF))
#define P_XB    ((bf16_t*)(A.ws + WS_XB))
#define P_RST   ((bf16_t*)(A.ws + WS_RST))
#define P_GST   ((bf16_t*)(A.ws + WS_GST))

__device__ __forceinline__ void tr_tile(const float* __restrict__ src, int pitch, int k0, int c0, bf16_t* dst, int Kd, int r0, float* scr, int lane) {
#pragma unroll
    for (int i = 0; i < 16; ++i) {
        const int kk = 4 * i + (lane >> 4), cc = 4 * (lane & 15);
        const f32x4 v = __builtin_nontemporal_load((const f32x4*)(src + (size_t)(k0 + kk) * pitch + c0 + cc));
        float* s = scr + kk * 65 + cc; s[0] = v.x; s[1] = v.y; s[2] = v.z; s[3] = v.w;
    }
    LDS_WAIT();
    const int c = lane & 7;
#pragma unroll
    for (int j = 0; j < 8; ++j) { const int n = (lane >> 3) + 8 * j; const float* s = scr + (8 * c) * 65 + n;
        u32x4 o; o.x = pk2(s[0], s[65]); o.y = pk2(s[130], s[195]); o.z = pk2(s[260], s[325]); o.w = pk2(s[390], s[455]);
        __builtin_nontemporal_store(o, (u32x4*)(dst + (size_t)(r0 + n) * Kd + k0 + 8 * c)); }
    LDS_WAIT();
}
__device__ __forceinline__ void tr_tile8(const float* __restrict__ src, int pitch, int k0, int c0, unsigned char* dst, int Kd, int r0, float* scr, int lane, float scale) {
#pragma unroll
    for (int i = 0; i < 16; ++i) {
        const int kk = 4 * i + (lane >> 4), cc = 4 * (lane & 15);
        const f32x4 v = __builtin_nontemporal_load((const f32x4*)(src + (size_t)(k0 + kk) * pitch + c0 + cc));
        float* s = scr + kk * 65 + cc; s[0] = v.x * scale; s[1] = v.y * scale; s[2] = v.z * scale; s[3] = v.w * scale;
    }
    LDS_WAIT();
    const int c = lane & 3;
#pragma unroll
    for (int j = 0; j < 4; ++j) { const int n = (lane >> 2) + 16 * j; const float* s = scr + (16 * c) * 65 + n;
        u32x4 o; o.x = pk8(s[0], s[65], s[130], s[195]); o.y = pk8(s[260], s[325], s[390], s[455]); o.z = pk8(s[520], s[585], s[650], s[715]); o.w = pk8(s[780], s[845], s[910], s[975]);
        __builtin_nontemporal_store(o, (u32x4*)(dst + (size_t)(r0 + n) * Kd + k0 + 16 * c)); }
    LDS_WAIT();
}
__device__ __forceinline__ void p0_prep(CArgs& A, const Frame& F) {
    float* scr = (float*)(F.lds) + F.wave * (64 * 65);
    const int gw = F.bid * 8 + F.wave, NGW = F.G * 8;
    constexpr int T0 = 16 * 32, T1 = 8 * 8, T2 = 16 * 16, T3 = 16 * 56, T4 = 16 * 16, T5 = 64 * 16 * 32, T6 = 64 * 16 * 16;
    constexpr int NTILES = T0 + T1 + T2 + T3 + T4 + T5 + T6;
    for (int it = gw; it < NTILES; it += NGW) {
        int r = it;
        if (r < T0) { const int kb = r / 32, nb = r % 32; tr_tile(A.in[I_EVWIN], 2056, kb * 64, nb * 64, P_WINE, 1024, nb * 64, scr, F.lane); continue; } r -= T0;
        if (r < T1) { const int kb = r / 8, nb = r % 8; tr_tile(A.in[I_GLUW], 512, kb * 64, nb * 64, P_WGLU, 512, nb * 64, scr, F.lane); continue; } r -= T1;
        if (r < T2) { const int kb = r / 16, nb = r % 16; tr_tile(A.in[I_EVWOUT], 1024, kb * 64, nb * 64, P_WOUTE, 1024, nb * 64, scr, F.lane); continue; } r -= T2;
        if (r < T3) { const int kb = r / 56, nb = r % 56; const int n0 = nb * 64; int c0;
            if (n0 < 1024) { const int pn = n0 >> 8, rem = n0 & 255, bj = rem >> 7, hl = (rem & 127) >> 6; c0 = 256 * pn + 128 * hl + 64 * bj; }
            else if (n0 < 3072) c0 = n0; else c0 = n0 + 16;
            tr_tile(A.in[I_ODWIN], 3600, kb * 64, c0, P_WINO, 1024, n0, scr, F.lane); continue; } r -= T3;
        if (r < T4) { const int kb = r / 16, nb = r % 16; tr_tile(A.in[I_ODWOUT], 1024, kb * 64, nb * 64, P_WOUTO, 1024, nb * 64, scr, F.lane); continue; } r -= T4;
        if (r < T5) { const int mat = r / 512, q = r % 512, kb = q / 32, nb = q % 32; const int n0 = nb * 64, pn = n0 >> 8, half = (n0 & 255) >> 7, j0 = n0 & 127;
            tr_tile8(A.in[I_WGU] + (size_t)mat * 1024 * 2048, 2048, kb * 64, half * 1024 + 128 * pn + j0, P_W1 + (size_t)mat * 2048 * 1024, 1024, n0, scr, F.lane, SC_W1); continue; } r -= T5;
        { const int mat = r / 256, q = r % 256, kb = q / 16, nb = q % 16;
            tr_tile8(A.in[I_WDN] + (size_t)mat * 1024 * 1024, 1024, kb * 64, nb * 64, P_W2 + (size_t)mat * 1024 * 1024, 1024, nb * 64, scr, F.lane, SC_W2); }
    }
    __syncthreads();
    {
        const int gt = F.bid * 512 + F.tid;
        if (gt < 32 * 64) {
            const int g = gt >> 6;
            const float lr = A.in[I_LAMRE][gt], li = A.in[I_LAMIM][gt], dt = expf(A.in[I_LOGDT][g]);
            const float mag = expf(lr * dt); float sn, cs; sincosf(li * dt, &sn, &cs);
            const float are = mag * cs, aim = mag * sn, den = lr * lr + li * li, nre = are - 1.f, nim = aim;
            const float zre = (nre * lr + nim * li) / den, zim = (nim * lr - nre * li) / den;
            P_S5A[gt * 2] = are; P_S5A[gt * 2 + 1] = aim;
            for (int c = 0; c < 16; ++c) { const float br = A.in[I_BRE][gt * 16 + c], bi = A.in[I_BIM][gt * 16 + c];
                P_S5BB[gt * 32 + c] = zre * br - zim * bi; P_S5BB[gt * 32 + 16 + c] = zre * bi + zim * br; }
        }
        for (int i = gt; i < 32 * 16 * 128; i += F.G * 512) { const int k = i & 127, gc = i >> 7, pp = k >> 1; const float v = (k & 1) ? -A.in[I_CIM][gc * 64 + pp] : A.in[I_CRE][gc * 64 + pp]; P_S5CK[i] = (bf16_t)f2bf(v); }
        for (int i = gt; i < 24 * 1024; i += F.G * 512) { const int o = i >> 10, k = i & 1023; P_WSIDE[i] = o < 8 ? A.in[I_EVWIN][(size_t)k * 2056 + 2048 + o] : A.in[I_ODWIN][(size_t)k * 3600 + 3072 + (o - 8)]; }
        for (int i = gt; i < SEQ * 64; i += F.G * 512) { const int pos = i >> 6, j = i & 63;
            const float inv = exp2f(-(float)j * (13.287712379549449f / 64.f)); const float ang = (float)pos * inv; float sn, cs; sincosf(ang, &sn, &cs);
            P_ROPE[i] = cs; P_ROPE[SEQ * 64 + i] = sn; }
    }
    if (F.bid < 192) {
        float* sc = (float*)F.lds;
        float* red = sc + 8192;
        for (int i = F.tid; i < 8192; i += 512) sc[i] = siluf_(A.in[I_C][i]);
        __syncthreads();
        const int l = F.bid / 96, n = (F.bid % 96) * 64 + F.lane;
        const float* w = A.in[I_ADAW] + (size_t)l * 1024 * 6144 + n;
        float a[8];
#pragma unroll
        for (int b = 0; b < 8; ++b) a[b] = 0.f;
        for (int k = 128 * F.wave; k < 128 * F.wave + 128; ++k) { const float wv = w[(size_t)k * 6144];
#pragma unroll
            for (int b = 0; b < 8; ++b) a[b] += sc[b * 1024 + k] * wv; }
#pragma unroll
        for (int b = 0; b < 8; ++b) red[(F.wave * 8 + b) * 64 + F.lane] = a[b];
        __syncthreads();
        { const int b = F.tid >> 6, ln = F.tid & 63; float s = 0.f;
#pragma unroll
          for (int w8 = 0; w8 < 8; ++w8) s += red[(w8 * 8 + b) * 64 + ln];
          const int nn = (F.bid % 96) * 64 + ln; P_MOD[(size_t)(l * 8 + b) * 6144 + nn] = s + A.in[I_ADAB][l * 6144 + nn]; }
    }
}

struct Row { f32x4 v[4]; };
__device__ __forceinline__ void row_load(Row& r, const float* p, int lane) {
#pragma unroll
    for (int j = 0; j < 4; ++j) r.v[j] = __builtin_nontemporal_load((const f32x4*)(p + 4 * lane + 256 * j));
}
__device__ __forceinline__ void row_load_bf16(Row& r, const bf16_t* p, int lane) {
#pragma unroll
    for (int j = 0; j < 4; ++j) { const u32x2 w = __builtin_nontemporal_load((const u32x2*)(p + 4 * lane + 256 * j)); r.v[j] = (f32x4){bflo(w.x), bfhi(w.x), bflo(w.y), bfhi(w.y)}; }
}
__device__ __forceinline__ void row_store(const Row& r, float* p, int lane) {
#pragma unroll
    for (int j = 0; j < 4; ++j) __builtin_nontemporal_store(r.v[j], (f32x4*)(p + 4 * lane + 256 * j));
}
__device__ __forceinline__ void row_store_bf16(const Row& r, bf16_t* p, int lane) {
#pragma unroll
    for (int j = 0; j < 4; ++j) { u32x2 w; w.x = pk2(r.v[j].x, r.v[j].y); w.y = pk2(r.v[j].z, r.v[j].w); *(u32x2*)(p + 4 * lane + 256 * j) = w; }
}
__device__ __forceinline__ void row_store_bf16_nt(const Row& r, bf16_t* p, int lane) {
#pragma unroll
    for (int j = 0; j < 4; ++j) { u32x2 w; w.x = pk2(r.v[j].x, r.v[j].y); w.y = pk2(r.v[j].z, r.v[j].w); __builtin_nontemporal_store(w, (u32x2*)(p + 4 * lane + 256 * j)); }
}
__device__ __forceinline__ float row_rstd(const Row& r) {
    float s = 0.f;
#pragma unroll
    for (int j = 0; j < 4; ++j) s += (r.v[j].x * r.v[j].x + r.v[j].y * r.v[j].y) + (r.v[j].z * r.v[j].z + r.v[j].w * r.v[j].w);
    return rsqrtf(wave_sum(s) * (1.f / DM) + EPS);
}
__device__ __forceinline__ void row_modnorm(Row& h, const Row& x, const float* gain, const float* sh, const float* sc, int lane) {
    const float r = row_rstd(x);
#pragma unroll
    for (int j = 0; j < 4; ++j) { const int k = 4 * lane + 256 * j; const f32x4 g = *(const f32x4*)(gain + k), a = *(const f32x4*)(sc + k), b = *(const f32x4*)(sh + k);
        h.v[j] = x.v[j] * r * g * (a + 1.f) + b; }
}
__device__ __forceinline__ void hprep_row(CArgs& A, const Frame& F, const Row& x, int l, int row, const float* wl) {
    const int b = row >> 11, lane = F.lane; const float* mod = P_MOD + (size_t)(l * 8 + b) * 6144;
    Row h; row_modnorm(h, x, A.in[I_NPM] + l * DM, mod, mod + 1024, lane);
    row_store_bf16(h, P_HB + (size_t)row * DM, lane);
    if (l == 0) {
        float mine = 0.f;
#pragma unroll
        for (int i = 0; i < 8; ++i) { float p = 0.f;
#pragma unroll
            for (int j = 0; j < 4; ++j) { const f32x4 w = *(const f32x4*)(wl + i * 1024 + 4 * lane + 256 * j); p += (h.v[j].x * w.x + h.v[j].y * w.y) + (h.v[j].z * w.z + h.v[j].w * w.w); }
            const float s = wave_sum(p); if (lane == i) mine = s; if ((i & 3) == 3) asm volatile("" ::: "memory"); }
        if (lane < 8) P_LSIG[(size_t)row * 8 + lane] = log_sigmoidf_(mine + A.in[I_FOXB][lane]);
    } else {
        float p[16];
#pragma unroll
        for (int i = 0; i < 16; ++i) { float q = 0.f;
#pragma unroll
            for (int j = 0; j < 4; ++j) { const f32x4 w = *(const f32x4*)(wl + i * 1024 + 4 * lane + 256 * j); q += (h.v[j].x * w.x + h.v[j].y * w.y) + (h.v[j].z * w.z + h.v[j].w * w.w); }
            p[i] = wave_sum(q); if ((i & 1) == 1) asm volatile("" ::: "memory"); }
        const float* wup = wl + 16 * 1024;
#pragma unroll
        for (int q = 0; q < 4; ++q) { const int jcol = lane + 64 * q; float s = wup[16 * 256 + jcol];
#pragma unroll
            for (int i = 0; i < 16; ++i) s += p[i] * wup[i * 256 + jcol];
            P_LOGA[(size_t)row * 256 + jcol] = log_sigmoidf_(s) * (1.f / 16.f); }
    }
}
__device__ __forceinline__ void stage_side(CArgs& A, const Frame& F, int l, float* wl) {
    __syncthreads();
    if (l == 0) { for (int i = F.tid; i < 8 * 256; i += 512) *(f32x4*)(wl + 4 * i) = *(const f32x4*)(P_WSIDE + 4 * i); }
    else { for (int i = F.tid; i < 16 * 256; i += 512) *(f32x4*)(wl + 4 * i) = *(const f32x4*)(P_WSIDE + 8192 + 4 * i);
           for (int i = F.tid; i < 16 * 64; i += 512) *(f32x4*)(wl + 16384 + 4 * i) = *(const f32x4*)(A.in[I_GLAWUP] + 4 * i);
           if (F.tid < 64) *(f32x4*)(wl + 16384 + 4096 + 4 * F.tid) = *(const f32x4*)(A.in[I_GLABG] + 4 * F.tid); }
    __syncthreads();
}
__device__ __forceinline__ void p1_hprep0(CArgs& A, const Frame& F) {
    float* wl = (float*)F.lds; stage_side(A, F, 0, wl);
    const int gw = F.bid * 8 + F.wave, NGW = F.G * 8;
    Row xn; if (gw < NTOK) row_load(xn, A.in[I_X] + (size_t)gw * DM, F.lane);
#pragma unroll 1
    for (int row = gw; row < NTOK; row += NGW) { Row x;
#pragma unroll
        for (int j = 0; j < 4; ++j) x.v[j] = xn.v[j];
        if (row + NGW < NTOK) row_load(xn, A.in[I_X] + (size_t)(row + NGW) * DM, F.lane); hprep_row(A, F, x, 0, row, wl); }
}

__device__ __forceinline__ void p_postmix(CArgs& A, const Frame& F, int l) {
    float* h2s = (float*)F.lds;
    float* red = h2s + 16 * 1028;
    float* lg = red + 8 * 16 * 32;
    float* tv = lg + 16 * 32;
    int* lcnt = (int*)(tv + 64);
    int* ent = lcnt + 64;
    if (F.tid < 32) lcnt[F.tid] = 0;
    int nent = 0;
    const float* rw = A.in[I_RW] + (size_t)l * 1024 * 32;
    u32x2 pm[2][4]; f32x4 pxf[2][4]; u32x2 pxb[2][4];
#define PM_LOAD(tile_) do { const int r0_ = (tile_) * 16 + 2 * F.wave; _Pragma("unroll") for (int rr = 0; rr < 2; ++rr) _Pragma("unroll") for (int j = 0; j < 4; ++j) { \
        pm[rr][j] = __builtin_nontemporal_load((const u32x2*)((const bf16_t*)P_MBUF + (size_t)(r0_ + rr) * DM + 4 * F.lane + 256 * j)); \
        if (l == 0) pxf[rr][j] = __builtin_nontemporal_load((const f32x4*)(A.in[I_X] + (size_t)(r0_ + rr) * DM + 4 * F.lane + 256 * j)); \
        else pxb[rr][j] = __builtin_nontemporal_load((const u32x2*)(P_XB + (size_t)(r0_ + rr) * DM + 4 * F.lane + 256 * j)); } } while (0)
    if (F.bid < NTOK / 16) PM_LOAD(F.bid);
#pragma unroll 1
    for (int tile = F.bid; tile < NTOK / 16; tile += F.G) {
        const int row0 = tile * 16 + 2 * F.wave;
        Row m0, x0, m1, x1;
#pragma unroll
        for (int j = 0; j < 4; ++j) { m0.v[j] = (f32x4){bflo(pm[0][j].x), bfhi(pm[0][j].x), bflo(pm[0][j].y), bfhi(pm[0][j].y)}; m1.v[j] = (f32x4){bflo(pm[1][j].x), bfhi(pm[1][j].x), bflo(pm[1][j].y), bfhi(pm[1][j].y)};
            if (l == 0) { x0.v[j] = pxf[0][j]; x1.v[j] = pxf[1][j]; }
            else { x0.v[j] = (f32x4){bflo(pxb[0][j].x), bfhi(pxb[0][j].x), bflo(pxb[0][j].y), bfhi(pxb[0][j].y)}; x1.v[j] = (f32x4){bflo(pxb[1][j].x), bfhi(pxb[1][j].x), bflo(pxb[1][j].y), bfhi(pxb[1][j].y)}; } }
        if (tile + F.G < NTOK / 16) PM_LOAD(tile + F.G);
#pragma unroll
        for (int rr = 0; rr < 2; ++rr) {
            const int lr = 2 * F.wave + rr, row = row0 + rr, b = row >> 11; const float* mod = P_MOD + (size_t)(l * 8 + b) * 6144;
            const Row& m = rr ? m1 : m0; Row x = rr ? x1 : x0;
            const float r1 = row_rstd(m);
#pragma unroll
            for (int j = 0; j < 4; ++j) { const int k = 4 * F.lane + 256 * j; const f32x4 gp = *(const f32x4*)(A.in[I_NQM] + l * DM + k), g1 = *(const f32x4*)(mod + 2048 + k);
                x.v[j] = x.v[j] + g1 * (m.v[j] * r1 * gp); }
            row_store_bf16_nt(x, P_XB + (size_t)row * DM, F.lane);
            Row h; row_modnorm(h, x, A.in[I_NPF] + l * DM, mod + 3072, mod + 4096, F.lane);
#pragma unroll
            for (int j = 0; j < 4; ++j) *(unsigned*)(P_HB8 + (size_t)row * DM + 4 * F.lane + 256 * j) = pk8(SC_H * h.v[j].x, SC_H * h.v[j].y, SC_H * h.v[j].z, SC_H * h.v[j].w);
#pragma unroll
            for (int j = 0; j < 4; ++j) *(f32x4*)(h2s + lr * 1028 + 4 * F.lane + 256 * j) = h.v[j];
        }
        __syncthreads();
        {
            f32x4 d0 = {0.f, 0.f, 0.f, 0.f}, d1 = {0.f, 0.f, 0.f, 0.f};
            const int r16 = F.lane & 15, kq = F.lane >> 4;
#pragma unroll 8
            for (int ks = 0; ks < 32; ++ks) { const int k = 128 * F.wave + 4 * ks + kq;
                const float a = h2s[r16 * 1028 + k]; const float b0 = rw[k * 32 + r16], b1 = rw[k * 32 + 16 + r16];
                d0 = __builtin_amdgcn_mfma_f32_16x16x4f32(a, b0, d0, 0, 0, 0); d1 = __builtin_amdgcn_mfma_f32_16x16x4f32(a, b1, d1, 0, 0, 0); }
#pragma unroll
            for (int q = 0; q < 4; ++q) { red[(F.wave * 16 + 4 * kq + q) * 32 + r16] = d0[q]; red[(F.wave * 16 + 4 * kq + q) * 32 + 16 + r16] = d1[q]; }
        }
        __syncthreads();
        const int r = F.tid >> 5, e = F.tid & 31;
        { float s = A.in[I_RB][l * 32 + e];
#pragma unroll
          for (int w8 = 0; w8 < 8; ++w8) s += red[(w8 * 16 + r) * 32 + e];
          lg[r * 32 + e] = s; }
        __syncthreads();
        const float v = lg[r * 32 + e]; int rank = 0;
#pragma unroll 8
        for (int q = 0; q < 32; ++q) { const float u = lg[r * 32 + q]; rank += (u > v || (u == v && q < e)) ? 1 : 0; }
        if (rank < 4) tv[r * 4 + rank] = v;
        __syncthreads();
        if (rank < 4) { const f32x4 t4 = *(const f32x4*)(tv + r * 4);
            const float wsum = 1.f + __expf(t4.y - t4.x) + __expf(t4.z - t4.x) + __expf(t4.w - t4.x), wk = __expf(v - t4.x);
            const int token = tile * 16 + r, lpos = atomicAdd(lcnt + e, 1), slot = nent + r * 4 + rank;
            ent[slot * 4] = e; ent[slot * 4 + 1] = lpos; ent[slot * 4 + 2] = token * 4 + rank; ent[slot * 4 + 3] = __float_as_int(wk / wsum); }
        nent += 64;
        __syncthreads();
    }
#undef PM_LOAD
    unsigned* cntp = P_CNT; int* ltk = P_LTK; float* lgp = P_LG;
    if (F.tid < 32) { const int n = lcnt[F.tid]; lcnt[32 + F.tid] = n > 0 ? (int)atomicAdd(cntp + 64 * (l * 32 + F.tid), (unsigned)n) : 0; }
    __syncthreads();
    if (F.tid < nent) { const int e = ent[F.tid * 4], pos = lcnt[32 + e] + ent[F.tid * 4 + 1];
        ltk[(size_t)(l * 32 + e) * LISTCAP + pos] = ent[F.tid * 4 + 2]; lgp[(size_t)(l * 32 + e) * LISTCAP + pos] = __int_as_float(ent[F.tid * 4 + 3]); }
    __syncthreads();
}
__device__ __forceinline__ void p_combine(CArgs& A, const Frame& F, int l) {
    float* wl = (float*)F.lds; if (l == 0) stage_side(A, F, 1, wl);
    const int gw = F.bid * 8 + F.wave, NGW = F.G * 8;
    u32x2 y[4][4]; Row xr;
#define COMB_LOAD(row_) do { _Pragma("unroll") for (int k = 0; k < 4; ++k) _Pragma("unroll") for (int j = 0; j < 4; ++j) y[k][j] = __builtin_nontemporal_load((const u32x2*)(P_Y + (size_t)((row_) * 4 + k) * DM + 4 * F.lane + 256 * j)); \
        row_load_bf16(xr, P_XB + (size_t)(row_) * DM, F.lane); } while (0)
    if (gw < NTOK) COMB_LOAD(gw);
#pragma unroll 1
    for (int row = gw; row < NTOK; row += NGW) {
        const int b = row >> 11; const float* mod = P_MOD + (size_t)(l * 8 + b) * 6144;
        Row f;
#pragma unroll
        for (int j = 0; j < 4; ++j) { f.v[j] = (f32x4){0.f, 0.f, 0.f, 0.f};
#pragma unroll
            for (int k = 0; k < 4; ++k) { const u32x2 w = y[k][j]; f.v[j].x += bflo(w.x); f.v[j].y += bfhi(w.x); f.v[j].z += bflo(w.y); f.v[j].w += bfhi(w.y); } }
        Row x = xr;
        if (row + NGW < NTOK) COMB_LOAD(row + NGW);
        const float r = row_rstd(f);
#pragma unroll
        for (int j = 0; j < 4; ++j) { const int k = 4 * F.lane + 256 * j; const f32x4 gp = *(const f32x4*)(A.in[I_NQF] + l * DM + k), g2 = *(const f32x4*)(mod + 5120 + k);
            x.v[j] = x.v[j] + g2 * (f.v[j] * r * gp); }
        if (l == 0) row_store_bf16_nt(x, P_XB + (size_t)row * DM, F.lane); else row_store(x, A.out + (size_t)row * DM, F.lane);
        if (l == 0) hprep_row(A, F, x, 1, row, wl);
    }
#undef COMB_LOAD
}
__device__ __forceinline__ int moe_tables(CArgs& A, const Frame& F, int l, LAS pg8::MoeTables* tb) {
    __syncthreads();
    if (F.tid < 32) tb->cnt[F.tid] = (int)__hip_atomic_load(P_CNT + 64 * (l * 32 + F.tid), __ATOMIC_RELAXED, __HIP_MEMORY_SCOPE_AGENT);
    __syncthreads();
    if (F.tid == 0) { int s = 0;
#pragma nounroll
        for (int e = 0; e < 32; ++e) { tb->mtstart[e] = s; s += (tb->cnt[e] + 255) >> 8; }
        tb->mtstart[32] = s; }
    __syncthreads();
    if (F.tid < 320) { int e = 0;
#pragma nounroll
        for (int q = 1; q < 32; ++q) if (tb->mtstart[q] <= F.tid) e = q;
        tb->tile_e[F.tid] = (unsigned char)e; }
    __syncthreads();
    return tb->mtstart[32];
}
__device__ __forceinline__ void fox_kbias(CArgs& A, const Frame& F, int b, int h, float* kb, float* wtot  ) {
    const int t0 = 4 * F.tid; float e[4];
#pragma unroll
    for (int i = 0; i < 4; ++i) e[i] = P_LSIG[(size_t)(b * SEQ + t0 + i) * 8 + h];
    const float s4 = (e[0] + e[1]) + (e[2] + e[3]); float v = s4;
#pragma unroll
    for (int o = 1; o < 64; o <<= 1) { const float tt = __shfl_up(v, o); if (F.lane >= o) v += tt; }
    if (F.lane == 63) wtot[F.wave] = v;
    __syncthreads();
    float off = 0.f;
#pragma unroll
    for (int w = 0; w < 8; ++w) if (w < F.wave) off += wtot[w];
    float c = off + v - s4;
#pragma unroll
    for (int i = 0; i < 4; ++i) { c += e[i]; kb[t0 + i] = -LOG2E * c; }
    __syncthreads();
}
#include <hip/hip_bf16.h>
namespace attn_body {
using bf16=__hip_bfloat16;
using bf16x8=__attribute__((ext_vector_type(8)))short;
using s16x4=__attribute__((ext_vector_type(4)))short;
using f32x16=__attribute__((ext_vector_type(16)))float;
using u32x4=__attribute__((ext_vector_type(4)))unsigned;
constexpr int BATCH=8,NHEAD=8,SEQ=2048,D=64,QP=2048,OP=1024;
constexpr int NW=8,QBLK=32,QB=QBLK*NW,KVBLK=64,NQB=SEQ/QB;
constexpr int ATTN_UNIT_ROWS=QB;
__device__ __forceinline__ int crow(int r,int hi){return (r&3)+8*(r>>2)+4*hi;}
#define SBAR() __builtin_amdgcn_sched_barrier(0)
__device__ __forceinline__ void cmask(f32x16&p0,f32x16&p1,int jb,int qrel,int hi){
  const float NEG=-INFINITY; int kb=64*jb+4*hi;
  #pragma unroll
  for(int r=0;r<16;++r){int kv=kb+(r&3)+8*(r>>2); if(kv>qrel)p0[r]=NEG; if(kv+32>qrel)p1[r]=NEG;}
}

constexpr int NSLOT=3, SLOTB=8192;
constexpr int LDS_K=0, LDS_V=NSLOT*SLOTB, LDS_WS=2*NSLOT*SLOTB, LDS_OST=LDS_WS+NW*64*4, LDS_BYTES=LDS_OST+NW*4096;
constexpr float C2=0.125f*1.4426950408889634f;
__device__ __forceinline__ void glds16(const void*gsrc,unsigned lds_dst){unsigned keep;
  asm volatile("s_mov_b32 %0, m0\n\ts_mov_b32 m0, %2\n\ts_nop 0\n\tglobal_load_lds_dwordx4 %1, off\n\ts_mov_b32 m0, %0":"=&s"(keep):"v"(gsrc),"s"(lds_dst):"memory");}
__device__ __forceinline__ float max3f(float a,float b,float c){float r;asm("v_max3_f32 %0, %1, %2, %3":"=v"(r):"v"(a),"v"(b),"v"(c));return r;}
__device__ __forceinline__ float max2f(float a,float b){float r;asm("v_max_f32_e32 %0, %1, %2":"=v"(r):"v"(a),"v"(b));return r;}
__device__ __forceinline__ float fadd_s(float a,float b){float r;asm("v_add_f32_e32 %0, %1, %2":"=v"(r):"v"(a),"v"(b));return r;}
__device__ __forceinline__ float fsub_s(float a,float b){float r;asm("v_sub_f32_e32 %0, %1, %2":"=v"(r):"v"(a),"v"(b));return r;}
typedef float f32x2_t __attribute__((ext_vector_type(2))); typedef float f32x4_t __attribute__((ext_vector_type(4))); typedef __bf16 bf16x2_t __attribute__((ext_vector_type(2)));
__device__ __forceinline__ unsigned cvtpk_s(float lo,float hi){f32x2_t v={lo,hi};bf16x2_t b=__builtin_convertvector(v,bf16x2_t);return __builtin_bit_cast(unsigned,b);}
#define WAIT_BAR(N) asm volatile("s_waitcnt vmcnt(" #N ") lgkmcnt(0)\n\ts_barrier":::"memory")

__device__ __forceinline__ void qkt(f32x16&p0,f32x16&p1,const char*Kslot,const bf16x8*qr,const f32x16&c0i,const f32x16&c1i,int r32,int hi){
  const char*kb=Kslot+hi*1024+r32*16;
  #pragma unroll
  for(int d0=0;d0<4;++d0){
    const bf16x8 b0=*reinterpret_cast<const bf16x8*>(kb+d0*2048);
    const bf16x8 b1=*reinterpret_cast<const bf16x8*>(kb+d0*2048+512);
    if(d0==0){p0=__builtin_amdgcn_mfma_f32_32x32x16_bf16(b0,qr[0],c0i,0,0,0);p1=__builtin_amdgcn_mfma_f32_32x32x16_bf16(b1,qr[0],c1i,0,0,0);}
    else{p0=__builtin_amdgcn_mfma_f32_32x32x16_bf16(b0,qr[d0],p0,0,0,0);p1=__builtin_amdgcn_mfma_f32_32x32x16_bf16(b1,qr[d0],p1,0,0,0);}}
}
typedef __attribute__((address_space(3))) const char* lds_cptr;
typedef short v4i16_t __attribute__((ext_vector_type(4)));
__device__ __forceinline__ void kload8(bf16x8*kf,lds_cptr kp){
  kf[0]=*(const __attribute__((address_space(3))) bf16x8*)(kp);      kf[1]=*(const __attribute__((address_space(3))) bf16x8*)(kp+512);
  kf[2]=*(const __attribute__((address_space(3))) bf16x8*)(kp+2048); kf[3]=*(const __attribute__((address_space(3))) bf16x8*)(kp+2560);
  kf[4]=*(const __attribute__((address_space(3))) bf16x8*)(kp+4096); kf[5]=*(const __attribute__((address_space(3))) bf16x8*)(kp+4608);
  kf[6]=*(const __attribute__((address_space(3))) bf16x8*)(kp+6144); kf[7]=*(const __attribute__((address_space(3))) bf16x8*)(kp+6656);
}
__device__ __forceinline__ void kload2(bf16x8*kf,lds_cptr kp,int j){ kf[2*j]=*(const __attribute__((address_space(3))) bf16x8*)(kp+j*2048); kf[2*j+1]=*(const __attribute__((address_space(3))) bf16x8*)(kp+j*2048+512); }
__device__ __forceinline__ s16x4 vtr(lds_cptr p){ return __builtin_bit_cast(s16x4,__builtin_amdgcn_ds_read_tr16_b64_v4i16((__attribute__((address_space(3))) v4i16_t*)p)); }
__device__ __forceinline__ float rowmax(const f32x16&p0,const f32x16&p1){
  float a=max3f(p0[0],p0[1],p1[0]),b=max3f(p0[2],p0[3],p1[1]);a=max3f(a,p1[2],p1[3]);
  #pragma unroll
  for(int r=4;r<16;r+=4){a=max3f(a,p0[r],p0[r+1]);b=max3f(b,p0[r+2],p0[r+3]);a=max3f(a,p1[r],p1[r+1]);b=max3f(b,p1[r+2],p1[r+3]);}
  const float m=max2f(a,b);
  auto rr=__builtin_amdgcn_permlane32_swap(__float_as_uint(m),__float_as_uint(m),false,false);
  return max2f(__uint_as_float(rr[0]),__uint_as_float(rr[1]));
}
__device__ __forceinline__ void pv(f32x16*o,int vb,bf16x8 pa0,bf16x8 pa1,bf16x8 pa2,bf16x8 pa3){
  #pragma unroll
  for(int d0=0;d0<2;++d0){s16x4 lo[4],hi[4];
    #pragma unroll
    for(int ks=0;ks<4;++ks){
      asm volatile("ds_read_b64_tr_b16 %0,%1 offset:%c2":"=&v"(lo[ks]):"v"(vb),"i"(d0*4096+ks*1024):"memory");
      asm volatile("ds_read_b64_tr_b16 %0,%1 offset:%c2":"=&v"(hi[ks]):"v"(vb),"i"(d0*4096+ks*1024+512):"memory");}
    asm volatile("s_waitcnt lgkmcnt(0)":::"memory");SBAR();
    #define PK(k) (bf16x8){lo[k][0],lo[k][1],lo[k][2],lo[k][3],hi[k][0],hi[k][1],hi[k][2],hi[k][3]}
    o[d0]=__builtin_amdgcn_mfma_f32_32x32x16_bf16(pa0,PK(0),o[d0],0,0,0);
    o[d0]=__builtin_amdgcn_mfma_f32_32x32x16_bf16(pa1,PK(1),o[d0],0,0,0);
    o[d0]=__builtin_amdgcn_mfma_f32_32x32x16_bf16(pa2,PK(2),o[d0],0,0,0);
    o[d0]=__builtin_amdgcn_mfma_f32_32x32x16_bf16(pa3,PK(3),o[d0],0,0,0);
    #undef PK
  }
}

#ifndef ATTN_STORE16
#define ATTN_STORE16(p,v) (*(u32x4*)(p)=(v))
#endif
typedef const __attribute__((address_space(3))) float* lds_fptr;
template<int THRL> __device__ __forceinline__ void attn_unit(int b,int h,int qb,const bf16*Q,const bf16*__restrict__ K,const bf16*__restrict__ V,bf16*O,char*shm,lds_fptr kb,int tid,int wid){
  const int lane=tid&63,r32=lane&31,hi=lane>>5;
  const long rowbase=(long)b*SEQ; const int q0=qb*QB;
  const bf16*Qw=Q+(rowbase+q0+wid*QBLK)*QP+h*D;
  const bf16*Kh=K+rowbase*QP+h*D,*Vh=V+rowbase*QP+h*D;
  const unsigned lds0=(unsigned)(uintptr_t)shm;
  float*wsf=(float*)(shm+LDS_WS)+wid*64;
  const bf16*ksrc=Kh+(long)lane*QP+wid*8;
  const bf16*vsrc=Vh+(long)(16*(wid&3)+(lane>>2))*QP+(wid>>2)*32+(lane&3)*8;
  const unsigned kdst=lds0+LDS_K+wid*1024, vdst=lds0+LDS_V+wid*1024;
  #define DMA_K(t,slot) glds16(ksrc+(long)(t)*KVBLK*QP,(unsigned)__builtin_amdgcn_readfirstlane(kdst+(slot)))
  #define DMA_V(t,slot) glds16(vsrc+(long)(t)*KVBLK*QP,(unsigned)__builtin_amdgcn_readfirstlane(vdst+(slot)))
  const int vb0=(int)(lds0+LDS_V)+((lane>>4)&1)*32+(lane&3)*8+(4*hi+((lane&15)>>2))*64;
  const char*Kbase=shm+LDS_K; bf16x8 kf[8];
  const lds_cptr shm3=(lds_cptr)shm; const lds_cptr kp0=shm3+LDS_K+hi*1024+r32*16; const lds_cptr vp0=shm3+LDS_V+((lane>>4)&1)*32+(lane&3)*8+(4*hi+((lane&15)>>2))*64;
  const int NT=(q0+QB)/KVBLK;
  DMA_K(0,0);DMA_V(0,0);DMA_K(1,SLOTB);
  bf16x8 qr[4];
  #pragma unroll
  for(int d0=0;d0<4;++d0)qr[d0]=*reinterpret_cast<const bf16x8*>(&Qw[(long)r32*QP+d0*16+hi*8]);
  float mhat=0.f,l_reg=0.f;f32x16 o[2];o[0]=f32x16{};o[1]=f32x16{};float nm=0.f;
  #define BIASFILL(C0,C1,t) do{ const lds_fptr kbt_=kb+64*(t)+4*hi; _Pragma("unroll") for(int g_=0;g_<4;++g_){ const f32x4_t v0_=*(const __attribute__((address_space(3))) f32x4_t*)(kbt_+8*g_), v1_=*(const __attribute__((address_space(3))) f32x4_t*)(kbt_+32+8*g_); \
      _Pragma("unroll") for(int i_=0;i_<4;++i_){ C0[4*g_+i_]=v0_[i_]+nm; C1[4*g_+i_]=v1_[i_]+nm; } } }while(0)
  const int qrel=wid*QBLK+r32;
  #define CMASK(P0,P1,t) do{int jb_=(t)-(NT-4); if(jb_>=0)cmask(P0,P1,jb_,qrel,hi);}while(0)
  bool resc=false;
  #define START(P0,P1) do{ const float rm=rowmax(P0,P1); resc=false; \
    { const float dl=rm; mhat=fadd_s(mhat,dl); \
      _Pragma("unroll") for(int r=0;r<16;++r){P0[r]=fsub_s(P0[r],dl);P1[r]=fsub_s(P1[r],dl);} \
      nm=-mhat; } \
    _Pragma("unroll") for(int r=0;r<16;++r)P0[r]=__builtin_amdgcn_exp2f(P0[r]); }while(0)
  #define RESC() do{ if(resc){ asm volatile("s_waitcnt lgkmcnt(0)":::"memory"); \
      _Pragma("unroll") for(int d_=0;d_<2;++d_) _Pragma("unroll") for(int r=0;r<16;++r)o[d_][r]*=wsf[crow(r,hi)]; } }while(0)
  f32x16 pA0,pA1,pB0,pB1;
  int sl_prev=0,sl_cur=0,sl_next=SLOTB;
  #define ROT() do{sl_prev=sl_cur;sl_cur=sl_next;sl_next=(sl_next==(NSLOT-1)*SLOTB)?0:sl_next+SLOTB;}while(0)
  DMA_K(2,2*SLOTB);
  WAIT_BAR(3);
  { f32x16 c0i,c1i; BIASFILL(c0i,c1i,0); qkt(pA0,pA1,Kbase,qr,c0i,c1i,r32,hi); }asm volatile("s_nop 15\n\ts_nop 7":"+v"(pA0),"+v"(pA1));CMASK(pA0,pA1,0);
  START(pA0,pA1);
  _Pragma("unroll") for(int r=0;r<16;++r)pA1[r]=__builtin_amdgcn_exp2f(pA1[r]);
  WAIT_BAR(0);
  DMA_K(3,0);DMA_V(1,SLOTB);
  ROT();
  kload8(kf,kp0+sl_cur);
  WAIT_BAR(2);
  s16x4 vlo[8],vhi[8]; u32x4 pw0,pw1,pw2,pw3;
  #define PKW(P,B) cvtpk_s(P[B],P[B+1])
  #define PAF(k) __builtin_bit_cast(bf16x8,pw##k)
  #define VFR(i) (bf16x8){vlo[i][0],vlo[i][1],vlo[i][2],vlo[i][3],vhi[i][0],vhi[i][1],vhi[i][2],vhi[i][3]}
  #define PIN(x) asm volatile("":"+v"(x))
  #define MX3(a,b,c) __builtin_fmaxf(__builtin_fmaxf((a),(b)),(c))
  #define GAPA(MF,A0,A1,A2,A3,W0,W1,PW) do{ MF; sacc+=A0; sacc+=A1; sacc+=A2; sacc+=A3; PIN(sacc); W0; W1; PIN(PW); SBAR(); }while(0)
  #define EX(v) __builtin_amdgcn_exp2f(v)
  #define GAPB(MF,X,B) do{ MF; X[B]=EX(X[B]); X[B+1]=EX(X[B+1]); X[B+2]=EX(X[B+2]); X[B+3]=EX(X[B+3]); PIN(X); SBAR(); }while(0)
  #define VRD(i) do{ vlo[i]=vtr(vp_+(((i)>>2)*4096+((i)&3)*1024)); vhi[i]=vtr(vp_+(((i)>>2)*4096+((i)&3)*1024+512)); }while(0)
  #define KRD(G,j) do{ if(G){ kload2(kf,kp0+sl_next,j); SBAR(); } }while(0)
  #define STEP(C0,C1,P0,P1,t,GK,GV,GL) do{ SBAR(); BIASFILL(C0,C1,t); SBAR(); \
    const lds_cptr vp_=vp0+sl_prev; \
    VRD(0); SBAR(); float sacc=(P0[0]+P0[1]); \
    GAPA(C0=__builtin_amdgcn_mfma_f32_32x32x16_bf16(kf[0],qr[0],C0,0,0,0), P0[2],P0[3],P0[4],P0[5],     pw0[0]=PKW(P0,0), pw0[1]=PKW(P0,2), pw0); \
    VRD(4); SBAR(); GAPA(C1=__builtin_amdgcn_mfma_f32_32x32x16_bf16(kf[1],qr[0],C1,0,0,0), P0[6],P0[7],P0[8],P0[9],     pw0[2]=PKW(P0,4), pw0[3]=PKW(P0,6), pw0); \
    VRD(1); SBAR(); GAPA(C0=__builtin_amdgcn_mfma_f32_32x32x16_bf16(kf[2],qr[1],C0,0,0,0),   P0[10],P0[11],P0[12],P0[13], pw1[0]=PKW(P0,8), pw1[1]=PKW(P0,10), pw1); \
    VRD(5); SBAR(); GAPA(C1=__builtin_amdgcn_mfma_f32_32x32x16_bf16(kf[3],qr[1],C1,0,0,0),   P0[14],P0[15],P1[0],P1[1],   pw1[2]=PKW(P0,12),pw1[3]=PKW(P0,14), pw1); \
    VRD(2); SBAR(); GAPA(C0=__builtin_amdgcn_mfma_f32_32x32x16_bf16(kf[4],qr[2],C0,0,0,0),   P1[2],P1[3],P1[4],P1[5],     pw2[0]=PKW(P1,0), pw2[1]=PKW(P1,2), pw2); \
    VRD(6); SBAR(); GAPA(C1=__builtin_amdgcn_mfma_f32_32x32x16_bf16(kf[5],qr[2],C1,0,0,0),   P1[6],P1[7],P1[8],P1[9],     pw2[2]=PKW(P1,4), pw2[3]=PKW(P1,6), pw2); \
    VRD(3); SBAR(); GAPA(C0=__builtin_amdgcn_mfma_f32_32x32x16_bf16(kf[6],qr[3],C0,0,0,0),   P1[10],P1[11],P1[12],P1[13], pw3[0]=PKW(P1,8), pw3[1]=PKW(P1,10), pw3); \
    VRD(7); SBAR(); GAPA(C1=__builtin_amdgcn_mfma_f32_32x32x16_bf16(kf[7],qr[3],C1,0,0,0),   P1[14],P1[15],0.f,0.f,       pw3[2]=PKW(P1,12),pw3[3]=PKW(P1,14), pw3); \
    l_reg+=sacc; \
    if(GK){DMA_K((t)+3,sl_cur);} if(GV){DMA_V((t)+1,sl_next);} \
    CMASK(C0,C1,t); \
    { float a=MX3(C0[0],C0[1],C1[0]),b=MX3(C0[2],C0[3],C1[1]); a=MX3(a,C1[2],C1[3]); \
      _Pragma("unroll") for(int r=4;r<16;r+=4){a=MX3(a,C0[r],C0[r+1]);b=MX3(b,C0[r+2],C0[r+3]);a=MX3(a,C1[r],C1[r+1]);b=MX3(b,C1[r+2],C1[r+3]);} \
      float rm=__builtin_fmaxf(a,b); { auto rr=__builtin_amdgcn_permlane32_swap(__float_as_uint(rm),__float_as_uint(rm),false,false); rm=__builtin_fmaxf(__uint_as_float(rr[0]),__uint_as_float(rr[1])); } \
      resc=false; \
      if(__builtin_expect(__any(rm>(float)THRL),0)){ const float dl=__builtin_fmaxf(rm,0.f); mhat+=dl; \
        _Pragma("unroll") for(int r=0;r<16;++r){C0[r]-=dl;C1[r]-=dl;} \
        nm=-mhat; \
        const float f=__builtin_amdgcn_exp2f(-dl); l_reg*=f; if(hi==0)wsf[r32]=f; resc=true; } } \
    SBAR(); \
    GAPB(o[0]=__builtin_amdgcn_mfma_f32_32x32x16_bf16(PAF(0),VFR(0),o[0],0,0,0), C0,0); \
    GAPB(o[1]=__builtin_amdgcn_mfma_f32_32x32x16_bf16(PAF(0),VFR(4),o[1],0,0,0), C0,4); \
    KRD(GL,0); GAPB(o[0]=__builtin_amdgcn_mfma_f32_32x32x16_bf16(PAF(1),VFR(1),o[0],0,0,0), C0,8); \
    KRD(GL,1); GAPB(o[1]=__builtin_amdgcn_mfma_f32_32x32x16_bf16(PAF(1),VFR(5),o[1],0,0,0), C0,12); \
    KRD(GL,2); GAPB(o[0]=__builtin_amdgcn_mfma_f32_32x32x16_bf16(PAF(2),VFR(2),o[0],0,0,0), C1,0); \
    KRD(GL,3); GAPB(o[1]=__builtin_amdgcn_mfma_f32_32x32x16_bf16(PAF(2),VFR(6),o[1],0,0,0), C1,4); \
    GAPB(o[0]=__builtin_amdgcn_mfma_f32_32x32x16_bf16(PAF(3),VFR(3),o[0],0,0,0), C1,8); \
    GAPB(o[1]=__builtin_amdgcn_mfma_f32_32x32x16_bf16(PAF(3),VFR(7),o[1],0,0,0), C1,12); \
    }while(0)
  int t=1;
  #undef CMASK
  #define CMASK(P0,P1,t) do{}while(0)
  for(;t+5<NT;t+=2){
    STEP(pB0,pB1,pA0,pA1,t,true,true,true);     WAIT_BAR(2); RESC(); ROT();
    STEP(pA0,pA1,pB0,pB1,t+1,true,true,true);   WAIT_BAR(2); RESC(); ROT();
  }
  #undef CMASK
  #define CMASK(P0,P1,t) do{int jb_=(t)-(NT-4); if(jb_>=0)cmask(P0,P1,jb_,qrel,hi);}while(0)
  #define ENDW(tt) do{ if((tt)+3<NT){WAIT_BAR(2);} else if((tt)+2<NT){WAIT_BAR(1);} else {WAIT_BAR(0);} }while(0)
  for(;t+1<NT;t+=2){
    STEP(pB0,pB1,pA0,pA1,t,(t+3<NT),(t+1<NT),(t+1<NT));       ENDW(t);   RESC(); ROT();
    STEP(pA0,pA1,pB0,pB1,t+1,(t+4<NT),(t+2<NT),(t+2<NT));     ENDW(t+1); RESC(); ROT();
  }
  STEP(pB0,pB1,pA0,pA1,NT-1,false,false,false); RESC();
  { float sacc=pB0[0]+pB0[1]; _Pragma("unroll") for(int r=2;r<16;++r)sacc+=pB0[r]; _Pragma("unroll") for(int r=0;r<16;++r)sacc+=pB1[r]; l_reg+=sacc;
    pw0=(u32x4){PKW(pB0,0),PKW(pB0,2),PKW(pB0,4),PKW(pB0,6)};pw1=(u32x4){PKW(pB0,8),PKW(pB0,10),PKW(pB0,12),PKW(pB0,14)};pw2=(u32x4){PKW(pB1,0),PKW(pB1,2),PKW(pB1,4),PKW(pB1,6)};pw3=(u32x4){PKW(pB1,8),PKW(pB1,10),PKW(pB1,12),PKW(pB1,14)};
    SBAR(); pv(o,vb0+sl_cur,PAF(0),PAF(1),PAF(2),PAF(3)); }
  #undef PKW
  #undef PAF
  #undef VFR
  #undef PIN
  #undef MX3
  #undef GAPA
  #undef GAPB
  #undef EX
  #undef VRD
  #undef KRD
  #undef STEP
  #undef ENDW
  {auto rr=__builtin_amdgcn_permlane32_swap(__float_as_uint(l_reg),__float_as_uint(l_reg),false,false);l_reg=__uint_as_float(rr[0])+__uint_as_float(rr[1]);}
  if(hi==0)wsf[32+r32]=l_reg;asm volatile("s_waitcnt lgkmcnt(0)":::"memory");
  float rli[16];
  #pragma unroll
  for(int r=0;r<16;++r)rli[r]=__builtin_amdgcn_rcpf(wsf[32+crow(r,hi)]);
  bf16*Ow=O+(rowbase+q0+wid*QBLK)*OP+h*D;
  { bf16*stg=(bf16*)(shm+LDS_OST)+wid*2048;
    #pragma unroll
    for(int r=0;r<16;++r){const int orow=crow(r,hi);
      #pragma unroll
      for(int d0=0;d0<2;++d0)stg[orow*64+d0*32+r32]=__float2bfloat16(o[d0][r]*rli[r]);}
    asm volatile("s_waitcnt lgkmcnt(0)":::"memory");
    #pragma unroll
    for(int i=0;i<4;++i){const int row=i*8+(lane>>3),ch=lane&7; const u32x4 v=*(const u32x4*)(stg+row*64+ch*8); ATTN_STORE16(Ow+(long)row*OP+ch*8,v);} }
  asm volatile("s_waitcnt lgkmcnt(0)\n\ts_barrier":::"memory");
  #undef DMA_K
  #undef DMA_V
  #undef CMASK
  #undef START
  #undef RESC
  #undef ROT
  #undef BIASFILL
}
constexpr int ATTN_LDS_BYTES=LDS_BYTES;
#undef SBAR
#undef WAIT_BAR
}
__device__ __forceinline__ void fox_fast(CArgs& A, const Frame& F) {
    float* kb = (float*)(F.lds + 86016); float* wtot = kb + 2048;
    const int v = (F.bid & 7) * 32 + (F.bid >> 3), bh = v >> 2, s = v & 3, b = bh >> 3, h = bh & 7;
    fox_kbias(A, F, b, h, kb, wtot);
    const attn_body::bf16* Zb = (const attn_body::bf16*)P_Z;
    const attn_body::lds_fptr kb3 = (attn_body::lds_fptr)(const __attribute__((address_space(3))) unsigned char*)((LAS unsigned char*)F.lds + 86016);
    attn_body::attn_unit<8>(b, h, 7 - s, Zb + 512, Zb + 1024, Zb + 1536, (attn_body::bf16*)P_YCAT + 512, (char*)F.lds, kb3, F.tid, F.wave);
    attn_body::attn_unit<8>(b, h, s, Zb + 512, Zb + 1024, Zb + 1536, (attn_body::bf16*)P_YCAT + 512, (char*)F.lds, kb3, F.tid, F.wave);
}
typedef float f32x16 __attribute__((ext_vector_type(16)));
__device__ __forceinline__ bf16x8 pack8(const f32x4& a, const f32x4& b) { u32x4 w; w.x = pk2(a.x, a.y); w.y = pk2(a.z, a.w); w.z = pk2(b.x, b.y); w.w = pk2(b.z, b.w); return __builtin_bit_cast(bf16x8, w); }
__device__ __forceinline__ void s5_fast(CArgs& A, const Frame& F, int item) {
    const int b = item >> 5, g = item & 31, lane = F.lane, w = F.wave, p = lane & 31, hh = lane >> 5, l15 = lane & 15, l4 = lane >> 4;
    float* Eseg = (float*)F.lds; float* Hin = Eseg + 2048;
    bf16_t* Hs = (bf16_t*)(F.lds + 16384) + w * 4352;
    bf16x8 bbr[2], bbi[2]; float are[2], aim[2];
#pragma unroll
    for (int nt = 0; nt < 2; ++nt) { const float* q = P_S5BB + (size_t)(g * 64 + 32 * nt + p) * 32 + 8 * hh;
        bbr[nt] = pack8(*(const f32x4*)q, *(const f32x4*)(q + 4)); bbi[nt] = pack8(*(const f32x4*)(q + 16), *(const f32x4*)(q + 20));
        are[nt] = P_S5A[(g * 64 + 32 * nt + p) * 2]; aim[nt] = P_S5A[(g * 64 + 32 * nt + p) * 2 + 1]; }
    const int rr = lane & 31, ahalf = (rr >> 2) & 1, atau = (rr & 3) + 4 * (rr >> 3);
    const bf16_t* usrc = P_Z + (size_t)(b * SEQ + 128 * (2 * w + ahalf) + atau) * ZP0 + g * 16 + 8 * hh;
    const f32x16 zero16 = {0.f, 0.f, 0.f, 0.f, 0.f, 0.f, 0.f, 0.f, 0.f, 0.f, 0.f, 0.f, 0.f, 0.f, 0.f, 0.f};
    float hr[2] = {0.f, 0.f}, hi[2] = {0.f, 0.f};
#define S5_ALOAD(blk_) (*(const bf16x8*)(usrc + (size_t)(blk_) * 16 * ZP0))
    { bf16x8 a0 = S5_ALOAD(0), a1 = S5_ALOAD(1), a2 = S5_ALOAD(2);
#pragma unroll 1
      for (int blk = 0; blk < 8; ++blk) {
        const bf16x8 a = a0; a0 = a1; a1 = a2; if (blk + 3 < 8) a2 = S5_ALOAD(blk + 3);
#pragma unroll
        for (int nt = 0; nt < 2; ++nt) {
            const f32x16 dre = __builtin_amdgcn_mfma_f32_32x32x16_bf16(a, bbr[nt], zero16, 0, 0, 0), dim = __builtin_amdgcn_mfma_f32_32x32x16_bf16(a, bbi[nt], zero16, 0, 0, 0);
#pragma unroll
            for (int i = 0; i < 16; ++i) { const float nr = are[nt] * hr[nt] - aim[nt] * hi[nt] + dre[i], ni = are[nt] * hi[nt] + aim[nt] * hr[nt] + dim[i]; hr[nt] = nr; hi[nt] = ni; }
        }
      } }
#pragma unroll
    for (int nt = 0; nt < 2; ++nt) { Eseg[((2 * w + hh) * 64 + 32 * nt + p) * 2] = hr[nt]; Eseg[((2 * w + hh) * 64 + 32 * nt + p) * 2 + 1] = hi[nt]; }
    __syncthreads();
    if (w == 0) {
        float xr = P_S5A[(g * 64 + lane) * 2], xi = P_S5A[(g * 64 + lane) * 2 + 1];
#pragma unroll
        for (int q = 0; q < 7; ++q) { const float nr = xr * xr - xi * xi, ni = 2.f * xr * xi; xr = nr; xi = ni; }
        float Hr = 0.f, Hi = 0.f;
#pragma unroll 1
        for (int s = 0; s < 16; ++s) { Hin[(s * 64 + lane) * 2] = Hr; Hin[(s * 64 + lane) * 2 + 1] = Hi;
            const float er = Eseg[(s * 64 + lane) * 2], ei = Eseg[(s * 64 + lane) * 2 + 1]; const float nr = xr * Hr - xi * Hi + er, ni = xr * Hi + xi * Hr + ei; Hr = nr; Hi = ni; }
    }
    __syncthreads();
#pragma unroll
    for (int nt = 0; nt < 2; ++nt) { hr[nt] = Hin[((2 * w + hh) * 64 + 32 * nt + p) * 2]; hi[nt] = Hin[((2 * w + hh) * 64 + 32 * nt + p) * 2 + 1]; }
    bf16x8 ck[4];
#pragma unroll
    for (int ks = 0; ks < 4; ++ks) ck[ks] = *(const bf16x8*)(P_S5CK + (size_t)(g * 16 + l15) * 128 + 32 * ks + 8 * l4);
    const int er = lane >> 1, eh = lane & 1;
    float* Ys = (float*)(F.lds + 86016) + w * 640;
    f32x4 dk0 = *(const f32x4*)(A.in[I_S5D] + g * 16 + 8 * eh), dk1 = *(const f32x4*)(A.in[I_S5D] + g * 16 + 8 * eh + 4);
#define S5_EROW(blk_) ((size_t)(b * SEQ + 128 * (2 * w + (er >> 4)) + 16 * (blk_) + (er & 15)))
    bf16x8 a0 = S5_ALOAD(0), a1 = S5_ALOAD(1), a2 = S5_ALOAD(2);
    u32x4 un = *(const u32x4*)(P_Z + S5_EROW(0) * ZP0 + g * 16 + 8 * eh);
#pragma unroll 1
    for (int blk = 0; blk < 8; ++blk) {
        const bf16x8 a = a0; a0 = a1; a1 = a2; if (blk + 3 < 8) a2 = S5_ALOAD(blk + 3);
        const u32x4 us = un; if (blk + 1 < 8) un = *(const u32x4*)(P_Z + S5_EROW(blk + 1) * ZP0 + g * 16 + 8 * eh);
#pragma unroll
        for (int nt = 0; nt < 2; ++nt) {
            const f32x16 dre = __builtin_amdgcn_mfma_f32_32x32x16_bf16(a, bbr[nt], zero16, 0, 0, 0), dim = __builtin_amdgcn_mfma_f32_32x32x16_bf16(a, bbi[nt], zero16, 0, 0, 0);
#pragma unroll
            for (int i = 0; i < 16; ++i) { const float nr = are[nt] * hr[nt] - aim[nt] * hi[nt] + dre[i], ni = are[nt] * hi[nt] + aim[nt] * hr[nt] + dim[i]; hr[nt] = nr; hi[nt] = ni;
                *(unsigned*)(Hs + (hh * 16 + i) * 136 + 2 * (32 * nt + p)) = pk2(nr, ni); }
        }
        LDS_WAIT();
#pragma unroll
        for (int sg = 0; sg < 2; ++sg) {
            f32x4 y = {0.f, 0.f, 0.f, 0.f};
#pragma unroll
            for (int ks = 0; ks < 4; ++ks) { const bf16x8 af = *(const bf16x8*)(Hs + (sg * 16 + l15) * 136 + 32 * ks + 8 * l4); y = __builtin_amdgcn_mfma_f32_16x16x32_bf16(af, ck[ks], y, 0, 0, 0); }
#pragma unroll
            for (int q = 0; q < 4; ++q) Ys[(sg * 16 + 4 * l4 + q) * 20 + l15] = y[q];
        }
        LDS_WAIT();
        { const f32x4 y0 = *(const f32x4*)(Ys + er * 20 + 8 * eh), y1 = *(const f32x4*)(Ys + er * 20 + 8 * eh + 4);
          float o[8]; o[0] = y0.x + dk0.x * bflo(us.x); o[1] = y0.y + dk0.y * bfhi(us.x); o[2] = y0.z + dk0.z * bflo(us.y); o[3] = y0.w + dk0.w * bfhi(us.y);
          o[4] = y1.x + dk1.x * bflo(us.z); o[5] = y1.y + dk1.y * bfhi(us.z); o[6] = y1.z + dk1.z * bflo(us.w); o[7] = y1.w + dk1.w * bfhi(us.w);
          u32x4 ov; ov.x = pk2(gelu_tanh(o[0]), gelu_tanh(o[1])); ov.y = pk2(gelu_tanh(o[2]), gelu_tanh(o[3])); ov.z = pk2(gelu_tanh(o[4]), gelu_tanh(o[5])); ov.w = pk2(gelu_tanh(o[6]), gelu_tanh(o[7]));
          *(u32x4*)(P_G5 + S5_EROW(blk) * 512 + g * 16 + 8 * eh) = ov; }
        LDS_WAIT();
    }
#undef S5_ALOAD
#undef S5_EROW
}
namespace lin {
typedef const LAS char* lptr;
typedef short s16x4 __attribute__((ext_vector_type(4)));
typedef short v4i16_t __attribute__((ext_vector_type(4)));
__device__ __forceinline__ s16x4 vtr(lptr p) { return __builtin_bit_cast(s16x4, __builtin_amdgcn_ds_read_tr16_b64_v4i16((LAS v4i16_t*)p)); }
__device__ __forceinline__ bf16x8 tr_frag(lptr sub, int ks, int lane) {
    const lptr p = sub + ((lane >> 4) & 1) * 32 + (lane & 3) * 8 + (4 * (lane >> 5) + ((lane & 15) >> 2)) * 64 + ks * 1024;
    const s16x4 lo = vtr(p), hi = vtr(p + 512);
    return (bf16x8){lo[0], lo[1], lo[2], lo[3], hi[0], hi[1], hi[2], hi[3]};
}
__device__ __forceinline__ bf16x8 nat_frag(lptr base, int ldb, int row0, int k0, int lane) { return *(const LAS bf16x8*)(base + (row0 + (lane & 31)) * ldb + (k0 + 8 * (lane >> 5)) * 2); }
__device__ __forceinline__ int crow(int r, int hh) { return (r & 3) + 8 * (r >> 2) + 4 * hh; }
__device__ __forceinline__ void unpack8(const u32x4& w, float (&f)[8]) { f[0] = bflo(w.x); f[1] = bfhi(w.x); f[2] = bflo(w.y); f[3] = bfhi(w.y); f[4] = bflo(w.z); f[5] = bfhi(w.z); f[6] = bflo(w.w); f[7] = bfhi(w.w); }
__device__ __forceinline__ u32x4 repack8(const float (&f)[8]) { u32x4 w; w.x = pk2(f[0], f[1]); w.y = pk2(f[2], f[3]); w.z = pk2(f[4], f[5]); w.w = pk2(f[6], f[7]); return w; }

__device__ __forceinline__ void gla_prefix(CArgs& A, const Frame& F, int item) {
    const int b = item >> 5, c = item & 31, half = F.tid >> 8, col = F.tid & 255;
    float* p = P_LOGA + (size_t)(b * SEQ + c * 64 + 32 * half) * 256 + col; float* tot = (float*)F.lds;
    float v[32];
#pragma unroll
    for (int i = 0; i < 32; ++i) v[i] = p[(size_t)i * 256];
#pragma unroll
    for (int i = 1; i < 32; ++i) v[i] += v[i - 1];
    if (half == 0) tot[col] = v[31];
    __syncthreads();
    const float off = half ? tot[col] : 0.f;
#pragma unroll
    for (int i = 0; i < 32; ++i) p[(size_t)i * 256] = v[i] + off;
    __syncthreads();
}
template <int KIND> __device__ __forceinline__ void r1_item(CArgs& A, const Frame& F, int bh, int vs) {
    constexpr int DK = KIND ? 64 : 128, ND = DK / 32;
    constexpr int KCOL = KIND ? 2304 : 512, VCOL = KIND ? 2560 : 1024;
    const int b = bh >> 2, h = bh & 3, tid = F.tid, lane = F.lane, w = F.wave, hh = lane >> 5;
    unsigned char* bufV = F.lds; unsigned char* bufK = F.lds + 4096;
    bf16_t* ST = (KIND ? P_GST : P_RST) + (size_t)bh * 32 * 128 * DK;
    const float log2g = KIND ? 0.f : log2f(1.f - exp2f(-5.f - (float)h));
    const float g64 = exp2f(64.f * log2g);
    f32x16 acc = {0.f, 0.f, 0.f, 0.f, 0.f, 0.f, 0.f, 0.f, 0.f, 0.f, 0.f, 0.f, 0.f, 0.f, 0.f, 0.f};
    const bf16_t* zb = P_Z + (size_t)(b * SEQ) * ZP1;
    const int vj = tid >> 2, vc = tid & 3;
    const int kj0 = KIND ? (tid >> 3) : (tid >> 4), kd0 = KIND ? (tid & 7) : (tid & 15);
#define R1_DECL(S) u32x4 rv##S = {0u, 0u, 0u, 0u}, rk0##S = {0u, 0u, 0u, 0u}, rk1##S = {0u, 0u, 0u, 0u}; f32x4 bj0##S = {0.f, 0.f, 0.f, 0.f}, bj1##S = bj0##S, bl0##S = bj0##S, bl1##S = bj0##S; float bd##S = 0.f;
#define R1_LOAD(S, c) do { const bf16_t* zc = zb + (size_t)((c) * 64) * ZP1; \
        if (tid < 256) rv##S = *(const u32x4*)(zc + (size_t)vj * ZP1 + VCOL + h * 128 + vs * 32 + vc * 8); \
        rk0##S = *(const u32x4*)(zc + (size_t)kj0 * ZP1 + KCOL + h * DK + kd0 * 8); \
        if (!KIND) rk1##S = *(const u32x4*)(zc + (size_t)(kj0 + 32) * ZP1 + KCOL + h * DK + kd0 * 8); \
        if (KIND) { const float* bp = P_LOGA + (size_t)(b * SEQ + (c) * 64) * 256 + h * 64; \
            bj0##S = *(const f32x4*)(bp + (size_t)kj0 * 256 + kd0 * 8); bj1##S = *(const f32x4*)(bp + (size_t)kj0 * 256 + kd0 * 8 + 4); \
            bl0##S = *(const f32x4*)(bp + 63 * 256 + kd0 * 8); bl1##S = *(const f32x4*)(bp + 63 * 256 + kd0 * 8 + 4); \
            if (w < ND) bd##S = bp[63 * 256 + 32 * w + (lane & 31)]; } } while (0)
#define R1_STEP(S, c) do { \
        if (tid < 256) { u32x4 o = rv##S; \
            if (!KIND) { float f[8]; unpack8(rv##S, f); const float z = exp2f((float)(63 - vj) * log2g); _Pragma("unroll") for (int e = 0; e < 8; ++e) f[e] *= z; o = repack8(f); } \
            *(u32x4*)(bufV + vj * 64 + vc * 16) = o; } \
        if (KIND) { float f[8]; unpack8(rk0##S, f); \
            f[0] *= __expf(bl0##S.x - bj0##S.x); f[1] *= __expf(bl0##S.y - bj0##S.y); f[2] *= __expf(bl0##S.z - bj0##S.z); f[3] *= __expf(bl0##S.w - bj0##S.w); \
            f[4] *= __expf(bl1##S.x - bj1##S.x); f[5] *= __expf(bl1##S.y - bj1##S.y); f[6] *= __expf(bl1##S.z - bj1##S.z); f[7] *= __expf(bl1##S.w - bj1##S.w); \
            *(u32x4*)(bufK + (kd0 >> 2) * 4096 + kj0 * 64 + (kd0 & 3) * 16) = repack8(f); \
        } else { \
            *(u32x4*)(bufK + (kd0 >> 2) * 4096 + kj0 * 64 + (kd0 & 3) * 16) = rk0##S; \
            *(u32x4*)(bufK + (kd0 >> 2) * 4096 + (kj0 + 32) * 64 + (kd0 & 3) * 16) = rk1##S; } \
        __syncthreads(); \
        const float decn = KIND ? __expf(bd##S) : 0.f; \
        if ((c) + 4 < 32) R1_LOAD(S, (c) + 4); \
        if (w < ND) { \
            bf16_t* sp = ST + ((size_t)(c) * 128 + vs * 32) * DK + 32 * w + (lane & 31); \
            const float dec = KIND ? decn : g64; \
            _Pragma("unroll") for (int r = 0; r < 16; ++r) { sp[(size_t)crow(r, hh) * DK] = (bf16_t)f2bf(acc[r]); acc[r] *= dec; } \
            _Pragma("unroll") for (int ks = 0; ks < 4; ++ks) acc = __builtin_amdgcn_mfma_f32_32x32x16_bf16(tr_frag((lptr)(LAS unsigned char*)bufV, ks, lane), tr_frag((lptr)(LAS unsigned char*)bufK + w * 4096, ks, lane), acc, 0, 0, 0); \
        } \
        __syncthreads(); } while (0)
    R1_DECL(0) R1_DECL(1) R1_DECL(2) R1_DECL(3)
    R1_LOAD(0, 0); R1_LOAD(1, 1); R1_LOAD(2, 2); R1_LOAD(3, 3);
#pragma unroll 1
    for (int c = 0; c < 32; c += 4) { R1_STEP(0, c); R1_STEP(1, c + 1); R1_STEP(2, c + 2); R1_STEP(3, c + 3); }
#undef R1_DECL
#undef R1_LOAD
#undef R1_STEP
}
__device__ __forceinline__ void p_lin_r1(CArgs& A, const Frame& F) {
    const int v = F.bid, r = v & 127;
    if (v < 128) r1_item<0>(A, F, r >> 2, r & 3); else r1_item<1>(A, F, r >> 2, r & 3);
}

template <int KIND> struct R2Regs {
    static constexpr int DK = KIND ? 64 : 128, NQP = 64 * DK / 8 / 512, NSP = 128 * DK / 8 / 512;
    u32x4 q[NQP], k[NQP], v[2], s[NSP], g[2]; f32x4 bq[NQP][2];
};
template <int KIND> __device__ __forceinline__ void r2_load(CArgs& A, const Frame& F, R2Regs<KIND>& R, int bh, int c) {
    constexpr int DK = KIND ? 64 : 128;
    constexpr int QCOL = KIND ? 2048 : 0, KCOL = KIND ? 2304 : 512, VCOL = KIND ? 2560 : 1024, GCOL = KIND ? 3072 : 1536;
    const int b = bh >> 2, h = bh & 3, tid = F.tid, lane = F.lane, w = F.wave, hh = lane >> 5, l31 = lane & 31, rb = w >> 2, cb = w & 3;
    const bf16_t* zc = P_Z + (size_t)(b * SEQ + c * 64) * ZP1;
    const bf16_t* ST = (KIND ? P_GST : P_RST) + ((size_t)bh * 32 + c) * 128 * DK;
#pragma unroll
    for (int r = 0; r < R2Regs<KIND>::NQP; ++r) { const int q = tid + 512 * r, i = q / (DK / 8), d8 = q % (DK / 8);
        R.q[r] = *(const u32x4*)(zc + (size_t)i * ZP1 + QCOL + h * DK + d8 * 8); R.k[r] = *(const u32x4*)(zc + (size_t)i * ZP1 + KCOL + h * DK + d8 * 8);
        if (KIND) { const float* bp = P_LOGA + (size_t)(b * SEQ + c * 64 + i) * 256 + h * 64 + d8 * 8; R.bq[r][0] = *(const f32x4*)bp; R.bq[r][1] = *(const f32x4*)(bp + 4); } }
#pragma unroll
    for (int r = 0; r < 2; ++r) { const int q = tid + 512 * r, j = q >> 4, v8 = q & 15; R.v[r] = *(const u32x4*)(zc + (size_t)j * ZP1 + VCOL + h * 128 + v8 * 8); }
#pragma unroll
    for (int r = 0; r < R2Regs<KIND>::NSP; ++r) { const int q = tid + 512 * r, vr = q / (DK / 8), d8 = q % (DK / 8); R.s[r] = *(const u32x4*)(ST + (size_t)vr * DK + d8 * 8); }
#pragma unroll
    for (int k2 = 0; k2 < 2; ++k2) { const int pp = lane + 64 * k2; R.g[k2] = *(const u32x4*)(zc + (size_t)(32 * rb + (pp >> 2)) * ZP1 + GCOL + h * 128 + 32 * cb + 8 * (pp & 3)); }
}
template <int KIND> struct R2Lds { static constexpr int DK = KIND ? 64 : 128, LDQ = (DK + 8) * 2, OFF_K = 64 * LDQ, OFF_V = 2 * 64 * LDQ, OFF_S = OFF_V + 16384, OFF_SSQ = OFF_S + 128 * LDQ, OFF_BC = OFF_SSQ + 1024; };
template <int KIND> __device__ __forceinline__ void r2_stage(const Frame& F, const R2Regs<KIND>& R, u32x4 (&gc)[2]) {
    typedef R2Lds<KIND> LL; constexpr int DK = LL::DK, LDQ = LL::LDQ;
    const int tid = F.tid; unsigned char* L = F.lds;
#pragma unroll
    for (int r = 0; r < R2Regs<KIND>::NQP; ++r) { const int q = tid + 512 * r, i = q / (DK / 8), d8 = q % (DK / 8);
        u32x4 qw = R.q[r], kw = R.k[r];
        if (KIND) { float fq[8], fk[8]; unpack8(qw, fq); unpack8(kw, fk);
#pragma unroll
            for (int e = 0; e < 8; ++e) { const float bb = R.bq[r][e >> 2][e & 3]; fq[e] *= __expf(bb); fk[e] *= __expf(-bb); }
            qw = repack8(fq); kw = repack8(fk); }
        *(u32x4*)(L + i * LDQ + d8 * 16) = qw; *(u32x4*)(L + LL::OFF_K + i * LDQ + d8 * 16) = kw; }
#pragma unroll
    for (int r = 0; r < 2; ++r) { const int q = tid + 512 * r, j = q >> 4, v8 = q & 15; *(u32x4*)(L + LL::OFF_V + (v8 >> 2) * 4096 + j * 64 + (v8 & 3) * 16) = R.v[r]; }
#pragma unroll
    for (int r = 0; r < R2Regs<KIND>::NSP; ++r) { const int q = tid + 512 * r, vr = q / (DK / 8), d8 = q % (DK / 8); *(u32x4*)(L + LL::OFF_S + vr * LDQ + d8 * 16) = R.s[r]; }
    gc[0] = R.g[0]; gc[1] = R.g[1];
    __syncthreads();
}
template <int KIND> __device__ __forceinline__ void r2_compute(CArgs& A, const Frame& F, int bh, int c, const u32x4 (&gc)[2]) {
    typedef R2Lds<KIND> LL; constexpr int DK = LL::DK, LDQ = LL::LDQ, OFF_K = LL::OFF_K, OFF_V = LL::OFF_V, OFF_S = LL::OFF_S;
    constexpr int OCOL = KIND ? 512 : 0;
    const int b = bh >> 2, h = bh & 3, lane = F.lane, w = F.wave, hh = lane >> 5, l31 = lane & 31, rb = w >> 2, cb = w & 3;
    unsigned char* L = F.lds; float* ssq = (float*)(L + LL::OFF_SSQ);
    const float log2g = KIND ? 0.f : log2f(1.f - exp2f(-5.f - (float)h));
    const lptr L3 = (lptr)(LAS unsigned char*)L;
    bf16x8 pa[2][2];
#pragma unroll
    for (int jt = 0; jt < 2; ++jt) {
        f32x16 p = {0.f, 0.f, 0.f, 0.f, 0.f, 0.f, 0.f, 0.f, 0.f, 0.f, 0.f, 0.f, 0.f, 0.f, 0.f, 0.f};
        if (jt <= rb) {
#pragma unroll
            for (int ks = 0; ks < DK / 16; ++ks) p = __builtin_amdgcn_mfma_f32_32x32x16_bf16(nat_frag(L3 + OFF_K, LDQ, 32 * jt, 16 * ks, lane), nat_frag(L3, LDQ, 32 * rb, 16 * ks, lane), p, 0, 0, 0);
        }
        const int i = 32 * rb + l31;
        float f[16];
#pragma unroll
        for (int r = 0; r < 16; ++r) { const int j = 32 * jt + crow(r, hh); float x = (i >= j) ? p[r] : 0.f; if (!KIND) x *= exp2f((float)(i - j) * log2g); f[r] = (i >= j) ? x : 0.f; }
#pragma unroll
        for (int s = 0; s < 2; ++s) { u32x4 wv; wv.x = pk2(f[8 * s], f[8 * s + 1]); wv.y = pk2(f[8 * s + 2], f[8 * s + 3]); wv.z = pk2(f[8 * s + 4], f[8 * s + 5]); wv.w = pk2(f[8 * s + 6], f[8 * s + 7]); pa[jt][s] = __builtin_bit_cast(bf16x8, wv); }
    }
    f32x16 o1 = {0.f, 0.f, 0.f, 0.f, 0.f, 0.f, 0.f, 0.f, 0.f, 0.f, 0.f, 0.f, 0.f, 0.f, 0.f, 0.f}, o2 = o1;
#pragma unroll
    for (int jt = 0; jt < 2; ++jt)
#pragma unroll
        for (int s = 0; s < 2; ++s) o1 = __builtin_amdgcn_mfma_f32_32x32x16_bf16(pa[jt][s], tr_frag(L3 + OFF_V + cb * 4096, 2 * jt + s, lane), o1, 0, 0, 0);
#pragma unroll
    for (int ks = 0; ks < DK / 16; ++ks) o2 = __builtin_amdgcn_mfma_f32_32x32x16_bf16(nat_frag(L3, LDQ, 32 * rb, 16 * ks, lane), nat_frag(L3 + OFF_S, LDQ, 32 * cb, 16 * ks, lane), o2, 0, 0, 0);
    float o[16];
#pragma unroll
    for (int r = 0; r < 16; ++r) { const int i = 32 * rb + crow(r, hh); const float xi = KIND ? 1.f : exp2f((float)(i + 1) * log2g); o[r] = o1[r] + xi * o2[r];
        const float sq = half_sum(o[r] * o[r]); if (l31 == 0) ssq[i * 4 + cb] = sq; }
    __syncthreads();
    float* Os = (float*)L + w * (32 * 33);
#pragma unroll
    for (int r = 0; r < 16; ++r) Os[crow(r, hh) * 33 + l31] = o[r];
    LDS_WAIT();
#pragma unroll
    for (int k2 = 0; k2 < 2; ++k2) { const int pp = lane + 64 * k2, rw = pp >> 2, ch = pp & 3, i = 32 * rb + rw;
        const f32x4 s4 = *(const f32x4*)(ssq + i * 4);
        const float rn = rsqrtf(((s4.x + s4.y) + (s4.z + s4.w)) * (1.f / 128.f) + EPS);
        float gv[8]; unpack8(gc[k2], gv); float y[8];
#pragma unroll
        for (int e = 0; e < 8; ++e) y[e] = siluf_(gv[e]) * Os[rw * 33 + 8 * ch + e] * rn;
        *(u32x4*)(P_YCAT + (size_t)(b * SEQ + c * 64 + i) * DM + OCOL + h * 128 + 32 * cb + 8 * ch) = repack8(y); }
    __syncthreads();
}
template <int KIND> __device__ __forceinline__ void r2_run(CArgs& A, const Frame& F0, int first, int n, int stride) {
    R2Regs<KIND> R; u32x4 gc[2];
    { Frame G2 = F0; int t_ = F0.tid; asm volatile("" : "+v"(t_)); G2.tid = t_; G2.lane = t_ & 63; r2_load<KIND>(A, G2, R, (first & 1023) >> 5, first & 31); }
#pragma unroll 1
    for (int i = 0; i < n; ++i) {
        Frame G2 = F0; { int t_ = F0.tid; asm volatile("" : "+v"(t_)); G2.tid = t_; G2.lane = t_ & 63; }
        const int r = (first + i * stride) & 1023;
        r2_stage<KIND>(G2, R, gc);
        if (i + 1 < n) { const int rn = (first + (i + 1) * stride) & 1023; r2_load<KIND>(A, G2, R, rn >> 5, rn & 31); }
        r2_compute<KIND>(A, G2, r >> 5, r & 31, gc);
    }
}
__device__ __forceinline__ void p_lin_r2(CArgs& A, const Frame& F) {
    r2_run<0>(A, F, F.bid, 4, F.G);
    r2_run<1>(A, F, 1024 + F.bid, 4, F.G);
}
}
#define XB_TMO      128
#define XB_XCNT(j)  (256  + 64 * (j))
#define XB_XSUB(j)  (1280 + 64 * (j))
#define XB_XGEN(j)  (2304 + 64 * (j))
#define XB_TOP      3328
#define XB_TOPGEN   3392
#define XCD_BAR_WORDS 3456
#define XB_SPIN_CAP (1u << 18)
__device__ __forceinline__ unsigned xb_ld(unsigned* p)              { return __hip_atomic_load(p, __ATOMIC_RELAXED, __HIP_MEMORY_SCOPE_AGENT); }
__device__ __forceinline__ unsigned xb_add(unsigned* p, unsigned v) { return __hip_atomic_fetch_add(p, v, __ATOMIC_RELAXED, __HIP_MEMORY_SCOPE_AGENT); }
__device__ __forceinline__ unsigned xb_xcc_id() { return (unsigned)__builtin_amdgcn_s_getreg((3 << 11) | 20) & 0xFu; }
#define XB_SPIN(cond, bar) do { unsigned _sp = 0; while (cond) { __builtin_amdgcn_s_sleep(1); \
    if ((++_sp & 255u) == 0u) { if (xb_ld(&(bar)[XB_TMO])) break; if (_sp > XB_SPIN_CAP) { atomicAdd(&(bar)[XB_TMO], 1u); break; } } } } while (0)
struct XcdBarrier { unsigned* bar; unsigned x; volatile LAS unsigned* st; };
__device__ __forceinline__ XcdBarrier xcd_barrier_post(unsigned* bar, volatile LAS unsigned* st, int tid) {
    XcdBarrier b; b.bar = bar; b.x = xb_xcc_id(); b.st = st;
    if (tid == 0) (void)xb_add(&bar[XB_XCNT(b.x)], 1u);
    return b;
}
__device__ __forceinline__ void xcd_barrier_complete(unsigned* bar, unsigned x, unsigned& nloc, unsigned& nx) {
    const unsigned G = gridDim.x * gridDim.y * gridDim.z;
    unsigned sum, cnt, mine, sp = 0u;
    for (;;) {
        sum = 0u; cnt = 0u; mine = 0u;
#pragma unroll
        for (unsigned j = 0; j < 16; ++j) { const unsigned c = xb_ld(&bar[XB_XCNT(j)]); sum += c; cnt += (c > 0u) ? 1u : 0u; mine = (j == x) ? c : mine; }
        if (sum == G) break;
        __builtin_amdgcn_s_sleep(1);
        if ((++sp & 255u) == 0u) { if (xb_ld(&bar[XB_TMO])) break; if (sp > XB_SPIN_CAP) { atomicAdd(&bar[XB_TMO], 1u); break; } }
    }
    nloc = mine > 0u ? mine : 1u; nx = cnt > 0u ? cnt : 1u;
}
__device__ __forceinline__ void xcd_barrier(const XcdBarrier& b, int tid) {
    asm volatile("s_waitcnt vmcnt(0)" ::: "memory");
    __syncthreads();
    if (tid == 0) {
        unsigned* bar = b.bar;
        __builtin_amdgcn_s_waitcnt(0);
        unsigned nloc = b.st[0], nx = b.st[1];
        if (nloc == 0u) { xcd_barrier_complete(bar, b.x, nloc, nx); b.st[0] = nloc; b.st[1] = nx; }
        const unsigned old = xb_add(&bar[XB_XSUB(b.x)], 1u);
        const unsigned gen = old / nloc;
        if (old + 1u == (gen + 1u) * nloc) {
            __builtin_amdgcn_fence(__ATOMIC_RELEASE, "agent");
            asm volatile("s_waitcnt vmcnt(0)" ::: "memory");
            const unsigned og = xb_add(&bar[XB_TOP], 1u);
            const unsigned tg = og / nx;
            if (og + 1u == (tg + 1u) * nx) xb_add(&bar[XB_TOPGEN], 1u);
            else XB_SPIN(xb_ld(&bar[XB_TOPGEN]) == tg, bar);
            __builtin_amdgcn_fence(__ATOMIC_ACQUIRE, "agent");
            xb_add(&bar[XB_XGEN(b.x)], 1u);
            asm volatile("s_waitcnt vmcnt(0)" ::: "memory");
        } else {
            XB_SPIN(xb_ld(&bar[XB_XGEN(b.x)]) == gen, bar);
            __builtin_amdgcn_fence(__ATOMIC_ACQUIRE, "agent");
            asm volatile("s_waitcnt vmcnt(0)" ::: "memory");
        }
    }
    __syncthreads();
}
#define REFRESH() do { int t_ = F.wave * 64 + lane_id(); asm volatile("" : "+v"(t_)); F.tid = t_; F.lane = t_ & 63; asm volatile("" : "+s"(ap)); int b_ = blockIdx.x; asm volatile("" : "+s"(b_)); F.bid = b_; } while (0)
#define A (*ap)
#define GSYNC() do { REFRESH(); xcd_barrier(xb, F.tid); } while (0)
template <int l> __device__ __forceinline__ void layer_fwd(CArgs*& ap, Frame& F, const XcdBarrier& xb, unsigned char* lds, LAS unsigned char* lds3, LAS pg8::MoeTables* tb) {
    if (l == 0) {
        { REFRESH(); pg8::DenseOrder S; S.init(P_HB, P_WINE, NTOK, 2048, 1024, F.G, F.bid); pg8::EpiZ0 E{P_Z};
          pg8::gemm_phase<pg8::EpiZ0, pg8::DenseOrder, true>(lds3, F.wave, 1024, S, E); }
        GSYNC();
        REFRESH(); fox_fast(A, F);
        __syncthreads();
        REFRESH(); s5_fast(A, F, F.bid);
        GSYNC();
        { REFRESH(); pg8::DenseOrder S; S.init(P_G5, P_WGLU, NTOK, 512, 512, F.G, F.bid); pg8::EpiGlu E{P_G5, A.in[I_GLUB], P_YCAT};
          pg8::gemm_phase<pg8::EpiGlu, pg8::DenseOrder, true>(lds3, F.wave, 512, S, E); }
        GSYNC();
    } else {
        REFRESH(); lin::gla_prefix(A, F, F.bid);
        { REFRESH(); pg8::DenseOrder S; S.init(P_HB, P_WINO, NTOK, 3584, 1024, F.G, F.bid); pg8::EpiZ1 E{P_Z, P_ROPE};
          pg8::gemm_phase<pg8::EpiZ1, pg8::DenseOrder, true>(lds3, F.wave, 1024, S, E); }
        GSYNC();
        REFRESH(); lin::p_lin_r1(A, F);
        GSYNC();
        REFRESH(); lin::p_lin_r2(A, F);
        GSYNC();
    }
    { REFRESH(); pg8::DenseOrder S; S.init(P_YCAT, l == 0 ? P_WOUTE : P_WOUTO, NTOK, 1024, 1024, F.G, F.bid); pg8::EpiBf16Plain E{(bf16_t*)P_MBUF, DM};
      pg8::gemm_phase<pg8::EpiBf16Plain, pg8::DenseOrder, true>(lds3, F.wave, 1024, S, E); }
    GSYNC();
    REFRESH(); p_postmix(A, F, l);
    GSYNC();
    REFRESH(); const int MT = moe_tables(A, F, l, tb);
    {
        const int mX = (MT >> 5) << 5, kk = MT - mX, rr = (64 - ((2 * kk) & 63)) & 63;
        const int mY = mX >= rr ? rr + (((mX - rr) >> 6) << 6) : 0;
        if (mX > 0) {
            { REFRESH(); pg8::MoeOrder<true> S; S.Ap = (const char*)P_HB8; S.Bt = (const char*)(P_W1 + (size_t)l * 32 * 2048 * 1024); S.estride = (size_t)2048 * 1024; S.K = 512; S.NP = 8; S.nwg = mX * 8; S.G = F.G; S.c = F.bid; S.mt0 = 0;
              S.list_tk = P_LTK + (size_t)l * 32 * LISTCAP; S.tb = tb;
              pg8::EpiSwiglu E{P_ACT, A.in[I_BGU] + (size_t)l * 32 * 2048};
              pg8::gemm_phase<pg8::EpiSwiglu, pg8::MoeOrder<true>, true, true>(lds3, F.wave, 512, S, E); }
            GSYNC();
        }
        if (8 * (MT - mX) + 4 * mY > 0) {
            { REFRESH(); pg8::MoeMixOrder S; S.ws = (const char*)A.ws; S.l = l;
              S.a0 = mX; S.nA = 8 * (MT - mX); S.b0 = 0; S.nB = 4 * mY; S.nwg = S.nA + S.nB; S.G = F.G; S.c = F.bid; S.tb = tb;
              pg8::EpiMoeMix E{ap, l};
              pg8::gemm_phase<pg8::EpiMoeMix, pg8::MoeMixOrder, true, true>(lds3, F.wave, 512, S, E); }
            GSYNC();
        }
        if (MT > mY) {
            { REFRESH(); pg8::MoeOrder<false> S; S.Ap = (const char*)P_ACT; S.Bt = (const char*)(P_W2 + (size_t)l * 32 * 1024 * 1024); S.estride = (size_t)1024 * 1024; S.K = 512; S.NP = 4; S.nwg = (MT - mY) * 4; S.G = F.G; S.c = F.bid; S.mt0 = mY;
              S.list_tk = P_LTK + (size_t)l * 32 * LISTCAP; S.tb = tb;
              pg8::EpiDown E{P_Y, A.in[I_BDN] + (size_t)l * 32 * 1024, P_LTK + (size_t)l * 32 * LISTCAP, P_LG + (size_t)l * 32 * LISTCAP};
              pg8::gemm_phase<pg8::EpiDown, pg8::MoeOrder<false>, true, true>(lds3, F.wave, 512, S, E); }
            GSYNC();
        }
    }
    REFRESH(); p_combine(A, F, l);
}

__global__ void __launch_bounds__(512, 2) mk_fwd(Args A_) {
    extern __shared__ __attribute__((aligned(16))) unsigned char lds[];
    cg::grid_group grid = cg::this_grid();
    CArgs* ap = (CArgs*)__builtin_amdgcn_kernarg_segment_ptr();
    Frame F;
    F.lds = lds; F.wave = __builtin_amdgcn_readfirstlane((int)threadIdx.x >> 6); F.tid = 0; F.lane = 0; F.bid = blockIdx.x; F.G = gridDim.x;
    LAS unsigned char* lds3 = (LAS unsigned char*)lds;
    LAS pg8::MoeTables* tb = (LAS pg8::MoeTables*)(lds3 + 133632);
    { volatile LAS unsigned* st = (volatile LAS unsigned*)(lds3 + (LDS_BYTES - 64)); REFRESH(); if (F.tid < 2) st[F.tid] = 0u; __syncthreads(); }
    XcdBarrier xb = xcd_barrier_post((unsigned*)(A.ws + WS_CTL) + 10240, (volatile LAS unsigned*)(lds3 + (LDS_BYTES - 64)), F.tid);
    REFRESH(); p0_prep(A, F);
    if (A.pad != 0) grid.sync();
    GSYNC();
    REFRESH(); p1_hprep0(A, F);
    GSYNC();
    layer_fwd<0>(ap, F, xb, lds, lds3, tb);
    GSYNC();
    layer_fwd<1>(ap, F, xb, lds, lds3, tb);
}
#undef A

extern "C" void kernel_launch(void* const* d_in, const int* in_sizes, int n_in, void* d_out, int out_size, void* d_ws, size_t ws_size, hipStream_t stream) {
    static int grid = 0;
    if (grid == 0) {
        if (n_in != 31 || out_size != NTOK * DM || ws_size < WS_END) { fprintf(stderr, "kernel_launch: unexpected problem (n_in %d out %d ws %zu)\n", n_in, out_size, ws_size); grid = -1; return; }
        int dev = 0, cus = 0, per_cu = 0;
        if (hipGetDevice(&dev) != hipSuccess || hipDeviceGetAttribute(&cus, hipDeviceAttributeMultiprocessorCount, dev) != hipSuccess) { grid = -1; return; }
        if (hipFuncSetAttribute((const void*)mk_fwd, hipFuncAttributeMaxDynamicSharedMemorySize, LDS_BYTES) != hipSuccess) { fprintf(stderr, "kernel_launch: hipFuncSetAttribute failed\n"); grid = -1; return; }
        if (hipOccupancyMaxActiveBlocksPerMultiprocessor(&per_cu, (const void*)mk_fwd, 512, LDS_BYTES) != hipSuccess || per_cu < 1) { fprintf(stderr, "kernel_launch: occupancy query says %d blocks per CU\n", per_cu); (void)hipGetLastError(); }
        grid = cus;
        if (grid != 256) fprintf(stderr, "kernel_launch: %d CUs; this kernel is built for a 256-CU grid\n", grid);
    }
    if (grid < 0) return;
    if (hipMemsetAsync((char*)d_ws + WS_CTL, 0, CTL_ZERO_BYTES, stream) != hipSuccess) { fprintf(stderr, "kernel_launch: memset failed\n"); return; }
    Args a{};
    for (int i = 0; i < 31; ++i) a.in[i] = (const float*)d_in[i];
    a.out = (float*)d_out; a.ws = (unsigned char*)d_ws;
    void* kargs[] = {&a};
    const hipError_t e = hipLaunchCooperativeKernel((const void*)mk_fwd, dim3(grid), dim3(512), kargs, LDS_BYTES, stream);
    if (e != hipSuccess) fprintf(stderr, "kernel_launch: cooperative launch failed: %s (grid %d)\n", hipGetErrorString(e), grid);
}
```

```cpp
#include <hip/hip_runtime.h>
#include <hip/hip_cooperative_groups.h>
#include <cstdio>
#include <cstdint>
namespace cg = cooperative_groups;

#define LAS __attribute__((address_space(3)))
typedef unsigned short bf16_t;
typedef short bf16x8 __attribute__((ext_vector_type(8)));
typedef float f32x4 __attribute__((ext_vector_type(4)));
typedef float f32x2 __attribute__((ext_vector_type(2)));
typedef unsigned u32x4 __attribute__((ext_vector_type(4)));
typedef unsigned u32x2 __attribute__((ext_vector_type(2)));
typedef int i32x4 __attribute__((ext_vector_type(4)));
typedef int i32x8 __attribute__((ext_vector_type(8)));

constexpr int NTOK = 16384, DM = 1024, SEQ = 2048, NB = 8;
constexpr int NEXP = 32, LISTCAP = 16384;
constexpr float EPS = 1e-6f;
constexpr float LOG2E = 1.4426950408889634f;
constexpr float C2 = 0.125f * LOG2E;
constexpr int ZP0 = 2048, ZP1 = 3584;

constexpr size_t MiB = 1u << 20;
constexpr size_t WS_CTL = 0, CTL_ZERO_BYTES = 65536;
constexpr size_t WS_MOD = 1 * MiB;
constexpr size_t WS_WSIDE = 1 * MiB + 512 * 1024;
constexpr size_t WS_S5A = 2 * MiB;
constexpr size_t WS_S5BB = 2 * MiB + 65536;
constexpr size_t WS_S5CK = 2 * MiB + 512 * 1024;
constexpr size_t WS_ROPE = 3 * MiB;
constexpr size_t WS_LTK = 4 * MiB;
constexpr size_t WS_LG = 8 * MiB;
constexpr size_t WS_WINE = 16 * MiB, WS_WGLU = 20 * MiB, WS_WOUTE = 21 * MiB, WS_WINO = 23 * MiB, WS_WOUTO = 30 * MiB;
constexpr size_t WS_W1 = 32 * MiB;
constexpr size_t WS_HB8 = 160 * MiB;
constexpr size_t WS_W2 = 288 * MiB;
constexpr size_t WS_HB = 416 * MiB;
constexpr size_t WS_Z = 448 * MiB;
constexpr size_t WS_LSIG = 560 * MiB;
constexpr size_t WS_LOGA = 562 * MiB;
constexpr size_t WS_G5 = 578 * MiB;
constexpr size_t WS_YCAT = 594 * MiB;
constexpr size_t WS_MBUF = 626 * MiB;
constexpr size_t WS_ACT = 690 * MiB;
constexpr size_t WS_Y = 834 * MiB;
constexpr size_t WS_RST = 962 * MiB;
constexpr size_t WS_GST = 994 * MiB;
constexpr size_t WS_XB = 1010 * MiB;
constexpr size_t WS_END = 1042 * MiB;
constexpr int CW_CNT = 1024;

constexpr int RING_BYTES = 131072;
constexpr int MISC_OFF = RING_BYTES;
constexpr int LDS_BYTES = 147456;

__device__ __forceinline__ unsigned f2bf(float f) { unsigned u = __builtin_bit_cast(unsigned, f); return (u + 0x7fffu + ((u >> 16) & 1u)) >> 16; }
typedef __bf16 bf16x2_hw __attribute__((ext_vector_type(2)));
__device__ __forceinline__ unsigned pk2(float lo, float hi) { const f32x2 v = {lo, hi}; return __builtin_bit_cast(unsigned, __builtin_convertvector(v, bf16x2_hw)); }
__device__ __forceinline__ float bflo(unsigned w) { return __builtin_bit_cast(float, w << 16); }
__device__ __forceinline__ float bfhi(unsigned w) { return __builtin_bit_cast(float, w & 0xffff0000u); }
__device__ __forceinline__ float bf1(bf16_t b) { return __builtin_bit_cast(float, ((unsigned)b) << 16); }
__device__ __forceinline__ int lane_id() { int l; asm volatile("v_mbcnt_lo_u32_b32 %0, -1, 0\n\tv_mbcnt_hi_u32_b32 %0, -1, %0" : "=v"(l)); return l; }
template <int CTRL> __device__ __forceinline__ float dppf(float v) { return __builtin_bit_cast(float, __builtin_amdgcn_update_dpp(0, __builtin_bit_cast(int, v), CTRL, 0xf, 0xf, true)); }
__device__ __forceinline__ float row16_sum(float v) {
    v += dppf<0xB1>(v); v += dppf<0x4E>(v); v += dppf<0x141>(v); v += dppf<0x140>(v); return v;
}
__device__ __forceinline__ float rdlane(float v, int l) { return __builtin_bit_cast(float, __builtin_amdgcn_readlane(__builtin_bit_cast(int, v), l)); }
__device__ __forceinline__ float wave_sum(float v) {
    v = row16_sum(v); return (rdlane(v, 0) + rdlane(v, 16)) + (rdlane(v, 32) + rdlane(v, 48));
}
__device__ __forceinline__ float half_sum(float v) {
    v = row16_sum(v); const float a = rdlane(v, 0) + rdlane(v, 16), b = rdlane(v, 32) + rdlane(v, 48); return (lane_id() < 32) ? a : b;
}
__device__ __forceinline__ float sigmoidf_(float x) { return __builtin_amdgcn_rcpf(1.f + __expf(-x)); }
__device__ __forceinline__ float log_sigmoidf_(float x) { return fminf(x, 0.f) - log1pf(__expf(-fabsf(x))); }
__device__ __forceinline__ float siluf_(float x) { return x * sigmoidf_(x); }
__device__ __forceinline__ float gelu_tanh(float x) { const float u2 = 1.5957691216057308f * (x + 0.044715f * x * x * x); return x * sigmoidf_(u2); }
constexpr float SC_H = 16.f, SC_W1 = 512.f, SC_A = 8.f, SC_W2 = 512.f;
__device__ __forceinline__ unsigned pk8(float a, float b, float c, float d) {
    a = __builtin_amdgcn_fmed3f(a, -448.f, 448.f); b = __builtin_amdgcn_fmed3f(b, -448.f, 448.f); c = __builtin_amdgcn_fmed3f(c, -448.f, 448.f); d = __builtin_amdgcn_fmed3f(d, -448.f, 448.f);
    int r = __builtin_amdgcn_cvt_pk_fp8_f32(a, b, 0, false); r = __builtin_amdgcn_cvt_pk_fp8_f32(c, d, r, true); return (unsigned)r;
}
#define LDS_WAIT() asm volatile("s_waitcnt lgkmcnt(0)" ::: "memory")

struct Args { const float* in[31]; float* out; unsigned char* ws; long long pad; };
typedef const __attribute__((address_space(4))) Args CArgs;
enum { I_X = 0, I_C, I_ADAW, I_ADAB, I_NPM, I_NQM, I_NPF, I_NQF, I_EVWIN, I_FOXB, I_LAMRE, I_LAMIM, I_LOGDT, I_BRE, I_BIM, I_CRE, I_CIM, I_S5D, I_GLUW, I_GLUB, I_EVWOUT,
       I_ODWIN, I_GLAWUP, I_GLABG, I_ODWOUT, I_RW, I_RB, I_WGU, I_BGU, I_WDN, I_BDN };

namespace pg8 {
constexpr int BM = 256, BK = 64, HALF = 128, HTB = HALF * BK * 2, STAGE_BYTES = 8 * HTB, NXCD = 8, WGM = 8;
__device__ __forceinline__ int lds_byte(int r, int c) { const int st = (r >> 4) * 2 + (c >> 5), rr = r & 15, cc = c & 31, ob = rr * 64 + cc * 2; return st * 1024 + (ob ^ (((ob >> 9) & 1) << 5)); }
__device__ __forceinline__ void stage_rc(int b, int& R, int& C) { const int st = b / 1024, sb = b % 1024, swz = sb ^ (((sb >> 9) & 1) << 5); R = (st >> 1) * 16 + swz / 64; C = (st & 1) * 32 + (swz % 64) / 2; }
__device__ __forceinline__ int perm32(int rho) { const int n = rho >> 4, i = rho & 15; return 8 * (i >> 2) + 4 * n + (i & 3); }
__device__ __forceinline__ unsigned cvt_pk_bf16(float lo, float hi) { unsigned r; asm volatile("v_cvt_pk_bf16_f32 %0, %1, %2" : "=v"(r) : "v"(lo), "v"(hi)); return r; }

struct Unit { int pm, pn, e, mb, nrows, kind; };
__device__ __forceinline__ int xcd_remap(int L, int nwg) { const int q = nwg / NXCD, r = nwg % NXCD, xcd = L % NXCD, off = L / NXCD; return (xcd < r ? xcd * (q + 1) : r * (q + 1) + (xcd - r) * q) + off; }

struct DenseOrder {
    const char* Ap; const char* Bt; int K, nM, nN, nwg, G, c;
    __device__ __forceinline__ void init(const void* A_, const void* Bt_, int M, int N, int K_, int G_, int c_) { Ap = (const char*)A_; Bt = (const char*)Bt_; K = K_; nM = M / BM; nN = N / BM; nwg = nM * nN; G = G_; c = c_; }
    __device__ __forceinline__ bool next(int i, Unit& u) const {
        const long L = (long)i * G + c; if (L >= nwg) return false;
        const int wgid = xcd_remap((int)L, nwg);
        const int nig = WGM * nN, gid = wgid / nig, fm = gid * WGM, gsz = (nM - fm) < WGM ? (nM - fm) : WGM;
        u.pm = fm + ((wgid % nig) % gsz); u.pn = (wgid % nig) / gsz; u.e = 0; u.mb = u.pm; u.nrows = BM; u.kind = 0; return true;
    }
    __device__ __forceinline__ const char* a_base(const Unit& u) const { return Ap + (size_t)u.pm * ((size_t)BM * K * 2); }
    __device__ __forceinline__ const char* b_base(const Unit& u) const { return Bt + (size_t)u.pn * ((size_t)BM * K * 2); }
    __device__ __forceinline__ void a_raw(const Unit&, const int (&)[2], int (&raw)[2][2]) const { raw[0][0] = raw[0][1] = raw[1][0] = raw[1][1] = 0; }
    __device__ __forceinline__ void a_offs(const Unit&, const int (&R)[2], const int (&C)[2], const int (&)[2][2], unsigned (&v)[2][2]) const {
#pragma unroll
        for (int h = 0; h < 2; ++h)
#pragma unroll
            for (int i = 0; i < 2; ++i) v[h][i] = (unsigned)((h * HALF + R[i]) * K + C[i]) * 2u;
    }
};
struct MoeTables { int cnt[NEXP]; int mtstart[NEXP + 1]; unsigned char tile_e[320]; };
template <bool GATHER> struct MoeOrder {
    const char* Ap; const char* Bt; size_t estride; int K, NP, nwg, G, c, mt0; const int* list_tk; const LAS MoeTables* tb;
    __device__ __forceinline__ bool next(int i, Unit& u) const {
        const long L = (long)i * G + c; if (L >= nwg) return false;
        const int w = xcd_remap((int)L, nwg);
        const int mq = w / NP, mt = mt0 + mq; u.pn = w - mq * NP; u.pm = mt; u.e = tb->tile_e[mt]; u.mb = mt - tb->mtstart[u.e];
        const int left = tb->cnt[u.e] - u.mb * BM; u.nrows = left < BM ? left : BM; u.kind = GATHER ? 0 : 1; return true;
    }
    __device__ __forceinline__ const char* a_base(const Unit& u) const { return GATHER ? Ap : Ap + (size_t)u.pm * ((size_t)BM * K * 2); }
    __device__ __forceinline__ const char* b_base(const Unit& u) const { return Bt + (size_t)u.e * estride + (size_t)u.pn * ((size_t)BM * K * 2); }
    __device__ __forceinline__ void a_raw(const Unit& u, const int (&R)[2], int (&raw)[2][2]) const {
#pragma unroll
        for (int h = 0; h < 2; ++h)
#pragma unroll
            for (int i = 0; i < 2; ++i) { if (GATHER) { const int r = h * HALF + R[i], rc = r < u.nrows ? r : 0; raw[h][i] = list_tk[u.e * LISTCAP + u.mb * BM + rc]; } else raw[h][i] = 0; }
    }
    __device__ __forceinline__ void a_offs(const Unit&, const int (&R)[2], const int (&C)[2], const int (&raw)[2][2], unsigned (&v)[2][2]) const {
#pragma unroll
        for (int h = 0; h < 2; ++h)
#pragma unroll
            for (int i = 0; i < 2; ++i) {
                if (GATHER) v[h][i] = (unsigned)((raw[h][i] >> 2) * K + C[i]) * 2u;
                else v[h][i] = (unsigned)((h * HALF + R[i]) * K + C[i]) * 2u;
            }
    }
};

struct MoeMixOrder {
    const char* ws; int l, a0, nA, b0, nB, nwg, G, c; const LAS MoeTables* tb;
    static constexpr int K = 512;
    __device__ __forceinline__ bool next(int i, Unit& u) const {
        const long L = (long)i * G + c; if (L >= nwg) return false;
        int w = xcd_remap((int)L, nwg), mt;
        if (w < nA) { u.kind = 0; mt = a0 + (w >> 3); u.pn = w & 7; } else { w -= nA; u.kind = 1; mt = b0 + (w >> 2); u.pn = w & 3; }
        u.pm = mt; u.e = tb->tile_e[mt]; u.mb = mt - tb->mtstart[u.e];
        const int left = tb->cnt[u.e] - u.mb * BM; u.nrows = left < BM ? left : BM; return true;
    }
    __device__ __forceinline__ const char* a_base(const Unit& u) const { return u.kind ? ws + WS_ACT : ws + WS_HB8; }
    __device__ __forceinline__ const char* b_base(const Unit& u) const { return u.kind ? ws + WS_W2 + (size_t)(l * 32 + u.e) * ((size_t)1024 * K * 2) + (size_t)u.pn * ((size_t)BM * K * 2) : ws + WS_W1 + (size_t)(l * 32 + u.e) * ((size_t)2048 * K * 2) + (size_t)u.pn * ((size_t)BM * K * 2); }
    __device__ __forceinline__ void a_raw(const Unit& u, const int (&R)[2], int (&raw)[2][2]) const {
#pragma unroll
        for (int h = 0; h < 2; ++h)
#pragma unroll
            for (int i = 0; i < 2; ++i) { const int r = h * HALF + R[i], rc = r < u.nrows ? r : 0; raw[h][i] = u.kind ? 4 * (u.pm * BM + r) : ((const int*)(ws + WS_LTK))[(l * 32 + u.e) * LISTCAP + u.mb * BM + rc]; }
    }
    __device__ __forceinline__ void a_offs(const Unit& u, const int (&R)[2], const int (&C)[2], const int (&raw)[2][2], unsigned (&v)[2][2]) const {
#pragma unroll
        for (int h = 0; h < 2; ++h)
#pragma unroll
            for (int i = 0; i < 2; ++i) v[h][i] = (unsigned)((raw[h][i] >> 2) * K + C[i]) * 2u;
    }
};

template <class Epi, class Sched, bool ALIGN_EPI, bool FP8 = false>
__device__ __forceinline__ void gemm_phase(LAS unsigned char* lds, const int wave_, const int K, const Sched& S, const Epi& E) {
    int tid_ = wave_ * 64 + lane_id(); asm volatile("" : "+v"(tid_));
    const int tid = tid_, wid = wave_, lane = tid & 63, wr = wid >> 2, wc = wid & 3, fr = lane & 15, fq = lane >> 4;
    int nt_ = K / BK; if constexpr (FP8) asm volatile("" : "+s"(nt_));
    const int nt = nt_;
    int Rr[2], Cc[2]; unsigned voffB[2];
#pragma unroll
    for (int i = 0; i < 2; ++i) { stage_rc(tid * 16 + i * 8192, Rr[i], Cc[i]); const int Rb = Epi::PERM ? ((Rr[i] & ~31) + perm32(Rr[i] & 31)) : Rr[i]; voffB[i] = (unsigned)(Rb * K + Cc[i]) * 2u; }
    const size_t kstep = (size_t)(BK * 2);
    const size_t hstep = (size_t)HALF * K * 2;
    const unsigned ldsw = (unsigned)wid * 1024u;
    const int aoff = lds_byte(wr * 64 + fr, fq * 8), boff = lds_byte(wc * 32 + fr, fq * 8);
#define PG8_SA(b, h) (((b) * 2 + (h)) * HTB)
#define PG8_SB(b, h) ((4 + (b) * 2 + (h)) * HTB)
#define PG8_STAGE(bufoff, gbase, voff) do { _Pragma("unroll") for (int _i = 0; _i < 2; ++_i) { unsigned vo_ = (voff)[_i]; if constexpr (FP8) asm volatile("" : "+v"(vo_));   \
        __builtin_amdgcn_global_load_lds((const unsigned*)((const char*)(gbase) + vo_), (LAS unsigned*)(lds + (bufoff) + ldsw + _i * 8192), 16, 0, 0); } } while (0)
#define PG8_LDA(dst, b, h) do { _Pragma("unroll") for (int m = 0; m < 4; ++m) { \
        if constexpr (FP8) { const i32x4 lo_ = *(const LAS i32x4*)(lds + PG8_SA(b, h) + aoff + m * 2048), hi_ = *(const LAS i32x4*)(lds + PG8_SA(b, h) + aoff + m * 2048 + 1024); dst##8[m] = __builtin_shufflevector(lo_, hi_, 0, 1, 2, 3, 4, 5, 6, 7); } \
        else { _Pragma("unroll") for (int k = 0; k < 2; ++k) dst[m][k] = *(const LAS bf16x8*)(lds + PG8_SA(b, h) + aoff + m * 2048 + k * 1024); } } } while (0)
#define PG8_LDB(dst, b, h) do { _Pragma("unroll") for (int n = 0; n < 2; ++n) { \
        if constexpr (FP8) { const i32x4 lo_ = *(const LAS i32x4*)(lds + PG8_SB(b, h) + boff + n * 2048), hi_ = *(const LAS i32x4*)(lds + PG8_SB(b, h) + boff + n * 2048 + 1024); dst##8[n] = __builtin_shufflevector(lo_, hi_, 0, 1, 2, 3, 4, 5, 6, 7); } \
        else { _Pragma("unroll") for (int k = 0; k < 2; ++k) dst[n][k] = *(const LAS bf16x8*)(lds + PG8_SB(b, h) + boff + n * 2048 + k * 1024); } } } while (0)
#define PG8_MMA(ai, bj, At, Bt) do { __builtin_amdgcn_s_setprio(1); _Pragma("unroll") for (int m = 0; m < 4; ++m) _Pragma("unroll") for (int n = 0; n < 2; ++n) { \
        if constexpr (FP8) asm volatile("v_mfma_f32_16x16x128_f8f6f4 %0, %1, %2, %0" : "+v"(acc[ai][bj][m][n]) : "v"(Bt##8[n]), "v"(At##8[m]));   \
        else { _Pragma("unroll") for (int k = 0; k < 2; ++k) acc[ai][bj][m][n] = __builtin_amdgcn_mfma_f32_16x16x32_bf16(Bt[n][k], At[m][k], acc[ai][bj][m][n], 0, 0, 0); } } \
        __builtin_amdgcn_s_setprio(0); } while (0)
#define PG8_WAIT_V(n) asm volatile("s_waitcnt vmcnt(" #n ")" ::: "memory")
#define PG8_WAIT_L(n) asm volatile("s_waitcnt lgkmcnt(" #n ")" ::: "memory")
#define PG8_BAR __builtin_amdgcn_s_barrier()
#define PG8_SCHED __builtin_amdgcn_sched_barrier(0)
    Unit cur, nxt; int ui = 0;
    if (!S.next(0, cur)) return;
    f32x4 acc[2][2][4][2];
#pragma unroll
    for (int a = 0; a < 2; ++a)
#pragma unroll
        for (int b = 0; b < 2; ++b)
#pragma unroll
            for (int m = 0; m < 4; ++m)
#pragma unroll
                for (int n = 0; n < 2; ++n) acc[a][b][m][n] = (f32x4){0.f, 0.f, 0.f, 0.f};
    bf16x8 At[4][2], B0[2][2], B1[2][2]; i32x8 At8[4], B08[2], B18[2];
    const char* cA = S.a_base(cur); const char* cB = S.b_base(cur);
    unsigned cv[2][2], nv[2][2]; int raw[2][2];
    S.a_raw(cur, Rr, raw); S.a_offs(cur, Rr, Cc, raw, cv);
    PG8_STAGE(PG8_SB(0, 0), cB, voffB); PG8_STAGE(PG8_SB(0, 1), cB + hstep, voffB); PG8_STAGE(PG8_SA(0, 0), cA, cv[0]); PG8_STAGE(PG8_SA(0, 1), cA, cv[1]);
    if (wr == 1) PG8_BAR;
    PG8_WAIT_V(2); PG8_BAR;
    PG8_STAGE(PG8_SB(1, 0), cB + kstep, voffB); PG8_STAGE(PG8_SA(1, 0), cA + kstep, cv[0]); PG8_STAGE(PG8_SB(1, 1), cB + hstep + kstep, voffB);
    PG8_WAIT_V(6); PG8_BAR;
    for (;;) {
        const bool has_next = S.next(ui + 1, nxt);
        const char* nA = has_next ? S.a_base(nxt) : cA; const char* nB = has_next ? S.b_base(nxt) : cB;
        if (has_next) S.a_raw(nxt, Rr, raw);
#pragma unroll
        for (int h = 0; h < 2; ++h)
#pragma unroll
            for (int i = 0; i < 2; ++i) nv[h][i] = cv[h][i];
        for (int t = 0; t < nt; t += 2) {
            const bool last = (t == nt - 2);
            if (last && has_next) S.a_offs(nxt, Rr, Cc, raw, nv);
            const char* a1 = cA + (size_t)(t + 1) * kstep;
            const char* a2 = last ? nA : cA + (size_t)(t + 2) * kstep; const char* b2 = last ? nB : cB + (size_t)(t + 2) * kstep;
            const char* a3 = a2 + kstep; const char* b3 = b2 + kstep;
            unsigned v2[2][2];
#pragma unroll
            for (int h = 0; h < 2; ++h)
#pragma unroll
                for (int i = 0; i < 2; ++i) v2[h][i] = last ? nv[h][i] : cv[h][i];
            PG8_LDB(B0, 0, 0); PG8_LDB(B1, 0, 1); PG8_SCHED; PG8_LDA(At, 0, 0); PG8_STAGE(PG8_SA(1, 1), a1, cv[1]);
            PG8_WAIT_V(8); PG8_WAIT_L(0); PG8_BAR; PG8_MMA(0, 0, At, B0); PG8_MMA(0, 1, At, B1); PG8_BAR; PG8_SCHED;
            PG8_LDA(At, 0, 1); PG8_STAGE(PG8_SB(0, 0), b2, voffB); PG8_STAGE(PG8_SB(0, 1), b2 + hstep, voffB); PG8_STAGE(PG8_SA(0, 0), a2, v2[0]);
            PG8_WAIT_V(8); PG8_WAIT_L(0); PG8_BAR; PG8_MMA(1, 0, At, B0); PG8_MMA(1, 1, At, B1); PG8_BAR; PG8_SCHED;
            PG8_LDB(B0, 1, 0); PG8_LDB(B1, 1, 1); PG8_SCHED; PG8_LDA(At, 1, 0); PG8_STAGE(PG8_SA(0, 1), a2, v2[1]);
            PG8_WAIT_V(8); PG8_WAIT_L(0); PG8_BAR; PG8_MMA(0, 0, At, B0); PG8_MMA(0, 1, At, B1); PG8_BAR; PG8_SCHED;
            PG8_LDA(At, 1, 1); PG8_STAGE(PG8_SB(1, 0), b3, voffB); PG8_STAGE(PG8_SB(1, 1), b3 + hstep, voffB); PG8_STAGE(PG8_SA(1, 0), a3, v2[0]);
            PG8_WAIT_V(8); PG8_WAIT_L(0); PG8_BAR; PG8_MMA(1, 0, At, B0); PG8_MMA(1, 1, At, B1); PG8_BAR; PG8_SCHED;
        }
        if constexpr (ALIGN_EPI) { if (wr == 0) PG8_BAR; }
        if constexpr (FP8) asm volatile("s_nop 15\n\ts_nop 15" ::: "memory");
        E(acc, cur, wr, wc, fr, fq);
        if (!has_next) break;
#pragma unroll
        for (int a = 0; a < 2; ++a)
#pragma unroll
            for (int b = 0; b < 2; ++b)
#pragma unroll
                for (int m = 0; m < 4; ++m)
#pragma unroll
                    for (int n = 0; n < 2; ++n) acc[a][b][m][n] = (f32x4){0.f, 0.f, 0.f, 0.f};
        cur = nxt; cA = nA; cB = nB; ++ui;
#pragma unroll
        for (int h = 0; h < 2; ++h)
#pragma unroll
            for (int i = 0; i < 2; ++i) cv[h][i] = nv[h][i];
        if constexpr (ALIGN_EPI) { if (wr == 1) PG8_BAR; }
    }
    PG8_WAIT_V(0);
    if constexpr (!ALIGN_EPI) { if (wr == 0) PG8_BAR; }
    PG8_BAR;
#undef PG8_SA
#undef PG8_SB
#undef PG8_STAGE
#undef PG8_LDA
#undef PG8_LDB
#undef PG8_MMA
#undef PG8_WAIT_V
#undef PG8_WAIT_L
#undef PG8_BAR
#undef PG8_SCHED
}
}
namespace pg8 {
typedef f32x4 Acc[2][2][4][2];
struct EpiZ0 {
    static constexpr bool PERM = true;
    bf16_t* Z;
    __device__ __forceinline__ void operator()(const Acc& acc, const Unit& u, int wr, int wc, int fr, int fq) const {
        const float sc = (u.pn == 2 || u.pn == 3) ? C2 : 1.f;
        const int row0 = u.pm * BM + wr * 64 + fr, col0 = u.pn * BM + wc * 32 + 8 * fq;
#pragma unroll
        for (int ai = 0; ai < 2; ++ai)
#pragma unroll
            for (int m = 0; m < 4; ++m) { bf16_t* rowp = Z + (size_t)(row0 + ai * HALF + m * 16) * ZP0 + col0;
#pragma unroll
                for (int bj = 0; bj < 2; ++bj) { const f32x4 v0 = acc[ai][bj][m][0] * sc, v1 = acc[ai][bj][m][1] * sc;
                    u32x4 w; w.x = cvt_pk_bf16(v0[0], v0[1]); w.y = cvt_pk_bf16(v0[2], v0[3]); w.z = cvt_pk_bf16(v1[0], v1[1]); w.w = cvt_pk_bf16(v1[2], v1[3]);
                    *(u32x4*)(rowp + bj * HALF) = w; } }
    }
};
struct EpiZ1 {
    static constexpr bool PERM = true;
    bf16_t* Z; const float* rope;
    __device__ __forceinline__ void operator()(const Acc& acc, const Unit& u, int wr, int wc, int fr, int fq) const {
        const int row0 = u.pm * BM + wr * 64 + fr;
        if (u.pn < 4) {
            const float sc = (u.pn >= 2) ? 0.08838834764831845f : 1.f;
            const int hl = wc >> 1, jj0 = 32 * (wc & 1) + 8 * fq;
#pragma unroll
            for (int ai = 0; ai < 2; ++ai)
#pragma unroll
                for (int m = 0; m < 4; ++m) { const int row = row0 + ai * HALF + m * 16, pos = row & (SEQ - 1);
                    const f32x4 c0 = *(const f32x4*)(rope + pos * 64 + jj0), c1 = *(const f32x4*)(rope + pos * 64 + jj0 + 4);
                    const f32x4 s0 = *(const f32x4*)(rope + SEQ * 64 + pos * 64 + jj0), s1 = *(const f32x4*)(rope + SEQ * 64 + pos * 64 + jj0 + 4);
                    const f32x4 x10 = acc[ai][0][m][0] * sc, x11 = acc[ai][0][m][1] * sc, x20 = acc[ai][1][m][0] * sc, x21 = acc[ai][1][m][1] * sc;
                    const f32x4 a0 = x10 * c0 - x20 * s0, a1 = x11 * c1 - x21 * s1, b0 = x10 * s0 + x20 * c0, b1 = x11 * s1 + x21 * c1;
                    bf16_t* rowp = Z + (size_t)row * ZP1 + u.pn * BM + 128 * hl + jj0;
                    u32x4 w; w.x = cvt_pk_bf16(a0[0], a0[1]); w.y = cvt_pk_bf16(a0[2], a0[3]); w.z = cvt_pk_bf16(a1[0], a1[1]); w.w = cvt_pk_bf16(a1[2], a1[3]);
                    *(u32x4*)(rowp) = w;
                    w.x = cvt_pk_bf16(b0[0], b0[1]); w.y = cvt_pk_bf16(b0[2], b0[3]); w.z = cvt_pk_bf16(b1[0], b1[1]); w.w = cvt_pk_bf16(b1[2], b1[3]);
                    *(u32x4*)(rowp + 64) = w; }
        } else {
            const float sc = (u.pn == 8) ? 0.125f : 1.f;
            const int col0 = u.pn * BM + wc * 32 + 8 * fq;
#pragma unroll
            for (int ai = 0; ai < 2; ++ai)
#pragma unroll
                for (int m = 0; m < 4; ++m) { bf16_t* rowp = Z + (size_t)(row0 + ai * HALF + m * 16) * ZP1 + col0;
#pragma unroll
                    for (int bj = 0; bj < 2; ++bj) { const f32x4 v0 = acc[ai][bj][m][0] * sc, v1 = acc[ai][bj][m][1] * sc;
                        u32x4 w; w.x = cvt_pk_bf16(v0[0], v0[1]); w.y = cvt_pk_bf16(v0[2], v0[3]); w.z = cvt_pk_bf16(v1[0], v1[1]); w.w = cvt_pk_bf16(v1[2], v1[3]);
                        *(u32x4*)(rowp + bj * HALF) = w; } }
        }
    }
};
struct EpiGlu {
    static constexpr bool PERM = true;
    const bf16_t* G5; const float* bias; bf16_t* Y;
    __device__ __forceinline__ void operator()(const Acc& acc, const Unit& u, int wr, int wc, int fr, int fq) const {
        const int row0 = u.pm * BM + wr * 64 + fr, col0 = u.pn * BM + wc * 32 + 8 * fq;
        f32x4 bv[2][2];
#pragma unroll
        for (int bj = 0; bj < 2; ++bj)
#pragma unroll
            for (int n = 0; n < 2; ++n) bv[bj][n] = *(const f32x4*)(bias + col0 + bj * HALF + 4 * n);
#pragma unroll
        for (int ai = 0; ai < 2; ++ai)
#pragma unroll
            for (int m = 0; m < 4; ++m) { const size_t row = (size_t)(row0 + ai * HALF + m * 16);
#pragma unroll
                for (int bj = 0; bj < 2; ++bj) { const u32x4 gw = *(const u32x4*)(G5 + row * 512 + col0 + bj * HALF);
                    const f32x4 v0 = acc[ai][bj][m][0] + bv[bj][0], v1 = acc[ai][bj][m][1] + bv[bj][1];
                    float o[8]; o[0] = bflo(gw.x) * sigmoidf_(v0[0]); o[1] = bfhi(gw.x) * sigmoidf_(v0[1]); o[2] = bflo(gw.y) * sigmoidf_(v0[2]); o[3] = bfhi(gw.y) * sigmoidf_(v0[3]);
                    o[4] = bflo(gw.z) * sigmoidf_(v1[0]); o[5] = bfhi(gw.z) * sigmoidf_(v1[1]); o[6] = bflo(gw.w) * sigmoidf_(v1[2]); o[7] = bfhi(gw.w) * sigmoidf_(v1[3]);
                    u32x4 w; w.x = cvt_pk_bf16(o[0], o[1]); w.y = cvt_pk_bf16(o[2], o[3]); w.z = cvt_pk_bf16(o[4], o[5]); w.w = cvt_pk_bf16(o[6], o[7]);
                    *(u32x4*)(Y + row * DM + col0 + bj * HALF) = w; } }
    }
};
struct EpiF32 {
    static constexpr bool PERM = false;
    float* Cp; int ldc;
    __device__ __forceinline__ void operator()(const Acc& acc, const Unit& u, int wr, int wc, int fr, int fq) const {
        const int row0 = u.pm * BM + wr * 64 + fr, col0 = u.pn * BM + wc * 32 + 4 * fq;
#pragma unroll
        for (int ai = 0; ai < 2; ++ai)
#pragma unroll
            for (int m = 0; m < 4; ++m) { float* rowp = Cp + (size_t)(row0 + ai * HALF + m * 16) * ldc + col0;
#pragma unroll
                for (int bj = 0; bj < 2; ++bj)
#pragma unroll
                    for (int n = 0; n < 2; ++n) *(f32x4*)(rowp + bj * HALF + n * 16) = acc[ai][bj][m][n]; }
    }
};
struct EpiBf16Plain {
    static constexpr bool PERM = true;
    bf16_t* Cp; int ldc;
    __device__ __forceinline__ void operator()(const Acc& acc, const Unit& u, int wr, int wc, int fr, int fq) const {
        const int row0 = u.pm * BM + wr * 64 + fr, col0 = u.pn * BM + wc * 32 + 8 * fq;
#pragma unroll
        for (int ai = 0; ai < 2; ++ai)
#pragma unroll
            for (int m = 0; m < 4; ++m) { bf16_t* rowp = Cp + (size_t)(row0 + ai * HALF + m * 16) * ldc + col0;
#pragma unroll
                for (int bj = 0; bj < 2; ++bj) { const f32x4 v0 = acc[ai][bj][m][0], v1 = acc[ai][bj][m][1];
                    u32x4 w; w.x = cvt_pk_bf16(v0[0], v0[1]); w.y = cvt_pk_bf16(v0[2], v0[3]); w.z = cvt_pk_bf16(v1[0], v1[1]); w.w = cvt_pk_bf16(v1[2], v1[3]);
                    *(u32x4*)(rowp + bj * HALF) = w; } }
    }
};
struct EpiSwiglu {
    static constexpr bool PERM = true;
    unsigned char* ACT; const float* bgu;
    __device__ __forceinline__ void operator()(const Acc& acc, const Unit& u, int wr, int wc, int fr, int fq) const {
        constexpr float INV = 1.f / (SC_H * SC_W1), INVL = INV * SC_A, CE = -1.702f * LOG2E;
        const int row0 = u.pm * BM + wr * 64 + fr, j0 = wc * 32 + 8 * fq, colg = u.pn * 128 + j0;
        const float* bp = bgu + (size_t)u.e * 2048 + colg;
        f32x2 bg[4], bl[4];
#pragma unroll
        for (int p = 0; p < 4; ++p) { bg[p] = *(const f32x2*)(bp + 2 * p); bl[p] = (*(const f32x2*)(bp + 1024 + 2 * p) + 1.f) * SC_A; }
#pragma unroll
        for (int ai = 0; ai < 2; ++ai)
#pragma unroll
            for (int m = 0; m < 4; ++m) {
                f32x2 o[4];
#pragma unroll
                for (int p = 0; p < 4; ++p) {
                    const f32x4 ag = acc[ai][0][m][p >> 1], al = acc[ai][1][m][p >> 1];
                    const f32x2 g = (p & 1 ? (f32x2){ag[2], ag[3]} : (f32x2){ag[0], ag[1]}) * INV + bg[p], l = (p & 1 ? (f32x2){al[2], al[3]} : (f32x2){al[0], al[1]}) * INVL + bl[p];
                    const f32x2 a = {fminf(g.x, 7.f), fminf(g.y, 7.f)}, b = {__builtin_amdgcn_fmed3f(l.x, -6.f * SC_A, 8.f * SC_A), __builtin_amdgcn_fmed3f(l.y, -6.f * SC_A, 8.f * SC_A)};
                    const f32x2 t = a * CE; const f32x2 d = (f32x2){__builtin_amdgcn_exp2f(t.x), __builtin_amdgcn_exp2f(t.y)} + 1.f;
                    const f32x2 sg = {__builtin_amdgcn_rcpf(d.x), __builtin_amdgcn_rcpf(d.y)};
                    o[p] = (a * sg) * b; }
                u32x2 w; int r0 = __builtin_amdgcn_cvt_pk_fp8_f32(o[0].x, o[0].y, 0, false); r0 = __builtin_amdgcn_cvt_pk_fp8_f32(o[1].x, o[1].y, r0, true);
                int r1 = __builtin_amdgcn_cvt_pk_fp8_f32(o[2].x, o[2].y, 0, false); r1 = __builtin_amdgcn_cvt_pk_fp8_f32(o[3].x, o[3].y, r1, true);
                w.x = (unsigned)r0; w.y = (unsigned)r1;
                *(u32x2*)(ACT + (size_t)(row0 + ai * HALF + m * 16) * DM + colg) = w; }
    }
};
struct EpiDown {
    static constexpr bool PERM = true;
    bf16_t* Y; const float* bdn; const int* list_tk; const float* list_g;
    __device__ __forceinline__ void operator()(const Acc& acc, const Unit& u, int wr, int wc, int fr, int fq) const {
        constexpr float INV = 1.f / (SC_A * SC_W2);
        const int r0 = wr * 64 + fr, col0 = u.pn * BM + wc * 32 + 8 * fq;
        const float* bp = bdn + (size_t)u.e * DM + col0;
        f32x4 bv[2][2];
#pragma unroll
        for (int bj = 0; bj < 2; ++bj)
#pragma unroll
            for (int n = 0; n < 2; ++n) bv[bj][n] = *(const f32x4*)(bp + bj * HALF + 4 * n);
        const size_t lbase = (size_t)u.e * LISTCAP + (size_t)u.mb * BM;
        int tkv[2][4]; float gtv[2][4];
#pragma unroll
        for (int ai = 0; ai < 2; ++ai)
#pragma unroll
            for (int m = 0; m < 4; ++m) { const int r = r0 + ai * HALF + m * 16, rc = r < u.nrows ? r : 0; tkv[ai][m] = list_tk[lbase + rc]; gtv[ai][m] = list_g[lbase + rc]; }
#pragma unroll
        for (int ai = 0; ai < 2; ++ai)
#pragma unroll
            for (int m = 0; m < 4; ++m) { const int r = r0 + ai * HALF + m * 16;
                if (r < u.nrows) { const float gt = gtv[ai][m];
                    bf16_t* rowp = Y + (size_t)tkv[ai][m] * DM + col0;
#pragma unroll
                    for (int bj = 0; bj < 2; ++bj) { const f32x4 v0 = (acc[ai][bj][m][0] * INV + bv[bj][0]) * gt, v1 = (acc[ai][bj][m][1] * INV + bv[bj][1]) * gt;
                        u32x4 w; w.x = cvt_pk_bf16(v0[0], v0[1]); w.y = cvt_pk_bf16(v0[2], v0[3]); w.z = cvt_pk_bf16(v1[0], v1[1]); w.w = cvt_pk_bf16(v1[2], v1[3]);
                        *(u32x4*)(rowp + bj * HALF) = w; } } }
    }
};
struct EpiMoeMix {
    static constexpr bool PERM = true;
    CArgs* ap; int l;
    __device__ __forceinline__ void operator()(const Acc& acc, const Unit& u, int wr, int wc, int fr, int fq) const {
        CArgs& A = *ap; unsigned char* ws = A.ws;
        if (u.kind == 0) { const EpiSwiglu sw{ws + WS_ACT, A.in[I_BGU] + (size_t)l * 32 * 2048}; sw(acc, u, wr, wc, fr, fq); }
        else { const EpiDown dn{(bf16_t*)(ws + WS_Y), A.in[I_BDN] + (size_t)l * 32 * 1024, (const int*)(ws + WS_LTK) + (size_t)l * 32 * LISTCAP, (const float*)(ws + WS_LG) + (size_t)l * 32 * LISTCAP}; dn(acc, u, wr, wc, fr, fq); }
    }
};
}
struct Frame { unsigned char* lds; int tid, lane, wave, bid, G; };
#define P_MOD   ((float*)(A.ws + WS_MOD))
#define P_S5A   ((float*)(A.ws + WS_S5A))
#define P_S5BB  ((float*)(A.ws + WS_S5BB))
#define P_ROPE  ((float*)(A.ws + WS_ROPE))
#define P_WSIDE ((float*)(A.ws + WS_WSIDE))
#define P_S5CK  ((bf16_t*)(A.ws + WS_S5CK))
#define P_LTK   ((int*)(A.ws + WS_LTK))
#define P_LG    ((float*)(A.ws + WS_LG))
#define P_CNT   ((unsigned*)(A.ws + WS_CTL) + CW_CNT)
#define P_WINE  ((bf16_t*)(A.ws + WS_WINE))
#define P_WGLU  ((bf16_t*)(A.ws + WS_WGLU))
#define P_WOUTE ((bf16_t*)(A.ws + WS_WOUTE))
#define P_WINO  ((bf16_t*)(A.ws + WS_WINO))
#define P_WOUTO ((bf16_t*)(A.ws + WS_WOUTO))
#define P_W1    (A.ws + WS_W1)
#define P_W2    (A.ws + WS_W2)
#define P_HB8   (A.ws + WS_HB8)
#define P_HB    ((bf16_t*)(A.ws + WS_HB))
#define P_Z     ((bf16_t*)(A.ws + WS_Z))
#define P_G5    ((bf16_t*)(A.ws + WS_G5))
#define P_YCAT  ((bf16_t*)(A.ws + WS_YCAT))
#define P_ACT   (A.ws + WS_ACT)
#define P_Y     ((bf16_t*)(A.ws + WS_Y))
#define P_LSIG  ((float*)(A.ws + WS_LSIG))
#define P_LOGA  ((float*)(A.ws + WS_LOGA))
#define P_MBUF  ((float*)(A.ws + WS_MBUF))
#define P_XB    ((bf16_t*)(A.ws + WS_XB))
#define P_RST   ((bf16_t*)(A.ws + WS_RST))
#define P_GST   ((bf16_t*)(A.ws + WS_GST))

__device__ __forceinline__ void tr_tile(const float* __restrict__ src, int pitch, int k0, int c0, bf16_t* dst, int Kd, int r0, float* scr, int lane) {
#pragma unroll
    for (int i = 0; i < 16; ++i) {
        const int kk = 4 * i + (lane >> 4), cc = 4 * (lane & 15);
        const f32x4 v = __builtin_nontemporal_load((const f32x4*)(src + (size_t)(k0 + kk) * pitch + c0 + cc));
        float* s = scr + kk * 65 + cc; s[0] = v.x; s[1] = v.y; s[2] = v.z; s[3] = v.w;
    }
    LDS_WAIT();
    const int c = lane & 7;
#pragma unroll
    for (int j = 0; j < 8; ++j) { const int n = (lane >> 3) + 8 * j; const float* s = scr + (8 * c) * 65 + n;
        u32x4 o; o.x = pk2(s[0], s[65]); o.y = pk2(s[130], s[195]); o.z = pk2(s[260], s[325]); o.w = pk2(s[390], s[455]);
        __builtin_nontemporal_store(o, (u32x4*)(dst + (size_t)(r0 + n) * Kd + k0 + 8 * c)); }
    LDS_WAIT();
}
__device__ __forceinline__ void tr_tile8(const float* __restrict__ src, int pitch, int k0, int c0, unsigned char* dst, int Kd, int r0, float* scr, int lane, float scale) {
#pragma unroll
    for (int i = 0; i < 16; ++i) {
        const int kk = 4 * i + (lane >> 4), cc = 4 * (lane & 15);
        const f32x4 v = __builtin_nontemporal_load((const f32x4*)(src + (size_t)(k0 + kk) * pitch + c0 + cc));
        float* s = scr + kk * 65 + cc; s[0] = v.x * scale; s[1] = v.y * scale; s[2] = v.z * scale; s[3] = v.w * scale;
    }
    LDS_WAIT();
    const int c = lane & 3;
#pragma unroll
    for (int j = 0; j < 4; ++j) { const int n = (lane >> 2) + 16 * j; const float* s = scr + (16 * c) * 65 + n;
        u32x4 o; o.x = pk8(s[0], s[65], s[130], s[195]); o.y = pk8(s[260], s[325], s[390], s[455]); o.z = pk8(s[520], s[585], s[650], s[715]); o.w = pk8(s[780], s[845], s[910], s[975]);
        __builtin_nontemporal_store(o, (u32x4*)(dst + (size_t)(r0 + n) * Kd + k0 + 16 * c)); }
    LDS_WAIT();
}
__device__ __forceinline__ void p0_prep(CArgs& A, const Frame& F) {
    float* scr = (float*)(F.lds) + F.wave * (64 * 65);
    const int gw = F.bid * 8 + F.wave, NGW = F.G * 8;
    constexpr int T0 = 16 * 32, T1 = 8 * 8, T2 = 16 * 16, T3 = 16 * 56, T4 = 16 * 16, T5 = 64 * 16 * 32, T6 = 64 * 16 * 16;
    constexpr int NTILES = T0 + T1 + T2 + T3 + T4 + T5 + T6;
    for (int it = gw; it < NTILES; it += NGW) {
        int r = it;
        if (r < T0) { const int kb = r / 32, nb = r % 32; tr_tile(A.in[I_EVWIN], 2056, kb * 64, nb * 64, P_WINE, 1024, nb * 64, scr, F.lane); continue; } r -= T0;
        if (r < T1) { const int kb = r / 8, nb = r % 8; tr_tile(A.in[I_GLUW], 512, kb * 64, nb * 64, P_WGLU, 512, nb * 64, scr, F.lane); continue; } r -= T1;
        if (r < T2) { const int kb = r / 16, nb = r % 16; tr_tile(A.in[I_EVWOUT], 1024, kb * 64, nb * 64, P_WOUTE, 1024, nb * 64, scr, F.lane); continue; } r -= T2;
        if (r < T3) { const int kb = r / 56, nb = r % 56; const int n0 = nb * 64; int c0;
            if (n0 < 1024) { const int pn = n0 >> 8, rem = n0 & 255, bj = rem >> 7, hl = (rem & 127) >> 6; c0 = 256 * pn + 128 * hl + 64 * bj; }
            else if (n0 < 3072) c0 = n0; else c0 = n0 + 16;
            tr_tile(A.in[I_ODWIN], 3600, kb * 64, c0, P_WINO, 1024, n0, scr, F.lane); continue; } r -= T3;
        if (r < T4) { const int kb = r / 16, nb = r % 16; tr_tile(A.in[I_ODWOUT], 1024, kb * 64, nb * 64, P_WOUTO, 1024, nb * 64, scr, F.lane); continue; } r -= T4;
        if (r < T5) { const int mat = r / 512, q = r % 512, kb = q / 32, nb = q % 32; const int n0 = nb * 64, pn = n0 >> 8, half = (n0 & 255) >> 7, j0 = n0 & 127;
            tr_tile8(A.in[I_WGU] + (size_t)mat * 1024 * 2048, 2048, kb * 64, half * 1024 + 128 * pn + j0, P_W1 + (size_t)mat * 2048 * 1024, 1024, n0, scr, F.lane, SC_W1); continue; } r -= T5;
        { const int mat = r / 256, q = r % 256, kb = q / 16, nb = q % 16;
            tr_tile8(A.in[I_WDN] + (size_t)mat * 1024 * 1024, 1024, kb * 64, nb * 64, P_W2 + (size_t)mat * 1024 * 1024, 1024, nb * 64, scr, F.lane, SC_W2); }
    }
    __syncthreads();
    {
        const int gt = F.bid * 512 + F.tid;
        if (gt < 32 * 64) {
            const int g = gt >> 6;
            const float lr = A.in[I_LAMRE][gt], li = A.in[I_LAMIM][gt], dt = expf(A.in[I_LOGDT][g]);
            const float mag = expf(lr * dt); float sn, cs; sincosf(li * dt, &sn, &cs);
            const float are = mag * cs, aim = mag * sn, den = lr * lr + li * li, nre = are - 1.f, nim = aim;
            const float zre = (nre * lr + nim * li) / den, zim = (nim * lr - nre * li) / den;
            P_S5A[gt * 2] = are; P_S5A[gt * 2 + 1] = aim;
            for (int c = 0; c < 16; ++c) { const float br = A.in[I_BRE][gt * 16 + c], bi = A.in[I_BIM][gt * 16 + c];
                P_S5BB[gt * 32 + c] = zre * br - zim * bi; P_S5BB[gt * 32 + 16 + c] = zre * bi + zim * br; }
        }
        for (int i = gt; i < 32 * 16 * 128; i += F.G * 512) { const int k = i & 127, gc = i >> 7, pp = k >> 1; const float v = (k & 1) ? -A.in[I_CIM][gc * 64 + pp] : A.in[I_CRE][gc * 64 + pp]; P_S5CK[i] = (bf16_t)f2bf(v); }
        for (int i = gt; i < 24 * 1024; i += F.G * 512) { const int o = i >> 10, k = i & 1023; P_WSIDE[i] = o < 8 ? A.in[I_EVWIN][(size_t)k * 2056 + 2048 + o] : A.in[I_ODWIN][(size_t)k * 3600 + 3072 + (o - 8)]; }
        for (int i = gt; i < SEQ * 64; i += F.G * 512) { const int pos = i >> 6, j = i & 63;
            const float inv = exp2f(-(float)j * (13.287712379549449f / 64.f)); const float ang = (float)pos * inv; float sn, cs; sincosf(ang, &sn, &cs);
            P_ROPE[i] = cs; P_ROPE[SEQ * 64 + i] = sn; }
    }
    if (F.bid < 192) {
        float* sc = (float*)F.lds;
        float* red = sc + 8192;
        for (int i = F.tid; i < 8192; i += 512) sc[i] = siluf_(A.in[I_C][i]);
        __syncthreads();
        const int l = F.bid / 96, n = (F.bid % 96) * 64 + F.lane;
        const float* w = A.in[I_ADAW] + (size_t)l * 1024 * 6144 + n;
        float a[8];
#pragma unroll
        for (int b = 0; b < 8; ++b) a[b] = 0.f;
        for (int k = 128 * F.wave; k < 128 * F.wave + 128; ++k) { const float wv = w[(size_t)k * 6144];
#pragma unroll
            for (int b = 0; b < 8; ++b) a[b] += sc[b * 1024 + k] * wv; }
#pragma unroll
        for (int b = 0; b < 8; ++b) red[(F.wave * 8 + b) * 64 + F.lane] = a[b];
        __syncthreads();
        { const int b = F.tid >> 6, ln = F.tid & 63; float s = 0.f;
#pragma unroll
          for (int w8 = 0; w8 < 8; ++w8) s += red[(w8 * 8 + b) * 64 + ln];
          const int nn = (F.bid % 96) * 64 + ln; P_MOD[(size_t)(l * 8 + b) * 6144 + nn] = s + A.in[I_ADAB][l * 6144 + nn]; }
    }
}

struct Row { f32x4 v[4]; };
__device__ __forceinline__ void row_load(Row& r, const float* p, int lane) {
#pragma unroll
    for (int j = 0; j < 4; ++j) r.v[j] = __builtin_nontemporal_load((const f32x4*)(p + 4 * lane + 256 * j));
}
__device__ __forceinline__ void row_load_bf16(Row& r, const bf16_t* p, int lane) {
#pragma unroll
    for (int j = 0; j < 4; ++j) { const u32x2 w = __builtin_nontemporal_load((const u32x2*)(p + 4 * lane + 256 * j)); r.v[j] = (f32x4){bflo(w.x), bfhi(w.x), bflo(w.y), bfhi(w.y)}; }
}
__device__ __forceinline__ void row_store(const Row& r, float* p, int lane) {
#pragma unroll
    for (int j = 0; j < 4; ++j) __builtin_nontemporal_store(r.v[j], (f32x4*)(p + 4 * lane + 256 * j));
}
__device__ __forceinline__ void row_store_bf16(const Row& r, bf16_t* p, int lane) {
#pragma unroll
    for (int j = 0; j < 4; ++j) { u32x2 w; w.x = pk2(r.v[j].x, r.v[j].y); w.y = pk2(r.v[j].z, r.v[j].w); *(u32x2*)(p + 4 * lane + 256 * j) = w; }
}
__device__ __forceinline__ void row_store_bf16_nt(const Row& r, bf16_t* p, int lane) {
#pragma unroll
    for (int j = 0; j < 4; ++j) { u32x2 w; w.x = pk2(r.v[j].x, r.v[j].y); w.y = pk2(r.v[j].z, r.v[j].w); __builtin_nontemporal_store(w, (u32x2*)(p + 4 * lane + 256 * j)); }
}
__device__ __forceinline__ float row_rstd(const Row& r) {
    float s = 0.f;
#pragma unroll
    for (int j = 0; j < 4; ++j) s += (r.v[j].x * r.v[j].x + r.v[j].y * r.v[j].y) + (r.v[j].z * r.v[j].z + r.v[j].w * r.v[j].w);
    return rsqrtf(wave_sum(s) * (1.f / DM) + EPS);
}
__device__ __forceinline__ void row_modnorm(Row& h, const Row& x, const float* gain, const float* sh, const float* sc, int lane) {
    const float r = row_rstd(x);
#pragma unroll
    for (int j = 0; j < 4; ++j) { const int k = 4 * lane + 256 * j; const f32x4 g = *(const f32x4*)(gain + k), a = *(const f32x4*)(sc + k), b = *(const f32x4*)(sh + k);
        h.v[j] = x.v[j] * r * g * (a + 1.f) + b; }
}
__device__ __forceinline__ void hprep_row(CArgs& A, const Frame& F, const Row& x, int l, int row, const float* wl) {
    const int b = row >> 11, lane = F.lane; const float* mod = P_MOD + (size_t)(l * 8 + b) * 6144;
    Row h; row_modnorm(h, x, A.in[I_NPM] + l * DM, mod, mod + 1024, lane);
    row_store_bf16(h, P_HB + (size_t)row * DM, lane);
    if (l == 0) {
        float mine = 0.f;
#pragma unroll
        for (int i = 0; i < 8; ++i) { float p = 0.f;
#pragma unroll
            for (int j = 0; j < 4; ++j) { const f32x4 w = *(const f32x4*)(wl + i * 1024 + 4 * lane + 256 * j); p += (h.v[j].x * w.x + h.v[j].y * w.y) + (h.v[j].z * w.z + h.v[j].w * w.w); }
            const float s = wave_sum(p); if (lane == i) mine = s; if ((i & 3) == 3) asm volatile("" ::: "memory"); }
        if (lane < 8) P_LSIG[(size_t)row * 8 + lane] = log_sigmoidf_(mine + A.in[I_FOXB][lane]);
    } else {
        float p[16];
#pragma unroll
        for (int i = 0; i < 16; ++i) { float q = 0.f;
#pragma unroll
            for (int j = 0; j < 4; ++j) { const f32x4 w = *(const f32x4*)(wl + i * 1024 + 4 * lane + 256 * j); q += (h.v[j].x * w.x + h.v[j].y * w.y) + (h.v[j].z * w.z + h.v[j].w * w.w); }
            p[i] = wave_sum(q); if ((i & 1) == 1) asm volatile("" ::: "memory"); }
        const float* wup = wl + 16 * 1024;
#pragma unroll
        for (int q = 0; q < 4; ++q) { const int jcol = lane + 64 * q; float s = wup[16 * 256 + jcol];
#pragma unroll
            for (int i = 0; i < 16; ++i) s += p[i] * wup[i * 256 + jcol];
            P_LOGA[(size_t)row * 256 + jcol] = log_sigmoidf_(s) * (1.f / 16.f); }
    }
}
__device__ __forceinline__ void stage_side(CArgs& A, const Frame& F, int l, float* wl) {
    __syncthreads();
    if (l == 0) { for (int i = F.tid; i < 8 * 256; i += 512) *(f32x4*)(wl + 4 * i) = *(const f32x4*)(P_WSIDE + 4 * i); }
    else { for (int i = F.tid; i < 16 * 256; i += 512) *(f32x4*)(wl + 4 * i) = *(const f32x4*)(P_WSIDE + 8192 + 4 * i);
           for (int i = F.tid; i < 16 * 64; i += 512) *(f32x4*)(wl + 16384 + 4 * i) = *(const f32x4*)(A.in[I_GLAWUP] + 4 * i);
           if (F.tid < 64) *(f32x4*)(wl + 16384 + 4096 + 4 * F.tid) = *(const f32x4*)(A.in[I_GLABG] + 4 * F.tid); }
    __syncthreads();
}
__device__ __forceinline__ void p1_hprep0(CArgs& A, const Frame& F) {
    float* wl = (float*)F.lds; stage_side(A, F, 0, wl);
    const int gw = F.bid * 8 + F.wave, NGW = F.G * 8;
    Row xn; if (gw < NTOK) row_load(xn, A.in[I_X] + (size_t)gw * DM, F.lane);
#pragma unroll 1
    for (int row = gw; row < NTOK; row += NGW) { Row x;
#pragma unroll
        for (int j = 0; j < 4; ++j) x.v[j] = xn.v[j];
        if (row + NGW < NTOK) row_load(xn, A.in[I_X] + (size_t)(row + NGW) * DM, F.lane); hprep_row(A, F, x, 0, row, wl); }
}

__device__ __forceinline__ void p_postmix(CArgs& A, const Frame& F, int l) {
    float* h2s = (float*)F.lds;
    float* red = h2s + 16 * 1028;
    float* lg = red + 8 * 16 * 32;
    float* tv = lg + 16 * 32;
    int* lcnt = (int*)(tv + 64);
    int* ent = lcnt + 64;
    if (F.tid < 32) lcnt[F.tid] = 0;
    int nent = 0;
    const float* rw = A.in[I_RW] + (size_t)l * 1024 * 32;
    u32x2 pm[2][4]; f32x4 pxf[2][4]; u32x2 pxb[2][4];
#define PM_LOAD(tile_) do { const int r0_ = (tile_) * 16 + 2 * F.wave; _Pragma("unroll") for (int rr = 0; rr < 2; ++rr) _Pragma("unroll") for (int j = 0; j < 4; ++j) { \
        pm[rr][j] = __builtin_nontemporal_load((const u32x2*)((const bf16_t*)P_MBUF + (size_t)(r0_ + rr) * DM + 4 * F.lane + 256 * j)); \
        if (l == 0) pxf[rr][j] = __builtin_nontemporal_load((const f32x4*)(A.in[I_X] + (size_t)(r0_ + rr) * DM + 4 * F.lane + 256 * j)); \
        else pxb[rr][j] = __builtin_nontemporal_load((const u32x2*)(P_XB + (size_t)(r0_ + rr) * DM + 4 * F.lane + 256 * j)); } } while (0)
    if (F.bid < NTOK / 16) PM_LOAD(F.bid);
#pragma unroll 1
    for (int tile = F.bid; tile < NTOK / 16; tile += F.G) {
        const int row0 = tile * 16 + 2 * F.wave;
        Row m0, x0, m1, x1;
#pragma unroll
        for (int j = 0; j < 4; ++j) { m0.v[j] = (f32x4){bflo(pm[0][j].x), bfhi(pm[0][j].x), bflo(pm[0][j].y), bfhi(pm[0][j].y)}; m1.v[j] = (f32x4){bflo(pm[1][j].x), bfhi(pm[1][j].x), bflo(pm[1][j].y), bfhi(pm[1][j].y)};
            if (l == 0) { x0.v[j] = pxf[0][j]; x1.v[j] = pxf[1][j]; }
            else { x0.v[j] = (f32x4){bflo(pxb[0][j].x), bfhi(pxb[0][j].x), bflo(pxb[0][j].y), bfhi(pxb[0][j].y)}; x1.v[j] = (f32x4){bflo(pxb[1][j].x), bfhi(pxb[1][j].x), bflo(pxb[1][j].y), bfhi(pxb[1][j].y)}; } }
        if (tile + F.G < NTOK / 16) PM_LOAD(tile + F.G);
#pragma unroll
        for (int rr = 0; rr < 2; ++rr) {
            const int lr = 2 * F.wave + rr, row = row0 + rr, b = row >> 11; const float* mod = P_MOD + (size_t)(l * 8 + b) * 6144;
            const Row& m = rr ? m1 : m0; Row x = rr ? x1 : x0;
            const float r1 = row_rstd(m);
#pragma unroll
            for (int j = 0; j < 4; ++j) { const int k = 4 * F.lane + 256 * j; const f32x4 gp = *(const f32x4*)(A.in[I_NQM] + l * DM + k), g1 = *(const f32x4*)(mod + 2048 + k);
                x.v[j] = x.v[j] + g1 * (m.v[j] * r1 * gp); }
            row_store_bf16_nt(x, P_XB + (size_t)row * DM, F.lane);
            Row h; row_modnorm(h, x, A.in[I_NPF] + l * DM, mod + 3072, mod + 4096, F.lane);
#pragma unroll
            for (int j = 0; j < 4; ++j) *(unsigned*)(P_HB8 + (size_t)row * DM + 4 * F.lane + 256 * j) = pk8(SC_H * h.v[j].x, SC_H * h.v[j].y, SC_H * h.v[j].z, SC_H * h.v[j].w);
#pragma unroll
            for (int j = 0; j < 4; ++j) *(f32x4*)(h2s + lr * 1028 + 4 * F.lane + 256 * j) = h.v[j];
        }
        __syncthreads();
        {
            f32x4 d0 = {0.f, 0.f, 0.f, 0.f}, d1 = {0.f, 0.f, 0.f, 0.f};
            const int r16 = F.lane & 15, kq = F.lane >> 4;
#pragma unroll 8
            for (int ks = 0; ks < 32; ++ks) { const int k = 128 * F.wave + 4 * ks + kq;
                const float a = h2s[r16 * 1028 + k]; const float b0 = rw[k * 32 + r16], b1 = rw[k * 32 + 16 + r16];
                d0 = __builtin_amdgcn_mfma_f32_16x16x4f32(a, b0, d0, 0, 0, 0); d1 = __builtin_amdgcn_mfma_f32_16x16x4f32(a, b1, d1, 0, 0, 0); }
#pragma unroll
            for (int q = 0; q < 4; ++q) { red[(F.wave * 16 + 4 * kq + q) * 32 + r16] = d0[q]; red[(F.wave * 16 + 4 * kq + q) * 32 + 16 + r16] = d1[q]; }
        }
        __syncthreads();
        const int r = F.tid >> 5, e = F.tid & 31;
        { float s = A.in[I_RB][l * 32 + e];
#pragma unroll
          for (int w8 = 0; w8 < 8; ++w8) s += red[(w8 * 16 + r) * 32 + e];
          lg[r * 32 + e] = s; }
        __syncthreads();
        const float v = lg[r * 32 + e]; int rank = 0;
#pragma unroll 8
        for (int q = 0; q < 32; ++q) { const float u = lg[r * 32 + q]; rank += (u > v || (u == v && q < e)) ? 1 : 0; }
        if (rank < 4) tv[r * 4 + rank] = v;
        __syncthreads();
        if (rank < 4) { const f32x4 t4 = *(const f32x4*)(tv + r * 4);
            const float wsum = 1.f + __expf(t4.y - t4.x) + __expf(t4.z - t4.x) + __expf(t4.w - t4.x), wk = __expf(v - t4.x);
            const int token = tile * 16 + r, lpos = atomicAdd(lcnt + e, 1), slot = nent + r * 4 + rank;
            ent[slot * 4] = e; ent[slot * 4 + 1] = lpos; ent[slot * 4 + 2] = token * 4 + rank; ent[slot * 4 + 3] = __float_as_int(wk / wsum); }
        nent += 64;
        __syncthreads();
    }
#undef PM_LOAD
    unsigned* cntp = P_CNT; int* ltk = P_LTK; float* lgp = P_LG;
    if (F.tid < 32) { const int n = lcnt[F.tid]; lcnt[32 + F.tid] = n > 0 ? (int)atomicAdd(cntp + 64 * (l * 32 + F.tid), (unsigned)n) : 0; }
    __syncthreads();
    if (F.tid < nent) { const int e = ent[F.tid * 4], pos = lcnt[32 + e] + ent[F.tid * 4 + 1];
        ltk[(size_t)(l * 32 + e) * LISTCAP + pos] = ent[F.tid * 4 + 2]; lgp[(size_t)(l * 32 + e) * LISTCAP + pos] = __int_as_float(ent[F.tid * 4 + 3]); }
    __syncthreads();
}
__device__ __forceinline__ void p_combine(CArgs& A, const Frame& F, int l) {
    float* wl = (float*)F.lds; if (l == 0) stage_side(A, F, 1, wl);
    const int gw = F.bid * 8 + F.wave, NGW = F.G * 8;
    u32x2 y[4][4]; Row xr;
#define COMB_LOAD(row_) do { _Pragma("unroll") for (int k = 0; k < 4; ++k) _Pragma("unroll") for (int j = 0; j < 4; ++j) y[k][j] = __builtin_nontemporal_load((const u32x2*)(P_Y + (size_t)((row_) * 4 + k) * DM + 4 * F.lane + 256 * j)); \
        row_load_bf16(xr, P_XB + (size_t)(row_) * DM, F.lane); } while (0)
    if (gw < NTOK) COMB_LOAD(gw);
#pragma unroll 1
    for (int row = gw; row < NTOK; row += NGW) {
        const int b = row >> 11; const float* mod = P_MOD + (size_t)(l * 8 + b) * 6144;
        Row f;
#pragma unroll
        for (int j = 0; j < 4; ++j) { f.v[j] = (f32x4){0.f, 0.f, 0.f, 0.f};
#pragma unroll
            for (int k = 0; k < 4; ++k) { const u32x2 w = y[k][j]; f.v[j].x += bflo(w.x); f.v[j].y += bfhi(w.x); f.v[j].z += bflo(w.y); f.v[j].w += bfhi(w.y); } }
        Row x = xr;
        if (row + NGW < NTOK) COMB_LOAD(row + NGW);
        const float r = row_rstd(f);
#pragma unroll
        for (int j = 0; j < 4; ++j) { const int k = 4 * F.lane + 256 * j; const f32x4 gp = *(const f32x4*)(A.in[I_NQF] + l * DM + k), g2 = *(const f32x4*)(mod + 5120 + k);
            x.v[j] = x.v[j] + g2 * (f.v[j] * r * gp); }
        if (l == 0) row_store_bf16_nt(x, P_XB + (size_t)row * DM, F.lane); else row_store(x, A.out + (size_t)row * DM, F.lane);
        if (l == 0) hprep_row(A, F, x, 1, row, wl);
    }
#undef COMB_LOAD
}
__device__ __forceinline__ int moe_tables(CArgs& A, const Frame& F, int l, LAS pg8::MoeTables* tb) {
    __syncthreads();
    if (F.tid < 32) tb->cnt[F.tid] = (int)__hip_atomic_load(P_CNT + 64 * (l * 32 + F.tid), __ATOMIC_RELAXED, __HIP_MEMORY_SCOPE_AGENT);
    __syncthreads();
    if (F.tid == 0) { int s = 0;
#pragma nounroll
        for (int e = 0; e < 32; ++e) { tb->mtstart[e] = s; s += (tb->cnt[e] + 255) >> 8; }
        tb->mtstart[32] = s; }
    __syncthreads();
    if (F.tid < 320) { int e = 0;
#pragma nounroll
        for (int q = 1; q < 32; ++q) if (tb->mtstart[q] <= F.tid) e = q;
        tb->tile_e[F.tid] = (unsigned char)e; }
    __syncthreads();
    return tb->mtstart[32];
}
__device__ __forceinline__ void fox_kbias(CArgs& A, const Frame& F, int b, int h, float* kb, float* wtot  ) {
    const int t0 = 4 * F.tid; float e[4];
#pragma unroll
    for (int i = 0; i < 4; ++i) e[i] = P_LSIG[(size_t)(b * SEQ + t0 + i) * 8 + h];
    const float s4 = (e[0] + e[1]) + (e[2] + e[3]); float v = s4;
#pragma unroll
    for (int o = 1; o < 64; o <<= 1) { const float tt = __shfl_up(v, o); if (F.lane >= o) v += tt; }
    if (F.lane == 63) wtot[F.wave] = v;
    __syncthreads();
    float off = 0.f;
#pragma unroll
    for (int w = 0; w < 8; ++w) if (w < F.wave) off += wtot[w];
    float c = off + v - s4;
#pragma unroll
    for (int i = 0; i < 4; ++i) { c += e[i]; kb[t0 + i] = -LOG2E * c; }
    __syncthreads();
}
#include <hip/hip_bf16.h>
namespace attn_body {
using bf16=__hip_bfloat16;
using bf16x8=__attribute__((ext_vector_type(8)))short;
using s16x4=__attribute__((ext_vector_type(4)))short;
using f32x16=__attribute__((ext_vector_type(16)))float;
using u32x4=__attribute__((ext_vector_type(4)))unsigned;
constexpr int BATCH=8,NHEAD=8,SEQ=2048,D=64,QP=2048,OP=1024;
constexpr int NW=8,QBLK=32,QB=QBLK*NW,KVBLK=64,NQB=SEQ/QB;
constexpr int ATTN_UNIT_ROWS=QB;
__device__ __forceinline__ int crow(int r,int hi){return (r&3)+8*(r>>2)+4*hi;}
#define SBAR() __builtin_amdgcn_sched_barrier(0)
__device__ __forceinline__ void cmask(f32x16&p0,f32x16&p1,int jb,int qrel,int hi){
  const float NEG=-INFINITY; int kb=64*jb+4*hi;
  #pragma unroll
  for(int r=0;r<16;++r){int kv=kb+(r&3)+8*(r>>2); if(kv>qrel)p0[r]=NEG; if(kv+32>qrel)p1[r]=NEG;}
}

constexpr int NSLOT=3, SLOTB=8192;
constexpr int LDS_K=0, LDS_V=NSLOT*SLOTB, LDS_WS=2*NSLOT*SLOTB, LDS_OST=LDS_WS+NW*64*4, LDS_BYTES=LDS_OST+NW*4096;
constexpr float C2=0.125f*1.4426950408889634f;
__device__ __forceinline__ void glds16(const void*gsrc,unsigned lds_dst){unsigned keep;
  asm volatile("s_mov_b32 %0, m0\n\ts_mov_b32 m0, %2\n\ts_nop 0\n\tglobal_load_lds_dwordx4 %1, off\n\ts_mov_b32 m0, %0":"=&s"(keep):"v"(gsrc),"s"(lds_dst):"memory");}
__device__ __forceinline__ float max3f(float a,float b,float c){float r;asm("v_max3_f32 %0, %1, %2, %3":"=v"(r):"v"(a),"v"(b),"v"(c));return r;}
__device__ __forceinline__ float max2f(float a,float b){float r;asm("v_max_f32_e32 %0, %1, %2":"=v"(r):"v"(a),"v"(b));return r;}
__device__ __forceinline__ float fadd_s(float a,float b){float r;asm("v_add_f32_e32 %0, %1, %2":"=v"(r):"v"(a),"v"(b));return r;}
__device__ __forceinline__ float fsub_s(float a,float b){float r;asm("v_sub_f32_e32 %0, %1, %2":"=v"(r):"v"(a),"v"(b));return r;}
typedef float f32x2_t __attribute__((ext_vector_type(2))); typedef float f32x4_t __attribute__((ext_vector_type(4))); typedef __bf16 bf16x2_t __attribute__((ext_vector_type(2)));
__device__ __forceinline__ unsigned cvtpk_s(float lo,float hi){f32x2_t v={lo,hi};bf16x2_t b=__builtin_convertvector(v,bf16x2_t);return __builtin_bit_cast(unsigned,b);}
#define WAIT_BAR(N) asm volatile("s_waitcnt vmcnt(" #N ") lgkmcnt(0)\n\ts_barrier":::"memory")

__device__ __forceinline__ void qkt(f32x16&p0,f32x16&p1,const char*Kslot,const bf16x8*qr,const f32x16&c0i,const f32x16&c1i,int r32,int hi){
  const char*kb=Kslot+hi*1024+r32*16;
  #pragma unroll
  for(int d0=0;d0<4;++d0){
    const bf16x8 b0=*reinterpret_cast<const bf16x8*>(kb+d0*2048);
    const bf16x8 b1=*reinterpret_cast<const bf16x8*>(kb+d0*2048+512);
    if(d0==0){p0=__builtin_amdgcn_mfma_f32_32x32x16_bf16(b0,qr[0],c0i,0,0,0);p1=__builtin_amdgcn_mfma_f32_32x32x16_bf16(b1,qr[0],c1i,0,0,0);}
    else{p0=__builtin_amdgcn_mfma_f32_32x32x16_bf16(b0,qr[d0],p0,0,0,0);p1=__builtin_amdgcn_mfma_f32_32x32x16_bf16(b1,qr[d0],p1,0,0,0);}}
}
typedef __attribute__((address_space(3))) const char* lds_cptr;
typedef short v4i16_t __attribute__((ext_vector_type(4)));
__device__ __forceinline__ void kload8(bf16x8*kf,lds_cptr kp){
  kf[0]=*(const __attribute__((address_space(3))) bf16x8*)(kp);      kf[1]=*(const __attribute__((address_space(3))) bf16x8*)(kp+512);
  kf[2]=*(const __attribute__((address_space(3))) bf16x8*)(kp+2048); kf[3]=*(const __attribute__((address_space(3))) bf16x8*)(kp+2560);
  kf[4]=*(const __attribute__((address_space(3))) bf16x8*)(kp+4096); kf[5]=*(const __attribute__((address_space(3))) bf16x8*)(kp+4608);
  kf[6]=*(const __attribute__((address_space(3))) bf16x8*)(kp+6144); kf[7]=*(const __attribute__((address_space(3))) bf16x8*)(kp+6656);
}
__device__ __forceinline__ void kload2(bf16x8*kf,lds_cptr kp,int j){ kf[2*j]=*(const __attribute__((address_space(3))) bf16x8*)(kp+j*2048); kf[2*j+1]=*(const __attribute__((address_space(3))) bf16x8*)(kp+j*2048+512); }
__device__ __forceinline__ s16x4 vtr(lds_cptr p){ return __builtin_bit_cast(s16x4,__builtin_amdgcn_ds_read_tr16_b64_v4i16((__attribute__((address_space(3))) v4i16_t*)p)); }
__device__ __forceinline__ float rowmax(const f32x16&p0,const f32x16&p1){
  float a=max3f(p0[0],p0[1],p1[0]),b=max3f(p0[2],p0[3],p1[1]);a=max3f(a,p1[2],p1[3]);
  #pragma unroll
  for(int r=4;r<16;r+=4){a=max3f(a,p0[r],p0[r+1]);b=max3f(b,p0[r+2],p0[r+3]);a=max3f(a,p1[r],p1[r+1]);b=max3f(b,p1[r+2],p1[r+3]);}
  const float m=max2f(a,b);
  auto rr=__builtin_amdgcn_permlane32_swap(__float_as_uint(m),__float_as_uint(m),false,false);
  return max2f(__uint_as_float(rr[0]),__uint_as_float(rr[1]));
}
__device__ __forceinline__ void pv(f32x16*o,int vb,bf16x8 pa0,bf16x8 pa1,bf16x8 pa2,bf16x8 pa3){
  #pragma unroll
  for(int d0=0;d0<2;++d0){s16x4 lo[4],hi[4];
    #pragma unroll
    for(int ks=0;ks<4;++ks){
      asm volatile("ds_read_b64_tr_b16 %0,%1 offset:%c2":"=&v"(lo[ks]):"v"(vb),"i"(d0*4096+ks*1024):"memory");
      asm volatile("ds_read_b64_tr_b16 %0,%1 offset:%c2":"=&v"(hi[ks]):"v"(vb),"i"(d0*4096+ks*1024+512):"memory");}
    asm volatile("s_waitcnt lgkmcnt(0)":::"memory");SBAR();
    #define PK(k) (bf16x8){lo[k][0],lo[k][1],lo[k][2],lo[k][3],hi[k][0],hi[k][1],hi[k][2],hi[k][3]}
    o[d0]=__builtin_amdgcn_mfma_f32_32x32x16_bf16(pa0,PK(0),o[d0],0,0,0);
    o[d0]=__builtin_amdgcn_mfma_f32_32x32x16_bf16(pa1,PK(1),o[d0],0,0,0);
    o[d0]=__builtin_amdgcn_mfma_f32_32x32x16_bf16(pa2,PK(2),o[d0],0,0,0);
    o[d0]=__builtin_amdgcn_mfma_f32_32x32x16_bf16(pa3,PK(3),o[d0],0,0,0);
    #undef PK
  }
}

#ifndef ATTN_STORE16
#define ATTN_STORE16(p,v) (*(u32x4*)(p)=(v))
#endif
typedef const __attribute__((address_space(3))) float* lds_fptr;
template<int THRL> __device__ __forceinline__ void attn_unit(int b,int h,int qb,const bf16*Q,const bf16*__restrict__ K,const bf16*__restrict__ V,bf16*O,char*shm,lds_fptr kb,int tid,int wid){
  const int lane=tid&63,r32=lane&31,hi=lane>>5;
  const long rowbase=(long)b*SEQ; const int q0=qb*QB;
  const bf16*Qw=Q+(rowbase+q0+wid*QBLK)*QP+h*D;
  const bf16*Kh=K+rowbase*QP+h*D,*Vh=V+rowbase*QP+h*D;
  const unsigned lds0=(unsigned)(uintptr_t)shm;
  float*wsf=(float*)(shm+LDS_WS)+wid*64;
  const bf16*ksrc=Kh+(long)lane*QP+wid*8;
  const bf16*vsrc=Vh+(long)(16*(wid&3)+(lane>>2))*QP+(wid>>2)*32+(lane&3)*8;
  const unsigned kdst=lds0+LDS_K+wid*1024, vdst=lds0+LDS_V+wid*1024;
  #define DMA_K(t,slot) glds16(ksrc+(long)(t)*KVBLK*QP,(unsigned)__builtin_amdgcn_readfirstlane(kdst+(slot)))
  #define DMA_V(t,slot) glds16(vsrc+(long)(t)*KVBLK*QP,(unsigned)__builtin_amdgcn_readfirstlane(vdst+(slot)))
  const int vb0=(int)(lds0+LDS_V)+((lane>>4)&1)*32+(lane&3)*8+(4*hi+((lane&15)>>2))*64;
  const char*Kbase=shm+LDS_K; bf16x8 kf[8];
  const lds_cptr shm3=(lds_cptr)shm; const lds_cptr kp0=shm3+LDS_K+hi*1024+r32*16; const lds_cptr vp0=shm3+LDS_V+((lane>>4)&1)*32+(lane&3)*8+(4*hi+((lane&15)>>2))*64;
  const int NT=(q0+QB)/KVBLK;
  DMA_K(0,0);DMA_V(0,0);DMA_K(1,SLOTB);
  bf16x8 qr[4];
  #pragma unroll
  for(int d0=0;d0<4;++d0)qr[d0]=*reinterpret_cast<const bf16x8*>(&Qw[(long)r32*QP+d0*16+hi*8]);
  float mhat=0.f,l_reg=0.f;f32x16 o[2];o[0]=f32x16{};o[1]=f32x16{};float nm=0.f;
  #define BIASFILL(C0,C1,t) do{ const lds_fptr kbt_=kb+64*(t)+4*hi; _Pragma("unroll") for(int g_=0;g_<4;++g_){ const f32x4_t v0_=*(const __attribute__((address_space(3))) f32x4_t*)(kbt_+8*g_), v1_=*(const __attribute__((address_space(3))) f32x4_t*)(kbt_+32+8*g_); \
      _Pragma("unroll") for(int i_=0;i_<4;++i_){ C0[4*g_+i_]=v0_[i_]+nm; C1[4*g_+i_]=v1_[i_]+nm; } } }while(0)
  const int qrel=wid*QBLK+r32;
  #define CMASK(P0,P1,t) do{int jb_=(t)-(NT-4); if(jb_>=0)cmask(P0,P1,jb_,qrel,hi);}while(0)
  bool resc=false;
  #define START(P0,P1) do{ const float rm=rowmax(P0,P1); resc=false; \
    { const float dl=rm; mhat=fadd_s(mhat,dl); \
      _Pragma("unroll") for(int r=0;r<16;++r){P0[r]=fsub_s(P0[r],dl);P1[r]=fsub_s(P1[r],dl);} \
      nm=-mhat; } \
    _Pragma("unroll") for(int r=0;r<16;++r)P0[r]=__builtin_amdgcn_exp2f(P0[r]); }while(0)
  #define RESC() do{ if(resc){ asm volatile("s_waitcnt lgkmcnt(0)":::"memory"); \
      _Pragma("unroll") for(int d_=0;d_<2;++d_) _Pragma("unroll") for(int r=0;r<16;++r)o[d_][r]*=wsf[crow(r,hi)]; } }while(0)
  f32x16 pA0,pA1,pB0,pB1;
  int sl_prev=0,sl_cur=0,sl_next=SLOTB;
  #define ROT() do{sl_prev=sl_cur;sl_cur=sl_next;sl_next=(sl_next==(NSLOT-1)*SLOTB)?0:sl_next+SLOTB;}while(0)
  DMA_K(2,2*SLOTB);
  WAIT_BAR(3);
  { f32x16 c0i,c1i; BIASFILL(c0i,c1i,0); qkt(pA0,pA1,Kbase,qr,c0i,c1i,r32,hi); }asm volatile("s_nop 15\n\ts_nop 7":"+v"(pA0),"+v"(pA1));CMASK(pA0,pA1,0);
  START(pA0,pA1);
  _Pragma("unroll") for(int r=0;r<16;++r)pA1[r]=__builtin_amdgcn_exp2f(pA1[r]);
  WAIT_BAR(0);
  DMA_K(3,0);DMA_V(1,SLOTB);
  ROT();
  kload8(kf,kp0+sl_cur);
  WAIT_BAR(2);
  s16x4 vlo[8],vhi[8]; u32x4 pw0,pw1,pw2,pw3;
  #define PKW(P,B) cvtpk_s(P[B],P[B+1])
  #define PAF(k) __builtin_bit_cast(bf16x8,pw##k)
  #define VFR(i) (bf16x8){vlo[i][0],vlo[i][1],vlo[i][2],vlo[i][3],vhi[i][0],vhi[i][1],vhi[i][2],vhi[i][3]}
  #define PIN(x) asm volatile("":"+v"(x))
  #define MX3(a,b,c) __builtin_fmaxf(__builtin_fmaxf((a),(b)),(c))
  #define GAPA(MF,A0,A1,A2,A3,W0,W1,PW) do{ MF; sacc+=A0; sacc+=A1; sacc+=A2; sacc+=A3; PIN(sacc); W0; W1; PIN(PW); SBAR(); }while(0)
  #define EX(v) __builtin_amdgcn_exp2f(v)
  #define GAPB(MF,X,B) do{ MF; X[B]=EX(X[B]); X[B+1]=EX(X[B+1]); X[B+2]=EX(X[B+2]); X[B+3]=EX(X[B+3]); PIN(X); SBAR(); }while(0)
  #define VRD(i) do{ vlo[i]=vtr(vp_+(((i)>>2)*4096+((i)&3)*1024)); vhi[i]=vtr(vp_+(((i)>>2)*4096+((i)&3)*1024+512)); }while(0)
  #define KRD(G,j) do{ if(G){ kload2(kf,kp0+sl_next,j); SBAR(); } }while(0)
  #define STEP(C0,C1,P0,P1,t,GK,GV,GL) do{ SBAR(); BIASFILL(C0,C1,t); SBAR(); \
    const lds_cptr vp_=vp0+sl_prev; \
    VRD(0); SBAR(); float sacc=(P0[0]+P0[1]); \
    GAPA(C0=__builtin_amdgcn_mfma_f32_32x32x16_bf16(kf[0],qr[0],C0,0,0,0), P0[2],P0[3],P0[4],P0[5],     pw0[0]=PKW(P0,0), pw0[1]=PKW(P0,2), pw0); \
    VRD(4); SBAR(); GAPA(C1=__builtin_amdgcn_mfma_f32_32x32x16_bf16(kf[1],qr[0],C1,0,0,0), P0[6],P0[7],P0[8],P0[9],     pw0[2]=PKW(P0,4), pw0[3]=PKW(P0,6), pw0); \
    VRD(1); SBAR(); GAPA(C0=__builtin_amdgcn_mfma_f32_32x32x16_bf16(kf[2],qr[1],C0,0,0,0),   P0[10],P0[11],P0[12],P0[13], pw1[0]=PKW(P0,8), pw1[1]=PKW(P0,10), pw1); \
    VRD(5); SBAR(); GAPA(C1=__builtin_amdgcn_mfma_f32_32x32x16_bf16(kf[3],qr[1],C1,0,0,0),   P0[14],P0[15],P1[0],P1[1],   pw1[2]=PKW(P0,12),pw1[3]=PKW(P0,14), pw1); \
    VRD(2); SBAR(); GAPA(C0=__builtin_amdgcn_mfma_f32_32x32x16_bf16(kf[4],qr[2],C0,0,0,0),   P1[2],P1[3],P1[4],P1[5],     pw2[0]=PKW(P1,0), pw2[1]=PKW(P1,2), pw2); \
    VRD(6); SBAR(); GAPA(C1=__builtin_amdgcn_mfma_f32_32x32x16_bf16(kf[5],qr[2],C1,0,0,0),   P1[6],P1[7],P1[8],P1[9],     pw2[2]=PKW(P1,4), pw2[3]=PKW(P1,6), pw2); \
    VRD(3); SBAR(); GAPA(C0=__builtin_amdgcn_mfma_f32_32x32x16_bf16(kf[6],qr[3],C0,0,0,0),   P1[10],P1[11],P1[12],P1[13], pw3[0]=PKW(P1,8), pw3[1]=PKW(P1,10), pw3); \
    VRD(7); SBAR(); GAPA(C1=__builtin_amdgcn_mfma_f32_32x32x16_bf16(kf[7],qr[3],C1,0,0,0),   P1[14],P1[15],0.f,0.f,       pw3[2]=PKW(P1,12),pw3[3]=PKW(P1,14), pw3); \
    l_reg+=sacc; \
    if(GK){DMA_K((t)+3,sl_cur);} if(GV){DMA_V((t)+1,sl_next);} \
    CMASK(C0,C1,t); \
    { float a=MX3(C0[0],C0[1],C1[0]),b=MX3(C0[2],C0[3],C1[1]); a=MX3(a,C1[2],C1[3]); \
      _Pragma("unroll") for(int r=4;r<16;r+=4){a=MX3(a,C0[r],C0[r+1]);b=MX3(b,C0[r+2],C0[r+3]);a=MX3(a,C1[r],C1[r+1]);b=MX3(b,C1[r+2],C1[r+3]);} \
      float rm=__builtin_fmaxf(a,b); { auto rr=__builtin_amdgcn_permlane32_swap(__float_as_uint(rm),__float_as_uint(rm),false,false); rm=__builtin_fmaxf(__uint_as_float(rr[0]),__uint_as_float(rr[1])); } \
      resc=false; \
      if(__builtin_expect(__any(rm>(float)THRL),0)){ const float dl=__builtin_fmaxf(rm,0.f); mhat+=dl; \
        _Pragma("unroll") for(int r=0;r<16;++r){C0[r]-=dl;C1[r]-=dl;} \
        nm=-mhat; \
        const float f=__builtin_amdgcn_exp2f(-dl); l_reg*=f; if(hi==0)wsf[r32]=f; resc=true; } } \
    SBAR(); \
    GAPB(o[0]=__builtin_amdgcn_mfma_f32_32x32x16_bf16(PAF(0),VFR(0),o[0],0,0,0), C0,0); \
    GAPB(o[1]=__builtin_amdgcn_mfma_f32_32x32x16_bf16(PAF(0),VFR(4),o[1],0,0,0), C0,4); \
    KRD(GL,0); GAPB(o[0]=__builtin_amdgcn_mfma_f32_32x32x16_bf16(PAF(1),VFR(1),o[0],0,0,0), C0,8); \
    KRD(GL,1); GAPB(o[1]=__builtin_amdgcn_mfma_f32_32x32x16_bf16(PAF(1),VFR(5),o[1],0,0,0), C0,12); \
    KRD(GL,2); GAPB(o[0]=__builtin_amdgcn_mfma_f32_32x32x16_bf16(PAF(2),VFR(2),o[0],0,0,0), C1,0); \
    KRD(GL,3); GAPB(o[1]=__builtin_amdgcn_mfma_f32_32x32x16_bf16(PAF(2),VFR(6),o[1],0,0,0), C1,4); \
    GAPB(o[0]=__builtin_amdgcn_mfma_f32_32x32x16_bf16(PAF(3),VFR(3),o[0],0,0,0), C1,8); \
    GAPB(o[1]=__builtin_amdgcn_mfma_f32_32x32x16_bf16(PAF(3),VFR(7),o[1],0,0,0), C1,12); \
    }while(0)
  int t=1;
  #undef CMASK
  #define CMASK(P0,P1,t) do{}while(0)
  for(;t+5<NT;t+=2){
    STEP(pB0,pB1,pA0,pA1,t,true,true,true);     WAIT_BAR(2); RESC(); ROT();
    STEP(pA0,pA1,pB0,pB1,t+1,true,true,true);   WAIT_BAR(2); RESC(); ROT();
  }
  #undef CMASK
  #define CMASK(P0,P1,t) do{int jb_=(t)-(NT-4); if(jb_>=0)cmask(P0,P1,jb_,qrel,hi);}while(0)
  #define ENDW(tt) do{ if((tt)+3<NT){WAIT_BAR(2);} else if((tt)+2<NT){WAIT_BAR(1);} else {WAIT_BAR(0);} }while(0)
  for(;t+1<NT;t+=2){
    STEP(pB0,pB1,pA0,pA1,t,(t+3<NT),(t+1<NT),(t+1<NT));       ENDW(t);   RESC(); ROT();
    STEP(pA0,pA1,pB0,pB1,t+1,(t+4<NT),(t+2<NT),(t+2<NT));     ENDW(t+1); RESC(); ROT();
  }
  STEP(pB0,pB1,pA0,pA1,NT-1,false,false,false); RESC();
  { float sacc=pB0[0]+pB0[1]; _Pragma("unroll") for(int r=2;r<16;++r)sacc+=pB0[r]; _Pragma("unroll") for(int r=0;r<16;++r)sacc+=pB1[r]; l_reg+=sacc;
    pw0=(u32x4){PKW(pB0,0),PKW(pB0,2),PKW(pB0,4),PKW(pB0,6)};pw1=(u32x4){PKW(pB0,8),PKW(pB0,10),PKW(pB0,12),PKW(pB0,14)};pw2=(u32x4){PKW(pB1,0),PKW(pB1,2),PKW(pB1,4),PKW(pB1,6)};pw3=(u32x4){PKW(pB1,8),PKW(pB1,10),PKW(pB1,12),PKW(pB1,14)};
    SBAR(); pv(o,vb0+sl_cur,PAF(0),PAF(1),PAF(2),PAF(3)); }
  #undef PKW
  #undef PAF
  #undef VFR
  #undef PIN
  #undef MX3
  #undef GAPA
  #undef GAPB
  #undef EX
  #undef VRD
  #undef KRD
  #undef STEP
  #undef ENDW
  {auto rr=__builtin_amdgcn_permlane32_swap(__float_as_uint(l_reg),__float_as_uint(l_reg),false,false);l_reg=__uint_as_float(rr[0])+__uint_as_float(rr[1]);}
  if(hi==0)wsf[32+r32]=l_reg;asm volatile("s_waitcnt lgkmcnt(0)":::"memory");
  float rli[16];
  #pragma unroll
  for(int r=0;r<16;++r)rli[r]=__builtin_amdgcn_rcpf(wsf[32+crow(r,hi)]);
  bf16*Ow=O+(rowbase+q0+wid*QBLK)*OP+h*D;
  { bf16*stg=(bf16*)(shm+LDS_OST)+wid*2048;
    #pragma unroll
    for(int r=0;r<16;++r){const int orow=crow(r,hi);
      #pragma unroll
      for(int d0=0;d0<2;++d0)stg[orow*64+d0*32+r32]=__float2bfloat16(o[d0][r]*rli[r]);}
    asm volatile("s_waitcnt lgkmcnt(0)":::"memory");
    #pragma unroll
    for(int i=0;i<4;++i){const int row=i*8+(lane>>3),ch=lane&7; const u32x4 v=*(const u32x4*)(stg+row*64+ch*8); ATTN_STORE16(Ow+(long)row*OP+ch*8,v);} }
  asm volatile("s_waitcnt lgkmcnt(0)\n\ts_barrier":::"memory");
  #undef DMA_K
  #undef DMA_V
  #undef CMASK
  #undef START
  #undef RESC
  #undef ROT
  #undef BIASFILL
}
constexpr int ATTN_LDS_BYTES=LDS_BYTES;
#undef SBAR
#undef WAIT_BAR
}
__device__ __forceinline__ void fox_fast(CArgs& A, const Frame& F) {
    float* kb = (float*)(F.lds + 86016); float* wtot = kb + 2048;
    const int v = (F.bid & 7) * 32 + (F.bid >> 3), bh = v >> 2, s = v & 3, b = bh >> 3, h = bh & 7;
    fox_kbias(A, F, b, h, kb, wtot);
    const attn_body::bf16* Zb = (const attn_body::bf16*)P_Z;
    const attn_body::lds_fptr kb3 = (attn_body::lds_fptr)(const __attribute__((address_space(3))) unsigned char*)((LAS unsigned char*)F.lds + 86016);
    attn_body::attn_unit<8>(b, h, 7 - s, Zb + 512, Zb + 1024, Zb + 1536, (attn_body::bf16*)P_YCAT + 512, (char*)F.lds, kb3, F.tid, F.wave);
    attn_body::attn_unit<8>(b, h, s, Zb + 512, Zb + 1024, Zb + 1536, (attn_body::bf16*)P_YCAT + 512, (char*)F.lds, kb3, F.tid, F.wave);
}
typedef float f32x16 __attribute__((ext_vector_type(16)));
__device__ __forceinline__ bf16x8 pack8(const f32x4& a, const f32x4& b) { u32x4 w; w.x = pk2(a.x, a.y); w.y = pk2(a.z, a.w); w.z = pk2(b.x, b.y); w.w = pk2(b.z, b.w); return __builtin_bit_cast(bf16x8, w); }
__device__ __forceinline__ void s5_fast(CArgs& A, const Frame& F, int item) {
    const int b = item >> 5, g = item & 31, lane = F.lane, w = F.wave, p = lane & 31, hh = lane >> 5, l15 = lane & 15, l4 = lane >> 4;
    float* Eseg = (float*)F.lds; float* Hin = Eseg + 2048;
    bf16_t* Hs = (bf16_t*)(F.lds + 16384) + w * 4352;
    bf16x8 bbr[2], bbi[2]; float are[2], aim[2];
#pragma unroll
    for (int nt = 0; nt < 2; ++nt) { const float* q = P_S5BB + (size_t)(g * 64 + 32 * nt + p) * 32 + 8 * hh;
        bbr[nt] = pack8(*(const f32x4*)q, *(const f32x4*)(q + 4)); bbi[nt] = pack8(*(const f32x4*)(q + 16), *(const f32x4*)(q + 20));
        are[nt] = P_S5A[(g * 64 + 32 * nt + p) * 2]; aim[nt] = P_S5A[(g * 64 + 32 * nt + p) * 2 + 1]; }
    const int rr = lane & 31, ahalf = (rr >> 2) & 1, atau = (rr & 3) + 4 * (rr >> 3);
    const bf16_t* usrc = P_Z + (size_t)(b * SEQ + 128 * (2 * w + ahalf) + atau) * ZP0 + g * 16 + 8 * hh;
    const f32x16 zero16 = {0.f, 0.f, 0.f, 0.f, 0.f, 0.f, 0.f, 0.f, 0.f, 0.f, 0.f, 0.f, 0.f, 0.f, 0.f, 0.f};
    float hr[2] = {0.f, 0.f}, hi[2] = {0.f, 0.f};
#define S5_ALOAD(blk_) (*(const bf16x8*)(usrc + (size_t)(blk_) * 16 * ZP0))
    { bf16x8 a0 = S5_ALOAD(0), a1 = S5_ALOAD(1), a2 = S5_ALOAD(2);
#pragma unroll 1
      for (int blk = 0; blk < 8; ++blk) {
        const bf16x8 a = a0; a0 = a1; a1 = a2; if (blk + 3 < 8) a2 = S5_ALOAD(blk + 3);
#pragma unroll
        for (int nt = 0; nt < 2; ++nt) {
            const f32x16 dre = __builtin_amdgcn_mfma_f32_32x32x16_bf16(a, bbr[nt], zero16, 0, 0, 0), dim = __builtin_amdgcn_mfma_f32_32x32x16_bf16(a, bbi[nt], zero16, 0, 0, 0);
#pragma unroll
            for (int i = 0; i < 16; ++i) { const float nr = are[nt] * hr[nt] - aim[nt] * hi[nt] + dre[i], ni = are[nt] * hi[nt] + aim[nt] * hr[nt] + dim[i]; hr[nt] = nr; hi[nt] = ni; }
        }
      } }
#pragma unroll
    for (int nt = 0; nt < 2; ++nt) { Eseg[((2 * w + hh) * 64 + 32 * nt + p) * 2] = hr[nt]; Eseg[((2 * w + hh) * 64 + 32 * nt + p) * 2 + 1] = hi[nt]; }
    __syncthreads();
    if (w == 0) {
        float xr = P_S5A[(g * 64 + lane) * 2], xi = P_S5A[(g * 64 + lane) * 2 + 1];
#pragma unroll
        for (int q = 0; q < 7; ++q) { const float nr = xr * xr - xi * xi, ni = 2.f * xr * xi; xr = nr; xi = ni; }
        float Hr = 0.f, Hi = 0.f;
#pragma unroll 1
        for (int s = 0; s < 16; ++s) { Hin[(s * 64 + lane) * 2] = Hr; Hin[(s * 64 + lane) * 2 + 1] = Hi;
            const float er = Eseg[(s * 64 + lane) * 2], ei = Eseg[(s * 64 + lane) * 2 + 1]; const float nr = xr * Hr - xi * Hi + er, ni = xr * Hi + xi * Hr + ei; Hr = nr; Hi = ni; }
    }
    __syncthreads();
#pragma unroll
    for (int nt = 0; nt < 2; ++nt) { hr[nt] = Hin[((2 * w + hh) * 64 + 32 * nt + p) * 2]; hi[nt] = Hin[((2 * w + hh) * 64 + 32 * nt + p) * 2 + 1]; }
    bf16x8 ck[4];
#pragma unroll
    for (int ks = 0; ks < 4; ++ks) ck[ks] = *(const bf16x8*)(P_S5CK + (size_t)(g * 16 + l15) * 128 + 32 * ks + 8 * l4);
    const int er = lane >> 1, eh = lane & 1;
    float* Ys = (float*)(F.lds + 86016) + w * 640;
    f32x4 dk0 = *(const f32x4*)(A.in[I_S5D] + g * 16 + 8 * eh), dk1 = *(const f32x4*)(A.in[I_S5D] + g * 16 + 8 * eh + 4);
#define S5_EROW(blk_) ((size_t)(b * SEQ + 128 * (2 * w + (er >> 4)) + 16 * (blk_) + (er & 15)))
    bf16x8 a0 = S5_ALOAD(0), a1 = S5_ALOAD(1), a2 = S5_ALOAD(2);
    u32x4 un = *(const u32x4*)(P_Z + S5_EROW(0) * ZP0 + g * 16 + 8 * eh);
#pragma unroll 1
    for (int blk = 0; blk < 8; ++blk) {
        const bf16x8 a = a0; a0 = a1; a1 = a2; if (blk + 3 < 8) a2 = S5_ALOAD(blk + 3);
        const u32x4 us = un; if (blk + 1 < 8) un = *(const u32x4*)(P_Z + S5_EROW(blk + 1) * ZP0 + g * 16 + 8 * eh);
#pragma unroll
        for (int nt = 0; nt < 2; ++nt) {
            const f32x16 dre = __builtin_amdgcn_mfma_f32_32x32x16_bf16(a, bbr[nt], zero16, 0, 0, 0), dim = __builtin_amdgcn_mfma_f32_32x32x16_bf16(a, bbi[nt], zero16, 0, 0, 0);
#pragma unroll
            for (int i = 0; i < 16; ++i) { const float nr = are[nt] * hr[nt] - aim[nt] * hi[nt] + dre[i], ni = are[nt] * hi[nt] + aim[nt] * hr[nt] + dim[i]; hr[nt] = nr; hi[nt] = ni;
                *(unsigned*)(Hs + (hh * 16 + i) * 136 + 2 * (32 * nt + p)) = pk2(nr, ni); }
        }
        LDS_WAIT();
#pragma unroll
        for (int sg = 0; sg < 2; ++sg) {
            f32x4 y = {0.f, 0.f, 0.f, 0.f};
#pragma unroll
            for (int ks = 0; ks < 4; ++ks) { const bf16x8 af = *(const bf16x8*)(Hs + (sg * 16 + l15) * 136 + 32 * ks + 8 * l4); y = __builtin_amdgcn_mfma_f32_16x16x32_bf16(af, ck[ks], y, 0, 0, 0); }
#pragma unroll
            for (int q = 0; q < 4; ++q) Ys[(sg * 16 + 4 * l4 + q) * 20 + l15] = y[q];
        }
        LDS_WAIT();
        { const f32x4 y0 = *(const f32x4*)(Ys + er * 20 + 8 * eh), y1 = *(const f32x4*)(Ys + er * 20 + 8 * eh + 4);
          float o[8]; o[0] = y0.x + dk0.x * bflo(us.x); o[1] = y0.y + dk0.y * bfhi(us.x); o[2] = y0.z + dk0.z * bflo(us.y); o[3] = y0.w + dk0.w * bfhi(us.y);
          o[4] = y1.x + dk1.x * bflo(us.z); o[5] = y1.y + dk1.y * bfhi(us.z); o[6] = y1.z + dk1.z * bflo(us.w); o[7] = y1.w + dk1.w * bfhi(us.w);
          u32x4 ov; ov.x = pk2(gelu_tanh(o[0]), gelu_tanh(o[1])); ov.y = pk2(gelu_tanh(o[2]), gelu_tanh(o[3])); ov.z = pk2(gelu_tanh(o[4]), gelu_tanh(o[5])); ov.w = pk2(gelu_tanh(o[6]), gelu_tanh(o[7]));
          *(u32x4*)(P_G5 + S5_EROW(blk) * 512 + g * 16 + 8 * eh) = ov; }
        LDS_WAIT();
    }
#undef S5_ALOAD
#undef S5_EROW
}
namespace lin {
typedef const LAS char* lptr;
typedef short s16x4 __attribute__((ext_vector_type(4)));
typedef short v4i16_t __attribute__((ext_vector_type(4)));
__device__ __forceinline__ s16x4 vtr(lptr p) { return __builtin_bit_cast(s16x4, __builtin_amdgcn_ds_read_tr16_b64_v4i16((LAS v4i16_t*)p)); }
__device__ __forceinline__ bf16x8 tr_frag(lptr sub, int ks, int lane) {
    const lptr p = sub + ((lane >> 4) & 1) * 32 + (lane & 3) * 8 + (4 * (lane >> 5) + ((lane & 15) >> 2)) * 64 + ks * 1024;
    const s16x4 lo = vtr(p), hi = vtr(p + 512);
    return (bf16x8){lo[0], lo[1], lo[2], lo[3], hi[0], hi[1], hi[2], hi[3]};
}
__device__ __forceinline__ bf16x8 nat_frag(lptr base, int ldb, int row0, int k0, int lane) { return *(const LAS bf16x8*)(base + (row0 + (lane & 31)) * ldb + (k0 + 8 * (lane >> 5)) * 2); }
__device__ __forceinline__ int crow(int r, int hh) { return (r & 3) + 8 * (r >> 2) + 4 * hh; }
__device__ __forceinline__ void unpack8(const u32x4& w, float (&f)[8]) { f[0] = bflo(w.x); f[1] = bfhi(w.x); f[2] = bflo(w.y); f[3] = bfhi(w.y); f[4] = bflo(w.z); f[5] = bfhi(w.z); f[6] = bflo(w.w); f[7] = bfhi(w.w); }
__device__ __forceinline__ u32x4 repack8(const float (&f)[8]) { u32x4 w; w.x = pk2(f[0], f[1]); w.y = pk2(f[2], f[3]); w.z = pk2(f[4], f[5]); w.w = pk2(f[6], f[7]); return w; }

__device__ __forceinline__ void gla_prefix(CArgs& A, const Frame& F, int item) {
    const int b = item >> 5, c = item & 31, half = F.tid >> 8, col = F.tid & 255;
    float* p = P_LOGA + (size_t)(b * SEQ + c * 64 + 32 * half) * 256 + col; float* tot = (float*)F.lds;
    float v[32];
#pragma unroll
    for (int i = 0; i < 32; ++i) v[i] = p[(size_t)i * 256];
#pragma unroll
    for (int i = 1; i < 32; ++i) v[i] += v[i - 1];
    if (half == 0) tot[col] = v[31];
    __syncthreads();
    const float off = half ? tot[col] : 0.f;
#pragma unroll
    for (int i = 0; i < 32; ++i) p[(size_t)i * 256] = v[i] + off;
    __syncthreads();
}
template <int KIND> __device__ __forceinline__ void r1_item(CArgs& A, const Frame& F, int bh, int vs) {
    constexpr int DK = KIND ? 64 : 128, ND = DK / 32;
    constexpr int KCOL = KIND ? 2304 : 512, VCOL = KIND ? 2560 : 1024;
    const int b = bh >> 2, h = bh & 3, tid = F.tid, lane = F.lane, w = F.wave, hh = lane >> 5;
    unsigned char* bufV = F.lds; unsigned char* bufK = F.lds + 4096;
    bf16_t* ST = (KIND ? P_GST : P_RST) + (size_t)bh * 32 * 128 * DK;
    const float log2g = KIND ? 0.f : log2f(1.f - exp2f(-5.f - (float)h));
    const float g64 = exp2f(64.f * log2g);
    f32x16 acc = {0.f, 0.f, 0.f, 0.f, 0.f, 0.f, 0.f, 0.f, 0.f, 0.f, 0.f, 0.f, 0.f, 0.f, 0.f, 0.f};
    const bf16_t* zb = P_Z + (size_t)(b * SEQ) * ZP1;
    const int vj = tid >> 2, vc = tid & 3;
    const int kj0 = KIND ? (tid >> 3) : (tid >> 4), kd0 = KIND ? (tid & 7) : (tid & 15);
#define R1_DECL(S) u32x4 rv##S = {0u, 0u, 0u, 0u}, rk0##S = {0u, 0u, 0u, 0u}, rk1##S = {0u, 0u, 0u, 0u}; f32x4 bj0##S = {0.f, 0.f, 0.f, 0.f}, bj1##S = bj0##S, bl0##S = bj0##S, bl1##S = bj0##S; float bd##S = 0.f;
#define R1_LOAD(S, c) do { const bf16_t* zc = zb + (size_t)((c) * 64) * ZP1; \
        if (tid < 256) rv##S = *(const u32x4*)(zc + (size_t)vj * ZP1 + VCOL + h * 128 + vs * 32 + vc * 8); \
        rk0##S = *(const u32x4*)(zc + (size_t)kj0 * ZP1 + KCOL + h * DK + kd0 * 8); \
        if (!KIND) rk1##S = *(const u32x4*)(zc + (size_t)(kj0 + 32) * ZP1 + KCOL + h * DK + kd0 * 8); \
        if (KIND) { const float* bp = P_LOGA + (size_t)(b * SEQ + (c) * 64) * 256 + h * 64; \
            bj0##S = *(const f32x4*)(bp + (size_t)kj0 * 256 + kd0 * 8); bj1##S = *(const f32x4*)(bp + (size_t)kj0 * 256 + kd0 * 8 + 4); \
            bl0##S = *(const f32x4*)(bp + 63 * 256 + kd0 * 8); bl1##S = *(const f32x4*)(bp + 63 * 256 + kd0 * 8 + 4); \
            if (w < ND) bd##S = bp[63 * 256 + 32 * w + (lane & 31)]; } } while (0)
#define R1_STEP(S, c) do { \
        if (tid < 256) { u32x4 o = rv##S; \
            if (!KIND) { float f[8]; unpack8(rv##S, f); const float z = exp2f((float)(63 - vj) * log2g); _Pragma("unroll") for (int e = 0; e < 8; ++e) f[e] *= z; o = repack8(f); } \
            *(u32x4*)(bufV + vj * 64 + vc * 16) = o; } \
        if (KIND) { float f[8]; unpack8(rk0##S, f); \
            f[0] *= __expf(bl0##S.x - bj0##S.x); f[1] *= __expf(bl0##S.y - bj0##S.y); f[2] *= __expf(bl0##S.z - bj0##S.z); f[3] *= __expf(bl0##S.w - bj0##S.w); \
            f[4] *= __expf(bl1##S.x - bj1##S.x); f[5] *= __expf(bl1##S.y - bj1##S.y); f[6] *= __expf(bl1##S.z - bj1##S.z); f[7] *= __expf(bl1##S.w - bj1##S.w); \
            *(u32x4*)(bufK + (kd0 >> 2) * 4096 + kj0 * 64 + (kd0 & 3) * 16) = repack8(f); \
        } else { \
            *(u32x4*)(bufK + (kd0 >> 2) * 4096 + kj0 * 64 + (kd0 & 3) * 16) = rk0##S; \
            *(u32x4*)(bufK + (kd0 >> 2) * 4096 + (kj0 + 32) * 64 + (kd0 & 3) * 16) = rk1##S; } \
        __syncthreads(); \
        const float decn = KIND ? __expf(bd##S) : 0.f; \
        if ((c) + 4 < 32) R1_LOAD(S, (c) + 4); \
        if (w < ND) { \
            bf16_t* sp = ST + ((size_t)(c) * 128 + vs * 32) * DK + 32 * w + (lane & 31); \
            const float dec = KIND ? decn : g64; \
            _Pragma("unroll") for (int r = 0; r < 16; ++r) { sp[(size_t)crow(r, hh) * DK] = (bf16_t)f2bf(acc[r]); acc[r] *= dec; } \
            _Pragma("unroll") for (int ks = 0; ks < 4; ++ks) acc = __builtin_amdgcn_mfma_f32_32x32x16_bf16(tr_frag((lptr)(LAS unsigned char*)bufV, ks, lane), tr_frag((lptr)(LAS unsigned char*)bufK + w * 4096, ks, lane), acc, 0, 0, 0); \
        } \
        __syncthreads(); } while (0)
    R1_DECL(0) R1_DECL(1) R1_DECL(2) R1_DECL(3)
    R1_LOAD(0, 0); R1_LOAD(1, 1); R1_LOAD(2, 2); R1_LOAD(3, 3);
#pragma unroll 1
    for (int c = 0; c < 32; c += 4) { R1_STEP(0, c); R1_STEP(1, c + 1); R1_STEP(2, c + 2); R1_STEP(3, c + 3); }
#undef R1_DECL
#undef R1_LOAD
#undef R1_STEP
}
__device__ __forceinline__ void p_lin_r1(CArgs& A, const Frame& F) {
    const int v = F.bid, r = v & 127;
    if (v < 128) r1_item<0>(A, F, r >> 2, r & 3); else r1_item<1>(A, F, r >> 2, r & 3);
}

template <int KIND> struct R2Regs {
    static constexpr int DK = KIND ? 64 : 128, NQP = 64 * DK / 8 / 512, NSP = 128 * DK / 8 / 512;
    u32x4 q[NQP], k[NQP], v[2], s[NSP], g[2]; f32x4 bq[NQP][2];
};
template <int KIND> __device__ __forceinline__ void r2_load(CArgs& A, const Frame& F, R2Regs<KIND>& R, int bh, int c) {
    constexpr int DK = KIND ? 64 : 128;
    constexpr int QCOL = KIND ? 2048 : 0, KCOL = KIND ? 2304 : 512, VCOL = KIND ? 2560 : 1024, GCOL = KIND ? 3072 : 1536;
    const int b = bh >> 2, h = bh & 3, tid = F.tid, lane = F.lane, w = F.wave, hh = lane >> 5, l31 = lane & 31, rb = w >> 2, cb = w & 3;
    const bf16_t* zc = P_Z + (size_t)(b * SEQ + c * 64) * ZP1;
    const bf16_t* ST = (KIND ? P_GST : P_RST) + ((size_t)bh * 32 + c) * 128 * DK;
#pragma unroll
    for (int r = 0; r < R2Regs<KIND>::NQP; ++r) { const int q = tid + 512 * r, i = q / (DK / 8), d8 = q % (DK / 8);
        R.q[r] = *(const u32x4*)(zc + (size_t)i * ZP1 + QCOL + h * DK + d8 * 8); R.k[r] = *(const u32x4*)(zc + (size_t)i * ZP1 + KCOL + h * DK + d8 * 8);
        if (KIND) { const float* bp = P_LOGA + (size_t)(b * SEQ + c * 64 + i) * 256 + h * 64 + d8 * 8; R.bq[r][0] = *(const f32x4*)bp; R.bq[r][1] = *(const f32x4*)(bp + 4); } }
#pragma unroll
    for (int r = 0; r < 2; ++r) { const int q = tid + 512 * r, j = q >> 4, v8 = q & 15; R.v[r] = *(const u32x4*)(zc + (size_t)j * ZP1 + VCOL + h * 128 + v8 * 8); }
#pragma unroll
    for (int r = 0; r < R2Regs<KIND>::NSP; ++r) { const int q = tid + 512 * r, vr = q / (DK / 8), d8 = q % (DK / 8); R.s[r] = *(const u32x4*)(ST + (size_t)vr * DK + d8 * 8); }
#pragma unroll
    for (int k2 = 0; k2 < 2; ++k2) { const int pp = lane + 64 * k2; R.g[k2] = *(const u32x4*)(zc + (size_t)(32 * rb + (pp >> 2)) * ZP1 + GCOL + h * 128 + 32 * cb + 8 * (pp & 3)); }
}
template <int KIND> struct R2Lds { static constexpr int DK = KIND ? 64 : 128, LDQ = (DK + 8) * 2, OFF_K = 64 * LDQ, OFF_V = 2 * 64 * LDQ, OFF_S = OFF_V + 16384, OFF_SSQ = OFF_S + 128 * LDQ, OFF_BC = OFF_SSQ + 1024; };
template <int KIND> __device__ __forceinline__ void r2_stage(const Frame& F, const R2Regs<KIND>& R, u32x4 (&gc)[2]) {
    typedef R2Lds<KIND> LL; constexpr int DK = LL::DK, LDQ = LL::LDQ;
    const int tid = F.tid; unsigned char* L = F.lds;
#pragma unroll
    for (int r = 0; r < R2Regs<KIND>::NQP; ++r) { const int q = tid + 512 * r, i = q / (DK / 8), d8 = q % (DK / 8);
        u32x4 qw = R.q[r], kw = R.k[r];
        if (KIND) { float fq[8], fk[8]; unpack8(qw, fq); unpack8(kw, fk);
#pragma unroll
            for (int e = 0; e < 8; ++e) { const float bb = R.bq[r][e >> 2][e & 3]; fq[e] *= __expf(bb); fk[e] *= __expf(-bb); }
            qw = repack8(fq); kw = repack8(fk); }
        *(u32x4*)(L + i * LDQ + d8 * 16) = qw; *(u32x4*)(L + LL::OFF_K + i * LDQ + d8 * 16) = kw; }
#pragma unroll
    for (int r = 0; r < 2; ++r) { const int q = tid + 512 * r, j = q >> 4, v8 = q & 15; *(u32x4*)(L + LL::OFF_V + (v8 >> 2) * 4096 + j * 64 + (v8 & 3) * 16) = R.v[r]; }
#pragma unroll
    for (int r = 0; r < R2Regs<KIND>::NSP; ++r) { const int q = tid + 512 * r, vr = q / (DK / 8), d8 = q % (DK / 8); *(u32x4*)(L + LL::OFF_S + vr * LDQ + d8 * 16) = R.s[r]; }
    gc[0] = R.g[0]; gc[1] = R.g[1];
    __syncthreads();
}
template <int KIND> __device__ __forceinline__ void r2_compute(CArgs& A, const Frame& F, int bh, int c, const u32x4 (&gc)[2]) {
    typedef R2Lds<KIND> LL; constexpr int DK = LL::DK, LDQ = LL::LDQ, OFF_K = LL::OFF_K, OFF_V = LL::OFF_V, OFF_S = LL::OFF_S;
    constexpr int OCOL = KIND ? 512 : 0;
    const int b = bh >> 2, h = bh & 3, lane = F.lane, w = F.wave, hh = lane >> 5, l31 = lane & 31, rb = w >> 2, cb = w & 3;
    unsigned char* L = F.lds; float* ssq = (float*)(L + LL::OFF_SSQ);
    const float log2g = KIND ? 0.f : log2f(1.f - exp2f(-5.f - (float)h));
    const lptr L3 = (lptr)(LAS unsigned char*)L;
    bf16x8 pa[2][2];
#pragma unroll
    for (int jt = 0; jt < 2; ++jt) {
        f32x16 p = {0.f, 0.f, 0.f, 0.f, 0.f, 0.f, 0.f, 0.f, 0.f, 0.f, 0.f, 0.f, 0.f, 0.f, 0.f, 0.f};
        if (jt <= rb) {
#pragma unroll
            for (int ks = 0; ks < DK / 16; ++ks) p = __builtin_amdgcn_mfma_f32_32x32x16_bf16(nat_frag(L3 + OFF_K, LDQ, 32 * jt, 16 * ks, lane), nat_frag(L3, LDQ, 32 * rb, 16 * ks, lane), p, 0, 0, 0);
        }
        const int i = 32 * rb + l31;
        float f[16];
#pragma unroll
        for (int r = 0; r < 16; ++r) { const int j = 32 * jt + crow(r, hh); float x = (i >= j) ? p[r] : 0.f; if (!KIND) x *= exp2f((float)(i - j) * log2g); f[r] = (i >= j) ? x : 0.f; }
#pragma unroll
        for (int s = 0; s < 2; ++s) { u32x4 wv; wv.x = pk2(f[8 * s], f[8 * s + 1]); wv.y = pk2(f[8 * s + 2], f[8 * s + 3]); wv.z = pk2(f[8 * s + 4], f[8 * s + 5]); wv.w = pk2(f[8 * s + 6], f[8 * s + 7]); pa[jt][s] = __builtin_bit_cast(bf16x8, wv); }
    }
    f32x16 o1 = {0.f, 0.f, 0.f, 0.f, 0.f, 0.f, 0.f, 0.f, 0.f, 0.f, 0.f, 0.f, 0.f, 0.f, 0.f, 0.f}, o2 = o1;
#pragma unroll
    for (int jt = 0; jt < 2; ++jt)
#pragma unroll
        for (int s = 0; s < 2; ++s) o1 = __builtin_amdgcn_mfma_f32_32x32x16_bf16(pa[jt][s], tr_frag(L3 + OFF_V + cb * 4096, 2 * jt + s, lane), o1, 0, 0, 0);
#pragma unroll
    for (int ks = 0; ks < DK / 16; ++ks) o2 = __builtin_amdgcn_mfma_f32_32x32x16_bf16(nat_frag(L3, LDQ, 32 * rb, 16 * ks, lane), nat_frag(L3 + OFF_S, LDQ, 32 * cb, 16 * ks, lane), o2, 0, 0, 0);
    float o[16];
#pragma unroll
    for (int r = 0; r < 16; ++r) { const int i = 32 * rb + crow(r, hh); const float xi = KIND ? 1.f : exp2f((float)(i + 1) * log2g); o[r] = o1[r] + xi * o2[r];
        const float sq = half_sum(o[r] * o[r]); if (l31 == 0) ssq[i * 4 + cb] = sq; }
    __syncthreads();
    float* Os = (float*)L + w * (32 * 33);
#pragma unroll
    for (int r = 0; r < 16; ++r) Os[crow(r, hh) * 33 + l31] = o[r];
    LDS_WAIT();
#pragma unroll
    for (int k2 = 0; k2 < 2; ++k2) { const int pp = lane + 64 * k2, rw = pp >> 2, ch = pp & 3, i = 32 * rb + rw;
        const f32x4 s4 = *(const f32x4*)(ssq + i * 4);
        const float rn = rsqrtf(((s4.x + s4.y) + (s4.z + s4.w)) * (1.f / 128.f) + EPS);
        float gv[8]; unpack8(gc[k2], gv); float y[8];
#pragma unroll
        for (int e = 0; e < 8; ++e) y[e] = siluf_(gv[e]) * Os[rw * 33 + 8 * ch + e] * rn;
        *(u32x4*)(P_YCAT + (size_t)(b * SEQ + c * 64 + i) * DM + OCOL + h * 128 + 32 * cb + 8 * ch) = repack8(y); }
    __syncthreads();
}
template <int KIND> __device__ __forceinline__ void r2_run(CArgs& A, const Frame& F0, int first, int n, int stride) {
    R2Regs<KIND> R; u32x4 gc[2];
    { Frame G2 = F0; int t_ = F0.tid; asm volatile("" : "+v"(t_)); G2.tid = t_; G2.lane = t_ & 63; r2_load<KIND>(A, G2, R, (first & 1023) >> 5, first & 31); }
#pragma unroll 1
    for (int i = 0; i < n; ++i) {
        Frame G2 = F0; { int t_ = F0.tid; asm volatile("" : "+v"(t_)); G2.tid = t_; G2.lane = t_ & 63; }
        const int r = (first + i * stride) & 1023;
        r2_stage<KIND>(G2, R, gc);
        if (i + 1 < n) { const int rn = (first + (i + 1) * stride) & 1023; r2_load<KIND>(A, G2, R, rn >> 5, rn & 31); }
        r2_compute<KIND>(A, G2, r >> 5, r & 31, gc);
    }
}
__device__ __forceinline__ void p_lin_r2(CArgs& A, const Frame& F) {
    r2_run<0>(A, F, F.bid, 4, F.G);
    r2_run<1>(A, F, 1024 + F.bid, 4, F.G);
}
}
#define XB_TMO      128
#define XB_XCNT(j)  (256  + 64 * (j))
#define XB_XSUB(j)  (1280 + 64 * (j))
#define XB_XGEN(j)  (2304 + 64 * (j))
#define XB_TOP      3328
#define XB_TOPGEN   3392
#define XCD_BAR_WORDS 3456
#define XB_SPIN_CAP (1u << 18)
__device__ __forceinline__ unsigned xb_ld(unsigned* p)              { return __hip_atomic_load(p, __ATOMIC_RELAXED, __HIP_MEMORY_SCOPE_AGENT); }
__device__ __forceinline__ unsigned xb_add(unsigned* p, unsigned v) { return __hip_atomic_fetch_add(p, v, __ATOMIC_RELAXED, __HIP_MEMORY_SCOPE_AGENT); }
__device__ __forceinline__ unsigned xb_xcc_id() { return (unsigned)__builtin_amdgcn_s_getreg((3 << 11) | 20) & 0xFu; }
#define XB_SPIN(cond, bar) do { unsigned _sp = 0; while (cond) { __builtin_amdgcn_s_sleep(1); \
    if ((++_sp & 255u) == 0u) { if (xb_ld(&(bar)[XB_TMO])) break; if (_sp > XB_SPIN_CAP) { atomicAdd(&(bar)[XB_TMO], 1u); break; } } } } while (0)
struct XcdBarrier { unsigned* bar; unsigned x; volatile LAS unsigned* st; };
__device__ __forceinline__ XcdBarrier xcd_barrier_post(unsigned* bar, volatile LAS unsigned* st, int tid) {
    XcdBarrier b; b.bar = bar; b.x = xb_xcc_id(); b.st = st;
    if (tid == 0) (void)xb_add(&bar[XB_XCNT(b.x)], 1u);
    return b;
}
__device__ __forceinline__ void xcd_barrier_complete(unsigned* bar, unsigned x, unsigned& nloc, unsigned& nx) {
    const unsigned G = gridDim.x * gridDim.y * gridDim.z;
    unsigned sum, cnt, mine, sp = 0u;
    for (;;) {
        sum = 0u; cnt = 0u; mine = 0u;
#pragma unroll
        for (unsigned j = 0; j < 16; ++j) { const unsigned c = xb_ld(&bar[XB_XCNT(j)]); sum += c; cnt += (c > 0u) ? 1u : 0u; mine = (j == x) ? c : mine; }
        if (sum == G) break;
        __builtin_amdgcn_s_sleep(1);
        if ((++sp & 255u) == 0u) { if (xb_ld(&bar[XB_TMO])) break; if (sp > XB_SPIN_CAP) { atomicAdd(&bar[XB_TMO], 1u); break; } }
    }
    nloc = mine > 0u ? mine : 1u; nx = cnt > 0u ? cnt : 1u;
}
__device__ __forceinline__ void xcd_barrier(const XcdBarrier& b, int tid) {
    asm volatile("s_waitcnt vmcnt(0)" ::: "memory");
    __syncthreads();
    if (tid == 0) {
        unsigned* bar = b.bar;
        __builtin_amdgcn_s_waitcnt(0);
        unsigned nloc = b.st[0], nx = b.st[1];
        if (nloc == 0u) { xcd_barrier_complete(bar, b.x, nloc, nx); b.st[0] = nloc; b.st[1] = nx; }
        const unsigned old = xb_add(&bar[XB_XSUB(b.x)], 1u);
        const unsigned gen = old / nloc;
        if (old + 1u == (gen + 1u) * nloc) {
            __builtin_amdgcn_fence(__ATOMIC_RELEASE, "agent");
            asm volatile("s_waitcnt vmcnt(0)" ::: "memory");
            const unsigned og = xb_add(&bar[XB_TOP], 1u);
            const unsigned tg = og / nx;
            if (og + 1u == (tg + 1u) * nx) xb_add(&bar[XB_TOPGEN], 1u);
            else XB_SPIN(xb_ld(&bar[XB_TOPGEN]) == tg, bar);
            __builtin_amdgcn_fence(__ATOMIC_ACQUIRE, "agent");
            xb_add(&bar[XB_XGEN(b.x)], 1u);
            asm volatile("s_waitcnt vmcnt(0)" ::: "memory");
        } else {
            XB_SPIN(xb_ld(&bar[XB_XGEN(b.x)]) == gen, bar);
            __builtin_amdgcn_fence(__ATOMIC_ACQUIRE, "agent");
            asm volatile("s_waitcnt vmcnt(0)" ::: "memory");
        }
    }
    __syncthreads();
}
#define REFRESH() do { int t_ = F.wave * 64 + lane_id(); asm volatile("" : "+v"(t_)); F.tid = t_; F.lane = t_ & 63; asm volatile("" : "+s"(ap)); int b_ = blockIdx.x; asm volatile("" : "+s"(b_)); F.bid = b_; } while (0)
#define A (*ap)
#define GSYNC() do { REFRESH(); xcd_barrier(xb, F.tid); } while (0)
template <int l> __device__ __forceinline__ void layer_fwd(CArgs*& ap, Frame& F, const XcdBarrier& xb, unsigned char* lds, LAS unsigned char* lds3, LAS pg8::MoeTables* tb) {
    if (l == 0) {
        { REFRESH(); pg8::DenseOrder S; S.init(P_HB, P_WINE, NTOK, 2048, 1024, F.G, F.bid); pg8::EpiZ0 E{P_Z};
          pg8::gemm_phase<pg8::EpiZ0, pg8::DenseOrder, true>(lds3, F.wave, 1024, S, E); }
        GSYNC();
        REFRESH(); fox_fast(A, F);
        __syncthreads();
        REFRESH(); s5_fast(A, F, F.bid);
        GSYNC();
        { REFRESH(); pg8::DenseOrder S; S.init(P_G5, P_WGLU, NTOK, 512, 512, F.G, F.bid); pg8::EpiGlu E{P_G5, A.in[I_GLUB], P_YCAT};
          pg8::gemm_phase<pg8::EpiGlu, pg8::DenseOrder, true>(lds3, F.wave, 512, S, E); }
        GSYNC();
    } else {
        REFRESH(); lin::gla_prefix(A, F, F.bid);
        { REFRESH(); pg8::DenseOrder S; S.init(P_HB, P_WINO, NTOK, 3584, 1024, F.G, F.bid); pg8::EpiZ1 E{P_Z, P_ROPE};
          pg8::gemm_phase<pg8::EpiZ1, pg8::DenseOrder, true>(lds3, F.wave, 1024, S, E); }
        GSYNC();
        REFRESH(); lin::p_lin_r1(A, F);
        GSYNC();
        REFRESH(); lin::p_lin_r2(A, F);
        GSYNC();
    }
    { REFRESH(); pg8::DenseOrder S; S.init(P_YCAT, l == 0 ? P_WOUTE : P_WOUTO, NTOK, 1024, 1024, F.G, F.bid); pg8::EpiBf16Plain E{(bf16_t*)P_MBUF, DM};
      pg8::gemm_phase<pg8::EpiBf16Plain, pg8::DenseOrder, true>(lds3, F.wave, 1024, S, E); }
    GSYNC();
    REFRESH(); p_postmix(A, F, l);
    GSYNC();
    REFRESH(); const int MT = moe_tables(A, F, l, tb);
    {
        const int mX = (MT >> 5) << 5, kk = MT - mX, rr = (64 - ((2 * kk) & 63)) & 63;
        const int mY = mX >= rr ? rr + (((mX - rr) >> 6) << 6) : 0;
        if (mX > 0) {
            { REFRESH(); pg8::MoeOrder<true> S; S.Ap = (const char*)P_HB8; S.Bt = (const char*)(P_W1 + (size_t)l * 32 * 2048 * 1024); S.estride = (size_t)2048 * 1024; S.K = 512; S.NP = 8; S.nwg = mX * 8; S.G = F.G; S.c = F.bid; S.mt0 = 0;
              S.list_tk = P_LTK + (size_t)l * 32 * LISTCAP; S.tb = tb;
              pg8::EpiSwiglu E{P_ACT, A.in[I_BGU] + (size_t)l * 32 * 2048};
              pg8::gemm_phase<pg8::EpiSwiglu, pg8::MoeOrder<true>, true, true>(lds3, F.wave, 512, S, E); }
            GSYNC();
        }
        if (8 * (MT - mX) + 4 * mY > 0) {
            { REFRESH(); pg8::MoeMixOrder S; S.ws = (const char*)A.ws; S.l = l;
              S.a0 = mX; S.nA = 8 * (MT - mX); S.b0 = 0; S.nB = 4 * mY; S.nwg = S.nA + S.nB; S.G = F.G; S.c = F.bid; S.tb = tb;
              pg8::EpiMoeMix E{ap, l};
              pg8::gemm_phase<pg8::EpiMoeMix, pg8::MoeMixOrder, true, true>(lds3, F.wave, 512, S, E); }
            GSYNC();
        }
        if (MT > mY) {
            { REFRESH(); pg8::MoeOrder<false> S; S.Ap = (const char*)P_ACT; S.Bt = (const char*)(P_W2 + (size_t)l * 32 * 1024 * 1024); S.estride = (size_t)1024 * 1024; S.K = 512; S.NP = 4; S.nwg = (MT - mY) * 4; S.G = F.G; S.c = F.bid; S.mt0 = mY;
              S.list_tk = P_LTK + (size_t)l * 32 * LISTCAP; S.tb = tb;
              pg8::EpiDown E{P_Y, A.in[I_BDN] + (size_t)l * 32 * 1024, P_LTK + (size_t)l * 32 * LISTCAP, P_LG + (size_t)l * 32 * LISTCAP};
              pg8::gemm_phase<pg8::EpiDown, pg8::MoeOrder<false>, true, true>(lds3, F.wave, 512, S, E); }
            GSYNC();
        }
    }
    REFRESH(); p_combine(A, F, l);
}

__global__ void __launch_bounds__(512, 2) mk_fwd(Args A_) {
    extern __shared__ __attribute__((aligned(16))) unsigned char lds[];
    cg::grid_group grid = cg::this_grid();
    CArgs* ap = (CArgs*)__builtin_amdgcn_kernarg_segment_ptr();
    Frame F;
    F.lds = lds; F.wave = __builtin_amdgcn_readfirstlane((int)threadIdx.x >> 6); F.tid = 0; F.lane = 0; F.bid = blockIdx.x; F.G = gridDim.x;
    LAS unsigned char* lds3 = (LAS unsigned char*)lds;
    LAS pg8::MoeTables* tb = (LAS pg8::MoeTables*)(lds3 + 133632);
    { volatile LAS unsigned* st = (volatile LAS unsigned*)(lds3 + (LDS_BYTES - 64)); REFRESH(); if (F.tid < 2) st[F.tid] = 0u; __syncthreads(); }
    XcdBarrier xb = xcd_barrier_post((unsigned*)(A.ws + WS_CTL) + 10240, (volatile LAS unsigned*)(lds3 + (LDS_BYTES - 64)), F.tid);
    REFRESH(); p0_prep(A, F);
    if (A.pad != 0) grid.sync();
    GSYNC();
    REFRESH(); p1_hprep0(A, F);
    GSYNC();
    layer_fwd<0>(ap, F, xb, lds, lds3, tb);
    GSYNC();
    layer_fwd<1>(ap, F, xb, lds, lds3, tb);
}
#undef A

extern "C" void kernel_launch(void* const* d_in, const int* in_sizes, int n_in, void* d_out, int out_size, void* d_ws, size_t ws_size, hipStream_t stream) {
    static int grid = 0;
    if (grid == 0) {
        if (n_in != 31 || out_size != NTOK * DM || ws_size < WS_END) { fprintf(stderr, "kernel_launch: unexpected problem (n_in %d out %d ws %zu)\n", n_in, out_size, ws_size); grid = -1; return; }
        int dev = 0, cus = 0, per_cu = 0;
        if (hipGetDevice(&dev) != hipSuccess || hipDeviceGetAttribute(&cus, hipDeviceAttributeMultiprocessorCount, dev) != hipSuccess) { grid = -1; return; }
        if (hipFuncSetAttribute((const void*)mk_fwd, hipFuncAttributeMaxDynamicSharedMemorySize, LDS_BYTES) != hipSuccess) { fprintf(stderr, "kernel_launch: hipFuncSetAttribute failed\n"); grid = -1; return; }
        if (hipOccupancyMaxActiveBlocksPerMultiprocessor(&per_cu, (const void*)mk_fwd, 512, LDS_BYTES) != hipSuccess || per_cu < 1) { fprintf(stderr, "kernel_launch: occupancy query says %d blocks per CU\n", per_cu); (void)hipGetLastError(); }
        grid = cus;
        if (grid != 256) fprintf(stderr, "kernel_launch: %d CUs; this kernel is built for a 256-CU grid\n", grid);
    }
    if (grid < 0) return;
    if (hipMemsetAsync((char*)d_ws + WS_CTL, 0, CTL_ZERO_BYTES, stream) != hipSuccess) { fprintf(stderr, "kernel_launch: memset failed\n"); return; }
    Args a{};
    for (int i = 0; i < 31; ++i) a.in[i] = (const float*)d_in[i];
    a.out = (float*)d_out; a.ws = (unsigned char*)d_ws;
    void* kargs[] = {&a};
    const hipError_t e = hipLaunchCooperativeKernel((const void*)mk_fwd, dim3(grid), dim3(512), kargs, LDS_BYTES, stream);
    if (e != hipSuccess) fprintf(stderr, "kernel_launch: cooperative launch failed: %s (grid %d)\n", hipGetErrorString(e), grid);
}
```

```cpp
#include <hip/hip_runtime.h>
#include <hip/hip_cooperative_groups.h>
#include <cstdio>
#include <cstdint>
namespace cg = cooperative_groups;

#define LAS __attribute__((address_space(3)))
typedef unsigned short bf16_t;
typedef short bf16x8 __attribute__((ext_vector_type(8)));
typedef float f32x4 __attribute__((ext_vector_type(4)));
typedef float f32x2 __attribute__((ext_vector_type(2)));
typedef unsigned u32x4 __attribute__((ext_vector_type(4)));
typedef unsigned u32x2 __attribute__((ext_vector_type(2)));
typedef int i32x4 __attribute__((ext_vector_type(4)));
typedef int i32x8 __attribute__((ext_vector_type(8)));

constexpr int NTOK = 16384, DM = 1024, SEQ = 2048, NB = 8;
constexpr int NEXP = 32, LISTCAP = 16384;
constexpr float EPS = 1e-6f;
constexpr float LOG2E = 1.4426950408889634f;
constexpr float C2 = 0.125f * LOG2E;
constexpr int ZP0 = 2048, ZP1 = 3584;

constexpr size_t MiB = 1u << 20;
constexpr size_t WS_CTL = 0, CTL_ZERO_BYTES = 65536;
constexpr size_t WS_MOD = 1 * MiB;
constexpr size_t WS_WSIDE = 1 * MiB + 512 * 1024;
constexpr size_t WS_S5A = 2 * MiB;
constexpr size_t WS_S5BB = 2 * MiB + 65536;
constexpr size_t WS_S5CK = 2 * MiB + 512 * 1024;
constexpr size_t WS_ROPE = 3 * MiB;
constexpr size_t WS_LTK = 4 * MiB;
constexpr size_t WS_LG = 8 * MiB;
constexpr size_t WS_WINE = 16 * MiB, WS_WGLU = 20 * MiB, WS_WOUTE = 21 * MiB, WS_WINO = 23 * MiB, WS_WOUTO = 30 * MiB;
constexpr size_t WS_W1 = 32 * MiB;
constexpr size_t WS_HB8 = 160 * MiB;
constexpr size_t WS_W2 = 288 * MiB;
constexpr size_t WS_HB = 416 * MiB;
constexpr size_t WS_Z = 448 * MiB;
constexpr size_t WS_LSIG = 560 * MiB;
constexpr size_t WS_LOGA = 562 * MiB;
constexpr size_t WS_G5 = 578 * MiB;
constexpr size_t WS_YCAT = 594 * MiB;
constexpr size_t WS_MBUF = 626 * MiB;
constexpr size_t WS_ACT = 690 * MiB;
constexpr size_t WS_Y = 834 * MiB;
constexpr size_t WS_RST = 962 * MiB;
constexpr size_t WS_GST = 994 * MiB;
constexpr size_t WS_XB = 1010 * MiB;
constexpr size_t WS_END = 1042 * MiB;
constexpr int CW_CNT = 1024;

constexpr int RING_BYTES = 131072;
constexpr int MISC_OFF = RING_BYTES;
constexpr int LDS_BYTES = 147456;

__device__ __forceinline__ unsigned f2bf(float f) { unsigned u = __builtin_bit_cast(unsigned, f); return (u + 0x7fffu + ((u >> 16) & 1u)) >> 16; }
typedef __bf16 bf16x2_hw __attribute__((ext_vector_type(2)));
__device__ __forceinline__ unsigned pk2(float lo, float hi) { const f32x2 v = {lo, hi}; return __builtin_bit_cast(unsigned, __builtin_convertvector(v, bf16x2_hw)); }
__device__ __forceinline__ float bflo(unsigned w) { return __builtin_bit_cast(float, w << 16); }
__device__ __forceinline__ float bfhi(unsigned w) { return __builtin_bit_cast(float, w & 0xffff0000u); }
__device__ __forceinline__ float bf1(bf16_t b) { return __builtin_bit_cast(float, ((unsigned)b) << 16); }
__device__ __forceinline__ int lane_id() { int l; asm volatile("v_mbcnt_lo_u32_b32 %0, -1, 0\n\tv_mbcnt_hi_u32_b32 %0, -1, %0" : "=v"(l)); return l; }
template <int CTRL> __device__ __forceinline__ float dppf(float v) { return __builtin_bit_cast(float, __builtin_amdgcn_update_dpp(0, __builtin_bit_cast(int, v), CTRL, 0xf, 0xf, true)); }
__device__ __forceinline__ float row16_sum(float v) {
    v += dppf<0xB1>(v); v += dppf<0x4E>(v); v += dppf<0x141>(v); v += dppf<0x140>(v); return v;
}
__device__ __forceinline__ float rdlane(float v, int l) { return __builtin_bit_cast(float, __builtin_amdgcn_readlane(__builtin_bit_cast(int, v), l)); }
__device__ __forceinline__ float wave_sum(float v) {
    v = row16_sum(v); return (rdlane(v, 0) + rdlane(v, 16)) + (rdlane(v, 32) + rdlane(v, 48));
}
__device__ __forceinline__ float half_sum(float v) {
    v = row16_sum(v); const float a = rdlane(v, 0) + rdlane(v, 16), b = rdlane(v, 32) + rdlane(v, 48); return (lane_id() < 32) ? a : b;
}
__device__ __forceinline__ float sigmoidf_(float x) { return __builtin_amdgcn_rcpf(1.f + __expf(-x)); }
__device__ __forceinline__ float log_sigmoidf_(float x) { return fminf(x, 0.f) - log1pf(__expf(-fabsf(x))); }
__device__ __forceinline__ float siluf_(float x) { return x * sigmoidf_(x); }
__device__ __forceinline__ float gelu_tanh(float x) { const float u2 = 1.5957691216057308f * (x + 0.044715f * x * x * x); return x * sigmoidf_(u2); }
constexpr float SC_H = 16.f, SC_W1 = 512.f, SC_A = 8.f, SC_W2 = 512.f, SC_WIN = 512.f;
__device__ __forceinline__ unsigned pk8(float a, float b, float c, float d) {
    a = __builtin_amdgcn_fmed3f(a, -448.f, 448.f); b = __builtin_amdgcn_fmed3f(b, -448.f, 448.f); c = __builtin_amdgcn_fmed3f(c, -448.f, 448.f); d = __builtin_amdgcn_fmed3f(d, -448.f, 448.f);
    int r = __builtin_amdgcn_cvt_pk_fp8_f32(a, b, 0, false); r = __builtin_amdgcn_cvt_pk_fp8_f32(c, d, r, true); return (unsigned)r;
}
#define LDS_WAIT() asm volatile("s_waitcnt lgkmcnt(0)" ::: "memory")

struct Args { const float* in[31]; float* out; unsigned char* ws; long long pad; };
typedef const __attribute__((address_space(4))) Args CArgs;
enum { I_X = 0, I_C, I_ADAW, I_ADAB, I_NPM, I_NQM, I_NPF, I_NQF, I_EVWIN, I_FOXB, I_LAMRE, I_LAMIM, I_LOGDT, I_BRE, I_BIM, I_CRE, I_CIM, I_S5D, I_GLUW, I_GLUB, I_EVWOUT,
       I_ODWIN, I_GLAWUP, I_GLABG, I_ODWOUT, I_RW, I_RB, I_WGU, I_BGU, I_WDN, I_BDN };

namespace pg8 {
constexpr int BM = 256, BK = 64, HALF = 128, HTB = HALF * BK * 2, STAGE_BYTES = 8 * HTB, NXCD = 8, WGM = 8;
__device__ __forceinline__ int lds_byte(int r, int c) { const int st = (r >> 4) * 2 + (c >> 5), rr = r & 15, cc = c & 31, ob = rr * 64 + cc * 2; return st * 1024 + (ob ^ (((ob >> 9) & 1) << 5)); }
__device__ __forceinline__ void stage_rc(int b, int& R, int& C) { const int st = b / 1024, sb = b % 1024, swz = sb ^ (((sb >> 9) & 1) << 5); R = (st >> 1) * 16 + swz / 64; C = (st & 1) * 32 + (swz % 64) / 2; }
__device__ __forceinline__ int perm32(int rho) { const int n = rho >> 4, i = rho & 15; return 8 * (i >> 2) + 4 * n + (i & 3); }
__device__ __forceinline__ unsigned cvt_pk_bf16(float lo, float hi) { unsigned r; asm volatile("v_cvt_pk_bf16_f32 %0, %1, %2" : "=v"(r) : "v"(lo), "v"(hi)); return r; }

struct Unit { int pm, pn, e, mb, nrows, kind; };
__device__ __forceinline__ int xcd_remap(int L, int nwg) { const int q = nwg / NXCD, r = nwg % NXCD, xcd = L % NXCD, off = L / NXCD; return (xcd < r ? xcd * (q + 1) : r * (q + 1) + (xcd - r) * q) + off; }

struct DenseOrder {
    const char* Ap; const char* Bt; int K, nM, nN, nwg, G, c;
    __device__ __forceinline__ void init(const void* A_, const void* Bt_, int M, int N, int K_, int G_, int c_) { Ap = (const char*)A_; Bt = (const char*)Bt_; K = K_; nM = M / BM; nN = N / BM; nwg = nM * nN; G = G_; c = c_; }
    __device__ __forceinline__ bool next(int i, Unit& u) const {
        const long L = (long)i * G + c; if (L >= nwg) return false;
        const int wgid = xcd_remap((int)L, nwg);
        const int nig = WGM * nN, gid = wgid / nig, fm = gid * WGM, gsz = (nM - fm) < WGM ? (nM - fm) : WGM;
        u.pm = fm + ((wgid % nig) % gsz); u.pn = (wgid % nig) / gsz; u.e = 0; u.mb = u.pm; u.nrows = BM; u.kind = 0; return true;
    }
    __device__ __forceinline__ const char* a_base(const Unit& u) const { return Ap + (size_t)u.pm * ((size_t)BM * K * 2); }
    __device__ __forceinline__ const char* b_base(const Unit& u) const { return Bt + (size_t)u.pn * ((size_t)BM * K * 2); }
    __device__ __forceinline__ void a_raw(const Unit&, const int (&)[2], int (&raw)[2][2]) const { raw[0][0] = raw[0][1] = raw[1][0] = raw[1][1] = 0; }
    __device__ __forceinline__ void a_offs(const Unit&, const int (&R)[2], const int (&C)[2], const int (&)[2][2], unsigned (&v)[2][2]) const {
#pragma unroll
        for (int h = 0; h < 2; ++h)
#pragma unroll
            for (int i = 0; i < 2; ++i) v[h][i] = (unsigned)((h * HALF + R[i]) * K + C[i]) * 2u;
    }
};
struct MoeTables { int cnt[NEXP]; int mtstart[NEXP + 1]; unsigned char tile_e[320]; };
template <bool GATHER> struct MoeOrder {
    const char* Ap; const char* Bt; size_t estride; int K, NP, nwg, G, c, mt0; const int* list_tk; const LAS MoeTables* tb;
    __device__ __forceinline__ bool next(int i, Unit& u) const {
        const long L = (long)i * G + c; if (L >= nwg) return false;
        const int w = xcd_remap((int)L, nwg);
        const int mq = w / NP, mt = mt0 + mq; u.pn = w - mq * NP; u.pm = mt; u.e = tb->tile_e[mt]; u.mb = mt - tb->mtstart[u.e];
        const int left = tb->cnt[u.e] - u.mb * BM; u.nrows = left < BM ? left : BM; u.kind = GATHER ? 0 : 1; return true;
    }
    __device__ __forceinline__ const char* a_base(const Unit& u) const { return GATHER ? Ap : Ap + (size_t)u.pm * ((size_t)BM * K * 2); }
    __device__ __forceinline__ const char* b_base(const Unit& u) const { return Bt + (size_t)u.e * estride + (size_t)u.pn * ((size_t)BM * K * 2); }
    __device__ __forceinline__ void a_raw(const Unit& u, const int (&R)[2], int (&raw)[2][2]) const {
#pragma unroll
        for (int h = 0; h < 2; ++h)
#pragma unroll
            for (int i = 0; i < 2; ++i) { if (GATHER) { const int r = h * HALF + R[i], rc = r < u.nrows ? r : 0; raw[h][i] = list_tk[u.e * LISTCAP + u.mb * BM + rc]; } else raw[h][i] = 0; }
    }
    __device__ __forceinline__ void a_offs(const Unit&, const int (&R)[2], const int (&C)[2], const int (&raw)[2][2], unsigned (&v)[2][2]) const {
#pragma unroll
        for (int h = 0; h < 2; ++h)
#pragma unroll
            for (int i = 0; i < 2; ++i) {
                if (GATHER) v[h][i] = (unsigned)((raw[h][i] >> 2) * K + C[i]) * 2u;
                else v[h][i] = (unsigned)((h * HALF + R[i]) * K + C[i]) * 2u;
            }
    }
};

struct MoeMixOrder {
    const char* ws; int l, a0, nA, b0, nB, nwg, G, c; const LAS MoeTables* tb;
    static constexpr int K = 512;
    __device__ __forceinline__ bool next(int i, Unit& u) const {
        const long L = (long)i * G + c; if (L >= nwg) return false;
        int w = xcd_remap((int)L, nwg), mt;
        if (w < nA) { u.kind = 0; mt = a0 + (w >> 3); u.pn = w & 7; } else { w -= nA; u.kind = 1; mt = b0 + (w >> 2); u.pn = w & 3; }
        u.pm = mt; u.e = tb->tile_e[mt]; u.mb = mt - tb->mtstart[u.e];
        const int left = tb->cnt[u.e] - u.mb * BM; u.nrows = left < BM ? left : BM; return true;
    }
    __device__ __forceinline__ const char* a_base(const Unit& u) const { return u.kind ? ws + WS_ACT : ws + WS_HB8; }
    __device__ __forceinline__ const char* b_base(const Unit& u) const { return u.kind ? ws + WS_W2 + (size_t)(l * 32 + u.e) * ((size_t)1024 * K * 2) + (size_t)u.pn * ((size_t)BM * K * 2) : ws + WS_W1 + (size_t)(l * 32 + u.e) * ((size_t)2048 * K * 2) + (size_t)u.pn * ((size_t)BM * K * 2); }
    __device__ __forceinline__ void a_raw(const Unit& u, const int (&R)[2], int (&raw)[2][2]) const {
#pragma unroll
        for (int h = 0; h < 2; ++h)
#pragma unroll
            for (int i = 0; i < 2; ++i) { const int r = h * HALF + R[i], rc = r < u.nrows ? r : 0; raw[h][i] = u.kind ? 4 * (u.pm * BM + r) : ((const int*)(ws + WS_LTK))[(l * 32 + u.e) * LISTCAP + u.mb * BM + rc]; }
    }
    __device__ __forceinline__ void a_offs(const Unit& u, const int (&R)[2], const int (&C)[2], const int (&raw)[2][2], unsigned (&v)[2][2]) const {
#pragma unroll
        for (int h = 0; h < 2; ++h)
#pragma unroll
            for (int i = 0; i < 2; ++i) v[h][i] = (unsigned)((raw[h][i] >> 2) * K + C[i]) * 2u;
    }
};

template <class Epi, class Sched, bool ALIGN_EPI, bool FP8 = false>
__device__ __forceinline__ void gemm_phase(LAS unsigned char* lds, const int wave_, const int K, const Sched& S, const Epi& E) {
    int tid_ = wave_ * 64 + lane_id(); asm volatile("" : "+v"(tid_));
    const int tid = tid_, wid = wave_, lane = tid & 63, wr = wid >> 2, wc = wid & 3, fr = lane & 15, fq = lane >> 4;
    int nt_ = K / BK; if constexpr (FP8) asm volatile("" : "+s"(nt_));
    const int nt = nt_;
    int Rr[2], Cc[2]; unsigned voffB[2];
#pragma unroll
    for (int i = 0; i < 2; ++i) { stage_rc(tid * 16 + i * 8192, Rr[i], Cc[i]); const int Rb = Epi::PERM ? ((Rr[i] & ~31) + perm32(Rr[i] & 31)) : Rr[i]; voffB[i] = (unsigned)(Rb * K + Cc[i]) * 2u; }
    const size_t kstep = (size_t)(BK * 2);
    const size_t hstep = (size_t)HALF * K * 2;
    const unsigned ldsw = (unsigned)wid * 1024u;
    const int aoff = lds_byte(wr * 64 + fr, fq * 8), boff = lds_byte(wc * 32 + fr, fq * 8);
#define PG8_SA(b, h) (((b) * 2 + (h)) * HTB)
#define PG8_SB(b, h) ((4 + (b) * 2 + (h)) * HTB)
#define PG8_STAGE(bufoff, gbase, voff) do { _Pragma("unroll") for (int _i = 0; _i < 2; ++_i) { unsigned vo_ = (voff)[_i]; if constexpr (FP8) asm volatile("" : "+v"(vo_));   \
        __builtin_amdgcn_global_load_lds((const unsigned*)((const char*)(gbase) + vo_), (LAS unsigned*)(lds + (bufoff) + ldsw + _i * 8192), 16, 0, 0); } } while (0)
#define PG8_LDA(dst, b, h) do { _Pragma("unroll") for (int m = 0; m < 4; ++m) { \
        if constexpr (FP8) { const i32x4 lo_ = *(const LAS i32x4*)(lds + PG8_SA(b, h) + aoff + m * 2048), hi_ = *(const LAS i32x4*)(lds + PG8_SA(b, h) + aoff + m * 2048 + 1024); dst##8[m] = __builtin_shufflevector(lo_, hi_, 0, 1, 2, 3, 4, 5, 6, 7); } \
        else { _Pragma("unroll") for (int k = 0; k < 2; ++k) dst[m][k] = *(const LAS bf16x8*)(lds + PG8_SA(b, h) + aoff + m * 2048 + k * 1024); } } } while (0)
#define PG8_LDB(dst, b, h) do { _Pragma("unroll") for (int n = 0; n < 2; ++n) { \
        if constexpr (FP8) { const i32x4 lo_ = *(const LAS i32x4*)(lds + PG8_SB(b, h) + boff + n * 2048), hi_ = *(const LAS i32x4*)(lds + PG8_SB(b, h) + boff + n * 2048 + 1024); dst##8[n] = __builtin_shufflevector(lo_, hi_, 0, 1, 2, 3, 4, 5, 6, 7); } \
        else { _Pragma("unroll") for (int k = 0; k < 2; ++k) dst[n][k] = *(const LAS bf16x8*)(lds + PG8_SB(b, h) + boff + n * 2048 + k * 1024); } } } while (0)
#define PG8_MMA(ai, bj, At, Bt) do { __builtin_amdgcn_s_setprio(1); _Pragma("unroll") for (int m = 0; m < 4; ++m) _Pragma("unroll") for (int n = 0; n < 2; ++n) { \
        if constexpr (FP8) asm volatile("v_mfma_f32_16x16x128_f8f6f4 %0, %1, %2, %0" : "+v"(acc[ai][bj][m][n]) : "v"(Bt##8[n]), "v"(At##8[m]));   \
        else { _Pragma("unroll") for (int k = 0; k < 2; ++k) acc[ai][bj][m][n] = __builtin_amdgcn_mfma_f32_16x16x32_bf16(Bt[n][k], At[m][k], acc[ai][bj][m][n], 0, 0, 0); } } \
        __builtin_amdgcn_s_setprio(0); } while (0)
#define PG8_WAIT_V(n) asm volatile("s_waitcnt vmcnt(" #n ")" ::: "memory")
#define PG8_WAIT_L(n) asm volatile("s_waitcnt lgkmcnt(" #n ")" ::: "memory")
#define PG8_BAR __builtin_amdgcn_s_barrier()
#define PG8_SCHED __builtin_amdgcn_sched_barrier(0)
    Unit cur, nxt; int ui = 0;
    if (!S.next(0, cur)) return;
    f32x4 acc[2][2][4][2];
#pragma unroll
    for (int a = 0; a < 2; ++a)
#pragma unroll
        for (int b = 0; b < 2; ++b)
#pragma unroll
            for (int m = 0; m < 4; ++m)
#pragma unroll
                for (int n = 0; n < 2; ++n) acc[a][b][m][n] = (f32x4){0.f, 0.f, 0.f, 0.f};
    bf16x8 At[4][2], B0[2][2], B1[2][2]; i32x8 At8[4], B08[2], B18[2];
    const char* cA = S.a_base(cur); const char* cB = S.b_base(cur);
    unsigned cv[2][2], nv[2][2]; int raw[2][2];
    S.a_raw(cur, Rr, raw); S.a_offs(cur, Rr, Cc, raw, cv);
    PG8_STAGE(PG8_SB(0, 0), cB, voffB); PG8_STAGE(PG8_SB(0, 1), cB + hstep, voffB); PG8_STAGE(PG8_SA(0, 0), cA, cv[0]); PG8_STAGE(PG8_SA(0, 1), cA, cv[1]);
    if (wr == 1) PG8_BAR;
    PG8_WAIT_V(2); PG8_BAR;
    PG8_STAGE(PG8_SB(1, 0), cB + kstep, voffB); PG8_STAGE(PG8_SA(1, 0), cA + kstep, cv[0]); PG8_STAGE(PG8_SB(1, 1), cB + hstep + kstep, voffB);
    PG8_WAIT_V(6); PG8_BAR;
    for (;;) {
        const bool has_next = S.next(ui + 1, nxt);
        const char* nA = has_next ? S.a_base(nxt) : cA; const char* nB = has_next ? S.b_base(nxt) : cB;
        if (has_next) S.a_raw(nxt, Rr, raw);
#pragma unroll
        for (int h = 0; h < 2; ++h)
#pragma unroll
            for (int i = 0; i < 2; ++i) nv[h][i] = cv[h][i];
        for (int t = 0; t < nt; t += 2) {
            const bool last = (t == nt - 2);
            if (last && has_next) S.a_offs(nxt, Rr, Cc, raw, nv);
            const char* a1 = cA + (size_t)(t + 1) * kstep;
            const char* a2 = last ? nA : cA + (size_t)(t + 2) * kstep; const char* b2 = last ? nB : cB + (size_t)(t + 2) * kstep;
            const char* a3 = a2 + kstep; const char* b3 = b2 + kstep;
            unsigned v2[2][2];
#pragma unroll
            for (int h = 0; h < 2; ++h)
#pragma unroll
                for (int i = 0; i < 2; ++i) v2[h][i] = last ? nv[h][i] : cv[h][i];
            PG8_LDB(B0, 0, 0); PG8_LDB(B1, 0, 1); PG8_SCHED; PG8_LDA(At, 0, 0); PG8_STAGE(PG8_SA(1, 1), a1, cv[1]);
            PG8_WAIT_V(8); PG8_WAIT_L(0); PG8_BAR; PG8_MMA(0, 0, At, B0); PG8_MMA(0, 1, At, B1); PG8_BAR; PG8_SCHED;
            PG8_LDA(At, 0, 1); PG8_STAGE(PG8_SB(0, 0), b2, voffB); PG8_STAGE(PG8_SB(0, 1), b2 + hstep, voffB); PG8_STAGE(PG8_SA(0, 0), a2, v2[0]);
            PG8_WAIT_V(8); PG8_WAIT_L(0); PG8_BAR; PG8_MMA(1, 0, At, B0); PG8_MMA(1, 1, At, B1); PG8_BAR; PG8_SCHED;
            PG8_LDB(B0, 1, 0); PG8_LDB(B1, 1, 1); PG8_SCHED; PG8_LDA(At, 1, 0); PG8_STAGE(PG8_SA(0, 1), a2, v2[1]);
            PG8_WAIT_V(8); PG8_WAIT_L(0); PG8_BAR; PG8_MMA(0, 0, At, B0); PG8_MMA(0, 1, At, B1); PG8_BAR; PG8_SCHED;
            PG8_LDA(At, 1, 1); PG8_STAGE(PG8_SB(1, 0), b3, voffB); PG8_STAGE(PG8_SB(1, 1), b3 + hstep, voffB); PG8_STAGE(PG8_SA(1, 0), a3, v2[0]);
            PG8_WAIT_V(8); PG8_WAIT_L(0); PG8_BAR; PG8_MMA(1, 0, At, B0); PG8_MMA(1, 1, At, B1); PG8_BAR; PG8_SCHED;
        }
        if constexpr (ALIGN_EPI) { if (wr == 0) PG8_BAR; }
        if constexpr (FP8) asm volatile("s_nop 15\n\ts_nop 15" ::: "memory");
        E(acc, cur, wr, wc, fr, fq);
        if (!has_next) break;
#pragma unroll
        for (int a = 0; a < 2; ++a)
#pragma unroll
            for (int b = 0; b < 2; ++b)
#pragma unroll
                for (int m = 0; m < 4; ++m)
#pragma unroll
                    for (int n = 0; n < 2; ++n) acc[a][b][m][n] = (f32x4){0.f, 0.f, 0.f, 0.f};
        cur = nxt; cA = nA; cB = nB; ++ui;
#pragma unroll
        for (int h = 0; h < 2; ++h)
#pragma unroll
            for (int i = 0; i < 2; ++i) cv[h][i] = nv[h][i];
        if constexpr (ALIGN_EPI) { if (wr == 1) PG8_BAR; }
    }
    PG8_WAIT_V(0);
    if constexpr (!ALIGN_EPI) { if (wr == 0) PG8_BAR; }
    PG8_BAR;
#undef PG8_SA
#undef PG8_SB
#undef PG8_STAGE
#undef PG8_LDA
#undef PG8_LDB
#undef PG8_MMA
#undef PG8_WAIT_V
#undef PG8_WAIT_L
#undef PG8_BAR
#undef PG8_SCHED
}
}
namespace pg8 {
typedef f32x4 Acc[2][2][4][2];
struct EpiZ0 {
    static constexpr bool PERM = true;
    bf16_t* Z;
    __device__ __forceinline__ void operator()(const Acc& acc, const Unit& u, int wr, int wc, int fr, int fq) const {
        const float sc = (u.pn == 2 || u.pn == 3) ? C2 : 1.f;
        const int row0 = u.pm * BM + wr * 64 + fr, col0 = u.pn * BM + wc * 32 + 8 * fq;
#pragma unroll
        for (int ai = 0; ai < 2; ++ai)
#pragma unroll
            for (int m = 0; m < 4; ++m) { bf16_t* rowp = Z + (size_t)(row0 + ai * HALF + m * 16) * ZP0 + col0;
#pragma unroll
                for (int bj = 0; bj < 2; ++bj) { const f32x4 v0 = acc[ai][bj][m][0] * sc, v1 = acc[ai][bj][m][1] * sc;
                    u32x4 w; w.x = cvt_pk_bf16(v0[0], v0[1]); w.y = cvt_pk_bf16(v0[2], v0[3]); w.z = cvt_pk_bf16(v1[0], v1[1]); w.w = cvt_pk_bf16(v1[2], v1[3]);
                    *(u32x4*)(rowp + bj * HALF) = w; } }
    }
};
struct EpiZ1 {
    static constexpr bool PERM = true;
    bf16_t* Z; const float* rope;
    __device__ __forceinline__ void operator()(const Acc& acc, const Unit& u, int wr, int wc, int fr, int fq) const {
        constexpr float INV = 1.f / (SC_H * SC_WIN);
        const int row0 = u.pm * BM + wr * 64 + fr;
        if (u.pn < 4) {
            const float sc = (u.pn >= 2) ? 0.08838834764831845f * INV : INV;
            const int hl = wc >> 1, jj0 = 32 * (wc & 1) + 8 * fq;
#pragma unroll
            for (int ai = 0; ai < 2; ++ai)
#pragma unroll
                for (int m = 0; m < 4; ++m) { const int row = row0 + ai * HALF + m * 16, pos = row & (SEQ - 1);
                    const f32x4 c0 = *(const f32x4*)(rope + pos * 64 + jj0), c1 = *(const f32x4*)(rope + pos * 64 + jj0 + 4);
                    const f32x4 s0 = *(const f32x4*)(rope + SEQ * 64 + pos * 64 + jj0), s1 = *(const f32x4*)(rope + SEQ * 64 + pos * 64 + jj0 + 4);
                    const f32x4 x10 = acc[ai][0][m][0] * sc, x11 = acc[ai][0][m][1] * sc, x20 = acc[ai][1][m][0] * sc, x21 = acc[ai][1][m][1] * sc;
                    const f32x4 a0 = x10 * c0 - x20 * s0, a1 = x11 * c1 - x21 * s1, b0 = x10 * s0 + x20 * c0, b1 = x11 * s1 + x21 * c1;
                    bf16_t* rowp = Z + (size_t)row * ZP1 + u.pn * BM + 128 * hl + jj0;
                    u32x4 w; w.x = cvt_pk_bf16(a0[0], a0[1]); w.y = cvt_pk_bf16(a0[2], a0[3]); w.z = cvt_pk_bf16(a1[0], a1[1]); w.w = cvt_pk_bf16(a1[2], a1[3]);
                    *(u32x4*)(rowp) = w;
                    w.x = cvt_pk_bf16(b0[0], b0[1]); w.y = cvt_pk_bf16(b0[2], b0[3]); w.z = cvt_pk_bf16(b1[0], b1[1]); w.w = cvt_pk_bf16(b1[2], b1[3]);
                    *(u32x4*)(rowp + 64) = w; }
        } else {
            const float sc = (u.pn == 8) ? 0.125f * INV : INV;
            const int col0 = u.pn * BM + wc * 32 + 8 * fq;
#pragma unroll
            for (int ai = 0; ai < 2; ++ai)
#pragma unroll
                for (int m = 0; m < 4; ++m) { bf16_t* rowp = Z + (size_t)(row0 + ai * HALF + m * 16) * ZP1 + col0;
#pragma unroll
                    for (int bj = 0; bj < 2; ++bj) { const f32x4 v0 = acc[ai][bj][m][0] * sc, v1 = acc[ai][bj][m][1] * sc;
                        u32x4 w; w.x = cvt_pk_bf16(v0[0], v0[1]); w.y = cvt_pk_bf16(v0[2], v0[3]); w.z = cvt_pk_bf16(v1[0], v1[1]); w.w = cvt_pk_bf16(v1[2], v1[3]);
                        *(u32x4*)(rowp + bj * HALF) = w; } }
        }
    }
};
struct EpiGlu {
    static constexpr bool PERM = true;
    const bf16_t* G5; const float* bias; bf16_t* Y;
    __device__ __forceinline__ void operator()(const Acc& acc, const Unit& u, int wr, int wc, int fr, int fq) const {
        const int row0 = u.pm * BM + wr * 64 + fr, col0 = u.pn * BM + wc * 32 + 8 * fq;
        f32x4 bv[2][2];
#pragma unroll
        for (int bj = 0; bj < 2; ++bj)
#pragma unroll
            for (int n = 0; n < 2; ++n) bv[bj][n] = *(const f32x4*)(bias + col0 + bj * HALF + 4 * n);
#pragma unroll
        for (int ai = 0; ai < 2; ++ai)
#pragma unroll
            for (int m = 0; m < 4; ++m) { const size_t row = (size_t)(row0 + ai * HALF + m * 16);
#pragma unroll
                for (int bj = 0; bj < 2; ++bj) { const u32x4 gw = *(const u32x4*)(G5 + row * 512 + col0 + bj * HALF);
                    const f32x4 v0 = acc[ai][bj][m][0] + bv[bj][0], v1 = acc[ai][bj][m][1] + bv[bj][1];
                    float o[8]; o[0] = bflo(gw.x) * sigmoidf_(v0[0]); o[1] = bfhi(gw.x) * sigmoidf_(v0[1]); o[2] = bflo(gw.y) * sigmoidf_(v0[2]); o[3] = bfhi(gw.y) * sigmoidf_(v0[3]);
                    o[4] = bflo(gw.z) * sigmoidf_(v1[0]); o[5] = bfhi(gw.z) * sigmoidf_(v1[1]); o[6] = bflo(gw.w) * sigmoidf_(v1[2]); o[7] = bfhi(gw.w) * sigmoidf_(v1[3]);
                    u32x4 w; w.x = cvt_pk_bf16(o[0], o[1]); w.y = cvt_pk_bf16(o[2], o[3]); w.z = cvt_pk_bf16(o[4], o[5]); w.w = cvt_pk_bf16(o[6], o[7]);
                    *(u32x4*)(Y + row * DM + col0 + bj * HALF) = w; } }
    }
};
struct EpiF32 {
    static constexpr bool PERM = false;
    float* Cp; int ldc;
    __device__ __forceinline__ void operator()(const Acc& acc, const Unit& u, int wr, int wc, int fr, int fq) const {
        const int row0 = u.pm * BM + wr * 64 + fr, col0 = u.pn * BM + wc * 32 + 4 * fq;
#pragma unroll
        for (int ai = 0; ai < 2; ++ai)
#pragma unroll
            for (int m = 0; m < 4; ++m) { float* rowp = Cp + (size_t)(row0 + ai * HALF + m * 16) * ldc + col0;
#pragma unroll
                for (int bj = 0; bj < 2; ++bj)
#pragma unroll
                    for (int n = 0; n < 2; ++n) *(f32x4*)(rowp + bj * HALF + n * 16) = acc[ai][bj][m][n]; }
    }
};
struct EpiBf16Plain {
    static constexpr bool PERM = true;
    bf16_t* Cp; int ldc;
    __device__ __forceinline__ void operator()(const Acc& acc, const Unit& u, int wr, int wc, int fr, int fq) const {
        const int row0 = u.pm * BM + wr * 64 + fr, col0 = u.pn * BM + wc * 32 + 8 * fq;
#pragma unroll
        for (int ai = 0; ai < 2; ++ai)
#pragma unroll
            for (int m = 0; m < 4; ++m) { bf16_t* rowp = Cp + (size_t)(row0 + ai * HALF + m * 16) * ldc + col0;
#pragma unroll
                for (int bj = 0; bj < 2; ++bj) { const f32x4 v0 = acc[ai][bj][m][0], v1 = acc[ai][bj][m][1];
                    u32x4 w; w.x = cvt_pk_bf16(v0[0], v0[1]); w.y = cvt_pk_bf16(v0[2], v0[3]); w.z = cvt_pk_bf16(v1[0], v1[1]); w.w = cvt_pk_bf16(v1[2], v1[3]);
                    *(u32x4*)(rowp + bj * HALF) = w; } }
    }
};
struct EpiSwiglu {
    static constexpr bool PERM = true;
    unsigned char* ACT; const float* bgu;
    __device__ __forceinline__ void operator()(const Acc& acc, const Unit& u, int wr, int wc, int fr, int fq) const {
        constexpr float INV = 1.f / (SC_H * SC_W1), INVL = INV * SC_A, CE = -1.702f * LOG2E;
        const int row0 = u.pm * BM + wr * 64 + fr, j0 = wc * 32 + 8 * fq, colg = u.pn * 128 + j0;
        const float* bp = bgu + (size_t)u.e * 2048 + colg;
        f32x2 bg[4], bl[4];
#pragma unroll
        for (int p = 0; p < 4; ++p) { bg[p] = *(const f32x2*)(bp + 2 * p); bl[p] = (*(const f32x2*)(bp + 1024 + 2 * p) + 1.f) * SC_A; }
#pragma unroll
        for (int ai = 0; ai < 2; ++ai)
#pragma unroll
            for (int m = 0; m < 4; ++m) {
                f32x2 o[4];
#pragma unroll
                for (int p = 0; p < 4; ++p) {
                    const f32x4 ag = acc[ai][0][m][p >> 1], al = acc[ai][1][m][p >> 1];
                    const f32x2 g = (p & 1 ? (f32x2){ag[2], ag[3]} : (f32x2){ag[0], ag[1]}) * INV + bg[p], l = (p & 1 ? (f32x2){al[2], al[3]} : (f32x2){al[0], al[1]}) * INVL + bl[p];
                    const f32x2 a = {fminf(g.x, 7.f), fminf(g.y, 7.f)}, b = {__builtin_amdgcn_fmed3f(l.x, -6.f * SC_A, 8.f * SC_A), __builtin_amdgcn_fmed3f(l.y, -6.f * SC_A, 8.f * SC_A)};
                    const f32x2 t = a * CE; const f32x2 d = (f32x2){__builtin_amdgcn_exp2f(t.x), __builtin_amdgcn_exp2f(t.y)} + 1.f;
                    const f32x2 sg = {__builtin_amdgcn_rcpf(d.x), __builtin_amdgcn_rcpf(d.y)};
                    o[p] = (a * sg) * b; }
                u32x2 w; int r0 = __builtin_amdgcn_cvt_pk_fp8_f32(o[0].x, o[0].y, 0, false); r0 = __builtin_amdgcn_cvt_pk_fp8_f32(o[1].x, o[1].y, r0, true);
                int r1 = __builtin_amdgcn_cvt_pk_fp8_f32(o[2].x, o[2].y, 0, false); r1 = __builtin_amdgcn_cvt_pk_fp8_f32(o[3].x, o[3].y, r1, true);
                w.x = (unsigned)r0; w.y = (unsigned)r1;
                *(u32x2*)(ACT + (size_t)(row0 + ai * HALF + m * 16) * DM + colg) = w; }
    }
};
struct EpiDown {
    static constexpr bool PERM = true;
    bf16_t* Y; const float* bdn; const int* list_tk; const float* list_g;
    __device__ __forceinline__ void operator()(const Acc& acc, const Unit& u, int wr, int wc, int fr, int fq) const {
        constexpr float INV = 1.f / (SC_A * SC_W2);
        const int r0 = wr * 64 + fr, col0 = u.pn * BM + wc * 32 + 8 * fq;
        const float* bp = bdn + (size_t)u.e * DM + col0;
        f32x4 bv[2][2];
#pragma unroll
        for (int bj = 0; bj < 2; ++bj)
#pragma unroll
            for (int n = 0; n < 2; ++n) bv[bj][n] = *(const f32x4*)(bp + bj * HALF + 4 * n);
        const size_t lbase = (size_t)u.e * LISTCAP + (size_t)u.mb * BM;
        int tkv[2][4]; float gtv[2][4];
#pragma unroll
        for (int ai = 0; ai < 2; ++ai)
#pragma unroll
            for (int m = 0; m < 4; ++m) { const int r = r0 + ai * HALF + m * 16, rc = r < u.nrows ? r : 0; tkv[ai][m] = list_tk[lbase + rc]; gtv[ai][m] = list_g[lbase + rc]; }
#pragma unroll
        for (int ai = 0; ai < 2; ++ai)
#pragma unroll
            for (int m = 0; m < 4; ++m) { const int r = r0 + ai * HALF + m * 16;
                if (r < u.nrows) { const float gt = gtv[ai][m];
                    bf16_t* rowp = Y + (size_t)tkv[ai][m] * DM + col0;
#pragma unroll
                    for (int bj = 0; bj < 2; ++bj) { const float gi = gt * INV; const f32x4 v0 = acc[ai][bj][m][0] * gi + bv[bj][0] * gt, v1 = acc[ai][bj][m][1] * gi + bv[bj][1] * gt;
                        u32x4 w; w.x = cvt_pk_bf16(v0[0], v0[1]); w.y = cvt_pk_bf16(v0[2], v0[3]); w.z = cvt_pk_bf16(v1[0], v1[1]); w.w = cvt_pk_bf16(v1[2], v1[3]);
                        *(u32x4*)(rowp + bj * HALF) = w; } } }
    }
};
struct EpiMoeMix {
    static constexpr bool PERM = true;
    CArgs* ap; int l;
    __device__ __forceinline__ void operator()(const Acc& acc, const Unit& u, int wr, int wc, int fr, int fq) const {
        CArgs& A = *ap; unsigned char* ws = A.ws;
        if (u.kind == 0) { const EpiSwiglu sw{ws + WS_ACT, A.in[I_BGU] + (size_t)l * 32 * 2048}; sw(acc, u, wr, wc, fr, fq); }
        else { const EpiDown dn{(bf16_t*)(ws + WS_Y), A.in[I_BDN] + (size_t)l * 32 * 1024, (const int*)(ws + WS_LTK) + (size_t)l * 32 * LISTCAP, (const float*)(ws + WS_LG) + (size_t)l * 32 * LISTCAP}; dn(acc, u, wr, wc, fr, fq); }
    }
};
}
struct Frame { unsigned char* lds; int tid, lane, wave, bid, G; };
#define P_MOD   ((float*)(A.ws + WS_MOD))
#define P_S5A   ((float*)(A.ws + WS_S5A))
#define P_S5BB  ((float*)(A.ws + WS_S5BB))
#define P_ROPE  ((float*)(A.ws + WS_ROPE))
#define P_WSIDE ((float*)(A.ws + WS_WSIDE))
#define P_S5CK  ((bf16_t*)(A.ws + WS_S5CK))
#define P_LTK   ((int*)(A.ws + WS_LTK))
#define P_LG    ((float*)(A.ws + WS_LG))
#define P_CNT   ((unsigned*)(A.ws + WS_CTL) + CW_CNT)
#define P_WINE  (A.ws + WS_WINE)
#define P_WGLU  ((bf16_t*)(A.ws + WS_WGLU))
#define P_WOUTE ((bf16_t*)(A.ws + WS_WOUTE))
#define P_WINO  (A.ws + WS_WINO)
#define P_WOUTO ((bf16_t*)(A.ws + WS_WOUTO))
#define P_W1    (A.ws + WS_W1)
#define P_W2    (A.ws + WS_W2)
#define P_HB8   (A.ws + WS_HB8)
#define P_HB    (A.ws + WS_HB)
#define P_Z     ((bf16_t*)(A.ws + WS_Z))
#define P_G5    ((bf16_t*)(A.ws + WS_G5))
#define P_YCAT  ((bf16_t*)(A.ws + WS_YCAT))
#define P_ACT   (A.ws + WS_ACT)
#define P_Y     ((bf16_t*)(A.ws + WS_Y))
#define P_LSIG  ((float*)(A.ws + WS_LSIG))
#define P_LOGA  ((float*)(A.ws + WS_LOGA))
#define P_MBUF  ((float*)(A.ws + WS_MBUF))
#define P_XB    ((bf16_t*)(A.ws + WS_XB))
#define P_RST   ((bf16_t*)(A.ws + WS_RST))
#define P_GST   ((bf16_t*)(A.ws + WS_GST))

__device__ __forceinline__ void tr_tile(const float* __restrict__ src, int pitch, int k0, int c0, bf16_t* dst, int Kd, int r0, float* scr, int lane) {
#pragma unroll
    for (int i = 0; i < 16; ++i) {
        const int kk = 4 * i + (lane >> 4), cc = 4 * (lane & 15);
        const f32x4 v = __builtin_nontemporal_load((const f32x4*)(src + (size_t)(k0 + kk) * pitch + c0 + cc));
        float* s = scr + kk * 65 + cc; s[0] = v.x; s[1] = v.y; s[2] = v.z; s[3] = v.w;
    }
    LDS_WAIT();
    const int c = lane & 7;
#pragma unroll
    for (int j = 0; j < 8; ++j) { const int n = (lane >> 3) + 8 * j; const float* s = scr + (8 * c) * 65 + n;
        u32x4 o; o.x = pk2(s[0], s[65]); o.y = pk2(s[130], s[195]); o.z = pk2(s[260], s[325]); o.w = pk2(s[390], s[455]);
        __builtin_nontemporal_store(o, (u32x4*)(dst + (size_t)(r0 + n) * Kd + k0 + 8 * c)); }
    LDS_WAIT();
}
__device__ __forceinline__ void tr_tile8(const float* __restrict__ src, int pitch, int k0, int c0, unsigned char* dst, int Kd, int r0, float* scr, int lane, float scale) {
#pragma unroll
    for (int i = 0; i < 16; ++i) {
        const int kk = 4 * i + (lane >> 4), cc = 4 * (lane & 15);
        const f32x4 v = __builtin_nontemporal_load((const f32x4*)(src + (size_t)(k0 + kk) * pitch + c0 + cc));
        float* s = scr + kk * 65 + cc; s[0] = v.x * scale; s[1] = v.y * scale; s[2] = v.z * scale; s[3] = v.w * scale;
    }
    LDS_WAIT();
    const int c = lane & 3;
#pragma unroll
    for (int j = 0; j < 4; ++j) { const int n = (lane >> 2) + 16 * j; const float* s = scr + (16 * c) * 65 + n;
        u32x4 o; o.x = pk8(s[0], s[65], s[130], s[195]); o.y = pk8(s[260], s[325], s[390], s[455]); o.z = pk8(s[520], s[585], s[650], s[715]); o.w = pk8(s[780], s[845], s[910], s[975]);
        __builtin_nontemporal_store(o, (u32x4*)(dst + (size_t)(r0 + n) * Kd + k0 + 16 * c)); }
    LDS_WAIT();
}
__device__ __forceinline__ void p0_prep(CArgs& A, const Frame& F) {
    if (F.bid < 192) {
        float* sc = (float*)F.lds;
        float* red = sc + 8192;
        for (int i = F.tid; i < 8192; i += 512) sc[i] = siluf_(A.in[I_C][i]);
        __syncthreads();
        const int l = F.bid / 96, n = (F.bid % 96) * 64 + F.lane;
        const float* w = A.in[I_ADAW] + (size_t)l * 1024 * 6144 + n;
        float a[8];
#pragma unroll
        for (int b = 0; b < 8; ++b) a[b] = 0.f;
        for (int k = 128 * F.wave; k < 128 * F.wave + 128; ++k) { const float wv = w[(size_t)k * 6144];
#pragma unroll
            for (int b = 0; b < 8; ++b) a[b] += sc[b * 1024 + k] * wv; }
#pragma unroll
        for (int b = 0; b < 8; ++b) red[(F.wave * 8 + b) * 64 + F.lane] = a[b];
        __syncthreads();
        { const int b = F.tid >> 6, ln = F.tid & 63; float s = 0.f;
#pragma unroll
          for (int w8 = 0; w8 < 8; ++w8) s += red[(w8 * 8 + b) * 64 + ln];
          const int nn = (F.bid % 96) * 64 + ln; __hip_atomic_store(P_MOD + (size_t)(l * 8 + b) * 6144 + nn, s + A.in[I_ADAB][l * 6144 + nn], __ATOMIC_RELAXED, __HIP_MEMORY_SCOPE_AGENT); }
    }
    {
        const int gt = F.bid * 512 + F.tid;
        if (gt < 32 * 64) {
            const int g = gt >> 6;
            const float lr = A.in[I_LAMRE][gt], li = A.in[I_LAMIM][gt], dt = expf(A.in[I_LOGDT][g]);
            const float mag = expf(lr * dt); float sn, cs; sincosf(li * dt, &sn, &cs);
            const float are = mag * cs, aim = mag * sn, den = lr * lr + li * li, nre = are - 1.f, nim = aim;
            const float zre = (nre * lr + nim * li) / den, zim = (nim * lr - nre * li) / den;
            P_S5A[gt * 2] = are; P_S5A[gt * 2 + 1] = aim;
            for (int c = 0; c < 16; ++c) { const float br = A.in[I_BRE][gt * 16 + c], bi = A.in[I_BIM][gt * 16 + c];
                P_S5BB[gt * 32 + c] = zre * br - zim * bi; P_S5BB[gt * 32 + 16 + c] = zre * bi + zim * br; }
        }
        for (int i = gt; i < 32 * 16 * 128; i += F.G * 512) { const int k = i & 127, gc = i >> 7, pp = k >> 1; const float v = (k & 1) ? -A.in[I_CIM][gc * 64 + pp] : A.in[I_CRE][gc * 64 + pp]; P_S5CK[i] = (bf16_t)f2bf(v); }
        for (int i = gt; i < 24 * 1024; i += F.G * 512) { const int o = i >> 10, k = i & 1023; P_WSIDE[i] = o < 8 ? A.in[I_EVWIN][(size_t)k * 2056 + 2048 + o] : A.in[I_ODWIN][(size_t)k * 3600 + 3072 + (o - 8)]; }
        for (int i = gt; i < SEQ * 64; i += F.G * 512) { const int pos = i >> 6, j = i & 63;
            const float inv = exp2f(-(float)j * (13.287712379549449f / 64.f)); const float ang = (float)pos * inv; float sn, cs; sincosf(ang, &sn, &cs);
            P_ROPE[i] = cs; P_ROPE[SEQ * 64 + i] = sn; }
    }
    __syncthreads();
    float* scr = (float*)(F.lds) + F.wave * (64 * 65);
    const int gw = F.bid * 8 + F.wave, NGW = F.G * 8;
    constexpr int T0 = 16 * 32, T1 = 8 * 8, T2 = 16 * 16, T3 = 16 * 56, T4 = 16 * 16, T5 = 64 * 16 * 32, T6 = 64 * 16 * 16;
    constexpr int NTILES = T0 + T1 + T2 + T3 + T4 + T5 + T6;
    for (int it = gw; it < NTILES; it += NGW) {
        int r = it;
        if (r < T0) { const int kb = r / 32, nb = r % 32; tr_tile(A.in[I_EVWIN], 2056, kb * 64, nb * 64, (bf16_t*)P_WINE, 1024, nb * 64, scr, F.lane); continue; } r -= T0;
        if (r < T1) { const int kb = r / 8, nb = r % 8; tr_tile(A.in[I_GLUW], 512, kb * 64, nb * 64, P_WGLU, 512, nb * 64, scr, F.lane); continue; } r -= T1;
        if (r < T2) { const int kb = r / 16, nb = r % 16; tr_tile(A.in[I_EVWOUT], 1024, kb * 64, nb * 64, P_WOUTE, 1024, nb * 64, scr, F.lane); continue; } r -= T2;
        if (r < T3) { const int kb = r / 56, nb = r % 56; const int n0 = nb * 64; int c0;
            if (n0 < 1024) { const int pn = n0 >> 8, rem = n0 & 255, bj = rem >> 7, hl = (rem & 127) >> 6; c0 = 256 * pn + 128 * hl + 64 * bj; }
            else if (n0 < 3072) c0 = n0; else c0 = n0 + 16;
            tr_tile8(A.in[I_ODWIN], 3600, kb * 64, c0, P_WINO, 1024, n0, scr, F.lane, SC_WIN); continue; } r -= T3;
        if (r < T4) { const int kb = r / 16, nb = r % 16; tr_tile(A.in[I_ODWOUT], 1024, kb * 64, nb * 64, P_WOUTO, 1024, nb * 64, scr, F.lane); continue; } r -= T4;
        if (r < T5) { const int mat = r / 512, q = r % 512, kb = q / 32, nb = q % 32; const int n0 = nb * 64, pn = n0 >> 8, half = (n0 & 255) >> 7, j0 = n0 & 127;
            tr_tile8(A.in[I_WGU] + (size_t)mat * 1024 * 2048, 2048, kb * 64, half * 1024 + 128 * pn + j0, P_W1 + (size_t)mat * 2048 * 1024, 1024, n0, scr, F.lane, SC_W1); continue; } r -= T5;
        { const int mat = r / 256, q = r % 256, kb = q / 16, nb = q % 16;
            tr_tile8(A.in[I_WDN] + (size_t)mat * 1024 * 1024, 1024, kb * 64, nb * 64, P_W2 + (size_t)mat * 1024 * 1024, 1024, nb * 64, scr, F.lane, SC_W2); }
    }
}

struct Row { f32x4 v[4]; };
__device__ __forceinline__ void row_load(Row& r, const float* p, int lane) {
#pragma unroll
    for (int j = 0; j < 4; ++j) r.v[j] = __builtin_nontemporal_load((const f32x4*)(p + 4 * lane + 256 * j));
}
__device__ __forceinline__ void row_load_bf16(Row& r, const bf16_t* p, int lane) {
#pragma unroll
    for (int j = 0; j < 4; ++j) { const u32x2 w = __builtin_nontemporal_load((const u32x2*)(p + 4 * lane + 256 * j)); r.v[j] = (f32x4){bflo(w.x), bfhi(w.x), bflo(w.y), bfhi(w.y)}; }
}
__device__ __forceinline__ void row_store(const Row& r, float* p, int lane) {
#pragma unroll
    for (int j = 0; j < 4; ++j) __builtin_nontemporal_store(r.v[j], (f32x4*)(p + 4 * lane + 256 * j));
}
__device__ __forceinline__ void row_store_bf16(const Row& r, bf16_t* p, int lane) {
#pragma unroll
    for (int j = 0; j < 4; ++j) { u32x2 w; w.x = pk2(r.v[j].x, r.v[j].y); w.y = pk2(r.v[j].z, r.v[j].w); *(u32x2*)(p + 4 * lane + 256 * j) = w; }
}
__device__ __forceinline__ void row_store_bf16_nt(const Row& r, bf16_t* p, int lane) {
#pragma unroll
    for (int j = 0; j < 4; ++j) { u32x2 w; w.x = pk2(r.v[j].x, r.v[j].y); w.y = pk2(r.v[j].z, r.v[j].w); __builtin_nontemporal_store(w, (u32x2*)(p + 4 * lane + 256 * j)); }
}
__device__ __forceinline__ float row_rstd(const Row& r) {
    float s = 0.f;
#pragma unroll
    for (int j = 0; j < 4; ++j) s += (r.v[j].x * r.v[j].x + r.v[j].y * r.v[j].y) + (r.v[j].z * r.v[j].z + r.v[j].w * r.v[j].w);
    return rsqrtf(wave_sum(s) * (1.f / DM) + EPS);
}
__device__ __forceinline__ void row_modnorm(Row& h, const Row& x, const float* gain, const float* sh, const float* sc, int lane) {
    const float r = row_rstd(x);
#pragma unroll
    for (int j = 0; j < 4; ++j) { const int k = 4 * lane + 256 * j; const f32x4 g = *(const f32x4*)(gain + k), a = *(const f32x4*)(sc + k), b = *(const f32x4*)(sh + k);
        h.v[j] = x.v[j] * r * g * (a + 1.f) + b; }
}
__device__ __forceinline__ void hprep_row(CArgs& A, const Frame& F, const Row& x, int l, int row, const float* wl) {
    const int b = row >> 11, lane = F.lane; const float* mod = P_MOD + (size_t)(l * 8 + b) * 6144;
    Row h; row_modnorm(h, x, A.in[I_NPM] + l * DM, mod, mod + 1024, lane);
    if (l == 0) row_store_bf16(h, (bf16_t*)P_HB + (size_t)row * DM, lane);
    else {
#pragma unroll
        for (int j = 0; j < 4; ++j) *(unsigned*)(P_HB + (size_t)row * DM + 4 * lane + 256 * j) = pk8(SC_H * h.v[j].x, SC_H * h.v[j].y, SC_H * h.v[j].z, SC_H * h.v[j].w);
    }
    if (l == 0) {
        float mine = 0.f;
#pragma unroll
        for (int i = 0; i < 8; ++i) { float p = 0.f;
#pragma unroll
            for (int j = 0; j < 4; ++j) { const f32x4 w = *(const f32x4*)(wl + i * 1024 + 4 * lane + 256 * j); p += (h.v[j].x * w.x + h.v[j].y * w.y) + (h.v[j].z * w.z + h.v[j].w * w.w); }
            const float s = wave_sum(p); if (lane == i) mine = s; if ((i & 3) == 3) asm volatile("" ::: "memory"); }
        if (lane < 8) P_LSIG[(size_t)row * 8 + lane] = log_sigmoidf_(mine + A.in[I_FOXB][lane]);
    } else {
        float p[16];
#pragma unroll
        for (int i = 0; i < 16; ++i) { float q = 0.f;
#pragma unroll
            for (int j = 0; j < 4; ++j) { const f32x4 w = *(const f32x4*)(wl + i * 1024 + 4 * lane + 256 * j); q += (h.v[j].x * w.x + h.v[j].y * w.y) + (h.v[j].z * w.z + h.v[j].w * w.w); }
            p[i] = wave_sum(q); if ((i & 1) == 1) asm volatile("" ::: "memory"); }
        const float* wup = wl + 16 * 1024;
#pragma unroll
        for (int q = 0; q < 4; ++q) { const int jcol = lane + 64 * q; float s = wup[16 * 256 + jcol];
#pragma unroll
            for (int i = 0; i < 16; ++i) s += p[i] * wup[i * 256 + jcol];
            P_LOGA[(size_t)row * 256 + jcol] = log_sigmoidf_(s) * (1.f / 16.f); }
    }
}
__device__ __forceinline__ void stage_side(CArgs& A, const Frame& F, int l, float* wl) {
    __syncthreads();
    if (l == 0) { for (int i = F.tid; i < 8 * 256; i += 512) *(f32x4*)(wl + 4 * i) = *(const f32x4*)(P_WSIDE + 4 * i); }
    else { for (int i = F.tid; i < 16 * 256; i += 512) *(f32x4*)(wl + 4 * i) = *(const f32x4*)(P_WSIDE + 8192 + 4 * i);
           for (int i = F.tid; i < 16 * 64; i += 512) *(f32x4*)(wl + 16384 + 4 * i) = *(const f32x4*)(A.in[I_GLAWUP] + 4 * i);
           if (F.tid < 64) *(f32x4*)(wl + 16384 + 4096 + 4 * F.tid) = *(const f32x4*)(A.in[I_GLABG] + 4 * F.tid); }
    __syncthreads();
}
__device__ __forceinline__ void p1_hprep0(CArgs& A, const Frame& F) {
    float* wl = (float*)F.lds; stage_side(A, F, 0, wl);
    const int gw = F.bid * 8 + F.wave, NGW = F.G * 8;
    Row xn; if (gw < NTOK) row_load(xn, A.in[I_X] + (size_t)gw * DM, F.lane);
#pragma unroll 1
    for (int row = gw; row < NTOK; row += NGW) { Row x;
#pragma unroll
        for (int j = 0; j < 4; ++j) x.v[j] = xn.v[j];
        if (row + NGW < NTOK) row_load(xn, A.in[I_X] + (size_t)(row + NGW) * DM, F.lane); hprep_row(A, F, x, 0, row, wl); }
}

__device__ __forceinline__ void p_postmix(CArgs& A, const Frame& F, int l) {
    float* h2s = (float*)F.lds;
    float* red = h2s + 16 * 1028;
    float* lg = red + 8 * 16 * 32;
    float* tv = lg + 16 * 32;
    int* lcnt = (int*)(tv + 64);
    int* ent = lcnt + 64;
    if (F.tid < 32) lcnt[F.tid] = 0;
    int nent = 0;
    const float* rw = A.in[I_RW] + (size_t)l * 1024 * 32;
    u32x2 pm[2][4]; f32x4 pxf[2][4]; u32x2 pxb[2][4];
#define PM_LOAD(tile_) do { const int r0_ = (tile_) * 16 + 2 * F.wave; _Pragma("unroll") for (int rr = 0; rr < 2; ++rr) _Pragma("unroll") for (int j = 0; j < 4; ++j) { \
        pm[rr][j] = __builtin_nontemporal_load((const u32x2*)((const bf16_t*)P_MBUF + (size_t)(r0_ + rr) * DM + 4 * F.lane + 256 * j)); \
        if (l == 0) pxf[rr][j] = __builtin_nontemporal_load((const f32x4*)(A.in[I_X] + (size_t)(r0_ + rr) * DM + 4 * F.lane + 256 * j)); \
        else pxb[rr][j] = __builtin_nontemporal_load((const u32x2*)(P_XB + (size_t)(r0_ + rr) * DM + 4 * F.lane + 256 * j)); } } while (0)
    if (F.bid < NTOK / 16) PM_LOAD(F.bid);
#pragma unroll 1
    for (int tile = F.bid; tile < NTOK / 16; tile += F.G) {
        const int row0 = tile * 16 + 2 * F.wave;
        Row m0, x0, m1, x1;
#pragma unroll
        for (int j = 0; j < 4; ++j) { m0.v[j] = (f32x4){bflo(pm[0][j].x), bfhi(pm[0][j].x), bflo(pm[0][j].y), bfhi(pm[0][j].y)}; m1.v[j] = (f32x4){bflo(pm[1][j].x), bfhi(pm[1][j].x), bflo(pm[1][j].y), bfhi(pm[1][j].y)};
            if (l == 0) { x0.v[j] = pxf[0][j]; x1.v[j] = pxf[1][j]; }
            else { x0.v[j] = (f32x4){bflo(pxb[0][j].x), bfhi(pxb[0][j].x), bflo(pxb[0][j].y), bfhi(pxb[0][j].y)}; x1.v[j] = (f32x4){bflo(pxb[1][j].x), bfhi(pxb[1][j].x), bflo(pxb[1][j].y), bfhi(pxb[1][j].y)}; } }
        if (tile + F.G < NTOK / 16) PM_LOAD(tile + F.G);
#pragma unroll
        for (int rr = 0; rr < 2; ++rr) {
            const int lr = 2 * F.wave + rr, row = row0 + rr, b = row >> 11; const float* mod = P_MOD + (size_t)(l * 8 + b) * 6144;
            const Row& m = rr ? m1 : m0; Row x = rr ? x1 : x0;
            const float r1 = row_rstd(m);
#pragma unroll
            for (int j = 0; j < 4; ++j) { const int k = 4 * F.lane + 256 * j; const f32x4 gp = *(const f32x4*)(A.in[I_NQM] + l * DM + k), g1 = *(const f32x4*)(mod + 2048 + k);
                x.v[j] = x.v[j] + g1 * (m.v[j] * r1 * gp); }
            row_store_bf16_nt(x, P_XB + (size_t)row * DM, F.lane);
            Row h; row_modnorm(h, x, A.in[I_NPF] + l * DM, mod + 3072, mod + 4096, F.lane);
#pragma unroll
            for (int j = 0; j < 4; ++j) *(unsigned*)(P_HB8 + (size_t)row * DM + 4 * F.lane + 256 * j) = pk8(SC_H * h.v[j].x, SC_H * h.v[j].y, SC_H * h.v[j].z, SC_H * h.v[j].w);
#pragma unroll
            for (int j = 0; j < 4; ++j) *(f32x4*)(h2s + lr * 1028 + 4 * F.lane + 256 * j) = h.v[j];
        }
        __syncthreads();
        {
            f32x4 d0 = {0.f, 0.f, 0.f, 0.f}, d1 = {0.f, 0.f, 0.f, 0.f};
            const int r16 = F.lane & 15, kq = F.lane >> 4;
#pragma unroll 8
            for (int ks = 0; ks < 32; ++ks) { const int k = 128 * F.wave + 4 * ks + kq;
                const float a = h2s[r16 * 1028 + k]; const float b0 = rw[k * 32 + r16], b1 = rw[k * 32 + 16 + r16];
                d0 = __builtin_amdgcn_mfma_f32_16x16x4f32(a, b0, d0, 0, 0, 0); d1 = __builtin_amdgcn_mfma_f32_16x16x4f32(a, b1, d1, 0, 0, 0); }
#pragma unroll
            for (int q = 0; q < 4; ++q) { red[(F.wave * 16 + 4 * kq + q) * 32 + r16] = d0[q]; red[(F.wave * 16 + 4 * kq + q) * 32 + 16 + r16] = d1[q]; }
        }
        __syncthreads();
        const int r = F.tid >> 5, e = F.tid & 31;
        { float s = A.in[I_RB][l * 32 + e];
#pragma unroll
          for (int w8 = 0; w8 < 8; ++w8) s += red[(w8 * 16 + r) * 32 + e];
          lg[r * 32 + e] = s; }
        __syncthreads();
        const float v = lg[r * 32 + e]; int rank = 0;
#pragma unroll 8
        for (int q = 0; q < 32; ++q) { const float u = lg[r * 32 + q]; rank += (u > v || (u == v && q < e)) ? 1 : 0; }
        if (rank < 4) tv[r * 4 + rank] = v;
        __syncthreads();
        if (rank < 4) { const f32x4 t4 = *(const f32x4*)(tv + r * 4);
            const float wsum = 1.f + __expf(t4.y - t4.x) + __expf(t4.z - t4.x) + __expf(t4.w - t4.x), wk = __expf(v - t4.x);
            const int token = tile * 16 + r, lpos = atomicAdd(lcnt + e, 1), slot = nent + r * 4 + rank;
            ent[slot * 4] = e; ent[slot * 4 + 1] = lpos; ent[slot * 4 + 2] = token * 4 + rank; ent[slot * 4 + 3] = __float_as_int(wk / wsum); }
        nent += 64;
        __syncthreads();
    }
#undef PM_LOAD
    unsigned* cntp = P_CNT; int* ltk = P_LTK; float* lgp = P_LG;
    if (F.tid < 32) { const int n = lcnt[F.tid]; lcnt[32 + F.tid] = n > 0 ? (int)atomicAdd(cntp + 64 * (l * 32 + F.tid), (unsigned)n) : 0; }
    __syncthreads();
    if (F.tid < nent) { const int e = ent[F.tid * 4], pos = lcnt[32 + e] + ent[F.tid * 4 + 1];
        ltk[(size_t)(l * 32 + e) * LISTCAP + pos] = ent[F.tid * 4 + 2]; lgp[(size_t)(l * 32 + e) * LISTCAP + pos] = __int_as_float(ent[F.tid * 4 + 3]); }
    __syncthreads();
}
__device__ __forceinline__ void p_combine(CArgs& A, const Frame& F, int l) {
    float* wl = (float*)F.lds; if (l == 0) stage_side(A, F, 1, wl);
    const int gw = F.bid * 8 + F.wave, NGW = F.G * 8;
    u32x2 y[4][4]; Row xr;
#define COMB_LOAD(row_) do { _Pragma("unroll") for (int k = 0; k < 4; ++k) _Pragma("unroll") for (int j = 0; j < 4; ++j) y[k][j] = __builtin_nontemporal_load((const u32x2*)(P_Y + (size_t)((row_) * 4 + k) * DM + 4 * F.lane + 256 * j)); \
        row_load_bf16(xr, P_XB + (size_t)(row_) * DM, F.lane); } while (0)
    if (gw < NTOK) COMB_LOAD(gw);
#pragma unroll 1
    for (int row = gw; row < NTOK; row += NGW) {
        const int b = row >> 11; const float* mod = P_MOD + (size_t)(l * 8 + b) * 6144;
        Row f;
#pragma unroll
        for (int j = 0; j < 4; ++j) { f.v[j] = (f32x4){0.f, 0.f, 0.f, 0.f};
#pragma unroll
            for (int k = 0; k < 4; ++k) { const u32x2 w = y[k][j]; f.v[j].x += bflo(w.x); f.v[j].y += bfhi(w.x); f.v[j].z += bflo(w.y); f.v[j].w += bfhi(w.y); } }
        Row x = xr;
        if (row + NGW < NTOK) COMB_LOAD(row + NGW);
        const float r = row_rstd(f);
#pragma unroll
        for (int j = 0; j < 4; ++j) { const int k = 4 * F.lane + 256 * j; const f32x4 gp = *(const f32x4*)(A.in[I_NQF] + l * DM + k), g2 = *(const f32x4*)(mod + 5120 + k);
            x.v[j] = x.v[j] + g2 * (f.v[j] * r * gp); }
        if (l == 0) row_store_bf16_nt(x, P_XB + (size_t)row * DM, F.lane); else row_store(x, A.out + (size_t)row * DM, F.lane);
        if (l == 0) hprep_row(A, F, x, 1, row, wl);
    }
#undef COMB_LOAD
}
__device__ __forceinline__ int moe_tables(CArgs& A, const Frame& F, int l, LAS pg8::MoeTables* tb) {
    __syncthreads();
    if (F.tid < 32) tb->cnt[F.tid] = (int)__hip_atomic_load(P_CNT + 64 * (l * 32 + F.tid), __ATOMIC_RELAXED, __HIP_MEMORY_SCOPE_AGENT);
    __syncthreads();
    if (F.tid == 0) { int s = 0;
#pragma nounroll
        for (int e = 0; e < 32; ++e) { tb->mtstart[e] = s; s += (tb->cnt[e] + 255) >> 8; }
        tb->mtstart[32] = s; }
    __syncthreads();
    if (F.tid < 320) { int e = 0;
#pragma nounroll
        for (int q = 1; q < 32; ++q) if (tb->mtstart[q] <= F.tid) e = q;
        tb->tile_e[F.tid] = (unsigned char)e; }
    __syncthreads();
    return tb->mtstart[32];
}
__device__ __forceinline__ void fox_kbias(CArgs& A, const Frame& F, int b, int h, float* kb, float* wtot  ) {
    const int t0 = 4 * F.tid; float e[4];
#pragma unroll
    for (int i = 0; i < 4; ++i) e[i] = P_LSIG[(size_t)(b * SEQ + t0 + i) * 8 + h];
    const float s4 = (e[0] + e[1]) + (e[2] + e[3]); float v = s4;
#pragma unroll
    for (int o = 1; o < 64; o <<= 1) { const float tt = __shfl_up(v, o); if (F.lane >= o) v += tt; }
    if (F.lane == 63) wtot[F.wave] = v;
    __syncthreads();
    float off = 0.f;
#pragma unroll
    for (int w = 0; w < 8; ++w) if (w < F.wave) off += wtot[w];
    float c = off + v - s4;
#pragma unroll
    for (int i = 0; i < 4; ++i) { c += e[i]; kb[t0 + i] = -LOG2E * c; }
    __syncthreads();
}
#include <hip/hip_bf16.h>
namespace attn_body {
using bf16=__hip_bfloat16;
using bf16x8=__attribute__((ext_vector_type(8)))short;
using s16x4=__attribute__((ext_vector_type(4)))short;
using f32x16=__attribute__((ext_vector_type(16)))float;
using u32x4=__attribute__((ext_vector_type(4)))unsigned;
constexpr int BATCH=8,NHEAD=8,SEQ=2048,D=64,QP=2048,OP=1024;
constexpr int NW=8,QBLK=32,QB=QBLK*NW,KVBLK=64,NQB=SEQ/QB;
constexpr int ATTN_UNIT_ROWS=QB;
__device__ __forceinline__ int crow(int r,int hi){return (r&3)+8*(r>>2)+4*hi;}
#define SBAR() __builtin_amdgcn_sched_barrier(0)
__device__ __forceinline__ void cmask(f32x16&p0,f32x16&p1,int jb,int qrel,int hi){
  const float NEG=-INFINITY; int kb=64*jb+4*hi;
  #pragma unroll
  for(int r=0;r<16;++r){int kv=kb+(r&3)+8*(r>>2); if(kv>qrel)p0[r]=NEG; if(kv+32>qrel)p1[r]=NEG;}
}

constexpr int NSLOT=3, SLOTB=8192;
constexpr int LDS_K=0, LDS_V=NSLOT*SLOTB, LDS_WS=2*NSLOT*SLOTB, LDS_OST=LDS_WS+NW*64*4, LDS_BYTES=LDS_OST+NW*4096;
constexpr float C2=0.125f*1.4426950408889634f;
__device__ __forceinline__ void glds16(const void*gsrc,unsigned lds_dst){unsigned keep;
  asm volatile("s_mov_b32 %0, m0\n\ts_mov_b32 m0, %2\n\ts_nop 0\n\tglobal_load_lds_dwordx4 %1, off\n\ts_mov_b32 m0, %0":"=&s"(keep):"v"(gsrc),"s"(lds_dst):"memory");}
__device__ __forceinline__ float max3f(float a,float b,float c){float r;asm("v_max3_f32 %0, %1, %2, %3":"=v"(r):"v"(a),"v"(b),"v"(c));return r;}
__device__ __forceinline__ float max2f(float a,float b){float r;asm("v_max_f32_e32 %0, %1, %2":"=v"(r):"v"(a),"v"(b));return r;}
__device__ __forceinline__ float fadd_s(float a,float b){float r;asm("v_add_f32_e32 %0, %1, %2":"=v"(r):"v"(a),"v"(b));return r;}
__device__ __forceinline__ float fsub_s(float a,float b){float r;asm("v_sub_f32_e32 %0, %1, %2":"=v"(r):"v"(a),"v"(b));return r;}
typedef float f32x2_t __attribute__((ext_vector_type(2))); typedef float f32x4_t __attribute__((ext_vector_type(4))); typedef __bf16 bf16x2_t __attribute__((ext_vector_type(2)));
__device__ __forceinline__ unsigned cvtpk_s(float lo,float hi){f32x2_t v={lo,hi};bf16x2_t b=__builtin_convertvector(v,bf16x2_t);return __builtin_bit_cast(unsigned,b);}
#define WAIT_BAR(N) asm volatile("s_waitcnt vmcnt(" #N ") lgkmcnt(0)\n\ts_barrier":::"memory")

__device__ __forceinline__ void qkt(f32x16&p0,f32x16&p1,const char*Kslot,const bf16x8*qr,const f32x16&c0i,const f32x16&c1i,int r32,int hi){
  const char*kb=Kslot+hi*1024+r32*16;
  #pragma unroll
  for(int d0=0;d0<4;++d0){
    const bf16x8 b0=*reinterpret_cast<const bf16x8*>(kb+d0*2048);
    const bf16x8 b1=*reinterpret_cast<const bf16x8*>(kb+d0*2048+512);
    if(d0==0){p0=__builtin_amdgcn_mfma_f32_32x32x16_bf16(b0,qr[0],c0i,0,0,0);p1=__builtin_amdgcn_mfma_f32_32x32x16_bf16(b1,qr[0],c1i,0,0,0);}
    else{p0=__builtin_amdgcn_mfma_f32_32x32x16_bf16(b0,qr[d0],p0,0,0,0);p1=__builtin_amdgcn_mfma_f32_32x32x16_bf16(b1,qr[d0],p1,0,0,0);}}
}
typedef __attribute__((address_space(3))) const char* lds_cptr;
typedef short v4i16_t __attribute__((ext_vector_type(4)));
__device__ __forceinline__ void kload8(bf16x8*kf,lds_cptr kp){
  kf[0]=*(const __attribute__((address_space(3))) bf16x8*)(kp);      kf[1]=*(const __attribute__((address_space(3))) bf16x8*)(kp+512);
  kf[2]=*(const __attribute__((address_space(3))) bf16x8*)(kp+2048); kf[3]=*(const __attribute__((address_space(3))) bf16x8*)(kp+2560);
  kf[4]=*(const __attribute__((address_space(3))) bf16x8*)(kp+4096); kf[5]=*(const __attribute__((address_space(3))) bf16x8*)(kp+4608);
  kf[6]=*(const __attribute__((address_space(3))) bf16x8*)(kp+6144); kf[7]=*(const __attribute__((address_space(3))) bf16x8*)(kp+6656);
}
__device__ __forceinline__ void kload2(bf16x8*kf,lds_cptr kp,int j){ kf[2*j]=*(const __attribute__((address_space(3))) bf16x8*)(kp+j*2048); kf[2*j+1]=*(const __attribute__((address_space(3))) bf16x8*)(kp+j*2048+512); }
__device__ __forceinline__ s16x4 vtr(lds_cptr p){ return __builtin_bit_cast(s16x4,__builtin_amdgcn_ds_read_tr16_b64_v4i16((__attribute__((address_space(3))) v4i16_t*)p)); }
__device__ __forceinline__ float rowmax(const f32x16&p0,const f32x16&p1){
  float a=max3f(p0[0],p0[1],p1[0]),b=max3f(p0[2],p0[3],p1[1]);a=max3f(a,p1[2],p1[3]);
  #pragma unroll
  for(int r=4;r<16;r+=4){a=max3f(a,p0[r],p0[r+1]);b=max3f(b,p0[r+2],p0[r+3]);a=max3f(a,p1[r],p1[r+1]);b=max3f(b,p1[r+2],p1[r+3]);}
  const float m=max2f(a,b);
  auto rr=__builtin_amdgcn_permlane32_swap(__float_as_uint(m),__float_as_uint(m),false,false);
  return max2f(__uint_as_float(rr[0]),__uint_as_float(rr[1]));
}
__device__ __forceinline__ void pv(f32x16*o,int vb,bf16x8 pa0,bf16x8 pa1,bf16x8 pa2,bf16x8 pa3){
  #pragma unroll
  for(int d0=0;d0<2;++d0){s16x4 lo[4],hi[4];
    #pragma unroll
    for(int ks=0;ks<4;++ks){
      asm volatile("ds_read_b64_tr_b16 %0,%1 offset:%c2":"=&v"(lo[ks]):"v"(vb),"i"(d0*4096+ks*1024):"memory");
      asm volatile("ds_read_b64_tr_b16 %0,%1 offset:%c2":"=&v"(hi[ks]):"v"(vb),"i"(d0*4096+ks*1024+512):"memory");}
    asm volatile("s_waitcnt lgkmcnt(0)":::"memory");SBAR();
    #define PK(k) (bf16x8){lo[k][0],lo[k][1],lo[k][2],lo[k][3],hi[k][0],hi[k][1],hi[k][2],hi[k][3]}
    o[d0]=__builtin_amdgcn_mfma_f32_32x32x16_bf16(pa0,PK(0),o[d0],0,0,0);
    o[d0]=__builtin_amdgcn_mfma_f32_32x32x16_bf16(pa1,PK(1),o[d0],0,0,0);
    o[d0]=__builtin_amdgcn_mfma_f32_32x32x16_bf16(pa2,PK(2),o[d0],0,0,0);
    o[d0]=__builtin_amdgcn_mfma_f32_32x32x16_bf16(pa3,PK(3),o[d0],0,0,0);
    #undef PK
  }
}

#ifndef ATTN_STORE16
#define ATTN_STORE16(p,v) (*(u32x4*)(p)=(v))
#endif
typedef const __attribute__((address_space(3))) float* lds_fptr;
template<int THRL> __device__ __forceinline__ void attn_unit(int b,int h,int qb,const bf16*Q,const bf16*__restrict__ K,const bf16*__restrict__ V,bf16*O,char*shm,lds_fptr kb,int tid,int wid){
  const int lane=tid&63,r32=lane&31,hi=lane>>5;
  const long rowbase=(long)b*SEQ; const int q0=qb*QB;
  const bf16*Qw=Q+(rowbase+q0+wid*QBLK)*QP+h*D;
  const bf16*Kh=K+rowbase*QP+h*D,*Vh=V+rowbase*QP+h*D;
  const unsigned lds0=(unsigned)(uintptr_t)shm;
  float*wsf=(float*)(shm+LDS_WS)+wid*64;
  const bf16*ksrc=Kh+(long)lane*QP+wid*8;
  const bf16*vsrc=Vh+(long)(16*(wid&3)+(lane>>2))*QP+(wid>>2)*32+(lane&3)*8;
  const unsigned kdst=lds0+LDS_K+wid*1024, vdst=lds0+LDS_V+wid*1024;
  #define DMA_K(t,slot) glds16(ksrc+(long)(t)*KVBLK*QP,(unsigned)__builtin_amdgcn_readfirstlane(kdst+(slot)))
  #define DMA_V(t,slot) glds16(vsrc+(long)(t)*KVBLK*QP,(unsigned)__builtin_amdgcn_readfirstlane(vdst+(slot)))
  const int vb0=(int)(lds0+LDS_V)+((lane>>4)&1)*32+(lane&3)*8+(4*hi+((lane&15)>>2))*64;
  const char*Kbase=shm+LDS_K; bf16x8 kf[8];
  const lds_cptr shm3=(lds_cptr)shm; const lds_cptr kp0=shm3+LDS_K+hi*1024+r32*16; const lds_cptr vp0=shm3+LDS_V+((lane>>4)&1)*32+(lane&3)*8+(4*hi+((lane&15)>>2))*64;
  const int NT=(q0+QB)/KVBLK;
  DMA_K(0,0);DMA_V(0,0);DMA_K(1,SLOTB);
  bf16x8 qr[4];
  #pragma unroll
  for(int d0=0;d0<4;++d0)qr[d0]=*reinterpret_cast<const bf16x8*>(&Qw[(long)r32*QP+d0*16+hi*8]);
  float mhat=0.f,l_reg=0.f;f32x16 o[2];o[0]=f32x16{};o[1]=f32x16{};float nm=0.f;
  #define BIASFILL(C0,C1,t) do{ const lds_fptr kbt_=kb+64*(t)+4*hi; _Pragma("unroll") for(int g_=0;g_<4;++g_){ const f32x4_t v0_=*(const __attribute__((address_space(3))) f32x4_t*)(kbt_+8*g_), v1_=*(const __attribute__((address_space(3))) f32x4_t*)(kbt_+32+8*g_); \
      _Pragma("unroll") for(int i_=0;i_<4;++i_){ C0[4*g_+i_]=v0_[i_]+nm; C1[4*g_+i_]=v1_[i_]+nm; } } }while(0)
  const int qrel=wid*QBLK+r32;
  #define CMASK(P0,P1,t) do{int jb_=(t)-(NT-4); if(jb_>=0)cmask(P0,P1,jb_,qrel,hi);}while(0)
  bool resc=false;
  #define START(P0,P1) do{ const float rm=rowmax(P0,P1); resc=false; \
    { const float dl=rm; mhat=fadd_s(mhat,dl); \
      _Pragma("unroll") for(int r=0;r<16;++r){P0[r]=fsub_s(P0[r],dl);P1[r]=fsub_s(P1[r],dl);} \
      nm=-mhat; } \
    _Pragma("unroll") for(int r=0;r<16;++r)P0[r]=__builtin_amdgcn_exp2f(P0[r]); }while(0)
  #define RESC() do{ if(resc){ asm volatile("s_waitcnt lgkmcnt(0)":::"memory"); \
      _Pragma("unroll") for(int d_=0;d_<2;++d_) _Pragma("unroll") for(int r=0;r<16;++r)o[d_][r]*=wsf[crow(r,hi)]; } }while(0)
  f32x16 pA0,pA1,pB0,pB1;
  int sl_prev=0,sl_cur=0,sl_next=SLOTB;
  #define ROT() do{sl_prev=sl_cur;sl_cur=sl_next;sl_next=(sl_next==(NSLOT-1)*SLOTB)?0:sl_next+SLOTB;}while(0)
  DMA_K(2,2*SLOTB);
  WAIT_BAR(3);
  { f32x16 c0i,c1i; BIASFILL(c0i,c1i,0); qkt(pA0,pA1,Kbase,qr,c0i,c1i,r32,hi); }asm volatile("s_nop 15\n\ts_nop 7":"+v"(pA0),"+v"(pA1));CMASK(pA0,pA1,0);
  START(pA0,pA1);
  _Pragma("unroll") for(int r=0;r<16;++r)pA1[r]=__builtin_amdgcn_exp2f(pA1[r]);
  WAIT_BAR(0);
  DMA_K(3,0);DMA_V(1,SLOTB);
  ROT();
  kload8(kf,kp0+sl_cur);
  WAIT_BAR(2);
  s16x4 vlo[8],vhi[8]; u32x4 pw0,pw1,pw2,pw3;
  #define PKW(P,B) cvtpk_s(P[B],P[B+1])
  #define PAF(k) __builtin_bit_cast(bf16x8,pw##k)
  #define VFR(i) (bf16x8){vlo[i][0],vlo[i][1],vlo[i][2],vlo[i][3],vhi[i][0],vhi[i][1],vhi[i][2],vhi[i][3]}
  #define PIN(x) asm volatile("":"+v"(x))
  #define MX3(a,b,c) __builtin_fmaxf(__builtin_fmaxf((a),(b)),(c))
  #define GAPA(MF,A0,A1,A2,A3,W0,W1,PW) do{ MF; sacc+=A0; sacc+=A1; sacc+=A2; sacc+=A3; PIN(sacc); W0; W1; PIN(PW); SBAR(); }while(0)
  #define EX(v) __builtin_amdgcn_exp2f(v)
  #define GAPB(MF,X,B) do{ MF; X[B]=EX(X[B]); X[B+1]=EX(X[B+1]); X[B+2]=EX(X[B+2]); X[B+3]=EX(X[B+3]); PIN(X); SBAR(); }while(0)
  #define VRD(i) do{ vlo[i]=vtr(vp_+(((i)>>2)*4096+((i)&3)*1024)); vhi[i]=vtr(vp_+(((i)>>2)*4096+((i)&3)*1024+512)); }while(0)
  #define KRD(G,j) do{ if(G){ kload2(kf,kp0+sl_next,j); SBAR(); } }while(0)
  #define STEP(C0,C1,P0,P1,t,GK,GV,GL) do{ SBAR(); BIASFILL(C0,C1,t); SBAR(); \
    const lds_cptr vp_=vp0+sl_prev; \
    VRD(0); SBAR(); float sacc=(P0[0]+P0[1]); \
    GAPA(C0=__builtin_amdgcn_mfma_f32_32x32x16_bf16(kf[0],qr[0],C0,0,0,0), P0[2],P0[3],P0[4],P0[5],     pw0[0]=PKW(P0,0), pw0[1]=PKW(P0,2), pw0); \
    VRD(4); SBAR(); GAPA(C1=__builtin_amdgcn_mfma_f32_32x32x16_bf16(kf[1],qr[0],C1,0,0,0), P0[6],P0[7],P0[8],P0[9],     pw0[2]=PKW(P0,4), pw0[3]=PKW(P0,6), pw0); \
    VRD(1); SBAR(); GAPA(C0=__builtin_amdgcn_mfma_f32_32x32x16_bf16(kf[2],qr[1],C0,0,0,0),   P0[10],P0[11],P0[12],P0[13], pw1[0]=PKW(P0,8), pw1[1]=PKW(P0,10), pw1); \
    VRD(5); SBAR(); GAPA(C1=__builtin_amdgcn_mfma_f32_32x32x16_bf16(kf[3],qr[1],C1,0,0,0),   P0[14],P0[15],P1[0],P1[1],   pw1[2]=PKW(P0,12),pw1[3]=PKW(P0,14), pw1); \
    VRD(2); SBAR(); GAPA(C0=__builtin_amdgcn_mfma_f32_32x32x16_bf16(kf[4],qr[2],C0,0,0,0),   P1[2],P1[3],P1[4],P1[5],     pw2[0]=PKW(P1,0), pw2[1]=PKW(P1,2), pw2); \
    VRD(6); SBAR(); GAPA(C1=__builtin_amdgcn_mfma_f32_32x32x16_bf16(kf[5],qr[2],C1,0,0,0),   P1[6],P1[7],P1[8],P1[9],     pw2[2]=PKW(P1,4), pw2[3]=PKW(P1,6), pw2); \
    VRD(3); SBAR(); GAPA(C0=__builtin_amdgcn_mfma_f32_32x32x16_bf16(kf[6],qr[3],C0,0,0,0),   P1[10],P1[11],P1[12],P1[13], pw3[0]=PKW(P1,8), pw3[1]=PKW(P1,10), pw3); \
    VRD(7); SBAR(); GAPA(C1=__builtin_amdgcn_mfma_f32_32x32x16_bf16(kf[7],qr[3],C1,0,0,0),   P1[14],P1[15],0.f,0.f,       pw3[2]=PKW(P1,12),pw3[3]=PKW(P1,14), pw3); \
    l_reg+=sacc; \
    if(GK){DMA_K((t)+3,sl_cur);} if(GV){DMA_V((t)+1,sl_next);} \
    CMASK(C0,C1,t); \
    { float a=MX3(C0[0],C0[1],C1[0]),b=MX3(C0[2],C0[3],C1[1]); a=MX3(a,C1[2],C1[3]); \
      _Pragma("unroll") for(int r=4;r<16;r+=4){a=MX3(a,C0[r],C0[r+1]);b=MX3(b,C0[r+2],C0[r+3]);a=MX3(a,C1[r],C1[r+1]);b=MX3(b,C1[r+2],C1[r+3]);} \
      float rm=__builtin_fmaxf(a,b); { auto rr=__builtin_amdgcn_permlane32_swap(__float_as_uint(rm),__float_as_uint(rm),false,false); rm=__builtin_fmaxf(__uint_as_float(rr[0]),__uint_as_float(rr[1])); } \
      resc=false; \
      if(__builtin_expect(__any(rm>(float)THRL),0)){ const float dl=__builtin_fmaxf(rm,0.f); mhat+=dl; \
        _Pragma("unroll") for(int r=0;r<16;++r){C0[r]-=dl;C1[r]-=dl;} \
        nm=-mhat; \
        const float f=__builtin_amdgcn_exp2f(-dl); l_reg*=f; if(hi==0)wsf[r32]=f; resc=true; } } \
    SBAR(); \
    GAPB(o[0]=__builtin_amdgcn_mfma_f32_32x32x16_bf16(PAF(0),VFR(0),o[0],0,0,0), C0,0); \
    GAPB(o[1]=__builtin_amdgcn_mfma_f32_32x32x16_bf16(PAF(0),VFR(4),o[1],0,0,0), C0,4); \
    KRD(GL,0); GAPB(o[0]=__builtin_amdgcn_mfma_f32_32x32x16_bf16(PAF(1),VFR(1),o[0],0,0,0), C0,8); \
    KRD(GL,1); GAPB(o[1]=__builtin_amdgcn_mfma_f32_32x32x16_bf16(PAF(1),VFR(5),o[1],0,0,0), C0,12); \
    KRD(GL,2); GAPB(o[0]=__builtin_amdgcn_mfma_f32_32x32x16_bf16(PAF(2),VFR(2),o[0],0,0,0), C1,0); \
    KRD(GL,3); GAPB(o[1]=__builtin_amdgcn_mfma_f32_32x32x16_bf16(PAF(2),VFR(6),o[1],0,0,0), C1,4); \
    GAPB(o[0]=__builtin_amdgcn_mfma_f32_32x32x16_bf16(PAF(3),VFR(3),o[0],0,0,0), C1,8); \
    GAPB(o[1]=__builtin_amdgcn_mfma_f32_32x32x16_bf16(PAF(3),VFR(7),o[1],0,0,0), C1,12); \
    }while(0)
  int t=1;
  #undef CMASK
  #define CMASK(P0,P1,t) do{}while(0)
  for(;t+5<NT;t+=2){
    STEP(pB0,pB1,pA0,pA1,t,true,true,true);     WAIT_BAR(2); RESC(); ROT();
    STEP(pA0,pA1,pB0,pB1,t+1,true,true,true);   WAIT_BAR(2); RESC(); ROT();
  }
  #undef CMASK
  #define CMASK(P0,P1,t) do{int jb_=(t)-(NT-4); if(jb_>=0)cmask(P0,P1,jb_,qrel,hi);}while(0)
  #define ENDW(tt) do{ if((tt)+3<NT){WAIT_BAR(2);} else if((tt)+2<NT){WAIT_BAR(1);} else {WAIT_BAR(0);} }while(0)
  for(;t+1<NT;t+=2){
    STEP(pB0,pB1,pA0,pA1,t,(t+3<NT),(t+1<NT),(t+1<NT));       ENDW(t);   RESC(); ROT();
    STEP(pA0,pA1,pB0,pB1,t+1,(t+4<NT),(t+2<NT),(t+2<NT));     ENDW(t+1); RESC(); ROT();
  }
  STEP(pB0,pB1,pA0,pA1,NT-1,false,false,false); RESC();
  { float sacc=pB0[0]+pB0[1]; _Pragma("unroll") for(int r=2;r<16;++r)sacc+=pB0[r]; _Pragma("unroll") for(int r=0;r<16;++r)sacc+=pB1[r]; l_reg+=sacc;
    pw0=(u32x4){PKW(pB0,0),PKW(pB0,2),PKW(pB0,4),PKW(pB0,6)};pw1=(u32x4){PKW(pB0,8),PKW(pB0,10),PKW(pB0,12),PKW(pB0,14)};pw2=(u32x4){PKW(pB1,0),PKW(pB1,2),PKW(pB1,4),PKW(pB1,6)};pw3=(u32x4){PKW(pB1,8),PKW(pB1,10),PKW(pB1,12),PKW(pB1,14)};
    SBAR(); pv(o,vb0+sl_cur,PAF(0),PAF(1),PAF(2),PAF(3)); }
  #undef PKW
  #undef PAF
  #undef VFR
  #undef PIN
  #undef MX3
  #undef GAPA
  #undef GAPB
  #undef EX
  #undef VRD
  #undef KRD
  #undef STEP
  #undef ENDW
  {auto rr=__builtin_amdgcn_permlane32_swap(__float_as_uint(l_reg),__float_as_uint(l_reg),false,false);l_reg=__uint_as_float(rr[0])+__uint_as_float(rr[1]);}
  if(hi==0)wsf[32+r32]=l_reg;asm volatile("s_waitcnt lgkmcnt(0)":::"memory");
  float rli[16];
  #pragma unroll
  for(int r=0;r<16;++r)rli[r]=__builtin_amdgcn_rcpf(wsf[32+crow(r,hi)]);
  bf16*Ow=O+(rowbase+q0+wid*QBLK)*OP+h*D;
  { bf16*stg=(bf16*)(shm+LDS_OST)+wid*2048;
    #pragma unroll
    for(int r=0;r<16;++r){const int orow=crow(r,hi);
      #pragma unroll
      for(int d0=0;d0<2;++d0)stg[orow*64+d0*32+r32]=__float2bfloat16(o[d0][r]*rli[r]);}
    asm volatile("s_waitcnt lgkmcnt(0)":::"memory");
    #pragma unroll
    for(int i=0;i<4;++i){const int row=i*8+(lane>>3),ch=lane&7; const u32x4 v=*(const u32x4*)(stg+row*64+ch*8); ATTN_STORE16(Ow+(long)row*OP+ch*8,v);} }
  asm volatile("s_waitcnt lgkmcnt(0)\n\ts_barrier":::"memory");
  #undef DMA_K
  #undef DMA_V
  #undef CMASK
  #undef START
  #undef RESC
  #undef ROT
  #undef BIASFILL
}
constexpr int ATTN_LDS_BYTES=LDS_BYTES;
#undef SBAR
#undef WAIT_BAR
}
__device__ __forceinline__ void fox_fast(CArgs& A, const Frame& F) {
    float* kb = (float*)(F.lds + 86016); float* wtot = kb + 2048;
    const int v = (F.bid & 7) * 32 + (F.bid >> 3), bh = v >> 2, s = v & 3, b = bh >> 3, h = bh & 7;
    fox_kbias(A, F, b, h, kb, wtot);
    const attn_body::bf16* Zb = (const attn_body::bf16*)P_Z;
    const attn_body::lds_fptr kb3 = (attn_body::lds_fptr)(const __attribute__((address_space(3))) unsigned char*)((LAS unsigned char*)F.lds + 86016);
    attn_body::attn_unit<8>(b, h, 7 - s, Zb + 512, Zb + 1024, Zb + 1536, (attn_body::bf16*)P_YCAT + 512, (char*)F.lds, kb3, F.tid, F.wave);
    attn_body::attn_unit<8>(b, h, s, Zb + 512, Zb + 1024, Zb + 1536, (attn_body::bf16*)P_YCAT + 512, (char*)F.lds, kb3, F.tid, F.wave);
}
typedef float f32x16 __attribute__((ext_vector_type(16)));
__device__ __forceinline__ bf16x8 pack8(const f32x4& a, const f32x4& b) { u32x4 w; w.x = pk2(a.x, a.y); w.y = pk2(a.z, a.w); w.z = pk2(b.x, b.y); w.w = pk2(b.z, b.w); return __builtin_bit_cast(bf16x8, w); }
__device__ __forceinline__ void s5_fast(CArgs& A, const Frame& F, int item) {
    const int b = item >> 5, g = item & 31, lane = F.lane, w = F.wave, p = lane & 31, hh = lane >> 5, l15 = lane & 15, l4 = lane >> 4;
    float* Eseg = (float*)F.lds; float* Hin = Eseg + 2048;
    bf16_t* Hs = (bf16_t*)(F.lds + 16384) + w * 4352;
    bf16x8 bbr[2], bbi[2]; float are[2], aim[2];
#pragma unroll
    for (int nt = 0; nt < 2; ++nt) { const float* q = P_S5BB + (size_t)(g * 64 + 32 * nt + p) * 32 + 8 * hh;
        bbr[nt] = pack8(*(const f32x4*)q, *(const f32x4*)(q + 4)); bbi[nt] = pack8(*(const f32x4*)(q + 16), *(const f32x4*)(q + 20));
        are[nt] = P_S5A[(g * 64 + 32 * nt + p) * 2]; aim[nt] = P_S5A[(g * 64 + 32 * nt + p) * 2 + 1]; }
    const int rr = lane & 31, ahalf = (rr >> 2) & 1, atau = (rr & 3) + 4 * (rr >> 3);
    const bf16_t* usrc = P_Z + (size_t)(b * SEQ + 128 * (2 * w + ahalf) + atau) * ZP0 + g * 16 + 8 * hh;
    const f32x16 zero16 = {0.f, 0.f, 0.f, 0.f, 0.f, 0.f, 0.f, 0.f, 0.f, 0.f, 0.f, 0.f, 0.f, 0.f, 0.f, 0.f};
    float hr[2] = {0.f, 0.f}, hi[2] = {0.f, 0.f};
#define S5_ALOAD(blk_) (*(const bf16x8*)(usrc + (size_t)(blk_) * 16 * ZP0))
    { bf16x8 a0 = S5_ALOAD(0), a1 = S5_ALOAD(1), a2 = S5_ALOAD(2);
#pragma unroll 1
      for (int blk = 0; blk < 8; ++blk) {
        const bf16x8 a = a0; a0 = a1; a1 = a2; if (blk + 3 < 8) a2 = S5_ALOAD(blk + 3);
#pragma unroll
        for (int nt = 0; nt < 2; ++nt) {
            const f32x16 dre = __builtin_amdgcn_mfma_f32_32x32x16_bf16(a, bbr[nt], zero16, 0, 0, 0), dim = __builtin_amdgcn_mfma_f32_32x32x16_bf16(a, bbi[nt], zero16, 0, 0, 0);
#pragma unroll
            for (int i = 0; i < 16; ++i) { const float nr = are[nt] * hr[nt] - aim[nt] * hi[nt] + dre[i], ni = are[nt] * hi[nt] + aim[nt] * hr[nt] + dim[i]; hr[nt] = nr; hi[nt] = ni; }
        }
      } }
#pragma unroll
    for (int nt = 0; nt < 2; ++nt) { Eseg[((2 * w + hh) * 64 + 32 * nt + p) * 2] = hr[nt]; Eseg[((2 * w + hh) * 64 + 32 * nt + p) * 2 + 1] = hi[nt]; }
    __syncthreads();
    if (w == 0) {
        float xr = P_S5A[(g * 64 + lane) * 2], xi = P_S5A[(g * 64 + lane) * 2 + 1];
#pragma unroll
        for (int q = 0; q < 7; ++q) { const float nr = xr * xr - xi * xi, ni = 2.f * xr * xi; xr = nr; xi = ni; }
        float Hr = 0.f, Hi = 0.f;
#pragma unroll 1
        for (int s = 0; s < 16; ++s) { Hin[(s * 64 + lane) * 2] = Hr; Hin[(s * 64 + lane) * 2 + 1] = Hi;
            const float er = Eseg[(s * 64 + lane) * 2], ei = Eseg[(s * 64 + lane) * 2 + 1]; const float nr = xr * Hr - xi * Hi + er, ni = xr * Hi + xi * Hr + ei; Hr = nr; Hi = ni; }
    }
    __syncthreads();
#pragma unroll
    for (int nt = 0; nt < 2; ++nt) { hr[nt] = Hin[((2 * w + hh) * 64 + 32 * nt + p) * 2]; hi[nt] = Hin[((2 * w + hh) * 64 + 32 * nt + p) * 2 + 1]; }
    bf16x8 ck[4];
#pragma unroll
    for (int ks = 0; ks < 4; ++ks) ck[ks] = *(const bf16x8*)(P_S5CK + (size_t)(g * 16 + l15) * 128 + 32 * ks + 8 * l4);
    const int er = lane >> 1, eh = lane & 1;
    float* Ys = (float*)(F.lds + 86016) + w * 640;
    f32x4 dk0 = *(const f32x4*)(A.in[I_S5D] + g * 16 + 8 * eh), dk1 = *(const f32x4*)(A.in[I_S5D] + g * 16 + 8 * eh + 4);
#define S5_EROW(blk_) ((size_t)(b * SEQ + 128 * (2 * w + (er >> 4)) + 16 * (blk_) + (er & 15)))
    bf16x8 a0 = S5_ALOAD(0), a1 = S5_ALOAD(1), a2 = S5_ALOAD(2);
    u32x4 un = *(const u32x4*)(P_Z + S5_EROW(0) * ZP0 + g * 16 + 8 * eh);
#pragma unroll 1
    for (int blk = 0; blk < 8; ++blk) {
        const bf16x8 a = a0; a0 = a1; a1 = a2; if (blk + 3 < 8) a2 = S5_ALOAD(blk + 3);
        const u32x4 us = un; if (blk + 1 < 8) un = *(const u32x4*)(P_Z + S5_EROW(blk + 1) * ZP0 + g * 16 + 8 * eh);
#pragma unroll
        for (int nt = 0; nt < 2; ++nt) {
            const f32x16 dre = __builtin_amdgcn_mfma_f32_32x32x16_bf16(a, bbr[nt], zero16, 0, 0, 0), dim = __builtin_amdgcn_mfma_f32_32x32x16_bf16(a, bbi[nt], zero16, 0, 0, 0);
#pragma unroll
            for (int i = 0; i < 16; ++i) { const float nr = are[nt] * hr[nt] - aim[nt] * hi[nt] + dre[i], ni = are[nt] * hi[nt] + aim[nt] * hr[nt] + dim[i]; hr[nt] = nr; hi[nt] = ni;
                *(unsigned*)(Hs + (hh * 16 + i) * 136 + 2 * (32 * nt + p)) = pk2(nr, ni); }
        }
        LDS_WAIT();
#pragma unroll
        for (int sg = 0; sg < 2; ++sg) {
            f32x4 y = {0.f, 0.f, 0.f, 0.f};
#pragma unroll
            for (int ks = 0; ks < 4; ++ks) { const bf16x8 af = *(const bf16x8*)(Hs + (sg * 16 + l15) * 136 + 32 * ks + 8 * l4); y = __builtin_amdgcn_mfma_f32_16x16x32_bf16(af, ck[ks], y, 0, 0, 0); }
#pragma unroll
            for (int q = 0; q < 4; ++q) Ys[(sg * 16 + 4 * l4 + q) * 20 + l15] = y[q];
        }
        LDS_WAIT();
        { const f32x4 y0 = *(const f32x4*)(Ys + er * 20 + 8 * eh), y1 = *(const f32x4*)(Ys + er * 20 + 8 * eh + 4);
          float o[8]; o[0] = y0.x + dk0.x * bflo(us.x); o[1] = y0.y + dk0.y * bfhi(us.x); o[2] = y0.z + dk0.z * bflo(us.y); o[3] = y0.w + dk0.w * bfhi(us.y);
          o[4] = y1.x + dk1.x * bflo(us.z); o[5] = y1.y + dk1.y * bfhi(us.z); o[6] = y1.z + dk1.z * bflo(us.w); o[7] = y1.w + dk1.w * bfhi(us.w);
          u32x4 ov; ov.x = pk2(gelu_tanh(o[0]), gelu_tanh(o[1])); ov.y = pk2(gelu_tanh(o[2]), gelu_tanh(o[3])); ov.z = pk2(gelu_tanh(o[4]), gelu_tanh(o[5])); ov.w = pk2(gelu_tanh(o[6]), gelu_tanh(o[7]));
          *(u32x4*)(P_G5 + S5_EROW(blk) * 512 + g * 16 + 8 * eh) = ov; }
        LDS_WAIT();
    }
#undef S5_ALOAD
#undef S5_EROW
}
namespace lin {
typedef const LAS char* lptr;
typedef short s16x4 __attribute__((ext_vector_type(4)));
typedef short v4i16_t __attribute__((ext_vector_type(4)));
__device__ __forceinline__ s16x4 vtr(lptr p) { return __builtin_bit_cast(s16x4, __builtin_amdgcn_ds_read_tr16_b64_v4i16((LAS v4i16_t*)p)); }
__device__ __forceinline__ bf16x8 tr_frag(lptr sub, int ks, int lane) {
    const lptr p = sub + ((lane >> 4) & 1) * 32 + (lane & 3) * 8 + (4 * (lane >> 5) + ((lane & 15) >> 2)) * 64 + ks * 1024;
    const s16x4 lo = vtr(p), hi = vtr(p + 512);
    return (bf16x8){lo[0], lo[1], lo[2], lo[3], hi[0], hi[1], hi[2], hi[3]};
}
__device__ __forceinline__ bf16x8 nat_frag(lptr base, int ldb, int row0, int k0, int lane) { return *(const LAS bf16x8*)(base + (row0 + (lane & 31)) * ldb + (k0 + 8 * (lane >> 5)) * 2); }
__device__ __forceinline__ int crow(int r, int hh) { return (r & 3) + 8 * (r >> 2) + 4 * hh; }
__device__ __forceinline__ void unpack8(const u32x4& w, float (&f)[8]) { f[0] = bflo(w.x); f[1] = bfhi(w.x); f[2] = bflo(w.y); f[3] = bfhi(w.y); f[4] = bflo(w.z); f[5] = bfhi(w.z); f[6] = bflo(w.w); f[7] = bfhi(w.w); }
__device__ __forceinline__ u32x4 repack8(const float (&f)[8]) { u32x4 w; w.x = pk2(f[0], f[1]); w.y = pk2(f[2], f[3]); w.z = pk2(f[4], f[5]); w.w = pk2(f[6], f[7]); return w; }

__device__ __forceinline__ void gla_prefix(CArgs& A, const Frame& F, int item) {
    const int b = item >> 5, c = item & 31, half = F.tid >> 8, col = F.tid & 255;
    float* p = P_LOGA + (size_t)(b * SEQ + c * 64 + 32 * half) * 256 + col; float* tot = (float*)F.lds;
    float v[32];
#pragma unroll
    for (int i = 0; i < 32; ++i) v[i] = p[(size_t)i * 256];
#pragma unroll
    for (int i = 1; i < 32; ++i) v[i] += v[i - 1];
    if (half == 0) tot[col] = v[31];
    __syncthreads();
    const float off = half ? tot[col] : 0.f;
#pragma unroll
    for (int i = 0; i < 32; ++i) p[(size_t)i * 256] = v[i] + off;
    __syncthreads();
}
template <int KIND> __device__ __forceinline__ void r1_item(CArgs& A, const Frame& F, int bh, int vs) {
    constexpr int DK = KIND ? 64 : 128, ND = DK / 32;
    constexpr int KCOL = KIND ? 2304 : 512, VCOL = KIND ? 2560 : 1024;
    const int b = bh >> 2, h = bh & 3, tid = F.tid, lane = F.lane, w = F.wave, hh = lane >> 5;
    unsigned char* bufV = F.lds; unsigned char* bufK = F.lds + 4096;
    bf16_t* ST = (KIND ? P_GST : P_RST) + (size_t)bh * 32 * 128 * DK;
    const float log2g = KIND ? 0.f : log2f(1.f - exp2f(-5.f - (float)h));
    const float g64 = exp2f(64.f * log2g);
    f32x16 acc = {0.f, 0.f, 0.f, 0.f, 0.f, 0.f, 0.f, 0.f, 0.f, 0.f, 0.f, 0.f, 0.f, 0.f, 0.f, 0.f};
    const bf16_t* zb = P_Z + (size_t)(b * SEQ) * ZP1;
    const int vj = tid >> 2, vc = tid & 3;
    const int kj0 = KIND ? (tid >> 3) : (tid >> 4), kd0 = KIND ? (tid & 7) : (tid & 15);
#define R1_DECL(S) u32x4 rv##S = {0u, 0u, 0u, 0u}, rk0##S = {0u, 0u, 0u, 0u}, rk1##S = {0u, 0u, 0u, 0u}; f32x4 bj0##S = {0.f, 0.f, 0.f, 0.f}, bj1##S = bj0##S, bl0##S = bj0##S, bl1##S = bj0##S; float bd##S = 0.f;
#define R1_LOAD(S, c) do { const bf16_t* zc = zb + (size_t)((c) * 64) * ZP1; \
        if (tid < 256) rv##S = *(const u32x4*)(zc + (size_t)vj * ZP1 + VCOL + h * 128 + vs * 32 + vc * 8); \
        rk0##S = *(const u32x4*)(zc + (size_t)kj0 * ZP1 + KCOL + h * DK + kd0 * 8); \
        if (!KIND) rk1##S = *(const u32x4*)(zc + (size_t)(kj0 + 32) * ZP1 + KCOL + h * DK + kd0 * 8); \
        if (KIND) { const float* bp = P_LOGA + (size_t)(b * SEQ + (c) * 64) * 256 + h * 64; \
            bj0##S = *(const f32x4*)(bp + (size_t)kj0 * 256 + kd0 * 8); bj1##S = *(const f32x4*)(bp + (size_t)kj0 * 256 + kd0 * 8 + 4); \
            bl0##S = *(const f32x4*)(bp + 63 * 256 + kd0 * 8); bl1##S = *(const f32x4*)(bp + 63 * 256 + kd0 * 8 + 4); \
            if (w < ND) bd##S = bp[63 * 256 + 32 * w + (lane & 31)]; } } while (0)
#define R1_STEP(S, c) do { \
        if (tid < 256) { u32x4 o = rv##S; \
            if (!KIND) { float f[8]; unpack8(rv##S, f); const float z = exp2f((float)(63 - vj) * log2g); _Pragma("unroll") for (int e = 0; e < 8; ++e) f[e] *= z; o = repack8(f); } \
            *(u32x4*)(bufV + vj * 64 + vc * 16) = o; } \
        if (KIND) { float f[8]; unpack8(rk0##S, f); \
            f[0] *= __expf(bl0##S.x - bj0##S.x); f[1] *= __expf(bl0##S.y - bj0##S.y); f[2] *= __expf(bl0##S.z - bj0##S.z); f[3] *= __expf(bl0##S.w - bj0##S.w); \
            f[4] *= __expf(bl1##S.x - bj1##S.x); f[5] *= __expf(bl1##S.y - bj1##S.y); f[6] *= __expf(bl1##S.z - bj1##S.z); f[7] *= __expf(bl1##S.w - bj1##S.w); \
            *(u32x4*)(bufK + (kd0 >> 2) * 4096 + kj0 * 64 + (kd0 & 3) * 16) = repack8(f); \
        } else { \
            *(u32x4*)(bufK + (kd0 >> 2) * 4096 + kj0 * 64 + (kd0 & 3) * 16) = rk0##S; \
            *(u32x4*)(bufK + (kd0 >> 2) * 4096 + (kj0 + 32) * 64 + (kd0 & 3) * 16) = rk1##S; } \
        __syncthreads(); \
        const float decn = KIND ? __expf(bd##S) : 0.f; \
        if ((c) + 4 < 32) R1_LOAD(S, (c) + 4); \
        if (w < ND) { \
            bf16_t* sp = ST + ((size_t)(c) * 128 + vs * 32) * DK + 32 * w + (lane & 31); \
            const float dec = KIND ? decn : g64; \
            _Pragma("unroll") for (int r = 0; r < 16; ++r) { sp[(size_t)crow(r, hh) * DK] = (bf16_t)f2bf(acc[r]); acc[r] *= dec; } \
            _Pragma("unroll") for (int ks = 0; ks < 4; ++ks) acc = __builtin_amdgcn_mfma_f32_32x32x16_bf16(tr_frag((lptr)(LAS unsigned char*)bufV, ks, lane), tr_frag((lptr)(LAS unsigned char*)bufK + w * 4096, ks, lane), acc, 0, 0, 0); \
        } \
        __syncthreads(); } while (0)
    R1_DECL(0) R1_DECL(1) R1_DECL(2) R1_DECL(3)
    R1_LOAD(0, 0); R1_LOAD(1, 1); R1_LOAD(2, 2); R1_LOAD(3, 3);
#pragma unroll 1
    for (int c = 0; c < 32; c += 4) { R1_STEP(0, c); R1_STEP(1, c + 1); R1_STEP(2, c + 2); R1_STEP(3, c + 3); }
#undef R1_DECL
#undef R1_LOAD
#undef R1_STEP
}
__device__ __forceinline__ void p_lin_r1(CArgs& A, const Frame& F) {
    const int v = F.bid, r = v & 127;
    if (v < 128) r1_item<0>(A, F, r >> 2, r & 3); else r1_item<1>(A, F, r >> 2, r & 3);
}

template <int KIND> struct R2Regs {
    static constexpr int DK = KIND ? 64 : 128, NQP = 64 * DK / 8 / 512, NSP = 128 * DK / 8 / 512;
    u32x4 q[NQP], k[NQP], v[2], s[NSP], g[2]; f32x4 bq[NQP][2];
};
template <int KIND> __device__ __forceinline__ void r2_load(CArgs& A, const Frame& F, R2Regs<KIND>& R, int bh, int c) {
    constexpr int DK = KIND ? 64 : 128;
    constexpr int QCOL = KIND ? 2048 : 0, KCOL = KIND ? 2304 : 512, VCOL = KIND ? 2560 : 1024, GCOL = KIND ? 3072 : 1536;
    const int b = bh >> 2, h = bh & 3, tid = F.tid, lane = F.lane, w = F.wave, hh = lane >> 5, l31 = lane & 31, rb = w >> 2, cb = w & 3;
    const bf16_t* zc = P_Z + (size_t)(b * SEQ + c * 64) * ZP1;
    const bf16_t* ST = (KIND ? P_GST : P_RST) + ((size_t)bh * 32 + c) * 128 * DK;
#pragma unroll
    for (int r = 0; r < R2Regs<KIND>::NQP; ++r) { const int q = tid + 512 * r, i = q / (DK / 8), d8 = q % (DK / 8);
        R.q[r] = *(const u32x4*)(zc + (size_t)i * ZP1 + QCOL + h * DK + d8 * 8); R.k[r] = *(const u32x4*)(zc + (size_t)i * ZP1 + KCOL + h * DK + d8 * 8);
        if (KIND) { const float* bp = P_LOGA + (size_t)(b * SEQ + c * 64 + i) * 256 + h * 64 + d8 * 8; R.bq[r][0] = *(const f32x4*)bp; R.bq[r][1] = *(const f32x4*)(bp + 4); } }
#pragma unroll
    for (int r = 0; r < 2; ++r) { const int q = tid + 512 * r, j = q >> 4, v8 = q & 15; R.v[r] = *(const u32x4*)(zc + (size_t)j * ZP1 + VCOL + h * 128 + v8 * 8); }
#pragma unroll
    for (int r = 0; r < R2Regs<KIND>::NSP; ++r) { const int q = tid + 512 * r, vr = q / (DK / 8), d8 = q % (DK / 8); R.s[r] = *(const u32x4*)(ST + (size_t)vr * DK + d8 * 8); }
#pragma unroll
    for (int k2 = 0; k2 < 2; ++k2) { const int pp = lane + 64 * k2; R.g[k2] = *(const u32x4*)(zc + (size_t)(32 * rb + (pp >> 2)) * ZP1 + GCOL + h * 128 + 32 * cb + 8 * (pp & 3)); }
}
template <int KIND> struct R2Lds { static constexpr int DK = KIND ? 64 : 128, LDQ = (DK + 8) * 2, OFF_K = 64 * LDQ, OFF_V = 2 * 64 * LDQ, OFF_S = OFF_V + 16384, OFF_SSQ = OFF_S + 128 * LDQ, OFF_BC = OFF_SSQ + 1024; };
template <int KIND> __device__ __forceinline__ void r2_stage(const Frame& F, const R2Regs<KIND>& R, u32x4 (&gc)[2]) {
    typedef R2Lds<KIND> LL; constexpr int DK = LL::DK, LDQ = LL::LDQ;
    const int tid = F.tid; unsigned char* L = F.lds;
#pragma unroll
    for (int r = 0; r < R2Regs<KIND>::NQP; ++r) { const int q = tid + 512 * r, i = q / (DK / 8), d8 = q % (DK / 8);
        u32x4 qw = R.q[r], kw = R.k[r];
        if (KIND) { float fq[8], fk[8]; unpack8(qw, fq); unpack8(kw, fk);
#pragma unroll
            for (int e = 0; e < 8; ++e) { const float bb = R.bq[r][e >> 2][e & 3]; fq[e] *= __expf(bb); fk[e] *= __expf(-bb); }
            qw = repack8(fq); kw = repack8(fk); }
        *(u32x4*)(L + i * LDQ + d8 * 16) = qw; *(u32x4*)(L + LL::OFF_K + i * LDQ + d8 * 16) = kw; }
#pragma unroll
    for (int r = 0; r < 2; ++r) { const int q = tid + 512 * r, j = q >> 4, v8 = q & 15; *(u32x4*)(L + LL::OFF_V + (v8 >> 2) * 4096 + j * 64 + (v8 & 3) * 16) = R.v[r]; }
#pragma unroll
    for (int r = 0; r < R2Regs<KIND>::NSP; ++r) { const int q = tid + 512 * r, vr = q / (DK / 8), d8 = q % (DK / 8); *(u32x4*)(L + LL::OFF_S + vr * LDQ + d8 * 16) = R.s[r]; }
    gc[0] = R.g[0]; gc[1] = R.g[1];
    __syncthreads();
}
template <int KIND> __device__ __forceinline__ void r2_compute(CArgs& A, const Frame& F, int bh, int c, const u32x4 (&gc)[2]) {
    typedef R2Lds<KIND> LL; constexpr int DK = LL::DK, LDQ = LL::LDQ, OFF_K = LL::OFF_K, OFF_V = LL::OFF_V, OFF_S = LL::OFF_S;
    constexpr int OCOL = KIND ? 512 : 0;
    const int b = bh >> 2, h = bh & 3, lane = F.lane, w = F.wave, hh = lane >> 5, l31 = lane & 31, rb = w >> 2, cb = w & 3;
    unsigned char* L = F.lds; float* ssq = (float*)(L + LL::OFF_SSQ);
    const float log2g = KIND ? 0.f : log2f(1.f - exp2f(-5.f - (float)h));
    const lptr L3 = (lptr)(LAS unsigned char*)L;
    bf16x8 pa[2][2];
#pragma unroll
    for (int jt = 0; jt < 2; ++jt) {
        f32x16 p = {0.f, 0.f, 0.f, 0.f, 0.f, 0.f, 0.f, 0.f, 0.f, 0.f, 0.f, 0.f, 0.f, 0.f, 0.f, 0.f};
        if (jt <= rb) {
#pragma unroll
            for (int ks = 0; ks < DK / 16; ++ks) p = __builtin_amdgcn_mfma_f32_32x32x16_bf16(nat_frag(L3 + OFF_K, LDQ, 32 * jt, 16 * ks, lane), nat_frag(L3, LDQ, 32 * rb, 16 * ks, lane), p, 0, 0, 0);
        }
        const int i = 32 * rb + l31;
        float f[16];
#pragma unroll
        for (int r = 0; r < 16; ++r) { const int j = 32 * jt + crow(r, hh); float x = (i >= j) ? p[r] : 0.f; if (!KIND) x *= exp2f((float)(i - j) * log2g); f[r] = (i >= j) ? x : 0.f; }
#pragma unroll
        for (int s = 0; s < 2; ++s) { u32x4 wv; wv.x = pk2(f[8 * s], f[8 * s + 1]); wv.y = pk2(f[8 * s + 2], f[8 * s + 3]); wv.z = pk2(f[8 * s + 4], f[8 * s + 5]); wv.w = pk2(f[8 * s + 6], f[8 * s + 7]); pa[jt][s] = __builtin_bit_cast(bf16x8, wv); }
    }
    f32x16 o1 = {0.f, 0.f, 0.f, 0.f, 0.f, 0.f, 0.f, 0.f, 0.f, 0.f, 0.f, 0.f, 0.f, 0.f, 0.f, 0.f}, o2 = o1;
#pragma unroll
    for (int jt = 0; jt < 2; ++jt)
#pragma unroll
        for (int s = 0; s < 2; ++s) o1 = __builtin_amdgcn_mfma_f32_32x32x16_bf16(pa[jt][s], tr_frag(L3 + OFF_V + cb * 4096, 2 * jt + s, lane), o1, 0, 0, 0);
#pragma unroll
    for (int ks = 0; ks < DK / 16; ++ks) o2 = __builtin_amdgcn_mfma_f32_32x32x16_bf16(nat_frag(L3, LDQ, 32 * rb, 16 * ks, lane), nat_frag(L3 + OFF_S, LDQ, 32 * cb, 16 * ks, lane), o2, 0, 0, 0);
    float o[16];
#pragma unroll
    for (int r = 0; r < 16; ++r) { const int i = 32 * rb + crow(r, hh); const float xi = KIND ? 1.f : exp2f((float)(i + 1) * log2g); o[r] = o1[r] + xi * o2[r];
        const float sq = half_sum(o[r] * o[r]); if (l31 == 0) ssq[i * 4 + cb] = sq; }
    __syncthreads();
    float* Os = (float*)L + w * (32 * 33);
#pragma unroll
    for (int r = 0; r < 16; ++r) Os[crow(r, hh) * 33 + l31] = o[r];
    LDS_WAIT();
#pragma unroll
    for (int k2 = 0; k2 < 2; ++k2) { const int pp = lane + 64 * k2, rw = pp >> 2, ch = pp & 3, i = 32 * rb + rw;
        const f32x4 s4 = *(const f32x4*)(ssq + i * 4);
        const float rn = rsqrtf(((s4.x + s4.y) + (s4.z + s4.w)) * (1.f / 128.f) + EPS);
        float gv[8]; unpack8(gc[k2], gv); float y[8];
#pragma unroll
        for (int e = 0; e < 8; ++e) y[e] = siluf_(gv[e]) * Os[rw * 33 + 8 * ch + e] * rn;
        *(u32x4*)(P_YCAT + (size_t)(b * SEQ + c * 64 + i) * DM + OCOL + h * 128 + 32 * cb + 8 * ch) = repack8(y); }
    __syncthreads();
}
template <int KIND> __device__ __forceinline__ void r2_run(CArgs& A, const Frame& F0, int first, int n, int stride) {
    R2Regs<KIND> R; u32x4 gc[2];
    { Frame G2 = F0; int t_ = F0.tid; asm volatile("" : "+v"(t_)); G2.tid = t_; G2.lane = t_ & 63; r2_load<KIND>(A, G2, R, (first & 1023) >> 5, first & 31); }
#pragma unroll 1
    for (int i = 0; i < n; ++i) {
        Frame G2 = F0; { int t_ = F0.tid; asm volatile("" : "+v"(t_)); G2.tid = t_; G2.lane = t_ & 63; }
        const int r = (first + i * stride) & 1023;
        r2_stage<KIND>(G2, R, gc);
        if (i + 1 < n) { const int rn = (first + (i + 1) * stride) & 1023; r2_load<KIND>(A, G2, R, rn >> 5, rn & 31); }
        r2_compute<KIND>(A, G2, r >> 5, r & 31, gc);
    }
}
__device__ __forceinline__ void p_lin_r2(CArgs& A, const Frame& F) {
    r2_run<0>(A, F, F.bid, 4, F.G);
    r2_run<1>(A, F, 1024 + F.bid, 4, F.G);
}
}
#define XB_TMO      128
#define XB_XCNT(j)  (256  + 64 * (j))
#define XB_XSUB(j)  (1280 + 64 * (j))
#define XB_XGEN(j)  (2304 + 64 * (j))
#define XB_TOP      3328
#define XB_TOPGEN   3392
#define XCD_BAR_WORDS 3456
#define XB_SPIN_CAP (1u << 18)
__device__ __forceinline__ unsigned xb_ld(unsigned* p)              { return __hip_atomic_load(p, __ATOMIC_RELAXED, __HIP_MEMORY_SCOPE_AGENT); }
__device__ __forceinline__ unsigned xb_add(unsigned* p, unsigned v) { return __hip_atomic_fetch_add(p, v, __ATOMIC_RELAXED, __HIP_MEMORY_SCOPE_AGENT); }
__device__ __forceinline__ unsigned xb_xcc_id() { return (unsigned)__builtin_amdgcn_s_getreg((3 << 11) | 20) & 0xFu; }
#define XB_SPIN(cond, bar) do { unsigned _sp = 0; while (cond) { __builtin_amdgcn_s_sleep(1); \
    if ((++_sp & 255u) == 0u) { if (xb_ld(&(bar)[XB_TMO])) break; if (_sp > XB_SPIN_CAP) { atomicAdd(&(bar)[XB_TMO], 1u); break; } } } } while (0)
struct XcdBarrier { unsigned* bar; unsigned x; volatile LAS unsigned* st; };
__device__ __forceinline__ XcdBarrier xcd_barrier_post(unsigned* bar, volatile LAS unsigned* st, int tid) {
    XcdBarrier b; b.bar = bar; b.x = xb_xcc_id(); b.st = st;
    if (tid == 0) (void)xb_add(&bar[XB_XCNT(b.x)], 1u);
    return b;
}
__device__ __forceinline__ void xcd_barrier_complete(unsigned* bar, unsigned x, unsigned& nloc, unsigned& nx) {
    const unsigned G = gridDim.x * gridDim.y * gridDim.z;
    unsigned sum, cnt, mine, sp = 0u;
    for (;;) {
        sum = 0u; cnt = 0u; mine = 0u;
#pragma unroll
        for (unsigned j = 0; j < 16; ++j) { const unsigned c = xb_ld(&bar[XB_XCNT(j)]); sum += c; cnt += (c > 0u) ? 1u : 0u; mine = (j == x) ? c : mine; }
        if (sum == G) break;
        __builtin_amdgcn_s_sleep(1);
        if ((++sp & 255u) == 0u) { if (xb_ld(&bar[XB_TMO])) break; if (sp > XB_SPIN_CAP) { atomicAdd(&bar[XB_TMO], 1u); break; } }
    }
    nloc = mine > 0u ? mine : 1u; nx = cnt > 0u ? cnt : 1u;
}
__device__ __forceinline__ void xcd_barrier(const XcdBarrier& b, int tid) {
    asm volatile("s_waitcnt vmcnt(0)" ::: "memory");
    __syncthreads();
    if (tid == 0) {
        unsigned* bar = b.bar;
        __builtin_amdgcn_s_waitcnt(0);
        unsigned nloc = b.st[0], nx = b.st[1];
        if (nloc == 0u) { xcd_barrier_complete(bar, b.x, nloc, nx); b.st[0] = nloc; b.st[1] = nx; }
        const unsigned old = xb_add(&bar[XB_XSUB(b.x)], 1u);
        const unsigned gen = old / nloc;
        if (old + 1u == (gen + 1u) * nloc) {
            __builtin_amdgcn_fence(__ATOMIC_RELEASE, "agent");
            asm volatile("s_waitcnt vmcnt(0)" ::: "memory");
            const unsigned og = xb_add(&bar[XB_TOP], 1u);
            const unsigned tg = og / nx;
            if (og + 1u == (tg + 1u) * nx) xb_add(&bar[XB_TOPGEN], 1u);
            else XB_SPIN(xb_ld(&bar[XB_TOPGEN]) == tg, bar);
            __builtin_amdgcn_fence(__ATOMIC_ACQUIRE, "agent");
            xb_add(&bar[XB_XGEN(b.x)], 1u);
            asm volatile("s_waitcnt vmcnt(0)" ::: "memory");
        } else {
            XB_SPIN(xb_ld(&bar[XB_XGEN(b.x)]) == gen, bar);
            __builtin_amdgcn_fence(__ATOMIC_ACQUIRE, "agent");
            asm volatile("s_waitcnt vmcnt(0)" ::: "memory");
        }
    }
    __syncthreads();
}
#define REFRESH() do { int t_ = F.wave * 64 + lane_id(); asm volatile("" : "+v"(t_)); F.tid = t_; F.lane = t_ & 63; asm volatile("" : "+s"(ap)); int b_ = blockIdx.x; asm volatile("" : "+s"(b_)); F.bid = b_; } while (0)
#define A (*ap)
#define GSYNC() do { REFRESH(); xcd_barrier(xb, F.tid); } while (0)
template <int l> __device__ __forceinline__ void layer_fwd(CArgs*& ap, Frame& F, const XcdBarrier& xb, unsigned char* lds, LAS unsigned char* lds3, LAS pg8::MoeTables* tb) {
    if (l == 0) {
        { REFRESH(); pg8::DenseOrder S; S.init(P_HB, P_WINE, NTOK, 2048, 1024, F.G, F.bid); pg8::EpiZ0 E{P_Z};
          pg8::gemm_phase<pg8::EpiZ0, pg8::DenseOrder, true>(lds3, F.wave, 1024, S, E); }
        GSYNC();
        REFRESH(); fox_fast(A, F);
        __syncthreads();
        REFRESH(); s5_fast(A, F, F.bid);
        GSYNC();
        { REFRESH(); pg8::DenseOrder S; S.init(P_G5, P_WGLU, NTOK, 512, 512, F.G, F.bid); pg8::EpiGlu E{P_G5, A.in[I_GLUB], P_YCAT};
          pg8::gemm_phase<pg8::EpiGlu, pg8::DenseOrder, true>(lds3, F.wave, 512, S, E); }
        GSYNC();
    } else {
        REFRESH(); lin::gla_prefix(A, F, F.bid);
        { REFRESH(); pg8::DenseOrder S; S.init(P_HB, P_WINO, NTOK, 3584, 512, F.G, F.bid); pg8::EpiZ1 E{P_Z, P_ROPE};
          pg8::gemm_phase<pg8::EpiZ1, pg8::DenseOrder, true, true>(lds3, F.wave, 512, S, E); }
        GSYNC();
        REFRESH(); lin::p_lin_r1(A, F);
        GSYNC();
        REFRESH(); lin::p_lin_r2(A, F);
        GSYNC();
    }
    { REFRESH(); pg8::DenseOrder S; S.init(P_YCAT, l == 0 ? P_WOUTE : P_WOUTO, NTOK, 1024, 1024, F.G, F.bid); pg8::EpiBf16Plain E{(bf16_t*)P_MBUF, DM};
      pg8::gemm_phase<pg8::EpiBf16Plain, pg8::DenseOrder, true>(lds3, F.wave, 1024, S, E); }
    GSYNC();
    REFRESH(); p_postmix(A, F, l);
    GSYNC();
    REFRESH(); const int MT = moe_tables(A, F, l, tb);
    {
        const int mX = (MT >> 5) << 5, kk = MT - mX, rr = (64 - ((2 * kk) & 63)) & 63;
        const int mY = mX >= rr ? rr + (((mX - rr) >> 6) << 6) : 0;
        if (mX > 0) {
            { REFRESH(); pg8::MoeOrder<true> S; S.Ap = (const char*)P_HB8; S.Bt = (const char*)(P_W1 + (size_t)l * 32 * 2048 * 1024); S.estride = (size_t)2048 * 1024; S.K = 512; S.NP = 8; S.nwg = mX * 8; S.G = F.G; S.c = F.bid; S.mt0 = 0;
              S.list_tk = P_LTK + (size_t)l * 32 * LISTCAP; S.tb = tb;
              pg8::EpiSwiglu E{P_ACT, A.in[I_BGU] + (size_t)l * 32 * 2048};
              pg8::gemm_phase<pg8::EpiSwiglu, pg8::MoeOrder<true>, true, true>(lds3, F.wave, 512, S, E); }
            GSYNC();
        }
        if (8 * (MT - mX) + 4 * mY > 0) {
            { REFRESH(); pg8::MoeMixOrder S; S.ws = (const char*)A.ws; S.l = l;
              S.a0 = mX; S.nA = 8 * (MT - mX); S.b0 = 0; S.nB = 4 * mY; S.nwg = S.nA + S.nB; S.G = F.G; S.c = F.bid; S.tb = tb;
              pg8::EpiMoeMix E{ap, l};
              pg8::gemm_phase<pg8::EpiMoeMix, pg8::MoeMixOrder, true, true>(lds3, F.wave, 512, S, E); }
            GSYNC();
        }
        if (MT > mY) {
            { REFRESH(); pg8::MoeOrder<false> S; S.Ap = (const char*)P_ACT; S.Bt = (const char*)(P_W2 + (size_t)l * 32 * 1024 * 1024); S.estride = (size_t)1024 * 1024; S.K = 512; S.NP = 4; S.nwg = (MT - mY) * 4; S.G = F.G; S.c = F.bid; S.mt0 = mY;
              S.list_tk = P_LTK + (size_t)l * 32 * LISTCAP; S.tb = tb;
              pg8::EpiDown E{P_Y, A.in[I_BDN] + (size_t)l * 32 * 1024, P_LTK + (size_t)l * 32 * LISTCAP, P_LG + (size_t)l * 32 * LISTCAP};
              pg8::gemm_phase<pg8::EpiDown, pg8::MoeOrder<false>, true, true>(lds3, F.wave, 512, S, E); }
            GSYNC();
        }
    }
    REFRESH(); p_combine(A, F, l);
}

__global__ void __launch_bounds__(512, 2) mk_fwd(Args A_) {
    extern __shared__ __attribute__((aligned(16))) unsigned char lds[];
    cg::grid_group grid = cg::this_grid();
    CArgs* ap = (CArgs*)__builtin_amdgcn_kernarg_segment_ptr();
    Frame F;
    F.lds = lds; F.wave = __builtin_amdgcn_readfirstlane((int)threadIdx.x >> 6); F.tid = 0; F.lane = 0; F.bid = blockIdx.x; F.G = gridDim.x;
    LAS unsigned char* lds3 = (LAS unsigned char*)lds;
    LAS pg8::MoeTables* tb = (LAS pg8::MoeTables*)(lds3 + 133632);
    { volatile LAS unsigned* st = (volatile LAS unsigned*)(lds3 + (LDS_BYTES - 64)); REFRESH(); if (F.tid < 2) st[F.tid] = 0u; __syncthreads(); }
    XcdBarrier xb = xcd_barrier_post((unsigned*)(A.ws + WS_CTL) + 10240, (volatile LAS unsigned*)(lds3 + (LDS_BYTES - 64)), F.tid);
    REFRESH(); p0_prep(A, F);
    if (A.pad != 0) grid.sync();
    GSYNC();
    asm volatile("s_sleep 40\n\ts_sleep 40" ::: "memory");
    REFRESH(); p1_hprep0(A, F);
    GSYNC();
    asm volatile("s_sleep 40\n\ts_sleep 40" ::: "memory");
    layer_fwd<0>(ap, F, xb, lds, lds3, tb);
    GSYNC();
    layer_fwd<1>(ap, F, xb, lds, lds3, tb);
}
#undef A

extern "C" void kernel_launch(void* const* d_in, const int* in_sizes, int n_in, void* d_out, int out_size, void* d_ws, size_t ws_size, hipStream_t stream) {
    static int grid = 0;
    if (grid == 0) {
        if (n_in != 31 || out_size != NTOK * DM || ws_size < WS_END) { fprintf(stderr, "kernel_launch: unexpected problem (n_in %d out %d ws %zu)\n", n_in, out_size, ws_size); grid = -1; return; }
        int dev = 0, cus = 0, per_cu = 0;
        if (hipGetDevice(&dev) != hipSuccess || hipDeviceGetAttribute(&cus, hipDeviceAttributeMultiprocessorCount, dev) != hipSuccess) { grid = -1; return; }
        if (hipFuncSetAttribute((const void*)mk_fwd, hipFuncAttributeMaxDynamicSharedMemorySize, LDS_BYTES) != hipSuccess) { fprintf(stderr, "kernel_launch: hipFuncSetAttribute failed\n"); grid = -1; return; }
        if (hipOccupancyMaxActiveBlocksPerMultiprocessor(&per_cu, (const void*)mk_fwd, 512, LDS_BYTES) != hipSuccess || per_cu < 1) { fprintf(stderr, "kernel_launch: occupancy query says %d blocks per CU\n", per_cu); (void)hipGetLastError(); }
        grid = cus;
        if (grid != 256) fprintf(stderr, "kernel_launch: %d CUs; this kernel is built for a 256-CU grid\n", grid);
    }
    if (grid < 0) return;
    if (hipMemsetAsync((char*)d_ws + WS_CTL, 0, CTL_ZERO_BYTES, stream) != hipSuccess) { fprintf(stderr, "kernel_launch: memset failed\n"); return; }
    Args a{};
    for (int i = 0; i < 31; ++i) a.in[i] = (const float*)d_in[i];
    a.out = (float*)d_out; a.ws = (unsigned char*)d_ws;
    void* kargs[] = {&a};
    const hipError_t e = hipLaunchCooperativeKernel((const void*)mk_fwd, dim3(grid), dim3(512), kargs, LDS_BYTES, stream);
    if (e != hipSuccess) fprintf(stderr, "kernel_launch: cooperative launch failed: %s (grid %d)\n", hipGetErrorString(e), grid);
}
```

```cpp
#include <hip/hip_runtime.h>
#include <hip/hip_cooperative_groups.h>
#include <cstdio>
#include <cstdint>
namespace cg = cooperative_groups;

#define LAS __attribute__((address_space(3)))
typedef unsigned short bf16_t;
typedef short bf16x8 __attribute__((ext_vector_type(8)));
typedef float f32x4 __attribute__((ext_vector_type(4)));
typedef float f32x2 __attribute__((ext_vector_type(2)));
typedef unsigned u32x4 __attribute__((ext_vector_type(4)));
typedef unsigned u32x2 __attribute__((ext_vector_type(2)));
typedef int i32x4 __attribute__((ext_vector_type(4)));
typedef int i32x8 __attribute__((ext_vector_type(8)));

constexpr int NTOK = 16384, DM = 1024, SEQ = 2048, NB = 8;
constexpr int NEXP = 32, LISTCAP = 16384;
constexpr float EPS = 1e-6f;
constexpr float LOG2E = 1.4426950408889634f;
constexpr float C2 = 0.125f * LOG2E;
constexpr int ZP0 = 2048, ZP1 = 3584;

constexpr size_t MiB = 1u << 20;
constexpr size_t WS_CTL = 0, CTL_ZERO_BYTES = 65536;
constexpr size_t WS_MOD = 1 * MiB;
constexpr size_t WS_WSIDE = 1 * MiB + 512 * 1024;
constexpr size_t WS_S5A = 2 * MiB;
constexpr size_t WS_S5BB = 2 * MiB + 65536;
constexpr size_t WS_S5CK = 2 * MiB + 512 * 1024;
constexpr size_t WS_ROPE = 3 * MiB;
constexpr size_t WS_LTK = 4 * MiB;
constexpr size_t WS_LG = 8 * MiB;
constexpr size_t WS_WINE = 16 * MiB, WS_WGLU = 20 * MiB, WS_WOUTE = 21 * MiB, WS_WINO = 23 * MiB, WS_WOUTO = 30 * MiB;
constexpr size_t WS_W1 = 32 * MiB;
constexpr size_t WS_HB8 = 160 * MiB;
constexpr size_t WS_W2 = 288 * MiB;
constexpr size_t WS_HB = 416 * MiB;
constexpr size_t WS_Z = 448 * MiB;
constexpr size_t WS_LSIG = 560 * MiB;
constexpr size_t WS_LOGA = 562 * MiB;
constexpr size_t WS_G5 = 578 * MiB;
constexpr size_t WS_YCAT = 594 * MiB;
constexpr size_t WS_MBUF = 626 * MiB;
constexpr size_t WS_ACT = 690 * MiB;
constexpr size_t WS_Y = 834 * MiB;
constexpr size_t WS_RST = 962 * MiB;
constexpr size_t WS_GST = 994 * MiB;
constexpr size_t WS_XB = 1010 * MiB;
constexpr size_t WS_END = 1042 * MiB;
constexpr int CW_CNT = 1024;

constexpr int RING_BYTES = 131072;
constexpr int MISC_OFF = RING_BYTES;
constexpr int LDS_BYTES = 147456;

__device__ __forceinline__ unsigned f2bf(float f) { unsigned u = __builtin_bit_cast(unsigned, f); return (u + 0x7fffu + ((u >> 16) & 1u)) >> 16; }
typedef __bf16 bf16x2_hw __attribute__((ext_vector_type(2)));
__device__ __forceinline__ unsigned pk2(float lo, float hi) { const f32x2 v = {lo, hi}; return __builtin_bit_cast(unsigned, __builtin_convertvector(v, bf16x2_hw)); }
__device__ __forceinline__ float bflo(unsigned w) { return __builtin_bit_cast(float, w << 16); }
__device__ __forceinline__ float bfhi(unsigned w) { return __builtin_bit_cast(float, w & 0xffff0000u); }
__device__ __forceinline__ float bf1(bf16_t b) { return __builtin_bit_cast(float, ((unsigned)b) << 16); }
__device__ __forceinline__ int lane_id() { int l; asm volatile("v_mbcnt_lo_u32_b32 %0, -1, 0\n\tv_mbcnt_hi_u32_b32 %0, -1, %0" : "=v"(l)); return l; }
template <int CTRL> __device__ __forceinline__ float dppf(float v) { return __builtin_bit_cast(float, __builtin_amdgcn_update_dpp(0, __builtin_bit_cast(int, v), CTRL, 0xf, 0xf, true)); }
__device__ __forceinline__ float row16_sum(float v) {
    v += dppf<0xB1>(v); v += dppf<0x4E>(v); v += dppf<0x141>(v); v += dppf<0x140>(v); return v;
}
__device__ __forceinline__ float rdlane(float v, int l) { return __builtin_bit_cast(float, __builtin_amdgcn_readlane(__builtin_bit_cast(int, v), l)); }
__device__ __forceinline__ float wave_sum(float v) {
    v = row16_sum(v); return (rdlane(v, 0) + rdlane(v, 16)) + (rdlane(v, 32) + rdlane(v, 48));
}
__device__ __forceinline__ float half_sum(float v) {
    v = row16_sum(v); const float a = rdlane(v, 0) + rdlane(v, 16), b = rdlane(v, 32) + rdlane(v, 48); return (lane_id() < 32) ? a : b;
}
__device__ __forceinline__ float sigmoidf_(float x) { return __builtin_amdgcn_rcpf(1.f + __expf(-x)); }
__device__ __forceinline__ float log_sigmoidf_(float x) { return fminf(x, 0.f) - log1pf(__expf(-fabsf(x))); }
__device__ __forceinline__ float siluf_(float x) { return x * sigmoidf_(x); }
__device__ __forceinline__ float gelu_tanh(float x) { const float u2 = 1.5957691216057308f * (x + 0.044715f * x * x * x); return x * sigmoidf_(u2); }
constexpr float SC_H = 16.f, SC_W1 = 512.f, SC_A = 8.f, SC_W2 = 512.f, SC_WIN = 512.f, SC_Y = 64.f;
__device__ __forceinline__ unsigned pk8(float a, float b, float c, float d) {
    a = __builtin_amdgcn_fmed3f(a, -448.f, 448.f); b = __builtin_amdgcn_fmed3f(b, -448.f, 448.f); c = __builtin_amdgcn_fmed3f(c, -448.f, 448.f); d = __builtin_amdgcn_fmed3f(d, -448.f, 448.f);
    int r = __builtin_amdgcn_cvt_pk_fp8_f32(a, b, 0, false); r = __builtin_amdgcn_cvt_pk_fp8_f32(c, d, r, true); return (unsigned)r;
}
#define LDS_WAIT() asm volatile("s_waitcnt lgkmcnt(0)" ::: "memory")

struct Args { const float* in[31]; float* out; unsigned char* ws; long long pad; };
typedef const __attribute__((address_space(4))) Args CArgs;
enum { I_X = 0, I_C, I_ADAW, I_ADAB, I_NPM, I_NQM, I_NPF, I_NQF, I_EVWIN, I_FOXB, I_LAMRE, I_LAMIM, I_LOGDT, I_BRE, I_BIM, I_CRE, I_CIM, I_S5D, I_GLUW, I_GLUB, I_EVWOUT,
       I_ODWIN, I_GLAWUP, I_GLABG, I_ODWOUT, I_RW, I_RB, I_WGU, I_BGU, I_WDN, I_BDN };

namespace pg8 {
constexpr int BM = 256, BK = 64, HALF = 128, HTB = HALF * BK * 2, STAGE_BYTES = 8 * HTB, NXCD = 8, WGM = 8;
__device__ __forceinline__ int lds_byte(int r, int c) { const int st = (r >> 4) * 2 + (c >> 5), rr = r & 15, cc = c & 31, ob = rr * 64 + cc * 2; return st * 1024 + (ob ^ (((ob >> 9) & 1) << 5)); }
__device__ __forceinline__ void stage_rc(int b, int& R, int& C) { const int st = b / 1024, sb = b % 1024, swz = sb ^ (((sb >> 9) & 1) << 5); R = (st >> 1) * 16 + swz / 64; C = (st & 1) * 32 + (swz % 64) / 2; }
__device__ __forceinline__ int perm32(int rho) { const int n = rho >> 4, i = rho & 15; return 8 * (i >> 2) + 4 * n + (i & 3); }
__device__ __forceinline__ unsigned cvt_pk_bf16(float lo, float hi) { unsigned r; asm volatile("v_cvt_pk_bf16_f32 %0, %1, %2" : "=v"(r) : "v"(lo), "v"(hi)); return r; }

struct Unit { int pm, pn, e, mb, nrows, kind; };
__device__ __forceinline__ int xcd_remap(int L, int nwg) { const int q = nwg / NXCD, r = nwg % NXCD, xcd = L % NXCD, off = L / NXCD; return (xcd < r ? xcd * (q + 1) : r * (q + 1) + (xcd - r) * q) + off; }

struct DenseOrder {
    const char* Ap; const char* Bt; int K, nM, nN, nwg, G, c;
    __device__ __forceinline__ void init(const void* A_, const void* Bt_, int M, int N, int K_, int G_, int c_) { Ap = (const char*)A_; Bt = (const char*)Bt_; K = K_; nM = M / BM; nN = N / BM; nwg = nM * nN; G = G_; c = c_; }
    __device__ __forceinline__ bool next(int i, Unit& u) const {
        const long L = (long)i * G + c; if (L >= nwg) return false;
        const int wgid = xcd_remap((int)L, nwg);
        const int nig = WGM * nN, gid = wgid / nig, fm = gid * WGM, gsz = (nM - fm) < WGM ? (nM - fm) : WGM;
        u.pm = fm + ((wgid % nig) % gsz); u.pn = (wgid % nig) / gsz; u.e = 0; u.mb = u.pm; u.nrows = BM; u.kind = 0; return true;
    }
    __device__ __forceinline__ const char* a_base(const Unit& u) const { return Ap + (size_t)u.pm * ((size_t)BM * K * 2); }
    __device__ __forceinline__ const char* b_base(const Unit& u) const { return Bt + (size_t)u.pn * ((size_t)BM * K * 2); }
    __device__ __forceinline__ void a_raw(const Unit&, const int (&)[2], int (&raw)[2][2]) const { raw[0][0] = raw[0][1] = raw[1][0] = raw[1][1] = 0; }
    __device__ __forceinline__ void a_offs(const Unit&, const int (&R)[2], const int (&C)[2], const int (&)[2][2], unsigned (&v)[2][2]) const {
#pragma unroll
        for (int h = 0; h < 2; ++h)
#pragma unroll
            for (int i = 0; i < 2; ++i) v[h][i] = (unsigned)((h * HALF + R[i]) * K + C[i]) * 2u;
    }
};
struct MoeTables { int cnt[NEXP]; int mtstart[NEXP + 1]; unsigned char tile_e[320]; };
template <bool GATHER> struct MoeOrder {
    const char* Ap; const char* Bt; size_t estride; int K, NP, nwg, G, c, mt0; const int* list_tk; const LAS MoeTables* tb;
    __device__ __forceinline__ bool next(int i, Unit& u) const {
        const long L = (long)i * G + c; if (L >= nwg) return false;
        const int w = xcd_remap((int)L, nwg);
        const int mq = w / NP, mt = mt0 + mq; u.pn = w - mq * NP; u.pm = mt; u.e = tb->tile_e[mt]; u.mb = mt - tb->mtstart[u.e];
        const int left = tb->cnt[u.e] - u.mb * BM; u.nrows = left < BM ? left : BM; u.kind = GATHER ? 0 : 1; return true;
    }
    __device__ __forceinline__ const char* a_base(const Unit& u) const { return GATHER ? Ap : Ap + (size_t)u.pm * ((size_t)BM * K * 2); }
    __device__ __forceinline__ const char* b_base(const Unit& u) const { return Bt + (size_t)u.e * estride + (size_t)u.pn * ((size_t)BM * K * 2); }
    __device__ __forceinline__ void a_raw(const Unit& u, const int (&R)[2], int (&raw)[2][2]) const {
#pragma unroll
        for (int h = 0; h < 2; ++h)
#pragma unroll
            for (int i = 0; i < 2; ++i) { if (GATHER) { const int r = h * HALF + R[i], rc = r < u.nrows ? r : 0; raw[h][i] = list_tk[u.e * LISTCAP + u.mb * BM + rc]; } else raw[h][i] = 0; }
    }
    __device__ __forceinline__ void a_offs(const Unit&, const int (&R)[2], const int (&C)[2], const int (&raw)[2][2], unsigned (&v)[2][2]) const {
#pragma unroll
        for (int h = 0; h < 2; ++h)
#pragma unroll
            for (int i = 0; i < 2; ++i) {
                if (GATHER) v[h][i] = (unsigned)((raw[h][i] >> 2) * K + C[i]) * 2u;
                else v[h][i] = (unsigned)((h * HALF + R[i]) * K + C[i]) * 2u;
            }
    }
};

struct MoeMixOrder {
    const char* ws; int l, a0, nA, b0, nB, nwg, G, c; const LAS MoeTables* tb;
    static constexpr int K = 512;
    __device__ __forceinline__ bool next(int i, Unit& u) const {
        const long L = (long)i * G + c; if (L >= nwg) return false;
        int w = xcd_remap((int)L, nwg), mt;
        if (w < nA) { u.kind = 0; mt = a0 + (w >> 3); u.pn = w & 7; } else { w -= nA; u.kind = 1; mt = b0 + (w >> 2); u.pn = w & 3; }
        u.pm = mt; u.e = tb->tile_e[mt]; u.mb = mt - tb->mtstart[u.e];
        const int left = tb->cnt[u.e] - u.mb * BM; u.nrows = left < BM ? left : BM; return true;
    }
    __device__ __forceinline__ const char* a_base(const Unit& u) const { return u.kind ? ws + WS_ACT : ws + WS_HB8; }
    __device__ __forceinline__ const char* b_base(const Unit& u) const { return u.kind ? ws + WS_W2 + (size_t)(l * 32 + u.e) * ((size_t)1024 * K * 2) + (size_t)u.pn * ((size_t)BM * K * 2) : ws + WS_W1 + (size_t)(l * 32 + u.e) * ((size_t)2048 * K * 2) + (size_t)u.pn * ((size_t)BM * K * 2); }
    __device__ __forceinline__ void a_raw(const Unit& u, const int (&R)[2], int (&raw)[2][2]) const {
#pragma unroll
        for (int h = 0; h < 2; ++h)
#pragma unroll
            for (int i = 0; i < 2; ++i) { const int r = h * HALF + R[i], rc = r < u.nrows ? r : 0; raw[h][i] = u.kind ? 4 * (u.pm * BM + r) : ((const int*)(ws + WS_LTK))[(l * 32 + u.e) * LISTCAP + u.mb * BM + rc]; }
    }
    __device__ __forceinline__ void a_offs(const Unit& u, const int (&R)[2], const int (&C)[2], const int (&raw)[2][2], unsigned (&v)[2][2]) const {
#pragma unroll
        for (int h = 0; h < 2; ++h)
#pragma unroll
            for (int i = 0; i < 2; ++i) v[h][i] = (unsigned)((raw[h][i] >> 2) * K + C[i]) * 2u;
    }
};

template <class Epi, class Sched, bool ALIGN_EPI, bool FP8 = false>
__device__ __forceinline__ void gemm_phase(LAS unsigned char* lds, const int wave_, const int K, const Sched& S, const Epi& E) {
    int tid_ = wave_ * 64 + lane_id(); asm volatile("" : "+v"(tid_));
    const int tid = tid_, wid = wave_, lane = tid & 63, wr = wid >> 2, wc = wid & 3, fr = lane & 15, fq = lane >> 4;
    int nt_ = K / BK; if constexpr (FP8) asm volatile("" : "+s"(nt_));
    const int nt = nt_;
    int Rr[2], Cc[2]; unsigned voffB[2];
#pragma unroll
    for (int i = 0; i < 2; ++i) { stage_rc(tid * 16 + i * 8192, Rr[i], Cc[i]); const int Rb = Epi::PERM ? ((Rr[i] & ~31) + perm32(Rr[i] & 31)) : Rr[i]; voffB[i] = (unsigned)(Rb * K + Cc[i]) * 2u; }
    const size_t kstep = (size_t)(BK * 2);
    const size_t hstep = (size_t)HALF * K * 2;
    const unsigned ldsw = (unsigned)wid * 1024u;
    const int aoff = lds_byte(wr * 64 + fr, fq * 8), boff = lds_byte(wc * 32 + fr, fq * 8);
#define PG8_SA(b, h) (((b) * 2 + (h)) * HTB)
#define PG8_SB(b, h) ((4 + (b) * 2 + (h)) * HTB)
#define PG8_STAGE(bufoff, gbase, voff) do { _Pragma("unroll") for (int _i = 0; _i < 2; ++_i) { unsigned vo_ = (voff)[_i]; if constexpr (FP8) asm volatile("" : "+v"(vo_));   \
        __builtin_amdgcn_global_load_lds((const unsigned*)((const char*)(gbase) + vo_), (LAS unsigned*)(lds + (bufoff) + ldsw + _i * 8192), 16, 0, 0); } } while (0)
#define PG8_LDA(dst, b, h) do { _Pragma("unroll") for (int m = 0; m < 4; ++m) { \
        if constexpr (FP8) { const i32x4 lo_ = *(const LAS i32x4*)(lds + PG8_SA(b, h) + aoff + m * 2048), hi_ = *(const LAS i32x4*)(lds + PG8_SA(b, h) + aoff + m * 2048 + 1024); dst##8[m] = __builtin_shufflevector(lo_, hi_, 0, 1, 2, 3, 4, 5, 6, 7); } \
        else { _Pragma("unroll") for (int k = 0; k < 2; ++k) dst[m][k] = *(const LAS bf16x8*)(lds + PG8_SA(b, h) + aoff + m * 2048 + k * 1024); } } } while (0)
#define PG8_LDB(dst, b, h) do { _Pragma("unroll") for (int n = 0; n < 2; ++n) { \
        if constexpr (FP8) { const i32x4 lo_ = *(const LAS i32x4*)(lds + PG8_SB(b, h) + boff + n * 2048), hi_ = *(const LAS i32x4*)(lds + PG8_SB(b, h) + boff + n * 2048 + 1024); dst##8[n] = __builtin_shufflevector(lo_, hi_, 0, 1, 2, 3, 4, 5, 6, 7); } \
        else { _Pragma("unroll") for (int k = 0; k < 2; ++k) dst[n][k] = *(const LAS bf16x8*)(lds + PG8_SB(b, h) + boff + n * 2048 + k * 1024); } } } while (0)
#define PG8_MMA(ai, bj, At, Bt) do { __builtin_amdgcn_s_setprio(1); _Pragma("unroll") for (int m = 0; m < 4; ++m) _Pragma("unroll") for (int n = 0; n < 2; ++n) { \
        if constexpr (FP8) asm volatile("v_mfma_f32_16x16x128_f8f6f4 %0, %1, %2, %0" : "+v"(acc[ai][bj][m][n]) : "v"(Bt##8[n]), "v"(At##8[m]));   \
        else { _Pragma("unroll") for (int k = 0; k < 2; ++k) acc[ai][bj][m][n] = __builtin_amdgcn_mfma_f32_16x16x32_bf16(Bt[n][k], At[m][k], acc[ai][bj][m][n], 0, 0, 0); } } \
        __builtin_amdgcn_s_setprio(0); } while (0)
#define PG8_WAIT_V(n) asm volatile("s_waitcnt vmcnt(" #n ")" ::: "memory")
#define PG8_WAIT_L(n) asm volatile("s_waitcnt lgkmcnt(" #n ")" ::: "memory")
#define PG8_BAR __builtin_amdgcn_s_barrier()
#define PG8_SCHED __builtin_amdgcn_sched_barrier(0)
    Unit cur, nxt; int ui = 0;
    if (!S.next(0, cur)) return;
    f32x4 acc[2][2][4][2];
#pragma unroll
    for (int a = 0; a < 2; ++a)
#pragma unroll
        for (int b = 0; b < 2; ++b)
#pragma unroll
            for (int m = 0; m < 4; ++m)
#pragma unroll
                for (int n = 0; n < 2; ++n) acc[a][b][m][n] = (f32x4){0.f, 0.f, 0.f, 0.f};
    bf16x8 At[4][2], B0[2][2], B1[2][2]; i32x8 At8[4], B08[2], B18[2];
    const char* cA = S.a_base(cur); const char* cB = S.b_base(cur);
    unsigned cv[2][2], nv[2][2]; int raw[2][2];
    S.a_raw(cur, Rr, raw); S.a_offs(cur, Rr, Cc, raw, cv);
    PG8_STAGE(PG8_SB(0, 0), cB, voffB); PG8_STAGE(PG8_SB(0, 1), cB + hstep, voffB); PG8_STAGE(PG8_SA(0, 0), cA, cv[0]); PG8_STAGE(PG8_SA(0, 1), cA, cv[1]);
    if (wr == 1) PG8_BAR;
    PG8_WAIT_V(2); PG8_BAR;
    PG8_STAGE(PG8_SB(1, 0), cB + kstep, voffB); PG8_STAGE(PG8_SA(1, 0), cA + kstep, cv[0]); PG8_STAGE(PG8_SB(1, 1), cB + hstep + kstep, voffB);
    PG8_WAIT_V(6); PG8_BAR;
    for (;;) {
        const bool has_next = S.next(ui + 1, nxt);
        const char* nA = has_next ? S.a_base(nxt) : cA; const char* nB = has_next ? S.b_base(nxt) : cB;
        if (has_next) S.a_raw(nxt, Rr, raw);
#pragma unroll
        for (int h = 0; h < 2; ++h)
#pragma unroll
            for (int i = 0; i < 2; ++i) nv[h][i] = cv[h][i];
        for (int t = 0; t < nt; t += 2) {
            const bool last = (t == nt - 2);
            if (last && has_next) S.a_offs(nxt, Rr, Cc, raw, nv);
            const char* a1 = cA + (size_t)(t + 1) * kstep;
            const char* a2 = last ? nA : cA + (size_t)(t + 2) * kstep; const char* b2 = last ? nB : cB + (size_t)(t + 2) * kstep;
            const char* a3 = a2 + kstep; const char* b3 = b2 + kstep;
            unsigned v2[2][2];
#pragma unroll
            for (int h = 0; h < 2; ++h)
#pragma unroll
                for (int i = 0; i < 2; ++i) v2[h][i] = last ? nv[h][i] : cv[h][i];
            PG8_LDB(B0, 0, 0); PG8_LDB(B1, 0, 1); PG8_SCHED; PG8_LDA(At, 0, 0); PG8_STAGE(PG8_SA(1, 1), a1, cv[1]);
            PG8_WAIT_V(8); PG8_WAIT_L(0); PG8_BAR; PG8_MMA(0, 0, At, B0); PG8_MMA(0, 1, At, B1); PG8_BAR; PG8_SCHED;
            PG8_LDA(At, 0, 1); PG8_STAGE(PG8_SB(0, 0), b2, voffB); PG8_STAGE(PG8_SB(0, 1), b2 + hstep, voffB); PG8_STAGE(PG8_SA(0, 0), a2, v2[0]);
            PG8_WAIT_V(8); PG8_WAIT_L(0); PG8_BAR; PG8_MMA(1, 0, At, B0); PG8_MMA(1, 1, At, B1); PG8_BAR; PG8_SCHED;
            PG8_LDB(B0, 1, 0); PG8_LDB(B1, 1, 1); PG8_SCHED; PG8_LDA(At, 1, 0); PG8_STAGE(PG8_SA(0, 1), a2, v2[1]);
            PG8_WAIT_V(8); PG8_WAIT_L(0); PG8_BAR; PG8_MMA(0, 0, At, B0); PG8_MMA(0, 1, At, B1); PG8_BAR; PG8_SCHED;
            PG8_LDA(At, 1, 1); PG8_STAGE(PG8_SB(1, 0), b3, voffB); PG8_STAGE(PG8_SB(1, 1), b3 + hstep, voffB); PG8_STAGE(PG8_SA(1, 0), a3, v2[0]);
            PG8_WAIT_V(8); PG8_WAIT_L(0); PG8_BAR; PG8_MMA(1, 0, At, B0); PG8_MMA(1, 1, At, B1); PG8_BAR; PG8_SCHED;
        }
        if constexpr (ALIGN_EPI) { if (wr == 0) PG8_BAR; }
        if constexpr (FP8) asm volatile("s_nop 15\n\ts_nop 15" ::: "memory");
        E(acc, cur, wr, wc, fr, fq);
        if (!has_next) break;
#pragma unroll
        for (int a = 0; a < 2; ++a)
#pragma unroll
            for (int b = 0; b < 2; ++b)
#pragma unroll
                for (int m = 0; m < 4; ++m)
#pragma unroll
                    for (int n = 0; n < 2; ++n) acc[a][b][m][n] = (f32x4){0.f, 0.f, 0.f, 0.f};
        cur = nxt; cA = nA; cB = nB; ++ui;
#pragma unroll
        for (int h = 0; h < 2; ++h)
#pragma unroll
            for (int i = 0; i < 2; ++i) cv[h][i] = nv[h][i];
        if constexpr (ALIGN_EPI) { if (wr == 1) PG8_BAR; }
    }
    PG8_WAIT_V(0);
    if constexpr (!ALIGN_EPI) { if (wr == 0) PG8_BAR; }
    PG8_BAR;
#undef PG8_SA
#undef PG8_SB
#undef PG8_STAGE
#undef PG8_LDA
#undef PG8_LDB
#undef PG8_MMA
#undef PG8_WAIT_V
#undef PG8_WAIT_L
#undef PG8_BAR
#undef PG8_SCHED
}
}
namespace pg8 {
typedef f32x4 Acc[2][2][4][2];
struct EpiZ0 {
    static constexpr bool PERM = true;
    bf16_t* Z;
    __device__ __forceinline__ void operator()(const Acc& acc, const Unit& u, int wr, int wc, int fr, int fq) const {
        const float sc = (u.pn == 2 || u.pn == 3) ? C2 : 1.f;
        const int row0 = u.pm * BM + wr * 64 + fr, col0 = u.pn * BM + wc * 32 + 8 * fq;
#pragma unroll
        for (int ai = 0; ai < 2; ++ai)
#pragma unroll
            for (int m = 0; m < 4; ++m) { bf16_t* rowp = Z + (size_t)(row0 + ai * HALF + m * 16) * ZP0 + col0;
#pragma unroll
                for (int bj = 0; bj < 2; ++bj) { const f32x4 v0 = acc[ai][bj][m][0] * sc, v1 = acc[ai][bj][m][1] * sc;
                    u32x4 w; w.x = cvt_pk_bf16(v0[0], v0[1]); w.y = cvt_pk_bf16(v0[2], v0[3]); w.z = cvt_pk_bf16(v1[0], v1[1]); w.w = cvt_pk_bf16(v1[2], v1[3]);
                    *(u32x4*)(rowp + bj * HALF) = w; } }
    }
};
struct EpiZ1 {
    static constexpr bool PERM = true;
    bf16_t* Z; const float* rope;
    __device__ __forceinline__ void operator()(const Acc& acc, const Unit& u, int wr, int wc, int fr, int fq) const {
        constexpr float INV = 1.f / (SC_H * SC_WIN);
        const int row0 = u.pm * BM + wr * 64 + fr;
        if (u.pn < 4) {
            const float sc = (u.pn >= 2) ? 0.08838834764831845f * INV : INV;
            const int hl = wc >> 1, jj0 = 32 * (wc & 1) + 8 * fq;
#pragma unroll
            for (int ai = 0; ai < 2; ++ai)
#pragma unroll
                for (int m = 0; m < 4; ++m) { const int row = row0 + ai * HALF + m * 16, pos = row & (SEQ - 1);
                    const f32x4 c0 = *(const f32x4*)(rope + pos * 64 + jj0), c1 = *(const f32x4*)(rope + pos * 64 + jj0 + 4);
                    const f32x4 s0 = *(const f32x4*)(rope + SEQ * 64 + pos * 64 + jj0), s1 = *(const f32x4*)(rope + SEQ * 64 + pos * 64 + jj0 + 4);
                    const f32x4 x10 = acc[ai][0][m][0] * sc, x11 = acc[ai][0][m][1] * sc, x20 = acc[ai][1][m][0] * sc, x21 = acc[ai][1][m][1] * sc;
                    const f32x4 a0 = x10 * c0 - x20 * s0, a1 = x11 * c1 - x21 * s1, b0 = x10 * s0 + x20 * c0, b1 = x11 * s1 + x21 * c1;
                    bf16_t* rowp = Z + (size_t)row * ZP1 + u.pn * BM + 128 * hl + jj0;
                    u32x4 w; w.x = cvt_pk_bf16(a0[0], a0[1]); w.y = cvt_pk_bf16(a0[2], a0[3]); w.z = cvt_pk_bf16(a1[0], a1[1]); w.w = cvt_pk_bf16(a1[2], a1[3]);
                    *(u32x4*)(rowp) = w;
                    w.x = cvt_pk_bf16(b0[0], b0[1]); w.y = cvt_pk_bf16(b0[2], b0[3]); w.z = cvt_pk_bf16(b1[0], b1[1]); w.w = cvt_pk_bf16(b1[2], b1[3]);
                    *(u32x4*)(rowp + 64) = w; }
        } else {
            const float sc = (u.pn == 8) ? 0.125f * INV : INV;
            const int col0 = u.pn * BM + wc * 32 + 8 * fq;
#pragma unroll
            for (int ai = 0; ai < 2; ++ai)
#pragma unroll
                for (int m = 0; m < 4; ++m) { bf16_t* rowp = Z + (size_t)(row0 + ai * HALF + m * 16) * ZP1 + col0;
#pragma unroll
                    for (int bj = 0; bj < 2; ++bj) { const f32x4 v0 = acc[ai][bj][m][0] * sc, v1 = acc[ai][bj][m][1] * sc;
                        u32x4 w; w.x = cvt_pk_bf16(v0[0], v0[1]); w.y = cvt_pk_bf16(v0[2], v0[3]); w.z = cvt_pk_bf16(v1[0], v1[1]); w.w = cvt_pk_bf16(v1[2], v1[3]);
                        *(u32x4*)(rowp + bj * HALF) = w; } }
        }
    }
};
struct EpiGlu {
    static constexpr bool PERM = true;
    const bf16_t* G5; const float* bias; bf16_t* Y;
    __device__ __forceinline__ void operator()(const Acc& acc, const Unit& u, int wr, int wc, int fr, int fq) const {
        const int row0 = u.pm * BM + wr * 64 + fr, col0 = u.pn * BM + wc * 32 + 8 * fq;
        f32x4 bv[2][2];
#pragma unroll
        for (int bj = 0; bj < 2; ++bj)
#pragma unroll
            for (int n = 0; n < 2; ++n) bv[bj][n] = *(const f32x4*)(bias + col0 + bj * HALF + 4 * n);
#pragma unroll
        for (int ai = 0; ai < 2; ++ai)
#pragma unroll
            for (int m = 0; m < 4; ++m) { const size_t row = (size_t)(row0 + ai * HALF + m * 16);
#pragma unroll
                for (int bj = 0; bj < 2; ++bj) { const u32x4 gw = *(const u32x4*)(G5 + row * 512 + col0 + bj * HALF);
                    const f32x4 v0 = acc[ai][bj][m][0] + bv[bj][0], v1 = acc[ai][bj][m][1] + bv[bj][1];
                    float o[8]; o[0] = bflo(gw.x) * sigmoidf_(v0[0]); o[1] = bfhi(gw.x) * sigmoidf_(v0[1]); o[2] = bflo(gw.y) * sigmoidf_(v0[2]); o[3] = bfhi(gw.y) * sigmoidf_(v0[3]);
                    o[4] = bflo(gw.z) * sigmoidf_(v1[0]); o[5] = bfhi(gw.z) * sigmoidf_(v1[1]); o[6] = bflo(gw.w) * sigmoidf_(v1[2]); o[7] = bfhi(gw.w) * sigmoidf_(v1[3]);
                    u32x4 w; w.x = cvt_pk_bf16(o[0], o[1]); w.y = cvt_pk_bf16(o[2], o[3]); w.z = cvt_pk_bf16(o[4], o[5]); w.w = cvt_pk_bf16(o[6], o[7]);
                    *(u32x4*)(Y + row * DM + col0 + bj * HALF) = w; } }
    }
};
struct EpiF32 {
    static constexpr bool PERM = false;
    float* Cp; int ldc;
    __device__ __forceinline__ void operator()(const Acc& acc, const Unit& u, int wr, int wc, int fr, int fq) const {
        const int row0 = u.pm * BM + wr * 64 + fr, col0 = u.pn * BM + wc * 32 + 4 * fq;
#pragma unroll
        for (int ai = 0; ai < 2; ++ai)
#pragma unroll
            for (int m = 0; m < 4; ++m) { float* rowp = Cp + (size_t)(row0 + ai * HALF + m * 16) * ldc + col0;
#pragma unroll
                for (int bj = 0; bj < 2; ++bj)
#pragma unroll
                    for (int n = 0; n < 2; ++n) *(f32x4*)(rowp + bj * HALF + n * 16) = acc[ai][bj][m][n]; }
    }
};
struct EpiBf16Plain {
    static constexpr bool PERM = true;
    bf16_t* Cp; int ldc;
    __device__ __forceinline__ void operator()(const Acc& acc, const Unit& u, int wr, int wc, int fr, int fq) const {
        const int row0 = u.pm * BM + wr * 64 + fr, col0 = u.pn * BM + wc * 32 + 8 * fq;
#pragma unroll
        for (int ai = 0; ai < 2; ++ai)
#pragma unroll
            for (int m = 0; m < 4; ++m) { bf16_t* rowp = Cp + (size_t)(row0 + ai * HALF + m * 16) * ldc + col0;
#pragma unroll
                for (int bj = 0; bj < 2; ++bj) { const f32x4 v0 = acc[ai][bj][m][0], v1 = acc[ai][bj][m][1];
                    u32x4 w; w.x = cvt_pk_bf16(v0[0], v0[1]); w.y = cvt_pk_bf16(v0[2], v0[3]); w.z = cvt_pk_bf16(v1[0], v1[1]); w.w = cvt_pk_bf16(v1[2], v1[3]);
                    *(u32x4*)(rowp + bj * HALF) = w; } }
    }
};
struct EpiSwiglu {
    static constexpr bool PERM = true;
    unsigned char* ACT; const float* bgu;
    __device__ __forceinline__ void operator()(const Acc& acc, const Unit& u, int wr, int wc, int fr, int fq) const {
        constexpr float INV = 1.f / (SC_H * SC_W1), INVL = INV * SC_A, CE = -1.702f * LOG2E;
        const int row0 = u.pm * BM + wr * 64 + fr, j0 = wc * 32 + 8 * fq, colg = u.pn * 128 + j0;
        const float* bp = bgu + (size_t)u.e * 2048 + colg;
        f32x2 bg[4], bl[4];
#pragma unroll
        for (int p = 0; p < 4; ++p) { bg[p] = *(const f32x2*)(bp + 2 * p); bl[p] = (*(const f32x2*)(bp + 1024 + 2 * p) + 1.f) * SC_A; }
#pragma unroll
        for (int ai = 0; ai < 2; ++ai)
#pragma unroll
            for (int m = 0; m < 4; ++m) {
                f32x2 o[4];
#pragma unroll
                for (int p = 0; p < 4; ++p) {
                    const f32x4 ag = acc[ai][0][m][p >> 1], al = acc[ai][1][m][p >> 1];
                    const f32x2 g = (p & 1 ? (f32x2){ag[2], ag[3]} : (f32x2){ag[0], ag[1]}) * INV + bg[p], l = (p & 1 ? (f32x2){al[2], al[3]} : (f32x2){al[0], al[1]}) * INVL + bl[p];
                    const f32x2 a = {fminf(g.x, 7.f), fminf(g.y, 7.f)}, b = {__builtin_amdgcn_fmed3f(l.x, -6.f * SC_A, 8.f * SC_A), __builtin_amdgcn_fmed3f(l.y, -6.f * SC_A, 8.f * SC_A)};
                    const f32x2 t = a * CE; const f32x2 d = (f32x2){__builtin_amdgcn_exp2f(t.x), __builtin_amdgcn_exp2f(t.y)} + 1.f;
                    const f32x2 sg = {__builtin_amdgcn_rcpf(d.x), __builtin_amdgcn_rcpf(d.y)};
                    o[p] = (a * sg) * b; }
                u32x2 w; int r0 = __builtin_amdgcn_cvt_pk_fp8_f32(o[0].x, o[0].y, 0, false); r0 = __builtin_amdgcn_cvt_pk_fp8_f32(o[1].x, o[1].y, r0, true);
                int r1 = __builtin_amdgcn_cvt_pk_fp8_f32(o[2].x, o[2].y, 0, false); r1 = __builtin_amdgcn_cvt_pk_fp8_f32(o[3].x, o[3].y, r1, true);
                w.x = (unsigned)r0; w.y = (unsigned)r1;
                *(u32x2*)(ACT + (size_t)(row0 + ai * HALF + m * 16) * DM + colg) = w; }
    }
};
struct EpiDown {
    static constexpr bool PERM = true;
    unsigned char* Y; const float* bdn; const int* list_tk; const float* list_g;
    __device__ __forceinline__ void operator()(const Acc& acc, const Unit& u, int wr, int wc, int fr, int fq) const {
        constexpr float INV = SC_Y / (SC_A * SC_W2);
        const int r0 = wr * 64 + fr, col0 = u.pn * BM + wc * 32 + 8 * fq;
        const float* bp = bdn + (size_t)u.e * DM + col0;
        f32x4 bv[2][2];
#pragma unroll
        for (int bj = 0; bj < 2; ++bj)
#pragma unroll
            for (int n = 0; n < 2; ++n) bv[bj][n] = *(const f32x4*)(bp + bj * HALF + 4 * n) * SC_Y;
        const size_t lbase = (size_t)u.e * LISTCAP + (size_t)u.mb * BM;
        int tkv[2][4]; float gtv[2][4];
#pragma unroll
        for (int ai = 0; ai < 2; ++ai)
#pragma unroll
            for (int m = 0; m < 4; ++m) { const int r = r0 + ai * HALF + m * 16, rc = r < u.nrows ? r : 0; tkv[ai][m] = list_tk[lbase + rc]; gtv[ai][m] = list_g[lbase + rc]; }
#pragma unroll
        for (int ai = 0; ai < 2; ++ai)
#pragma unroll
            for (int m = 0; m < 4; ++m) { const int r = r0 + ai * HALF + m * 16;
                if (r < u.nrows) { const float gt = gtv[ai][m];
                    unsigned char* rowp = Y + (size_t)tkv[ai][m] * DM + col0;
#pragma unroll
                    for (int bj = 0; bj < 2; ++bj) { const float gi = gt * INV; const f32x4 v0 = acc[ai][bj][m][0] * gi + bv[bj][0] * gt, v1 = acc[ai][bj][m][1] * gi + bv[bj][1] * gt;
                        u32x2 w; w.x = pk8(v0[0], v0[1], v0[2], v0[3]); w.y = pk8(v1[0], v1[1], v1[2], v1[3]);
                        *(u32x2*)(rowp + bj * HALF) = w; } } }
    }
};
struct EpiMoeMix {
    static constexpr bool PERM = true;
    CArgs* ap; int l;
    __device__ __forceinline__ void operator()(const Acc& acc, const Unit& u, int wr, int wc, int fr, int fq) const {
        CArgs& A = *ap; unsigned char* ws = A.ws;
        if (u.kind == 0) { const EpiSwiglu sw{ws + WS_ACT, A.in[I_BGU] + (size_t)l * 32 * 2048}; sw(acc, u, wr, wc, fr, fq); }
        else { const EpiDown dn{ws + WS_Y, A.in[I_BDN] + (size_t)l * 32 * 1024, (const int*)(ws + WS_LTK) + (size_t)l * 32 * LISTCAP, (const float*)(ws + WS_LG) + (size_t)l * 32 * LISTCAP}; dn(acc, u, wr, wc, fr, fq); }
    }
};
}
struct Frame { unsigned char* lds; int tid, lane, wave, bid, G; };
#define P_MOD   ((float*)(A.ws + WS_MOD))
#define P_S5A   ((float*)(A.ws + WS_S5A))
#define P_S5BB  ((float*)(A.ws + WS_S5BB))
#define P_ROPE  ((float*)(A.ws + WS_ROPE))
#define P_WSIDE ((float*)(A.ws + WS_WSIDE))
#define P_S5CK  ((bf16_t*)(A.ws + WS_S5CK))
#define P_LTK   ((int*)(A.ws + WS_LTK))
#define P_LG    ((float*)(A.ws + WS_LG))
#define P_CNT   ((unsigned*)(A.ws + WS_CTL) + CW_CNT)
#define P_WINE  (A.ws + WS_WINE)
#define P_WGLU  ((bf16_t*)(A.ws + WS_WGLU))
#define P_WOUTE ((bf16_t*)(A.ws + WS_WOUTE))
#define P_WINO  (A.ws + WS_WINO)
#define P_WOUTO ((bf16_t*)(A.ws + WS_WOUTO))
#define P_W1    (A.ws + WS_W1)
#define P_W2    (A.ws + WS_W2)
#define P_HB8   (A.ws + WS_HB8)
#define P_HB    (A.ws + WS_HB)
#define P_Z     ((bf16_t*)(A.ws + WS_Z))
#define P_G5    ((bf16_t*)(A.ws + WS_G5))
#define P_YCAT  ((bf16_t*)(A.ws + WS_YCAT))
#define P_ACT   (A.ws + WS_ACT)
#define P_Y     (A.ws + WS_Y)
#define P_LSIG  ((float*)(A.ws + WS_LSIG))
#define P_LOGA  ((float*)(A.ws + WS_LOGA))
#define P_MBUF  ((float*)(A.ws + WS_MBUF))
#define P_XB    ((bf16_t*)(A.ws + WS_XB))
#define P_RST   ((bf16_t*)(A.ws + WS_RST))
#define P_GST   ((bf16_t*)(A.ws + WS_GST))

__device__ __forceinline__ void tr_tile(const float* __restrict__ src, int pitch, int k0, int c0, bf16_t* dst, int Kd, int r0, float* scr, int lane) {
#pragma unroll
    for (int i = 0; i < 16; ++i) {
        const int kk = 4 * i + (lane >> 4), cc = 4 * (lane & 15);
        const f32x4 v = __builtin_nontemporal_load((const f32x4*)(src + (size_t)(k0 + kk) * pitch + c0 + cc));
        float* s = scr + kk * 65 + cc; s[0] = v.x; s[1] = v.y; s[2] = v.z; s[3] = v.w;
    }
    LDS_WAIT();
    const int c = lane & 7;
#pragma unroll
    for (int j = 0; j < 8; ++j) { const int n = (lane >> 3) + 8 * j; const float* s = scr + (8 * c) * 65 + n;
        u32x4 o; o.x = pk2(s[0], s[65]); o.y = pk2(s[130], s[195]); o.z = pk2(s[260], s[325]); o.w = pk2(s[390], s[455]);
        __builtin_nontemporal_store(o, (u32x4*)(dst + (size_t)(r0 + n) * Kd + k0 + 8 * c)); }
    LDS_WAIT();
}
__device__ __forceinline__ void tr_tile8(const float* __restrict__ src, int pitch, int k0, int c0, unsigned char* dst, int Kd, int r0, float* scr, int lane, float scale) {
#pragma unroll
    for (int i = 0; i < 16; ++i) {
        const int kk = 4 * i + (lane >> 4), cc = 4 * (lane & 15);
        const f32x4 v = __builtin_nontemporal_load((const f32x4*)(src + (size_t)(k0 + kk) * pitch + c0 + cc));
        float* s = scr + kk * 65 + cc; s[0] = v.x * scale; s[1] = v.y * scale; s[2] = v.z * scale; s[3] = v.w * scale;
    }
    LDS_WAIT();
    const int c = lane & 3;
#pragma unroll
    for (int j = 0; j < 4; ++j) { const int n = (lane >> 2) + 16 * j; const float* s = scr + (16 * c) * 65 + n;
        u32x4 o; o.x = pk8(s[0], s[65], s[130], s[195]); o.y = pk8(s[260], s[325], s[390], s[455]); o.z = pk8(s[520], s[585], s[650], s[715]); o.w = pk8(s[780], s[845], s[910], s[975]);
        __builtin_nontemporal_store(o, (u32x4*)(dst + (size_t)(r0 + n) * Kd + k0 + 16 * c)); }
    LDS_WAIT();
}
__device__ __forceinline__ void p0_prep(CArgs& A, const Frame& F) {
    if (F.bid < 192) {
        float* sc = (float*)F.lds;
        float* red = sc + 8192;
        for (int i = F.tid; i < 8192; i += 512) sc[i] = siluf_(A.in[I_C][i]);
        __syncthreads();
        const int l = F.bid / 96, n = (F.bid % 96) * 64 + F.lane;
        const float* w = A.in[I_ADAW] + (size_t)l * 1024 * 6144 + n;
        float a[8];
#pragma unroll
        for (int b = 0; b < 8; ++b) a[b] = 0.f;
        for (int k = 128 * F.wave; k < 128 * F.wave + 128; ++k) { const float wv = w[(size_t)k * 6144];
#pragma unroll
            for (int b = 0; b < 8; ++b) a[b] += sc[b * 1024 + k] * wv; }
#pragma unroll
        for (int b = 0; b < 8; ++b) red[(F.wave * 8 + b) * 64 + F.lane] = a[b];
        __syncthreads();
        { const int b = F.tid >> 6, ln = F.tid & 63; float s = 0.f;
#pragma unroll
          for (int w8 = 0; w8 < 8; ++w8) s += red[(w8 * 8 + b) * 64 + ln];
          const int nn = (F.bid % 96) * 64 + ln; __hip_atomic_store(P_MOD + (size_t)(l * 8 + b) * 6144 + nn, s + A.in[I_ADAB][l * 6144 + nn], __ATOMIC_RELAXED, __HIP_MEMORY_SCOPE_AGENT); }
    }
    {
        const int gt = F.bid * 512 + F.tid;
        if (gt < 32 * 64) {
            const int g = gt >> 6;
            const float lr = A.in[I_LAMRE][gt], li = A.in[I_LAMIM][gt], dt = expf(A.in[I_LOGDT][g]);
            const float mag = expf(lr * dt); float sn, cs; sincosf(li * dt, &sn, &cs);
            const float are = mag * cs, aim = mag * sn, den = lr * lr + li * li, nre = are - 1.f, nim = aim;
            const float zre = (nre * lr + nim * li) / den, zim = (nim * lr - nre * li) / den;
            P_S5A[gt * 2] = are; P_S5A[gt * 2 + 1] = aim;
            for (int c = 0; c < 16; ++c) { const float br = A.in[I_BRE][gt * 16 + c], bi = A.in[I_BIM][gt * 16 + c];
                P_S5BB[gt * 32 + c] = zre * br - zim * bi; P_S5BB[gt * 32 + 16 + c] = zre * bi + zim * br; }
        }
        for (int i = gt; i < 32 * 16 * 128; i += F.G * 512) { const int k = i & 127, gc = i >> 7, pp = k >> 1; const float v = (k & 1) ? -A.in[I_CIM][gc * 64 + pp] : A.in[I_CRE][gc * 64 + pp]; P_S5CK[i] = (bf16_t)f2bf(v); }
        for (int i = gt; i < 24 * 1024; i += F.G * 512) { const int o = i >> 10, k = i & 1023; P_WSIDE[i] = o < 8 ? A.in[I_EVWIN][(size_t)k * 2056 + 2048 + o] : A.in[I_ODWIN][(size_t)k * 3600 + 3072 + (o - 8)]; }
        for (int i = gt; i < SEQ * 64; i += F.G * 512) { const int pos = i >> 6, j = i & 63;
            const float inv = exp2f(-(float)j * (13.287712379549449f / 64.f)); const float ang = (float)pos * inv; float sn, cs; sincosf(ang, &sn, &cs);
            P_ROPE[i] = cs; P_ROPE[SEQ * 64 + i] = sn; }
    }
    __syncthreads();
    float* scr = (float*)(F.lds) + F.wave * (64 * 65);
    const int gw = F.bid * 8 + F.wave, NGW = F.G * 8;
    constexpr int T0 = 16 * 32, T1 = 8 * 8, T2 = 16 * 16, T3 = 16 * 56, T4 = 16 * 16, T5 = 64 * 16 * 32, T6 = 64 * 16 * 16;
    constexpr int NTILES = T0 + T1 + T2 + T3 + T4 + T5 + T6;
    for (int it = gw; it < NTILES; it += NGW) {
        int r = it;
        if (r < T0) { const int kb = r / 32, nb = r % 32; tr_tile(A.in[I_EVWIN], 2056, kb * 64, nb * 64, (bf16_t*)P_WINE, 1024, nb * 64, scr, F.lane); continue; } r -= T0;
        if (r < T1) { const int kb = r / 8, nb = r % 8; tr_tile(A.in[I_GLUW], 512, kb * 64, nb * 64, P_WGLU, 512, nb * 64, scr, F.lane); continue; } r -= T1;
        if (r < T2) { const int kb = r / 16, nb = r % 16; tr_tile(A.in[I_EVWOUT], 1024, kb * 64, nb * 64, P_WOUTE, 1024, nb * 64, scr, F.lane); continue; } r -= T2;
        if (r < T3) { const int kb = r / 56, nb = r % 56; const int n0 = nb * 64; int c0;
            if (n0 < 1024) { const int pn = n0 >> 8, rem = n0 & 255, bj = rem >> 7, hl = (rem & 127) >> 6; c0 = 256 * pn + 128 * hl + 64 * bj; }
            else if (n0 < 3072) c0 = n0; else c0 = n0 + 16;
            tr_tile8(A.in[I_ODWIN], 3600, kb * 64, c0, P_WINO, 1024, n0, scr, F.lane, SC_WIN); continue; } r -= T3;
        if (r < T4) { const int kb = r / 16, nb = r % 16; tr_tile(A.in[I_ODWOUT], 1024, kb * 64, nb * 64, P_WOUTO, 1024, nb * 64, scr, F.lane); continue; } r -= T4;
        if (r < T5) { const int mat = r / 512, q = r % 512, kb = q / 32, nb = q % 32; const int n0 = nb * 64, pn = n0 >> 8, half = (n0 & 255) >> 7, j0 = n0 & 127;
            tr_tile8(A.in[I_WGU] + (size_t)mat * 1024 * 2048, 2048, kb * 64, half * 1024 + 128 * pn + j0, P_W1 + (size_t)mat * 2048 * 1024, 1024, n0, scr, F.lane, SC_W1); continue; } r -= T5;
        { const int mat = r / 256, q = r % 256, kb = q / 16, nb = q % 16;
            tr_tile8(A.in[I_WDN] + (size_t)mat * 1024 * 1024, 1024, kb * 64, nb * 64, P_W2 + (size_t)mat * 1024 * 1024, 1024, nb * 64, scr, F.lane, SC_W2); }
    }
}

struct Row { f32x4 v[4]; };
__device__ __forceinline__ void row_load(Row& r, const float* p, int lane) {
#pragma unroll
    for (int j = 0; j < 4; ++j) r.v[j] = __builtin_nontemporal_load((const f32x4*)(p + 4 * lane + 256 * j));
}
__device__ __forceinline__ void row_load_bf16(Row& r, const bf16_t* p, int lane) {
#pragma unroll
    for (int j = 0; j < 4; ++j) { const u32x2 w = __builtin_nontemporal_load((const u32x2*)(p + 4 * lane + 256 * j)); r.v[j] = (f32x4){bflo(w.x), bfhi(w.x), bflo(w.y), bfhi(w.y)}; }
}
__device__ __forceinline__ void row_store(const Row& r, float* p, int lane) {
#pragma unroll
    for (int j = 0; j < 4; ++j) __builtin_nontemporal_store(r.v[j], (f32x4*)(p + 4 * lane + 256 * j));
}
__device__ __forceinline__ void row_store_bf16(const Row& r, bf16_t* p, int lane) {
#pragma unroll
    for (int j = 0; j < 4; ++j) { u32x2 w; w.x = pk2(r.v[j].x, r.v[j].y); w.y = pk2(r.v[j].z, r.v[j].w); *(u32x2*)(p + 4 * lane + 256 * j) = w; }
}
__device__ __forceinline__ void row_store_bf16_nt(const Row& r, bf16_t* p, int lane) {
#pragma unroll
    for (int j = 0; j < 4; ++j) { u32x2 w; w.x = pk2(r.v[j].x, r.v[j].y); w.y = pk2(r.v[j].z, r.v[j].w); __builtin_nontemporal_store(w, (u32x2*)(p + 4 * lane + 256 * j)); }
}
__device__ __forceinline__ float row_rstd(const Row& r) {
    float s = 0.f;
#pragma unroll
    for (int j = 0; j < 4; ++j) s += (r.v[j].x * r.v[j].x + r.v[j].y * r.v[j].y) + (r.v[j].z * r.v[j].z + r.v[j].w * r.v[j].w);
    return rsqrtf(wave_sum(s) * (1.f / DM) + EPS);
}
__device__ __forceinline__ void row_modnorm(Row& h, const Row& x, const float* gain, const float* sh, const float* sc, int lane) {
    const float r = row_rstd(x);
#pragma unroll
    for (int j = 0; j < 4; ++j) { const int k = 4 * lane + 256 * j; const f32x4 g = *(const f32x4*)(gain + k), a = *(const f32x4*)(sc + k), b = *(const f32x4*)(sh + k);
        h.v[j] = x.v[j] * r * g * (a + 1.f) + b; }
}
__device__ __forceinline__ void hprep_row(CArgs& A, const Frame& F, const Row& x, int l, int row, const float* wl) {
    const int b = row >> 11, lane = F.lane; const float* mod = P_MOD + (size_t)(l * 8 + b) * 6144;
    Row h; row_modnorm(h, x, A.in[I_NPM] + l * DM, mod, mod + 1024, lane);
    if (l == 0) row_store_bf16(h, (bf16_t*)P_HB + (size_t)row * DM, lane);
    else {
#pragma unroll
        for (int j = 0; j < 4; ++j) *(unsigned*)(P_HB + (size_t)row * DM + 4 * lane + 256 * j) = pk8(SC_H * h.v[j].x, SC_H * h.v[j].y, SC_H * h.v[j].z, SC_H * h.v[j].w);
    }
    if (l == 0) {
        float mine = 0.f;
#pragma unroll
        for (int i = 0; i < 8; ++i) { float p = 0.f;
#pragma unroll
            for (int j = 0; j < 4; ++j) { const f32x4 w = *(const f32x4*)(wl + i * 1024 + 4 * lane + 256 * j); p += (h.v[j].x * w.x + h.v[j].y * w.y) + (h.v[j].z * w.z + h.v[j].w * w.w); }
            const float s = wave_sum(p); if (lane == i) mine = s; if ((i & 3) == 3) asm volatile("" ::: "memory"); }
        if (lane < 8) P_LSIG[(size_t)row * 8 + lane] = log_sigmoidf_(mine + A.in[I_FOXB][lane]);
    } else {
        float p[16];
#pragma unroll
        for (int i = 0; i < 16; ++i) { float q = 0.f;
#pragma unroll
            for (int j = 0; j < 4; ++j) { const f32x4 w = *(const f32x4*)(wl + i * 1024 + 4 * lane + 256 * j); q += (h.v[j].x * w.x + h.v[j].y * w.y) + (h.v[j].z * w.z + h.v[j].w * w.w); }
            p[i] = wave_sum(q); if ((i & 1) == 1) asm volatile("" ::: "memory"); }
        const float* wup = wl + 16 * 1024;
#pragma unroll
        for (int q = 0; q < 4; ++q) { const int jcol = lane + 64 * q; float s = wup[16 * 256 + jcol];
#pragma unroll
            for (int i = 0; i < 16; ++i) s += p[i] * wup[i * 256 + jcol];
            P_LOGA[(size_t)row * 256 + jcol] = log_sigmoidf_(s) * (1.f / 16.f); }
    }
}
__device__ __forceinline__ void stage_side(CArgs& A, const Frame& F, int l, float* wl) {
    __syncthreads();
    if (l == 0) { for (int i = F.tid; i < 8 * 256; i += 512) *(f32x4*)(wl + 4 * i) = *(const f32x4*)(P_WSIDE + 4 * i); }
    else { for (int i = F.tid; i < 16 * 256; i += 512) *(f32x4*)(wl + 4 * i) = *(const f32x4*)(P_WSIDE + 8192 + 4 * i);
           for (int i = F.tid; i < 16 * 64; i += 512) *(f32x4*)(wl + 16384 + 4 * i) = *(const f32x4*)(A.in[I_GLAWUP] + 4 * i);
           if (F.tid < 64) *(f32x4*)(wl + 16384 + 4096 + 4 * F.tid) = *(const f32x4*)(A.in[I_GLABG] + 4 * F.tid); }
    __syncthreads();
}
__device__ __forceinline__ void p1_hprep0(CArgs& A, const Frame& F) {
    float* wl = (float*)F.lds; stage_side(A, F, 0, wl);
    const int gw = F.bid * 8 + F.wave, NGW = F.G * 8;
    Row xn; if (gw < NTOK) row_load(xn, A.in[I_X] + (size_t)gw * DM, F.lane);
#pragma unroll 1
    for (int row = gw; row < NTOK; row += NGW) { Row x;
#pragma unroll
        for (int j = 0; j < 4; ++j) x.v[j] = xn.v[j];
        if (row + NGW < NTOK) row_load(xn, A.in[I_X] + (size_t)(row + NGW) * DM, F.lane); hprep_row(A, F, x, 0, row, wl); }
}

__device__ __forceinline__ void p_postmix(CArgs& A, const Frame& F, int l) {
    float* h2s = (float*)F.lds;
    float* red = h2s + 16 * 1028;
    float* lg = red + 8 * 16 * 32;
    float* tv = lg + 16 * 32;
    int* lcnt = (int*)(tv + 64);
    int* ent = lcnt + 64;
    if (F.tid < 32) lcnt[F.tid] = 0;
    int nent = 0;
    const float* rw = A.in[I_RW] + (size_t)l * 1024 * 32;
    u32x2 pm[2][4]; f32x4 pxf[2][4]; u32x2 pxb[2][4];
#define PM_LOAD(tile_) do { const int r0_ = (tile_) * 16 + 2 * F.wave; _Pragma("unroll") for (int rr = 0; rr < 2; ++rr) _Pragma("unroll") for (int j = 0; j < 4; ++j) { \
        pm[rr][j] = __builtin_nontemporal_load((const u32x2*)((const bf16_t*)P_MBUF + (size_t)(r0_ + rr) * DM + 4 * F.lane + 256 * j)); \
        if (l == 0) pxf[rr][j] = __builtin_nontemporal_load((const f32x4*)(A.in[I_X] + (size_t)(r0_ + rr) * DM + 4 * F.lane + 256 * j)); \
        else pxb[rr][j] = __builtin_nontemporal_load((const u32x2*)(P_XB + (size_t)(r0_ + rr) * DM + 4 * F.lane + 256 * j)); } } while (0)
    if (F.bid < NTOK / 16) PM_LOAD(F.bid);
#pragma unroll 1
    for (int tile = F.bid; tile < NTOK / 16; tile += F.G) {
        const int row0 = tile * 16 + 2 * F.wave;
        Row m0, x0, m1, x1;
#pragma unroll
        for (int j = 0; j < 4; ++j) { m0.v[j] = (f32x4){bflo(pm[0][j].x), bfhi(pm[0][j].x), bflo(pm[0][j].y), bfhi(pm[0][j].y)}; m1.v[j] = (f32x4){bflo(pm[1][j].x), bfhi(pm[1][j].x), bflo(pm[1][j].y), bfhi(pm[1][j].y)};
            if (l == 0) { x0.v[j] = pxf[0][j]; x1.v[j] = pxf[1][j]; }
            else { x0.v[j] = (f32x4){bflo(pxb[0][j].x), bfhi(pxb[0][j].x), bflo(pxb[0][j].y), bfhi(pxb[0][j].y)}; x1.v[j] = (f32x4){bflo(pxb[1][j].x), bfhi(pxb[1][j].x), bflo(pxb[1][j].y), bfhi(pxb[1][j].y)}; } }
        if (tile + F.G < NTOK / 16) PM_LOAD(tile + F.G);
#pragma unroll
        for (int rr = 0; rr < 2; ++rr) {
            const int lr = 2 * F.wave + rr, row = row0 + rr, b = row >> 11; const float* mod = P_MOD + (size_t)(l * 8 + b) * 6144;
            const Row& m = rr ? m1 : m0; Row x = rr ? x1 : x0;
            const float r1 = row_rstd(m);
#pragma unroll
            for (int j = 0; j < 4; ++j) { const int k = 4 * F.lane + 256 * j; const f32x4 gp = *(const f32x4*)(A.in[I_NQM] + l * DM + k), g1 = *(const f32x4*)(mod + 2048 + k);
                x.v[j] = x.v[j] + g1 * (m.v[j] * r1 * gp); }
            row_store_bf16_nt(x, P_XB + (size_t)row * DM, F.lane);
            Row h; row_modnorm(h, x, A.in[I_NPF] + l * DM, mod + 3072, mod + 4096, F.lane);
#pragma unroll
            for (int j = 0; j < 4; ++j) *(unsigned*)(P_HB8 + (size_t)row * DM + 4 * F.lane + 256 * j) = pk8(SC_H * h.v[j].x, SC_H * h.v[j].y, SC_H * h.v[j].z, SC_H * h.v[j].w);
#pragma unroll
            for (int j = 0; j < 4; ++j) *(f32x4*)(h2s + lr * 1028 + 4 * F.lane + 256 * j) = h.v[j];
        }
        __syncthreads();
        {
            f32x4 d0 = {0.f, 0.f, 0.f, 0.f}, d1 = {0.f, 0.f, 0.f, 0.f};
            const int r16 = F.lane & 15, kq = F.lane >> 4;
#pragma unroll 8
            for (int ks = 0; ks < 32; ++ks) { const int k = 128 * F.wave + 4 * ks + kq;
                const float a = h2s[r16 * 1028 + k]; const float b0 = rw[k * 32 + r16], b1 = rw[k * 32 + 16 + r16];
                d0 = __builtin_amdgcn_mfma_f32_16x16x4f32(a, b0, d0, 0, 0, 0); d1 = __builtin_amdgcn_mfma_f32_16x16x4f32(a, b1, d1, 0, 0, 0); }
#pragma unroll
            for (int q = 0; q < 4; ++q) { red[(F.wave * 16 + 4 * kq + q) * 32 + r16] = d0[q]; red[(F.wave * 16 + 4 * kq + q) * 32 + 16 + r16] = d1[q]; }
        }
        __syncthreads();
        const int r = F.tid >> 5, e = F.tid & 31;
        { float s = A.in[I_RB][l * 32 + e];
#pragma unroll
          for (int w8 = 0; w8 < 8; ++w8) s += red[(w8 * 16 + r) * 32 + e];
          lg[r * 32 + e] = s; }
        __syncthreads();
        const float v = lg[r * 32 + e]; int rank = 0;
#pragma unroll 8
        for (int q = 0; q < 32; ++q) { const float u = lg[r * 32 + q]; rank += (u > v || (u == v && q < e)) ? 1 : 0; }
        if (rank < 4) tv[r * 4 + rank] = v;
        __syncthreads();
        if (rank < 4) { const f32x4 t4 = *(const f32x4*)(tv + r * 4);
            const float wsum = 1.f + __expf(t4.y - t4.x) + __expf(t4.z - t4.x) + __expf(t4.w - t4.x), wk = __expf(v - t4.x);
            const int token = tile * 16 + r, lpos = atomicAdd(lcnt + e, 1), slot = nent + r * 4 + rank;
            ent[slot * 4] = e; ent[slot * 4 + 1] = lpos; ent[slot * 4 + 2] = token * 4 + rank; ent[slot * 4 + 3] = __float_as_int(wk / wsum); }
        nent += 64;
        __syncthreads();
    }
#undef PM_LOAD
    unsigned* cntp = P_CNT; int* ltk = P_LTK; float* lgp = P_LG;
    if (F.tid < 32) { const int n = lcnt[F.tid]; lcnt[32 + F.tid] = n > 0 ? (int)atomicAdd(cntp + 64 * (l * 32 + F.tid), (unsigned)n) : 0; }
    __syncthreads();
    if (F.tid < nent) { const int e = ent[F.tid * 4], pos = lcnt[32 + e] + ent[F.tid * 4 + 1];
        ltk[(size_t)(l * 32 + e) * LISTCAP + pos] = ent[F.tid * 4 + 2]; lgp[(size_t)(l * 32 + e) * LISTCAP + pos] = __int_as_float(ent[F.tid * 4 + 3]); }
    __syncthreads();
}
__device__ __forceinline__ void p_combine(CArgs& A, const Frame& F, int l) {
    float* wl = (float*)F.lds; if (l == 0) stage_side(A, F, 1, wl);
    const int gw = F.bid * 8 + F.wave, NGW = F.G * 8;
    unsigned y[4][4]; Row xr;
#define COMB_LOAD(row_) do { _Pragma("unroll") for (int k = 0; k < 4; ++k) _Pragma("unroll") for (int j = 0; j < 4; ++j) y[k][j] = __builtin_nontemporal_load((const unsigned*)(P_Y + (size_t)((row_) * 4 + k) * DM + 4 * F.lane + 256 * j)); \
        row_load_bf16(xr, P_XB + (size_t)(row_) * DM, F.lane); } while (0)
    if (gw < NTOK) COMB_LOAD(gw);
#pragma unroll 1
    for (int row = gw; row < NTOK; row += NGW) {
        const int b = row >> 11; const float* mod = P_MOD + (size_t)(l * 8 + b) * 6144;
        Row f;
#pragma unroll
        for (int j = 0; j < 4; ++j) { f.v[j] = (f32x4){0.f, 0.f, 0.f, 0.f};
#pragma unroll
            for (int k = 0; k < 4; ++k) { const f32x2 lo = __builtin_amdgcn_cvt_pk_f32_fp8((int)y[k][j], false), hi = __builtin_amdgcn_cvt_pk_f32_fp8((int)y[k][j], true); f.v[j].x += lo.x; f.v[j].y += lo.y; f.v[j].z += hi.x; f.v[j].w += hi.y; }
            f.v[j] = f.v[j] * (1.f / SC_Y); }
        Row x = xr;
        if (row + NGW < NTOK) COMB_LOAD(row + NGW);
        const float r = row_rstd(f);
#pragma unroll
        for (int j = 0; j < 4; ++j) { const int k = 4 * F.lane + 256 * j; const f32x4 gp = *(const f32x4*)(A.in[I_NQF] + l * DM + k), g2 = *(const f32x4*)(mod + 5120 + k);
            x.v[j] = x.v[j] + g2 * (f.v[j] * r * gp); }
        if (l == 0) row_store_bf16_nt(x, P_XB + (size_t)row * DM, F.lane); else row_store(x, A.out + (size_t)row * DM, F.lane);
        if (l == 0) hprep_row(A, F, x, 1, row, wl);
    }
#undef COMB_LOAD
}
__device__ __forceinline__ int moe_tables(CArgs& A, const Frame& F, int l, LAS pg8::MoeTables* tb) {
    __syncthreads();
    if (F.tid < 32) tb->cnt[F.tid] = (int)__hip_atomic_load(P_CNT + 64 * (l * 32 + F.tid), __ATOMIC_RELAXED, __HIP_MEMORY_SCOPE_AGENT);
    __syncthreads();
    if (F.tid == 0) { int s = 0;
#pragma nounroll
        for (int e = 0; e < 32; ++e) { tb->mtstart[e] = s; s += (tb->cnt[e] + 255) >> 8; }
        tb->mtstart[32] = s; }
    __syncthreads();
    if (F.tid < 320) { int e = 0;
#pragma nounroll
        for (int q = 1; q < 32; ++q) if (tb->mtstart[q] <= F.tid) e = q;
        tb->tile_e[F.tid] = (unsigned char)e; }
    __syncthreads();
    return tb->mtstart[32];
}
__device__ __forceinline__ void fox_kbias(CArgs& A, const Frame& F, int b, int h, float* kb, float* wtot  ) {
    const int t0 = 4 * F.tid; float e[4];
#pragma unroll
    for (int i = 0; i < 4; ++i) e[i] = P_LSIG[(size_t)(b * SEQ + t0 + i) * 8 + h];
    const float s4 = (e[0] + e[1]) + (e[2] + e[3]); float v = s4;
#pragma unroll
    for (int o = 1; o < 64; o <<= 1) { const float tt = __shfl_up(v, o); if (F.lane >= o) v += tt; }
    if (F.lane == 63) wtot[F.wave] = v;
    __syncthreads();
    float off = 0.f;
#pragma unroll
    for (int w = 0; w < 8; ++w) if (w < F.wave) off += wtot[w];
    float c = off + v - s4;
#pragma unroll
    for (int i = 0; i < 4; ++i) { c += e[i]; kb[t0 + i] = -LOG2E * c; }
    __syncthreads();
}
#include <hip/hip_bf16.h>
namespace attn_body {
using bf16=__hip_bfloat16;
using bf16x8=__attribute__((ext_vector_type(8)))short;
using s16x4=__attribute__((ext_vector_type(4)))short;
using f32x16=__attribute__((ext_vector_type(16)))float;
using u32x4=__attribute__((ext_vector_type(4)))unsigned;
constexpr int BATCH=8,NHEAD=8,SEQ=2048,D=64,QP=2048,OP=1024;
constexpr int NW=8,QBLK=32,QB=QBLK*NW,KVBLK=64,NQB=SEQ/QB;
constexpr int ATTN_UNIT_ROWS=QB;
__device__ __forceinline__ int crow(int r,int hi){return (r&3)+8*(r>>2)+4*hi;}
#define SBAR() __builtin_amdgcn_sched_barrier(0)
__device__ __forceinline__ void cmask(f32x16&p0,f32x16&p1,int jb,int qrel,int hi){
  const float NEG=-INFINITY; int kb=64*jb+4*hi;
  #pragma unroll
  for(int r=0;r<16;++r){int kv=kb+(r&3)+8*(r>>2); if(kv>qrel)p0[r]=NEG; if(kv+32>qrel)p1[r]=NEG;}
}

constexpr int NSLOT=3, SLOTB=8192;
constexpr int LDS_K=0, LDS_V=NSLOT*SLOTB, LDS_WS=2*NSLOT*SLOTB, LDS_OST=LDS_WS+NW*64*4, LDS_BYTES=LDS_OST+NW*4096;
constexpr float C2=0.125f*1.4426950408889634f;
__device__ __forceinline__ void glds16(const void*gsrc,unsigned lds_dst){unsigned keep;
  asm volatile("s_mov_b32 %0, m0\n\ts_mov_b32 m0, %2\n\ts_nop 0\n\tglobal_load_lds_dwordx4 %1, off\n\ts_mov_b32 m0, %0":"=&s"(keep):"v"(gsrc),"s"(lds_dst):"memory");}
__device__ __forceinline__ float max3f(float a,float b,float c){float r;asm("v_max3_f32 %0, %1, %2, %3":"=v"(r):"v"(a),"v"(b),"v"(c));return r;}
__device__ __forceinline__ float max2f(float a,float b){float r;asm("v_max_f32_e32 %0, %1, %2":"=v"(r):"v"(a),"v"(b));return r;}
__device__ __forceinline__ float fadd_s(float a,float b){float r;asm("v_add_f32_e32 %0, %1, %2":"=v"(r):"v"(a),"v"(b));return r;}
__device__ __forceinline__ float fsub_s(float a,float b){float r;asm("v_sub_f32_e32 %0, %1, %2":"=v"(r):"v"(a),"v"(b));return r;}
typedef float f32x2_t __attribute__((ext_vector_type(2))); typedef float f32x4_t __attribute__((ext_vector_type(4))); typedef __bf16 bf16x2_t __attribute__((ext_vector_type(2)));
__device__ __forceinline__ unsigned cvtpk_s(float lo,float hi){f32x2_t v={lo,hi};bf16x2_t b=__builtin_convertvector(v,bf16x2_t);return __builtin_bit_cast(unsigned,b);}
#define WAIT_BAR(N) asm volatile("s_waitcnt vmcnt(" #N ") lgkmcnt(0)\n\ts_barrier":::"memory")

__device__ __forceinline__ void qkt(f32x16&p0,f32x16&p1,const char*Kslot,const bf16x8*qr,const f32x16&c0i,const f32x16&c1i,int r32,int hi){
  const char*kb=Kslot+hi*1024+r32*16;
  #pragma unroll
  for(int d0=0;d0<4;++d0){
    const bf16x8 b0=*reinterpret_cast<const bf16x8*>(kb+d0*2048);
    const bf16x8 b1=*reinterpret_cast<const bf16x8*>(kb+d0*2048+512);
    if(d0==0){p0=__builtin_amdgcn_mfma_f32_32x32x16_bf16(b0,qr[0],c0i,0,0,0);p1=__builtin_amdgcn_mfma_f32_32x32x16_bf16(b1,qr[0],c1i,0,0,0);}
    else{p0=__builtin_amdgcn_mfma_f32_32x32x16_bf16(b0,qr[d0],p0,0,0,0);p1=__builtin_amdgcn_mfma_f32_32x32x16_bf16(b1,qr[d0],p1,0,0,0);}}
}
typedef __attribute__((address_space(3))) const char* lds_cptr;
typedef short v4i16_t __attribute__((ext_vector_type(4)));
__device__ __forceinline__ void kload8(bf16x8*kf,lds_cptr kp){
  kf[0]=*(const __attribute__((address_space(3))) bf16x8*)(kp);      kf[1]=*(const __attribute__((address_space(3))) bf16x8*)(kp+512);
  kf[2]=*(const __attribute__((address_space(3))) bf16x8*)(kp+2048); kf[3]=*(const __attribute__((address_space(3))) bf16x8*)(kp+2560);
  kf[4]=*(const __attribute__((address_space(3))) bf16x8*)(kp+4096); kf[5]=*(const __attribute__((address_space(3))) bf16x8*)(kp+4608);
  kf[6]=*(const __attribute__((address_space(3))) bf16x8*)(kp+6144); kf[7]=*(const __attribute__((address_space(3))) bf16x8*)(kp+6656);
}
__device__ __forceinline__ void kload2(bf16x8*kf,lds_cptr kp,int j){ kf[2*j]=*(const __attribute__((address_space(3))) bf16x8*)(kp+j*2048); kf[2*j+1]=*(const __attribute__((address_space(3))) bf16x8*)(kp+j*2048+512); }
__device__ __forceinline__ s16x4 vtr(lds_cptr p){ return __builtin_bit_cast(s16x4,__builtin_amdgcn_ds_read_tr16_b64_v4i16((__attribute__((address_space(3))) v4i16_t*)p)); }
__device__ __forceinline__ float rowmax(const f32x16&p0,const f32x16&p1){
  float a=max3f(p0[0],p0[1],p1[0]),b=max3f(p0[2],p0[3],p1[1]);a=max3f(a,p1[2],p1[3]);
  #pragma unroll
  for(int r=4;r<16;r+=4){a=max3f(a,p0[r],p0[r+1]);b=max3f(b,p0[r+2],p0[r+3]);a=max3f(a,p1[r],p1[r+1]);b=max3f(b,p1[r+2],p1[r+3]);}
  const float m=max2f(a,b);
  auto rr=__builtin_amdgcn_permlane32_swap(__float_as_uint(m),__float_as_uint(m),false,false);
  return max2f(__uint_as_float(rr[0]),__uint_as_float(rr[1]));
}
__device__ __forceinline__ void pv(f32x16*o,int vb,bf16x8 pa0,bf16x8 pa1,bf16x8 pa2,bf16x8 pa3){
  #pragma unroll
  for(int d0=0;d0<2;++d0){s16x4 lo[4],hi[4];
    #pragma unroll
    for(int ks=0;ks<4;++ks){
      asm volatile("ds_read_b64_tr_b16 %0,%1 offset:%c2":"=&v"(lo[ks]):"v"(vb),"i"(d0*4096+ks*1024):"memory");
      asm volatile("ds_read_b64_tr_b16 %0,%1 offset:%c2":"=&v"(hi[ks]):"v"(vb),"i"(d0*4096+ks*1024+512):"memory");}
    asm volatile("s_waitcnt lgkmcnt(0)":::"memory");SBAR();
    #define PK(k) (bf16x8){lo[k][0],lo[k][1],lo[k][2],lo[k][3],hi[k][0],hi[k][1],hi[k][2],hi[k][3]}
    o[d0]=__builtin_amdgcn_mfma_f32_32x32x16_bf16(pa0,PK(0),o[d0],0,0,0);
    o[d0]=__builtin_amdgcn_mfma_f32_32x32x16_bf16(pa1,PK(1),o[d0],0,0,0);
    o[d0]=__builtin_amdgcn_mfma_f32_32x32x16_bf16(pa2,PK(2),o[d0],0,0,0);
    o[d0]=__builtin_amdgcn_mfma_f32_32x32x16_bf16(pa3,PK(3),o[d0],0,0,0);
    #undef PK
  }
}

#ifndef ATTN_STORE16
#define ATTN_STORE16(p,v) (*(u32x4*)(p)=(v))
#endif
typedef const __attribute__((address_space(3))) float* lds_fptr;
template<int THRL> __device__ __forceinline__ void attn_unit(int b,int h,int qb,const bf16*Q,const bf16*__restrict__ K,const bf16*__restrict__ V,bf16*O,char*shm,lds_fptr kb,int tid,int wid){
  const int lane=tid&63,r32=lane&31,hi=lane>>5;
  const long rowbase=(long)b*SEQ; const int q0=qb*QB;
  const bf16*Qw=Q+(rowbase+q0+wid*QBLK)*QP+h*D;
  const bf16*Kh=K+rowbase*QP+h*D,*Vh=V+rowbase*QP+h*D;
  const unsigned lds0=(unsigned)(uintptr_t)shm;
  float*wsf=(float*)(shm+LDS_WS)+wid*64;
  const bf16*ksrc=Kh+(long)lane*QP+wid*8;
  const bf16*vsrc=Vh+(long)(16*(wid&3)+(lane>>2))*QP+(wid>>2)*32+(lane&3)*8;
  const unsigned kdst=lds0+LDS_K+wid*1024, vdst=lds0+LDS_V+wid*1024;
  #define DMA_K(t,slot) glds16(ksrc+(long)(t)*KVBLK*QP,(unsigned)__builtin_amdgcn_readfirstlane(kdst+(slot)))
  #define DMA_V(t,slot) glds16(vsrc+(long)(t)*KVBLK*QP,(unsigned)__builtin_amdgcn_readfirstlane(vdst+(slot)))
  const int vb0=(int)(lds0+LDS_V)+((lane>>4)&1)*32+(lane&3)*8+(4*hi+((lane&15)>>2))*64;
  const char*Kbase=shm+LDS_K; bf16x8 kf[8];
  const lds_cptr shm3=(lds_cptr)shm; const lds_cptr kp0=shm3+LDS_K+hi*1024+r32*16; const lds_cptr vp0=shm3+LDS_V+((lane>>4)&1)*32+(lane&3)*8+(4*hi+((lane&15)>>2))*64;
  const int NT=(q0+QB)/KVBLK;
  DMA_K(0,0);DMA_V(0,0);DMA_K(1,SLOTB);
  bf16x8 qr[4];
  #pragma unroll
  for(int d0=0;d0<4;++d0)qr[d0]=*reinterpret_cast<const bf16x8*>(&Qw[(long)r32*QP+d0*16+hi*8]);
  float mhat=0.f,l_reg=0.f;f32x16 o[2];o[0]=f32x16{};o[1]=f32x16{};float nm=0.f;
  #define BIASFILL(C0,C1,t) do{ const lds_fptr kbt_=kb+64*(t)+4*hi; _Pragma("unroll") for(int g_=0;g_<4;++g_){ const f32x4_t v0_=*(const __attribute__((address_space(3))) f32x4_t*)(kbt_+8*g_), v1_=*(const __attribute__((address_space(3))) f32x4_t*)(kbt_+32+8*g_); \
      _Pragma("unroll") for(int i_=0;i_<4;++i_){ C0[4*g_+i_]=v0_[i_]+nm; C1[4*g_+i_]=v1_[i_]+nm; } } }while(0)
  const int qrel=wid*QBLK+r32;
  #define CMASK(P0,P1,t) do{int jb_=(t)-(NT-4); if(jb_>=0)cmask(P0,P1,jb_,qrel,hi);}while(0)
  bool resc=false;
  #define START(P0,P1) do{ const float rm=rowmax(P0,P1); resc=false; \
    { const float dl=rm; mhat=fadd_s(mhat,dl); \
      _Pragma("unroll") for(int r=0;r<16;++r){P0[r]=fsub_s(P0[r],dl);P1[r]=fsub_s(P1[r],dl);} \
      nm=-mhat; } \
    _Pragma("unroll") for(int r=0;r<16;++r)P0[r]=__builtin_amdgcn_exp2f(P0[r]); }while(0)
  #define RESC() do{ if(resc){ asm volatile("s_waitcnt lgkmcnt(0)":::"memory"); \
      _Pragma("unroll") for(int d_=0;d_<2;++d_) _Pragma("unroll") for(int r=0;r<16;++r)o[d_][r]*=wsf[crow(r,hi)]; } }while(0)
  f32x16 pA0,pA1,pB0,pB1;
  int sl_prev=0,sl_cur=0,sl_next=SLOTB;
  #define ROT() do{sl_prev=sl_cur;sl_cur=sl_next;sl_next=(sl_next==(NSLOT-1)*SLOTB)?0:sl_next+SLOTB;}while(0)
  DMA_K(2,2*SLOTB);
  WAIT_BAR(3);
  { f32x16 c0i,c1i; BIASFILL(c0i,c1i,0); qkt(pA0,pA1,Kbase,qr,c0i,c1i,r32,hi); }asm volatile("s_nop 15\n\ts_nop 7":"+v"(pA0),"+v"(pA1));CMASK(pA0,pA1,0);
  START(pA0,pA1);
  _Pragma("unroll") for(int r=0;r<16;++r)pA1[r]=__builtin_amdgcn_exp2f(pA1[r]);
  WAIT_BAR(0);
  DMA_K(3,0);DMA_V(1,SLOTB);
  ROT();
  kload8(kf,kp0+sl_cur);
  WAIT_BAR(2);
  s16x4 vlo[8],vhi[8]; u32x4 pw0,pw1,pw2,pw3;
  #define PKW(P,B) cvtpk_s(P[B],P[B+1])
  #define PAF(k) __builtin_bit_cast(bf16x8,pw##k)
  #define VFR(i) (bf16x8){vlo[i][0],vlo[i][1],vlo[i][2],vlo[i][3],vhi[i][0],vhi[i][1],vhi[i][2],vhi[i][3]}
  #define PIN(x) asm volatile("":"+v"(x))
  #define MX3(a,b,c) __builtin_fmaxf(__builtin_fmaxf((a),(b)),(c))
  #define GAPA(MF,A0,A1,A2,A3,W0,W1,PW) do{ MF; sacc+=A0; sacc+=A1; sacc+=A2; sacc+=A3; PIN(sacc); W0; W1; PIN(PW); SBAR(); }while(0)
  #define EX(v) __builtin_amdgcn_exp2f(v)
  #define GAPB(MF,X,B) do{ MF; X[B]=EX(X[B]); X[B+1]=EX(X[B+1]); X[B+2]=EX(X[B+2]); X[B+3]=EX(X[B+3]); PIN(X); SBAR(); }while(0)
  #define VRD(i) do{ vlo[i]=vtr(vp_+(((i)>>2)*4096+((i)&3)*1024)); vhi[i]=vtr(vp_+(((i)>>2)*4096+((i)&3)*1024+512)); }while(0)
  #define KRD(G,j) do{ if(G){ kload2(kf,kp0+sl_next,j); SBAR(); } }while(0)
  #define STEP(C0,C1,P0,P1,t,GK,GV,GL) do{ SBAR(); BIASFILL(C0,C1,t); SBAR(); \
    const lds_cptr vp_=vp0+sl_prev; \
    VRD(0); SBAR(); float sacc=(P0[0]+P0[1]); \
    GAPA(C0=__builtin_amdgcn_mfma_f32_32x32x16_bf16(kf[0],qr[0],C0,0,0,0), P0[2],P0[3],P0[4],P0[5],     pw0[0]=PKW(P0,0), pw0[1]=PKW(P0,2), pw0); \
    VRD(4); SBAR(); GAPA(C1=__builtin_amdgcn_mfma_f32_32x32x16_bf16(kf[1],qr[0],C1,0,0,0), P0[6],P0[7],P0[8],P0[9],     pw0[2]=PKW(P0,4), pw0[3]=PKW(P0,6), pw0); \
    VRD(1); SBAR(); GAPA(C0=__builtin_amdgcn_mfma_f32_32x32x16_bf16(kf[2],qr[1],C0,0,0,0),   P0[10],P0[11],P0[12],P0[13], pw1[0]=PKW(P0,8), pw1[1]=PKW(P0,10), pw1); \
    VRD(5); SBAR(); GAPA(C1=__builtin_amdgcn_mfma_f32_32x32x16_bf16(kf[3],qr[1],C1,0,0,0),   P0[14],P0[15],P1[0],P1[1],   pw1[2]=PKW(P0,12),pw1[3]=PKW(P0,14), pw1); \
    VRD(2); SBAR(); GAPA(C0=__builtin_amdgcn_mfma_f32_32x32x16_bf16(kf[4],qr[2],C0,0,0,0),   P1[2],P1[3],P1[4],P1[5],     pw2[0]=PKW(P1,0), pw2[1]=PKW(P1,2), pw2); \
    VRD(6); SBAR(); GAPA(C1=__builtin_amdgcn_mfma_f32_32x32x16_bf16(kf[5],qr[2],C1,0,0,0),   P1[6],P1[7],P1[8],P1[9],     pw2[2]=PKW(P1,4), pw2[3]=PKW(P1,6), pw2); \
    VRD(3); SBAR(); GAPA(C0=__builtin_amdgcn_mfma_f32_32x32x16_bf16(kf[6],qr[3],C0,0,0,0),   P1[10],P1[11],P1[12],P1[13], pw3[0]=PKW(P1,8), pw3[1]=PKW(P1,10), pw3); \
    VRD(7); SBAR(); GAPA(C1=__builtin_amdgcn_mfma_f32_32x32x16_bf16(kf[7],qr[3],C1,0,0,0),   P1[14],P1[15],0.f,0.f,       pw3[2]=PKW(P1,12),pw3[3]=PKW(P1,14), pw3); \
    l_reg+=sacc; \
    if(GK){DMA_K((t)+3,sl_cur);} if(GV){DMA_V((t)+1,sl_next);} \
    CMASK(C0,C1,t); \
    { float a=MX3(C0[0],C0[1],C1[0]),b=MX3(C0[2],C0[3],C1[1]); a=MX3(a,C1[2],C1[3]); \
      _Pragma("unroll") for(int r=4;r<16;r+=4){a=MX3(a,C0[r],C0[r+1]);b=MX3(b,C0[r+2],C0[r+3]);a=MX3(a,C1[r],C1[r+1]);b=MX3(b,C1[r+2],C1[r+3]);} \
      float rm=__builtin_fmaxf(a,b); { auto rr=__builtin_amdgcn_permlane32_swap(__float_as_uint(rm),__float_as_uint(rm),false,false); rm=__builtin_fmaxf(__uint_as_float(rr[0]),__uint_as_float(rr[1])); } \
      resc=false; \
      if(__builtin_expect(__any(rm>(float)THRL),0)){ const float dl=__builtin_fmaxf(rm,0.f); mhat+=dl; \
        _Pragma("unroll") for(int r=0;r<16;++r){C0[r]-=dl;C1[r]-=dl;} \
        nm=-mhat; \
        const float f=__builtin_amdgcn_exp2f(-dl); l_reg*=f; if(hi==0)wsf[r32]=f; resc=true; } } \
    SBAR(); \
    GAPB(o[0]=__builtin_amdgcn_mfma_f32_32x32x16_bf16(PAF(0),VFR(0),o[0],0,0,0), C0,0); \
    GAPB(o[1]=__builtin_amdgcn_mfma_f32_32x32x16_bf16(PAF(0),VFR(4),o[1],0,0,0), C0,4); \
    KRD(GL,0); GAPB(o[0]=__builtin_amdgcn_mfma_f32_32x32x16_bf16(PAF(1),VFR(1),o[0],0,0,0), C0,8); \
    KRD(GL,1); GAPB(o[1]=__builtin_amdgcn_mfma_f32_32x32x16_bf16(PAF(1),VFR(5),o[1],0,0,0), C0,12); \
    KRD(GL,2); GAPB(o[0]=__builtin_amdgcn_mfma_f32_32x32x16_bf16(PAF(2),VFR(2),o[0],0,0,0), C1,0); \
    KRD(GL,3); GAPB(o[1]=__builtin_amdgcn_mfma_f32_32x32x16_bf16(PAF(2),VFR(6),o[1],0,0,0), C1,4); \
    GAPB(o[0]=__builtin_amdgcn_mfma_f32_32x32x16_bf16(PAF(3),VFR(3),o[0],0,0,0), C1,8); \
    GAPB(o[1]=__builtin_amdgcn_mfma_f32_32x32x16_bf16(PAF(3),VFR(7),o[1],0,0,0), C1,12); \
    }while(0)
  int t=1;
  #undef CMASK
  #define CMASK(P0,P1,t) do{}while(0)
  for(;t+5<NT;t+=2){
    STEP(pB0,pB1,pA0,pA1,t,true,true,true);     WAIT_BAR(2); RESC(); ROT();
    STEP(pA0,pA1,pB0,pB1,t+1,true,true,true);   WAIT_BAR(2); RESC(); ROT();
  }
  #undef CMASK
  #define CMASK(P0,P1,t) do{int jb_=(t)-(NT-4); if(jb_>=0)cmask(P0,P1,jb_,qrel,hi);}while(0)
  #define ENDW(tt) do{ if((tt)+3<NT){WAIT_BAR(2);} else if((tt)+2<NT){WAIT_BAR(1);} else {WAIT_BAR(0);} }while(0)
  for(;t+1<NT;t+=2){
    STEP(pB0,pB1,pA0,pA1,t,(t+3<NT),(t+1<NT),(t+1<NT));       ENDW(t);   RESC(); ROT();
    STEP(pA0,pA1,pB0,pB1,t+1,(t+4<NT),(t+2<NT),(t+2<NT));     ENDW(t+1); RESC(); ROT();
  }
  STEP(pB0,pB1,pA0,pA1,NT-1,false,false,false); RESC();
  { float sacc=pB0[0]+pB0[1]; _Pragma("unroll") for(int r=2;r<16;++r)sacc+=pB0[r]; _Pragma("unroll") for(int r=0;r<16;++r)sacc+=pB1[r]; l_reg+=sacc;
    pw0=(u32x4){PKW(pB0,0),PKW(pB0,2),PKW(pB0,4),PKW(pB0,6)};pw1=(u32x4){PKW(pB0,8),PKW(pB0,10),PKW(pB0,12),PKW(pB0,14)};pw2=(u32x4){PKW(pB1,0),PKW(pB1,2),PKW(pB1,4),PKW(pB1,6)};pw3=(u32x4){PKW(pB1,8),PKW(pB1,10),PKW(pB1,12),PKW(pB1,14)};
    SBAR(); pv(o,vb0+sl_cur,PAF(0),PAF(1),PAF(2),PAF(3)); }
  #undef PKW
  #undef PAF
  #undef VFR
  #undef PIN
  #undef MX3
  #undef GAPA
  #undef GAPB
  #undef EX
  #undef VRD
  #undef KRD
  #undef STEP
  #undef ENDW
  {auto rr=__builtin_amdgcn_permlane32_swap(__float_as_uint(l_reg),__float_as_uint(l_reg),false,false);l_reg=__uint_as_float(rr[0])+__uint_as_float(rr[1]);}
  if(hi==0)wsf[32+r32]=l_reg;asm volatile("s_waitcnt lgkmcnt(0)":::"memory");
  float rli[16];
  #pragma unroll
  for(int r=0;r<16;++r)rli[r]=__builtin_amdgcn_rcpf(wsf[32+crow(r,hi)]);
  bf16*Ow=O+(rowbase+q0+wid*QBLK)*OP+h*D;
  { bf16*stg=(bf16*)(shm+LDS_OST)+wid*2048;
    #pragma unroll
    for(int r=0;r<16;++r){const int orow=crow(r,hi);
      #pragma unroll
      for(int d0=0;d0<2;++d0)stg[orow*64+d0*32+r32]=__float2bfloat16(o[d0][r]*rli[r]);}
    asm volatile("s_waitcnt lgkmcnt(0)":::"memory");
    #pragma unroll
    for(int i=0;i<4;++i){const int row=i*8+(lane>>3),ch=lane&7; const u32x4 v=*(const u32x4*)(stg+row*64+ch*8); ATTN_STORE16(Ow+(long)row*OP+ch*8,v);} }
  asm volatile("s_waitcnt lgkmcnt(0)\n\ts_barrier":::"memory");
  #undef DMA_K
  #undef DMA_V
  #undef CMASK
  #undef START
  #undef RESC
  #undef ROT
  #undef BIASFILL
}
constexpr int ATTN_LDS_BYTES=LDS_BYTES;
#undef SBAR
#undef WAIT_BAR
}
__device__ __forceinline__ void fox_fast(CArgs& A, const Frame& F) {
    float* kb = (float*)(F.lds + 86016); float* wtot = kb + 2048;
    const int v = (F.bid & 7) * 32 + (F.bid >> 3), bh = v >> 2, s = v & 3, b = bh >> 3, h = bh & 7;
    fox_kbias(A, F, b, h, kb, wtot);
    const attn_body::bf16* Zb = (const attn_body::bf16*)P_Z;
    const attn_body::lds_fptr kb3 = (attn_body::lds_fptr)(const __attribute__((address_space(3))) unsigned char*)((LAS unsigned char*)F.lds + 86016);
    attn_body::attn_unit<8>(b, h, 7 - s, Zb + 512, Zb + 1024, Zb + 1536, (attn_body::bf16*)P_YCAT + 512, (char*)F.lds, kb3, F.tid, F.wave);
    attn_body::attn_unit<8>(b, h, s, Zb + 512, Zb + 1024, Zb + 1536, (attn_body::bf16*)P_YCAT + 512, (char*)F.lds, kb3, F.tid, F.wave);
}
typedef float f32x16 __attribute__((ext_vector_type(16)));
__device__ __forceinline__ bf16x8 pack8(const f32x4& a, const f32x4& b) { u32x4 w; w.x = pk2(a.x, a.y); w.y = pk2(a.z, a.w); w.z = pk2(b.x, b.y); w.w = pk2(b.z, b.w); return __builtin_bit_cast(bf16x8, w); }
__device__ __forceinline__ void s5_fast(CArgs& A, const Frame& F, int item) {
    const int b = item >> 5, g = item & 31, lane = F.lane, w = F.wave, p = lane & 31, hh = lane >> 5, l15 = lane & 15, l4 = lane >> 4;
    float* Eseg = (float*)F.lds; float* Hin = Eseg + 2048;
    bf16_t* Hs = (bf16_t*)(F.lds + 16384) + w * 4352;
    bf16x8 bbr[2], bbi[2]; float are[2], aim[2];
#pragma unroll
    for (int nt = 0; nt < 2; ++nt) { const float* q = P_S5BB + (size_t)(g * 64 + 32 * nt + p) * 32 + 8 * hh;
        bbr[nt] = pack8(*(const f32x4*)q, *(const f32x4*)(q + 4)); bbi[nt] = pack8(*(const f32x4*)(q + 16), *(const f32x4*)(q + 20));
        are[nt] = P_S5A[(g * 64 + 32 * nt + p) * 2]; aim[nt] = P_S5A[(g * 64 + 32 * nt + p) * 2 + 1]; }
    const int rr = lane & 31, ahalf = (rr >> 2) & 1, atau = (rr & 3) + 4 * (rr >> 3);
    const bf16_t* usrc = P_Z + (size_t)(b * SEQ + 128 * (2 * w + ahalf) + atau) * ZP0 + g * 16 + 8 * hh;
    const f32x16 zero16 = {0.f, 0.f, 0.f, 0.f, 0.f, 0.f, 0.f, 0.f, 0.f, 0.f, 0.f, 0.f, 0.f, 0.f, 0.f, 0.f};
    float hr[2] = {0.f, 0.f}, hi[2] = {0.f, 0.f};
#define S5_ALOAD(blk_) (*(const bf16x8*)(usrc + (size_t)(blk_) * 16 * ZP0))
    { bf16x8 a0 = S5_ALOAD(0), a1 = S5_ALOAD(1), a2 = S5_ALOAD(2);
#pragma unroll 1
      for (int blk = 0; blk < 8; ++blk) {
        const bf16x8 a = a0; a0 = a1; a1 = a2; if (blk + 3 < 8) a2 = S5_ALOAD(blk + 3);
#pragma unroll
        for (int nt = 0; nt < 2; ++nt) {
            const f32x16 dre = __builtin_amdgcn_mfma_f32_32x32x16_bf16(a, bbr[nt], zero16, 0, 0, 0), dim = __builtin_amdgcn_mfma_f32_32x32x16_bf16(a, bbi[nt], zero16, 0, 0, 0);
#pragma unroll
            for (int i = 0; i < 16; ++i) { const float nr = are[nt] * hr[nt] - aim[nt] * hi[nt] + dre[i], ni = are[nt] * hi[nt] + aim[nt] * hr[nt] + dim[i]; hr[nt] = nr; hi[nt] = ni; }
        }
      } }
#pragma unroll
    for (int nt = 0; nt < 2; ++nt) { Eseg[((2 * w + hh) * 64 + 32 * nt + p) * 2] = hr[nt]; Eseg[((2 * w + hh) * 64 + 32 * nt + p) * 2 + 1] = hi[nt]; }
    __syncthreads();
    if (w == 0) {
        float xr = P_S5A[(g * 64 + lane) * 2], xi = P_S5A[(g * 64 + lane) * 2 + 1];
#pragma unroll
        for (int q = 0; q < 7; ++q) { const float nr = xr * xr - xi * xi, ni = 2.f * xr * xi; xr = nr; xi = ni; }
        float Hr = 0.f, Hi = 0.f;
#pragma unroll 1
        for (int s = 0; s < 16; ++s) { Hin[(s * 64 + lane) * 2] = Hr; Hin[(s * 64 + lane) * 2 + 1] = Hi;
            const float er = Eseg[(s * 64 + lane) * 2], ei = Eseg[(s * 64 + lane) * 2 + 1]; const float nr = xr * Hr - xi * Hi + er, ni = xr * Hi + xi * Hr + ei; Hr = nr; Hi = ni; }
    }
    __syncthreads();
#pragma unroll
    for (int nt = 0; nt < 2; ++nt) { hr[nt] = Hin[((2 * w + hh) * 64 + 32 * nt + p) * 2]; hi[nt] = Hin[((2 * w + hh) * 64 + 32 * nt + p) * 2 + 1]; }
    bf16x8 ck[4];
#pragma unroll
    for (int ks = 0; ks < 4; ++ks) ck[ks] = *(const bf16x8*)(P_S5CK + (size_t)(g * 16 + l15) * 128 + 32 * ks + 8 * l4);
    const int er = lane >> 1, eh = lane & 1;
    float* Ys = (float*)(F.lds + 86016) + w * 640;
    f32x4 dk0 = *(const f32x4*)(A.in[I_S5D] + g * 16 + 8 * eh), dk1 = *(const f32x4*)(A.in[I_S5D] + g * 16 + 8 * eh + 4);
#define S5_EROW(blk_) ((size_t)(b * SEQ + 128 * (2 * w + (er >> 4)) + 16 * (blk_) + (er & 15)))
    bf16x8 a0 = S5_ALOAD(0), a1 = S5_ALOAD(1), a2 = S5_ALOAD(2);
    u32x4 un = *(const u32x4*)(P_Z + S5_EROW(0) * ZP0 + g * 16 + 8 * eh);
#pragma unroll 1
    for (int blk = 0; blk < 8; ++blk) {
        const bf16x8 a = a0; a0 = a1; a1 = a2; if (blk + 3 < 8) a2 = S5_ALOAD(blk + 3);
        const u32x4 us = un; if (blk + 1 < 8) un = *(const u32x4*)(P_Z + S5_EROW(blk + 1) * ZP0 + g * 16 + 8 * eh);
#pragma unroll
        for (int nt = 0; nt < 2; ++nt) {
            const f32x16 dre = __builtin_amdgcn_mfma_f32_32x32x16_bf16(a, bbr[nt], zero16, 0, 0, 0), dim = __builtin_amdgcn_mfma_f32_32x32x16_bf16(a, bbi[nt], zero16, 0, 0, 0);
#pragma unroll
            for (int i = 0; i < 16; ++i) { const float nr = are[nt] * hr[nt] - aim[nt] * hi[nt] + dre[i], ni = are[nt] * hi[nt] + aim[nt] * hr[nt] + dim[i]; hr[nt] = nr; hi[nt] = ni;
                *(unsigned*)(Hs + (hh * 16 + i) * 136 + 2 * (32 * nt + p)) = pk2(nr, ni); }
        }
        LDS_WAIT();
#pragma unroll
        for (int sg = 0; sg < 2; ++sg) {
            f32x4 y = {0.f, 0.f, 0.f, 0.f};
#pragma unroll
            for (int ks = 0; ks < 4; ++ks) { const bf16x8 af = *(const bf16x8*)(Hs + (sg * 16 + l15) * 136 + 32 * ks + 8 * l4); y = __builtin_amdgcn_mfma_f32_16x16x32_bf16(af, ck[ks], y, 0, 0, 0); }
#pragma unroll
            for (int q = 0; q < 4; ++q) Ys[(sg * 16 + 4 * l4 + q) * 20 + l15] = y[q];
        }
        LDS_WAIT();
        { const f32x4 y0 = *(const f32x4*)(Ys + er * 20 + 8 * eh), y1 = *(const f32x4*)(Ys + er * 20 + 8 * eh + 4);
          float o[8]; o[0] = y0.x + dk0.x * bflo(us.x); o[1] = y0.y + dk0.y * bfhi(us.x); o[2] = y0.z + dk0.z * bflo(us.y); o[3] = y0.w + dk0.w * bfhi(us.y);
          o[4] = y1.x + dk1.x * bflo(us.z); o[5] = y1.y + dk1.y * bfhi(us.z); o[6] = y1.z + dk1.z * bflo(us.w); o[7] = y1.w + dk1.w * bfhi(us.w);
          u32x4 ov; ov.x = pk2(gelu_tanh(o[0]), gelu_tanh(o[1])); ov.y = pk2(gelu_tanh(o[2]), gelu_tanh(o[3])); ov.z = pk2(gelu_tanh(o[4]), gelu_tanh(o[5])); ov.w = pk2(gelu_tanh(o[6]), gelu_tanh(o[7]));
          *(u32x4*)(P_G5 + S5_EROW(blk) * 512 + g * 16 + 8 * eh) = ov; }
        LDS_WAIT();
    }
#undef S5_ALOAD
#undef S5_EROW
}
namespace lin {
typedef const LAS char* lptr;
typedef short s16x4 __attribute__((ext_vector_type(4)));
typedef short v4i16_t __attribute__((ext_vector_type(4)));
__device__ __forceinline__ s16x4 vtr(lptr p) { return __builtin_bit_cast(s16x4, __builtin_amdgcn_ds_read_tr16_b64_v4i16((LAS v4i16_t*)p)); }
__device__ __forceinline__ bf16x8 tr_frag(lptr sub, int ks, int lane) {
    const lptr p = sub + ((lane >> 4) & 1) * 32 + (lane & 3) * 8 + (4 * (lane >> 5) + ((lane & 15) >> 2)) * 64 + ks * 1024;
    const s16x4 lo = vtr(p), hi = vtr(p + 512);
    return (bf16x8){lo[0], lo[1], lo[2], lo[3], hi[0], hi[1], hi[2], hi[3]};
}
__device__ __forceinline__ bf16x8 nat_frag(lptr base, int ldb, int row0, int k0, int lane) { return *(const LAS bf16x8*)(base + (row0 + (lane & 31)) * ldb + (k0 + 8 * (lane >> 5)) * 2); }
__device__ __forceinline__ int crow(int r, int hh) { return (r & 3) + 8 * (r >> 2) + 4 * hh; }
__device__ __forceinline__ void unpack8(const u32x4& w, float (&f)[8]) { f[0] = bflo(w.x); f[1] = bfhi(w.x); f[2] = bflo(w.y); f[3] = bfhi(w.y); f[4] = bflo(w.z); f[5] = bfhi(w.z); f[6] = bflo(w.w); f[7] = bfhi(w.w); }
__device__ __forceinline__ u32x4 repack8(const float (&f)[8]) { u32x4 w; w.x = pk2(f[0], f[1]); w.y = pk2(f[2], f[3]); w.z = pk2(f[4], f[5]); w.w = pk2(f[6], f[7]); return w; }

__device__ __forceinline__ void gla_prefix(CArgs& A, const Frame& F, int item) {
    const int b = item >> 5, c = item & 31, half = F.tid >> 8, col = F.tid & 255;
    float* p = P_LOGA + (size_t)(b * SEQ + c * 64 + 32 * half) * 256 + col; float* tot = (float*)F.lds;
    float v[32];
#pragma unroll
    for (int i = 0; i < 32; ++i) v[i] = p[(size_t)i * 256];
#pragma unroll
    for (int i = 1; i < 32; ++i) v[i] += v[i - 1];
    if (half == 0) tot[col] = v[31];
    __syncthreads();
    const float off = half ? tot[col] : 0.f;
#pragma unroll
    for (int i = 0; i < 32; ++i) p[(size_t)i * 256] = v[i] + off;
    __syncthreads();
}
template <int KIND> __device__ __forceinline__ void r1_item(CArgs& A, const Frame& F, int bh, int vs) {
    constexpr int DK = KIND ? 64 : 128, ND = DK / 32;
    constexpr int KCOL = KIND ? 2304 : 512, VCOL = KIND ? 2560 : 1024;
    const int b = bh >> 2, h = bh & 3, tid = F.tid, lane = F.lane, w = F.wave, hh = lane >> 5;
    unsigned char* bufV = F.lds; unsigned char* bufK = F.lds + 4096;
    bf16_t* ST = (KIND ? P_GST : P_RST) + (size_t)bh * 32 * 128 * DK;
    const float log2g = KIND ? 0.f : log2f(1.f - exp2f(-5.f - (float)h));
    const float g64 = exp2f(64.f * log2g);
    f32x16 acc = {0.f, 0.f, 0.f, 0.f, 0.f, 0.f, 0.f, 0.f, 0.f, 0.f, 0.f, 0.f, 0.f, 0.f, 0.f, 0.f};
    const bf16_t* zb = P_Z + (size_t)(b * SEQ) * ZP1;
    const int vj = tid >> 2, vc = tid & 3;
    const int kj0 = KIND ? (tid >> 3) : (tid >> 4), kd0 = KIND ? (tid & 7) : (tid & 15);
#define R1_DECL(S) u32x4 rv##S = {0u, 0u, 0u, 0u}, rk0##S = {0u, 0u, 0u, 0u}, rk1##S = {0u, 0u, 0u, 0u}; f32x4 bj0##S = {0.f, 0.f, 0.f, 0.f}, bj1##S = bj0##S, bl0##S = bj0##S, bl1##S = bj0##S; float bd##S = 0.f;
#define R1_LOAD(S, c) do { const bf16_t* zc = zb + (size_t)((c) * 64) * ZP1; \
        if (tid < 256) rv##S = *(const u32x4*)(zc + (size_t)vj * ZP1 + VCOL + h * 128 + vs * 32 + vc * 8); \
        rk0##S = *(const u32x4*)(zc + (size_t)kj0 * ZP1 + KCOL + h * DK + kd0 * 8); \
        if (!KIND) rk1##S = *(const u32x4*)(zc + (size_t)(kj0 + 32) * ZP1 + KCOL + h * DK + kd0 * 8); \
        if (KIND) { const float* bp = P_LOGA + (size_t)(b * SEQ + (c) * 64) * 256 + h * 64; \
            bj0##S = *(const f32x4*)(bp + (size_t)kj0 * 256 + kd0 * 8); bj1##S = *(const f32x4*)(bp + (size_t)kj0 * 256 + kd0 * 8 + 4); \
            bl0##S = *(const f32x4*)(bp + 63 * 256 + kd0 * 8); bl1##S = *(const f32x4*)(bp + 63 * 256 + kd0 * 8 + 4); \
            if (w < ND) bd##S = bp[63 * 256 + 32 * w + (lane & 31)]; } } while (0)
#define R1_STEP(S, c) do { \
        if (tid < 256) { u32x4 o = rv##S; \
            if (!KIND) { float f[8]; unpack8(rv##S, f); const float z = exp2f((float)(63 - vj) * log2g); _Pragma("unroll") for (int e = 0; e < 8; ++e) f[e] *= z; o = repack8(f); } \
            *(u32x4*)(bufV + vj * 64 + vc * 16) = o; } \
        if (KIND) { float f[8]; unpack8(rk0##S, f); \
            f[0] *= __expf(bl0##S.x - bj0##S.x); f[1] *= __expf(bl0##S.y - bj0##S.y); f[2] *= __expf(bl0##S.z - bj0##S.z); f[3] *= __expf(bl0##S.w - bj0##S.w); \
            f[4] *= __expf(bl1##S.x - bj1##S.x); f[5] *= __expf(bl1##S.y - bj1##S.y); f[6] *= __expf(bl1##S.z - bj1##S.z); f[7] *= __expf(bl1##S.w - bj1##S.w); \
            *(u32x4*)(bufK + (kd0 >> 2) * 4096 + kj0 * 64 + (kd0 & 3) * 16) = repack8(f); \
        } else { \
            *(u32x4*)(bufK + (kd0 >> 2) * 4096 + kj0 * 64 + (kd0 & 3) * 16) = rk0##S; \
            *(u32x4*)(bufK + (kd0 >> 2) * 4096 + (kj0 + 32) * 64 + (kd0 & 3) * 16) = rk1##S; } \
        __syncthreads(); \
        const float decn = KIND ? __expf(bd##S) : 0.f; \
        if ((c) + 4 < 32) R1_LOAD(S, (c) + 4); \
        if (w < ND) { \
            bf16_t* sp = ST + ((size_t)(c) * 128 + vs * 32) * DK + 32 * w + (lane & 31); \
            const float dec = KIND ? decn : g64; \
            _Pragma("unroll") for (int r = 0; r < 16; ++r) { sp[(size_t)crow(r, hh) * DK] = (bf16_t)f2bf(acc[r]); acc[r] *= dec; } \
            _Pragma("unroll") for (int ks = 0; ks < 4; ++ks) acc = __builtin_amdgcn_mfma_f32_32x32x16_bf16(tr_frag((lptr)(LAS unsigned char*)bufV, ks, lane), tr_frag((lptr)(LAS unsigned char*)bufK + w * 4096, ks, lane), acc, 0, 0, 0); \
        } \
        __syncthreads(); } while (0)
    R1_DECL(0) R1_DECL(1) R1_DECL(2) R1_DECL(3)
    R1_LOAD(0, 0); R1_LOAD(1, 1); R1_LOAD(2, 2); R1_LOAD(3, 3);
#pragma unroll 1
    for (int c = 0; c < 32; c += 4) { R1_STEP(0, c); R1_STEP(1, c + 1); R1_STEP(2, c + 2); R1_STEP(3, c + 3); }
#undef R1_DECL
#undef R1_LOAD
#undef R1_STEP
}
__device__ __forceinline__ void p_lin_r1(CArgs& A, const Frame& F) {
    const int v = F.bid, r = v & 127;
    if (v < 128) r1_item<0>(A, F, r >> 2, r & 3); else r1_item<1>(A, F, r >> 2, r & 3);
}

template <int KIND> struct R2Regs {
    static constexpr int DK = KIND ? 64 : 128, NQP = 64 * DK / 8 / 512, NSP = 128 * DK / 8 / 512;
    u32x4 q[NQP], k[NQP], v[2], s[NSP], g[2]; f32x4 bq[NQP][2];
};
template <int KIND> __device__ __forceinline__ void r2_load(CArgs& A, const Frame& F, R2Regs<KIND>& R, int bh, int c) {
    constexpr int DK = KIND ? 64 : 128;
    constexpr int QCOL = KIND ? 2048 : 0, KCOL = KIND ? 2304 : 512, VCOL = KIND ? 2560 : 1024, GCOL = KIND ? 3072 : 1536;
    const int b = bh >> 2, h = bh & 3, tid = F.tid, lane = F.lane, w = F.wave, hh = lane >> 5, l31 = lane & 31, rb = w >> 2, cb = w & 3;
    const bf16_t* zc = P_Z + (size_t)(b * SEQ + c * 64) * ZP1;
    const bf16_t* ST = (KIND ? P_GST : P_RST) + ((size_t)bh * 32 + c) * 128 * DK;
#pragma unroll
    for (int r = 0; r < R2Regs<KIND>::NQP; ++r) { const int q = tid + 512 * r, i = q / (DK / 8), d8 = q % (DK / 8);
        R.q[r] = *(const u32x4*)(zc + (size_t)i * ZP1 + QCOL + h * DK + d8 * 8); R.k[r] = *(const u32x4*)(zc + (size_t)i * ZP1 + KCOL + h * DK + d8 * 8);
        if (KIND) { const float* bp = P_LOGA + (size_t)(b * SEQ + c * 64 + i) * 256 + h * 64 + d8 * 8; R.bq[r][0] = *(const f32x4*)bp; R.bq[r][1] = *(const f32x4*)(bp + 4); } }
#pragma unroll
    for (int r = 0; r < 2; ++r) { const int q = tid + 512 * r, j = q >> 4, v8 = q & 15; R.v[r] = *(const u32x4*)(zc + (size_t)j * ZP1 + VCOL + h * 128 + v8 * 8); }
#pragma unroll
    for (int r = 0; r < R2Regs<KIND>::NSP; ++r) { const int q = tid + 512 * r, vr = q / (DK / 8), d8 = q % (DK / 8); R.s[r] = *(const u32x4*)(ST + (size_t)vr * DK + d8 * 8); }
#pragma unroll
    for (int k2 = 0; k2 < 2; ++k2) { const int pp = lane + 64 * k2; R.g[k2] = *(const u32x4*)(zc + (size_t)(32 * rb + (pp >> 2)) * ZP1 + GCOL + h * 128 + 32 * cb + 8 * (pp & 3)); }
}
template <int KIND> struct R2Lds { static constexpr int DK = KIND ? 64 : 128, LDQ = (DK + 8) * 2, OFF_K = 64 * LDQ, OFF_V = 2 * 64 * LDQ, OFF_S = OFF_V + 16384, OFF_SSQ = OFF_S + 128 * LDQ, OFF_BC = OFF_SSQ + 1024; };
template <int KIND> __device__ __forceinline__ void r2_stage(const Frame& F, const R2Regs<KIND>& R, u32x4 (&gc)[2]) {
    typedef R2Lds<KIND> LL; constexpr int DK = LL::DK, LDQ = LL::LDQ;
    const int tid = F.tid; unsigned char* L = F.lds;
#pragma unroll
    for (int r = 0; r < R2Regs<KIND>::NQP; ++r) { const int q = tid + 512 * r, i = q / (DK / 8), d8 = q % (DK / 8);
        u32x4 qw = R.q[r], kw = R.k[r];
        if (KIND) { float fq[8], fk[8]; unpack8(qw, fq); unpack8(kw, fk);
#pragma unroll
            for (int e = 0; e < 8; ++e) { const float bb = R.bq[r][e >> 2][e & 3]; fq[e] *= __expf(bb); fk[e] *= __expf(-bb); }
            qw = repack8(fq); kw = repack8(fk); }
        *(u32x4*)(L + i * LDQ + d8 * 16) = qw; *(u32x4*)(L + LL::OFF_K + i * LDQ + d8 * 16) = kw; }
#pragma unroll
    for (int r = 0; r < 2; ++r) { const int q = tid + 512 * r, j = q >> 4, v8 = q & 15; *(u32x4*)(L + LL::OFF_V + (v8 >> 2) * 4096 + j * 64 + (v8 & 3) * 16) = R.v[r]; }
#pragma unroll
    for (int r = 0; r < R2Regs<KIND>::NSP; ++r) { const int q = tid + 512 * r, vr = q / (DK / 8), d8 = q % (DK / 8); *(u32x4*)(L + LL::OFF_S + vr * LDQ + d8 * 16) = R.s[r]; }
    gc[0] = R.g[0]; gc[1] = R.g[1];
    __syncthreads();
}
template <int KIND> __device__ __forceinline__ void r2_compute(CArgs& A, const Frame& F, int bh, int c, const u32x4 (&gc)[2]) {
    typedef R2Lds<KIND> LL; constexpr int DK = LL::DK, LDQ = LL::LDQ, OFF_K = LL::OFF_K, OFF_V = LL::OFF_V, OFF_S = LL::OFF_S;
    constexpr int OCOL = KIND ? 512 : 0;
    const int b = bh >> 2, h = bh & 3, lane = F.lane, w = F.wave, hh = lane >> 5, l31 = lane & 31, rb = w >> 2, cb = w & 3;
    unsigned char* L = F.lds; float* ssq = (float*)(L + LL::OFF_SSQ);
    const float log2g = KIND ? 0.f : log2f(1.f - exp2f(-5.f - (float)h));
    const lptr L3 = (lptr)(LAS unsigned char*)L;
    bf16x8 pa[2][2];
#pragma unroll
    for (int jt = 0; jt < 2; ++jt) {
        f32x16 p = {0.f, 0.f, 0.f, 0.f, 0.f, 0.f, 0.f, 0.f, 0.f, 0.f, 0.f, 0.f, 0.f, 0.f, 0.f, 0.f};
        if (jt <= rb) {
#pragma unroll
            for (int ks = 0; ks < DK / 16; ++ks) p = __builtin_amdgcn_mfma_f32_32x32x16_bf16(nat_frag(L3 + OFF_K, LDQ, 32 * jt, 16 * ks, lane), nat_frag(L3, LDQ, 32 * rb, 16 * ks, lane), p, 0, 0, 0);
        }
        const int i = 32 * rb + l31;
        float f[16];
#pragma unroll
        for (int r = 0; r < 16; ++r) { const int j = 32 * jt + crow(r, hh); float x = (i >= j) ? p[r] : 0.f; if (!KIND) x *= exp2f((float)(i - j) * log2g); f[r] = (i >= j) ? x : 0.f; }
#pragma unroll
        for (int s = 0; s < 2; ++s) { u32x4 wv; wv.x = pk2(f[8 * s], f[8 * s + 1]); wv.y = pk2(f[8 * s + 2], f[8 * s + 3]); wv.z = pk2(f[8 * s + 4], f[8 * s + 5]); wv.w = pk2(f[8 * s + 6], f[8 * s + 7]); pa[jt][s] = __builtin_bit_cast(bf16x8, wv); }
    }
    f32x16 o1 = {0.f, 0.f, 0.f, 0.f, 0.f, 0.f, 0.f, 0.f, 0.f, 0.f, 0.f, 0.f, 0.f, 0.f, 0.f, 0.f}, o2 = o1;
#pragma unroll
    for (int jt = 0; jt < 2; ++jt)
#pragma unroll
        for (int s = 0; s < 2; ++s) o1 = __builtin_amdgcn_mfma_f32_32x32x16_bf16(pa[jt][s], tr_frag(L3 + OFF_V + cb * 4096, 2 * jt + s, lane), o1, 0, 0, 0);
#pragma unroll
    for (int ks = 0; ks < DK / 16; ++ks) o2 = __builtin_amdgcn_mfma_f32_32x32x16_bf16(nat_frag(L3, LDQ, 32 * rb, 16 * ks, lane), nat_frag(L3 + OFF_S, LDQ, 32 * cb, 16 * ks, lane), o2, 0, 0, 0);
    float o[16];
#pragma unroll
    for (int r = 0; r < 16; ++r) { const int i = 32 * rb + crow(r, hh); const float xi = KIND ? 1.f : exp2f((float)(i + 1) * log2g); o[r] = o1[r] + xi * o2[r];
        const float sq = half_sum(o[r] * o[r]); if (l31 == 0) ssq[i * 4 + cb] = sq; }
    __syncthreads();
    float* Os = (float*)L + w * (32 * 33);
#pragma unroll
    for (int r = 0; r < 16; ++r) Os[crow(r, hh) * 33 + l31] = o[r];
    LDS_WAIT();
#pragma unroll
    for (int k2 = 0; k2 < 2; ++k2) { const int pp = lane + 64 * k2, rw = pp >> 2, ch = pp & 3, i = 32 * rb + rw;
        const f32x4 s4 = *(const f32x4*)(ssq + i * 4);
        const float rn = rsqrtf(((s4.x + s4.y) + (s4.z + s4.w)) * (1.f / 128.f) + EPS);
        float gv[8]; unpack8(gc[k2], gv); float y[8];
#pragma unroll
        for (int e = 0; e < 8; ++e) y[e] = siluf_(gv[e]) * Os[rw * 33 + 8 * ch + e] * rn;
        *(u32x4*)(P_YCAT + (size_t)(b * SEQ + c * 64 + i) * DM + OCOL + h * 128 + 32 * cb + 8 * ch) = repack8(y); }
    __syncthreads();
}
template <int KIND> __device__ __forceinline__ void r2_run(CArgs& A, const Frame& F0, int first, int n, int stride) {
    R2Regs<KIND> R; u32x4 gc[2];
    { Frame G2 = F0; int t_ = F0.tid; asm volatile("" : "+v"(t_)); G2.tid = t_; G2.lane = t_ & 63; r2_load<KIND>(A, G2, R, (first & 1023) >> 5, first & 31); }
#pragma unroll 1
    for (int i = 0; i < n; ++i) {
        Frame G2 = F0; { int t_ = F0.tid; asm volatile("" : "+v"(t_)); G2.tid = t_; G2.lane = t_ & 63; }
        const int r = (first + i * stride) & 1023;
        r2_stage<KIND>(G2, R, gc);
        if (i + 1 < n) { const int rn = (first + (i + 1) * stride) & 1023; r2_load<KIND>(A, G2, R, rn >> 5, rn & 31); }
        r2_compute<KIND>(A, G2, r >> 5, r & 31, gc);
    }
}
__device__ __forceinline__ void p_lin_r2(CArgs& A, const Frame& F) {
    r2_run<0>(A, F, F.bid, 4, F.G);
    r2_run<1>(A, F, 1024 + F.bid, 4, F.G);
}
}
#define XB_TMO      128
#define XB_XCNT(j)  (256  + 64 * (j))
#define XB_XSUB(j)  (1280 + 64 * (j))
#define XB_XGEN(j)  (2304 + 64 * (j))
#define XB_TOP      3328
#define XB_TOPGEN   3392
#define XCD_BAR_WORDS 3456
#define XB_SPIN_CAP (1u << 18)
__device__ __forceinline__ unsigned xb_ld(unsigned* p)              { return __hip_atomic_load(p, __ATOMIC_RELAXED, __HIP_MEMORY_SCOPE_AGENT); }
__device__ __forceinline__ unsigned xb_add(unsigned* p, unsigned v) { return __hip_atomic_fetch_add(p, v, __ATOMIC_RELAXED, __HIP_MEMORY_SCOPE_AGENT); }
__device__ __forceinline__ unsigned xb_xcc_id() { return (unsigned)__builtin_amdgcn_s_getreg((3 << 11) | 20) & 0xFu; }
#define XB_SPIN(cond, bar) do { unsigned _sp = 0; while (cond) { __builtin_amdgcn_s_sleep(1); \
    if ((++_sp & 255u) == 0u) { if (xb_ld(&(bar)[XB_TMO])) break; if (_sp > XB_SPIN_CAP) { atomicAdd(&(bar)[XB_TMO], 1u); break; } } } } while (0)
struct XcdBarrier { unsigned* bar; unsigned x; volatile LAS unsigned* st; };
__device__ __forceinline__ XcdBarrier xcd_barrier_post(unsigned* bar, volatile LAS unsigned* st, int tid) {
    XcdBarrier b; b.bar = bar; b.x = xb_xcc_id(); b.st = st;
    if (tid == 0) (void)xb_add(&bar[XB_XCNT(b.x)], 1u);
    return b;
}
__device__ __forceinline__ void xcd_barrier_complete(unsigned* bar, unsigned x, unsigned& nloc, unsigned& nx) {
    const unsigned G = gridDim.x * gridDim.y * gridDim.z;
    unsigned sum, cnt, mine, sp = 0u;
    for (;;) {
        sum = 0u; cnt = 0u; mine = 0u;
#pragma unroll
        for (unsigned j = 0; j < 16; ++j) { const unsigned c = xb_ld(&bar[XB_XCNT(j)]); sum += c; cnt += (c > 0u) ? 1u : 0u; mine = (j == x) ? c : mine; }
        if (sum == G) break;
        __builtin_amdgcn_s_sleep(1);
        if ((++sp & 255u) == 0u) { if (xb_ld(&bar[XB_TMO])) break; if (sp > XB_SPIN_CAP) { atomicAdd(&bar[XB_TMO], 1u); break; } }
    }
    nloc = mine > 0u ? mine : 1u; nx = cnt > 0u ? cnt : 1u;
}
__device__ __forceinline__ void xcd_barrier(const XcdBarrier& b, int tid) {
    asm volatile("s_waitcnt vmcnt(0)" ::: "memory");
    __syncthreads();
    if (tid == 0) {
        unsigned* bar = b.bar;
        __builtin_amdgcn_s_waitcnt(0);
        unsigned nloc = b.st[0], nx = b.st[1];
        if (nloc == 0u) { xcd_barrier_complete(bar, b.x, nloc, nx); b.st[0] = nloc; b.st[1] = nx; }
        const unsigned old = xb_add(&bar[XB_XSUB(b.x)], 1u);
        const unsigned gen = old / nloc;
        if (old + 1u == (gen + 1u) * nloc) {
            __builtin_amdgcn_fence(__ATOMIC_RELEASE, "agent");
            asm volatile("s_waitcnt vmcnt(0)" ::: "memory");
            const unsigned og = xb_add(&bar[XB_TOP], 1u);
            const unsigned tg = og / nx;
            if (og + 1u == (tg + 1u) * nx) xb_add(&bar[XB_TOPGEN], 1u);
            else XB_SPIN(xb_ld(&bar[XB_TOPGEN]) == tg, bar);
            __builtin_amdgcn_fence(__ATOMIC_ACQUIRE, "agent");
            xb_add(&bar[XB_XGEN(b.x)], 1u);
            asm volatile("s_waitcnt vmcnt(0)" ::: "memory");
        } else {
            XB_SPIN(xb_ld(&bar[XB_XGEN(b.x)]) == gen, bar);
            __builtin_amdgcn_fence(__ATOMIC_ACQUIRE, "agent");
            asm volatile("s_waitcnt vmcnt(0)" ::: "memory");
        }
    }
    __syncthreads();
}
#define REFRESH() do { int t_ = F.wave * 64 + lane_id(); asm volatile("" : "+v"(t_)); F.tid = t_; F.lane = t_ & 63; asm volatile("" : "+s"(ap)); int b_ = blockIdx.x; asm volatile("" : "+s"(b_)); F.bid = b_; } while (0)
#define A (*ap)
#define GSYNC() do { REFRESH(); xcd_barrier(xb, F.tid); } while (0)
template <int l> __device__ __forceinline__ void layer_fwd(CArgs*& ap, Frame& F, const XcdBarrier& xb, unsigned char* lds, LAS unsigned char* lds3, LAS pg8::MoeTables* tb) {
    if (l == 0) {
        { REFRESH(); pg8::DenseOrder S; S.init(P_HB, P_WINE, NTOK, 2048, 1024, F.G, F.bid); pg8::EpiZ0 E{P_Z};
          pg8::gemm_phase<pg8::EpiZ0, pg8::DenseOrder, true>(lds3, F.wave, 1024, S, E); }
        GSYNC();
        REFRESH(); fox_fast(A, F);
        __syncthreads();
        REFRESH(); s5_fast(A, F, F.bid);
        GSYNC();
        { REFRESH(); pg8::DenseOrder S; S.init(P_G5, P_WGLU, NTOK, 512, 512, F.G, F.bid); pg8::EpiGlu E{P_G5, A.in[I_GLUB], P_YCAT};
          pg8::gemm_phase<pg8::EpiGlu, pg8::DenseOrder, true>(lds3, F.wave, 512, S, E); }
        GSYNC();
    } else {
        REFRESH(); lin::gla_prefix(A, F, F.bid);
        { REFRESH(); pg8::DenseOrder S; S.init(P_HB, P_WINO, NTOK, 3584, 512, F.G, F.bid); pg8::EpiZ1 E{P_Z, P_ROPE};
          pg8::gemm_phase<pg8::EpiZ1, pg8::DenseOrder, true, true>(lds3, F.wave, 512, S, E); }
        GSYNC();
        REFRESH(); lin::p_lin_r1(A, F);
        GSYNC();
        REFRESH(); lin::p_lin_r2(A, F);
        GSYNC();
    }
    { REFRESH(); pg8::DenseOrder S; S.init(P_YCAT, l == 0 ? P_WOUTE : P_WOUTO, NTOK, 1024, 1024, F.G, F.bid); pg8::EpiBf16Plain E{(bf16_t*)P_MBUF, DM};
      pg8::gemm_phase<pg8::EpiBf16Plain, pg8::DenseOrder, true>(lds3, F.wave, 1024, S, E); }
    GSYNC();
    REFRESH(); p_postmix(A, F, l);
    GSYNC();
    REFRESH(); const int MT = moe_tables(A, F, l, tb);
    {
        const int mX = (MT >> 5) << 5, kk = MT - mX, rr = (64 - ((2 * kk) & 63)) & 63;
        const int mY = mX >= rr ? rr + (((mX - rr) >> 6) << 6) : 0;
        if (mX > 0) {
            { REFRESH(); pg8::MoeOrder<true> S; S.Ap = (const char*)P_HB8; S.Bt = (const char*)(P_W1 + (size_t)l * 32 * 2048 * 1024); S.estride = (size_t)2048 * 1024; S.K = 512; S.NP = 8; S.nwg = mX * 8; S.G = F.G; S.c = F.bid; S.mt0 = 0;
              S.list_tk = P_LTK + (size_t)l * 32 * LISTCAP; S.tb = tb;
              pg8::EpiSwiglu E{P_ACT, A.in[I_BGU] + (size_t)l * 32 * 2048};
              pg8::gemm_phase<pg8::EpiSwiglu, pg8::MoeOrder<true>, true, true>(lds3, F.wave, 512, S, E); }
            GSYNC();
        }
        if (8 * (MT - mX) + 4 * mY > 0) {
            { REFRESH(); pg8::MoeMixOrder S; S.ws = (const char*)A.ws; S.l = l;
              S.a0 = mX; S.nA = 8 * (MT - mX); S.b0 = 0; S.nB = 4 * mY; S.nwg = S.nA + S.nB; S.G = F.G; S.c = F.bid; S.tb = tb;
              pg8::EpiMoeMix E{ap, l};
              pg8::gemm_phase<pg8::EpiMoeMix, pg8::MoeMixOrder, true, true>(lds3, F.wave, 512, S, E); }
            GSYNC();
        }
        if (MT > mY) {
            { REFRESH(); pg8::MoeOrder<false> S; S.Ap = (const char*)P_ACT; S.Bt = (const char*)(P_W2 + (size_t)l * 32 * 1024 * 1024); S.estride = (size_t)1024 * 1024; S.K = 512; S.NP = 4; S.nwg = (MT - mY) * 4; S.G = F.G; S.c = F.bid; S.mt0 = mY;
              S.list_tk = P_LTK + (size_t)l * 32 * LISTCAP; S.tb = tb;
              pg8::EpiDown E{P_Y, A.in[I_BDN] + (size_t)l * 32 * 1024, P_LTK + (size_t)l * 32 * LISTCAP, P_LG + (size_t)l * 32 * LISTCAP};
              pg8::gemm_phase<pg8::EpiDown, pg8::MoeOrder<false>, true, true>(lds3, F.wave, 512, S, E); }
            GSYNC();
        }
    }
    REFRESH(); p_combine(A, F, l);
}

__global__ void __launch_bounds__(512, 2) mk_fwd(Args A_) {
    extern __shared__ __attribute__((aligned(16))) unsigned char lds[];
    cg::grid_group grid = cg::this_grid();
    CArgs* ap = (CArgs*)__builtin_amdgcn_kernarg_segment_ptr();
    Frame F;
    F.lds = lds; F.wave = __builtin_amdgcn_readfirstlane((int)threadIdx.x >> 6); F.tid = 0; F.lane = 0; F.bid = blockIdx.x; F.G = gridDim.x;
    LAS unsigned char* lds3 = (LAS unsigned char*)lds;
    LAS pg8::MoeTables* tb = (LAS pg8::MoeTables*)(lds3 + 133632);
    { volatile LAS unsigned* st = (volatile LAS unsigned*)(lds3 + (LDS_BYTES - 64)); REFRESH(); if (F.tid < 2) st[F.tid] = 0u; __syncthreads(); }
    XcdBarrier xb = xcd_barrier_post((unsigned*)(A.ws + WS_CTL) + 10240, (volatile LAS unsigned*)(lds3 + (LDS_BYTES - 64)), F.tid);
    REFRESH(); p0_prep(A, F);
    if (A.pad != 0) grid.sync();
    GSYNC();
    asm volatile("s_sleep 40\n\ts_sleep 40" ::: "memory");
    REFRESH(); p1_hprep0(A, F);
    GSYNC();
    asm volatile("s_sleep 40\n\ts_sleep 40" ::: "memory");
    layer_fwd<0>(ap, F, xb, lds, lds3, tb);
    GSYNC();
    layer_fwd<1>(ap, F, xb, lds, lds3, tb);
}
#undef A

extern "C" void kernel_launch(void* const* d_in, const int* in_sizes, int n_in, void* d_out, int out_size, void* d_ws, size_t ws_size, hipStream_t stream) {
    static int grid = 0;
    if (grid == 0) {
        if (n_in != 31 || out_size != NTOK * DM || ws_size < WS_END) { fprintf(stderr, "kernel_launch: unexpected problem (n_in %d out %d ws %zu)\n", n_in, out_size, ws_size); grid = -1; return; }
        int dev = 0, cus = 0, per_cu = 0;
        if (hipGetDevice(&dev) != hipSuccess || hipDeviceGetAttribute(&cus, hipDeviceAttributeMultiprocessorCount, dev) != hipSuccess) { grid = -1; return; }
        if (hipFuncSetAttribute((const void*)mk_fwd, hipFuncAttributeMaxDynamicSharedMemorySize, LDS_BYTES) != hipSuccess) { fprintf(stderr, "kernel_launch: hipFuncSetAttribute failed\n"); grid = -1; return; }
        if (hipOccupancyMaxActiveBlocksPerMultiprocessor(&per_cu, (const void*)mk_fwd, 512, LDS_BYTES) != hipSuccess || per_cu < 1) { fprintf(stderr, "kernel_launch: occupancy query says %d blocks per CU\n", per_cu); (void)hipGetLastError(); }
        grid = cus;
        if (grid != 256) fprintf(stderr, "kernel_launch: %d CUs; this kernel is built for a 256-CU grid\n", grid);
    }
    if (grid < 0) return;
    if (hipMemsetAsync((char*)d_ws + WS_CTL, 0, CTL_ZERO_BYTES, stream) != hipSuccess) { fprintf(stderr, "kernel_launch: memset failed\n"); return; }
    Args a{};
    for (int i = 0; i < 31; ++i) a.in[i] = (const float*)d_in[i];
    a.out = (float*)d_out; a.ws = (unsigned char*)d_ws;
    void* kargs[] = {&a};
    const hipError_t e = hipLaunchCooperativeKernel((const void*)mk_fwd, dim3(grid), dim3(512), kargs, LDS_BYTES, stream);
    if (e != hipSuccess) fprintf(stderr, "kernel_launch: cooperative launch failed: %s (grid %d)\n", hipGetErrorString(e), grid);
}
```

```cpp
#include <hip/hip_runtime.h>
#include <hip/hip_cooperative_groups.h>
#include <cstdio>
#include <cstdint>
namespace cg = cooperative_groups;

#define LAS __attribute__((address_space(3)))
typedef unsigned short bf16_t;
typedef short bf16x8 __attribute__((ext_vector_type(8)));
typedef float f32x4 __attribute__((ext_vector_type(4)));
typedef float f32x2 __attribute__((ext_vector_type(2)));
typedef unsigned u32x4 __attribute__((ext_vector_type(4)));
typedef unsigned u32x2 __attribute__((ext_vector_type(2)));
typedef int i32x4 __attribute__((ext_vector_type(4)));
typedef int i32x8 __attribute__((ext_vector_type(8)));

constexpr int NTOK = 16384, DM = 1024, SEQ = 2048, NB = 8;
constexpr int NEXP = 32, LISTCAP = 16384;
constexpr float EPS = 1e-6f;
constexpr float LOG2E = 1.4426950408889634f;
constexpr float C2 = 0.125f * LOG2E;
constexpr int ZP0 = 2048, ZP1 = 3584;

constexpr size_t MiB = 1u << 20;
constexpr size_t WS_CTL = 0, CTL_ZERO_BYTES = 65536;
constexpr size_t WS_MOD = 1 * MiB;
constexpr size_t WS_WSIDE = 1 * MiB + 512 * 1024;
constexpr size_t WS_S5A = 2 * MiB;
constexpr size_t WS_S5BB = 2 * MiB + 65536;
constexpr size_t WS_S5CK = 2 * MiB + 512 * 1024;
constexpr size_t WS_ROPE = 3 * MiB;
constexpr size_t WS_LTK = 4 * MiB;
constexpr size_t WS_LG = 8 * MiB;
constexpr size_t WS_WINE = 16 * MiB, WS_WGLU = 20 * MiB, WS_WOUTE = 21 * MiB, WS_WINO = 23 * MiB, WS_WOUTO = 30 * MiB;
constexpr size_t WS_W1 = 32 * MiB;
constexpr size_t WS_HB8 = 160 * MiB;
constexpr size_t WS_W2 = 288 * MiB;
constexpr size_t WS_HB = 416 * MiB;
constexpr size_t WS_Z = 448 * MiB;
constexpr size_t WS_LSIG = 560 * MiB;
constexpr size_t WS_LOGA = 562 * MiB;
constexpr size_t WS_G5 = 578 * MiB;
constexpr size_t WS_YCAT = 594 * MiB;
constexpr size_t WS_MBUF = 626 * MiB;
constexpr size_t WS_ACT = 690 * MiB;
constexpr size_t WS_Y = 834 * MiB;
constexpr size_t WS_RST = 962 * MiB;
constexpr size_t WS_GST = 994 * MiB;
constexpr size_t WS_XB = 1010 * MiB;
constexpr size_t WS_END = 1042 * MiB;
constexpr int CW_CNT = 1024;

constexpr int RING_BYTES = 131072;
constexpr int MISC_OFF = RING_BYTES;
constexpr int LDS_BYTES = 147456;

__device__ __forceinline__ unsigned f2bf(float f) { unsigned u = __builtin_bit_cast(unsigned, f); return (u + 0x7fffu + ((u >> 16) & 1u)) >> 16; }
typedef __bf16 bf16x2_hw __attribute__((ext_vector_type(2)));
__device__ __forceinline__ unsigned pk2(float lo, float hi) { const f32x2 v = {lo, hi}; return __builtin_bit_cast(unsigned, __builtin_convertvector(v, bf16x2_hw)); }
__device__ __forceinline__ float bflo(unsigned w) { return __builtin_bit_cast(float, w << 16); }
__device__ __forceinline__ float bfhi(unsigned w) { return __builtin_bit_cast(float, w & 0xffff0000u); }
__device__ __forceinline__ float bf1(bf16_t b) { return __builtin_bit_cast(float, ((unsigned)b) << 16); }
__device__ __forceinline__ int lane_id() { int l; asm volatile("v_mbcnt_lo_u32_b32 %0, -1, 0\n\tv_mbcnt_hi_u32_b32 %0, -1, %0" : "=v"(l)); return l; }
template <int CTRL> __device__ __forceinline__ float dppf(float v) { return __builtin_bit_cast(float, __builtin_amdgcn_update_dpp(0, __builtin_bit_cast(int, v), CTRL, 0xf, 0xf, true)); }
__device__ __forceinline__ float row16_sum(float v) {
    v += dppf<0xB1>(v); v += dppf<0x4E>(v); v += dppf<0x141>(v); v += dppf<0x140>(v); return v;
}
__device__ __forceinline__ float rdlane(float v, int l) { return __builtin_bit_cast(float, __builtin_amdgcn_readlane(__builtin_bit_cast(int, v), l)); }
__device__ __forceinline__ float wave_sum(float v) {
    v = row16_sum(v); return (rdlane(v, 0) + rdlane(v, 16)) + (rdlane(v, 32) + rdlane(v, 48));
}
__device__ __forceinline__ float half_sum(float v) {
    v = row16_sum(v); const float a = rdlane(v, 0) + rdlane(v, 16), b = rdlane(v, 32) + rdlane(v, 48); return (lane_id() < 32) ? a : b;
}
__device__ __forceinline__ float sigmoidf_(float x) { return __builtin_amdgcn_rcpf(1.f + __expf(-x)); }
__device__ __forceinline__ float log_sigmoidf_(float x) { return fminf(x, 0.f) - log1pf(__expf(-fabsf(x))); }
__device__ __forceinline__ float siluf_(float x) { return x * sigmoidf_(x); }
__device__ __forceinline__ float gelu_tanh(float x) { const float u2 = 1.5957691216057308f * (x + 0.044715f * x * x * x); return x * sigmoidf_(u2); }
constexpr float SC_H = 16.f, SC_W1 = 512.f, SC_A = 8.f, SC_W2 = 512.f, SC_WIN = 512.f, SC_Y = 64.f;
__device__ __forceinline__ unsigned pk8(float a, float b, float c, float d) {
    a = __builtin_amdgcn_fmed3f(a, -448.f, 448.f); b = __builtin_amdgcn_fmed3f(b, -448.f, 448.f); c = __builtin_amdgcn_fmed3f(c, -448.f, 448.f); d = __builtin_amdgcn_fmed3f(d, -448.f, 448.f);
    int r = __builtin_amdgcn_cvt_pk_fp8_f32(a, b, 0, false); r = __builtin_amdgcn_cvt_pk_fp8_f32(c, d, r, true); return (unsigned)r;
}
#define LDS_WAIT() asm volatile("s_waitcnt lgkmcnt(0)" ::: "memory")

struct Args { const float* in[31]; float* out; unsigned char* ws; long long pad; };
typedef const __attribute__((address_space(4))) Args CArgs;
enum { I_X = 0, I_C, I_ADAW, I_ADAB, I_NPM, I_NQM, I_NPF, I_NQF, I_EVWIN, I_FOXB, I_LAMRE, I_LAMIM, I_LOGDT, I_BRE, I_BIM, I_CRE, I_CIM, I_S5D, I_GLUW, I_GLUB, I_EVWOUT,
       I_ODWIN, I_GLAWUP, I_GLABG, I_ODWOUT, I_RW, I_RB, I_WGU, I_BGU, I_WDN, I_BDN };

namespace pg8 {
constexpr int BM = 256, BK = 64, HALF = 128, HTB = HALF * BK * 2, STAGE_BYTES = 8 * HTB, NXCD = 8, WGM = 8;
__device__ __forceinline__ int lds_byte(int r, int c) { const int st = (r >> 4) * 2 + (c >> 5), rr = r & 15, cc = c & 31, ob = rr * 64 + cc * 2; return st * 1024 + (ob ^ (((ob >> 9) & 1) << 5)); }
__device__ __forceinline__ void stage_rc(int b, int& R, int& C) { const int st = b / 1024, sb = b % 1024, swz = sb ^ (((sb >> 9) & 1) << 5); R = (st >> 1) * 16 + swz / 64; C = (st & 1) * 32 + (swz % 64) / 2; }
__device__ __forceinline__ int perm32(int rho) { const int n = rho >> 4, i = rho & 15; return 8 * (i >> 2) + 4 * n + (i & 3); }
__device__ __forceinline__ unsigned cvt_pk_bf16(float lo, float hi) { unsigned r; asm volatile("v_cvt_pk_bf16_f32 %0, %1, %2" : "=v"(r) : "v"(lo), "v"(hi)); return r; }

struct Unit { int pm, pn, e, mb, nrows, kind; };
__device__ __forceinline__ int xcd_remap(int L, int nwg) { const int q = nwg / NXCD, r = nwg % NXCD, xcd = L % NXCD, off = L / NXCD; return (xcd < r ? xcd * (q + 1) : r * (q + 1) + (xcd - r) * q) + off; }

struct DenseOrder {
    const char* Ap; const char* Bt; int K, nM, nN, nwg, G, c;
    __device__ __forceinline__ void init(const void* A_, const void* Bt_, int M, int N, int K_, int G_, int c_) { Ap = (const char*)A_; Bt = (const char*)Bt_; K = K_; nM = M / BM; nN = N / BM; nwg = nM * nN; G = G_; c = c_; }
    __device__ __forceinline__ bool next(int i, Unit& u) const {
        const long L = (long)i * G + c; if (L >= nwg) return false;
        const int wgid = xcd_remap((int)L, nwg);
        const int nig = WGM * nN, gid = wgid / nig, fm = gid * WGM, gsz = (nM - fm) < WGM ? (nM - fm) : WGM;
        u.pm = fm + ((wgid % nig) % gsz); u.pn = (wgid % nig) / gsz; u.e = 0; u.mb = u.pm; u.nrows = BM; u.kind = 0; return true;
    }
    __device__ __forceinline__ const char* a_base(const Unit& u) const { return Ap + (size_t)u.pm * ((size_t)BM * K * 2); }
    __device__ __forceinline__ const char* b_base(const Unit& u) const { return Bt + (size_t)u.pn * ((size_t)BM * K * 2); }
    __device__ __forceinline__ void a_raw(const Unit&, const int (&)[2], int (&raw)[2][2]) const { raw[0][0] = raw[0][1] = raw[1][0] = raw[1][1] = 0; }
    __device__ __forceinline__ void a_offs(const Unit&, const int (&R)[2], const int (&C)[2], const int (&)[2][2], unsigned (&v)[2][2]) const {
#pragma unroll
        for (int h = 0; h < 2; ++h)
#pragma unroll
            for (int i = 0; i < 2; ++i) v[h][i] = (unsigned)((h * HALF + R[i]) * K + C[i]) * 2u;
    }
};
struct MoeTables { int cnt[NEXP]; int mtstart[NEXP + 1]; unsigned char tile_e[320]; };
template <bool GATHER> struct MoeOrder {
    const char* Ap; const char* Bt; size_t estride; int K, NP, nwg, G, c, mt0; const int* list_tk; const LAS MoeTables* tb;
    __device__ __forceinline__ bool next(int i, Unit& u) const {
        const long L = (long)i * G + c; if (L >= nwg) return false;
        const int w = xcd_remap((int)L, nwg);
        const int mq = w / NP, mt = mt0 + mq; u.pn = w - mq * NP; u.pm = mt; u.e = tb->tile_e[mt]; u.mb = mt - tb->mtstart[u.e];
        const int left = tb->cnt[u.e] - u.mb * BM; u.nrows = left < BM ? left : BM; u.kind = GATHER ? 0 : 1; return true;
    }
    __device__ __forceinline__ const char* a_base(const Unit& u) const { return GATHER ? Ap : Ap + (size_t)u.pm * ((size_t)BM * K * 2); }
    __device__ __forceinline__ const char* b_base(const Unit& u) const { return Bt + (size_t)u.e * estride + (size_t)u.pn * ((size_t)BM * K * 2); }
    __device__ __forceinline__ void a_raw(const Unit& u, const int (&R)[2], int (&raw)[2][2]) const {
#pragma unroll
        for (int h = 0; h < 2; ++h)
#pragma unroll
            for (int i = 0; i < 2; ++i) { if (GATHER) { const int r = h * HALF + R[i], rc = r < u.nrows ? r : 0; raw[h][i] = list_tk[u.e * LISTCAP + u.mb * BM + rc]; } else raw[h][i] = 0; }
    }
    __device__ __forceinline__ void a_offs(const Unit&, const int (&R)[2], const int (&C)[2], const int (&raw)[2][2], unsigned (&v)[2][2]) const {
#pragma unroll
        for (int h = 0; h < 2; ++h)
#pragma unroll
            for (int i = 0; i < 2; ++i) {
                if (GATHER) v[h][i] = (unsigned)((raw[h][i] >> 2) * K + C[i]) * 2u;
                else v[h][i] = (unsigned)((h * HALF + R[i]) * K + C[i]) * 2u;
            }
    }
};

struct MoeMixOrder {
    const char* ws; int l, a0, nA, b0, nB, nwg, G, c; const LAS MoeTables* tb;
    static constexpr int K = 512;
    __device__ __forceinline__ bool next(int i, Unit& u) const {
        const long L = (long)i * G + c; if (L >= nwg) return false;
        int w = xcd_remap((int)L, nwg), mt;
        if (w < nA) { u.kind = 0; mt = a0 + (w >> 3); u.pn = w & 7; } else { w -= nA; u.kind = 1; mt = b0 + (w >> 2); u.pn = w & 3; }
        u.pm = mt; u.e = tb->tile_e[mt]; u.mb = mt - tb->mtstart[u.e];
        const int left = tb->cnt[u.e] - u.mb * BM; u.nrows = left < BM ? left : BM; return true;
    }
    __device__ __forceinline__ const char* a_base(const Unit& u) const { return u.kind ? ws + WS_ACT : ws + WS_HB8; }
    __device__ __forceinline__ const char* b_base(const Unit& u) const { return u.kind ? ws + WS_W2 + (size_t)(l * 32 + u.e) * ((size_t)1024 * K * 2) + (size_t)u.pn * ((size_t)BM * K * 2) : ws + WS_W1 + (size_t)(l * 32 + u.e) * ((size_t)2048 * K * 2) + (size_t)u.pn * ((size_t)BM * K * 2); }
    __device__ __forceinline__ void a_raw(const Unit& u, const int (&R)[2], int (&raw)[2][2]) const {
#pragma unroll
        for (int h = 0; h < 2; ++h)
#pragma unroll
            for (int i = 0; i < 2; ++i) { const int r = h * HALF + R[i], rc = r < u.nrows ? r : 0; raw[h][i] = u.kind ? 4 * (u.pm * BM + r) : ((const int*)(ws + WS_LTK))[(l * 32 + u.e) * LISTCAP + u.mb * BM + rc]; }
    }
    __device__ __forceinline__ void a_offs(const Unit& u, const int (&R)[2], const int (&C)[2], const int (&raw)[2][2], unsigned (&v)[2][2]) const {
#pragma unroll
        for (int h = 0; h < 2; ++h)
#pragma unroll
            for (int i = 0; i < 2; ++i) v[h][i] = (unsigned)((raw[h][i] >> 2) * K + C[i]) * 2u;
    }
};

template <class Epi, class Sched, bool ALIGN_EPI, bool FP8 = false>
__device__ __forceinline__ void gemm_phase(LAS unsigned char* lds, const int wave_, const int K, const Sched& S, const Epi& E) {
    int tid_ = wave_ * 64 + lane_id(); asm volatile("" : "+v"(tid_));
    const int tid = tid_, wid = wave_, lane = tid & 63, wr = wid >> 2, wc = wid & 3, fr = lane & 15, fq = lane >> 4;
    int nt_ = K / BK; if constexpr (FP8) asm volatile("" : "+s"(nt_));
    const int nt = nt_;
    int Rr[2], Cc[2]; unsigned voffB[2];
#pragma unroll
    for (int i = 0; i < 2; ++i) { stage_rc(tid * 16 + i * 8192, Rr[i], Cc[i]); const int Rb = Epi::PERM ? ((Rr[i] & ~31) + perm32(Rr[i] & 31)) : Rr[i]; voffB[i] = (unsigned)(Rb * K + Cc[i]) * 2u; }
    const size_t kstep = (size_t)(BK * 2);
    const size_t hstep = (size_t)HALF * K * 2;
    const unsigned ldsw = (unsigned)wid * 1024u;
    const int aoff = lds_byte(wr * 64 + fr, fq * 8), boff = lds_byte(wc * 32 + fr, fq * 8);
#define PG8_SA(b, h) (((b) * 2 + (h)) * HTB)
#define PG8_SB(b, h) ((4 + (b) * 2 + (h)) * HTB)
#define PG8_STAGE(bufoff, gbase, voff) do { _Pragma("unroll") for (int _i = 0; _i < 2; ++_i) { unsigned vo_ = (voff)[_i]; if constexpr (FP8) asm volatile("" : "+v"(vo_));   \
        __builtin_amdgcn_global_load_lds((const unsigned*)((const char*)(gbase) + vo_), (LAS unsigned*)(lds + (bufoff) + ldsw + _i * 8192), 16, 0, 0); } } while (0)
#define PG8_LDA(dst, b, h) do { _Pragma("unroll") for (int m = 0; m < 4; ++m) { \
        if constexpr (FP8) { const i32x4 lo_ = *(const LAS i32x4*)(lds + PG8_SA(b, h) + aoff + m * 2048), hi_ = *(const LAS i32x4*)(lds + PG8_SA(b, h) + aoff + m * 2048 + 1024); dst##8[m] = __builtin_shufflevector(lo_, hi_, 0, 1, 2, 3, 4, 5, 6, 7); } \
        else { _Pragma("unroll") for (int k = 0; k < 2; ++k) dst[m][k] = *(const LAS bf16x8*)(lds + PG8_SA(b, h) + aoff + m * 2048 + k * 1024); } } } while (0)
#define PG8_LDB(dst, b, h) do { _Pragma("unroll") for (int n = 0; n < 2; ++n) { \
        if constexpr (FP8) { const i32x4 lo_ = *(const LAS i32x4*)(lds + PG8_SB(b, h) + boff + n * 2048), hi_ = *(const LAS i32x4*)(lds + PG8_SB(b, h) + boff + n * 2048 + 1024); dst##8[n] = __builtin_shufflevector(lo_, hi_, 0, 1, 2, 3, 4, 5, 6, 7); } \
        else { _Pragma("unroll") for (int k = 0; k < 2; ++k) dst[n][k] = *(const LAS bf16x8*)(lds + PG8_SB(b, h) + boff + n * 2048 + k * 1024); } } } while (0)
#define PG8_MMA(ai, bj, At, Bt) do { __builtin_amdgcn_s_setprio(1); _Pragma("unroll") for (int m = 0; m < 4; ++m) _Pragma("unroll") for (int n = 0; n < 2; ++n) { \
        if constexpr (FP8) asm volatile("v_mfma_f32_16x16x128_f8f6f4 %0, %1, %2, %0" : "+v"(acc[ai][bj][m][n]) : "v"(Bt##8[n]), "v"(At##8[m]));   \
        else { _Pragma("unroll") for (int k = 0; k < 2; ++k) acc[ai][bj][m][n] = __builtin_amdgcn_mfma_f32_16x16x32_bf16(Bt[n][k], At[m][k], acc[ai][bj][m][n], 0, 0, 0); } } \
        __builtin_amdgcn_s_setprio(0); } while (0)
#define PG8_WAIT_V(n) asm volatile("s_waitcnt vmcnt(" #n ")" ::: "memory")
#define PG8_WAIT_L(n) asm volatile("s_waitcnt lgkmcnt(" #n ")" ::: "memory")
#define PG8_BAR __builtin_amdgcn_s_barrier()
#define PG8_SCHED __builtin_amdgcn_sched_barrier(0)
    Unit cur, nxt; int ui = 0;
    if (!S.next(0, cur)) return;
    f32x4 acc[2][2][4][2];
#pragma unroll
    for (int a = 0; a < 2; ++a)
#pragma unroll
        for (int b = 0; b < 2; ++b)
#pragma unroll
            for (int m = 0; m < 4; ++m)
#pragma unroll
                for (int n = 0; n < 2; ++n) acc[a][b][m][n] = (f32x4){0.f, 0.f, 0.f, 0.f};
    bf16x8 At[4][2], B0[2][2], B1[2][2]; i32x8 At8[4], B08[2], B18[2];
    const char* cA = S.a_base(cur); const char* cB = S.b_base(cur);
    unsigned cv[2][2], nv[2][2]; int raw[2][2];
    S.a_raw(cur, Rr, raw); S.a_offs(cur, Rr, Cc, raw, cv);
    PG8_STAGE(PG8_SB(0, 0), cB, voffB); PG8_STAGE(PG8_SB(0, 1), cB + hstep, voffB); PG8_STAGE(PG8_SA(0, 0), cA, cv[0]); PG8_STAGE(PG8_SA(0, 1), cA, cv[1]);
    if (wr == 1) PG8_BAR;
    PG8_WAIT_V(2); PG8_BAR;
    PG8_STAGE(PG8_SB(1, 0), cB + kstep, voffB); PG8_STAGE(PG8_SA(1, 0), cA + kstep, cv[0]); PG8_STAGE(PG8_SB(1, 1), cB + hstep + kstep, voffB);
    PG8_WAIT_V(6); PG8_BAR;
    for (;;) {
        const bool has_next = S.next(ui + 1, nxt);
        const char* nA = has_next ? S.a_base(nxt) : cA; const char* nB = has_next ? S.b_base(nxt) : cB;
        if (has_next) S.a_raw(nxt, Rr, raw);
#pragma unroll
        for (int h = 0; h < 2; ++h)
#pragma unroll
            for (int i = 0; i < 2; ++i) nv[h][i] = cv[h][i];
        for (int t = 0; t < nt; t += 2) {
            const bool last = (t == nt - 2);
            if (last && has_next) S.a_offs(nxt, Rr, Cc, raw, nv);
            const char* a1 = cA + (size_t)(t + 1) * kstep;
            const char* a2 = last ? nA : cA + (size_t)(t + 2) * kstep; const char* b2 = last ? nB : cB + (size_t)(t + 2) * kstep;
            const char* a3 = a2 + kstep; const char* b3 = b2 + kstep;
            unsigned v2[2][2];
#pragma unroll
            for (int h = 0; h < 2; ++h)
#pragma unroll
                for (int i = 0; i < 2; ++i) v2[h][i] = last ? nv[h][i] : cv[h][i];
            PG8_LDB(B0, 0, 0); PG8_LDB(B1, 0, 1); PG8_SCHED; PG8_LDA(At, 0, 0); PG8_STAGE(PG8_SA(1, 1), a1, cv[1]);
            PG8_WAIT_V(8); PG8_WAIT_L(0); PG8_BAR; PG8_MMA(0, 0, At, B0); PG8_MMA(0, 1, At, B1); PG8_BAR; PG8_SCHED;
            PG8_LDA(At, 0, 1); PG8_STAGE(PG8_SB(0, 0), b2, voffB); PG8_STAGE(PG8_SB(0, 1), b2 + hstep, voffB); PG8_STAGE(PG8_SA(0, 0), a2, v2[0]);
            PG8_WAIT_V(8); PG8_WAIT_L(0); PG8_BAR; PG8_MMA(1, 0, At, B0); PG8_MMA(1, 1, At, B1); PG8_BAR; PG8_SCHED;
            PG8_LDB(B0, 1, 0); PG8_LDB(B1, 1, 1); PG8_SCHED; PG8_LDA(At, 1, 0); PG8_STAGE(PG8_SA(0, 1), a2, v2[1]);
            PG8_WAIT_V(8); PG8_WAIT_L(0); PG8_BAR; PG8_MMA(0, 0, At, B0); PG8_MMA(0, 1, At, B1); PG8_BAR; PG8_SCHED;
            PG8_LDA(At, 1, 1); PG8_STAGE(PG8_SB(1, 0), b3, voffB); PG8_STAGE(PG8_SB(1, 1), b3 + hstep, voffB); PG8_STAGE(PG8_SA(1, 0), a3, v2[0]);
            PG8_WAIT_V(8); PG8_WAIT_L(0); PG8_BAR; PG8_MMA(1, 0, At, B0); PG8_MMA(1, 1, At, B1); PG8_BAR; PG8_SCHED;
        }
        if constexpr (ALIGN_EPI) { if (wr == 0) PG8_BAR; }
        if constexpr (FP8) asm volatile("s_nop 15\n\ts_nop 15" ::: "memory");
        E(acc, cur, wr, wc, fr, fq);
        if (!has_next) break;
#pragma unroll
        for (int a = 0; a < 2; ++a)
#pragma unroll
            for (int b = 0; b < 2; ++b)
#pragma unroll
                for (int m = 0; m < 4; ++m)
#pragma unroll
                    for (int n = 0; n < 2; ++n) acc[a][b][m][n] = (f32x4){0.f, 0.f, 0.f, 0.f};
        cur = nxt; cA = nA; cB = nB; ++ui;
#pragma unroll
        for (int h = 0; h < 2; ++h)
#pragma unroll
            for (int i = 0; i < 2; ++i) cv[h][i] = nv[h][i];
        if constexpr (ALIGN_EPI) { if (wr == 1) PG8_BAR; }
    }
    PG8_WAIT_V(0);
    if constexpr (!ALIGN_EPI) { if (wr == 0) PG8_BAR; }
    PG8_BAR;
#undef PG8_SA
#undef PG8_SB
#undef PG8_STAGE
#undef PG8_LDA
#undef PG8_LDB
#undef PG8_MMA
#undef PG8_WAIT_V
#undef PG8_WAIT_L
#undef PG8_BAR
#undef PG8_SCHED
}
}
namespace pg8 {
typedef f32x4 Acc[2][2][4][2];
struct EpiZ0 {
    static constexpr bool PERM = true;
    bf16_t* Z;
    __device__ __forceinline__ void operator()(const Acc& acc, const Unit& u, int wr, int wc, int fr, int fq) const {
        const float sc = (u.pn == 2 || u.pn == 3) ? C2 : 1.f;
        const int row0 = u.pm * BM + wr * 64 + fr, col0 = u.pn * BM + wc * 32 + 8 * fq;
#pragma unroll
        for (int ai = 0; ai < 2; ++ai)
#pragma unroll
            for (int m = 0; m < 4; ++m) { bf16_t* rowp = Z + (size_t)(row0 + ai * HALF + m * 16) * ZP0 + col0;
#pragma unroll
                for (int bj = 0; bj < 2; ++bj) { const f32x4 v0 = acc[ai][bj][m][0] * sc, v1 = acc[ai][bj][m][1] * sc;
                    u32x4 w; w.x = cvt_pk_bf16(v0[0], v0[1]); w.y = cvt_pk_bf16(v0[2], v0[3]); w.z = cvt_pk_bf16(v1[0], v1[1]); w.w = cvt_pk_bf16(v1[2], v1[3]);
                    *(u32x4*)(rowp + bj * HALF) = w; } }
    }
};
struct EpiZ1 {
    static constexpr bool PERM = true;
    bf16_t* Z; const float* rope;
    __device__ __forceinline__ void operator()(const Acc& acc, const Unit& u, int wr, int wc, int fr, int fq) const {
        constexpr float INV = 1.f / (SC_H * SC_WIN);
        const int row0 = u.pm * BM + wr * 64 + fr;
        if (u.pn < 4) {
            const float sc = (u.pn >= 2) ? 0.08838834764831845f * INV : INV;
            const int hl = wc >> 1, jj0 = 32 * (wc & 1) + 8 * fq;
#pragma unroll
            for (int ai = 0; ai < 2; ++ai)
#pragma unroll
                for (int m = 0; m < 4; ++m) { const int row = row0 + ai * HALF + m * 16, pos = row & (SEQ - 1);
                    const f32x4 c0 = *(const f32x4*)(rope + pos * 64 + jj0), c1 = *(const f32x4*)(rope + pos * 64 + jj0 + 4);
                    const f32x4 s0 = *(const f32x4*)(rope + SEQ * 64 + pos * 64 + jj0), s1 = *(const f32x4*)(rope + SEQ * 64 + pos * 64 + jj0 + 4);
                    const f32x4 x10 = acc[ai][0][m][0] * sc, x11 = acc[ai][0][m][1] * sc, x20 = acc[ai][1][m][0] * sc, x21 = acc[ai][1][m][1] * sc;
                    const f32x4 a0 = x10 * c0 - x20 * s0, a1 = x11 * c1 - x21 * s1, b0 = x10 * s0 + x20 * c0, b1 = x11 * s1 + x21 * c1;
                    bf16_t* rowp = Z + (size_t)row * ZP1 + u.pn * BM + 128 * hl + jj0;
                    u32x4 w; w.x = cvt_pk_bf16(a0[0], a0[1]); w.y = cvt_pk_bf16(a0[2], a0[3]); w.z = cvt_pk_bf16(a1[0], a1[1]); w.w = cvt_pk_bf16(a1[2], a1[3]);
                    *(u32x4*)(rowp) = w;
                    w.x = cvt_pk_bf16(b0[0], b0[1]); w.y = cvt_pk_bf16(b0[2], b0[3]); w.z = cvt_pk_bf16(b1[0], b1[1]); w.w = cvt_pk_bf16(b1[2], b1[3]);
                    *(u32x4*)(rowp + 64) = w; }
        } else {
            const float sc = (u.pn == 8) ? 0.125f * INV : INV;
            const int col0 = u.pn * BM + wc * 32 + 8 * fq;
#pragma unroll
            for (int ai = 0; ai < 2; ++ai)
#pragma unroll
                for (int m = 0; m < 4; ++m) { bf16_t* rowp = Z + (size_t)(row0 + ai * HALF + m * 16) * ZP1 + col0;
#pragma unroll
                    for (int bj = 0; bj < 2; ++bj) { const f32x4 v0 = acc[ai][bj][m][0] * sc, v1 = acc[ai][bj][m][1] * sc;
                        u32x4 w; w.x = cvt_pk_bf16(v0[0], v0[1]); w.y = cvt_pk_bf16(v0[2], v0[3]); w.z = cvt_pk_bf16(v1[0], v1[1]); w.w = cvt_pk_bf16(v1[2], v1[3]);
                        *(u32x4*)(rowp + bj * HALF) = w; } }
        }
    }
};
struct EpiGlu {
    static constexpr bool PERM = true;
    const bf16_t* G5; const float* bias; bf16_t* Y;
    __device__ __forceinline__ void operator()(const Acc& acc, const Unit& u, int wr, int wc, int fr, int fq) const {
        const int row0 = u.pm * BM + wr * 64 + fr, col0 = u.pn * BM + wc * 32 + 8 * fq;
        f32x4 bv[2][2];
#pragma unroll
        for (int bj = 0; bj < 2; ++bj)
#pragma unroll
            for (int n = 0; n < 2; ++n) bv[bj][n] = *(const f32x4*)(bias + col0 + bj * HALF + 4 * n);
#pragma unroll
        for (int ai = 0; ai < 2; ++ai)
#pragma unroll
            for (int m = 0; m < 4; ++m) { const size_t row = (size_t)(row0 + ai * HALF + m * 16);
#pragma unroll
                for (int bj = 0; bj < 2; ++bj) { const u32x4 gw = *(const u32x4*)(G5 + row * 512 + col0 + bj * HALF);
                    const f32x4 v0 = acc[ai][bj][m][0] + bv[bj][0], v1 = acc[ai][bj][m][1] + bv[bj][1];
                    float o[8]; o[0] = bflo(gw.x) * sigmoidf_(v0[0]); o[1] = bfhi(gw.x) * sigmoidf_(v0[1]); o[2] = bflo(gw.y) * sigmoidf_(v0[2]); o[3] = bfhi(gw.y) * sigmoidf_(v0[3]);
                    o[4] = bflo(gw.z) * sigmoidf_(v1[0]); o[5] = bfhi(gw.z) * sigmoidf_(v1[1]); o[6] = bflo(gw.w) * sigmoidf_(v1[2]); o[7] = bfhi(gw.w) * sigmoidf_(v1[3]);
                    u32x4 w; w.x = cvt_pk_bf16(o[0], o[1]); w.y = cvt_pk_bf16(o[2], o[3]); w.z = cvt_pk_bf16(o[4], o[5]); w.w = cvt_pk_bf16(o[6], o[7]);
                    *(u32x4*)(Y + row * DM + col0 + bj * HALF) = w; } }
    }
};
struct EpiF32 {
    static constexpr bool PERM = false;
    float* Cp; int ldc;
    __device__ __forceinline__ void operator()(const Acc& acc, const Unit& u, int wr, int wc, int fr, int fq) const {
        const int row0 = u.pm * BM + wr * 64 + fr, col0 = u.pn * BM + wc * 32 + 4 * fq;
#pragma unroll
        for (int ai = 0; ai < 2; ++ai)
#pragma unroll
            for (int m = 0; m < 4; ++m) { float* rowp = Cp + (size_t)(row0 + ai * HALF + m * 16) * ldc + col0;
#pragma unroll
                for (int bj = 0; bj < 2; ++bj)
#pragma unroll
                    for (int n = 0; n < 2; ++n) *(f32x4*)(rowp + bj * HALF + n * 16) = acc[ai][bj][m][n]; }
    }
};
struct EpiBf16Plain {
    static constexpr bool PERM = true;
    bf16_t* Cp; int ldc;
    __device__ __forceinline__ void operator()(const Acc& acc, const Unit& u, int wr, int wc, int fr, int fq) const {
        const int row0 = u.pm * BM + wr * 64 + fr, col0 = u.pn * BM + wc * 32 + 8 * fq;
#pragma unroll
        for (int ai = 0; ai < 2; ++ai)
#pragma unroll
            for (int m = 0; m < 4; ++m) { bf16_t* rowp = Cp + (size_t)(row0 + ai * HALF + m * 16) * ldc + col0;
#pragma unroll
                for (int bj = 0; bj < 2; ++bj) { const f32x4 v0 = acc[ai][bj][m][0], v1 = acc[ai][bj][m][1];
                    u32x4 w; w.x = cvt_pk_bf16(v0[0], v0[1]); w.y = cvt_pk_bf16(v0[2], v0[3]); w.z = cvt_pk_bf16(v1[0], v1[1]); w.w = cvt_pk_bf16(v1[2], v1[3]);
                    *(u32x4*)(rowp + bj * HALF) = w; } }
    }
};
struct EpiSwiglu {
    static constexpr bool PERM = true;
    unsigned char* ACT; const float* bgu;
    __device__ __forceinline__ void operator()(const Acc& acc, const Unit& u, int wr, int wc, int fr, int fq) const {
        constexpr float INV = 1.f / (SC_H * SC_W1), INVL = INV * SC_A, CE = -1.702f * LOG2E;
        const int row0 = u.pm * BM + wr * 64 + fr, j0 = wc * 32 + 8 * fq, colg = u.pn * 128 + j0;
        const float* bp = bgu + (size_t)u.e * 2048 + colg;
        f32x2 bg[4], bl[4];
#pragma unroll
        for (int p = 0; p < 4; ++p) { bg[p] = *(const f32x2*)(bp + 2 * p); bl[p] = (*(const f32x2*)(bp + 1024 + 2 * p) + 1.f) * SC_A; }
#pragma unroll
        for (int ai = 0; ai < 2; ++ai)
#pragma unroll
            for (int m = 0; m < 4; ++m) {
                f32x2 o[4];
#pragma unroll
                for (int p = 0; p < 4; ++p) {
                    const f32x4 ag = acc[ai][0][m][p >> 1], al = acc[ai][1][m][p >> 1];
                    const f32x2 g = (p & 1 ? (f32x2){ag[2], ag[3]} : (f32x2){ag[0], ag[1]}) * INV + bg[p], l = (p & 1 ? (f32x2){al[2], al[3]} : (f32x2){al[0], al[1]}) * INVL + bl[p];
                    const f32x2 a = {fminf(g.x, 7.f), fminf(g.y, 7.f)}, b = {__builtin_amdgcn_fmed3f(l.x, -6.f * SC_A, 8.f * SC_A), __builtin_amdgcn_fmed3f(l.y, -6.f * SC_A, 8.f * SC_A)};
                    const f32x2 t = a * CE; const f32x2 d = (f32x2){__builtin_amdgcn_exp2f(t.x), __builtin_amdgcn_exp2f(t.y)} + 1.f;
                    const f32x2 sg = {__builtin_amdgcn_rcpf(d.x), __builtin_amdgcn_rcpf(d.y)};
                    o[p] = (a * sg) * b; }
                u32x2 w; int r0 = __builtin_amdgcn_cvt_pk_fp8_f32(o[0].x, o[0].y, 0, false); r0 = __builtin_amdgcn_cvt_pk_fp8_f32(o[1].x, o[1].y, r0, true);
                int r1 = __builtin_amdgcn_cvt_pk_fp8_f32(o[2].x, o[2].y, 0, false); r1 = __builtin_amdgcn_cvt_pk_fp8_f32(o[3].x, o[3].y, r1, true);
                w.x = (unsigned)r0; w.y = (unsigned)r1;
                *(u32x2*)(ACT + (size_t)(row0 + ai * HALF + m * 16) * DM + colg) = w; }
    }
};
struct EpiDown {
    static constexpr bool PERM = true;
    unsigned char* Y; const float* bdn; const int* list_tk; const float* list_g;
    __device__ __forceinline__ void operator()(const Acc& acc, const Unit& u, int wr, int wc, int fr, int fq) const {
        constexpr float INV = SC_Y / (SC_A * SC_W2);
        const int r0 = wr * 64 + fr, col0 = u.pn * BM + wc * 32 + 8 * fq;
        const float* bp = bdn + (size_t)u.e * DM + col0;
        f32x4 bv[2][2];
#pragma unroll
        for (int bj = 0; bj < 2; ++bj)
#pragma unroll
            for (int n = 0; n < 2; ++n) bv[bj][n] = *(const f32x4*)(bp + bj * HALF + 4 * n) * SC_Y;
        const size_t lbase = (size_t)u.e * LISTCAP + (size_t)u.mb * BM;
        int tkv[2][4]; float gtv[2][4];
#pragma unroll
        for (int ai = 0; ai < 2; ++ai)
#pragma unroll
            for (int m = 0; m < 4; ++m) { const int r = r0 + ai * HALF + m * 16, rc = r < u.nrows ? r : 0; tkv[ai][m] = list_tk[lbase + rc]; gtv[ai][m] = list_g[lbase + rc]; }
#pragma unroll
        for (int ai = 0; ai < 2; ++ai)
#pragma unroll
            for (int m = 0; m < 4; ++m) { const int r = r0 + ai * HALF + m * 16;
                if (r < u.nrows) { const float gt = gtv[ai][m];
                    unsigned char* rowp = Y + (size_t)tkv[ai][m] * DM + col0;
#pragma unroll
                    for (int bj = 0; bj < 2; ++bj) { const float gi = gt * INV; const f32x4 v0 = acc[ai][bj][m][0] * gi + bv[bj][0] * gt, v1 = acc[ai][bj][m][1] * gi + bv[bj][1] * gt;
                        u32x2 w; w.x = pk8(v0[0], v0[1], v0[2], v0[3]); w.y = pk8(v1[0], v1[1], v1[2], v1[3]);
                        *(u32x2*)(rowp + bj * HALF) = w; } } }
    }
};
struct EpiMoeMix {
    static constexpr bool PERM = true;
    CArgs* ap; int l;
    __device__ __forceinline__ void operator()(const Acc& acc, const Unit& u, int wr, int wc, int fr, int fq) const {
        CArgs& A = *ap; unsigned char* ws = A.ws;
        if (u.kind == 0) { const EpiSwiglu sw{ws + WS_ACT, A.in[I_BGU] + (size_t)l * 32 * 2048}; sw(acc, u, wr, wc, fr, fq); }
        else { const EpiDown dn{ws + WS_Y, A.in[I_BDN] + (size_t)l * 32 * 1024, (const int*)(ws + WS_LTK) + (size_t)l * 32 * LISTCAP, (const float*)(ws + WS_LG) + (size_t)l * 32 * LISTCAP}; dn(acc, u, wr, wc, fr, fq); }
    }
};
}
struct Frame { unsigned char* lds; int tid, lane, wave, bid, G; };
#define P_MOD   ((float*)(A.ws + WS_MOD))
#define P_S5A   ((float*)(A.ws + WS_S5A))
#define P_S5BB  ((float*)(A.ws + WS_S5BB))
#define P_ROPE  ((float*)(A.ws + WS_ROPE))
#define P_WSIDE ((float*)(A.ws + WS_WSIDE))
#define P_S5CK  ((bf16_t*)(A.ws + WS_S5CK))
#define P_LTK   ((int*)(A.ws + WS_LTK))
#define P_LG    ((float*)(A.ws + WS_LG))
#define P_CNT   ((unsigned*)(A.ws + WS_CTL) + CW_CNT)
#define P_WINE  (A.ws + WS_WINE)
#define P_WGLU  ((bf16_t*)(A.ws + WS_WGLU))
#define P_WOUTE ((bf16_t*)(A.ws + WS_WOUTE))
#define P_WINO  (A.ws + WS_WINO)
#define P_WOUTO ((bf16_t*)(A.ws + WS_WOUTO))
#define P_W1    (A.ws + WS_W1)
#define P_W2    (A.ws + WS_W2)
#define P_HB8   (A.ws + WS_HB8)
#define P_HB    (A.ws + WS_HB)
#define P_Z     ((bf16_t*)(A.ws + WS_Z))
#define P_G5    ((bf16_t*)(A.ws + WS_G5))
#define P_YCAT  ((bf16_t*)(A.ws + WS_YCAT))
#define P_ACT   (A.ws + WS_ACT)
#define P_Y     (A.ws + WS_Y)
#define P_LSIG  ((float*)(A.ws + WS_LSIG))
#define P_LOGA  ((float*)(A.ws + WS_LOGA))
#define P_MBUF  ((float*)(A.ws + WS_MBUF))
#define P_XB    ((bf16_t*)(A.ws + WS_XB))
#define P_RST   ((bf16_t*)(A.ws + WS_RST))
#define P_GST   ((bf16_t*)(A.ws + WS_GST))

__device__ __forceinline__ void tr_tile(const float* __restrict__ src, int pitch, int k0, int c0, bf16_t* dst, int Kd, int r0, float* scr, int lane) {
#pragma unroll
    for (int i = 0; i < 16; ++i) {
        const int kk = 4 * i + (lane >> 4), cc = 4 * (lane & 15);
        const f32x4 v = __builtin_nontemporal_load((const f32x4*)(src + (size_t)(k0 + kk) * pitch + c0 + cc));
        float* s = scr + kk * 65 + cc; s[0] = v.x; s[1] = v.y; s[2] = v.z; s[3] = v.w;
    }
    LDS_WAIT();
    const int c = lane & 7;
#pragma unroll
    for (int j = 0; j < 8; ++j) { const int n = (lane >> 3) + 8 * j; const float* s = scr + (8 * c) * 65 + n;
        u32x4 o; o.x = pk2(s[0], s[65]); o.y = pk2(s[130], s[195]); o.z = pk2(s[260], s[325]); o.w = pk2(s[390], s[455]);
        __builtin_nontemporal_store(o, (u32x4*)(dst + (size_t)(r0 + n) * Kd + k0 + 8 * c)); }
    LDS_WAIT();
}
__device__ __forceinline__ void tr_tile8(const float* __restrict__ src, int pitch, int k0, int c0, unsigned char* dst, int Kd, int r0, float* scr, int lane, float scale) {
#pragma unroll
    for (int i = 0; i < 16; ++i) {
        const int kk = 4 * i + (lane >> 4), cc = 4 * (lane & 15);
        const f32x4 v = __builtin_nontemporal_load((const f32x4*)(src + (size_t)(k0 + kk) * pitch + c0 + cc));
        float* s = scr + kk * 65 + cc; s[0] = v.x * scale; s[1] = v.y * scale; s[2] = v.z * scale; s[3] = v.w * scale;
    }
    LDS_WAIT();
    const int c = lane & 3;
#pragma unroll
    for (int j = 0; j < 4; ++j) { const int n = (lane >> 2) + 16 * j; const float* s = scr + (16 * c) * 65 + n;
        u32x4 o; o.x = pk8(s[0], s[65], s[130], s[195]); o.y = pk8(s[260], s[325], s[390], s[455]); o.z = pk8(s[520], s[585], s[650], s[715]); o.w = pk8(s[780], s[845], s[910], s[975]);
        __builtin_nontemporal_store(o, (u32x4*)(dst + (size_t)(r0 + n) * Kd + k0 + 16 * c)); }
    LDS_WAIT();
}
struct TileD { const float* src; unsigned char* dst; int pitch, rp, mode; float scale; };
constexpr int P0_T0 = 16 * 32, P0_T1 = 8 * 8, P0_T2 = 16 * 16, P0_T3 = 16 * 56, P0_T4 = 16 * 16, P0_T5 = 64 * 16 * 32, P0_T6 = 64 * 16 * 16;
constexpr int P0_NTILES = P0_T0 + P0_T1 + P0_T2 + P0_T3 + P0_T4 + P0_T5 + P0_T6;
__device__ __forceinline__ void tile_set(TileD& d, const float* src, int pitch, int k0, int c0, unsigned char* dst, int Kd, int r0, int mode, float scale) {
    d.src = src + (size_t)k0 * pitch + c0; d.pitch = pitch; d.mode = mode; d.scale = scale;
    d.rp = mode ? Kd : 2 * Kd; d.dst = dst + (size_t)r0 * d.rp + (mode ? k0 : 2 * k0);
}
__device__ __forceinline__ void tile_decode(CArgs& A, int it, TileD& d) {
    int r = it;
    if (r < P0_T0) { const int kb = r / 32, nb = r % 32; tile_set(d, A.in[I_EVWIN], 2056, kb * 64, nb * 64, P_WINE, 1024, nb * 64, 0, 1.f); return; } r -= P0_T0;
    if (r < P0_T1) { const int kb = r / 8, nb = r % 8; tile_set(d, A.in[I_GLUW], 512, kb * 64, nb * 64, (unsigned char*)P_WGLU, 512, nb * 64, 0, 1.f); return; } r -= P0_T1;
    if (r < P0_T2) { const int kb = r / 16, nb = r % 16; tile_set(d, A.in[I_EVWOUT], 1024, kb * 64, nb * 64, (unsigned char*)P_WOUTE, 1024, nb * 64, 0, 1.f); return; } r -= P0_T2;
    if (r < P0_T3) { const int kb = r / 56, nb = r % 56; const int n0 = nb * 64; int c0;
        if (n0 < 1024) { const int pn = n0 >> 8, rem = n0 & 255, bj = rem >> 7, hl = (rem & 127) >> 6; c0 = 256 * pn + 128 * hl + 64 * bj; }
        else if (n0 < 3072) c0 = n0; else c0 = n0 + 16;
        tile_set(d, A.in[I_ODWIN], 3600, kb * 64, c0, P_WINO, 1024, n0, 1, SC_WIN); return; } r -= P0_T3;
    if (r < P0_T4) { const int kb = r / 16, nb = r % 16; tile_set(d, A.in[I_ODWOUT], 1024, kb * 64, nb * 64, (unsigned char*)P_WOUTO, 1024, nb * 64, 0, 1.f); return; } r -= P0_T4;
    if (r < P0_T5) { const int mat = r / 512, q = r % 512, kb = q / 32, nb = q % 32; const int n0 = nb * 64, pn = n0 >> 8, half = (n0 & 255) >> 7, j0 = n0 & 127;
        tile_set(d, A.in[I_WGU] + (size_t)mat * 1024 * 2048, 2048, kb * 64, half * 1024 + 128 * pn + j0, P_W1 + (size_t)mat * 2048 * 1024, 1024, n0, 1, SC_W1); return; } r -= P0_T5;
    { const int mat = r / 256, q = r % 256, kb = q / 16, nb = q % 16;
        tile_set(d, A.in[I_WDN] + (size_t)mat * 1024 * 1024, 1024, kb * 64, nb * 64, P_W2 + (size_t)mat * 1024 * 1024, 1024, nb * 64, 1, SC_W2); }
}
__device__ __forceinline__ void tile_load(const TileD& d, f32x4 (&R)[16], int lane) {
#pragma unroll
    for (int i = 0; i < 16; ++i) R[i] = __builtin_nontemporal_load((const f32x4*)(d.src + (size_t)(4 * i + (lane >> 4)) * d.pitch + 4 * (lane & 15)));
}
__device__ __forceinline__ void tile_finish(const TileD& d, const float* scr, int lane) {
    if (d.mode == 0) {
        const int c = lane & 7;
#pragma unroll
        for (int j = 0; j < 8; ++j) { const int n = (lane >> 3) + 8 * j; const float* s = scr + (8 * c) * 65 + n;
            u32x4 o; o.x = pk2(s[0], s[65]); o.y = pk2(s[130], s[195]); o.z = pk2(s[260], s[325]); o.w = pk2(s[390], s[455]);
            __builtin_nontemporal_store(o, (u32x4*)(d.dst + (size_t)n * d.rp + 16 * c)); }
    } else {
        const int c = lane & 3;
#pragma unroll
        for (int j = 0; j < 4; ++j) { const int n = (lane >> 2) + 16 * j; const float* s = scr + (16 * c) * 65 + n;
            u32x4 o; o.x = pk8(s[0], s[65], s[130], s[195]); o.y = pk8(s[260], s[325], s[390], s[455]); o.z = pk8(s[520], s[585], s[650], s[715]); o.w = pk8(s[780], s[845], s[910], s[975]);
            __builtin_nontemporal_store(o, (u32x4*)(d.dst + (size_t)n * d.rp + 16 * c)); }
    }
}
__device__ __forceinline__ void p0_prep(CArgs& A, const Frame& F) {
    if (F.bid < 192) {
        float* sc = (float*)F.lds;
        float* red = sc + 8192;
        for (int i = F.tid; i < 8192; i += 512) sc[i] = siluf_(A.in[I_C][i]);
        __syncthreads();
        const int l = F.bid / 96, n = (F.bid % 96) * 64 + F.lane;
        const float* w = A.in[I_ADAW] + (size_t)l * 1024 * 6144 + n;
        float a[8];
#pragma unroll
        for (int b = 0; b < 8; ++b) a[b] = 0.f;
        for (int k = 128 * F.wave; k < 128 * F.wave + 128; ++k) { const float wv = w[(size_t)k * 6144];
#pragma unroll
            for (int b = 0; b < 8; ++b) a[b] += sc[b * 1024 + k] * wv; }
#pragma unroll
        for (int b = 0; b < 8; ++b) red[(F.wave * 8 + b) * 64 + F.lane] = a[b];
        __syncthreads();
        { const int b = F.tid >> 6, ln = F.tid & 63; float s = 0.f;
#pragma unroll
          for (int w8 = 0; w8 < 8; ++w8) s += red[(w8 * 8 + b) * 64 + ln];
          const int nn = (F.bid % 96) * 64 + ln; __hip_atomic_store(P_MOD + (size_t)(l * 8 + b) * 6144 + nn, s + A.in[I_ADAB][l * 6144 + nn], __ATOMIC_RELAXED, __HIP_MEMORY_SCOPE_AGENT); }
    }
    {
        const int gt = F.bid * 512 + F.tid;
        if (gt < 32 * 64) {
            const int g = gt >> 6;
            const float lr = A.in[I_LAMRE][gt], li = A.in[I_LAMIM][gt], dt = expf(A.in[I_LOGDT][g]);
            const float mag = expf(lr * dt); float sn, cs; sincosf(li * dt, &sn, &cs);
            const float are = mag * cs, aim = mag * sn, den = lr * lr + li * li, nre = are - 1.f, nim = aim;
            const float zre = (nre * lr + nim * li) / den, zim = (nim * lr - nre * li) / den;
            P_S5A[gt * 2] = are; P_S5A[gt * 2 + 1] = aim;
            for (int c = 0; c < 16; ++c) { const float br = A.in[I_BRE][gt * 16 + c], bi = A.in[I_BIM][gt * 16 + c];
                P_S5BB[gt * 32 + c] = zre * br - zim * bi; P_S5BB[gt * 32 + 16 + c] = zre * bi + zim * br; }
        }
        for (int i = gt; i < 32 * 16 * 128; i += F.G * 512) { const int k = i & 127, gc = i >> 7, pp = k >> 1; const float v = (k & 1) ? -A.in[I_CIM][gc * 64 + pp] : A.in[I_CRE][gc * 64 + pp]; P_S5CK[i] = (bf16_t)f2bf(v); }
        for (int i = gt; i < 24 * 1024; i += F.G * 512) { const int o = i >> 10, k = i & 1023; P_WSIDE[i] = o < 8 ? A.in[I_EVWIN][(size_t)k * 2056 + 2048 + o] : A.in[I_ODWIN][(size_t)k * 3600 + 3072 + (o - 8)]; }
        for (int i = gt; i < SEQ * 64; i += F.G * 512) { const int pos = i >> 6, j = i & 63;
            const float inv = exp2f(-(float)j * (13.287712379549449f / 64.f)); const float ang = (float)pos * inv; float sn, cs; sincosf(ang, &sn, &cs);
            P_ROPE[i] = cs; P_ROPE[SEQ * 64 + i] = sn; }
    }
    __syncthreads();
    float* scr = (float*)(F.lds) + F.wave * (64 * 65);
    const int gw = F.bid * 8 + F.wave, NGW = F.G * 8;
    int it = gw; TileD cur, nxt; f32x4 R[16];
    cur.src = nullptr; cur.dst = nullptr; cur.pitch = 0; cur.rp = 0; cur.mode = 0; cur.scale = 1.f; nxt = cur;
    if (it < P0_NTILES) { tile_decode(A, it, cur); tile_load(cur, R, F.lane); }
#pragma unroll 1
    while (it < P0_NTILES) {
        const int nx = it + NGW; const bool hn = nx < P0_NTILES;
#pragma unroll
        for (int i = 0; i < 16; ++i) { const int kk = 4 * i + (F.lane >> 4), cc = 4 * (F.lane & 15); float* s = scr + kk * 65 + cc; s[0] = R[i].x * cur.scale; s[1] = R[i].y * cur.scale; s[2] = R[i].z * cur.scale; s[3] = R[i].w * cur.scale; }
        if (hn) { tile_decode(A, nx, nxt); tile_load(nxt, R, F.lane); }
        asm volatile("" ::: "memory");
        LDS_WAIT();
        tile_finish(cur, scr, F.lane);
        LDS_WAIT();
        cur = nxt; it = nx;
    }
}

struct Row { f32x4 v[4]; };
__device__ __forceinline__ void row_load(Row& r, const float* p, int lane) {
#pragma unroll
    for (int j = 0; j < 4; ++j) r.v[j] = __builtin_nontemporal_load((const f32x4*)(p + 4 * lane + 256 * j));
}
__device__ __forceinline__ void row_load_bf16(Row& r, const bf16_t* p, int lane) {
#pragma unroll
    for (int j = 0; j < 4; ++j) { const u32x2 w = __builtin_nontemporal_load((const u32x2*)(p + 4 * lane + 256 * j)); r.v[j] = (f32x4){bflo(w.x), bfhi(w.x), bflo(w.y), bfhi(w.y)}; }
}
__device__ __forceinline__ void row_store(const Row& r, float* p, int lane) {
#pragma unroll
    for (int j = 0; j < 4; ++j) __builtin_nontemporal_store(r.v[j], (f32x4*)(p + 4 * lane + 256 * j));
}
__device__ __forceinline__ void row_store_bf16(const Row& r, bf16_t* p, int lane) {
#pragma unroll
    for (int j = 0; j < 4; ++j) { u32x2 w; w.x = pk2(r.v[j].x, r.v[j].y); w.y = pk2(r.v[j].z, r.v[j].w); *(u32x2*)(p + 4 * lane + 256 * j) = w; }
}
__device__ __forceinline__ void row_store_bf16_nt(const Row& r, bf16_t* p, int lane) {
#pragma unroll
    for (int j = 0; j < 4; ++j) { u32x2 w; w.x = pk2(r.v[j].x, r.v[j].y); w.y = pk2(r.v[j].z, r.v[j].w); __builtin_nontemporal_store(w, (u32x2*)(p + 4 * lane + 256 * j)); }
}
__device__ __forceinline__ float row_rstd(const Row& r) {
    float s = 0.f;
#pragma unroll
    for (int j = 0; j < 4; ++j) s += (r.v[j].x * r.v[j].x + r.v[j].y * r.v[j].y) + (r.v[j].z * r.v[j].z + r.v[j].w * r.v[j].w);
    return rsqrtf(wave_sum(s) * (1.f / DM) + EPS);
}
__device__ __forceinline__ void row_modnorm(Row& h, const Row& x, const float* gain, const float* sh, const float* sc, int lane) {
    const float r = row_rstd(x);
#pragma unroll
    for (int j = 0; j < 4; ++j) { const int k = 4 * lane + 256 * j; const f32x4 g = *(const f32x4*)(gain + k), a = *(const f32x4*)(sc + k), b = *(const f32x4*)(sh + k);
        h.v[j] = x.v[j] * r * g * (a + 1.f) + b; }
}
__device__ __forceinline__ void hprep_row(CArgs& A, const Frame& F, const Row& x, int l, int row, const float* wl) {
    const int b = row >> 11, lane = F.lane; const float* mod = P_MOD + (size_t)(l * 8 + b) * 6144;
    Row h; row_modnorm(h, x, A.in[I_NPM] + l * DM, mod, mod + 1024, lane);
    if (l == 0) row_store_bf16(h, (bf16_t*)P_HB + (size_t)row * DM, lane);
    else {
#pragma unroll
        for (int j = 0; j < 4; ++j) *(unsigned*)(P_HB + (size_t)row * DM + 4 * lane + 256 * j) = pk8(SC_H * h.v[j].x, SC_H * h.v[j].y, SC_H * h.v[j].z, SC_H * h.v[j].w);
    }
    if (l == 0) {
        float mine = 0.f;
#pragma unroll
        for (int i = 0; i < 8; ++i) { float p = 0.f;
#pragma unroll
            for (int j = 0; j < 4; ++j) { const f32x4 w = *(const f32x4*)(wl + i * 1024 + 4 * lane + 256 * j); p += (h.v[j].x * w.x + h.v[j].y * w.y) + (h.v[j].z * w.z + h.v[j].w * w.w); }
            const float s = wave_sum(p); if (lane == i) mine = s; if ((i & 3) == 3) asm volatile("" ::: "memory"); }
        if (lane < 8) P_LSIG[(size_t)row * 8 + lane] = log_sigmoidf_(mine + A.in[I_FOXB][lane]);
    } else {
        float p[16];
#pragma unroll
        for (int i = 0; i < 16; ++i) { float q = 0.f;
#pragma unroll
            for (int j = 0; j < 4; ++j) { const f32x4 w = *(const f32x4*)(wl + i * 1024 + 4 * lane + 256 * j); q += (h.v[j].x * w.x + h.v[j].y * w.y) + (h.v[j].z * w.z + h.v[j].w * w.w); }
            p[i] = wave_sum(q); if ((i & 1) == 1) asm volatile("" ::: "memory"); }
        const float* wup = wl + 16 * 1024;
#pragma unroll
        for (int q = 0; q < 4; ++q) { const int jcol = lane + 64 * q; float s = wup[16 * 256 + jcol];
#pragma unroll
            for (int i = 0; i < 16; ++i) s += p[i] * wup[i * 256 + jcol];
            P_LOGA[(size_t)row * 256 + jcol] = log_sigmoidf_(s) * (1.f / 16.f); }
    }
}
__device__ __forceinline__ void stage_side(CArgs& A, const Frame& F, int l, float* wl) {
    __syncthreads();
    if (l == 0) { for (int i = F.tid; i < 8 * 256; i += 512) *(f32x4*)(wl + 4 * i) = *(const f32x4*)(P_WSIDE + 4 * i); }
    else { for (int i = F.tid; i < 16 * 256; i += 512) *(f32x4*)(wl + 4 * i) = *(const f32x4*)(P_WSIDE + 8192 + 4 * i);
           for (int i = F.tid; i < 16 * 64; i += 512) *(f32x4*)(wl + 16384 + 4 * i) = *(const f32x4*)(A.in[I_GLAWUP] + 4 * i);
           if (F.tid < 64) *(f32x4*)(wl + 16384 + 4096 + 4 * F.tid) = *(const f32x4*)(A.in[I_GLABG] + 4 * F.tid); }
    __syncthreads();
}
__device__ __forceinline__ void p1_hprep0(CArgs& A, const Frame& F) {
    float* wl = (float*)F.lds; stage_side(A, F, 0, wl);
    const int gw = F.bid * 8 + F.wave, NGW = F.G * 8;
    Row xn; if (gw < NTOK) row_load(xn, A.in[I_X] + (size_t)gw * DM, F.lane);
#pragma unroll 1
    for (int row = gw; row < NTOK; row += NGW) { Row x;
#pragma unroll
        for (int j = 0; j < 4; ++j) x.v[j] = xn.v[j];
        if (row + NGW < NTOK) row_load(xn, A.in[I_X] + (size_t)(row + NGW) * DM, F.lane); hprep_row(A, F, x, 0, row, wl); }
}

__device__ __forceinline__ void p_postmix(CArgs& A, const Frame& F, int l) {
    float* h2s = (float*)F.lds;
    float* red = h2s + 16 * 1028;
    float* lg = red + 8 * 16 * 32;
    float* tv = lg + 16 * 32;
    int* lcnt = (int*)(tv + 64);
    int* ent = lcnt + 64;
    if (F.tid < 32) lcnt[F.tid] = 0;
    int nent = 0;
    const float* rw = A.in[I_RW] + (size_t)l * 1024 * 32;
    u32x2 pm[2][4]; f32x4 pxf[2][4]; u32x2 pxb[2][4];
#define PM_LOAD(tile_) do { const int r0_ = (tile_) * 16 + 2 * F.wave; _Pragma("unroll") for (int rr = 0; rr < 2; ++rr) _Pragma("unroll") for (int j = 0; j < 4; ++j) { \
        pm[rr][j] = __builtin_nontemporal_load((const u32x2*)((const bf16_t*)P_MBUF + (size_t)(r0_ + rr) * DM + 4 * F.lane + 256 * j)); \
        if (l == 0) pxf[rr][j] = __builtin_nontemporal_load((const f32x4*)(A.in[I_X] + (size_t)(r0_ + rr) * DM + 4 * F.lane + 256 * j)); \
        else pxb[rr][j] = __builtin_nontemporal_load((const u32x2*)(P_XB + (size_t)(r0_ + rr) * DM + 4 * F.lane + 256 * j)); } } while (0)
    if (F.bid < NTOK / 16) PM_LOAD(F.bid);
#pragma unroll 1
    for (int tile = F.bid; tile < NTOK / 16; tile += F.G) {
        const int row0 = tile * 16 + 2 * F.wave;
        Row m0, x0, m1, x1;
#pragma unroll
        for (int j = 0; j < 4; ++j) { m0.v[j] = (f32x4){bflo(pm[0][j].x), bfhi(pm[0][j].x), bflo(pm[0][j].y), bfhi(pm[0][j].y)}; m1.v[j] = (f32x4){bflo(pm[1][j].x), bfhi(pm[1][j].x), bflo(pm[1][j].y), bfhi(pm[1][j].y)};
            if (l == 0) { x0.v[j] = pxf[0][j]; x1.v[j] = pxf[1][j]; }
            else { x0.v[j] = (f32x4){bflo(pxb[0][j].x), bfhi(pxb[0][j].x), bflo(pxb[0][j].y), bfhi(pxb[0][j].y)}; x1.v[j] = (f32x4){bflo(pxb[1][j].x), bfhi(pxb[1][j].x), bflo(pxb[1][j].y), bfhi(pxb[1][j].y)}; } }
        if (tile + F.G < NTOK / 16) PM_LOAD(tile + F.G);
#pragma unroll
        for (int rr = 0; rr < 2; ++rr) {
            const int lr = 2 * F.wave + rr, row = row0 + rr, b = row >> 11; const float* mod = P_MOD + (size_t)(l * 8 + b) * 6144;
            const Row& m = rr ? m1 : m0; Row x = rr ? x1 : x0;
            const float r1 = row_rstd(m);
#pragma unroll
            for (int j = 0; j < 4; ++j) { const int k = 4 * F.lane + 256 * j; const f32x4 gp = *(const f32x4*)(A.in[I_NQM] + l * DM + k), g1 = *(const f32x4*)(mod + 2048 + k);
                x.v[j] = x.v[j] + g1 * (m.v[j] * r1 * gp); }
            row_store_bf16_nt(x, P_XB + (size_t)row * DM, F.lane);
            Row h; row_modnorm(h, x, A.in[I_NPF] + l * DM, mod + 3072, mod + 4096, F.lane);
#pragma unroll
            for (int j = 0; j < 4; ++j) *(unsigned*)(P_HB8 + (size_t)row * DM + 4 * F.lane + 256 * j) = pk8(SC_H * h.v[j].x, SC_H * h.v[j].y, SC_H * h.v[j].z, SC_H * h.v[j].w);
#pragma unroll
            for (int j = 0; j < 4; ++j) *(f32x4*)(h2s + lr * 1028 + 4 * F.lane + 256 * j) = h.v[j];
        }
        __syncthreads();
        {
            f32x4 d0 = {0.f, 0.f, 0.f, 0.f}, d1 = {0.f, 0.f, 0.f, 0.f};
            const int r16 = F.lane & 15, kq = F.lane >> 4;
#pragma unroll 8
            for (int ks = 0; ks < 32; ++ks) { const int k = 128 * F.wave + 4 * ks + kq;
                const float a = h2s[r16 * 1028 + k]; const float b0 = rw[k * 32 + r16], b1 = rw[k * 32 + 16 + r16];
                d0 = __builtin_amdgcn_mfma_f32_16x16x4f32(a, b0, d0, 0, 0, 0); d1 = __builtin_amdgcn_mfma_f32_16x16x4f32(a, b1, d1, 0, 0, 0); }
#pragma unroll
            for (int q = 0; q < 4; ++q) { red[(F.wave * 16 + 4 * kq + q) * 32 + r16] = d0[q]; red[(F.wave * 16 + 4 * kq + q) * 32 + 16 + r16] = d1[q]; }
        }
        __syncthreads();
        const int r = F.tid >> 5, e = F.tid & 31;
        { float s = A.in[I_RB][l * 32 + e];
#pragma unroll
          for (int w8 = 0; w8 < 8; ++w8) s += red[(w8 * 16 + r) * 32 + e];
          lg[r * 32 + e] = s; }
        __syncthreads();
        const float v = lg[r * 32 + e]; int rank = 0;
#pragma unroll 8
        for (int q = 0; q < 32; ++q) { const float u = lg[r * 32 + q]; rank += (u > v || (u == v && q < e)) ? 1 : 0; }
        if (rank < 4) tv[r * 4 + rank] = v;
        __syncthreads();
        if (rank < 4) { const f32x4 t4 = *(const f32x4*)(tv + r * 4);
            const float wsum = 1.f + __expf(t4.y - t4.x) + __expf(t4.z - t4.x) + __expf(t4.w - t4.x), wk = __expf(v - t4.x);
            const int token = tile * 16 + r, lpos = atomicAdd(lcnt + e, 1), slot = nent + r * 4 + rank;
            ent[slot * 4] = e; ent[slot * 4 + 1] = lpos; ent[slot * 4 + 2] = token * 4 + rank; ent[slot * 4 + 3] = __float_as_int(wk / wsum); }
        nent += 64;
        __syncthreads();
    }
#undef PM_LOAD
    unsigned* cntp = P_CNT; int* ltk = P_LTK; float* lgp = P_LG;
    if (F.tid < 32) { const int n = lcnt[F.tid]; lcnt[32 + F.tid] = n > 0 ? (int)atomicAdd(cntp + 64 * (l * 32 + F.tid), (unsigned)n) : 0; }
    __syncthreads();
    if (F.tid < nent) { const int e = ent[F.tid * 4], pos = lcnt[32 + e] + ent[F.tid * 4 + 1];
        ltk[(size_t)(l * 32 + e) * LISTCAP + pos] = ent[F.tid * 4 + 2]; lgp[(size_t)(l * 32 + e) * LISTCAP + pos] = __int_as_float(ent[F.tid * 4 + 3]); }
    __syncthreads();
}
__device__ __forceinline__ void p_combine(CArgs& A, const Frame& F, int l) {
    float* wl = (float*)F.lds; if (l == 0) stage_side(A, F, 1, wl);
    const int gw = F.bid * 8 + F.wave, NGW = F.G * 8;
    unsigned y[4][4]; Row xr;
#define COMB_LOAD(row_) do { _Pragma("unroll") for (int k = 0; k < 4; ++k) _Pragma("unroll") for (int j = 0; j < 4; ++j) y[k][j] = __builtin_nontemporal_load((const unsigned*)(P_Y + (size_t)((row_) * 4 + k) * DM + 4 * F.lane + 256 * j)); \
        row_load_bf16(xr, P_XB + (size_t)(row_) * DM, F.lane); } while (0)
    if (gw < NTOK) COMB_LOAD(gw);
#pragma unroll 1
    for (int row = gw; row < NTOK; row += NGW) {
        const int b = row >> 11; const float* mod = P_MOD + (size_t)(l * 8 + b) * 6144;
        Row f;
#pragma unroll
        for (int j = 0; j < 4; ++j) { f.v[j] = (f32x4){0.f, 0.f, 0.f, 0.f};
#pragma unroll
            for (int k = 0; k < 4; ++k) { const f32x2 lo = __builtin_amdgcn_cvt_pk_f32_fp8((int)y[k][j], false), hi = __builtin_amdgcn_cvt_pk_f32_fp8((int)y[k][j], true); f.v[j].x += lo.x; f.v[j].y += lo.y; f.v[j].z += hi.x; f.v[j].w += hi.y; }
            f.v[j] = f.v[j] * (1.f / SC_Y); }
        Row x = xr;
        if (row + NGW < NTOK) COMB_LOAD(row + NGW);
        const float r = row_rstd(f);
#pragma unroll
        for (int j = 0; j < 4; ++j) { const int k = 4 * F.lane + 256 * j; const f32x4 gp = *(const f32x4*)(A.in[I_NQF] + l * DM + k), g2 = *(const f32x4*)(mod + 5120 + k);
            x.v[j] = x.v[j] + g2 * (f.v[j] * r * gp); }
        if (l == 0) row_store_bf16_nt(x, P_XB + (size_t)row * DM, F.lane); else row_store(x, A.out + (size_t)row * DM, F.lane);
        if (l == 0) hprep_row(A, F, x, 1, row, wl);
    }
#undef COMB_LOAD
}
__device__ __forceinline__ int moe_tables(CArgs& A, const Frame& F, int l, LAS pg8::MoeTables* tb) {
    __syncthreads();
    if (F.tid < 32) tb->cnt[F.tid] = (int)__hip_atomic_load(P_CNT + 64 * (l * 32 + F.tid), __ATOMIC_RELAXED, __HIP_MEMORY_SCOPE_AGENT);
    __syncthreads();
    if (F.tid == 0) { int s = 0;
#pragma nounroll
        for (int e = 0; e < 32; ++e) { tb->mtstart[e] = s; s += (tb->cnt[e] + 255) >> 8; }
        tb->mtstart[32] = s; }
    __syncthreads();
    if (F.tid < 320) { int e = 0;
#pragma nounroll
        for (int q = 1; q < 32; ++q) if (tb->mtstart[q] <= F.tid) e = q;
        tb->tile_e[F.tid] = (unsigned char)e; }
    __syncthreads();
    return tb->mtstart[32];
}
__device__ __forceinline__ void fox_kbias(CArgs& A, const Frame& F, int b, int h, float* kb, float* wtot  ) {
    const int t0 = 4 * F.tid; float e[4];
#pragma unroll
    for (int i = 0; i < 4; ++i) e[i] = P_LSIG[(size_t)(b * SEQ + t0 + i) * 8 + h];
    const float s4 = (e[0] + e[1]) + (e[2] + e[3]); float v = s4;
#pragma unroll
    for (int o = 1; o < 64; o <<= 1) { const float tt = __shfl_up(v, o); if (F.lane >= o) v += tt; }
    if (F.lane == 63) wtot[F.wave] = v;
    __syncthreads();
    float off = 0.f;
#pragma unroll
    for (int w = 0; w < 8; ++w) if (w < F.wave) off += wtot[w];
    float c = off + v - s4;
#pragma unroll
    for (int i = 0; i < 4; ++i) { c += e[i]; kb[t0 + i] = -LOG2E * c; }
    __syncthreads();
}
#include <hip/hip_bf16.h>
namespace attn_body {
using bf16=__hip_bfloat16;
using bf16x8=__attribute__((ext_vector_type(8)))short;
using s16x4=__attribute__((ext_vector_type(4)))short;
using f32x16=__attribute__((ext_vector_type(16)))float;
using u32x4=__attribute__((ext_vector_type(4)))unsigned;
constexpr int BATCH=8,NHEAD=8,SEQ=2048,D=64,QP=2048,OP=1024;
constexpr int NW=8,QBLK=32,QB=QBLK*NW,KVBLK=64,NQB=SEQ/QB;
constexpr int ATTN_UNIT_ROWS=QB;
__device__ __forceinline__ int crow(int r,int hi){return (r&3)+8*(r>>2)+4*hi;}
#define SBAR() __builtin_amdgcn_sched_barrier(0)
__device__ __forceinline__ void cmask(f32x16&p0,f32x16&p1,int jb,int qrel,int hi){
  const float NEG=-INFINITY; int kb=64*jb+4*hi;
  #pragma unroll
  for(int r=0;r<16;++r){int kv=kb+(r&3)+8*(r>>2); if(kv>qrel)p0[r]=NEG; if(kv+32>qrel)p1[r]=NEG;}
}

constexpr int NSLOT=3, SLOTB=8192;
constexpr int LDS_K=0, LDS_V=NSLOT*SLOTB, LDS_WS=2*NSLOT*SLOTB, LDS_OST=LDS_WS+NW*64*4, LDS_BYTES=LDS_OST+NW*4096;
constexpr float C2=0.125f*1.4426950408889634f;
__device__ __forceinline__ void glds16(const void*gsrc,unsigned lds_dst){unsigned keep;
  asm volatile("s_mov_b32 %0, m0\n\ts_mov_b32 m0, %2\n\ts_nop 0\n\tglobal_load_lds_dwordx4 %1, off\n\ts_mov_b32 m0, %0":"=&s"(keep):"v"(gsrc),"s"(lds_dst):"memory");}
__device__ __forceinline__ float max3f(float a,float b,float c){float r;asm("v_max3_f32 %0, %1, %2, %3":"=v"(r):"v"(a),"v"(b),"v"(c));return r;}
__device__ __forceinline__ float max2f(float a,float b){float r;asm("v_max_f32_e32 %0, %1, %2":"=v"(r):"v"(a),"v"(b));return r;}
__device__ __forceinline__ float fadd_s(float a,float b){float r;asm("v_add_f32_e32 %0, %1, %2":"=v"(r):"v"(a),"v"(b));return r;}
__device__ __forceinline__ float fsub_s(float a,float b){float r;asm("v_sub_f32_e32 %0, %1, %2":"=v"(r):"v"(a),"v"(b));return r;}
typedef float f32x2_t __attribute__((ext_vector_type(2))); typedef float f32x4_t __attribute__((ext_vector_type(4))); typedef __bf16 bf16x2_t __attribute__((ext_vector_type(2)));
__device__ __forceinline__ unsigned cvtpk_s(float lo,float hi){f32x2_t v={lo,hi};bf16x2_t b=__builtin_convertvector(v,bf16x2_t);return __builtin_bit_cast(unsigned,b);}
#define WAIT_BAR(N) asm volatile("s_waitcnt vmcnt(" #N ") lgkmcnt(0)\n\ts_barrier":::"memory")

__device__ __forceinline__ void qkt(f32x16&p0,f32x16&p1,const char*Kslot,const bf16x8*qr,const f32x16&c0i,const f32x16&c1i,int r32,int hi){
  const char*kb=Kslot+hi*1024+r32*16;
  #pragma unroll
  for(int d0=0;d0<4;++d0){
    const bf16x8 b0=*reinterpret_cast<const bf16x8*>(kb+d0*2048);
    const bf16x8 b1=*reinterpret_cast<const bf16x8*>(kb+d0*2048+512);
    if(d0==0){p0=__builtin_amdgcn_mfma_f32_32x32x16_bf16(b0,qr[0],c0i,0,0,0);p1=__builtin_amdgcn_mfma_f32_32x32x16_bf16(b1,qr[0],c1i,0,0,0);}
    else{p0=__builtin_amdgcn_mfma_f32_32x32x16_bf16(b0,qr[d0],p0,0,0,0);p1=__builtin_amdgcn_mfma_f32_32x32x16_bf16(b1,qr[d0],p1,0,0,0);}}
}
typedef __attribute__((address_space(3))) const char* lds_cptr;
typedef short v4i16_t __attribute__((ext_vector_type(4)));
__device__ __forceinline__ void kload8(bf16x8*kf,lds_cptr kp){
  kf[0]=*(const __attribute__((address_space(3))) bf16x8*)(kp);      kf[1]=*(const __attribute__((address_space(3))) bf16x8*)(kp+512);
  kf[2]=*(const __attribute__((address_space(3))) bf16x8*)(kp+2048); kf[3]=*(const __attribute__((address_space(3))) bf16x8*)(kp+2560);
  kf[4]=*(const __attribute__((address_space(3))) bf16x8*)(kp+4096); kf[5]=*(const __attribute__((address_space(3))) bf16x8*)(kp+4608);
  kf[6]=*(const __attribute__((address_space(3))) bf16x8*)(kp+6144); kf[7]=*(const __attribute__((address_space(3))) bf16x8*)(kp+6656);
}
__device__ __forceinline__ void kload2(bf16x8*kf,lds_cptr kp,int j){ kf[2*j]=*(const __attribute__((address_space(3))) bf16x8*)(kp+j*2048); kf[2*j+1]=*(const __attribute__((address_space(3))) bf16x8*)(kp+j*2048+512); }
__device__ __forceinline__ s16x4 vtr(lds_cptr p){ return __builtin_bit_cast(s16x4,__builtin_amdgcn_ds_read_tr16_b64_v4i16((__attribute__((address_space(3))) v4i16_t*)p)); }
__device__ __forceinline__ float rowmax(const f32x16&p0,const f32x16&p1){
  float a=max3f(p0[0],p0[1],p1[0]),b=max3f(p0[2],p0[3],p1[1]);a=max3f(a,p1[2],p1[3]);
  #pragma unroll
  for(int r=4;r<16;r+=4){a=max3f(a,p0[r],p0[r+1]);b=max3f(b,p0[r+2],p0[r+3]);a=max3f(a,p1[r],p1[r+1]);b=max3f(b,p1[r+2],p1[r+3]);}
  const float m=max2f(a,b);
  auto rr=__builtin_amdgcn_permlane32_swap(__float_as_uint(m),__float_as_uint(m),false,false);
  return max2f(__uint_as_float(rr[0]),__uint_as_float(rr[1]));
}
__device__ __forceinline__ void pv(f32x16*o,int vb,bf16x8 pa0,bf16x8 pa1,bf16x8 pa2,bf16x8 pa3){
  #pragma unroll
  for(int d0=0;d0<2;++d0){s16x4 lo[4],hi[4];
    #pragma unroll
    for(int ks=0;ks<4;++ks){
      asm volatile("ds_read_b64_tr_b16 %0,%1 offset:%c2":"=&v"(lo[ks]):"v"(vb),"i"(d0*4096+ks*1024):"memory");
      asm volatile("ds_read_b64_tr_b16 %0,%1 offset:%c2":"=&v"(hi[ks]):"v"(vb),"i"(d0*4096+ks*1024+512):"memory");}
    asm volatile("s_waitcnt lgkmcnt(0)":::"memory");SBAR();
    #define PK(k) (bf16x8){lo[k][0],lo[k][1],lo[k][2],lo[k][3],hi[k][0],hi[k][1],hi[k][2],hi[k][3]}
    o[d0]=__builtin_amdgcn_mfma_f32_32x32x16_bf16(pa0,PK(0),o[d0],0,0,0);
    o[d0]=__builtin_amdgcn_mfma_f32_32x32x16_bf16(pa1,PK(1),o[d0],0,0,0);
    o[d0]=__builtin_amdgcn_mfma_f32_32x32x16_bf16(pa2,PK(2),o[d0],0,0,0);
    o[d0]=__builtin_amdgcn_mfma_f32_32x32x16_bf16(pa3,PK(3),o[d0],0,0,0);
    #undef PK
  }
}

#ifndef ATTN_STORE16
#define ATTN_STORE16(p,v) (*(u32x4*)(p)=(v))
#endif
typedef const __attribute__((address_space(3))) float* lds_fptr;
template<int THRL> __device__ __forceinline__ void attn_unit(int b,int h,int qb,const bf16*Q,const bf16*__restrict__ K,const bf16*__restrict__ V,bf16*O,char*shm,lds_fptr kb,int tid,int wid){
  const int lane=tid&63,r32=lane&31,hi=lane>>5;
  const long rowbase=(long)b*SEQ; const int q0=qb*QB;
  const bf16*Qw=Q+(rowbase+q0+wid*QBLK)*QP+h*D;
  const bf16*Kh=K+rowbase*QP+h*D,*Vh=V+rowbase*QP+h*D;
  const unsigned lds0=(unsigned)(uintptr_t)shm;
  float*wsf=(float*)(shm+LDS_WS)+wid*64;
  const bf16*ksrc=Kh+(long)lane*QP+wid*8;
  const bf16*vsrc=Vh+(long)(16*(wid&3)+(lane>>2))*QP+(wid>>2)*32+(lane&3)*8;
  const unsigned kdst=lds0+LDS_K+wid*1024, vdst=lds0+LDS_V+wid*1024;
  #define DMA_K(t,slot) glds16(ksrc+(long)(t)*KVBLK*QP,(unsigned)__builtin_amdgcn_readfirstlane(kdst+(slot)))
  #define DMA_V(t,slot) glds16(vsrc+(long)(t)*KVBLK*QP,(unsigned)__builtin_amdgcn_readfirstlane(vdst+(slot)))
  const int vb0=(int)(lds0+LDS_V)+((lane>>4)&1)*32+(lane&3)*8+(4*hi+((lane&15)>>2))*64;
  const char*Kbase=shm+LDS_K; bf16x8 kf[8];
  const lds_cptr shm3=(lds_cptr)shm; const lds_cptr kp0=shm3+LDS_K+hi*1024+r32*16; const lds_cptr vp0=shm3+LDS_V+((lane>>4)&1)*32+(lane&3)*8+(4*hi+((lane&15)>>2))*64;
  const int NT=(q0+QB)/KVBLK;
  DMA_K(0,0);DMA_V(0,0);DMA_K(1,SLOTB);
  bf16x8 qr[4];
  #pragma unroll
  for(int d0=0;d0<4;++d0)qr[d0]=*reinterpret_cast<const bf16x8*>(&Qw[(long)r32*QP+d0*16+hi*8]);
  float mhat=0.f,l_reg=0.f;f32x16 o[2];o[0]=f32x16{};o[1]=f32x16{};float nm=0.f;
  #define BIASFILL(C0,C1,t) do{ const lds_fptr kbt_=kb+64*(t)+4*hi; _Pragma("unroll") for(int g_=0;g_<4;++g_){ const f32x4_t v0_=*(const __attribute__((address_space(3))) f32x4_t*)(kbt_+8*g_), v1_=*(const __attribute__((address_space(3))) f32x4_t*)(kbt_+32+8*g_); \
      _Pragma("unroll") for(int i_=0;i_<4;++i_){ C0[4*g_+i_]=v0_[i_]+nm; C1[4*g_+i_]=v1_[i_]+nm; } } }while(0)
  const int qrel=wid*QBLK+r32;
  #define CMASK(P0,P1,t) do{int jb_=(t)-(NT-4); if(jb_>=0)cmask(P0,P1,jb_,qrel,hi);}while(0)
  bool resc=false;
  #define START(P0,P1) do{ const float rm=rowmax(P0,P1); resc=false; \
    { const float dl=rm; mhat=fadd_s(mhat,dl); \
      _Pragma("unroll") for(int r=0;r<16;++r){P0[r]=fsub_s(P0[r],dl);P1[r]=fsub_s(P1[r],dl);} \
      nm=-mhat; } \
    _Pragma("unroll") for(int r=0;r<16;++r)P0[r]=__builtin_amdgcn_exp2f(P0[r]); }while(0)
  #define RESC() do{ if(resc){ asm volatile("s_waitcnt lgkmcnt(0)":::"memory"); \
      _Pragma("unroll") for(int d_=0;d_<2;++d_) _Pragma("unroll") for(int r=0;r<16;++r)o[d_][r]*=wsf[crow(r,hi)]; } }while(0)
  f32x16 pA0,pA1,pB0,pB1;
  int sl_prev=0,sl_cur=0,sl_next=SLOTB;
  #define ROT() do{sl_prev=sl_cur;sl_cur=sl_next;sl_next=(sl_next==(NSLOT-1)*SLOTB)?0:sl_next+SLOTB;}while(0)
  DMA_K(2,2*SLOTB);
  WAIT_BAR(3);
  { f32x16 c0i,c1i; BIASFILL(c0i,c1i,0); qkt(pA0,pA1,Kbase,qr,c0i,c1i,r32,hi); }asm volatile("s_nop 15\n\ts_nop 7":"+v"(pA0),"+v"(pA1));CMASK(pA0,pA1,0);
  START(pA0,pA1);
  _Pragma("unroll") for(int r=0;r<16;++r)pA1[r]=__builtin_amdgcn_exp2f(pA1[r]);
  WAIT_BAR(0);
  DMA_K(3,0);DMA_V(1,SLOTB);
  ROT();
  kload8(kf,kp0+sl_cur);
  WAIT_BAR(2);
  s16x4 vlo[8],vhi[8]; u32x4 pw0,pw1,pw2,pw3;
  #define PKW(P,B) cvtpk_s(P[B],P[B+1])
  #define PAF(k) __builtin_bit_cast(bf16x8,pw##k)
  #define VFR(i) (bf16x8){vlo[i][0],vlo[i][1],vlo[i][2],vlo[i][3],vhi[i][0],vhi[i][1],vhi[i][2],vhi[i][3]}
  #define PIN(x) asm volatile("":"+v"(x))
  #define MX3(a,b,c) __builtin_fmaxf(__builtin_fmaxf((a),(b)),(c))
  #define GAPA(MF,A0,A1,A2,A3,W0,W1,PW) do{ MF; sacc+=A0; sacc+=A1; sacc+=A2; sacc+=A3; PIN(sacc); W0; W1; PIN(PW); SBAR(); }while(0)
  #define EX(v) __builtin_amdgcn_exp2f(v)
  #define GAPB(MF,X,B) do{ MF; X[B]=EX(X[B]); X[B+1]=EX(X[B+1]); X[B+2]=EX(X[B+2]); X[B+3]=EX(X[B+3]); PIN(X); SBAR(); }while(0)
  #define VRD(i) do{ vlo[i]=vtr(vp_+(((i)>>2)*4096+((i)&3)*1024)); vhi[i]=vtr(vp_+(((i)>>2)*4096+((i)&3)*1024+512)); }while(0)
  #define KRD(G,j) do{ if(G){ kload2(kf,kp0+sl_next,j); SBAR(); } }while(0)
  #define STEP(C0,C1,P0,P1,t,GK,GV,GL) do{ SBAR(); BIASFILL(C0,C1,t); SBAR(); \
    const lds_cptr vp_=vp0+sl_prev; \
    VRD(0); SBAR(); float sacc=(P0[0]+P0[1]); \
    GAPA(C0=__builtin_amdgcn_mfma_f32_32x32x16_bf16(kf[0],qr[0],C0,0,0,0), P0[2],P0[3],P0[4],P0[5],     pw0[0]=PKW(P0,0), pw0[1]=PKW(P0,2), pw0); \
    VRD(4); SBAR(); GAPA(C1=__builtin_amdgcn_mfma_f32_32x32x16_bf16(kf[1],qr[0],C1,0,0,0), P0[6],P0[7],P0[8],P0[9],     pw0[2]=PKW(P0,4), pw0[3]=PKW(P0,6), pw0); \
    VRD(1); SBAR(); GAPA(C0=__builtin_amdgcn_mfma_f32_32x32x16_bf16(kf[2],qr[1],C0,0,0,0),   P0[10],P0[11],P0[12],P0[13], pw1[0]=PKW(P0,8), pw1[1]=PKW(P0,10), pw1); \
    VRD(5); SBAR(); GAPA(C1=__builtin_amdgcn_mfma_f32_32x32x16_bf16(kf[3],qr[1],C1,0,0,0),   P0[14],P0[15],P1[0],P1[1],   pw1[2]=PKW(P0,12),pw1[3]=PKW(P0,14), pw1); \
    VRD(2); SBAR(); GAPA(C0=__builtin_amdgcn_mfma_f32_32x32x16_bf16(kf[4],qr[2],C0,0,0,0),   P1[2],P1[3],P1[4],P1[5],     pw2[0]=PKW(P1,0), pw2[1]=PKW(P1,2), pw2); \
    VRD(6); SBAR(); GAPA(C1=__builtin_amdgcn_mfma_f32_32x32x16_bf16(kf[5],qr[2],C1,0,0,0),   P1[6],P1[7],P1[8],P1[9],     pw2[2]=PKW(P1,4), pw2[3]=PKW(P1,6), pw2); \
    VRD(3); SBAR(); GAPA(C0=__builtin_amdgcn_mfma_f32_32x32x16_bf16(kf[6],qr[3],C0,0,0,0),   P1[10],P1[11],P1[12],P1[13], pw3[0]=PKW(P1,8), pw3[1]=PKW(P1,10), pw3); \
    VRD(7); SBAR(); GAPA(C1=__builtin_amdgcn_mfma_f32_32x32x16_bf16(kf[7],qr[3],C1,0,0,0),   P1[14],P1[15],0.f,0.f,       pw3[2]=PKW(P1,12),pw3[3]=PKW(P1,14), pw3); \
    l_reg+=sacc; \
    if(GK){DMA_K((t)+3,sl_cur);} if(GV){DMA_V((t)+1,sl_next);} \
    CMASK(C0,C1,t); \
    { float a=MX3(C0[0],C0[1],C1[0]),b=MX3(C0[2],C0[3],C1[1]); a=MX3(a,C1[2],C1[3]); \
      _Pragma("unroll") for(int r=4;r<16;r+=4){a=MX3(a,C0[r],C0[r+1]);b=MX3(b,C0[r+2],C0[r+3]);a=MX3(a,C1[r],C1[r+1]);b=MX3(b,C1[r+2],C1[r+3]);} \
      float rm=__builtin_fmaxf(a,b); { auto rr=__builtin_amdgcn_permlane32_swap(__float_as_uint(rm),__float_as_uint(rm),false,false); rm=__builtin_fmaxf(__uint_as_float(rr[0]),__uint_as_float(rr[1])); } \
      resc=false; \
      if(__builtin_expect(__any(rm>(float)THRL),0)){ const float dl=__builtin_fmaxf(rm,0.f); mhat+=dl; \
        _Pragma("unroll") for(int r=0;r<16;++r){C0[r]-=dl;C1[r]-=dl;} \
        nm=-mhat; \
        const float f=__builtin_amdgcn_exp2f(-dl); l_reg*=f; if(hi==0)wsf[r32]=f; resc=true; } } \
    SBAR(); \
    GAPB(o[0]=__builtin_amdgcn_mfma_f32_32x32x16_bf16(PAF(0),VFR(0),o[0],0,0,0), C0,0); \
    GAPB(o[1]=__builtin_amdgcn_mfma_f32_32x32x16_bf16(PAF(0),VFR(4),o[1],0,0,0), C0,4); \
    KRD(GL,0); GAPB(o[0]=__builtin_amdgcn_mfma_f32_32x32x16_bf16(PAF(1),VFR(1),o[0],0,0,0), C0,8); \
    KRD(GL,1); GAPB(o[1]=__builtin_amdgcn_mfma_f32_32x32x16_bf16(PAF(1),VFR(5),o[1],0,0,0), C0,12); \
    KRD(GL,2); GAPB(o[0]=__builtin_amdgcn_mfma_f32_32x32x16_bf16(PAF(2),VFR(2),o[0],0,0,0), C1,0); \
    KRD(GL,3); GAPB(o[1]=__builtin_amdgcn_mfma_f32_32x32x16_bf16(PAF(2),VFR(6),o[1],0,0,0), C1,4); \
    GAPB(o[0]=__builtin_amdgcn_mfma_f32_32x32x16_bf16(PAF(3),VFR(3),o[0],0,0,0), C1,8); \
    GAPB(o[1]=__builtin_amdgcn_mfma_f32_32x32x16_bf16(PAF(3),VFR(7),o[1],0,0,0), C1,12); \
    }while(0)
  int t=1;
  #undef CMASK
  #define CMASK(P0,P1,t) do{}while(0)
  for(;t+5<NT;t+=2){
    STEP(pB0,pB1,pA0,pA1,t,true,true,true);     WAIT_BAR(2); RESC(); ROT();
    STEP(pA0,pA1,pB0,pB1,t+1,true,true,true);   WAIT_BAR(2); RESC(); ROT();
  }
  #undef CMASK
  #define CMASK(P0,P1,t) do{int jb_=(t)-(NT-4); if(jb_>=0)cmask(P0,P1,jb_,qrel,hi);}while(0)
  #define ENDW(tt) do{ if((tt)+3<NT){WAIT_BAR(2);} else if((tt)+2<NT){WAIT_BAR(1);} else {WAIT_BAR(0);} }while(0)
  for(;t+1<NT;t+=2){
    STEP(pB0,pB1,pA0,pA1,t,(t+3<NT),(t+1<NT),(t+1<NT));       ENDW(t);   RESC(); ROT();
    STEP(pA0,pA1,pB0,pB1,t+1,(t+4<NT),(t+2<NT),(t+2<NT));     ENDW(t+1); RESC(); ROT();
  }
  STEP(pB0,pB1,pA0,pA1,NT-1,false,false,false); RESC();
  { float sacc=pB0[0]+pB0[1]; _Pragma("unroll") for(int r=2;r<16;++r)sacc+=pB0[r]; _Pragma("unroll") for(int r=0;r<16;++r)sacc+=pB1[r]; l_reg+=sacc;
    pw0=(u32x4){PKW(pB0,0),PKW(pB0,2),PKW(pB0,4),PKW(pB0,6)};pw1=(u32x4){PKW(pB0,8),PKW(pB0,10),PKW(pB0,12),PKW(pB0,14)};pw2=(u32x4){PKW(pB1,0),PKW(pB1,2),PKW(pB1,4),PKW(pB1,6)};pw3=(u32x4){PKW(pB1,8),PKW(pB1,10),PKW(pB1,12),PKW(pB1,14)};
    SBAR(); pv(o,vb0+sl_cur,PAF(0),PAF(1),PAF(2),PAF(3)); }
  #undef PKW
  #undef PAF
  #undef VFR
  #undef PIN
  #undef MX3
  #undef GAPA
  #undef GAPB
  #undef EX
  #undef VRD
  #undef KRD
  #undef STEP
  #undef ENDW
  {auto rr=__builtin_amdgcn_permlane32_swap(__float_as_uint(l_reg),__float_as_uint(l_reg),false,false);l_reg=__uint_as_float(rr[0])+__uint_as_float(rr[1]);}
  if(hi==0)wsf[32+r32]=l_reg;asm volatile("s_waitcnt lgkmcnt(0)":::"memory");
  float rli[16];
  #pragma unroll
  for(int r=0;r<16;++r)rli[r]=__builtin_amdgcn_rcpf(wsf[32+crow(r,hi)]);
  bf16*Ow=O+(rowbase+q0+wid*QBLK)*OP+h*D;
  { bf16*stg=(bf16*)(shm+LDS_OST)+wid*2048;
    #pragma unroll
    for(int r=0;r<16;++r){const int orow=crow(r,hi);
      #pragma unroll
      for(int d0=0;d0<2;++d0)stg[orow*64+d0*32+r32]=__float2bfloat16(o[d0][r]*rli[r]);}
    asm volatile("s_waitcnt lgkmcnt(0)":::"memory");
    #pragma unroll
    for(int i=0;i<4;++i){const int row=i*8+(lane>>3),ch=lane&7; const u32x4 v=*(const u32x4*)(stg+row*64+ch*8); ATTN_STORE16(Ow+(long)row*OP+ch*8,v);} }
  asm volatile("s_waitcnt lgkmcnt(0)\n\ts_barrier":::"memory");
  #undef DMA_K
  #undef DMA_V
  #undef CMASK
  #undef START
  #undef RESC
  #undef ROT
  #undef BIASFILL
}
constexpr int ATTN_LDS_BYTES=LDS_BYTES;
#undef SBAR
#undef WAIT_BAR
}
__device__ __forceinline__ void fox_fast(CArgs& A, const Frame& F) {
    float* kb = (float*)(F.lds + 86016); float* wtot = kb + 2048;
    const int v = (F.bid & 7) * 32 + (F.bid >> 3), bh = v >> 2, s = v & 3, b = bh >> 3, h = bh & 7;
    fox_kbias(A, F, b, h, kb, wtot);
    const attn_body::bf16* Zb = (const attn_body::bf16*)P_Z;
    const attn_body::lds_fptr kb3 = (attn_body::lds_fptr)(const __attribute__((address_space(3))) unsigned char*)((LAS unsigned char*)F.lds + 86016);
    attn_body::attn_unit<8>(b, h, 7 - s, Zb + 512, Zb + 1024, Zb + 1536, (attn_body::bf16*)P_YCAT + 512, (char*)F.lds, kb3, F.tid, F.wave);
    attn_body::attn_unit<8>(b, h, s, Zb + 512, Zb + 1024, Zb + 1536, (attn_body::bf16*)P_YCAT + 512, (char*)F.lds, kb3, F.tid, F.wave);
}
typedef float f32x16 __attribute__((ext_vector_type(16)));
__device__ __forceinline__ bf16x8 pack8(const f32x4& a, const f32x4& b) { u32x4 w; w.x = pk2(a.x, a.y); w.y = pk2(a.z, a.w); w.z = pk2(b.x, b.y); w.w = pk2(b.z, b.w); return __builtin_bit_cast(bf16x8, w); }
__device__ __forceinline__ void s5_fast(CArgs& A, const Frame& F, int item) {
    const int b = item >> 5, g = item & 31, lane = F.lane, w = F.wave, p = lane & 31, hh = lane >> 5, l15 = lane & 15, l4 = lane >> 4;
    float* Eseg = (float*)F.lds; float* Hin = Eseg + 2048;
    bf16_t* Hs = (bf16_t*)(F.lds + 16384) + w * 4352;
    bf16x8 bbr[2], bbi[2]; float are[2], aim[2];
#pragma unroll
    for (int nt = 0; nt < 2; ++nt) { const float* q = P_S5BB + (size_t)(g * 64 + 32 * nt + p) * 32 + 8 * hh;
        bbr[nt] = pack8(*(const f32x4*)q, *(const f32x4*)(q + 4)); bbi[nt] = pack8(*(const f32x4*)(q + 16), *(const f32x4*)(q + 20));
        are[nt] = P_S5A[(g * 64 + 32 * nt + p) * 2]; aim[nt] = P_S5A[(g * 64 + 32 * nt + p) * 2 + 1]; }
    const int rr = lane & 31, ahalf = (rr >> 2) & 1, atau = (rr & 3) + 4 * (rr >> 3);
    const bf16_t* usrc = P_Z + (size_t)(b * SEQ + 128 * (2 * w + ahalf) + atau) * ZP0 + g * 16 + 8 * hh;
    const f32x16 zero16 = {0.f, 0.f, 0.f, 0.f, 0.f, 0.f, 0.f, 0.f, 0.f, 0.f, 0.f, 0.f, 0.f, 0.f, 0.f, 0.f};
    float hr[2] = {0.f, 0.f}, hi[2] = {0.f, 0.f};
#define S5_ALOAD(blk_) (*(const bf16x8*)(usrc + (size_t)(blk_) * 16 * ZP0))
    { bf16x8 a0 = S5_ALOAD(0), a1 = S5_ALOAD(1), a2 = S5_ALOAD(2);
#pragma unroll 1
      for (int blk = 0; blk < 8; ++blk) {
        const bf16x8 a = a0; a0 = a1; a1 = a2; if (blk + 3 < 8) a2 = S5_ALOAD(blk + 3);
#pragma unroll
        for (int nt = 0; nt < 2; ++nt) {
            const f32x16 dre = __builtin_amdgcn_mfma_f32_32x32x16_bf16(a, bbr[nt], zero16, 0, 0, 0), dim = __builtin_amdgcn_mfma_f32_32x32x16_bf16(a, bbi[nt], zero16, 0, 0, 0);
#pragma unroll
            for (int i = 0; i < 16; ++i) { const float nr = are[nt] * hr[nt] - aim[nt] * hi[nt] + dre[i], ni = are[nt] * hi[nt] + aim[nt] * hr[nt] + dim[i]; hr[nt] = nr; hi[nt] = ni; }
        }
      } }
#pragma unroll
    for (int nt = 0; nt < 2; ++nt) { Eseg[((2 * w + hh) * 64 + 32 * nt + p) * 2] = hr[nt]; Eseg[((2 * w + hh) * 64 + 32 * nt + p) * 2 + 1] = hi[nt]; }
    __syncthreads();
    if (w == 0) {
        float xr = P_S5A[(g * 64 + lane) * 2], xi = P_S5A[(g * 64 + lane) * 2 + 1];
#pragma unroll
        for (int q = 0; q < 7; ++q) { const float nr = xr * xr - xi * xi, ni = 2.f * xr * xi; xr = nr; xi = ni; }
        float Hr = 0.f, Hi = 0.f;
#pragma unroll 1
        for (int s = 0; s < 16; ++s) { Hin[(s * 64 + lane) * 2] = Hr; Hin[(s * 64 + lane) * 2 + 1] = Hi;
            const float er = Eseg[(s * 64 + lane) * 2], ei = Eseg[(s * 64 + lane) * 2 + 1]; const float nr = xr * Hr - xi * Hi + er, ni = xr * Hi + xi * Hr + ei; Hr = nr; Hi = ni; }
    }
    __syncthreads();
#pragma unroll
    for (int nt = 0; nt < 2; ++nt) { hr[nt] = Hin[((2 * w + hh) * 64 + 32 * nt + p) * 2]; hi[nt] = Hin[((2 * w + hh) * 64 + 32 * nt + p) * 2 + 1]; }
    bf16x8 ck[4];
#pragma unroll
    for (int ks = 0; ks < 4; ++ks) ck[ks] = *(const bf16x8*)(P_S5CK + (size_t)(g * 16 + l15) * 128 + 32 * ks + 8 * l4);
    const int er = lane >> 1, eh = lane & 1;
    float* Ys = (float*)(F.lds + 86016) + w * 640;
    f32x4 dk0 = *(const f32x4*)(A.in[I_S5D] + g * 16 + 8 * eh), dk1 = *(const f32x4*)(A.in[I_S5D] + g * 16 + 8 * eh + 4);
#define S5_EROW(blk_) ((size_t)(b * SEQ + 128 * (2 * w + (er >> 4)) + 16 * (blk_) + (er & 15)))
    bf16x8 a0 = S5_ALOAD(0), a1 = S5_ALOAD(1), a2 = S5_ALOAD(2);
    u32x4 un = *(const u32x4*)(P_Z + S5_EROW(0) * ZP0 + g * 16 + 8 * eh);
#pragma unroll 1
    for (int blk = 0; blk < 8; ++blk) {
        const bf16x8 a = a0; a0 = a1; a1 = a2; if (blk + 3 < 8) a2 = S5_ALOAD(blk + 3);
        const u32x4 us = un; if (blk + 1 < 8) un = *(const u32x4*)(P_Z + S5_EROW(blk + 1) * ZP0 + g * 16 + 8 * eh);
#pragma unroll
        for (int nt = 0; nt < 2; ++nt) {
            const f32x16 dre = __builtin_amdgcn_mfma_f32_32x32x16_bf16(a, bbr[nt], zero16, 0, 0, 0), dim = __builtin_amdgcn_mfma_f32_32x32x16_bf16(a, bbi[nt], zero16, 0, 0, 0);
#pragma unroll
            for (int i = 0; i < 16; ++i) { const float nr = are[nt] * hr[nt] - aim[nt] * hi[nt] + dre[i], ni = are[nt] * hi[nt] + aim[nt] * hr[nt] + dim[i]; hr[nt] = nr; hi[nt] = ni;
                *(unsigned*)(Hs + (hh * 16 + i) * 136 + 2 * (32 * nt + p)) = pk2(nr, ni); }
        }
        LDS_WAIT();
#pragma unroll
        for (int sg = 0; sg < 2; ++sg) {
            f32x4 y = {0.f, 0.f, 0.f, 0.f};
#pragma unroll
            for (int ks = 0; ks < 4; ++ks) { const bf16x8 af = *(const bf16x8*)(Hs + (sg * 16 + l15) * 136 + 32 * ks + 8 * l4); y = __builtin_amdgcn_mfma_f32_16x16x32_bf16(af, ck[ks], y, 0, 0, 0); }
#pragma unroll
            for (int q = 0; q < 4; ++q) Ys[(sg * 16 + 4 * l4 + q) * 20 + l15] = y[q];
        }
        LDS_WAIT();
        { const f32x4 y0 = *(const f32x4*)(Ys + er * 20 + 8 * eh), y1 = *(const f32x4*)(Ys + er * 20 + 8 * eh + 4);
          float o[8]; o[0] = y0.x + dk0.x * bflo(us.x); o[1] = y0.y + dk0.y * bfhi(us.x); o[2] = y0.z + dk0.z * bflo(us.y); o[3] = y0.w + dk0.w * bfhi(us.y);
          o[4] = y1.x + dk1.x * bflo(us.z); o[5] = y1.y + dk1.y * bfhi(us.z); o[6] = y1.z + dk1.z * bflo(us.w); o[7] = y1.w + dk1.w * bfhi(us.w);
          u32x4 ov; ov.x = pk2(gelu_tanh(o[0]), gelu_tanh(o[1])); ov.y = pk2(gelu_tanh(o[2]), gelu_tanh(o[3])); ov.z = pk2(gelu_tanh(o[4]), gelu_tanh(o[5])); ov.w = pk2(gelu_tanh(o[6]), gelu_tanh(o[7]));
          *(u32x4*)(P_G5 + S5_EROW(blk) * 512 + g * 16 + 8 * eh) = ov; }
        LDS_WAIT();
    }
#undef S5_ALOAD
#undef S5_EROW
}
namespace lin {
typedef const LAS char* lptr;
typedef short s16x4 __attribute__((ext_vector_type(4)));
typedef short v4i16_t __attribute__((ext_vector_type(4)));
__device__ __forceinline__ s16x4 vtr(lptr p) { return __builtin_bit_cast(s16x4, __builtin_amdgcn_ds_read_tr16_b64_v4i16((LAS v4i16_t*)p)); }
__device__ __forceinline__ bf16x8 tr_frag(lptr sub, int ks, int lane) {
    const lptr p = sub + ((lane >> 4) & 1) * 32 + (lane & 3) * 8 + (4 * (lane >> 5) + ((lane & 15) >> 2)) * 64 + ks * 1024;
    const s16x4 lo = vtr(p), hi = vtr(p + 512);
    return (bf16x8){lo[0], lo[1], lo[2], lo[3], hi[0], hi[1], hi[2], hi[3]};
}
__device__ __forceinline__ bf16x8 nat_frag(lptr base, int ldb, int row0, int k0, int lane) { return *(const LAS bf16x8*)(base + (row0 + (lane & 31)) * ldb + (k0 + 8 * (lane >> 5)) * 2); }
__device__ __forceinline__ int crow(int r, int hh) { return (r & 3) + 8 * (r >> 2) + 4 * hh; }
__device__ __forceinline__ void unpack8(const u32x4& w, float (&f)[8]) { f[0] = bflo(w.x); f[1] = bfhi(w.x); f[2] = bflo(w.y); f[3] = bfhi(w.y); f[4] = bflo(w.z); f[5] = bfhi(w.z); f[6] = bflo(w.w); f[7] = bfhi(w.w); }
__device__ __forceinline__ u32x4 repack8(const float (&f)[8]) { u32x4 w; w.x = pk2(f[0], f[1]); w.y = pk2(f[2], f[3]); w.z = pk2(f[4], f[5]); w.w = pk2(f[6], f[7]); return w; }

__device__ __forceinline__ void gla_prefix(CArgs& A, const Frame& F, int item) {
    const int b = item >> 5, c = item & 31, half = F.tid >> 8, col = F.tid & 255;
    float* p = P_LOGA + (size_t)(b * SEQ + c * 64 + 32 * half) * 256 + col; float* tot = (float*)F.lds;
    float v[32];
#pragma unroll
    for (int i = 0; i < 32; ++i) v[i] = p[(size_t)i * 256];
#pragma unroll
    for (int i = 1; i < 32; ++i) v[i] += v[i - 1];
    if (half == 0) tot[col] = v[31];
    __syncthreads();
    const float off = half ? tot[col] : 0.f;
#pragma unroll
    for (int i = 0; i < 32; ++i) p[(size_t)i * 256] = v[i] + off;
    __syncthreads();
}
template <int KIND> __device__ __forceinline__ void r1_item(CArgs& A, const Frame& F, int bh, int vs) {
    constexpr int DK = KIND ? 64 : 128, ND = DK / 32;
    constexpr int KCOL = KIND ? 2304 : 512, VCOL = KIND ? 2560 : 1024;
    const int b = bh >> 2, h = bh & 3, tid = F.tid, lane = F.lane, w = F.wave, hh = lane >> 5;
    unsigned char* bufV = F.lds; unsigned char* bufK = F.lds + 4096;
    bf16_t* ST = (KIND ? P_GST : P_RST) + (size_t)bh * 32 * 128 * DK;
    const float log2g = KIND ? 0.f : log2f(1.f - exp2f(-5.f - (float)h));
    const float g64 = exp2f(64.f * log2g);
    f32x16 acc = {0.f, 0.f, 0.f, 0.f, 0.f, 0.f, 0.f, 0.f, 0.f, 0.f, 0.f, 0.f, 0.f, 0.f, 0.f, 0.f};
    const bf16_t* zb = P_Z + (size_t)(b * SEQ) * ZP1;
    const int vj = tid >> 2, vc = tid & 3;
    const int kj0 = KIND ? (tid >> 3) : (tid >> 4), kd0 = KIND ? (tid & 7) : (tid & 15);
#define R1_DECL(S) u32x4 rv##S = {0u, 0u, 0u, 0u}, rk0##S = {0u, 0u, 0u, 0u}, rk1##S = {0u, 0u, 0u, 0u}; f32x4 bj0##S = {0.f, 0.f, 0.f, 0.f}, bj1##S = bj0##S, bl0##S = bj0##S, bl1##S = bj0##S; float bd##S = 0.f;
#define R1_LOAD(S, c) do { const bf16_t* zc = zb + (size_t)((c) * 64) * ZP1; \
        if (tid < 256) rv##S = *(const u32x4*)(zc + (size_t)vj * ZP1 + VCOL + h * 128 + vs * 32 + vc * 8); \
        rk0##S = *(const u32x4*)(zc + (size_t)kj0 * ZP1 + KCOL + h * DK + kd0 * 8); \
        if (!KIND) rk1##S = *(const u32x4*)(zc + (size_t)(kj0 + 32) * ZP1 + KCOL + h * DK + kd0 * 8); \
        if (KIND) { const float* bp = P_LOGA + (size_t)(b * SEQ + (c) * 64) * 256 + h * 64; \
            bj0##S = *(const f32x4*)(bp + (size_t)kj0 * 256 + kd0 * 8); bj1##S = *(const f32x4*)(bp + (size_t)kj0 * 256 + kd0 * 8 + 4); \
            bl0##S = *(const f32x4*)(bp + 63 * 256 + kd0 * 8); bl1##S = *(const f32x4*)(bp + 63 * 256 + kd0 * 8 + 4); \
            if (w < ND) bd##S = bp[63 * 256 + 32 * w + (lane & 31)]; } } while (0)
#define R1_STEP(S, c) do { \
        if (tid < 256) { u32x4 o = rv##S; \
            if (!KIND) { float f[8]; unpack8(rv##S, f); const float z = exp2f((float)(63 - vj) * log2g); _Pragma("unroll") for (int e = 0; e < 8; ++e) f[e] *= z; o = repack8(f); } \
            *(u32x4*)(bufV + vj * 64 + vc * 16) = o; } \
        if (KIND) { float f[8]; unpack8(rk0##S, f); \
            f[0] *= __expf(bl0##S.x - bj0##S.x); f[1] *= __expf(bl0##S.y - bj0##S.y); f[2] *= __expf(bl0##S.z - bj0##S.z); f[3] *= __expf(bl0##S.w - bj0##S.w); \
            f[4] *= __expf(bl1##S.x - bj1##S.x); f[5] *= __expf(bl1##S.y - bj1##S.y); f[6] *= __expf(bl1##S.z - bj1##S.z); f[7] *= __expf(bl1##S.w - bj1##S.w); \
            *(u32x4*)(bufK + (kd0 >> 2) * 4096 + kj0 * 64 + (kd0 & 3) * 16) = repack8(f); \
        } else { \
            *(u32x4*)(bufK + (kd0 >> 2) * 4096 + kj0 * 64 + (kd0 & 3) * 16) = rk0##S; \
            *(u32x4*)(bufK + (kd0 >> 2) * 4096 + (kj0 + 32) * 64 + (kd0 & 3) * 16) = rk1##S; } \
        __syncthreads(); \
        const float decn = KIND ? __expf(bd##S) : 0.f; \
        if ((c) + 4 < 32) R1_LOAD(S, (c) + 4); \
        if (w < ND) { \
            bf16_t* sp = ST + ((size_t)(c) * 128 + vs * 32) * DK + 32 * w + (lane & 31); \
            const float dec = KIND ? decn : g64; \
            _Pragma("unroll") for (int r = 0; r < 16; ++r) { sp[(size_t)crow(r, hh) * DK] = (bf16_t)f2bf(acc[r]); acc[r] *= dec; } \
            _Pragma("unroll") for (int ks = 0; ks < 4; ++ks) acc = __builtin_amdgcn_mfma_f32_32x32x16_bf16(tr_frag((lptr)(LAS unsigned char*)bufV, ks, lane), tr_frag((lptr)(LAS unsigned char*)bufK + w * 4096, ks, lane), acc, 0, 0, 0); \
        } \
        __syncthreads(); } while (0)
    R1_DECL(0) R1_DECL(1) R1_DECL(2) R1_DECL(3)
    R1_LOAD(0, 0); R1_LOAD(1, 1); R1_LOAD(2, 2); R1_LOAD(3, 3);
#pragma unroll 1
    for (int c = 0; c < 32; c += 4) { R1_STEP(0, c); R1_STEP(1, c + 1); R1_STEP(2, c + 2); R1_STEP(3, c + 3); }
#undef R1_DECL
#undef R1_LOAD
#undef R1_STEP
}
__device__ __forceinline__ void p_lin_r1(CArgs& A, const Frame& F) {
    const int v = F.bid, r = v & 127;
    if (v < 128) r1_item<0>(A, F, r >> 2, r & 3); else r1_item<1>(A, F, r >> 2, r & 3);
}

template <int KIND> struct R2Regs {
    static constexpr int DK = KIND ? 64 : 128, NQP = 64 * DK / 8 / 512, NSP = 128 * DK / 8 / 512;
    u32x4 q[NQP], k[NQP], v[2], s[NSP], g[2]; f32x4 bq[NQP][2];
};
template <int KIND> __device__ __forceinline__ void r2_load(CArgs& A, const Frame& F, R2Regs<KIND>& R, int bh, int c) {
    constexpr int DK = KIND ? 64 : 128;
    constexpr int QCOL = KIND ? 2048 : 0, KCOL = KIND ? 2304 : 512, VCOL = KIND ? 2560 : 1024, GCOL = KIND ? 3072 : 1536;
    const int b = bh >> 2, h = bh & 3, tid = F.tid, lane = F.lane, w = F.wave, hh = lane >> 5, l31 = lane & 31, rb = w >> 2, cb = w & 3;
    const bf16_t* zc = P_Z + (size_t)(b * SEQ + c * 64) * ZP1;
    const bf16_t* ST = (KIND ? P_GST : P_RST) + ((size_t)bh * 32 + c) * 128 * DK;
#pragma unroll
    for (int r = 0; r < R2Regs<KIND>::NQP; ++r) { const int q = tid + 512 * r, i = q / (DK / 8), d8 = q % (DK / 8);
        R.q[r] = *(const u32x4*)(zc + (size_t)i * ZP1 + QCOL + h * DK + d8 * 8); R.k[r] = *(const u32x4*)(zc + (size_t)i * ZP1 + KCOL + h * DK + d8 * 8);
        if (KIND) { const float* bp = P_LOGA + (size_t)(b * SEQ + c * 64 + i) * 256 + h * 64 + d8 * 8; R.bq[r][0] = *(const f32x4*)bp; R.bq[r][1] = *(const f32x4*)(bp + 4); } }
#pragma unroll
    for (int r = 0; r < 2; ++r) { const int q = tid + 512 * r, j = q >> 4, v8 = q & 15; R.v[r] = *(const u32x4*)(zc + (size_t)j * ZP1 + VCOL + h * 128 + v8 * 8); }
#pragma unroll
    for (int r = 0; r < R2Regs<KIND>::NSP; ++r) { const int q = tid + 512 * r, vr = q / (DK / 8), d8 = q % (DK / 8); R.s[r] = *(const u32x4*)(ST + (size_t)vr * DK + d8 * 8); }
#pragma unroll
    for (int k2 = 0; k2 < 2; ++k2) { const int pp = lane + 64 * k2; R.g[k2] = *(const u32x4*)(zc + (size_t)(32 * rb + (pp >> 2)) * ZP1 + GCOL + h * 128 + 32 * cb + 8 * (pp & 3)); }
}
template <int KIND> struct R2Lds { static constexpr int DK = KIND ? 64 : 128, LDQ = (DK + 8) * 2, OFF_K = 64 * LDQ, OFF_V = 2 * 64 * LDQ, OFF_S = OFF_V + 16384, OFF_SSQ = OFF_S + 128 * LDQ, OFF_BC = OFF_SSQ + 1024; };
template <int KIND> __device__ __forceinline__ void r2_stage(const Frame& F, const R2Regs<KIND>& R, u32x4 (&gc)[2]) {
    typedef R2Lds<KIND> LL; constexpr int DK = LL::DK, LDQ = LL::LDQ;
    const int tid = F.tid; unsigned char* L = F.lds;
#pragma unroll
    for (int r = 0; r < R2Regs<KIND>::NQP; ++r) { const int q = tid + 512 * r, i = q / (DK / 8), d8 = q % (DK / 8);
        u32x4 qw = R.q[r], kw = R.k[r];
        if (KIND) { float fq[8], fk[8]; unpack8(qw, fq); unpack8(kw, fk);
#pragma unroll
            for (int e = 0; e < 8; ++e) { const float bb = R.bq[r][e >> 2][e & 3]; fq[e] *= __expf(bb); fk[e] *= __expf(-bb); }
            qw = repack8(fq); kw = repack8(fk); }
        *(u32x4*)(L + i * LDQ + d8 * 16) = qw; *(u32x4*)(L + LL::OFF_K + i * LDQ + d8 * 16) = kw; }
#pragma unroll
    for (int r = 0; r < 2; ++r) { const int q = tid + 512 * r, j = q >> 4, v8 = q & 15; *(u32x4*)(L + LL::OFF_V + (v8 >> 2) * 4096 + j * 64 + (v8 & 3) * 16) = R.v[r]; }
#pragma unroll
    for (int r = 0; r < R2Regs<KIND>::NSP; ++r) { const int q = tid + 512 * r, vr = q / (DK / 8), d8 = q % (DK / 8); *(u32x4*)(L + LL::OFF_S + vr * LDQ + d8 * 16) = R.s[r]; }
    gc[0] = R.g[0]; gc[1] = R.g[1];
    __syncthreads();
}
template <int KIND> __device__ __forceinline__ void r2_compute(CArgs& A, const Frame& F, int bh, int c, const u32x4 (&gc)[2]) {
    typedef R2Lds<KIND> LL; constexpr int DK = LL::DK, LDQ = LL::LDQ, OFF_K = LL::OFF_K, OFF_V = LL::OFF_V, OFF_S = LL::OFF_S;
    constexpr int OCOL = KIND ? 512 : 0;
    const int b = bh >> 2, h = bh & 3, lane = F.lane, w = F.wave, hh = lane >> 5, l31 = lane & 31, rb = w >> 2, cb = w & 3;
    unsigned char* L = F.lds; float* ssq = (float*)(L + LL::OFF_SSQ);
    const float log2g = KIND ? 0.f : log2f(1.f - exp2f(-5.f - (float)h));
    const lptr L3 = (lptr)(LAS unsigned char*)L;
    bf16x8 pa[2][2];
#pragma unroll
    for (int jt = 0; jt < 2; ++jt) {
        f32x16 p = {0.f, 0.f, 0.f, 0.f, 0.f, 0.f, 0.f, 0.f, 0.f, 0.f, 0.f, 0.f, 0.f, 0.f, 0.f, 0.f};
        if (jt <= rb) {
#pragma unroll
            for (int ks = 0; ks < DK / 16; ++ks) p = __builtin_amdgcn_mfma_f32_32x32x16_bf16(nat_frag(L3 + OFF_K, LDQ, 32 * jt, 16 * ks, lane), nat_frag(L3, LDQ, 32 * rb, 16 * ks, lane), p, 0, 0, 0);
        }
        const int i = 32 * rb + l31;
        float f[16];
#pragma unroll
        for (int r = 0; r < 16; ++r) { const int j = 32 * jt + crow(r, hh); float x = (i >= j) ? p[r] : 0.f; if (!KIND) x *= exp2f((float)(i - j) * log2g); f[r] = (i >= j) ? x : 0.f; }
#pragma unroll
        for (int s = 0; s < 2; ++s) { u32x4 wv; wv.x = pk2(f[8 * s], f[8 * s + 1]); wv.y = pk2(f[8 * s + 2], f[8 * s + 3]); wv.z = pk2(f[8 * s + 4], f[8 * s + 5]); wv.w = pk2(f[8 * s + 6], f[8 * s + 7]); pa[jt][s] = __builtin_bit_cast(bf16x8, wv); }
    }
    f32x16 o1 = {0.f, 0.f, 0.f, 0.f, 0.f, 0.f, 0.f, 0.f, 0.f, 0.f, 0.f, 0.f, 0.f, 0.f, 0.f, 0.f}, o2 = o1;
#pragma unroll
    for (int jt = 0; jt < 2; ++jt)
#pragma unroll
        for (int s = 0; s < 2; ++s) o1 = __builtin_amdgcn_mfma_f32_32x32x16_bf16(pa[jt][s], tr_frag(L3 + OFF_V + cb * 4096, 2 * jt + s, lane), o1, 0, 0, 0);
#pragma unroll
    for (int ks = 0; ks < DK / 16; ++ks) o2 = __builtin_amdgcn_mfma_f32_32x32x16_bf16(nat_frag(L3, LDQ, 32 * rb, 16 * ks, lane), nat_frag(L3 + OFF_S, LDQ, 32 * cb, 16 * ks, lane), o2, 0, 0, 0);
    float o[16];
#pragma unroll
    for (int r = 0; r < 16; ++r) { const int i = 32 * rb + crow(r, hh); const float xi = KIND ? 1.f : exp2f((float)(i + 1) * log2g); o[r] = o1[r] + xi * o2[r];
        const float sq = half_sum(o[r] * o[r]); if (l31 == 0) ssq[i * 4 + cb] = sq; }
    __syncthreads();
    float* Os = (float*)L + w * (32 * 33);
#pragma unroll
    for (int r = 0; r < 16; ++r) Os[crow(r, hh) * 33 + l31] = o[r];
    LDS_WAIT();
#pragma unroll
    for (int k2 = 0; k2 < 2; ++k2) { const int pp = lane + 64 * k2, rw = pp >> 2, ch = pp & 3, i = 32 * rb + rw;
        const f32x4 s4 = *(const f32x4*)(ssq + i * 4);
        const float rn = rsqrtf(((s4.x + s4.y) + (s4.z + s4.w)) * (1.f / 128.f) + EPS);
        float gv[8]; unpack8(gc[k2], gv); float y[8];
#pragma unroll
        for (int e = 0; e < 8; ++e) y[e] = siluf_(gv[e]) * Os[rw * 33 + 8 * ch + e] * rn;
        *(u32x4*)(P_YCAT + (size_t)(b * SEQ + c * 64 + i) * DM + OCOL + h * 128 + 32 * cb + 8 * ch) = repack8(y); }
    __syncthreads();
}
template <int KIND> __device__ __forceinline__ void r2_run(CArgs& A, const Frame& F0, int first, int n, int stride) {
    R2Regs<KIND> R; u32x4 gc[2];
    { Frame G2 = F0; int t_ = F0.tid; asm volatile("" : "+v"(t_)); G2.tid = t_; G2.lane = t_ & 63; r2_load<KIND>(A, G2, R, (first & 1023) >> 5, first & 31); }
#pragma unroll 1
    for (int i = 0; i < n; ++i) {
        Frame G2 = F0; { int t_ = F0.tid; asm volatile("" : "+v"(t_)); G2.tid = t_; G2.lane = t_ & 63; }
        const int r = (first + i * stride) & 1023;
        r2_stage<KIND>(G2, R, gc);
        if (i + 1 < n) { const int rn = (first + (i + 1) * stride) & 1023; r2_load<KIND>(A, G2, R, rn >> 5, rn & 31); }
        r2_compute<KIND>(A, G2, r >> 5, r & 31, gc);
    }
}
__device__ __forceinline__ void p_lin_r2(CArgs& A, const Frame& F) {
    r2_run<0>(A, F, F.bid, 4, F.G);
    r2_run<1>(A, F, 1024 + F.bid, 4, F.G);
}
}
#define XB_TMO      128
#define XB_XCNT(j)  (256  + 64 * (j))
#define XB_XSUB(j)  (1280 + 64 * (j))
#define XB_XGEN(j)  (2304 + 64 * (j))
#define XB_TOP      3328
#define XB_TOPGEN   3392
#define XCD_BAR_WORDS 3456
#define XB_SPIN_CAP (1u << 18)
__device__ __forceinline__ unsigned xb_ld(unsigned* p)              { return __hip_atomic_load(p, __ATOMIC_RELAXED, __HIP_MEMORY_SCOPE_AGENT); }
__device__ __forceinline__ unsigned xb_add(unsigned* p, unsigned v) { return __hip_atomic_fetch_add(p, v, __ATOMIC_RELAXED, __HIP_MEMORY_SCOPE_AGENT); }
__device__ __forceinline__ unsigned xb_xcc_id() { return (unsigned)__builtin_amdgcn_s_getreg((3 << 11) | 20) & 0xFu; }
#define XB_SPIN(cond, bar) do { unsigned _sp = 0; while (cond) { __builtin_amdgcn_s_sleep(1); \
    if ((++_sp & 255u) == 0u) { if (xb_ld(&(bar)[XB_TMO])) break; if (_sp > XB_SPIN_CAP) { atomicAdd(&(bar)[XB_TMO], 1u); break; } } } } while (0)
struct XcdBarrier { unsigned* bar; unsigned x; volatile LAS unsigned* st; };
__device__ __forceinline__ XcdBarrier xcd_barrier_post(unsigned* bar, volatile LAS unsigned* st, int tid) {
    XcdBarrier b; b.bar = bar; b.x = xb_xcc_id(); b.st = st;
    if (tid == 0) (void)xb_add(&bar[XB_XCNT(b.x)], 1u);
    return b;
}
__device__ __forceinline__ void xcd_barrier_complete(unsigned* bar, unsigned x, unsigned& nloc, unsigned& nx) {
    const unsigned G = gridDim.x * gridDim.y * gridDim.z;
    unsigned sum, cnt, mine, sp = 0u;
    for (;;) {
        sum = 0u; cnt = 0u; mine = 0u;
#pragma unroll
        for (unsigned j = 0; j < 16; ++j) { const unsigned c = xb_ld(&bar[XB_XCNT(j)]); sum += c; cnt += (c > 0u) ? 1u : 0u; mine = (j == x) ? c : mine; }
        if (sum == G) break;
        __builtin_amdgcn_s_sleep(1);
        if ((++sp & 255u) == 0u) { if (xb_ld(&bar[XB_TMO])) break; if (sp > XB_SPIN_CAP) { atomicAdd(&bar[XB_TMO], 1u); break; } }
    }
    nloc = mine > 0u ? mine : 1u; nx = cnt > 0u ? cnt : 1u;
}
__device__ __forceinline__ void xcd_barrier(const XcdBarrier& b, int tid) {
    asm volatile("s_waitcnt vmcnt(0)" ::: "memory");
    __syncthreads();
    if (tid == 0) {
        unsigned* bar = b.bar;
        __builtin_amdgcn_s_waitcnt(0);
        unsigned nloc = b.st[0], nx = b.st[1];
        if (nloc == 0u) { xcd_barrier_complete(bar, b.x, nloc, nx); b.st[0] = nloc; b.st[1] = nx; }
        const unsigned old = xb_add(&bar[XB_XSUB(b.x)], 1u);
        const unsigned gen = old / nloc;
        if (old + 1u == (gen + 1u) * nloc) {
            __builtin_amdgcn_fence(__ATOMIC_RELEASE, "agent");
            asm volatile("s_waitcnt vmcnt(0)" ::: "memory");
            const unsigned og = xb_add(&bar[XB_TOP], 1u);
            const unsigned tg = og / nx;
            if (og + 1u == (tg + 1u) * nx) xb_add(&bar[XB_TOPGEN], 1u);
            else XB_SPIN(xb_ld(&bar[XB_TOPGEN]) == tg, bar);
            __builtin_amdgcn_fence(__ATOMIC_ACQUIRE, "agent");
            xb_add(&bar[XB_XGEN(b.x)], 1u);
            asm volatile("s_waitcnt vmcnt(0)" ::: "memory");
        } else {
            XB_SPIN(xb_ld(&bar[XB_XGEN(b.x)]) == gen, bar);
            __builtin_amdgcn_fence(__ATOMIC_ACQUIRE, "agent");
            asm volatile("s_waitcnt vmcnt(0)" ::: "memory");
        }
    }
    __syncthreads();
}
#define REFRESH() do { int t_ = F.wave * 64 + lane_id(); asm volatile("" : "+v"(t_)); F.tid = t_; F.lane = t_ & 63; asm volatile("" : "+s"(ap)); int b_ = blockIdx.x; asm volatile("" : "+s"(b_)); F.bid = b_; } while (0)
#define A (*ap)
#define GSYNC() do { REFRESH(); xcd_barrier(xb, F.tid); } while (0)
template <int l> __device__ __forceinline__ void layer_fwd(CArgs*& ap, Frame& F, const XcdBarrier& xb, unsigned char* lds, LAS unsigned char* lds3, LAS pg8::MoeTables* tb) {
    if (l == 0) {
        { REFRESH(); pg8::DenseOrder S; S.init(P_HB, P_WINE, NTOK, 2048, 1024, F.G, F.bid); pg8::EpiZ0 E{P_Z};
          pg8::gemm_phase<pg8::EpiZ0, pg8::DenseOrder, true>(lds3, F.wave, 1024, S, E); }
        GSYNC();
        REFRESH(); fox_fast(A, F);
        __syncthreads();
        REFRESH(); s5_fast(A, F, F.bid);
        GSYNC();
        { REFRESH(); pg8::DenseOrder S; S.init(P_G5, P_WGLU, NTOK, 512, 512, F.G, F.bid); pg8::EpiGlu E{P_G5, A.in[I_GLUB], P_YCAT};
          pg8::gemm_phase<pg8::EpiGlu, pg8::DenseOrder, true>(lds3, F.wave, 512, S, E); }
        GSYNC();
    } else {
        REFRESH(); lin::gla_prefix(A, F, F.bid);
        { REFRESH(); pg8::DenseOrder S; S.init(P_HB, P_WINO, NTOK, 3584, 512, F.G, F.bid); pg8::EpiZ1 E{P_Z, P_ROPE};
          pg8::gemm_phase<pg8::EpiZ1, pg8::DenseOrder, true, true>(lds3, F.wave, 512, S, E); }
        GSYNC();
        REFRESH(); lin::p_lin_r1(A, F);
        GSYNC();
        REFRESH(); lin::p_lin_r2(A, F);
        GSYNC();
    }
    { REFRESH(); pg8::DenseOrder S; S.init(P_YCAT, l == 0 ? P_WOUTE : P_WOUTO, NTOK, 1024, 1024, F.G, F.bid); pg8::EpiBf16Plain E{(bf16_t*)P_MBUF, DM};
      pg8::gemm_phase<pg8::EpiBf16Plain, pg8::DenseOrder, true>(lds3, F.wave, 1024, S, E); }
    GSYNC();
    REFRESH(); p_postmix(A, F, l);
    GSYNC();
    REFRESH(); const int MT = moe_tables(A, F, l, tb);
    {
        const int mX = (MT >> 5) << 5, kk = MT - mX, rr = (64 - ((2 * kk) & 63)) & 63;
        const int mY = mX >= rr ? rr + (((mX - rr) >> 6) << 6) : 0;
        if (mX > 0) {
            { REFRESH(); pg8::MoeOrder<true> S; S.Ap = (const char*)P_HB8; S.Bt = (const char*)(P_W1 + (size_t)l * 32 * 2048 * 1024); S.estride = (size_t)2048 * 1024; S.K = 512; S.NP = 8; S.nwg = mX * 8; S.G = F.G; S.c = F.bid; S.mt0 = 0;
              S.list_tk = P_LTK + (size_t)l * 32 * LISTCAP; S.tb = tb;
              pg8::EpiSwiglu E{P_ACT, A.in[I_BGU] + (size_t)l * 32 * 2048};
              pg8::gemm_phase<pg8::EpiSwiglu, pg8::MoeOrder<true>, true, true>(lds3, F.wave, 512, S, E); }
            GSYNC();
        }
        if (8 * (MT - mX) + 4 * mY > 0) {
            { REFRESH(); pg8::MoeMixOrder S; S.ws = (const char*)A.ws; S.l = l;
              S.a0 = mX; S.nA = 8 * (MT - mX); S.b0 = 0; S.nB = 4 * mY; S.nwg = S.nA + S.nB; S.G = F.G; S.c = F.bid; S.tb = tb;
              pg8::EpiMoeMix E{ap, l};
              pg8::gemm_phase<pg8::EpiMoeMix, pg8::MoeMixOrder, true, true>(lds3, F.wave, 512, S, E); }
            GSYNC();
        }
        if (MT > mY) {
            { REFRESH(); pg8::MoeOrder<false> S; S.Ap = (const char*)P_ACT; S.Bt = (const char*)(P_W2 + (size_t)l * 32 * 1024 * 1024); S.estride = (size_t)1024 * 1024; S.K = 512; S.NP = 4; S.nwg = (MT - mY) * 4; S.G = F.G; S.c = F.bid; S.mt0 = mY;
              S.list_tk = P_LTK + (size_t)l * 32 * LISTCAP; S.tb = tb;
              pg8::EpiDown E{P_Y, A.in[I_BDN] + (size_t)l * 32 * 1024, P_LTK + (size_t)l * 32 * LISTCAP, P_LG + (size_t)l * 32 * LISTCAP};
              pg8::gemm_phase<pg8::EpiDown, pg8::MoeOrder<false>, true, true>(lds3, F.wave, 512, S, E); }
            GSYNC();
        }
    }
    REFRESH(); p_combine(A, F, l);
}

__global__ void __launch_bounds__(512, 2) mk_fwd(Args A_) {
    extern __shared__ __attribute__((aligned(16))) unsigned char lds[];
    cg::grid_group grid = cg::this_grid();
    CArgs* ap = (CArgs*)__builtin_amdgcn_kernarg_segment_ptr();
    Frame F;
    F.lds = lds; F.wave = __builtin_amdgcn_readfirstlane((int)threadIdx.x >> 6); F.tid = 0; F.lane = 0; F.bid = blockIdx.x; F.G = gridDim.x;
    LAS unsigned char* lds3 = (LAS unsigned char*)lds;
    LAS pg8::MoeTables* tb = (LAS pg8::MoeTables*)(lds3 + 133632);
    { volatile LAS unsigned* st = (volatile LAS unsigned*)(lds3 + (LDS_BYTES - 64)); REFRESH(); if (F.tid < 2) st[F.tid] = 0u; __syncthreads(); }
    XcdBarrier xb = xcd_barrier_post((unsigned*)(A.ws + WS_CTL) + 10240, (volatile LAS unsigned*)(lds3 + (LDS_BYTES - 64)), F.tid);
    REFRESH(); p0_prep(A, F);
    if (A.pad != 0) grid.sync();
    GSYNC();
    asm volatile("s_sleep 40\n\ts_sleep 40" ::: "memory");
    REFRESH(); p1_hprep0(A, F);
    GSYNC();
    asm volatile("s_sleep 40\n\ts_sleep 40" ::: "memory");
    layer_fwd<0>(ap, F, xb, lds, lds3, tb);
    GSYNC();
    layer_fwd<1>(ap, F, xb, lds, lds3, tb);
}
#undef A

extern "C" void kernel_launch(void* const* d_in, const int* in_sizes, int n_in, void* d_out, int out_size, void* d_ws, size_t ws_size, hipStream_t stream) {
    static int grid = 0;
    if (grid == 0) {
        if (n_in != 31 || out_size != NTOK * DM || ws_size < WS_END) { fprintf(stderr, "kernel_launch: unexpected problem (n_in %d out %d ws %zu)\n", n_in, out_size, ws_size); grid = -1; return; }
        int dev = 0, cus = 0, per_cu = 0;
        if (hipGetDevice(&dev) != hipSuccess || hipDeviceGetAttribute(&cus, hipDeviceAttributeMultiprocessorCount, dev) != hipSuccess) { grid = -1; return; }
        if (hipFuncSetAttribute((const void*)mk_fwd, hipFuncAttributeMaxDynamicSharedMemorySize, LDS_BYTES) != hipSuccess) { fprintf(stderr, "kernel_launch: hipFuncSetAttribute failed\n"); grid = -1; return; }
        if (hipOccupancyMaxActiveBlocksPerMultiprocessor(&per_cu, (const void*)mk_fwd, 512, LDS_BYTES) != hipSuccess || per_cu < 1) { fprintf(stderr, "kernel_launch: occupancy query says %d blocks per CU\n", per_cu); (void)hipGetLastError(); }
        grid = cus;
        if (grid != 256) fprintf(stderr, "kernel_launch: %d CUs; this kernel is built for a 256-CU grid\n", grid);
    }
    if (grid < 0) return;
    if (hipMemsetAsync((char*)d_ws + WS_CTL, 0, CTL_ZERO_BYTES, stream) != hipSuccess) { fprintf(stderr, "kernel_launch: memset failed\n"); return; }
    Args a{};
    for (int i = 0; i < 31; ++i) a.in[i] = (const float*)d_in[i];
    a.out = (float*)d_out; a.ws = (unsigned char*)d_ws;
    void* kargs[] = {&a};
    const hipError_t e = hipLaunchCooperativeKernel((const void*)mk_fwd, dim3(grid), dim3(512), kargs, LDS_BYTES, stream);
    if (e != hipSuccess) fprintf(stderr, "kernel_launch: cooperative launch failed: %s (grid %d)\n", hipGetErrorString(e), grid);
}
```

```cpp
#include <hip/hip_runtime.h>
#include <hip/hip_cooperative_groups.h>
#include <cstdio>
#include <cstdint>
namespace cg = cooperative_groups;

#define LAS __attribute__((address_space(3)))
typedef unsigned short bf16_t;
typedef short bf16x8 __attribute__((ext_vector_type(8)));
typedef float f32x4 __attribute__((ext_vector_type(4)));
typedef float f32x2 __attribute__((ext_vector_type(2)));
typedef unsigned u32x4 __attribute__((ext_vector_type(4)));
typedef unsigned u32x2 __attribute__((ext_vector_type(2)));
typedef int i32x4 __attribute__((ext_vector_type(4)));
typedef int i32x8 __attribute__((ext_vector_type(8)));

constexpr int NTOK = 16384, DM = 1024, SEQ = 2048, NB = 8;
constexpr int NEXP = 32, LISTCAP = 16384;
constexpr float EPS = 1e-6f;
constexpr float LOG2E = 1.4426950408889634f;
constexpr float C2 = 0.125f * LOG2E;
constexpr int ZP0 = 2048, ZP1 = 3584;

constexpr size_t MiB = 1u << 20;
constexpr size_t WS_CTL = 0, CTL_ZERO_BYTES = 65536;
constexpr size_t WS_MOD = 1 * MiB;
constexpr size_t WS_WSIDE = 1 * MiB + 512 * 1024;
constexpr size_t WS_S5A = 2 * MiB;
constexpr size_t WS_S5BB = 2 * MiB + 65536;
constexpr size_t WS_S5CK = 2 * MiB + 512 * 1024;
constexpr size_t WS_ROPE = 3 * MiB;
constexpr size_t WS_LTK = 4 * MiB;
constexpr size_t WS_LG = 8 * MiB;
constexpr size_t WS_WINE = 16 * MiB, WS_WGLU = 20 * MiB, WS_WOUTE = 21 * MiB, WS_WINO = 23 * MiB, WS_WOUTO = 30 * MiB;
constexpr size_t WS_W1 = 32 * MiB;
constexpr size_t WS_HB8 = 160 * MiB;
constexpr size_t WS_W2 = 288 * MiB;
constexpr size_t WS_HB = 416 * MiB;
constexpr size_t WS_Z = 448 * MiB;
constexpr size_t WS_LSIG = 560 * MiB;
constexpr size_t WS_LOGA = 562 * MiB;
constexpr size_t WS_G5 = 578 * MiB;
constexpr size_t WS_YCAT = 594 * MiB;
constexpr size_t WS_MBUF = 626 * MiB;
constexpr size_t WS_ACT = 690 * MiB;
constexpr size_t WS_Y = 834 * MiB;
constexpr size_t WS_RST = 962 * MiB;
constexpr size_t WS_GST = 994 * MiB;
constexpr size_t WS_XB = 1010 * MiB;
constexpr size_t WS_END = 1042 * MiB;
constexpr int CW_CNT = 1024;

constexpr int RING_BYTES = 131072;
constexpr int MISC_OFF = RING_BYTES;
constexpr int LDS_BYTES = 147456;

__device__ __forceinline__ unsigned f2bf(float f) { unsigned u = __builtin_bit_cast(unsigned, f); return (u + 0x7fffu + ((u >> 16) & 1u)) >> 16; }
typedef __bf16 bf16x2_hw __attribute__((ext_vector_type(2)));
__device__ __forceinline__ unsigned pk2(float lo, float hi) { const f32x2 v = {lo, hi}; return __builtin_bit_cast(unsigned, __builtin_convertvector(v, bf16x2_hw)); }
__device__ __forceinline__ float bflo(unsigned w) { return __builtin_bit_cast(float, w << 16); }
__device__ __forceinline__ float bfhi(unsigned w) { return __builtin_bit_cast(float, w & 0xffff0000u); }
__device__ __forceinline__ float bf1(bf16_t b) { return __builtin_bit_cast(float, ((unsigned)b) << 16); }
__device__ __forceinline__ int lane_id() { int l; asm volatile("v_mbcnt_lo_u32_b32 %0, -1, 0\n\tv_mbcnt_hi_u32_b32 %0, -1, %0" : "=v"(l)); return l; }
template <int CTRL> __device__ __forceinline__ float dppf(float v) { return __builtin_bit_cast(float, __builtin_amdgcn_update_dpp(0, __builtin_bit_cast(int, v), CTRL, 0xf, 0xf, true)); }
__device__ __forceinline__ float row16_sum(float v) {
    v += dppf<0xB1>(v); v += dppf<0x4E>(v); v += dppf<0x141>(v); v += dppf<0x140>(v); return v;
}
__device__ __forceinline__ float rdlane(float v, int l) { return __builtin_bit_cast(float, __builtin_amdgcn_readlane(__builtin_bit_cast(int, v), l)); }
__device__ __forceinline__ float wave_sum(float v) {
    v = row16_sum(v); return (rdlane(v, 0) + rdlane(v, 16)) + (rdlane(v, 32) + rdlane(v, 48));
}
__device__ __forceinline__ float half_sum(float v) {
    v = row16_sum(v); const float a = rdlane(v, 0) + rdlane(v, 16), b = rdlane(v, 32) + rdlane(v, 48); return (lane_id() < 32) ? a : b;
}
__device__ __forceinline__ float sigmoidf_(float x) { return __builtin_amdgcn_rcpf(1.f + __expf(-x)); }
__device__ __forceinline__ float log_sigmoidf_(float x) { return fminf(x, 0.f) - log1pf(__expf(-fabsf(x))); }
__device__ __forceinline__ float siluf_(float x) { return x * sigmoidf_(x); }
__device__ __forceinline__ float gelu_tanh(float x) { const float u2 = 1.5957691216057308f * (x + 0.044715f * x * x * x); return x * sigmoidf_(u2); }
constexpr float SC_H = 16.f, SC_W1 = 512.f, SC_A = 8.f, SC_W2 = 512.f, SC_WIN = 512.f, SC_Y = 64.f;
__device__ __forceinline__ unsigned pk8(float a, float b, float c, float d) {
    a = __builtin_amdgcn_fmed3f(a, -448.f, 448.f); b = __builtin_amdgcn_fmed3f(b, -448.f, 448.f); c = __builtin_amdgcn_fmed3f(c, -448.f, 448.f); d = __builtin_amdgcn_fmed3f(d, -448.f, 448.f);
    int r = __builtin_amdgcn_cvt_pk_fp8_f32(a, b, 0, false); r = __builtin_amdgcn_cvt_pk_fp8_f32(c, d, r, true); return (unsigned)r;
}
#define LDS_WAIT() asm volatile("s_waitcnt lgkmcnt(0)" ::: "memory")

struct Args { const float* in[31]; float* out; unsigned char* ws; long long pad; };
typedef const __attribute__((address_space(4))) Args CArgs;
enum { I_X = 0, I_C, I_ADAW, I_ADAB, I_NPM, I_NQM, I_NPF, I_NQF, I_EVWIN, I_FOXB, I_LAMRE, I_LAMIM, I_LOGDT, I_BRE, I_BIM, I_CRE, I_CIM, I_S5D, I_GLUW, I_GLUB, I_EVWOUT,
       I_ODWIN, I_GLAWUP, I_GLABG, I_ODWOUT, I_RW, I_RB, I_WGU, I_BGU, I_WDN, I_BDN };

namespace pg8 {
constexpr int BM = 256, BK = 64, HALF = 128, HTB = HALF * BK * 2, STAGE_BYTES = 8 * HTB, NXCD = 8, WGM = 8;
__device__ __forceinline__ int lds_byte(int r, int c) { const int st = (r >> 4) * 2 + (c >> 5), rr = r & 15, cc = c & 31, ob = rr * 64 + cc * 2; return st * 1024 + (ob ^ (((ob >> 9) & 1) << 5)); }
__device__ __forceinline__ void stage_rc(int b, int& R, int& C) { const int st = b / 1024, sb = b % 1024, swz = sb ^ (((sb >> 9) & 1) << 5); R = (st >> 1) * 16 + swz / 64; C = (st & 1) * 32 + (swz % 64) / 2; }
__device__ __forceinline__ int perm32(int rho) { const int n = rho >> 4, i = rho & 15; return 8 * (i >> 2) + 4 * n + (i & 3); }
__device__ __forceinline__ unsigned cvt_pk_bf16(float lo, float hi) { unsigned r; asm volatile("v_cvt_pk_bf16_f32 %0, %1, %2" : "=v"(r) : "v"(lo), "v"(hi)); return r; }

struct Unit { int pm, pn, e, mb, nrows, kind; };
__device__ __forceinline__ int xcd_remap(int L, int nwg) { const int q = nwg / NXCD, r = nwg % NXCD, xcd = L % NXCD, off = L / NXCD; return (xcd < r ? xcd * (q + 1) : r * (q + 1) + (xcd - r) * q) + off; }

struct DenseOrder {
    const char* Ap; const char* Bt; int K, nM, nN, nwg, G, c;
    __device__ __forceinline__ void init(const void* A_, const void* Bt_, int M, int N, int K_, int G_, int c_) { Ap = (const char*)A_; Bt = (const char*)Bt_; K = K_; nM = M / BM; nN = N / BM; nwg = nM * nN; G = G_; c = c_; }
    __device__ __forceinline__ bool next(int i, Unit& u) const {
        const long L = (long)i * G + c; if (L >= nwg) return false;
        const int wgid = xcd_remap((int)L, nwg);
        const int nig = WGM * nN, gid = wgid / nig, fm = gid * WGM, gsz = (nM - fm) < WGM ? (nM - fm) : WGM;
        u.pm = fm + ((wgid % nig) % gsz); u.pn = (wgid % nig) / gsz; u.e = 0; u.mb = u.pm; u.nrows = BM; u.kind = 0; return true;
    }
    __device__ __forceinline__ const char* a_base(const Unit& u) const { return Ap + (size_t)u.pm * ((size_t)BM * K * 2); }
    __device__ __forceinline__ const char* b_base(const Unit& u) const { return Bt + (size_t)u.pn * ((size_t)BM * K * 2); }
    __device__ __forceinline__ void a_raw(const Unit&, const int (&)[2], int (&raw)[2][2]) const { raw[0][0] = raw[0][1] = raw[1][0] = raw[1][1] = 0; }
    __device__ __forceinline__ void a_offs(const Unit&, const int (&R)[2], const int (&C)[2], const int (&)[2][2], unsigned (&v)[2][2]) const {
#pragma unroll
        for (int h = 0; h < 2; ++h)
#pragma unroll
            for (int i = 0; i < 2; ++i) v[h][i] = (unsigned)((h * HALF + R[i]) * K + C[i]) * 2u;
    }
};
struct MoeTables { int cnt[NEXP]; int mtstart[NEXP + 1]; unsigned char tile_e[320]; };
template <bool GATHER> struct MoeOrder {
    const char* Ap; const char* Bt; size_t estride; int K, NP, nwg, G, c, mt0; const int* list_tk; const LAS MoeTables* tb;
    __device__ __forceinline__ bool next(int i, Unit& u) const {
        const long L = (long)i * G + c; if (L >= nwg) return false;
        const int w = xcd_remap((int)L, nwg);
        const int mq = w / NP, mt = mt0 + mq; u.pn = w - mq * NP; u.pm = mt; u.e = tb->tile_e[mt]; u.mb = mt - tb->mtstart[u.e];
        const int left = tb->cnt[u.e] - u.mb * BM; u.nrows = left < BM ? left : BM; u.kind = GATHER ? 0 : 1; return true;
    }
    __device__ __forceinline__ const char* a_base(const Unit& u) const { return GATHER ? Ap : Ap + (size_t)u.pm * ((size_t)BM * K * 2); }
    __device__ __forceinline__ const char* b_base(const Unit& u) const { return Bt + (size_t)u.e * estride + (size_t)u.pn * ((size_t)BM * K * 2); }
    __device__ __forceinline__ void a_raw(const Unit& u, const int (&R)[2], int (&raw)[2][2]) const {
#pragma unroll
        for (int h = 0; h < 2; ++h)
#pragma unroll
            for (int i = 0; i < 2; ++i) { if (GATHER) { const int r = h * HALF + R[i], rc = r < u.nrows ? r : 0; raw[h][i] = list_tk[u.e * LISTCAP + u.mb * BM + rc]; } else raw[h][i] = 0; }
    }
    __device__ __forceinline__ void a_offs(const Unit&, const int (&R)[2], const int (&C)[2], const int (&raw)[2][2], unsigned (&v)[2][2]) const {
#pragma unroll
        for (int h = 0; h < 2; ++h)
#pragma unroll
            for (int i = 0; i < 2; ++i) {
                if (GATHER) v[h][i] = (unsigned)((raw[h][i] >> 2) * K + C[i]) * 2u;
                else v[h][i] = (unsigned)((h * HALF + R[i]) * K + C[i]) * 2u;
            }
    }
};

struct MoeMixOrder {
    const char* ws; int l, a0, nA, b0, nB, nwg, G, c; const LAS MoeTables* tb;
    static constexpr int K = 512;
    __device__ __forceinline__ bool next(int i, Unit& u) const {
        const long L = (long)i * G + c; if (L >= nwg) return false;
        int w = xcd_remap((int)L, nwg), mt;
        if (w < nA) { u.kind = 0; mt = a0 + (w >> 3); u.pn = w & 7; } else { w -= nA; u.kind = 1; mt = b0 + (w >> 2); u.pn = w & 3; }
        u.pm = mt; u.e = tb->tile_e[mt]; u.mb = mt - tb->mtstart[u.e];
        const int left = tb->cnt[u.e] - u.mb * BM; u.nrows = left < BM ? left : BM; return true;
    }
    __device__ __forceinline__ const char* a_base(const Unit& u) const { return u.kind ? ws + WS_ACT : ws + WS_HB8; }
    __device__ __forceinline__ const char* b_base(const Unit& u) const { return u.kind ? ws + WS_W2 + (size_t)(l * 32 + u.e) * ((size_t)1024 * K * 2) + (size_t)u.pn * ((size_t)BM * K * 2) : ws + WS_W1 + (size_t)(l * 32 + u.e) * ((size_t)2048 * K * 2) + (size_t)u.pn * ((size_t)BM * K * 2); }
    __device__ __forceinline__ void a_raw(const Unit& u, const int (&R)[2], int (&raw)[2][2]) const {
#pragma unroll
        for (int h = 0; h < 2; ++h)
#pragma unroll
            for (int i = 0; i < 2; ++i) { const int r = h * HALF + R[i], rc = r < u.nrows ? r : 0; raw[h][i] = u.kind ? 4 * (u.pm * BM + r) : ((const int*)(ws + WS_LTK))[(l * 32 + u.e) * LISTCAP + u.mb * BM + rc]; }
    }
    __device__ __forceinline__ void a_offs(const Unit& u, const int (&R)[2], const int (&C)[2], const int (&raw)[2][2], unsigned (&v)[2][2]) const {
#pragma unroll
        for (int h = 0; h < 2; ++h)
#pragma unroll
            for (int i = 0; i < 2; ++i) v[h][i] = (unsigned)((raw[h][i] >> 2) * K + C[i]) * 2u;
    }
};

template <class Epi, class Sched, bool ALIGN_EPI, bool FP8 = false>
__device__ __forceinline__ void gemm_phase(LAS unsigned char* lds, const int wave_, const int K, const Sched& S, const Epi& E) {
    int tid_ = wave_ * 64 + lane_id(); asm volatile("" : "+v"(tid_));
    const int tid = tid_, wid = wave_, lane = tid & 63, wr = wid >> 2, wc = wid & 3, fr = lane & 15, fq = lane >> 4;
    int nt_ = K / BK; if constexpr (FP8) asm volatile("" : "+s"(nt_));
    const int nt = nt_;
    int Rr[2], Cc[2]; unsigned voffB[2];
#pragma unroll
    for (int i = 0; i < 2; ++i) { stage_rc(tid * 16 + i * 8192, Rr[i], Cc[i]); const int Rb = Epi::PERM ? ((Rr[i] & ~31) + perm32(Rr[i] & 31)) : Rr[i]; voffB[i] = (unsigned)(Rb * K + Cc[i]) * 2u; }
    const size_t kstep = (size_t)(BK * 2);
    const size_t hstep = (size_t)HALF * K * 2;
    const unsigned ldsw = (unsigned)wid * 1024u;
    const int aoff = lds_byte(wr * 64 + fr, fq * 8), boff = lds_byte(wc * 32 + fr, fq * 8);
#define PG8_SA(b, h) (((b) * 2 + (h)) * HTB)
#define PG8_SB(b, h) ((4 + (b) * 2 + (h)) * HTB)
#define PG8_STAGE(bufoff, gbase, voff) do { _Pragma("unroll") for (int _i = 0; _i < 2; ++_i) { unsigned vo_ = (voff)[_i]; if constexpr (FP8) asm volatile("" : "+v"(vo_));   \
        __builtin_amdgcn_global_load_lds((const unsigned*)((const char*)(gbase) + vo_), (LAS unsigned*)(lds + (bufoff) + ldsw + _i * 8192), 16, 0, 0); } } while (0)
#define PG8_LDA(dst, b, h) do { _Pragma("unroll") for (int m = 0; m < 4; ++m) { \
        if constexpr (FP8) { const i32x4 lo_ = *(const LAS i32x4*)(lds + PG8_SA(b, h) + aoff + m * 2048), hi_ = *(const LAS i32x4*)(lds + PG8_SA(b, h) + aoff + m * 2048 + 1024); dst##8[m] = __builtin_shufflevector(lo_, hi_, 0, 1, 2, 3, 4, 5, 6, 7); } \
        else { _Pragma("unroll") for (int k = 0; k < 2; ++k) dst[m][k] = *(const LAS bf16x8*)(lds + PG8_SA(b, h) + aoff + m * 2048 + k * 1024); } } } while (0)
#define PG8_LDB(dst, b, h) do { _Pragma("unroll") for (int n = 0; n < 2; ++n) { \
        if constexpr (FP8) { const i32x4 lo_ = *(const LAS i32x4*)(lds + PG8_SB(b, h) + boff + n * 2048), hi_ = *(const LAS i32x4*)(lds + PG8_SB(b, h) + boff + n * 2048 + 1024); dst##8[n] = __builtin_shufflevector(lo_, hi_, 0, 1, 2, 3, 4, 5, 6, 7); } \
        else { _Pragma("unroll") for (int k = 0; k < 2; ++k) dst[n][k] = *(const LAS bf16x8*)(lds + PG8_SB(b, h) + boff + n * 2048 + k * 1024); } } } while (0)
#define PG8_MMA(ai, bj, At, Bt) do { __builtin_amdgcn_s_setprio(1); _Pragma("unroll") for (int m = 0; m < 4; ++m) _Pragma("unroll") for (int n = 0; n < 2; ++n) { \
        if constexpr (FP8) asm volatile("v_mfma_f32_16x16x128_f8f6f4 %0, %1, %2, %0" : "+v"(acc[ai][bj][m][n]) : "v"(Bt##8[n]), "v"(At##8[m]));   \
        else { _Pragma("unroll") for (int k = 0; k < 2; ++k) acc[ai][bj][m][n] = __builtin_amdgcn_mfma_f32_16x16x32_bf16(Bt[n][k], At[m][k], acc[ai][bj][m][n], 0, 0, 0); } } \
        __builtin_amdgcn_s_setprio(0); } while (0)
#define PG8_WAIT_V(n) asm volatile("s_waitcnt vmcnt(" #n ")" ::: "memory")
#define PG8_WAIT_L(n) asm volatile("s_waitcnt lgkmcnt(" #n ")" ::: "memory")
#define PG8_BAR __builtin_amdgcn_s_barrier()
#define PG8_SCHED __builtin_amdgcn_sched_barrier(0)
    Unit cur, nxt; int ui = 0;
    if (!S.next(0, cur)) return;
    f32x4 acc[2][2][4][2];
#pragma unroll
    for (int a = 0; a < 2; ++a)
#pragma unroll
        for (int b = 0; b < 2; ++b)
#pragma unroll
            for (int m = 0; m < 4; ++m)
#pragma unroll
                for (int n = 0; n < 2; ++n) acc[a][b][m][n] = (f32x4){0.f, 0.f, 0.f, 0.f};
    bf16x8 At[4][2], B0[2][2], B1[2][2]; i32x8 At8[4], B08[2], B18[2];
    const char* cA = S.a_base(cur); const char* cB = S.b_base(cur);
    unsigned cv[2][2], nv[2][2]; int raw[2][2];
    S.a_raw(cur, Rr, raw); S.a_offs(cur, Rr, Cc, raw, cv);
    PG8_STAGE(PG8_SB(0, 0), cB, voffB); PG8_STAGE(PG8_SB(0, 1), cB + hstep, voffB); PG8_STAGE(PG8_SA(0, 0), cA, cv[0]); PG8_STAGE(PG8_SA(0, 1), cA, cv[1]);
    if (wr == 1) PG8_BAR;
    PG8_WAIT_V(2); PG8_BAR;
    PG8_STAGE(PG8_SB(1, 0), cB + kstep, voffB); PG8_STAGE(PG8_SA(1, 0), cA + kstep, cv[0]); PG8_STAGE(PG8_SB(1, 1), cB + hstep + kstep, voffB);
    PG8_WAIT_V(6); PG8_BAR;
    for (;;) {
        const bool has_next = S.next(ui + 1, nxt);
        const char* nA = has_next ? S.a_base(nxt) : cA; const char* nB = has_next ? S.b_base(nxt) : cB;
        if (has_next) S.a_raw(nxt, Rr, raw);
#pragma unroll
        for (int h = 0; h < 2; ++h)
#pragma unroll
            for (int i = 0; i < 2; ++i) nv[h][i] = cv[h][i];
        for (int t = 0; t < nt; t += 2) {
            const bool last = (t == nt - 2);
            if (last && has_next) S.a_offs(nxt, Rr, Cc, raw, nv);
            const char* a1 = cA + (size_t)(t + 1) * kstep;
            const char* a2 = last ? nA : cA + (size_t)(t + 2) * kstep; const char* b2 = last ? nB : cB + (size_t)(t + 2) * kstep;
            const char* a3 = a2 + kstep; const char* b3 = b2 + kstep;
            unsigned v2[2][2];
#pragma unroll
            for (int h = 0; h < 2; ++h)
#pragma unroll
                for (int i = 0; i < 2; ++i) v2[h][i] = last ? nv[h][i] : cv[h][i];
            PG8_LDB(B0, 0, 0); PG8_LDB(B1, 0, 1); PG8_SCHED; PG8_LDA(At, 0, 0); PG8_STAGE(PG8_SA(1, 1), a1, cv[1]);
            PG8_WAIT_V(8); PG8_WAIT_L(0); PG8_BAR; PG8_MMA(0, 0, At, B0); PG8_MMA(0, 1, At, B1); PG8_BAR; PG8_SCHED;
            PG8_LDA(At, 0, 1); PG8_STAGE(PG8_SB(0, 0), b2, voffB); PG8_STAGE(PG8_SB(0, 1), b2 + hstep, voffB); PG8_STAGE(PG8_SA(0, 0), a2, v2[0]);
            PG8_WAIT_V(8); PG8_WAIT_L(0); PG8_BAR; PG8_MMA(1, 0, At, B0); PG8_MMA(1, 1, At, B1); PG8_BAR; PG8_SCHED;
            PG8_LDB(B0, 1, 0); PG8_LDB(B1, 1, 1); PG8_SCHED; PG8_LDA(At, 1, 0); PG8_STAGE(PG8_SA(0, 1), a2, v2[1]);
            PG8_WAIT_V(8); PG8_WAIT_L(0); PG8_BAR; PG8_MMA(0, 0, At, B0); PG8_MMA(0, 1, At, B1); PG8_BAR; PG8_SCHED;
            PG8_LDA(At, 1, 1); PG8_STAGE(PG8_SB(1, 0), b3, voffB); PG8_STAGE(PG8_SB(1, 1), b3 + hstep, voffB); PG8_STAGE(PG8_SA(1, 0), a3, v2[0]);
            PG8_WAIT_V(8); PG8_WAIT_L(0); PG8_BAR; PG8_MMA(1, 0, At, B0); PG8_MMA(1, 1, At, B1); PG8_BAR; PG8_SCHED;
        }
        if constexpr (ALIGN_EPI) { if (wr == 0) PG8_BAR; }
        if constexpr (FP8) asm volatile("s_nop 15\n\ts_nop 15" ::: "memory");
        E(acc, cur, wr, wc, fr, fq);
        if (!has_next) break;
#pragma unroll
        for (int a = 0; a < 2; ++a)
#pragma unroll
            for (int b = 0; b < 2; ++b)
#pragma unroll
                for (int m = 0; m < 4; ++m)
#pragma unroll
                    for (int n = 0; n < 2; ++n) acc[a][b][m][n] = (f32x4){0.f, 0.f, 0.f, 0.f};
        cur = nxt; cA = nA; cB = nB; ++ui;
#pragma unroll
        for (int h = 0; h < 2; ++h)
#pragma unroll
            for (int i = 0; i < 2; ++i) cv[h][i] = nv[h][i];
        if constexpr (ALIGN_EPI) { if (wr == 1) PG8_BAR; }
    }
    PG8_WAIT_V(0);
    if constexpr (!ALIGN_EPI) { if (wr == 0) PG8_BAR; }
    PG8_BAR;
#undef PG8_SA
#undef PG8_SB
#undef PG8_STAGE
#undef PG8_LDA
#undef PG8_LDB
#undef PG8_MMA
#undef PG8_WAIT_V
#undef PG8_WAIT_L
#undef PG8_BAR
#undef PG8_SCHED
}
}
namespace pg8 {
typedef f32x4 Acc[2][2][4][2];
struct EpiZ0 {
    static constexpr bool PERM = true;
    bf16_t* Z;
    __device__ __forceinline__ void operator()(const Acc& acc, const Unit& u, int wr, int wc, int fr, int fq) const {
        const float sc = (u.pn == 2 || u.pn == 3) ? C2 : 1.f;
        const int row0 = u.pm * BM + wr * 64 + fr, col0 = u.pn * BM + wc * 32 + 8 * fq;
#pragma unroll
        for (int ai = 0; ai < 2; ++ai)
#pragma unroll
            for (int m = 0; m < 4; ++m) { bf16_t* rowp = Z + (size_t)(row0 + ai * HALF + m * 16) * ZP0 + col0;
#pragma unroll
                for (int bj = 0; bj < 2; ++bj) { const f32x4 v0 = acc[ai][bj][m][0] * sc, v1 = acc[ai][bj][m][1] * sc;
                    u32x4 w; w.x = cvt_pk_bf16(v0[0], v0[1]); w.y = cvt_pk_bf16(v0[2], v0[3]); w.z = cvt_pk_bf16(v1[0], v1[1]); w.w = cvt_pk_bf16(v1[2], v1[3]);
                    *(u32x4*)(rowp + bj * HALF) = w; } }
    }
};
struct EpiZ1 {
    static constexpr bool PERM = true;
    bf16_t* Z; const float* rope;
    __device__ __forceinline__ void operator()(const Acc& acc, const Unit& u, int wr, int wc, int fr, int fq) const {
        constexpr float INV = 1.f / (SC_H * SC_WIN);
        const int row0 = u.pm * BM + wr * 64 + fr;
        if (u.pn < 4) {
            const float sc = (u.pn >= 2) ? 0.08838834764831845f * INV : INV;
            const int hl = wc >> 1, jj0 = 32 * (wc & 1) + 8 * fq;
#pragma unroll
            for (int ai = 0; ai < 2; ++ai)
#pragma unroll
                for (int m = 0; m < 4; ++m) { const int row = row0 + ai * HALF + m * 16, pos = row & (SEQ - 1);
                    const f32x4 c0 = *(const f32x4*)(rope + pos * 64 + jj0), c1 = *(const f32x4*)(rope + pos * 64 + jj0 + 4);
                    const f32x4 s0 = *(const f32x4*)(rope + SEQ * 64 + pos * 64 + jj0), s1 = *(const f32x4*)(rope + SEQ * 64 + pos * 64 + jj0 + 4);
                    const f32x4 x10 = acc[ai][0][m][0] * sc, x11 = acc[ai][0][m][1] * sc, x20 = acc[ai][1][m][0] * sc, x21 = acc[ai][1][m][1] * sc;
                    const f32x4 a0 = x10 * c0 - x20 * s0, a1 = x11 * c1 - x21 * s1, b0 = x10 * s0 + x20 * c0, b1 = x11 * s1 + x21 * c1;
                    bf16_t* rowp = Z + (size_t)row * ZP1 + u.pn * BM + 128 * hl + jj0;
                    u32x4 w; w.x = cvt_pk_bf16(a0[0], a0[1]); w.y = cvt_pk_bf16(a0[2], a0[3]); w.z = cvt_pk_bf16(a1[0], a1[1]); w.w = cvt_pk_bf16(a1[2], a1[3]);
                    *(u32x4*)(rowp) = w;
                    w.x = cvt_pk_bf16(b0[0], b0[1]); w.y = cvt_pk_bf16(b0[2], b0[3]); w.z = cvt_pk_bf16(b1[0], b1[1]); w.w = cvt_pk_bf16(b1[2], b1[3]);
                    *(u32x4*)(rowp + 64) = w; }
        } else {
            const float sc = (u.pn == 8) ? 0.125f * INV : INV;
            const int col0 = u.pn * BM + wc * 32 + 8 * fq;
#pragma unroll
            for (int ai = 0; ai < 2; ++ai)
#pragma unroll
                for (int m = 0; m < 4; ++m) { bf16_t* rowp = Z + (size_t)(row0 + ai * HALF + m * 16) * ZP1 + col0;
#pragma unroll
                    for (int bj = 0; bj < 2; ++bj) { const f32x4 v0 = acc[ai][bj][m][0] * sc, v1 = acc[ai][bj][m][1] * sc;
                        u32x4 w; w.x = cvt_pk_bf16(v0[0], v0[1]); w.y = cvt_pk_bf16(v0[2], v0[3]); w.z = cvt_pk_bf16(v1[0], v1[1]); w.w = cvt_pk_bf16(v1[2], v1[3]);
                        *(u32x4*)(rowp + bj * HALF) = w; } }
        }
    }
};
struct EpiGlu {
    static constexpr bool PERM = true;
    const bf16_t* G5; const float* bias; bf16_t* Y;
    __device__ __forceinline__ void operator()(const Acc& acc, const Unit& u, int wr, int wc, int fr, int fq) const {
        const int row0 = u.pm * BM + wr * 64 + fr, col0 = u.pn * BM + wc * 32 + 8 * fq;
        f32x4 bv[2][2];
#pragma unroll
        for (int bj = 0; bj < 2; ++bj)
#pragma unroll
            for (int n = 0; n < 2; ++n) bv[bj][n] = *(const f32x4*)(bias + col0 + bj * HALF + 4 * n);
#pragma unroll
        for (int ai = 0; ai < 2; ++ai)
#pragma unroll
            for (int m = 0; m < 4; ++m) { const size_t row = (size_t)(row0 + ai * HALF + m * 16);
#pragma unroll
                for (int bj = 0; bj < 2; ++bj) { const u32x4 gw = *(const u32x4*)(G5 + row * 512 + col0 + bj * HALF);
                    const f32x4 v0 = acc[ai][bj][m][0] + bv[bj][0], v1 = acc[ai][bj][m][1] + bv[bj][1];
                    float o[8]; o[0] = bflo(gw.x) * sigmoidf_(v0[0]); o[1] = bfhi(gw.x) * sigmoidf_(v0[1]); o[2] = bflo(gw.y) * sigmoidf_(v0[2]); o[3] = bfhi(gw.y) * sigmoidf_(v0[3]);
                    o[4] = bflo(gw.z) * sigmoidf_(v1[0]); o[5] = bfhi(gw.z) * sigmoidf_(v1[1]); o[6] = bflo(gw.w) * sigmoidf_(v1[2]); o[7] = bfhi(gw.w) * sigmoidf_(v1[3]);
                    u32x4 w; w.x = cvt_pk_bf16(o[0], o[1]); w.y = cvt_pk_bf16(o[2], o[3]); w.z = cvt_pk_bf16(o[4], o[5]); w.w = cvt_pk_bf16(o[6], o[7]);
                    *(u32x4*)(Y + row * DM + col0 + bj * HALF) = w; } }
    }
};
struct EpiF32 {
    static constexpr bool PERM = false;
    float* Cp; int ldc;
    __device__ __forceinline__ void operator()(const Acc& acc, const Unit& u, int wr, int wc, int fr, int fq) const {
        const int row0 = u.pm * BM + wr * 64 + fr, col0 = u.pn * BM + wc * 32 + 4 * fq;
#pragma unroll
        for (int ai = 0; ai < 2; ++ai)
#pragma unroll
            for (int m = 0; m < 4; ++m) { float* rowp = Cp + (size_t)(row0 + ai * HALF + m * 16) * ldc + col0;
#pragma unroll
                for (int bj = 0; bj < 2; ++bj)
#pragma unroll
                    for (int n = 0; n < 2; ++n) *(f32x4*)(rowp + bj * HALF + n * 16) = acc[ai][bj][m][n]; }
    }
};
struct EpiBf16Plain {
    static constexpr bool PERM = true;
    bf16_t* Cp; int ldc;
    __device__ __forceinline__ void operator()(const Acc& acc, const Unit& u, int wr, int wc, int fr, int fq) const {
        const int row0 = u.pm * BM + wr * 64 + fr, col0 = u.pn * BM + wc * 32 + 8 * fq;
#pragma unroll
        for (int ai = 0; ai < 2; ++ai)
#pragma unroll
            for (int m = 0; m < 4; ++m) { bf16_t* rowp = Cp + (size_t)(row0 + ai * HALF + m * 16) * ldc + col0;
#pragma unroll
                for (int bj = 0; bj < 2; ++bj) { const f32x4 v0 = acc[ai][bj][m][0], v1 = acc[ai][bj][m][1];
                    u32x4 w; w.x = cvt_pk_bf16(v0[0], v0[1]); w.y = cvt_pk_bf16(v0[2], v0[3]); w.z = cvt_pk_bf16(v1[0], v1[1]); w.w = cvt_pk_bf16(v1[2], v1[3]);
                    *(u32x4*)(rowp + bj * HALF) = w; } }
    }
};
struct EpiSwiglu {
    static constexpr bool PERM = true;
    unsigned char* ACT; const float* bgu;
    __device__ __forceinline__ void operator()(const Acc& acc, const Unit& u, int wr, int wc, int fr, int fq) const {
        constexpr float INV = 1.f / (SC_H * SC_W1), INVL = INV * SC_A, CE = -1.702f * LOG2E;
        const int row0 = u.pm * BM + wr * 64 + fr, j0 = wc * 32 + 8 * fq, colg = u.pn * 128 + j0;
        const float* bp = bgu + (size_t)u.e * 2048 + colg;
        f32x2 bg[4], bl[4];
#pragma unroll
        for (int p = 0; p < 4; ++p) { bg[p] = *(const f32x2*)(bp + 2 * p); bl[p] = (*(const f32x2*)(bp + 1024 + 2 * p) + 1.f) * SC_A; }
#pragma unroll
        for (int ai = 0; ai < 2; ++ai)
#pragma unroll
            for (int m = 0; m < 4; ++m) {
                f32x2 o[4];
#pragma unroll
                for (int p = 0; p < 4; ++p) {
                    const f32x4 ag = acc[ai][0][m][p >> 1], al = acc[ai][1][m][p >> 1];
                    const f32x2 g = (p & 1 ? (f32x2){ag[2], ag[3]} : (f32x2){ag[0], ag[1]}) * INV + bg[p], l = (p & 1 ? (f32x2){al[2], al[3]} : (f32x2){al[0], al[1]}) * INVL + bl[p];
                    const f32x2 a = {fminf(g.x, 7.f), fminf(g.y, 7.f)}, b = {__builtin_amdgcn_fmed3f(l.x, -6.f * SC_A, 8.f * SC_A), __builtin_amdgcn_fmed3f(l.y, -6.f * SC_A, 8.f * SC_A)};
                    const f32x2 t = a * CE; const f32x2 d = (f32x2){__builtin_amdgcn_exp2f(t.x), __builtin_amdgcn_exp2f(t.y)} + 1.f;
                    const f32x2 sg = {__builtin_amdgcn_rcpf(d.x), __builtin_amdgcn_rcpf(d.y)};
                    o[p] = (a * sg) * b; }
                u32x2 w; int r0 = __builtin_amdgcn_cvt_pk_fp8_f32(o[0].x, o[0].y, 0, false); r0 = __builtin_amdgcn_cvt_pk_fp8_f32(o[1].x, o[1].y, r0, true);
                int r1 = __builtin_amdgcn_cvt_pk_fp8_f32(o[2].x, o[2].y, 0, false); r1 = __builtin_amdgcn_cvt_pk_fp8_f32(o[3].x, o[3].y, r1, true);
                w.x = (unsigned)r0; w.y = (unsigned)r1;
                *(u32x2*)(ACT + (size_t)(row0 + ai * HALF + m * 16) * DM + colg) = w; }
    }
};
struct EpiDown {
    static constexpr bool PERM = true;
    unsigned char* Y; const float* bdn; const int* list_tk; const float* list_g;
    __device__ __forceinline__ void operator()(const Acc& acc, const Unit& u, int wr, int wc, int fr, int fq) const {
        constexpr float INV = SC_Y / (SC_A * SC_W2);
        const int r0 = wr * 64 + fr, col0 = u.pn * BM + wc * 32 + 8 * fq;
        const float* bp = bdn + (size_t)u.e * DM + col0;
        f32x4 bv[2][2];
#pragma unroll
        for (int bj = 0; bj < 2; ++bj)
#pragma unroll
            for (int n = 0; n < 2; ++n) bv[bj][n] = *(const f32x4*)(bp + bj * HALF + 4 * n) * SC_Y;
        const size_t lbase = (size_t)u.e * LISTCAP + (size_t)u.mb * BM;
        int tkv[2][4]; float gtv[2][4];
#pragma unroll
        for (int ai = 0; ai < 2; ++ai)
#pragma unroll
            for (int m = 0; m < 4; ++m) { const int r = r0 + ai * HALF + m * 16, rc = r < u.nrows ? r : 0; tkv[ai][m] = list_tk[lbase + rc]; gtv[ai][m] = list_g[lbase + rc]; }
#pragma unroll
        for (int ai = 0; ai < 2; ++ai)
#pragma unroll
            for (int m = 0; m < 4; ++m) { const int r = r0 + ai * HALF + m * 16;
                if (r < u.nrows) { const float gt = gtv[ai][m];
                    unsigned char* rowp = Y + (size_t)tkv[ai][m] * DM + col0;
#pragma unroll
                    for (int bj = 0; bj < 2; ++bj) { const float gi = gt * INV; const f32x4 v0 = acc[ai][bj][m][0] * gi + bv[bj][0] * gt, v1 = acc[ai][bj][m][1] * gi + bv[bj][1] * gt;
                        u32x2 w; w.x = pk8(v0[0], v0[1], v0[2], v0[3]); w.y = pk8(v1[0], v1[1], v1[2], v1[3]);
                        *(u32x2*)(rowp + bj * HALF) = w; } } }
    }
};
struct EpiMoeMix {
    static constexpr bool PERM = true;
    CArgs* ap; int l;
    __device__ __forceinline__ void operator()(const Acc& acc, const Unit& u, int wr, int wc, int fr, int fq) const {
        CArgs& A = *ap; unsigned char* ws = A.ws;
        if (u.kind == 0) { const EpiSwiglu sw{ws + WS_ACT, A.in[I_BGU] + (size_t)l * 32 * 2048}; sw(acc, u, wr, wc, fr, fq); }
        else { const EpiDown dn{ws + WS_Y, A.in[I_BDN] + (size_t)l * 32 * 1024, (const int*)(ws + WS_LTK) + (size_t)l * 32 * LISTCAP, (const float*)(ws + WS_LG) + (size_t)l * 32 * LISTCAP}; dn(acc, u, wr, wc, fr, fq); }
    }
};
}
struct Frame { unsigned char* lds; int tid, lane, wave, bid, G; };
#define P_MOD   ((float*)(A.ws + WS_MOD))
#define P_S5A   ((float*)(A.ws + WS_S5A))
#define P_S5BB  ((float*)(A.ws + WS_S5BB))
#define P_ROPE  ((float*)(A.ws + WS_ROPE))
#define P_WSIDE ((float*)(A.ws + WS_WSIDE))
#define P_S5CK  ((bf16_t*)(A.ws + WS_S5CK))
#define P_LTK   ((int*)(A.ws + WS_LTK))
#define P_LG    ((float*)(A.ws + WS_LG))
#define P_CNT   ((unsigned*)(A.ws + WS_CTL) + CW_CNT)
#define P_WINE  (A.ws + WS_WINE)
#define P_WGLU  ((bf16_t*)(A.ws + WS_WGLU))
#define P_WOUTE ((bf16_t*)(A.ws + WS_WOUTE))
#define P_WINO  (A.ws + WS_WINO)
#define P_WOUTO ((bf16_t*)(A.ws + WS_WOUTO))
#define P_W1    (A.ws + WS_W1)
#define P_W2    (A.ws + WS_W2)
#define P_HB8   (A.ws + WS_HB8)
#define P_HB    (A.ws + WS_HB)
#define P_Z     ((bf16_t*)(A.ws + WS_Z))
#define P_G5    ((bf16_t*)(A.ws + WS_G5))
#define P_YCAT  ((bf16_t*)(A.ws + WS_YCAT))
#define P_ACT   (A.ws + WS_ACT)
#define P_Y     (A.ws + WS_Y)
#define P_LSIG  ((float*)(A.ws + WS_LSIG))
#define P_LOGA  ((float*)(A.ws + WS_LOGA))
#define P_MBUF  ((float*)(A.ws + WS_MBUF))
#define P_XB    ((bf16_t*)(A.ws + WS_XB))
#define P_RST   ((bf16_t*)(A.ws + WS_RST))
#define P_GST   ((bf16_t*)(A.ws + WS_GST))

__device__ __forceinline__ void tr_tile(const float* __restrict__ src, int pitch, int k0, int c0, bf16_t* dst, int Kd, int r0, float* scr, int lane) {
#pragma unroll
    for (int i = 0; i < 16; ++i) {
        const int kk = 4 * i + (lane >> 4), cc = 4 * (lane & 15);
        const f32x4 v = __builtin_nontemporal_load((const f32x4*)(src + (size_t)(k0 + kk) * pitch + c0 + cc));
        float* s = scr + kk * 65 + cc; s[0] = v.x; s[1] = v.y; s[2] = v.z; s[3] = v.w;
    }
    LDS_WAIT();
    const int c = lane & 7;
#pragma unroll
    for (int j = 0; j < 8; ++j) { const int n = (lane >> 3) + 8 * j; const float* s = scr + (8 * c) * 65 + n;
        u32x4 o; o.x = pk2(s[0], s[65]); o.y = pk2(s[130], s[195]); o.z = pk2(s[260], s[325]); o.w = pk2(s[390], s[455]);
        __builtin_nontemporal_store(o, (u32x4*)(dst + (size_t)(r0 + n) * Kd + k0 + 8 * c)); }
    LDS_WAIT();
}
__device__ __forceinline__ void tr_tile8(const float* __restrict__ src, int pitch, int k0, int c0, unsigned char* dst, int Kd, int r0, float* scr, int lane, float scale) {
#pragma unroll
    for (int i = 0; i < 16; ++i) {
        const int kk = 4 * i + (lane >> 4), cc = 4 * (lane & 15);
        const f32x4 v = __builtin_nontemporal_load((const f32x4*)(src + (size_t)(k0 + kk) * pitch + c0 + cc));
        float* s = scr + kk * 65 + cc; s[0] = v.x * scale; s[1] = v.y * scale; s[2] = v.z * scale; s[3] = v.w * scale;
    }
    LDS_WAIT();
    const int c = lane & 3;
#pragma unroll
    for (int j = 0; j < 4; ++j) { const int n = (lane >> 2) + 16 * j; const float* s = scr + (16 * c) * 65 + n;
        u32x4 o; o.x = pk8(s[0], s[65], s[130], s[195]); o.y = pk8(s[260], s[325], s[390], s[455]); o.z = pk8(s[520], s[585], s[650], s[715]); o.w = pk8(s[780], s[845], s[910], s[975]);
        __builtin_nontemporal_store(o, (u32x4*)(dst + (size_t)(r0 + n) * Kd + k0 + 16 * c)); }
    LDS_WAIT();
}
struct TileD { const float* src; unsigned char* dst; int pitch, rp, mode; float scale; };
constexpr int P0_T0 = 16 * 32, P0_T1 = 8 * 8, P0_T2 = 16 * 16, P0_T3 = 16 * 56, P0_T4 = 16 * 16, P0_T5 = 64 * 16 * 32, P0_T6 = 64 * 16 * 16;
constexpr int P0_NTILES = P0_T0 + P0_T1 + P0_T2 + P0_T3 + P0_T4 + P0_T5 + P0_T6;
__device__ __forceinline__ void tile_set(TileD& d, const float* src, int pitch, int k0, int c0, unsigned char* dst, int Kd, int r0, int mode, float scale) {
    d.src = src + (size_t)k0 * pitch + c0; d.pitch = pitch; d.mode = mode; d.scale = scale;
    d.rp = mode ? Kd : 2 * Kd; d.dst = dst + (size_t)r0 * d.rp + (mode ? k0 : 2 * k0);
}
__device__ __forceinline__ void tile_decode(CArgs& A, int it, TileD& d) {
    int r = it;
    if (r < P0_T0) { const int kb = r / 32, nb = r % 32; tile_set(d, A.in[I_EVWIN], 2056, kb * 64, nb * 64, P_WINE, 1024, nb * 64, 0, 1.f); return; } r -= P0_T0;
    if (r < P0_T1) { const int kb = r / 8, nb = r % 8; tile_set(d, A.in[I_GLUW], 512, kb * 64, nb * 64, (unsigned char*)P_WGLU, 512, nb * 64, 0, 1.f); return; } r -= P0_T1;
    if (r < P0_T2) { const int kb = r / 16, nb = r % 16; tile_set(d, A.in[I_EVWOUT], 1024, kb * 64, nb * 64, (unsigned char*)P_WOUTE, 1024, nb * 64, 0, 1.f); return; } r -= P0_T2;
    if (r < P0_T3) { const int kb = r / 112, nb = r % 112; const int n0 = nb * 32; int c0;
        if (n0 < 1024) { const int pn = n0 >> 8, rem = n0 & 255, bj = rem >> 7, hl = (rem & 127) >> 6; c0 = 256 * pn + 128 * hl + 64 * bj + (n0 & 63); }
        else if (n0 < 3072) c0 = n0; else c0 = n0 + 16;
        tile_set(d, A.in[I_ODWIN], 3600, kb * 128, c0, P_WINO, 1024, n0, 1, SC_WIN); return; } r -= P0_T3;
    if (r < P0_T4) { const int kb = r / 16, nb = r % 16; tile_set(d, A.in[I_ODWOUT], 1024, kb * 64, nb * 64, (unsigned char*)P_WOUTO, 1024, nb * 64, 0, 1.f); return; } r -= P0_T4;
    if (r < P0_T5) { const int mat = r / 512, q = r % 512, kb = q / 64, nb = q % 64; const int n0 = nb * 32, pn = n0 >> 8, half = (n0 & 255) >> 7, j0 = n0 & 127;
        tile_set(d, A.in[I_WGU] + (size_t)mat * 1024 * 2048, 2048, kb * 128, half * 1024 + 128 * pn + j0, P_W1 + (size_t)mat * 2048 * 1024, 1024, n0, 1, SC_W1); return; } r -= P0_T5;
    { const int mat = r / 256, q = r % 256, kb = q / 32, nb = q % 32;
        tile_set(d, A.in[I_WDN] + (size_t)mat * 1024 * 1024, 1024, kb * 128, nb * 32, P_W2 + (size_t)mat * 1024 * 1024, 1024, nb * 32, 1, SC_W2); }
}
__device__ __forceinline__ void tile_load(const TileD& d, f32x4 (&R)[16], int lane) {
    const int rs = d.mode ? 3 : 4, kr = lane >> rs, cc = 4 * (lane & ((1 << rs) - 1)), kstep = 64 >> rs;
#pragma unroll
    for (int i = 0; i < 16; ++i) R[i] = __builtin_nontemporal_load((const f32x4*)(d.src + (size_t)(kstep * i + kr) * d.pitch + cc));
}
__device__ __forceinline__ void tile_to_lds(const TileD& d, const f32x4 (&R)[16], float* scr, int lane) {
    const int rs = d.mode ? 3 : 4, kr = lane >> rs, cc = 4 * (lane & ((1 << rs) - 1)), kstep = 64 >> rs, P = d.mode ? 33 : 65;
#pragma unroll
    for (int i = 0; i < 16; ++i) { float* s = scr + (kstep * i + kr) * P + cc; s[0] = R[i].x * d.scale; s[1] = R[i].y * d.scale; s[2] = R[i].z * d.scale; s[3] = R[i].w * d.scale; }
}
__device__ __forceinline__ void tile_finish(const TileD& d, const float* scr, int lane) {
    if (d.mode == 0) {
        const int c = lane & 7;
#pragma unroll
        for (int j = 0; j < 8; ++j) { const int n = (lane >> 3) + 8 * j; const float* s = scr + (8 * c) * 65 + n;
            u32x4 o; o.x = pk2(s[0], s[65]); o.y = pk2(s[130], s[195]); o.z = pk2(s[260], s[325]); o.w = pk2(s[390], s[455]);
            __builtin_nontemporal_store(o, (u32x4*)(d.dst + (size_t)n * d.rp + 16 * c)); }
    } else {
        const int c = lane & 7; const float* s0 = scr + (16 * c) * 33 + (lane >> 3);
        float v[4][16];
#pragma unroll
        for (int j = 0; j < 4; ++j)
#pragma unroll
            for (int t = 0; t < 16; ++t) v[j][t] = s0[8 * j + 33 * t];
#pragma unroll
        for (int j = 0; j < 4; ++j) { const int n = (lane >> 3) + 8 * j;
            u32x4 o; o.x = pk8(v[j][0], v[j][1], v[j][2], v[j][3]); o.y = pk8(v[j][4], v[j][5], v[j][6], v[j][7]); o.z = pk8(v[j][8], v[j][9], v[j][10], v[j][11]); o.w = pk8(v[j][12], v[j][13], v[j][14], v[j][15]);
            __builtin_nontemporal_store(o, (u32x4*)(d.dst + (size_t)n * d.rp + 16 * c)); }
    }
}
__device__ __forceinline__ void p0_prep(CArgs& A, const Frame& F) {
    if (F.bid < 192) {
        float* sc = (float*)F.lds;
        float* red = sc + 8192;
        for (int i = F.tid; i < 8192; i += 512) sc[i] = siluf_(A.in[I_C][i]);
        __syncthreads();
        const int l = F.bid / 96;
        const float* wb = A.in[I_ADAW] + (size_t)l * 1024 * 6144 + (F.bid % 96) * 64;
        float a[8];
#pragma unroll
        for (int b = 0; b < 8; ++b) a[b] = 0.f;
#pragma unroll 1
        for (int kb = 128 * F.wave; kb < 128 * F.wave + 128; kb += 32) { float wv[32];
#pragma unroll
            for (int t = 0; t < 32; ++t) wv[t] = __builtin_nontemporal_load(wb + (size_t)(kb + t) * 6144 + F.lane);
#pragma unroll
            for (int t = 0; t < 32; ++t)
#pragma unroll
                for (int b = 0; b < 8; ++b) a[b] += sc[b * 1024 + kb + t] * wv[t]; }
#pragma unroll
        for (int b = 0; b < 8; ++b) red[(F.wave * 8 + b) * 64 + F.lane] = a[b];
        __syncthreads();
        { const int b = F.tid >> 6, ln = F.tid & 63; float s = 0.f;
#pragma unroll
          for (int w8 = 0; w8 < 8; ++w8) s += red[(w8 * 8 + b) * 64 + ln];
          const int nn = (F.bid % 96) * 64 + ln; __hip_atomic_store(P_MOD + (size_t)(l * 8 + b) * 6144 + nn, s + A.in[I_ADAB][l * 6144 + nn], __ATOMIC_RELAXED, __HIP_MEMORY_SCOPE_AGENT); }
    }
    {
        const int gt = F.bid * 512 + F.tid;
        if (gt < 32 * 64) {
            const int g = gt >> 6;
            const float lr = A.in[I_LAMRE][gt], li = A.in[I_LAMIM][gt], dt = expf(A.in[I_LOGDT][g]);
            const float mag = expf(lr * dt); float sn, cs; sincosf(li * dt, &sn, &cs);
            const float are = mag * cs, aim = mag * sn, den = lr * lr + li * li, nre = are - 1.f, nim = aim;
            const float zre = (nre * lr + nim * li) / den, zim = (nim * lr - nre * li) / den;
            P_S5A[gt * 2] = are; P_S5A[gt * 2 + 1] = aim;
            for (int c = 0; c < 16; ++c) { const float br = A.in[I_BRE][gt * 16 + c], bi = A.in[I_BIM][gt * 16 + c];
                P_S5BB[gt * 32 + c] = zre * br - zim * bi; P_S5BB[gt * 32 + 16 + c] = zre * bi + zim * br; }
        }
        for (int i = gt; i < 32 * 16 * 128; i += F.G * 512) { const int k = i & 127, gc = i >> 7, pp = k >> 1; const float v = (k & 1) ? -A.in[I_CIM][gc * 64 + pp] : A.in[I_CRE][gc * 64 + pp]; P_S5CK[i] = (bf16_t)f2bf(v); }
        for (int i = gt; i < 24 * 1024; i += F.G * 512) { const int o = i >> 10, k = i & 1023; P_WSIDE[i] = o < 8 ? A.in[I_EVWIN][(size_t)k * 2056 + 2048 + o] : A.in[I_ODWIN][(size_t)k * 3600 + 3072 + (o - 8)]; }
        for (int i = gt; i < SEQ * 64; i += F.G * 512) { const int pos = i >> 6, j = i & 63;
            const float inv = exp2f(-(float)j * (13.287712379549449f / 64.f)); const float ang = (float)pos * inv; float sn, cs; sincosf(ang, &sn, &cs);
            P_ROPE[i] = cs; P_ROPE[SEQ * 64 + i] = sn; }
    }
    __syncthreads();
    float* scr = (float*)(F.lds) + F.wave * (128 * 33);
    const int gw = F.bid * 8 + F.wave, NGW = F.G * 8;
    int it = gw; TileD cur, nxt; f32x4 R[16];
    cur.src = nullptr; cur.dst = nullptr; cur.pitch = 0; cur.rp = 0; cur.mode = 0; cur.scale = 1.f; nxt = cur;
    if (it < P0_NTILES) { tile_decode(A, it, cur); tile_load(cur, R, F.lane); }
#pragma unroll 1
    while (it < P0_NTILES) {
        const int nx = it + NGW; const bool hn = nx < P0_NTILES;
        tile_to_lds(cur, R, scr, F.lane);
        if (hn) { tile_decode(A, nx, nxt); tile_load(nxt, R, F.lane); }
        asm volatile("" ::: "memory");
        LDS_WAIT();
        tile_finish(cur, scr, F.lane);
        LDS_WAIT();
        cur = nxt; it = nx;
    }
}

struct Row { f32x4 v[4]; };
__device__ __forceinline__ void row_load(Row& r, const float* p, int lane) {
#pragma unroll
    for (int j = 0; j < 4; ++j) r.v[j] = __builtin_nontemporal_load((const f32x4*)(p + 4 * lane + 256 * j));
}
__device__ __forceinline__ void row_load_bf16(Row& r, const bf16_t* p, int lane) {
#pragma unroll
    for (int j = 0; j < 4; ++j) { const u32x2 w = __builtin_nontemporal_load((const u32x2*)(p + 4 * lane + 256 * j)); r.v[j] = (f32x4){bflo(w.x), bfhi(w.x), bflo(w.y), bfhi(w.y)}; }
}
__device__ __forceinline__ void row_store(const Row& r, float* p, int lane) {
#pragma unroll
    for (int j = 0; j < 4; ++j) __builtin_nontemporal_store(r.v[j], (f32x4*)(p + 4 * lane + 256 * j));
}
__device__ __forceinline__ void row_store_bf16(const Row& r, bf16_t* p, int lane) {
#pragma unroll
    for (int j = 0; j < 4; ++j) { u32x2 w; w.x = pk2(r.v[j].x, r.v[j].y); w.y = pk2(r.v[j].z, r.v[j].w); *(u32x2*)(p + 4 * lane + 256 * j) = w; }
}
__device__ __forceinline__ void row_store_bf16_nt(const Row& r, bf16_t* p, int lane) {
#pragma unroll
    for (int j = 0; j < 4; ++j) { u32x2 w; w.x = pk2(r.v[j].x, r.v[j].y); w.y = pk2(r.v[j].z, r.v[j].w); __builtin_nontemporal_store(w, (u32x2*)(p + 4 * lane + 256 * j)); }
}
__device__ __forceinline__ float row_rstd(const Row& r) {
    float s = 0.f;
#pragma unroll
    for (int j = 0; j < 4; ++j) s += (r.v[j].x * r.v[j].x + r.v[j].y * r.v[j].y) + (r.v[j].z * r.v[j].z + r.v[j].w * r.v[j].w);
    return rsqrtf(wave_sum(s) * (1.f / DM) + EPS);
}
__device__ __forceinline__ void row_modnorm(Row& h, const Row& x, const float* gain, const float* sh, const float* sc, int lane) {
    const float r = row_rstd(x);
#pragma unroll
    for (int j = 0; j < 4; ++j) { const int k = 4 * lane + 256 * j; const f32x4 g = *(const f32x4*)(gain + k), a = *(const f32x4*)(sc + k), b = *(const f32x4*)(sh + k);
        h.v[j] = x.v[j] * r * g * (a + 1.f) + b; }
}
__device__ __forceinline__ void hprep_row(CArgs& A, const Frame& F, const Row& x, int l, int row, const float* wl) {
    const int b = row >> 11, lane = F.lane; const float* mod = P_MOD + (size_t)(l * 8 + b) * 6144;
    Row h; row_modnorm(h, x, A.in[I_NPM] + l * DM, mod, mod + 1024, lane);
    if (l == 0) row_store_bf16(h, (bf16_t*)P_HB + (size_t)row * DM, lane);
    else {
#pragma unroll
        for (int j = 0; j < 4; ++j) *(unsigned*)(P_HB + (size_t)row * DM + 4 * lane + 256 * j) = pk8(SC_H * h.v[j].x, SC_H * h.v[j].y, SC_H * h.v[j].z, SC_H * h.v[j].w);
    }
    if (l == 0) {
        float mine = 0.f;
#pragma unroll
        for (int i = 0; i < 8; ++i) { float p = 0.f;
#pragma unroll
            for (int j = 0; j < 4; ++j) { const f32x4 w = *(const f32x4*)(wl + i * 1024 + 4 * lane + 256 * j); p += (h.v[j].x * w.x + h.v[j].y * w.y) + (h.v[j].z * w.z + h.v[j].w * w.w); }
            const float s = wave_sum(p); if (lane == i) mine = s; if ((i & 3) == 3) asm volatile("" ::: "memory"); }
        if (lane < 8) P_LSIG[(size_t)row * 8 + lane] = log_sigmoidf_(mine + A.in[I_FOXB][lane]);
    } else {
        float p[16];
#pragma unroll
        for (int i = 0; i < 16; ++i) { float q = 0.f;
#pragma unroll
            for (int j = 0; j < 4; ++j) { const f32x4 w = *(const f32x4*)(wl + i * 1024 + 4 * lane + 256 * j); q += (h.v[j].x * w.x + h.v[j].y * w.y) + (h.v[j].z * w.z + h.v[j].w * w.w); }
            p[i] = wave_sum(q); if ((i & 1) == 1) asm volatile("" ::: "memory"); }
        const float* wup = wl + 16 * 1024;
#pragma unroll
        for (int q = 0; q < 4; ++q) { const int jcol = lane + 64 * q; float s = wup[16 * 256 + jcol];
#pragma unroll
            for (int i = 0; i < 16; ++i) s += p[i] * wup[i * 256 + jcol];
            P_LOGA[(size_t)row * 256 + jcol] = log_sigmoidf_(s) * (1.f / 16.f); }
    }
}
__device__ __forceinline__ void stage_side(CArgs& A, const Frame& F, int l, float* wl) {
    __syncthreads();
    if (l == 0) { for (int i = F.tid; i < 8 * 256; i += 512) *(f32x4*)(wl + 4 * i) = *(const f32x4*)(P_WSIDE + 4 * i); }
    else { for (int i = F.tid; i < 16 * 256; i += 512) *(f32x4*)(wl + 4 * i) = *(const f32x4*)(P_WSIDE + 8192 + 4 * i);
           for (int i = F.tid; i < 16 * 64; i += 512) *(f32x4*)(wl + 16384 + 4 * i) = *(const f32x4*)(A.in[I_GLAWUP] + 4 * i);
           if (F.tid < 64) *(f32x4*)(wl + 16384 + 4096 + 4 * F.tid) = *(const f32x4*)(A.in[I_GLABG] + 4 * F.tid); }
    __syncthreads();
}
__device__ __forceinline__ void p1_hprep0(CArgs& A, const Frame& F) {
    float* wl = (float*)F.lds; stage_side(A, F, 0, wl);
    const int gw = F.bid * 8 + F.wave, NGW = F.G * 8;
    Row xn; if (gw < NTOK) row_load(xn, A.in[I_X] + (size_t)gw * DM, F.lane);
#pragma unroll 1
    for (int row = gw; row < NTOK; row += NGW) { Row x;
#pragma unroll
        for (int j = 0; j < 4; ++j) x.v[j] = xn.v[j];
        if (row + NGW < NTOK) row_load(xn, A.in[I_X] + (size_t)(row + NGW) * DM, F.lane); hprep_row(A, F, x, 0, row, wl); }
}

__device__ __forceinline__ void p_postmix(CArgs& A, const Frame& F, int l) {
    float* h2s = (float*)F.lds;
    float* red = h2s + 16 * 1028;
    float* lg = red + 8 * 16 * 32;
    float* tv = lg + 16 * 32;
    int* lcnt = (int*)(tv + 64);
    int* ent = lcnt + 64;
    if (F.tid < 32) lcnt[F.tid] = 0;
    int nent = 0;
    const float* rw = A.in[I_RW] + (size_t)l * 1024 * 32;
    u32x2 pm[2][4]; f32x4 pxf[2][4]; u32x2 pxb[2][4];
#define PM_LOAD(tile_) do { const int r0_ = (tile_) * 16 + 2 * F.wave; _Pragma("unroll") for (int rr = 0; rr < 2; ++rr) _Pragma("unroll") for (int j = 0; j < 4; ++j) { \
        pm[rr][j] = __builtin_nontemporal_load((const u32x2*)((const bf16_t*)P_MBUF + (size_t)(r0_ + rr) * DM + 4 * F.lane + 256 * j)); \
        if (l == 0) pxf[rr][j] = __builtin_nontemporal_load((const f32x4*)(A.in[I_X] + (size_t)(r0_ + rr) * DM + 4 * F.lane + 256 * j)); \
        else pxb[rr][j] = __builtin_nontemporal_load((const u32x2*)(P_XB + (size_t)(r0_ + rr) * DM + 4 * F.lane + 256 * j)); } } while (0)
    if (F.bid < NTOK / 16) PM_LOAD(F.bid);
#pragma unroll 1
    for (int tile = F.bid; tile < NTOK / 16; tile += F.G) {
        const int row0 = tile * 16 + 2 * F.wave;
        Row m0, x0, m1, x1;
#pragma unroll
        for (int j = 0; j < 4; ++j) { m0.v[j] = (f32x4){bflo(pm[0][j].x), bfhi(pm[0][j].x), bflo(pm[0][j].y), bfhi(pm[0][j].y)}; m1.v[j] = (f32x4){bflo(pm[1][j].x), bfhi(pm[1][j].x), bflo(pm[1][j].y), bfhi(pm[1][j].y)};
            if (l == 0) { x0.v[j] = pxf[0][j]; x1.v[j] = pxf[1][j]; }
            else { x0.v[j] = (f32x4){bflo(pxb[0][j].x), bfhi(pxb[0][j].x), bflo(pxb[0][j].y), bfhi(pxb[0][j].y)}; x1.v[j] = (f32x4){bflo(pxb[1][j].x), bfhi(pxb[1][j].x), bflo(pxb[1][j].y), bfhi(pxb[1][j].y)}; } }
        if (tile + F.G < NTOK / 16) PM_LOAD(tile + F.G);
#pragma unroll
        for (int rr = 0; rr < 2; ++rr) {
            const int lr = 2 * F.wave + rr, row = row0 + rr, b = row >> 11; const float* mod = P_MOD + (size_t)(l * 8 + b) * 6144;
            const Row& m = rr ? m1 : m0; Row x = rr ? x1 : x0;
            const float r1 = row_rstd(m);
#pragma unroll
            for (int j = 0; j < 4; ++j) { const int k = 4 * F.lane + 256 * j; const f32x4 gp = *(const f32x4*)(A.in[I_NQM] + l * DM + k), g1 = *(const f32x4*)(mod + 2048 + k);
                x.v[j] = x.v[j] + g1 * (m.v[j] * r1 * gp); }
            row_store_bf16_nt(x, P_XB + (size_t)row * DM, F.lane);
            Row h; row_modnorm(h, x, A.in[I_NPF] + l * DM, mod + 3072, mod + 4096, F.lane);
#pragma unroll
            for (int j = 0; j < 4; ++j) *(unsigned*)(P_HB8 + (size_t)row * DM + 4 * F.lane + 256 * j) = pk8(SC_H * h.v[j].x, SC_H * h.v[j].y, SC_H * h.v[j].z, SC_H * h.v[j].w);
#pragma unroll
            for (int j = 0; j < 4; ++j) *(f32x4*)(h2s + lr * 1028 + 4 * F.lane + 256 * j) = h.v[j];
        }
        __syncthreads();
        {
            f32x4 d0 = {0.f, 0.f, 0.f, 0.f}, d1 = {0.f, 0.f, 0.f, 0.f};
            const int r16 = F.lane & 15, kq = F.lane >> 4;
#pragma unroll 8
            for (int ks = 0; ks < 32; ++ks) { const int k = 128 * F.wave + 4 * ks + kq;
                const float a = h2s[r16 * 1028 + k]; const float b0 = rw[k * 32 + r16], b1 = rw[k * 32 + 16 + r16];
                d0 = __builtin_amdgcn_mfma_f32_16x16x4f32(a, b0, d0, 0, 0, 0); d1 = __builtin_amdgcn_mfma_f32_16x16x4f32(a, b1, d1, 0, 0, 0); }
#pragma unroll
            for (int q = 0; q < 4; ++q) { red[(F.wave * 16 + 4 * kq + q) * 32 + r16] = d0[q]; red[(F.wave * 16 + 4 * kq + q) * 32 + 16 + r16] = d1[q]; }
        }
        __syncthreads();
        const int r = F.tid >> 5, e = F.tid & 31;
        { float s = A.in[I_RB][l * 32 + e];
#pragma unroll
          for (int w8 = 0; w8 < 8; ++w8) s += red[(w8 * 16 + r) * 32 + e];
          lg[r * 32 + e] = s; }
        __syncthreads();
        const float v = lg[r * 32 + e]; int rank = 0;
#pragma unroll 8
        for (int q = 0; q < 32; ++q) { const float u = lg[r * 32 + q]; rank += (u > v || (u == v && q < e)) ? 1 : 0; }
        if (rank < 4) tv[r * 4 + rank] = v;
        __syncthreads();
        if (rank < 4) { const f32x4 t4 = *(const f32x4*)(tv + r * 4);
            const float wsum = 1.f + __expf(t4.y - t4.x) + __expf(t4.z - t4.x) + __expf(t4.w - t4.x), wk = __expf(v - t4.x);
            const int token = tile * 16 + r, lpos = atomicAdd(lcnt + e, 1), slot = nent + r * 4 + rank;
            ent[slot * 4] = e; ent[slot * 4 + 1] = lpos; ent[slot * 4 + 2] = token * 4 + rank; ent[slot * 4 + 3] = __float_as_int(wk / wsum); }
        nent += 64;
        __syncthreads();
    }
#undef PM_LOAD
    unsigned* cntp = P_CNT; int* ltk = P_LTK; float* lgp = P_LG;
    if (F.tid < 32) { const int n = lcnt[F.tid]; lcnt[32 + F.tid] = n > 0 ? (int)atomicAdd(cntp + 64 * (l * 32 + F.tid), (unsigned)n) : 0; }
    __syncthreads();
    if (F.tid < nent) { const int e = ent[F.tid * 4], pos = lcnt[32 + e] + ent[F.tid * 4 + 1];
        ltk[(size_t)(l * 32 + e) * LISTCAP + pos] = ent[F.tid * 4 + 2]; lgp[(size_t)(l * 32 + e) * LISTCAP + pos] = __int_as_float(ent[F.tid * 4 + 3]); }
    __syncthreads();
}
__device__ __forceinline__ void p_combine(CArgs& A, const Frame& F, int l) {
    float* wl = (float*)F.lds; if (l == 0) stage_side(A, F, 1, wl);
    const int gw = F.bid * 8 + F.wave, NGW = F.G * 8;
    unsigned y[4][4]; Row xr;
#define COMB_LOAD(row_) do { _Pragma("unroll") for (int k = 0; k < 4; ++k) _Pragma("unroll") for (int j = 0; j < 4; ++j) y[k][j] = __builtin_nontemporal_load((const unsigned*)(P_Y + (size_t)((row_) * 4 + k) * DM + 4 * F.lane + 256 * j)); \
        row_load_bf16(xr, P_XB + (size_t)(row_) * DM, F.lane); } while (0)
    if (gw < NTOK) COMB_LOAD(gw);
#pragma unroll 1
    for (int row = gw; row < NTOK; row += NGW) {
        const int b = row >> 11; const float* mod = P_MOD + (size_t)(l * 8 + b) * 6144;
        Row f;
#pragma unroll
        for (int j = 0; j < 4; ++j) { f.v[j] = (f32x4){0.f, 0.f, 0.f, 0.f};
#pragma unroll
            for (int k = 0; k < 4; ++k) { const f32x2 lo = __builtin_amdgcn_cvt_pk_f32_fp8((int)y[k][j], false), hi = __builtin_amdgcn_cvt_pk_f32_fp8((int)y[k][j], true); f.v[j].x += lo.x; f.v[j].y += lo.y; f.v[j].z += hi.x; f.v[j].w += hi.y; }
            f.v[j] = f.v[j] * (1.f / SC_Y); }
        Row x = xr;
        if (row + NGW < NTOK) COMB_LOAD(row + NGW);
        const float r = row_rstd(f);
#pragma unroll
        for (int j = 0; j < 4; ++j) { const int k = 4 * F.lane + 256 * j; const f32x4 gp = *(const f32x4*)(A.in[I_NQF] + l * DM + k), g2 = *(const f32x4*)(mod + 5120 + k);
            x.v[j] = x.v[j] + g2 * (f.v[j] * r * gp); }
        if (l == 0) row_store_bf16_nt(x, P_XB + (size_t)row * DM, F.lane); else row_store(x, A.out + (size_t)row * DM, F.lane);
        if (l == 0) hprep_row(A, F, x, 1, row, wl);
    }
#undef COMB_LOAD
}
__device__ __forceinline__ int moe_tables(CArgs& A, const Frame& F, int l, LAS pg8::MoeTables* tb) {
    __syncthreads();
    if (F.tid < 32) tb->cnt[F.tid] = (int)__hip_atomic_load(P_CNT + 64 * (l * 32 + F.tid), __ATOMIC_RELAXED, __HIP_MEMORY_SCOPE_AGENT);
    __syncthreads();
    if (F.tid == 0) { int s = 0;
#pragma nounroll
        for (int e = 0; e < 32; ++e) { tb->mtstart[e] = s; s += (tb->cnt[e] + 255) >> 8; }
        tb->mtstart[32] = s; }
    __syncthreads();
    if (F.tid < 320) { int e = 0;
#pragma nounroll
        for (int q = 1; q < 32; ++q) if (tb->mtstart[q] <= F.tid) e = q;
        tb->tile_e[F.tid] = (unsigned char)e; }
    __syncthreads();
    return tb->mtstart[32];
}
__device__ __forceinline__ void fox_kbias(CArgs& A, const Frame& F, int b, int h, float* kb, float* wtot  ) {
    const int t0 = 4 * F.tid; float e[4];
#pragma unroll
    for (int i = 0; i < 4; ++i) e[i] = P_LSIG[(size_t)(b * SEQ + t0 + i) * 8 + h];
    const float s4 = (e[0] + e[1]) + (e[2] + e[3]); float v = s4;
#pragma unroll
    for (int o = 1; o < 64; o <<= 1) { const float tt = __shfl_up(v, o); if (F.lane >= o) v += tt; }
    if (F.lane == 63) wtot[F.wave] = v;
    __syncthreads();
    float off = 0.f;
#pragma unroll
    for (int w = 0; w < 8; ++w) if (w < F.wave) off += wtot[w];
    float c = off + v - s4;
#pragma unroll
    for (int i = 0; i < 4; ++i) { c += e[i]; kb[t0 + i] = -LOG2E * c; }
    __syncthreads();
}
#include <hip/hip_bf16.h>
namespace attn_body {
using bf16=__hip_bfloat16;
using bf16x8=__attribute__((ext_vector_type(8)))short;
using s16x4=__attribute__((ext_vector_type(4)))short;
using f32x16=__attribute__((ext_vector_type(16)))float;
using u32x4=__attribute__((ext_vector_type(4)))unsigned;
constexpr int BATCH=8,NHEAD=8,SEQ=2048,D=64,QP=2048,OP=1024;
constexpr int NW=8,QBLK=32,QB=QBLK*NW,KVBLK=64,NQB=SEQ/QB;
constexpr int ATTN_UNIT_ROWS=QB;
__device__ __forceinline__ int crow(int r,int hi){return (r&3)+8*(r>>2)+4*hi;}
#define SBAR() __builtin_amdgcn_sched_barrier(0)
__device__ __forceinline__ void cmask(f32x16&p0,f32x16&p1,int jb,int qrel,int hi){
  const float NEG=-INFINITY; int kb=64*jb+4*hi;
  #pragma unroll
  for(int r=0;r<16;++r){int kv=kb+(r&3)+8*(r>>2); if(kv>qrel)p0[r]=NEG; if(kv+32>qrel)p1[r]=NEG;}
}

constexpr int NSLOT=3, SLOTB=8192;
constexpr int LDS_K=0, LDS_V=NSLOT*SLOTB, LDS_WS=2*NSLOT*SLOTB, LDS_OST=LDS_WS+NW*64*4, LDS_BYTES=LDS_OST+NW*4096;
constexpr float C2=0.125f*1.4426950408889634f;
__device__ __forceinline__ void glds16(const void*gsrc,unsigned lds_dst){unsigned keep;
  asm volatile("s_mov_b32 %0, m0\n\ts_mov_b32 m0, %2\n\ts_nop 0\n\tglobal_load_lds_dwordx4 %1, off\n\ts_mov_b32 m0, %0":"=&s"(keep):"v"(gsrc),"s"(lds_dst):"memory");}
__device__ __forceinline__ float max3f(float a,float b,float c){float r;asm("v_max3_f32 %0, %1, %2, %3":"=v"(r):"v"(a),"v"(b),"v"(c));return r;}
__device__ __forceinline__ float max2f(float a,float b){float r;asm("v_max_f32_e32 %0, %1, %2":"=v"(r):"v"(a),"v"(b));return r;}
__device__ __forceinline__ float fadd_s(float a,float b){float r;asm("v_add_f32_e32 %0, %1, %2":"=v"(r):"v"(a),"v"(b));return r;}
__device__ __forceinline__ float fsub_s(float a,float b){float r;asm("v_sub_f32_e32 %0, %1, %2":"=v"(r):"v"(a),"v"(b));return r;}
typedef float f32x2_t __attribute__((ext_vector_type(2))); typedef float f32x4_t __attribute__((ext_vector_type(4))); typedef __bf16 bf16x2_t __attribute__((ext_vector_type(2)));
__device__ __forceinline__ unsigned cvtpk_s(float lo,float hi){f32x2_t v={lo,hi};bf16x2_t b=__builtin_convertvector(v,bf16x2_t);return __builtin_bit_cast(unsigned,b);}
#define WAIT_BAR(N) asm volatile("s_waitcnt vmcnt(" #N ") lgkmcnt(0)\n\ts_barrier":::"memory")

__device__ __forceinline__ void qkt(f32x16&p0,f32x16&p1,const char*Kslot,const bf16x8*qr,const f32x16&c0i,const f32x16&c1i,int r32,int hi){
  const char*kb=Kslot+hi*1024+r32*16;
  #pragma unroll
  for(int d0=0;d0<4;++d0){
    const bf16x8 b0=*reinterpret_cast<const bf16x8*>(kb+d0*2048);
    const bf16x8 b1=*reinterpret_cast<const bf16x8*>(kb+d0*2048+512);
    if(d0==0){p0=__builtin_amdgcn_mfma_f32_32x32x16_bf16(b0,qr[0],c0i,0,0,0);p1=__builtin_amdgcn_mfma_f32_32x32x16_bf16(b1,qr[0],c1i,0,0,0);}
    else{p0=__builtin_amdgcn_mfma_f32_32x32x16_bf16(b0,qr[d0],p0,0,0,0);p1=__builtin_amdgcn_mfma_f32_32x32x16_bf16(b1,qr[d0],p1,0,0,0);}}
}
typedef __attribute__((address_space(3))) const char* lds_cptr;
typedef short v4i16_t __attribute__((ext_vector_type(4)));
__device__ __forceinline__ void kload8(bf16x8*kf,lds_cptr kp){
  kf[0]=*(const __attribute__((address_space(3))) bf16x8*)(kp);      kf[1]=*(const __attribute__((address_space(3))) bf16x8*)(kp+512);
  kf[2]=*(const __attribute__((address_space(3))) bf16x8*)(kp+2048); kf[3]=*(const __attribute__((address_space(3))) bf16x8*)(kp+2560);
  kf[4]=*(const __attribute__((address_space(3))) bf16x8*)(kp+4096); kf[5]=*(const __attribute__((address_space(3))) bf16x8*)(kp+4608);
  kf[6]=*(const __attribute__((address_space(3))) bf16x8*)(kp+6144); kf[7]=*(const __attribute__((address_space(3))) bf16x8*)(kp+6656);
}
__device__ __forceinline__ void kload2(bf16x8*kf,lds_cptr kp,int j){ kf[2*j]=*(const __attribute__((address_space(3))) bf16x8*)(kp+j*2048); kf[2*j+1]=*(const __attribute__((address_space(3))) bf16x8*)(kp+j*2048+512); }
__device__ __forceinline__ s16x4 vtr(lds_cptr p){ return __builtin_bit_cast(s16x4,__builtin_amdgcn_ds_read_tr16_b64_v4i16((__attribute__((address_space(3))) v4i16_t*)p)); }
__device__ __forceinline__ float rowmax(const f32x16&p0,const f32x16&p1){
  float a=max3f(p0[0],p0[1],p1[0]),b=max3f(p0[2],p0[3],p1[1]);a=max3f(a,p1[2],p1[3]);
  #pragma unroll
  for(int r=4;r<16;r+=4){a=max3f(a,p0[r],p0[r+1]);b=max3f(b,p0[r+2],p0[r+3]);a=max3f(a,p1[r],p1[r+1]);b=max3f(b,p1[r+2],p1[r+3]);}
  const float m=max2f(a,b);
  auto rr=__builtin_amdgcn_permlane32_swap(__float_as_uint(m),__float_as_uint(m),false,false);
  return max2f(__uint_as_float(rr[0]),__uint_as_float(rr[1]));
}
__device__ __forceinline__ void pv(f32x16*o,int vb,bf16x8 pa0,bf16x8 pa1,bf16x8 pa2,bf16x8 pa3){
  #pragma unroll
  for(int d0=0;d0<2;++d0){s16x4 lo[4],hi[4];
    #pragma unroll
    for(int ks=0;ks<4;++ks){
      asm volatile("ds_read_b64_tr_b16 %0,%1 offset:%c2":"=&v"(lo[ks]):"v"(vb),"i"(d0*4096+ks*1024):"memory");
      asm volatile("ds_read_b64_tr_b16 %0,%1 offset:%c2":"=&v"(hi[ks]):"v"(vb),"i"(d0*4096+ks*1024+512):"memory");}
    asm volatile("s_waitcnt lgkmcnt(0)":::"memory");SBAR();
    #define PK(k) (bf16x8){lo[k][0],lo[k][1],lo[k][2],lo[k][3],hi[k][0],hi[k][1],hi[k][2],hi[k][3]}
    o[d0]=__builtin_amdgcn_mfma_f32_32x32x16_bf16(pa0,PK(0),o[d0],0,0,0);
    o[d0]=__builtin_amdgcn_mfma_f32_32x32x16_bf16(pa1,PK(1),o[d0],0,0,0);
    o[d0]=__builtin_amdgcn_mfma_f32_32x32x16_bf16(pa2,PK(2),o[d0],0,0,0);
    o[d0]=__builtin_amdgcn_mfma_f32_32x32x16_bf16(pa3,PK(3),o[d0],0,0,0);
    #undef PK
  }
}

#ifndef ATTN_STORE16
#define ATTN_STORE16(p,v) (*(u32x4*)(p)=(v))
#endif
typedef const __attribute__((address_space(3))) float* lds_fptr;
template<int THRL> __device__ __forceinline__ void attn_unit(int b,int h,int qb,const bf16*Q,const bf16*__restrict__ K,const bf16*__restrict__ V,bf16*O,char*shm,lds_fptr kb,int tid,int wid){
  const int lane=tid&63,r32=lane&31,hi=lane>>5;
  const long rowbase=(long)b*SEQ; const int q0=qb*QB;
  const bf16*Qw=Q+(rowbase+q0+wid*QBLK)*QP+h*D;
  const bf16*Kh=K+rowbase*QP+h*D,*Vh=V+rowbase*QP+h*D;
  const unsigned lds0=(unsigned)(uintptr_t)shm;
  float*wsf=(float*)(shm+LDS_WS)+wid*64;
  const bf16*ksrc=Kh+(long)lane*QP+wid*8;
  const bf16*vsrc=Vh+(long)(16*(wid&3)+(lane>>2))*QP+(wid>>2)*32+(lane&3)*8;
  const unsigned kdst=lds0+LDS_K+wid*1024, vdst=lds0+LDS_V+wid*1024;
  #define DMA_K(t,slot) glds16(ksrc+(long)(t)*KVBLK*QP,(unsigned)__builtin_amdgcn_readfirstlane(kdst+(slot)))
  #define DMA_V(t,slot) glds16(vsrc+(long)(t)*KVBLK*QP,(unsigned)__builtin_amdgcn_readfirstlane(vdst+(slot)))
  const int vb0=(int)(lds0+LDS_V)+((lane>>4)&1)*32+(lane&3)*8+(4*hi+((lane&15)>>2))*64;
  const char*Kbase=shm+LDS_K; bf16x8 kf[8];
  const lds_cptr shm3=(lds_cptr)shm; const lds_cptr kp0=shm3+LDS_K+hi*1024+r32*16; const lds_cptr vp0=shm3+LDS_V+((lane>>4)&1)*32+(lane&3)*8+(4*hi+((lane&15)>>2))*64;
  const int NT=(q0+QB)/KVBLK;
  DMA_K(0,0);DMA_V(0,0);DMA_K(1,SLOTB);
  bf16x8 qr[4];
  #pragma unroll
  for(int d0=0;d0<4;++d0)qr[d0]=*reinterpret_cast<const bf16x8*>(&Qw[(long)r32*QP+d0*16+hi*8]);
  float mhat=0.f,l_reg=0.f;f32x16 o[2];o[0]=f32x16{};o[1]=f32x16{};float nm=0.f;
  #define BIASFILL(C0,C1,t) do{ const lds_fptr kbt_=kb+64*(t)+4*hi; _Pragma("unroll") for(int g_=0;g_<4;++g_){ const f32x4_t v0_=*(const __attribute__((address_space(3))) f32x4_t*)(kbt_+8*g_), v1_=*(const __attribute__((address_space(3))) f32x4_t*)(kbt_+32+8*g_); \
      _Pragma("unroll") for(int i_=0;i_<4;++i_){ C0[4*g_+i_]=v0_[i_]+nm; C1[4*g_+i_]=v1_[i_]+nm; } } }while(0)
  const int qrel=wid*QBLK+r32;
  #define CMASK(P0,P1,t) do{int jb_=(t)-(NT-4); if(jb_>=0)cmask(P0,P1,jb_,qrel,hi);}while(0)
  bool resc=false;
  #define START(P0,P1) do{ const float rm=rowmax(P0,P1); resc=false; \
    { const float dl=rm; mhat=fadd_s(mhat,dl); \
      _Pragma("unroll") for(int r=0;r<16;++r){P0[r]=fsub_s(P0[r],dl);P1[r]=fsub_s(P1[r],dl);} \
      nm=-mhat; } \
    _Pragma("unroll") for(int r=0;r<16;++r)P0[r]=__builtin_amdgcn_exp2f(P0[r]); }while(0)
  #define RESC() do{ if(resc){ asm volatile("s_waitcnt lgkmcnt(0)":::"memory"); \
      _Pragma("unroll") for(int d_=0;d_<2;++d_) _Pragma("unroll") for(int r=0;r<16;++r)o[d_][r]*=wsf[crow(r,hi)]; } }while(0)
  f32x16 pA0,pA1,pB0,pB1;
  int sl_prev=0,sl_cur=0,sl_next=SLOTB;
  #define ROT() do{sl_prev=sl_cur;sl_cur=sl_next;sl_next=(sl_next==(NSLOT-1)*SLOTB)?0:sl_next+SLOTB;}while(0)
  DMA_K(2,2*SLOTB);
  WAIT_BAR(3);
  { f32x16 c0i,c1i; BIASFILL(c0i,c1i,0); qkt(pA0,pA1,Kbase,qr,c0i,c1i,r32,hi); }asm volatile("s_nop 15\n\ts_nop 7":"+v"(pA0),"+v"(pA1));CMASK(pA0,pA1,0);
  START(pA0,pA1);
  _Pragma("unroll") for(int r=0;r<16;++r)pA1[r]=__builtin_amdgcn_exp2f(pA1[r]);
  WAIT_BAR(0);
  DMA_K(3,0);DMA_V(1,SLOTB);
  ROT();
  kload8(kf,kp0+sl_cur);
  WAIT_BAR(2);
  s16x4 vlo[8],vhi[8]; u32x4 pw0,pw1,pw2,pw3;
  #define PKW(P,B) cvtpk_s(P[B],P[B+1])
  #define PAF(k) __builtin_bit_cast(bf16x8,pw##k)
  #define VFR(i) (bf16x8){vlo[i][0],vlo[i][1],vlo[i][2],vlo[i][3],vhi[i][0],vhi[i][1],vhi[i][2],vhi[i][3]}
  #define PIN(x) asm volatile("":"+v"(x))
  #define MX3(a,b,c) __builtin_fmaxf(__builtin_fmaxf((a),(b)),(c))
  #define GAPA(MF,A0,A1,A2,A3,W0,W1,PW) do{ MF; sacc+=A0; sacc+=A1; sacc+=A2; sacc+=A3; PIN(sacc); W0; W1; PIN(PW); SBAR(); }while(0)
  #define EX(v) __builtin_amdgcn_exp2f(v)
  #define GAPB(MF,X,B) do{ MF; X[B]=EX(X[B]); X[B+1]=EX(X[B+1]); X[B+2]=EX(X[B+2]); X[B+3]=EX(X[B+3]); PIN(X); SBAR(); }while(0)
  #define VRD(i) do{ vlo[i]=vtr(vp_+(((i)>>2)*4096+((i)&3)*1024)); vhi[i]=vtr(vp_+(((i)>>2)*4096+((i)&3)*1024+512)); }while(0)
  #define KRD(G,j) do{ if(G){ kload2(kf,kp0+sl_next,j); SBAR(); } }while(0)
  #define STEP(C0,C1,P0,P1,t,GK,GV,GL) do{ SBAR(); BIASFILL(C0,C1,t); SBAR(); \
    const lds_cptr vp_=vp0+sl_prev; \
    VRD(0); SBAR(); float sacc=(P0[0]+P0[1]); \
    GAPA(C0=__builtin_amdgcn_mfma_f32_32x32x16_bf16(kf[0],qr[0],C0,0,0,0), P0[2],P0[3],P0[4],P0[5],     pw0[0]=PKW(P0,0), pw0[1]=PKW(P0,2), pw0); \
    VRD(4); SBAR(); GAPA(C1=__builtin_amdgcn_mfma_f32_32x32x16_bf16(kf[1],qr[0],C1,0,0,0), P0[6],P0[7],P0[8],P0[9],     pw0[2]=PKW(P0,4), pw0[3]=PKW(P0,6), pw0); \
    VRD(1); SBAR(); GAPA(C0=__builtin_amdgcn_mfma_f32_32x32x16_bf16(kf[2],qr[1],C0,0,0,0),   P0[10],P0[11],P0[12],P0[13], pw1[0]=PKW(P0,8), pw1[1]=PKW(P0,10), pw1); \
    VRD(5); SBAR(); GAPA(C1=__builtin_amdgcn_mfma_f32_32x32x16_bf16(kf[3],qr[1],C1,0,0,0),   P0[14],P0[15],P1[0],P1[1],   pw1[2]=PKW(P0,12),pw1[3]=PKW(P0,14), pw1); \
    VRD(2); SBAR(); GAPA(C0=__builtin_amdgcn_mfma_f32_32x32x16_bf16(kf[4],qr[2],C0,0,0,0),   P1[2],P1[3],P1[4],P1[5],     pw2[0]=PKW(P1,0), pw2[1]=PKW(P1,2), pw2); \
    VRD(6); SBAR(); GAPA(C1=__builtin_amdgcn_mfma_f32_32x32x16_bf16(kf[5],qr[2],C1,0,0,0),   P1[6],P1[7],P1[8],P1[9],     pw2[2]=PKW(P1,4), pw2[3]=PKW(P1,6), pw2); \
    VRD(3); SBAR(); GAPA(C0=__builtin_amdgcn_mfma_f32_32x32x16_bf16(kf[6],qr[3],C0,0,0,0),   P1[10],P1[11],P1[12],P1[13], pw3[0]=PKW(P1,8), pw3[1]=PKW(P1,10), pw3); \
    VRD(7); SBAR(); GAPA(C1=__builtin_amdgcn_mfma_f32_32x32x16_bf16(kf[7],qr[3],C1,0,0,0),   P1[14],P1[15],0.f,0.f,       pw3[2]=PKW(P1,12),pw3[3]=PKW(P1,14), pw3); \
    l_reg+=sacc; \
    if(GK){DMA_K((t)+3,sl_cur);} if(GV){DMA_V((t)+1,sl_next);} \
    CMASK(C0,C1,t); \
    { float a=MX3(C0[0],C0[1],C1[0]),b=MX3(C0[2],C0[3],C1[1]); a=MX3(a,C1[2],C1[3]); \
      _Pragma("unroll") for(int r=4;r<16;r+=4){a=MX3(a,C0[r],C0[r+1]);b=MX3(b,C0[r+2],C0[r+3]);a=MX3(a,C1[r],C1[r+1]);b=MX3(b,C1[r+2],C1[r+3]);} \
      float rm=__builtin_fmaxf(a,b); { auto rr=__builtin_amdgcn_permlane32_swap(__float_as_uint(rm),__float_as_uint(rm),false,false); rm=__builtin_fmaxf(__uint_as_float(rr[0]),__uint_as_float(rr[1])); } \
      resc=false; \
      if(__builtin_expect(__any(rm>(float)THRL),0)){ const float dl=__builtin_fmaxf(rm,0.f); mhat+=dl; \
        _Pragma("unroll") for(int r=0;r<16;++r){C0[r]-=dl;C1[r]-=dl;} \
        nm=-mhat; \
        const float f=__builtin_amdgcn_exp2f(-dl); l_reg*=f; if(hi==0)wsf[r32]=f; resc=true; } } \
    SBAR(); \
    GAPB(o[0]=__builtin_amdgcn_mfma_f32_32x32x16_bf16(PAF(0),VFR(0),o[0],0,0,0), C0,0); \
    GAPB(o[1]=__builtin_amdgcn_mfma_f32_32x32x16_bf16(PAF(0),VFR(4),o[1],0,0,0), C0,4); \
    KRD(GL,0); GAPB(o[0]=__builtin_amdgcn_mfma_f32_32x32x16_bf16(PAF(1),VFR(1),o[0],0,0,0), C0,8); \
    KRD(GL,1); GAPB(o[1]=__builtin_amdgcn_mfma_f32_32x32x16_bf16(PAF(1),VFR(5),o[1],0,0,0), C0,12); \
    KRD(GL,2); GAPB(o[0]=__builtin_amdgcn_mfma_f32_32x32x16_bf16(PAF(2),VFR(2),o[0],0,0,0), C1,0); \
    KRD(GL,3); GAPB(o[1]=__builtin_amdgcn_mfma_f32_32x32x16_bf16(PAF(2),VFR(6),o[1],0,0,0), C1,4); \
    GAPB(o[0]=__builtin_amdgcn_mfma_f32_32x32x16_bf16(PAF(3),VFR(3),o[0],0,0,0), C1,8); \
    GAPB(o[1]=__builtin_amdgcn_mfma_f32_32x32x16_bf16(PAF(3),VFR(7),o[1],0,0,0), C1,12); \
    }while(0)
  int t=1;
  #undef CMASK
  #define CMASK(P0,P1,t) do{}while(0)
  for(;t+5<NT;t+=2){
    STEP(pB0,pB1,pA0,pA1,t,true,true,true);     WAIT_BAR(2); RESC(); ROT();
    STEP(pA0,pA1,pB0,pB1,t+1,true,true,true);   WAIT_BAR(2); RESC(); ROT();
  }
  #undef CMASK
  #define CMASK(P0,P1,t) do{int jb_=(t)-(NT-4); if(jb_>=0)cmask(P0,P1,jb_,qrel,hi);}while(0)
  #define ENDW(tt) do{ if((tt)+3<NT){WAIT_BAR(2);} else if((tt)+2<NT){WAIT_BAR(1);} else {WAIT_BAR(0);} }while(0)
  for(;t+1<NT;t+=2){
    STEP(pB0,pB1,pA0,pA1,t,(t+3<NT),(t+1<NT),(t+1<NT));       ENDW(t);   RESC(); ROT();
    STEP(pA0,pA1,pB0,pB1,t+1,(t+4<NT),(t+2<NT),(t+2<NT));     ENDW(t+1); RESC(); ROT();
  }
  STEP(pB0,pB1,pA0,pA1,NT-1,false,false,false); RESC();
  { float sacc=pB0[0]+pB0[1]; _Pragma("unroll") for(int r=2;r<16;++r)sacc+=pB0[r]; _Pragma("unroll") for(int r=0;r<16;++r)sacc+=pB1[r]; l_reg+=sacc;
    pw0=(u32x4){PKW(pB0,0),PKW(pB0,2),PKW(pB0,4),PKW(pB0,6)};pw1=(u32x4){PKW(pB0,8),PKW(pB0,10),PKW(pB0,12),PKW(pB0,14)};pw2=(u32x4){PKW(pB1,0),PKW(pB1,2),PKW(pB1,4),PKW(pB1,6)};pw3=(u32x4){PKW(pB1,8),PKW(pB1,10),PKW(pB1,12),PKW(pB1,14)};
    SBAR(); pv(o,vb0+sl_cur,PAF(0),PAF(1),PAF(2),PAF(3)); }
  #undef PKW
  #undef PAF
  #undef VFR
  #undef PIN
  #undef MX3
  #undef GAPA
  #undef GAPB
  #undef EX
  #undef VRD
  #undef KRD
  #undef STEP
  #undef ENDW
  {auto rr=__builtin_amdgcn_permlane32_swap(__float_as_uint(l_reg),__float_as_uint(l_reg),false,false);l_reg=__uint_as_float(rr[0])+__uint_as_float(rr[1]);}
  if(hi==0)wsf[32+r32]=l_reg;asm volatile("s_waitcnt lgkmcnt(0)":::"memory");
  float rli[16];
  #pragma unroll
  for(int r=0;r<16;++r)rli[r]=__builtin_amdgcn_rcpf(wsf[32+crow(r,hi)]);
  bf16*Ow=O+(rowbase+q0+wid*QBLK)*OP+h*D;
  { bf16*stg=(bf16*)(shm+LDS_OST)+wid*2048;
    #pragma unroll
    for(int r=0;r<16;++r){const int orow=crow(r,hi);
      #pragma unroll
      for(int d0=0;d0<2;++d0)stg[orow*64+d0*32+r32]=__float2bfloat16(o[d0][r]*rli[r]);}
    asm volatile("s_waitcnt lgkmcnt(0)":::"memory");
    #pragma unroll
    for(int i=0;i<4;++i){const int row=i*8+(lane>>3),ch=lane&7; const u32x4 v=*(const u32x4*)(stg+row*64+ch*8); ATTN_STORE16(Ow+(long)row*OP+ch*8,v);} }
  asm volatile("s_waitcnt lgkmcnt(0)\n\ts_barrier":::"memory");
  #undef DMA_K
  #undef DMA_V
  #undef CMASK
  #undef START
  #undef RESC
  #undef ROT
  #undef BIASFILL
}
constexpr int ATTN_LDS_BYTES=LDS_BYTES;
#undef SBAR
#undef WAIT_BAR
}
__device__ __forceinline__ void fox_fast(CArgs& A, const Frame& F) {
    float* kb = (float*)(F.lds + 86016); float* wtot = kb + 2048;
    const int v = (F.bid & 7) * 32 + (F.bid >> 3), bh = v >> 2, s = v & 3, b = bh >> 3, h = bh & 7;
    fox_kbias(A, F, b, h, kb, wtot);
    const attn_body::bf16* Zb = (const attn_body::bf16*)P_Z;
    const attn_body::lds_fptr kb3 = (attn_body::lds_fptr)(const __attribute__((address_space(3))) unsigned char*)((LAS unsigned char*)F.lds + 86016);
    attn_body::attn_unit<8>(b, h, 7 - s, Zb + 512, Zb + 1024, Zb + 1536, (attn_body::bf16*)P_YCAT + 512, (char*)F.lds, kb3, F.tid, F.wave);
    attn_body::attn_unit<8>(b, h, s, Zb + 512, Zb + 1024, Zb + 1536, (attn_body::bf16*)P_YCAT + 512, (char*)F.lds, kb3, F.tid, F.wave);
}
typedef float f32x16 __attribute__((ext_vector_type(16)));
__device__ __forceinline__ bf16x8 pack8(const f32x4& a, const f32x4& b) { u32x4 w; w.x = pk2(a.x, a.y); w.y = pk2(a.z, a.w); w.z = pk2(b.x, b.y); w.w = pk2(b.z, b.w); return __builtin_bit_cast(bf16x8, w); }
__device__ __forceinline__ void s5_fast(CArgs& A, const Frame& F, int item) {
    const int b = item >> 5, g = item & 31, lane = F.lane, w = F.wave, p = lane & 31, hh = lane >> 5, l15 = lane & 15, l4 = lane >> 4;
    float* Eseg = (float*)F.lds; float* Hin = Eseg + 2048;
    bf16_t* Hs = (bf16_t*)(F.lds + 16384) + w * 4352;
    bf16x8 bbr[2], bbi[2]; float are[2], aim[2];
#pragma unroll
    for (int nt = 0; nt < 2; ++nt) { const float* q = P_S5BB + (size_t)(g * 64 + 32 * nt + p) * 32 + 8 * hh;
        bbr[nt] = pack8(*(const f32x4*)q, *(const f32x4*)(q + 4)); bbi[nt] = pack8(*(const f32x4*)(q + 16), *(const f32x4*)(q + 20));
        are[nt] = P_S5A[(g * 64 + 32 * nt + p) * 2]; aim[nt] = P_S5A[(g * 64 + 32 * nt + p) * 2 + 1]; }
    const int rr = lane & 31, ahalf = (rr >> 2) & 1, atau = (rr & 3) + 4 * (rr >> 3);
    const bf16_t* usrc = P_Z + (size_t)(b * SEQ + 128 * (2 * w + ahalf) + atau) * ZP0 + g * 16 + 8 * hh;
    const f32x16 zero16 = {0.f, 0.f, 0.f, 0.f, 0.f, 0.f, 0.f, 0.f, 0.f, 0.f, 0.f, 0.f, 0.f, 0.f, 0.f, 0.f};
    float hr[2] = {0.f, 0.f}, hi[2] = {0.f, 0.f};
#define S5_ALOAD(blk_) (*(const bf16x8*)(usrc + (size_t)(blk_) * 16 * ZP0))
    { bf16x8 a0 = S5_ALOAD(0), a1 = S5_ALOAD(1), a2 = S5_ALOAD(2);
#pragma unroll 1
      for (int blk = 0; blk < 8; ++blk) {
        const bf16x8 a = a0; a0 = a1; a1 = a2; if (blk + 3 < 8) a2 = S5_ALOAD(blk + 3);
#pragma unroll
        for (int nt = 0; nt < 2; ++nt) {
            const f32x16 dre = __builtin_amdgcn_mfma_f32_32x32x16_bf16(a, bbr[nt], zero16, 0, 0, 0), dim = __builtin_amdgcn_mfma_f32_32x32x16_bf16(a, bbi[nt], zero16, 0, 0, 0);
#pragma unroll
            for (int i = 0; i < 16; ++i) { const float nr = are[nt] * hr[nt] - aim[nt] * hi[nt] + dre[i], ni = are[nt] * hi[nt] + aim[nt] * hr[nt] + dim[i]; hr[nt] = nr; hi[nt] = ni; }
        }
      } }
#pragma unroll
    for (int nt = 0; nt < 2; ++nt) { Eseg[((2 * w + hh) * 64 + 32 * nt + p) * 2] = hr[nt]; Eseg[((2 * w + hh) * 64 + 32 * nt + p) * 2 + 1] = hi[nt]; }
    __syncthreads();
    if (w == 0) {
        float xr = P_S5A[(g * 64 + lane) * 2], xi = P_S5A[(g * 64 + lane) * 2 + 1];
#pragma unroll
        for (int q = 0; q < 7; ++q) { const float nr = xr * xr - xi * xi, ni = 2.f * xr * xi; xr = nr; xi = ni; }
        float Hr = 0.f, Hi = 0.f;
#pragma unroll 1
        for (int s = 0; s < 16; ++s) { Hin[(s * 64 + lane) * 2] = Hr; Hin[(s * 64 + lane) * 2 + 1] = Hi;
            const float er = Eseg[(s * 64 + lane) * 2], ei = Eseg[(s * 64 + lane) * 2 + 1]; const float nr = xr * Hr - xi * Hi + er, ni = xr * Hi + xi * Hr + ei; Hr = nr; Hi = ni; }
    }
    __syncthreads();
#pragma unroll
    for (int nt = 0; nt < 2; ++nt) { hr[nt] = Hin[((2 * w + hh) * 64 + 32 * nt + p) * 2]; hi[nt] = Hin[((2 * w + hh) * 64 + 32 * nt + p) * 2 + 1]; }
    bf16x8 ck[4];
#pragma unroll
    for (int ks = 0; ks < 4; ++ks) ck[ks] = *(const bf16x8*)(P_S5CK + (size_t)(g * 16 + l15) * 128 + 32 * ks + 8 * l4);
    const int er = lane >> 1, eh = lane & 1;
    float* Ys = (float*)(F.lds + 86016) + w * 640;
    f32x4 dk0 = *(const f32x4*)(A.in[I_S5D] + g * 16 + 8 * eh), dk1 = *(const f32x4*)(A.in[I_S5D] + g * 16 + 8 * eh + 4);
#define S5_EROW(blk_) ((size_t)(b * SEQ + 128 * (2 * w + (er >> 4)) + 16 * (blk_) + (er & 15)))
    bf16x8 a0 = S5_ALOAD(0), a1 = S5_ALOAD(1), a2 = S5_ALOAD(2);
    u32x4 un = *(const u32x4*)(P_Z + S5_EROW(0) * ZP0 + g * 16 + 8 * eh);
#pragma unroll 1
    for (int blk = 0; blk < 8; ++blk) {
        const bf16x8 a = a0; a0 = a1; a1 = a2; if (blk + 3 < 8) a2 = S5_ALOAD(blk + 3);
        const u32x4 us = un; if (blk + 1 < 8) un = *(const u32x4*)(P_Z + S5_EROW(blk + 1) * ZP0 + g * 16 + 8 * eh);
#pragma unroll
        for (int nt = 0; nt < 2; ++nt) {
            const f32x16 dre = __builtin_amdgcn_mfma_f32_32x32x16_bf16(a, bbr[nt], zero16, 0, 0, 0), dim = __builtin_amdgcn_mfma_f32_32x32x16_bf16(a, bbi[nt], zero16, 0, 0, 0);
#pragma unroll
            for (int i = 0; i < 16; ++i) { const float nr = are[nt] * hr[nt] - aim[nt] * hi[nt] + dre[i], ni = are[nt] * hi[nt] + aim[nt] * hr[nt] + dim[i]; hr[nt] = nr; hi[nt] = ni;
                *(unsigned*)(Hs + (hh * 16 + i) * 136 + 2 * (32 * nt + p)) = pk2(nr, ni); }
        }
        LDS_WAIT();
#pragma unroll
        for (int sg = 0; sg < 2; ++sg) {
            f32x4 y = {0.f, 0.f, 0.f, 0.f};
#pragma unroll
            for (int ks = 0; ks < 4; ++ks) { const bf16x8 af = *(const bf16x8*)(Hs + (sg * 16 + l15) * 136 + 32 * ks + 8 * l4); y = __builtin_amdgcn_mfma_f32_16x16x32_bf16(af, ck[ks], y, 0, 0, 0); }
#pragma unroll
            for (int q = 0; q < 4; ++q) Ys[(sg * 16 + 4 * l4 + q) * 20 + l15] = y[q];
        }
        LDS_WAIT();
        { const f32x4 y0 = *(const f32x4*)(Ys + er * 20 + 8 * eh), y1 = *(const f32x4*)(Ys + er * 20 + 8 * eh + 4);
          float o[8]; o[0] = y0.x + dk0.x * bflo(us.x); o[1] = y0.y + dk0.y * bfhi(us.x); o[2] = y0.z + dk0.z * bflo(us.y); o[3] = y0.w + dk0.w * bfhi(us.y);
          o[4] = y1.x + dk1.x * bflo(us.z); o[5] = y1.y + dk1.y * bfhi(us.z); o[6] = y1.z + dk1.z * bflo(us.w); o[7] = y1.w + dk1.w * bfhi(us.w);
          u32x4 ov; ov.x = pk2(gelu_tanh(o[0]), gelu_tanh(o[1])); ov.y = pk2(gelu_tanh(o[2]), gelu_tanh(o[3])); ov.z = pk2(gelu_tanh(o[4]), gelu_tanh(o[5])); ov.w = pk2(gelu_tanh(o[6]), gelu_tanh(o[7]));
          *(u32x4*)(P_G5 + S5_EROW(blk) * 512 + g * 16 + 8 * eh) = ov; }
        LDS_WAIT();
    }
#undef S5_ALOAD
#undef S5_EROW
}
namespace lin {
typedef const LAS char* lptr;
typedef short s16x4 __attribute__((ext_vector_type(4)));
typedef short v4i16_t __attribute__((ext_vector_type(4)));
__device__ __forceinline__ s16x4 vtr(lptr p) { return __builtin_bit_cast(s16x4, __builtin_amdgcn_ds_read_tr16_b64_v4i16((LAS v4i16_t*)p)); }
__device__ __forceinline__ bf16x8 tr_frag(lptr sub, int ks, int lane) {
    const lptr p = sub + ((lane >> 4) & 1) * 32 + (lane & 3) * 8 + (4 * (lane >> 5) + ((lane & 15) >> 2)) * 64 + ks * 1024;
    const s16x4 lo = vtr(p), hi = vtr(p + 512);
    return (bf16x8){lo[0], lo[1], lo[2], lo[3], hi[0], hi[1], hi[2], hi[3]};
}
__device__ __forceinline__ bf16x8 nat_frag(lptr base, int ldb, int row0, int k0, int lane) { return *(const LAS bf16x8*)(base + (row0 + (lane & 31)) * ldb + (k0 + 8 * (lane >> 5)) * 2); }
__device__ __forceinline__ int crow(int r, int hh) { return (r & 3) + 8 * (r >> 2) + 4 * hh; }
__device__ __forceinline__ void unpack8(const u32x4& w, float (&f)[8]) { f[0] = bflo(w.x); f[1] = bfhi(w.x); f[2] = bflo(w.y); f[3] = bfhi(w.y); f[4] = bflo(w.z); f[5] = bfhi(w.z); f[6] = bflo(w.w); f[7] = bfhi(w.w); }
__device__ __forceinline__ u32x4 repack8(const float (&f)[8]) { u32x4 w; w.x = pk2(f[0], f[1]); w.y = pk2(f[2], f[3]); w.z = pk2(f[4], f[5]); w.w = pk2(f[6], f[7]); return w; }

__device__ __forceinline__ void gla_prefix(CArgs& A, const Frame& F, int item) {
    const int b = item >> 5, c = item & 31, half = F.tid >> 8, col = F.tid & 255;
    float* p = P_LOGA + (size_t)(b * SEQ + c * 64 + 32 * half) * 256 + col; float* tot = (float*)F.lds;
    float v[32];
#pragma unroll
    for (int i = 0; i < 32; ++i) v[i] = p[(size_t)i * 256];
#pragma unroll
    for (int i = 1; i < 32; ++i) v[i] += v[i - 1];
    if (half == 0) tot[col] = v[31];
    __syncthreads();
    const float off = half ? tot[col] : 0.f;
#pragma unroll
    for (int i = 0; i < 32; ++i) p[(size_t)i * 256] = v[i] + off;
    __syncthreads();
}
template <int KIND> __device__ __forceinline__ void r1_item(CArgs& A, const Frame& F, int bh, int vs) {
    constexpr int DK = KIND ? 64 : 128, ND = DK / 32;
    constexpr int KCOL = KIND ? 2304 : 512, VCOL = KIND ? 2560 : 1024;
    const int b = bh >> 2, h = bh & 3, tid = F.tid, lane = F.lane, w = F.wave, hh = lane >> 5;
    unsigned char* bufV = F.lds; unsigned char* bufK = F.lds + 4096;
    bf16_t* ST = (KIND ? P_GST : P_RST) + (size_t)bh * 32 * 128 * DK;
    const float log2g = KIND ? 0.f : log2f(1.f - exp2f(-5.f - (float)h));
    const float g64 = exp2f(64.f * log2g);
    f32x16 acc = {0.f, 0.f, 0.f, 0.f, 0.f, 0.f, 0.f, 0.f, 0.f, 0.f, 0.f, 0.f, 0.f, 0.f, 0.f, 0.f};
    const bf16_t* zb = P_Z + (size_t)(b * SEQ) * ZP1;
    const int vj = tid >> 2, vc = tid & 3;
    const int kj0 = KIND ? (tid >> 3) : (tid >> 4), kd0 = KIND ? (tid & 7) : (tid & 15);
#define R1_DECL(S) u32x4 rv##S = {0u, 0u, 0u, 0u}, rk0##S = {0u, 0u, 0u, 0u}, rk1##S = {0u, 0u, 0u, 0u}; f32x4 bj0##S = {0.f, 0.f, 0.f, 0.f}, bj1##S = bj0##S, bl0##S = bj0##S, bl1##S = bj0##S; float bd##S = 0.f;
#define R1_LOAD(S, c) do { const bf16_t* zc = zb + (size_t)((c) * 64) * ZP1; \
        if (tid < 256) rv##S = *(const u32x4*)(zc + (size_t)vj * ZP1 + VCOL + h * 128 + vs * 32 + vc * 8); \
        rk0##S = *(const u32x4*)(zc + (size_t)kj0 * ZP1 + KCOL + h * DK + kd0 * 8); \
        if (!KIND) rk1##S = *(const u32x4*)(zc + (size_t)(kj0 + 32) * ZP1 + KCOL + h * DK + kd0 * 8); \
        if (KIND) { const float* bp = P_LOGA + (size_t)(b * SEQ + (c) * 64) * 256 + h * 64; \
            bj0##S = *(const f32x4*)(bp + (size_t)kj0 * 256 + kd0 * 8); bj1##S = *(const f32x4*)(bp + (size_t)kj0 * 256 + kd0 * 8 + 4); \
            bl0##S = *(const f32x4*)(bp + 63 * 256 + kd0 * 8); bl1##S = *(const f32x4*)(bp + 63 * 256 + kd0 * 8 + 4); \
            if (w < ND) bd##S = bp[63 * 256 + 32 * w + (lane & 31)]; } } while (0)
#define R1_STEP(S, c) do { \
        if (tid < 256) { u32x4 o = rv##S; \
            if (!KIND) { float f[8]; unpack8(rv##S, f); const float z = exp2f((float)(63 - vj) * log2g); _Pragma("unroll") for (int e = 0; e < 8; ++e) f[e] *= z; o = repack8(f); } \
            *(u32x4*)(bufV + vj * 64 + vc * 16) = o; } \
        if (KIND) { float f[8]; unpack8(rk0##S, f); \
            f[0] *= __expf(bl0##S.x - bj0##S.x); f[1] *= __expf(bl0##S.y - bj0##S.y); f[2] *= __expf(bl0##S.z - bj0##S.z); f[3] *= __expf(bl0##S.w - bj0##S.w); \
            f[4] *= __expf(bl1##S.x - bj1##S.x); f[5] *= __expf(bl1##S.y - bj1##S.y); f[6] *= __expf(bl1##S.z - bj1##S.z); f[7] *= __expf(bl1##S.w - bj1##S.w); \
            *(u32x4*)(bufK + (kd0 >> 2) * 4096 + kj0 * 64 + (kd0 & 3) * 16) = repack8(f); \
        } else { \
            *(u32x4*)(bufK + (kd0 >> 2) * 4096 + kj0 * 64 + (kd0 & 3) * 16) = rk0##S; \
            *(u32x4*)(bufK + (kd0 >> 2) * 4096 + (kj0 + 32) * 64 + (kd0 & 3) * 16) = rk1##S; } \
        __syncthreads(); \
        const float decn = KIND ? __expf(bd##S) : 0.f; \
        if ((c) + 4 < 32) R1_LOAD(S, (c) + 4); \
        if (w < ND) { \
            bf16_t* sp = ST + ((size_t)(c) * 128 + vs * 32) * DK + 32 * w + (lane & 31); \
            const float dec = KIND ? decn : g64; \
            _Pragma("unroll") for (int r = 0; r < 16; ++r) { sp[(size_t)crow(r, hh) * DK] = (bf16_t)f2bf(acc[r]); acc[r] *= dec; } \
            _Pragma("unroll") for (int ks = 0; ks < 4; ++ks) acc = __builtin_amdgcn_mfma_f32_32x32x16_bf16(tr_frag((lptr)(LAS unsigned char*)bufV, ks, lane), tr_frag((lptr)(LAS unsigned char*)bufK + w * 4096, ks, lane), acc, 0, 0, 0); \
        } \
        __syncthreads(); } while (0)
    R1_DECL(0) R1_DECL(1) R1_DECL(2) R1_DECL(3)
    R1_LOAD(0, 0); R1_LOAD(1, 1); R1_LOAD(2, 2); R1_LOAD(3, 3);
#pragma unroll 1
    for (int c = 0; c < 32; c += 4) { R1_STEP(0, c); R1_STEP(1, c + 1); R1_STEP(2, c + 2); R1_STEP(3, c + 3); }
#undef R1_DECL
#undef R1_LOAD
#undef R1_STEP
}
__device__ __forceinline__ void p_lin_r1(CArgs& A, const Frame& F) {
    const int v = F.bid, r = v & 127;
    if (v < 128) r1_item<0>(A, F, r >> 2, r & 3); else r1_item<1>(A, F, r >> 2, r & 3);
}

template <int KIND> struct R2Regs {
    static constexpr int DK = KIND ? 64 : 128, NQP = 64 * DK / 8 / 512, NSP = 128 * DK / 8 / 512;
    u32x4 q[NQP], k[NQP], v[2], s[NSP], g[2]; f32x4 bq[NQP][2];
};
template <int KIND> __device__ __forceinline__ void r2_load(CArgs& A, const Frame& F, R2Regs<KIND>& R, int bh, int c) {
    constexpr int DK = KIND ? 64 : 128;
    constexpr int QCOL = KIND ? 2048 : 0, KCOL = KIND ? 2304 : 512, VCOL = KIND ? 2560 : 1024, GCOL = KIND ? 3072 : 1536;
    const int b = bh >> 2, h = bh & 3, tid = F.tid, lane = F.lane, w = F.wave, hh = lane >> 5, l31 = lane & 31, rb = w >> 2, cb = w & 3;
    const bf16_t* zc = P_Z + (size_t)(b * SEQ + c * 64) * ZP1;
    const bf16_t* ST = (KIND ? P_GST : P_RST) + ((size_t)bh * 32 + c) * 128 * DK;
#pragma unroll
    for (int r = 0; r < R2Regs<KIND>::NQP; ++r) { const int q = tid + 512 * r, i = q / (DK / 8), d8 = q % (DK / 8);
        R.q[r] = *(const u32x4*)(zc + (size_t)i * ZP1 + QCOL + h * DK + d8 * 8); R.k[r] = *(const u32x4*)(zc + (size_t)i * ZP1 + KCOL + h * DK + d8 * 8);
        if (KIND) { const float* bp = P_LOGA + (size_t)(b * SEQ + c * 64 + i) * 256 + h * 64 + d8 * 8; R.bq[r][0] = *(const f32x4*)bp; R.bq[r][1] = *(const f32x4*)(bp + 4); } }
#pragma unroll
    for (int r = 0; r < 2; ++r) { const int q = tid + 512 * r, j = q >> 4, v8 = q & 15; R.v[r] = *(const u32x4*)(zc + (size_t)j * ZP1 + VCOL + h * 128 + v8 * 8); }
#pragma unroll
    for (int r = 0; r < R2Regs<KIND>::NSP; ++r) { const int q = tid + 512 * r, vr = q / (DK / 8), d8 = q % (DK / 8); R.s[r] = *(const u32x4*)(ST + (size_t)vr * DK + d8 * 8); }
#pragma unroll
    for (int k2 = 0; k2 < 2; ++k2) { const int pp = lane + 64 * k2; R.g[k2] = *(const u32x4*)(zc + (size_t)(32 * rb + (pp >> 2)) * ZP1 + GCOL + h * 128 + 32 * cb + 8 * (pp & 3)); }
}
template <int KIND> struct R2Lds { static constexpr int DK = KIND ? 64 : 128, LDQ = (DK + 8) * 2, OFF_K = 64 * LDQ, OFF_V = 2 * 64 * LDQ, OFF_S = OFF_V + 16384, OFF_SSQ = OFF_S + 128 * LDQ, OFF_BC = OFF_SSQ + 1024; };
template <int KIND> __device__ __forceinline__ void r2_stage(const Frame& F, const R2Regs<KIND>& R, u32x4 (&gc)[2]) {
    typedef R2Lds<KIND> LL; constexpr int DK = LL::DK, LDQ = LL::LDQ;
    const int tid = F.tid; unsigned char* L = F.lds;
#pragma unroll
    for (int r = 0; r < R2Regs<KIND>::NQP; ++r) { const int q = tid + 512 * r, i = q / (DK / 8), d8 = q % (DK / 8);
        u32x4 qw = R.q[r], kw = R.k[r];
        if (KIND) { float fq[8], fk[8]; unpack8(qw, fq); unpack8(kw, fk);
#pragma unroll
            for (int e = 0; e < 8; ++e) { const float bb = R.bq[r][e >> 2][e & 3]; fq[e] *= __expf(bb); fk[e] *= __expf(-bb); }
            qw = repack8(fq); kw = repack8(fk); }
        *(u32x4*)(L + i * LDQ + d8 * 16) = qw; *(u32x4*)(L + LL::OFF_K + i * LDQ + d8 * 16) = kw; }
#pragma unroll
    for (int r = 0; r < 2; ++r) { const int q = tid + 512 * r, j = q >> 4, v8 = q & 15; *(u32x4*)(L + LL::OFF_V + (v8 >> 2) * 4096 + j * 64 + (v8 & 3) * 16) = R.v[r]; }
#pragma unroll
    for (int r = 0; r < R2Regs<KIND>::NSP; ++r) { const int q = tid + 512 * r, vr = q / (DK / 8), d8 = q % (DK / 8); *(u32x4*)(L + LL::OFF_S + vr * LDQ + d8 * 16) = R.s[r]; }
    gc[0] = R.g[0]; gc[1] = R.g[1];
    __syncthreads();
}
template <int KIND> __device__ __forceinline__ void r2_compute(CArgs& A, const Frame& F, int bh, int c, const u32x4 (&gc)[2]) {
    typedef R2Lds<KIND> LL; constexpr int DK = LL::DK, LDQ = LL::LDQ, OFF_K = LL::OFF_K, OFF_V = LL::OFF_V, OFF_S = LL::OFF_S;
    constexpr int OCOL = KIND ? 512 : 0;
    const int b = bh >> 2, h = bh & 3, lane = F.lane, w = F.wave, hh = lane >> 5, l31 = lane & 31, rb = w >> 2, cb = w & 3;
    unsigned char* L = F.lds; float* ssq = (float*)(L + LL::OFF_SSQ);
    const float log2g = KIND ? 0.f : log2f(1.f - exp2f(-5.f - (float)h));
    const lptr L3 = (lptr)(LAS unsigned char*)L;
    bf16x8 pa[2][2];
#pragma unroll
    for (int jt = 0; jt < 2; ++jt) {
        f32x16 p = {0.f, 0.f, 0.f, 0.f, 0.f, 0.f, 0.f, 0.f, 0.f, 0.f, 0.f, 0.f, 0.f, 0.f, 0.f, 0.f};
        if (jt <= rb) {
#pragma unroll
            for (int ks = 0; ks < DK / 16; ++ks) p = __builtin_amdgcn_mfma_f32_32x32x16_bf16(nat_frag(L3 + OFF_K, LDQ, 32 * jt, 16 * ks, lane), nat_frag(L3, LDQ, 32 * rb, 16 * ks, lane), p, 0, 0, 0);
        }
        const int i = 32 * rb + l31;
        float f[16];
#pragma unroll
        for (int r = 0; r < 16; ++r) { const int j = 32 * jt + crow(r, hh); float x = (i >= j) ? p[r] : 0.f; if (!KIND) x *= exp2f((float)(i - j) * log2g); f[r] = (i >= j) ? x : 0.f; }
#pragma unroll
        for (int s = 0; s < 2; ++s) { u32x4 wv; wv.x = pk2(f[8 * s], f[8 * s + 1]); wv.y = pk2(f[8 * s + 2], f[8 * s + 3]); wv.z = pk2(f[8 * s + 4], f[8 * s + 5]); wv.w = pk2(f[8 * s + 6], f[8 * s + 7]); pa[jt][s] = __builtin_bit_cast(bf16x8, wv); }
    }
    f32x16 o1 = {0.f, 0.f, 0.f, 0.f, 0.f, 0.f, 0.f, 0.f, 0.f, 0.f, 0.f, 0.f, 0.f, 0.f, 0.f, 0.f}, o2 = o1;
#pragma unroll
    for (int jt = 0; jt < 2; ++jt)
#pragma unroll
        for (int s = 0; s < 2; ++s) o1 = __builtin_amdgcn_mfma_f32_32x32x16_bf16(pa[jt][s], tr_frag(L3 + OFF_V + cb * 4096, 2 * jt + s, lane), o1, 0, 0, 0);
#pragma unroll
    for (int ks = 0; ks < DK / 16; ++ks) o2 = __builtin_amdgcn_mfma_f32_32x32x16_bf16(nat_frag(L3, LDQ, 32 * rb, 16 * ks, lane), nat_frag(L3 + OFF_S, LDQ, 32 * cb, 16 * ks, lane), o2, 0, 0, 0);
    float o[16];
#pragma unroll
    for (int r = 0; r < 16; ++r) { const int i = 32 * rb + crow(r, hh); const float xi = KIND ? 1.f : exp2f((float)(i + 1) * log2g); o[r] = o1[r] + xi * o2[r];
        const float sq = half_sum(o[r] * o[r]); if (l31 == 0) ssq[i * 4 + cb] = sq; }
    __syncthreads();
    float* Os = (float*)L + w * (32 * 33);
#pragma unroll
    for (int r = 0; r < 16; ++r) Os[crow(r, hh) * 33 + l31] = o[r];
    LDS_WAIT();
#pragma unroll
    for (int k2 = 0; k2 < 2; ++k2) { const int pp = lane + 64 * k2, rw = pp >> 2, ch = pp & 3, i = 32 * rb + rw;
        const f32x4 s4 = *(const f32x4*)(ssq + i * 4);
        const float rn = rsqrtf(((s4.x + s4.y) + (s4.z + s4.w)) * (1.f / 128.f) + EPS);
        float gv[8]; unpack8(gc[k2], gv); float y[8];
#pragma unroll
        for (int e = 0; e < 8; ++e) y[e] = siluf_(gv[e]) * Os[rw * 33 + 8 * ch + e] * rn;
        *(u32x4*)(P_YCAT + (size_t)(b * SEQ + c * 64 + i) * DM + OCOL + h * 128 + 32 * cb + 8 * ch) = repack8(y); }
    __syncthreads();
}
template <int KIND> __device__ __forceinline__ void r2_run(CArgs& A, const Frame& F0, int first, int n, int stride) {
    R2Regs<KIND> R; u32x4 gc[2];
    { Frame G2 = F0; int t_ = F0.tid; asm volatile("" : "+v"(t_)); G2.tid = t_; G2.lane = t_ & 63; r2_load<KIND>(A, G2, R, (first & 1023) >> 5, first & 31); }
#pragma unroll 1
    for (int i = 0; i < n; ++i) {
        Frame G2 = F0; { int t_ = F0.tid; asm volatile("" : "+v"(t_)); G2.tid = t_; G2.lane = t_ & 63; }
        const int r = (first + i * stride) & 1023;
        r2_stage<KIND>(G2, R, gc);
        if (i + 1 < n) { const int rn = (first + (i + 1) * stride) & 1023; r2_load<KIND>(A, G2, R, rn >> 5, rn & 31); }
        r2_compute<KIND>(A, G2, r >> 5, r & 31, gc);
    }
}
__device__ __forceinline__ void p_lin_r2(CArgs& A, const Frame& F) {
    r2_run<0>(A, F, F.bid, 4, F.G);
    r2_run<1>(A, F, 1024 + F.bid, 4, F.G);
}
}
#define XB_TMO      128
#define XB_XCNT(j)  (256  + 64 * (j))
#define XB_XSUB(j)  (1280 + 64 * (j))
#define XB_XGEN(j)  (2304 + 64 * (j))
#define XB_TOP      3328
#define XB_TOPGEN   3392
#define XCD_BAR_WORDS 3456
#define XB_SPIN_CAP (1u << 18)
__device__ __forceinline__ unsigned xb_ld(unsigned* p)              { return __hip_atomic_load(p, __ATOMIC_RELAXED, __HIP_MEMORY_SCOPE_AGENT); }
__device__ __forceinline__ unsigned xb_add(unsigned* p, unsigned v) { return __hip_atomic_fetch_add(p, v, __ATOMIC_RELAXED, __HIP_MEMORY_SCOPE_AGENT); }
__device__ __forceinline__ unsigned xb_xcc_id() { return (unsigned)__builtin_amdgcn_s_getreg((3 << 11) | 20) & 0xFu; }
#define XB_SPIN(cond, bar) do { unsigned _sp = 0; while (cond) { __builtin_amdgcn_s_sleep(1); \
    if ((++_sp & 255u) == 0u) { if (xb_ld(&(bar)[XB_TMO])) break; if (_sp > XB_SPIN_CAP) { atomicAdd(&(bar)[XB_TMO], 1u); break; } } } } while (0)
struct XcdBarrier { unsigned* bar; unsigned x; volatile LAS unsigned* st; };
__device__ __forceinline__ XcdBarrier xcd_barrier_post(unsigned* bar, volatile LAS unsigned* st, int tid) {
    XcdBarrier b; b.bar = bar; b.x = xb_xcc_id(); b.st = st;
    if (tid == 0) (void)xb_add(&bar[XB_XCNT(b.x)], 1u);
    return b;
}
__device__ __forceinline__ void xcd_barrier_complete(unsigned* bar, unsigned x, unsigned& nloc, unsigned& nx) {
    const unsigned G = gridDim.x * gridDim.y * gridDim.z;
    unsigned sum, cnt, mine, sp = 0u;
    for (;;) {
        sum = 0u; cnt = 0u; mine = 0u;
#pragma unroll
        for (unsigned j = 0; j < 16; ++j) { const unsigned c = xb_ld(&bar[XB_XCNT(j)]); sum += c; cnt += (c > 0u) ? 1u : 0u; mine = (j == x) ? c : mine; }
        if (sum == G) break;
        __builtin_amdgcn_s_sleep(1);
        if ((++sp & 255u) == 0u) { if (xb_ld(&bar[XB_TMO])) break; if (sp > XB_SPIN_CAP) { atomicAdd(&bar[XB_TMO], 1u); break; } }
    }
    nloc = mine > 0u ? mine : 1u; nx = cnt > 0u ? cnt : 1u;
}
__device__ __forceinline__ void xcd_barrier(const XcdBarrier& b, int tid) {
    asm volatile("s_waitcnt vmcnt(0)" ::: "memory");
    __syncthreads();
    if (tid == 0) {
        unsigned* bar = b.bar;
        __builtin_amdgcn_s_waitcnt(0);
        unsigned nloc = b.st[0], nx = b.st[1];
        if (nloc == 0u) { xcd_barrier_complete(bar, b.x, nloc, nx); b.st[0] = nloc; b.st[1] = nx; }
        const unsigned old = xb_add(&bar[XB_XSUB(b.x)], 1u);
        const unsigned gen = old / nloc;
        if (old + 1u == (gen + 1u) * nloc) {
            __builtin_amdgcn_fence(__ATOMIC_RELEASE, "agent");
            asm volatile("s_waitcnt vmcnt(0)" ::: "memory");
            const unsigned og = xb_add(&bar[XB_TOP], 1u);
            const unsigned tg = og / nx;
            if (og + 1u == (tg + 1u) * nx) xb_add(&bar[XB_TOPGEN], 1u);
            else XB_SPIN(xb_ld(&bar[XB_TOPGEN]) == tg, bar);
            __builtin_amdgcn_fence(__ATOMIC_ACQUIRE, "agent");
            xb_add(&bar[XB_XGEN(b.x)], 1u);
            asm volatile("s_waitcnt vmcnt(0)" ::: "memory");
        } else {
            XB_SPIN(xb_ld(&bar[XB_XGEN(b.x)]) == gen, bar);
            __builtin_amdgcn_fence(__ATOMIC_ACQUIRE, "agent");
            asm volatile("s_waitcnt vmcnt(0)" ::: "memory");
        }
    }
    __syncthreads();
}
#define REFRESH() do { int t_ = F.wave * 64 + lane_id(); asm volatile("" : "+v"(t_)); F.tid = t_; F.lane = t_ & 63; asm volatile("" : "+s"(ap)); int b_ = blockIdx.x; asm volatile("" : "+s"(b_)); F.bid = b_; } while (0)
#define A (*ap)
#define GSYNC() do { REFRESH(); xcd_barrier(xb, F.tid); } while (0)
template <int l> __device__ __forceinline__ void layer_fwd(CArgs*& ap, Frame& F, const XcdBarrier& xb, unsigned char* lds, LAS unsigned char* lds3, LAS pg8::MoeTables* tb) {
    if (l == 0) {
        { REFRESH(); pg8::DenseOrder S; S.init(P_HB, P_WINE, NTOK, 2048, 1024, F.G, F.bid); pg8::EpiZ0 E{P_Z};
          pg8::gemm_phase<pg8::EpiZ0, pg8::DenseOrder, true>(lds3, F.wave, 1024, S, E); }
        GSYNC();
        REFRESH(); fox_fast(A, F);
        __syncthreads();
        REFRESH(); s5_fast(A, F, F.bid);
        GSYNC();
        { REFRESH(); pg8::DenseOrder S; S.init(P_G5, P_WGLU, NTOK, 512, 512, F.G, F.bid); pg8::EpiGlu E{P_G5, A.in[I_GLUB], P_YCAT};
          pg8::gemm_phase<pg8::EpiGlu, pg8::DenseOrder, true>(lds3, F.wave, 512, S, E); }
        GSYNC();
    } else {
        REFRESH(); lin::gla_prefix(A, F, F.bid);
        { REFRESH(); pg8::DenseOrder S; S.init(P_HB, P_WINO, NTOK, 3584, 512, F.G, F.bid); pg8::EpiZ1 E{P_Z, P_ROPE};
          pg8::gemm_phase<pg8::EpiZ1, pg8::DenseOrder, true, true>(lds3, F.wave, 512, S, E); }
        GSYNC();
        REFRESH(); lin::p_lin_r1(A, F);
        GSYNC();
        REFRESH(); lin::p_lin_r2(A, F);
        GSYNC();
    }
    { REFRESH(); pg8::DenseOrder S; S.init(P_YCAT, l == 0 ? P_WOUTE : P_WOUTO, NTOK, 1024, 1024, F.G, F.bid); pg8::EpiBf16Plain E{(bf16_t*)P_MBUF, DM};
      pg8::gemm_phase<pg8::EpiBf16Plain, pg8::DenseOrder, true>(lds3, F.wave, 1024, S, E); }
    GSYNC();
    REFRESH(); p_postmix(A, F, l);
    GSYNC();
    REFRESH(); const int MT = moe_tables(A, F, l, tb);
    {
        const int mX = (MT >> 5) << 5, kk = MT - mX, rr = (64 - ((2 * kk) & 63)) & 63;
        const int mY = mX >= rr ? rr + (((mX - rr) >> 6) << 6) : 0;
        if (mX > 0) {
            { REFRESH(); pg8::MoeOrder<true> S; S.Ap = (const char*)P_HB8; S.Bt = (const char*)(P_W1 + (size_t)l * 32 * 2048 * 1024); S.estride = (size_t)2048 * 1024; S.K = 512; S.NP = 8; S.nwg = mX * 8; S.G = F.G; S.c = F.bid; S.mt0 = 0;
              S.list_tk = P_LTK + (size_t)l * 32 * LISTCAP; S.tb = tb;
              pg8::EpiSwiglu E{P_ACT, A.in[I_BGU] + (size_t)l * 32 * 2048};
              pg8::gemm_phase<pg8::EpiSwiglu, pg8::MoeOrder<true>, true, true>(lds3, F.wave, 512, S, E); }
            GSYNC();
        }
        if (8 * (MT - mX) + 4 * mY > 0) {
            { REFRESH(); pg8::MoeMixOrder S; S.ws = (const char*)A.ws; S.l = l;
              S.a0 = mX; S.nA = 8 * (MT - mX); S.b0 = 0; S.nB = 4 * mY; S.nwg = S.nA + S.nB; S.G = F.G; S.c = F.bid; S.tb = tb;
              pg8::EpiMoeMix E{ap, l};
              pg8::gemm_phase<pg8::EpiMoeMix, pg8::MoeMixOrder, true, true>(lds3, F.wave, 512, S, E); }
            GSYNC();
        }
        if (MT > mY) {
            { REFRESH(); pg8::MoeOrder<false> S; S.Ap = (const char*)P_ACT; S.Bt = (const char*)(P_W2 + (size_t)l * 32 * 1024 * 1024); S.estride = (size_t)1024 * 1024; S.K = 512; S.NP = 4; S.nwg = (MT - mY) * 4; S.G = F.G; S.c = F.bid; S.mt0 = mY;
              S.list_tk = P_LTK + (size_t)l * 32 * LISTCAP; S.tb = tb;
              pg8::EpiDown E{P_Y, A.in[I_BDN] + (size_t)l * 32 * 1024, P_LTK + (size_t)l * 32 * LISTCAP, P_LG + (size_t)l * 32 * LISTCAP};
              pg8::gemm_phase<pg8::EpiDown, pg8::MoeOrder<false>, true, true>(lds3, F.wave, 512, S, E); }
            GSYNC();
        }
    }
    REFRESH(); p_combine(A, F, l);
}

__global__ void __launch_bounds__(512, 2) mk_fwd(Args A_) {
    extern __shared__ __attribute__((aligned(16))) unsigned char lds[];
    cg::grid_group grid = cg::this_grid();
    CArgs* ap = (CArgs*)__builtin_amdgcn_kernarg_segment_ptr();
    Frame F;
    F.lds = lds; F.wave = __builtin_amdgcn_readfirstlane((int)threadIdx.x >> 6); F.tid = 0; F.lane = 0; F.bid = blockIdx.x; F.G = gridDim.x;
    LAS unsigned char* lds3 = (LAS unsigned char*)lds;
    LAS pg8::MoeTables* tb = (LAS pg8::MoeTables*)(lds3 + 133632);
    { volatile LAS unsigned* st = (volatile LAS unsigned*)(lds3 + (LDS_BYTES - 64)); REFRESH(); if (F.tid < 2) st[F.tid] = 0u; __syncthreads(); }
    XcdBarrier xb = xcd_barrier_post((unsigned*)(A.ws + WS_CTL) + 10240, (volatile LAS unsigned*)(lds3 + (LDS_BYTES - 64)), F.tid);
    REFRESH(); p0_prep(A, F);
    if (A.pad != 0) grid.sync();
    GSYNC();
    asm volatile("s_sleep 40\n\ts_sleep 40" ::: "memory");
    REFRESH(); p1_hprep0(A, F);
    GSYNC();
    asm volatile("s_sleep 40\n\ts_sleep 40" ::: "memory");
    layer_fwd<0>(ap, F, xb, lds, lds3, tb);
    GSYNC();
    layer_fwd<1>(ap, F, xb, lds, lds3, tb);
}
#undef A

extern "C" void kernel_launch(void* const* d_in, const int* in_sizes, int n_in, void* d_out, int out_size, void* d_ws, size_t ws_size, hipStream_t stream) {
    static int grid = 0;
    if (grid == 0) {
        if (n_in != 31 || out_size != NTOK * DM || ws_size < WS_END) { fprintf(stderr, "kernel_launch: unexpected problem (n_in %d out %d ws %zu)\n", n_in, out_size, ws_size); grid = -1; return; }
        int dev = 0, cus = 0, per_cu = 0;
        if (hipGetDevice(&dev) != hipSuccess || hipDeviceGetAttribute(&cus, hipDeviceAttributeMultiprocessorCount, dev) != hipSuccess) { grid = -1; return; }
        if (hipFuncSetAttribute((const void*)mk_fwd, hipFuncAttributeMaxDynamicSharedMemorySize, LDS_BYTES) != hipSuccess) { fprintf(stderr, "kernel_launch: hipFuncSetAttribute failed\n"); grid = -1; return; }
        if (hipOccupancyMaxActiveBlocksPerMultiprocessor(&per_cu, (const void*)mk_fwd, 512, LDS_BYTES) != hipSuccess || per_cu < 1) { fprintf(stderr, "kernel_launch: occupancy query says %d blocks per CU\n", per_cu); (void)hipGetLastError(); }
        grid = cus;
        if (grid != 256) fprintf(stderr, "kernel_launch: %d CUs; this kernel is built for a 256-CU grid\n", grid);
    }
    if (grid < 0) return;
    if (hipMemsetAsync((char*)d_ws + WS_CTL, 0, CTL_ZERO_BYTES, stream) != hipSuccess) { fprintf(stderr, "kernel_launch: memset failed\n"); return; }
    Args a{};
    for (int i = 0; i < 31; ++i) a.in[i] = (const float*)d_in[i];
    a.out = (float*)d_out; a.ws = (unsigned char*)d_ws;
    void* kargs[] = {&a};
    const hipError_t e = hipLaunchCooperativeKernel((const void*)mk_fwd, dim3(grid), dim3(512), kargs, LDS_BYTES, stream);
    if (e != hipSuccess) fprintf(stderr, "kernel_launch: cooperative launch failed: %s (grid %d)\n", hipGetErrorString(e), grid);
}
```

```cpp
#include <hip/hip_runtime.h>
#include <hip/hip_cooperative_groups.h>
#include <cstdio>
#include <cstdint>
namespace cg = cooperative_groups;

#define LAS __attribute__((address_space(3)))
typedef unsigned short bf16_t;
typedef short bf16x8 __attribute__((ext_vector_type(8)));
typedef float f32x4 __attribute__((ext_vector_type(4)));
typedef float f32x2 __attribute__((ext_vector_type(2)));
typedef unsigned u32x4 __attribute__((ext_vector_type(4)));
typedef unsigned u32x2 __attribute__((ext_vector_type(2)));
typedef int i32x4 __attribute__((ext_vector_type(4)));
typedef int i32x8 __attribute__((ext_vector_type(8)));

constexpr int NTOK = 16384, DM = 1024, SEQ = 2048, NB = 8;
constexpr int NEXP = 32, LISTCAP = 16384;
constexpr float EPS = 1e-6f;
constexpr float LOG2E = 1.4426950408889634f;
constexpr float C2 = 0.125f * LOG2E;
constexpr int ZP0 = 2048, ZP1 = 3584;

constexpr size_t MiB = 1u << 20;
constexpr size_t WS_CTL = 0, CTL_ZERO_BYTES = 65536;
constexpr size_t WS_MOD = 1 * MiB;
constexpr size_t WS_WSIDE = 1 * MiB + 512 * 1024;
constexpr size_t WS_S5A = 2 * MiB;
constexpr size_t WS_S5BB = 2 * MiB + 65536;
constexpr size_t WS_S5CK = 2 * MiB + 512 * 1024;
constexpr size_t WS_ROPE = 3 * MiB;
constexpr size_t WS_LTK = 4 * MiB;
constexpr size_t WS_LG = 8 * MiB;
constexpr size_t WS_WINE = 16 * MiB, WS_WGLU = 20 * MiB, WS_WOUTE = 21 * MiB, WS_WINO = 23 * MiB, WS_WOUTO = 30 * MiB;
constexpr size_t WS_W1 = 32 * MiB;
constexpr size_t WS_HB8 = 160 * MiB;
constexpr size_t WS_W2 = 288 * MiB;
constexpr size_t WS_HB = 416 * MiB;
constexpr size_t WS_Z = 448 * MiB;
constexpr size_t WS_LSIG = 560 * MiB;
constexpr size_t WS_LOGA = 562 * MiB;
constexpr size_t WS_G5 = 578 * MiB;
constexpr size_t WS_YCAT = 594 * MiB;
constexpr size_t WS_MBUF = 626 * MiB;
constexpr size_t WS_ACT = 690 * MiB;
constexpr size_t WS_Y = 834 * MiB;
constexpr size_t WS_RST = 962 * MiB;
constexpr size_t WS_GST = 994 * MiB;
constexpr size_t WS_XB = 1010 * MiB;
constexpr size_t WS_END = 1042 * MiB;
constexpr int CW_CNT = 1024;

constexpr int RING_BYTES = 131072;
constexpr int MISC_OFF = RING_BYTES;
constexpr int LDS_BYTES = 147456;

__device__ __forceinline__ unsigned f2bf(float f) { unsigned u = __builtin_bit_cast(unsigned, f); return (u + 0x7fffu + ((u >> 16) & 1u)) >> 16; }
typedef __bf16 bf16x2_hw __attribute__((ext_vector_type(2)));
__device__ __forceinline__ unsigned pk2(float lo, float hi) { const f32x2 v = {lo, hi}; return __builtin_bit_cast(unsigned, __builtin_convertvector(v, bf16x2_hw)); }
__device__ __forceinline__ float bflo(unsigned w) { return __builtin_bit_cast(float, w << 16); }
__device__ __forceinline__ float bfhi(unsigned w) { return __builtin_bit_cast(float, w & 0xffff0000u); }
__device__ __forceinline__ float bf1(bf16_t b) { return __builtin_bit_cast(float, ((unsigned)b) << 16); }
__device__ __forceinline__ int lane_id() { int l; asm volatile("v_mbcnt_lo_u32_b32 %0, -1, 0\n\tv_mbcnt_hi_u32_b32 %0, -1, %0" : "=v"(l)); return l; }
template <int CTRL> __device__ __forceinline__ float dppf(float v) { return __builtin_bit_cast(float, __builtin_amdgcn_update_dpp(0, __builtin_bit_cast(int, v), CTRL, 0xf, 0xf, true)); }
__device__ __forceinline__ float row16_sum(float v) {
    v += dppf<0xB1>(v); v += dppf<0x4E>(v); v += dppf<0x141>(v); v += dppf<0x140>(v); return v;
}
__device__ __forceinline__ float rdlane(float v, int l) { return __builtin_bit_cast(float, __builtin_amdgcn_readlane(__builtin_bit_cast(int, v), l)); }
__device__ __forceinline__ float wave_sum(float v) {
    v = row16_sum(v); return (rdlane(v, 0) + rdlane(v, 16)) + (rdlane(v, 32) + rdlane(v, 48));
}
__device__ __forceinline__ float half_sum(float v) {
    v = row16_sum(v); const float a = rdlane(v, 0) + rdlane(v, 16), b = rdlane(v, 32) + rdlane(v, 48); return (lane_id() < 32) ? a : b;
}
__device__ __forceinline__ float sigmoidf_(float x) { return __builtin_amdgcn_rcpf(1.f + __expf(-x)); }
__device__ __forceinline__ float log_sigmoidf_(float x) { return fminf(x, 0.f) - log1pf(__expf(-fabsf(x))); }
__device__ __forceinline__ float siluf_(float x) { return x * sigmoidf_(x); }
__device__ __forceinline__ float gelu_tanh(float x) { const float u2 = 1.5957691216057308f * (x + 0.044715f * x * x * x); return x * sigmoidf_(u2); }
constexpr float SC_H = 16.f, SC_W1 = 512.f, SC_A = 8.f, SC_W2 = 512.f, SC_WIN = 512.f, SC_Y = 64.f;
__device__ __forceinline__ unsigned pk8(float a, float b, float c, float d) {
    a = __builtin_amdgcn_fmed3f(a, -448.f, 448.f); b = __builtin_amdgcn_fmed3f(b, -448.f, 448.f); c = __builtin_amdgcn_fmed3f(c, -448.f, 448.f); d = __builtin_amdgcn_fmed3f(d, -448.f, 448.f);
    int r = __builtin_amdgcn_cvt_pk_fp8_f32(a, b, 0, false); r = __builtin_amdgcn_cvt_pk_fp8_f32(c, d, r, true); return (unsigned)r;
}
#define LDS_WAIT() asm volatile("s_waitcnt lgkmcnt(0)" ::: "memory")

struct Args { const float* in[31]; float* out; unsigned char* ws; long long pad; };
typedef const __attribute__((address_space(4))) Args CArgs;
enum { I_X = 0, I_C, I_ADAW, I_ADAB, I_NPM, I_NQM, I_NPF, I_NQF, I_EVWIN, I_FOXB, I_LAMRE, I_LAMIM, I_LOGDT, I_BRE, I_BIM, I_CRE, I_CIM, I_S5D, I_GLUW, I_GLUB, I_EVWOUT,
       I_ODWIN, I_GLAWUP, I_GLABG, I_ODWOUT, I_RW, I_RB, I_WGU, I_BGU, I_WDN, I_BDN };

namespace pg8 {
constexpr int BM = 256, BK = 64, HALF = 128, HTB = HALF * BK * 2, STAGE_BYTES = 8 * HTB, NXCD = 8, WGM = 8;
__device__ __forceinline__ int lds_byte(int r, int c) { const int st = (r >> 4) * 2 + (c >> 5), rr = r & 15, cc = c & 31, ob = rr * 64 + cc * 2; return st * 1024 + (ob ^ (((ob >> 9) & 1) << 5)); }
__device__ __forceinline__ void stage_rc(int b, int& R, int& C) { const int st = b / 1024, sb = b % 1024, swz = sb ^ (((sb >> 9) & 1) << 5); R = (st >> 1) * 16 + swz / 64; C = (st & 1) * 32 + (swz % 64) / 2; }
__device__ __forceinline__ int perm32(int rho) { const int n = rho >> 4, i = rho & 15; return 8 * (i >> 2) + 4 * n + (i & 3); }
__device__ __forceinline__ unsigned cvt_pk_bf16(float lo, float hi) { unsigned r; asm volatile("v_cvt_pk_bf16_f32 %0, %1, %2" : "=v"(r) : "v"(lo), "v"(hi)); return r; }

struct Unit { int pm, pn, e, mb, nrows, kind; };
__device__ __forceinline__ int xcd_remap(int L, int nwg) { const int q = nwg / NXCD, r = nwg % NXCD, xcd = L % NXCD, off = L / NXCD; return (xcd < r ? xcd * (q + 1) : r * (q + 1) + (xcd - r) * q) + off; }

struct DenseOrder {
    const char* Ap; const char* Bt; int K, nM, nN, nwg, G, c;
    __device__ __forceinline__ void init(const void* A_, const void* Bt_, int M, int N, int K_, int G_, int c_) { Ap = (const char*)A_; Bt = (const char*)Bt_; K = K_; nM = M / BM; nN = N / BM; nwg = nM * nN; G = G_; c = c_; }
    __device__ __forceinline__ bool next(int i, Unit& u) const {
        const long L = (long)i * G + c; if (L >= nwg) return false;
        const int wgid = xcd_remap((int)L, nwg);
        const int nig = WGM * nN, gid = wgid / nig, fm = gid * WGM, gsz = (nM - fm) < WGM ? (nM - fm) : WGM;
        u.pm = fm + ((wgid % nig) % gsz); u.pn = (wgid % nig) / gsz; u.e = 0; u.mb = u.pm; u.nrows = BM; u.kind = 0; return true;
    }
    __device__ __forceinline__ const char* a_base(const Unit& u) const { return Ap + (size_t)u.pm * ((size_t)BM * K * 2); }
    __device__ __forceinline__ const char* b_base(const Unit& u) const { return Bt + (size_t)u.pn * ((size_t)BM * K * 2); }
    __device__ __forceinline__ void a_raw(const Unit&, const int (&)[2], int (&raw)[2][2]) const { raw[0][0] = raw[0][1] = raw[1][0] = raw[1][1] = 0; }
    __device__ __forceinline__ void a_offs(const Unit&, const int (&R)[2], const int (&C)[2], const int (&)[2][2], unsigned (&v)[2][2]) const {
#pragma unroll
        for (int h = 0; h < 2; ++h)
#pragma unroll
            for (int i = 0; i < 2; ++i) v[h][i] = (unsigned)((h * HALF + R[i]) * K + C[i]) * 2u;
    }
};
struct MoeTables { int cnt[NEXP]; int mtstart[NEXP + 1]; unsigned char tile_e[320]; };
template <bool GATHER> struct MoeOrder {
    const char* Ap; const char* Bt; size_t estride; int K, NP, nwg, G, c, mt0; const int* list_tk; const LAS MoeTables* tb;
    __device__ __forceinline__ bool next(int i, Unit& u) const {
        const long L = (long)i * G + c; if (L >= nwg) return false;
        const int w = xcd_remap((int)L, nwg);
        const int mq = w / NP, mt = mt0 + mq; u.pn = w - mq * NP; u.pm = mt; u.e = tb->tile_e[mt]; u.mb = mt - tb->mtstart[u.e];
        const int left = tb->cnt[u.e] - u.mb * BM; u.nrows = left < BM ? left : BM; u.kind = GATHER ? 0 : 1; return true;
    }
    __device__ __forceinline__ const char* a_base(const Unit& u) const { return GATHER ? Ap : Ap + (size_t)u.pm * ((size_t)BM * K * 2); }
    __device__ __forceinline__ const char* b_base(const Unit& u) const { return Bt + (size_t)u.e * estride + (size_t)u.pn * ((size_t)BM * K * 2); }
    __device__ __forceinline__ void a_raw(const Unit& u, const int (&R)[2], int (&raw)[2][2]) const {
#pragma unroll
        for (int h = 0; h < 2; ++h)
#pragma unroll
            for (int i = 0; i < 2; ++i) { if (GATHER) { const int r = h * HALF + R[i], rc = r < u.nrows ? r : 0; raw[h][i] = list_tk[u.e * LISTCAP + u.mb * BM + rc]; } else raw[h][i] = 0; }
    }
    __device__ __forceinline__ void a_offs(const Unit&, const int (&R)[2], const int (&C)[2], const int (&raw)[2][2], unsigned (&v)[2][2]) const {
#pragma unroll
        for (int h = 0; h < 2; ++h)
#pragma unroll
            for (int i = 0; i < 2; ++i) {
                if (GATHER) v[h][i] = (unsigned)((raw[h][i] >> 2) * K + C[i]) * 2u;
                else v[h][i] = (unsigned)((h * HALF + R[i]) * K + C[i]) * 2u;
            }
    }
};

struct MoeMixOrder {
    const char* ws; int l, a0, nA, b0, nB, nwg, G, c; const LAS MoeTables* tb;
    static constexpr int K = 512;
    __device__ __forceinline__ bool next(int i, Unit& u) const {
        const long L = (long)i * G + c; if (L >= nwg) return false;
        int w = xcd_remap((int)L, nwg), mt;
        if (w < nA) { u.kind = 0; mt = a0 + (w >> 3); u.pn = w & 7; } else { w -= nA; u.kind = 1; mt = b0 + (w >> 2); u.pn = w & 3; }
        u.pm = mt; u.e = tb->tile_e[mt]; u.mb = mt - tb->mtstart[u.e];
        const int left = tb->cnt[u.e] - u.mb * BM; u.nrows = left < BM ? left : BM; return true;
    }
    __device__ __forceinline__ const char* a_base(const Unit& u) const { return u.kind ? ws + WS_ACT : ws + WS_HB8; }
    __device__ __forceinline__ const char* b_base(const Unit& u) const { return u.kind ? ws + WS_W2 + (size_t)(l * 32 + u.e) * ((size_t)1024 * K * 2) + (size_t)u.pn * ((size_t)BM * K * 2) : ws + WS_W1 + (size_t)(l * 32 + u.e) * ((size_t)2048 * K * 2) + (size_t)u.pn * ((size_t)BM * K * 2); }
    __device__ __forceinline__ void a_raw(const Unit& u, const int (&R)[2], int (&raw)[2][2]) const {
#pragma unroll
        for (int h = 0; h < 2; ++h)
#pragma unroll
            for (int i = 0; i < 2; ++i) { const int r = h * HALF + R[i], rc = r < u.nrows ? r : 0; raw[h][i] = u.kind ? 4 * (u.pm * BM + r) : ((const int*)(ws + WS_LTK))[(l * 32 + u.e) * LISTCAP + u.mb * BM + rc]; }
    }
    __device__ __forceinline__ void a_offs(const Unit& u, const int (&R)[2], const int (&C)[2], const int (&raw)[2][2], unsigned (&v)[2][2]) const {
#pragma unroll
        for (int h = 0; h < 2; ++h)
#pragma unroll
            for (int i = 0; i < 2; ++i) v[h][i] = (unsigned)((raw[h][i] >> 2) * K + C[i]) * 2u;
    }
};

template <class Epi, class Sched, bool ALIGN_EPI, bool FP8 = false>
__device__ __forceinline__ void gemm_phase(LAS unsigned char* lds, const int wave_, const int K, const Sched& S, const Epi& E) {
    int tid_ = wave_ * 64 + lane_id(); asm volatile("" : "+v"(tid_));
    const int tid = tid_, wid = wave_, lane = tid & 63, wr = wid >> 2, wc = wid & 3, fr = lane & 15, fq = lane >> 4;
    int nt_ = K / BK; if constexpr (FP8) asm volatile("" : "+s"(nt_));
    const int nt = nt_;
    int Rr[2], Cc[2]; unsigned voffB[2];
#pragma unroll
    for (int i = 0; i < 2; ++i) { stage_rc(tid * 16 + i * 8192, Rr[i], Cc[i]); const int Rb = Epi::PERM ? ((Rr[i] & ~31) + perm32(Rr[i] & 31)) : Rr[i]; voffB[i] = (unsigned)(Rb * K + Cc[i]) * 2u; }
    const size_t kstep = (size_t)(BK * 2);
    const size_t hstep = (size_t)HALF * K * 2;
    const unsigned ldsw = (unsigned)wid * 1024u;
    const int aoff = lds_byte(wr * 64 + fr, fq * 8), boff = lds_byte(wc * 32 + fr, fq * 8);
#define PG8_SA(b, h) (((b) * 2 + (h)) * HTB)
#define PG8_SB(b, h) ((4 + (b) * 2 + (h)) * HTB)
#define PG8_STAGE(bufoff, gbase, voff) do { _Pragma("unroll") for (int _i = 0; _i < 2; ++_i) { unsigned vo_ = (voff)[_i]; if constexpr (FP8) asm volatile("" : "+v"(vo_));   \
        __builtin_amdgcn_global_load_lds((const unsigned*)((const char*)(gbase) + vo_), (LAS unsigned*)(lds + (bufoff) + ldsw + _i * 8192), 16, 0, 0); } } while (0)
#define PG8_LDA(dst, b, h) do { _Pragma("unroll") for (int m = 0; m < 4; ++m) { \
        if constexpr (FP8) { const i32x4 lo_ = *(const LAS i32x4*)(lds + PG8_SA(b, h) + aoff + m * 2048), hi_ = *(const LAS i32x4*)(lds + PG8_SA(b, h) + aoff + m * 2048 + 1024); dst##8[m] = __builtin_shufflevector(lo_, hi_, 0, 1, 2, 3, 4, 5, 6, 7); } \
        else { _Pragma("unroll") for (int k = 0; k < 2; ++k) dst[m][k] = *(const LAS bf16x8*)(lds + PG8_SA(b, h) + aoff + m * 2048 + k * 1024); } } } while (0)
#define PG8_LDB(dst, b, h) do { _Pragma("unroll") for (int n = 0; n < 2; ++n) { \
        if constexpr (FP8) { const i32x4 lo_ = *(const LAS i32x4*)(lds + PG8_SB(b, h) + boff + n * 2048), hi_ = *(const LAS i32x4*)(lds + PG8_SB(b, h) + boff + n * 2048 + 1024); dst##8[n] = __builtin_shufflevector(lo_, hi_, 0, 1, 2, 3, 4, 5, 6, 7); } \
        else { _Pragma("unroll") for (int k = 0; k < 2; ++k) dst[n][k] = *(const LAS bf16x8*)(lds + PG8_SB(b, h) + boff + n * 2048 + k * 1024); } } } while (0)
#define PG8_MMA(ai, bj, At, Bt) do { __builtin_amdgcn_s_setprio(1); _Pragma("unroll") for (int m = 0; m < 4; ++m) _Pragma("unroll") for (int n = 0; n < 2; ++n) { \
        if constexpr (FP8) asm volatile("v_mfma_f32_16x16x128_f8f6f4 %0, %1, %2, %0" : "+v"(acc[ai][bj][m][n]) : "v"(Bt##8[n]), "v"(At##8[m]));   \
        else { _Pragma("unroll") for (int k = 0; k < 2; ++k) acc[ai][bj][m][n] = __builtin_amdgcn_mfma_f32_16x16x32_bf16(Bt[n][k], At[m][k], acc[ai][bj][m][n], 0, 0, 0); } } \
        __builtin_amdgcn_s_setprio(0); } while (0)
#define PG8_WAIT_V(n) asm volatile("s_waitcnt vmcnt(" #n ")" ::: "memory")
#define PG8_WAIT_L(n) asm volatile("s_waitcnt lgkmcnt(" #n ")" ::: "memory")
#define PG8_BAR __builtin_amdgcn_s_barrier()
#define PG8_SCHED __builtin_amdgcn_sched_barrier(0)
    Unit cur, nxt; int ui = 0;
    if (!S.next(0, cur)) return;
    f32x4 acc[2][2][4][2];
#pragma unroll
    for (int a = 0; a < 2; ++a)
#pragma unroll
        for (int b = 0; b < 2; ++b)
#pragma unroll
            for (int m = 0; m < 4; ++m)
#pragma unroll
                for (int n = 0; n < 2; ++n) acc[a][b][m][n] = (f32x4){0.f, 0.f, 0.f, 0.f};
    bf16x8 At[4][2], B0[2][2], B1[2][2]; i32x8 At8[4], B08[2], B18[2];
    const char* cA = S.a_base(cur); const char* cB = S.b_base(cur);
    unsigned cv[2][2], nv[2][2]; int raw[2][2];
    S.a_raw(cur, Rr, raw); S.a_offs(cur, Rr, Cc, raw, cv);
    PG8_STAGE(PG8_SB(0, 0), cB, voffB); PG8_STAGE(PG8_SB(0, 1), cB + hstep, voffB); PG8_STAGE(PG8_SA(0, 0), cA, cv[0]); PG8_STAGE(PG8_SA(0, 1), cA, cv[1]);
    if (wr == 1) PG8_BAR;
    PG8_WAIT_V(2); PG8_BAR;
    PG8_STAGE(PG8_SB(1, 0), cB + kstep, voffB); PG8_STAGE(PG8_SA(1, 0), cA + kstep, cv[0]); PG8_STAGE(PG8_SB(1, 1), cB + hstep + kstep, voffB);
    PG8_WAIT_V(6); PG8_BAR;
    for (;;) {
        const bool has_next = S.next(ui + 1, nxt);
        const char* nA = has_next ? S.a_base(nxt) : cA; const char* nB = has_next ? S.b_base(nxt) : cB;
        if (has_next) S.a_raw(nxt, Rr, raw);
#pragma unroll
        for (int h = 0; h < 2; ++h)
#pragma unroll
            for (int i = 0; i < 2; ++i) nv[h][i] = cv[h][i];
        for (int t = 0; t < nt; t += 2) {
            const bool last = (t == nt - 2);
            if (last && has_next) S.a_offs(nxt, Rr, Cc, raw, nv);
            const char* a1 = cA + (size_t)(t + 1) * kstep;
            const char* a2 = last ? nA : cA + (size_t)(t + 2) * kstep; const char* b2 = last ? nB : cB + (size_t)(t + 2) * kstep;
            const char* a3 = a2 + kstep; const char* b3 = b2 + kstep;
            unsigned v2[2][2];
#pragma unroll
            for (int h = 0; h < 2; ++h)
#pragma unroll
                for (int i = 0; i < 2; ++i) v2[h][i] = last ? nv[h][i] : cv[h][i];
            PG8_LDB(B0, 0, 0); PG8_LDB(B1, 0, 1); PG8_SCHED; PG8_LDA(At, 0, 0); PG8_STAGE(PG8_SA(1, 1), a1, cv[1]);
            PG8_WAIT_V(8); PG8_WAIT_L(0); PG8_BAR; PG8_MMA(0, 0, At, B0); PG8_MMA(0, 1, At, B1); PG8_BAR; PG8_SCHED;
            PG8_LDA(At, 0, 1); PG8_STAGE(PG8_SB(0, 0), b2, voffB); PG8_STAGE(PG8_SB(0, 1), b2 + hstep, voffB); PG8_STAGE(PG8_SA(0, 0), a2, v2[0]);
            PG8_WAIT_V(8); PG8_WAIT_L(0); PG8_BAR; PG8_MMA(1, 0, At, B0); PG8_MMA(1, 1, At, B1); PG8_BAR; PG8_SCHED;
            PG8_LDB(B0, 1, 0); PG8_LDB(B1, 1, 1); PG8_SCHED; PG8_LDA(At, 1, 0); PG8_STAGE(PG8_SA(0, 1), a2, v2[1]);
            PG8_WAIT_V(8); PG8_WAIT_L(0); PG8_BAR; PG8_MMA(0, 0, At, B0); PG8_MMA(0, 1, At, B1); PG8_BAR; PG8_SCHED;
            PG8_LDA(At, 1, 1); PG8_STAGE(PG8_SB(1, 0), b3, voffB); PG8_STAGE(PG8_SB(1, 1), b3 + hstep, voffB); PG8_STAGE(PG8_SA(1, 0), a3, v2[0]);
            PG8_WAIT_V(8); PG8_WAIT_L(0); PG8_BAR; PG8_MMA(1, 0, At, B0); PG8_MMA(1, 1, At, B1); PG8_BAR; PG8_SCHED;
        }
        if constexpr (ALIGN_EPI) { if (wr == 0) PG8_BAR; }
        if constexpr (FP8) asm volatile("s_nop 15\n\ts_nop 15" ::: "memory");
        E(acc, cur, wr, wc, fr, fq);
        if (!has_next) break;
#pragma unroll
        for (int a = 0; a < 2; ++a)
#pragma unroll
            for (int b = 0; b < 2; ++b)
#pragma unroll
                for (int m = 0; m < 4; ++m)
#pragma unroll
                    for (int n = 0; n < 2; ++n) acc[a][b][m][n] = (f32x4){0.f, 0.f, 0.f, 0.f};
        cur = nxt; cA = nA; cB = nB; ++ui;
#pragma unroll
        for (int h = 0; h < 2; ++h)
#pragma unroll
            for (int i = 0; i < 2; ++i) cv[h][i] = nv[h][i];
        if constexpr (ALIGN_EPI) { if (wr == 1) PG8_BAR; }
    }
    PG8_WAIT_V(0);
    if constexpr (!ALIGN_EPI) { if (wr == 0) PG8_BAR; }
    PG8_BAR;
#undef PG8_SA
#undef PG8_SB
#undef PG8_STAGE
#undef PG8_LDA
#undef PG8_LDB
#undef PG8_MMA
#undef PG8_WAIT_V
#undef PG8_WAIT_L
#undef PG8_BAR
#undef PG8_SCHED
}
}
namespace pg8 {
typedef f32x4 Acc[2][2][4][2];
struct EpiZ0 {
    static constexpr bool PERM = true;
    bf16_t* Z;
    __device__ __forceinline__ void operator()(const Acc& acc, const Unit& u, int wr, int wc, int fr, int fq) const {
        const float sc = (u.pn == 2 || u.pn == 3) ? C2 : 1.f;
        const int row0 = u.pm * BM + wr * 64 + fr, col0 = u.pn * BM + wc * 32 + 8 * fq;
#pragma unroll
        for (int ai = 0; ai < 2; ++ai)
#pragma unroll
            for (int m = 0; m < 4; ++m) { bf16_t* rowp = Z + (size_t)(row0 + ai * HALF + m * 16) * ZP0 + col0;
#pragma unroll
                for (int bj = 0; bj < 2; ++bj) { const f32x4 v0 = acc[ai][bj][m][0] * sc, v1 = acc[ai][bj][m][1] * sc;
                    u32x4 w; w.x = cvt_pk_bf16(v0[0], v0[1]); w.y = cvt_pk_bf16(v0[2], v0[3]); w.z = cvt_pk_bf16(v1[0], v1[1]); w.w = cvt_pk_bf16(v1[2], v1[3]);
                    *(u32x4*)(rowp + bj * HALF) = w; } }
    }
};
struct EpiZ1 {
    static constexpr bool PERM = true;
    bf16_t* Z; const float* rope;
    __device__ __forceinline__ void operator()(const Acc& acc, const Unit& u, int wr, int wc, int fr, int fq) const {
        constexpr float INV = 1.f / (SC_H * SC_WIN);
        const int row0 = u.pm * BM + wr * 64 + fr;
        if (u.pn < 4) {
            const float sc = (u.pn >= 2) ? 0.08838834764831845f * INV : INV;
            const int hl = wc >> 1, jj0 = 32 * (wc & 1) + 8 * fq;
#pragma unroll
            for (int ai = 0; ai < 2; ++ai)
#pragma unroll
                for (int m = 0; m < 4; ++m) { const int row = row0 + ai * HALF + m * 16, pos = row & (SEQ - 1);
                    const f32x4 c0 = *(const f32x4*)(rope + pos * 64 + jj0), c1 = *(const f32x4*)(rope + pos * 64 + jj0 + 4);
                    const f32x4 s0 = *(const f32x4*)(rope + SEQ * 64 + pos * 64 + jj0), s1 = *(const f32x4*)(rope + SEQ * 64 + pos * 64 + jj0 + 4);
                    const f32x4 x10 = acc[ai][0][m][0] * sc, x11 = acc[ai][0][m][1] * sc, x20 = acc[ai][1][m][0] * sc, x21 = acc[ai][1][m][1] * sc;
                    const f32x4 a0 = x10 * c0 - x20 * s0, a1 = x11 * c1 - x21 * s1, b0 = x10 * s0 + x20 * c0, b1 = x11 * s1 + x21 * c1;
                    bf16_t* rowp = Z + (size_t)row * ZP1 + u.pn * BM + 128 * hl + jj0;
                    u32x4 w; w.x = cvt_pk_bf16(a0[0], a0[1]); w.y = cvt_pk_bf16(a0[2], a0[3]); w.z = cvt_pk_bf16(a1[0], a1[1]); w.w = cvt_pk_bf16(a1[2], a1[3]);
                    *(u32x4*)(rowp) = w;
                    w.x = cvt_pk_bf16(b0[0], b0[1]); w.y = cvt_pk_bf16(b0[2], b0[3]); w.z = cvt_pk_bf16(b1[0], b1[1]); w.w = cvt_pk_bf16(b1[2], b1[3]);
                    *(u32x4*)(rowp + 64) = w; }
        } else {
            const float sc = (u.pn == 8) ? 0.125f * INV : INV;
            const int col0 = u.pn * BM + wc * 32 + 8 * fq;
#pragma unroll
            for (int ai = 0; ai < 2; ++ai)
#pragma unroll
                for (int m = 0; m < 4; ++m) { bf16_t* rowp = Z + (size_t)(row0 + ai * HALF + m * 16) * ZP1 + col0;
#pragma unroll
                    for (int bj = 0; bj < 2; ++bj) { const f32x4 v0 = acc[ai][bj][m][0] * sc, v1 = acc[ai][bj][m][1] * sc;
                        u32x4 w; w.x = cvt_pk_bf16(v0[0], v0[1]); w.y = cvt_pk_bf16(v0[2], v0[3]); w.z = cvt_pk_bf16(v1[0], v1[1]); w.w = cvt_pk_bf16(v1[2], v1[3]);
                        *(u32x4*)(rowp + bj * HALF) = w; } }
        }
    }
};
struct EpiGlu {
    static constexpr bool PERM = true;
    const bf16_t* G5; const float* bias; bf16_t* Y;
    __device__ __forceinline__ void operator()(const Acc& acc, const Unit& u, int wr, int wc, int fr, int fq) const {
        const int row0 = u.pm * BM + wr * 64 + fr, col0 = u.pn * BM + wc * 32 + 8 * fq;
        f32x4 bv[2][2];
#pragma unroll
        for (int bj = 0; bj < 2; ++bj)
#pragma unroll
            for (int n = 0; n < 2; ++n) bv[bj][n] = *(const f32x4*)(bias + col0 + bj * HALF + 4 * n);
#pragma unroll
        for (int ai = 0; ai < 2; ++ai)
#pragma unroll
            for (int m = 0; m < 4; ++m) { const size_t row = (size_t)(row0 + ai * HALF + m * 16);
#pragma unroll
                for (int bj = 0; bj < 2; ++bj) { const u32x4 gw = *(const u32x4*)(G5 + row * 512 + col0 + bj * HALF);
                    const f32x4 v0 = acc[ai][bj][m][0] + bv[bj][0], v1 = acc[ai][bj][m][1] + bv[bj][1];
                    float o[8]; o[0] = bflo(gw.x) * sigmoidf_(v0[0]); o[1] = bfhi(gw.x) * sigmoidf_(v0[1]); o[2] = bflo(gw.y) * sigmoidf_(v0[2]); o[3] = bfhi(gw.y) * sigmoidf_(v0[3]);
                    o[4] = bflo(gw.z) * sigmoidf_(v1[0]); o[5] = bfhi(gw.z) * sigmoidf_(v1[1]); o[6] = bflo(gw.w) * sigmoidf_(v1[2]); o[7] = bfhi(gw.w) * sigmoidf_(v1[3]);
                    u32x4 w; w.x = cvt_pk_bf16(o[0], o[1]); w.y = cvt_pk_bf16(o[2], o[3]); w.z = cvt_pk_bf16(o[4], o[5]); w.w = cvt_pk_bf16(o[6], o[7]);
                    *(u32x4*)(Y + row * DM + col0 + bj * HALF) = w; } }
    }
};
struct EpiF32 {
    static constexpr bool PERM = false;
    float* Cp; int ldc;
    __device__ __forceinline__ void operator()(const Acc& acc, const Unit& u, int wr, int wc, int fr, int fq) const {
        const int row0 = u.pm * BM + wr * 64 + fr, col0 = u.pn * BM + wc * 32 + 4 * fq;
#pragma unroll
        for (int ai = 0; ai < 2; ++ai)
#pragma unroll
            for (int m = 0; m < 4; ++m) { float* rowp = Cp + (size_t)(row0 + ai * HALF + m * 16) * ldc + col0;
#pragma unroll
                for (int bj = 0; bj < 2; ++bj)
#pragma unroll
                    for (int n = 0; n < 2; ++n) *(f32x4*)(rowp + bj * HALF + n * 16) = acc[ai][bj][m][n]; }
    }
};
struct EpiBf16Plain {
    static constexpr bool PERM = true;
    bf16_t* Cp; int ldc;
    __device__ __forceinline__ void operator()(const Acc& acc, const Unit& u, int wr, int wc, int fr, int fq) const {
        const int row0 = u.pm * BM + wr * 64 + fr, col0 = u.pn * BM + wc * 32 + 8 * fq;
#pragma unroll
        for (int ai = 0; ai < 2; ++ai)
#pragma unroll
            for (int m = 0; m < 4; ++m) { bf16_t* rowp = Cp + (size_t)(row0 + ai * HALF + m * 16) * ldc + col0;
#pragma unroll
                for (int bj = 0; bj < 2; ++bj) { const f32x4 v0 = acc[ai][bj][m][0], v1 = acc[ai][bj][m][1];
                    u32x4 w; w.x = cvt_pk_bf16(v0[0], v0[1]); w.y = cvt_pk_bf16(v0[2], v0[3]); w.z = cvt_pk_bf16(v1[0], v1[1]); w.w = cvt_pk_bf16(v1[2], v1[3]);
                    *(u32x4*)(rowp + bj * HALF) = w; } }
    }
};
struct EpiSwiglu {
    static constexpr bool PERM = true;
    unsigned char* ACT; const float* bgu;
    __device__ __forceinline__ void operator()(const Acc& acc, const Unit& u, int wr, int wc, int fr, int fq) const {
        constexpr float INV = 1.f / (SC_H * SC_W1), INVL = INV * SC_A, CE = -1.702f * LOG2E;
        const int row0 = u.pm * BM + wr * 64 + fr, j0 = wc * 32 + 8 * fq, colg = u.pn * 128 + j0;
        const float* bp = bgu + (size_t)u.e * 2048 + colg;
        f32x2 bg[4], bl[4];
#pragma unroll
        for (int p = 0; p < 4; ++p) { bg[p] = *(const f32x2*)(bp + 2 * p); bl[p] = (*(const f32x2*)(bp + 1024 + 2 * p) + 1.f) * SC_A; }
#pragma unroll
        for (int ai = 0; ai < 2; ++ai)
#pragma unroll
            for (int m = 0; m < 4; ++m) {
                f32x2 o[4];
#pragma unroll
                for (int p = 0; p < 4; ++p) {
                    const f32x4 ag = acc[ai][0][m][p >> 1], al = acc[ai][1][m][p >> 1];
                    const f32x2 g = (p & 1 ? (f32x2){ag[2], ag[3]} : (f32x2){ag[0], ag[1]}) * INV + bg[p], l = (p & 1 ? (f32x2){al[2], al[3]} : (f32x2){al[0], al[1]}) * INVL + bl[p];
                    const f32x2 a = {fminf(g.x, 7.f), fminf(g.y, 7.f)}, b = {__builtin_amdgcn_fmed3f(l.x, -6.f * SC_A, 8.f * SC_A), __builtin_amdgcn_fmed3f(l.y, -6.f * SC_A, 8.f * SC_A)};
                    const f32x2 t = a * CE; const f32x2 d = (f32x2){__builtin_amdgcn_exp2f(t.x), __builtin_amdgcn_exp2f(t.y)} + 1.f;
                    const f32x2 sg = {__builtin_amdgcn_rcpf(d.x), __builtin_amdgcn_rcpf(d.y)};
                    o[p] = (a * sg) * b; }
                u32x2 w; int r0 = __builtin_amdgcn_cvt_pk_fp8_f32(o[0].x, o[0].y, 0, false); r0 = __builtin_amdgcn_cvt_pk_fp8_f32(o[1].x, o[1].y, r0, true);
                int r1 = __builtin_amdgcn_cvt_pk_fp8_f32(o[2].x, o[2].y, 0, false); r1 = __builtin_amdgcn_cvt_pk_fp8_f32(o[3].x, o[3].y, r1, true);
                w.x = (unsigned)r0; w.y = (unsigned)r1;
                *(u32x2*)(ACT + (size_t)(row0 + ai * HALF + m * 16) * DM + colg) = w; }
    }
};
struct EpiDown {
    static constexpr bool PERM = true;
    unsigned char* Y; const float* bdn; const int* list_tk; const float* list_g;
    __device__ __forceinline__ void operator()(const Acc& acc, const Unit& u, int wr, int wc, int fr, int fq) const {
        constexpr float INV = SC_Y / (SC_A * SC_W2);
        const int r0 = wr * 64 + fr, col0 = u.pn * BM + wc * 32 + 8 * fq;
        const float* bp = bdn + (size_t)u.e * DM + col0;
        f32x4 bv[2][2];
#pragma unroll
        for (int bj = 0; bj < 2; ++bj)
#pragma unroll
            for (int n = 0; n < 2; ++n) bv[bj][n] = *(const f32x4*)(bp + bj * HALF + 4 * n) * SC_Y;
        const size_t lbase = (size_t)u.e * LISTCAP + (size_t)u.mb * BM;
        int tkv[2][4]; float gtv[2][4];
#pragma unroll
        for (int ai = 0; ai < 2; ++ai)
#pragma unroll
            for (int m = 0; m < 4; ++m) { const int r = r0 + ai * HALF + m * 16, rc = r < u.nrows ? r : 0; tkv[ai][m] = list_tk[lbase + rc]; gtv[ai][m] = list_g[lbase + rc]; }
#pragma unroll
        for (int ai = 0; ai < 2; ++ai)
#pragma unroll
            for (int m = 0; m < 4; ++m) { const int r = r0 + ai * HALF + m * 16;
                if (r < u.nrows) { const float gt = gtv[ai][m];
                    unsigned char* rowp = Y + (size_t)tkv[ai][m] * DM + col0;
#pragma unroll
                    for (int bj = 0; bj < 2; ++bj) { const float gi = gt * INV; const f32x4 v0 = acc[ai][bj][m][0] * gi + bv[bj][0] * gt, v1 = acc[ai][bj][m][1] * gi + bv[bj][1] * gt;
                        u32x2 w; w.x = pk8(v0[0], v0[1], v0[2], v0[3]); w.y = pk8(v1[0], v1[1], v1[2], v1[3]);
                        *(u32x2*)(rowp + bj * HALF) = w; } } }
    }
};
struct EpiMoeMix {
    static constexpr bool PERM = true;
    CArgs* ap; int l;
    __device__ __forceinline__ void operator()(const Acc& acc, const Unit& u, int wr, int wc, int fr, int fq) const {
        CArgs& A = *ap; unsigned char* ws = A.ws;
        if (u.kind == 0) { const EpiSwiglu sw{ws + WS_ACT, A.in[I_BGU] + (size_t)l * 32 * 2048}; sw(acc, u, wr, wc, fr, fq); }
        else { const EpiDown dn{ws + WS_Y, A.in[I_BDN] + (size_t)l * 32 * 1024, (const int*)(ws + WS_LTK) + (size_t)l * 32 * LISTCAP, (const float*)(ws + WS_LG) + (size_t)l * 32 * LISTCAP}; dn(acc, u, wr, wc, fr, fq); }
    }
};
}
struct Frame { unsigned char* lds; int tid, lane, wave, bid, G; };
#define P_MOD   ((float*)(A.ws + WS_MOD))
#define P_S5A   ((float*)(A.ws + WS_S5A))
#define P_S5BB  ((float*)(A.ws + WS_S5BB))
#define P_ROPE  ((float*)(A.ws + WS_ROPE))
#define P_WSIDE ((float*)(A.ws + WS_WSIDE))
#define P_S5CK  ((bf16_t*)(A.ws + WS_S5CK))
#define P_LTK   ((int*)(A.ws + WS_LTK))
#define P_LG    ((float*)(A.ws + WS_LG))
#define P_CNT   ((unsigned*)(A.ws + WS_CTL) + CW_CNT)
#define P_WINE  (A.ws + WS_WINE)
#define P_WGLU  ((bf16_t*)(A.ws + WS_WGLU))
#define P_WOUTE ((bf16_t*)(A.ws + WS_WOUTE))
#define P_WINO  (A.ws + WS_WINO)
#define P_WOUTO ((bf16_t*)(A.ws + WS_WOUTO))
#define P_W1    (A.ws + WS_W1)
#define P_W2    (A.ws + WS_W2)
#define P_HB8   (A.ws + WS_HB8)
#define P_HB    (A.ws + WS_HB)
#define P_Z     ((bf16_t*)(A.ws + WS_Z))
#define P_G5    ((bf16_t*)(A.ws + WS_G5))
#define P_YCAT  ((bf16_t*)(A.ws + WS_YCAT))
#define P_ACT   (A.ws + WS_ACT)
#define P_Y     (A.ws + WS_Y)
#define P_LSIG  ((float*)(A.ws + WS_LSIG))
#define P_LOGA  ((float*)(A.ws + WS_LOGA))
#define P_MBUF  ((float*)(A.ws + WS_MBUF))
#define P_XB    ((bf16_t*)(A.ws + WS_XB))
#define P_RST   ((bf16_t*)(A.ws + WS_RST))
#define P_GST   ((bf16_t*)(A.ws + WS_GST))

__device__ __forceinline__ void tr_tile(const float* __restrict__ src, int pitch, int k0, int c0, bf16_t* dst, int Kd, int r0, float* scr, int lane) {
#pragma unroll
    for (int i = 0; i < 16; ++i) {
        const int kk = 4 * i + (lane >> 4), cc = 4 * (lane & 15);
        const f32x4 v = __builtin_nontemporal_load((const f32x4*)(src + (size_t)(k0 + kk) * pitch + c0 + cc));
        float* s = scr + kk * 65 + cc; s[0] = v.x; s[1] = v.y; s[2] = v.z; s[3] = v.w;
    }
    LDS_WAIT();
    const int c = lane & 7;
#pragma unroll
    for (int j = 0; j < 8; ++j) { const int n = (lane >> 3) + 8 * j; const float* s = scr + (8 * c) * 65 + n;
        u32x4 o; o.x = pk2(s[0], s[65]); o.y = pk2(s[130], s[195]); o.z = pk2(s[260], s[325]); o.w = pk2(s[390], s[455]);
        __builtin_nontemporal_store(o, (u32x4*)(dst + (size_t)(r0 + n) * Kd + k0 + 8 * c)); }
    LDS_WAIT();
}
__device__ __forceinline__ void tr_tile8(const float* __restrict__ src, int pitch, int k0, int c0, unsigned char* dst, int Kd, int r0, float* scr, int lane, float scale) {
#pragma unroll
    for (int i = 0; i < 16; ++i) {
        const int kk = 4 * i + (lane >> 4), cc = 4 * (lane & 15);
        const f32x4 v = __builtin_nontemporal_load((const f32x4*)(src + (size_t)(k0 + kk) * pitch + c0 + cc));
        float* s = scr + kk * 65 + cc; s[0] = v.x * scale; s[1] = v.y * scale; s[2] = v.z * scale; s[3] = v.w * scale;
    }
    LDS_WAIT();
    const int c = lane & 3;
#pragma unroll
    for (int j = 0; j < 4; ++j) { const int n = (lane >> 2) + 16 * j; const float* s = scr + (16 * c) * 65 + n;
        u32x4 o; o.x = pk8(s[0], s[65], s[130], s[195]); o.y = pk8(s[260], s[325], s[390], s[455]); o.z = pk8(s[520], s[585], s[650], s[715]); o.w = pk8(s[780], s[845], s[910], s[975]);
        __builtin_nontemporal_store(o, (u32x4*)(dst + (size_t)(r0 + n) * Kd + k0 + 16 * c)); }
    LDS_WAIT();
}
struct TileD { const float* src; unsigned char* dst; int pitch, rp, mode; float scale; };
constexpr int P0_T0 = 16 * 32, P0_T1 = 8 * 8, P0_T2 = 16 * 16, P0_T3 = 16 * 56, P0_T4 = 16 * 16, P0_T5 = 64 * 16 * 32, P0_T6 = 64 * 16 * 16;
constexpr int P0_NTILES = P0_T0 + P0_T1 + P0_T2 + P0_T3 + P0_T4 + P0_T5 + P0_T6;
__device__ __forceinline__ void tile_set(TileD& d, const float* src, int pitch, int k0, int c0, unsigned char* dst, int Kd, int r0, int mode, float scale) {
    d.src = src + (size_t)k0 * pitch + c0; d.pitch = pitch; d.mode = mode; d.scale = scale;
    d.rp = mode ? Kd : 2 * Kd; d.dst = dst + (size_t)r0 * d.rp + (mode ? k0 : 2 * k0);
}
__device__ __forceinline__ void tile_decode(CArgs& A, int it, TileD& d) {
    int r = it;
    if (r < P0_T0) { const int kb = r / 32, nb = r % 32; tile_set(d, A.in[I_EVWIN], 2056, kb * 64, nb * 64, P_WINE, 1024, nb * 64, 0, 1.f); return; } r -= P0_T0;
    if (r < P0_T1) { const int kb = r / 8, nb = r % 8; tile_set(d, A.in[I_GLUW], 512, kb * 64, nb * 64, (unsigned char*)P_WGLU, 512, nb * 64, 0, 1.f); return; } r -= P0_T1;
    if (r < P0_T2) { const int kb = r / 16, nb = r % 16; tile_set(d, A.in[I_EVWOUT], 1024, kb * 64, nb * 64, (unsigned char*)P_WOUTE, 1024, nb * 64, 0, 1.f); return; } r -= P0_T2;
    if (r < P0_T3) { const int kb = r / 112, nb = r % 112; const int n0 = nb * 32; int c0;
        if (n0 < 1024) { const int pn = n0 >> 8, rem = n0 & 255, bj = rem >> 7, hl = (rem & 127) >> 6; c0 = 256 * pn + 128 * hl + 64 * bj + (n0 & 63); }
        else if (n0 < 3072) c0 = n0; else c0 = n0 + 16;
        tile_set(d, A.in[I_ODWIN], 3600, kb * 128, c0, P_WINO, 1024, n0, 1, SC_WIN); return; } r -= P0_T3;
    if (r < P0_T4) { const int kb = r / 16, nb = r % 16; tile_set(d, A.in[I_ODWOUT], 1024, kb * 64, nb * 64, (unsigned char*)P_WOUTO, 1024, nb * 64, 0, 1.f); return; } r -= P0_T4;
    if (r < P0_T5) { const int mat = r / 512, q = r % 512, kb = q / 64, nb = q % 64; const int n0 = nb * 32, pn = n0 >> 8, half = (n0 & 255) >> 7, j0 = n0 & 127;
        tile_set(d, A.in[I_WGU] + (size_t)mat * 1024 * 2048, 2048, kb * 128, half * 1024 + 128 * pn + j0, P_W1 + (size_t)mat * 2048 * 1024, 1024, n0, 1, SC_W1); return; } r -= P0_T5;
    { const int mat = r / 256, q = r % 256, kb = q / 32, nb = q % 32;
        tile_set(d, A.in[I_WDN] + (size_t)mat * 1024 * 1024, 1024, kb * 128, nb * 32, P_W2 + (size_t)mat * 1024 * 1024, 1024, nb * 32, 1, SC_W2); }
}
__device__ __forceinline__ void tile_load(const TileD& d, f32x4 (&R)[16], int lane) {
    const int rs = d.mode ? 3 : 4, kr = lane >> rs, cc = 4 * (lane & ((1 << rs) - 1)), kstep = 64 >> rs;
#pragma unroll
    for (int i = 0; i < 16; ++i) R[i] = __builtin_nontemporal_load((const f32x4*)(d.src + (size_t)(kstep * i + kr) * d.pitch + cc));
}
__device__ __forceinline__ void tile_to_lds(const TileD& d, const f32x4 (&R)[16], float* scr, int lane) {
    const int rs = d.mode ? 3 : 4, kr = lane >> rs, cc = 4 * (lane & ((1 << rs) - 1)), kstep = 64 >> rs, P = d.mode ? 33 : 65;
#pragma unroll
    for (int i = 0; i < 16; ++i) { float* s = scr + (kstep * i + kr) * P + cc; s[0] = R[i].x * d.scale; s[1] = R[i].y * d.scale; s[2] = R[i].z * d.scale; s[3] = R[i].w * d.scale; }
}
__device__ __forceinline__ void tile_finish(const TileD& d, const float* scr, int lane) {
    if (d.mode == 0) {
        const int c = lane & 7;
#pragma unroll
        for (int j = 0; j < 8; ++j) { const int n = (lane >> 3) + 8 * j; const float* s = scr + (8 * c) * 65 + n;
            u32x4 o; o.x = pk2(s[0], s[65]); o.y = pk2(s[130], s[195]); o.z = pk2(s[260], s[325]); o.w = pk2(s[390], s[455]);
            __builtin_nontemporal_store(o, (u32x4*)(d.dst + (size_t)n * d.rp + 16 * c)); }
    } else {
        const int c = lane & 7; const float* s0 = scr + (16 * c) * 33 + (lane >> 3);
        float v[4][16];
#pragma unroll
        for (int j = 0; j < 4; ++j)
#pragma unroll
            for (int t = 0; t < 16; ++t) v[j][t] = s0[8 * j + 33 * t];
#pragma unroll
        for (int j = 0; j < 4; ++j) { const int n = (lane >> 3) + 8 * j;
            u32x4 o; o.x = pk8(v[j][0], v[j][1], v[j][2], v[j][3]); o.y = pk8(v[j][4], v[j][5], v[j][6], v[j][7]); o.z = pk8(v[j][8], v[j][9], v[j][10], v[j][11]); o.w = pk8(v[j][12], v[j][13], v[j][14], v[j][15]);
            __builtin_nontemporal_store(o, (u32x4*)(d.dst + (size_t)n * d.rp + 16 * c)); }
    }
}
__device__ __forceinline__ void p0_tables(CArgs& A, const Frame& F) {
    if (F.bid < 192) {
        float* sc = (float*)F.lds;
        float* red = sc + 8192;
        for (int i = F.tid; i < 8192; i += 512) sc[i] = siluf_(A.in[I_C][i]);
        __syncthreads();
        const int l = F.bid / 96;
        const float* wb = A.in[I_ADAW] + (size_t)l * 1024 * 6144 + (F.bid % 96) * 64;
        float a[8];
#pragma unroll
        for (int b = 0; b < 8; ++b) a[b] = 0.f;
#pragma unroll 1
        for (int kb = 128 * F.wave; kb < 128 * F.wave + 128; kb += 32) { float wv[32];
#pragma unroll
            for (int t = 0; t < 32; ++t) { unsigned vo_ = 4u * (unsigned)F.lane; asm volatile("" : "+v"(vo_));
                wv[t] = __builtin_nontemporal_load((const float*)((const char*)(wb + (size_t)(kb + t) * 6144) + vo_)); }
#pragma unroll
            for (int t = 0; t < 32; ++t)
#pragma unroll
                for (int b = 0; b < 8; ++b) a[b] += sc[b * 1024 + kb + t] * wv[t]; }
#pragma unroll
        for (int b = 0; b < 8; ++b) red[(F.wave * 8 + b) * 64 + F.lane] = a[b];
        __syncthreads();
        { const int b = F.tid >> 6, ln = F.tid & 63; float s = 0.f;
#pragma unroll
          for (int w8 = 0; w8 < 8; ++w8) s += red[(w8 * 8 + b) * 64 + ln];
          const int nn = (F.bid % 96) * 64 + ln; __hip_atomic_store(P_MOD + (size_t)(l * 8 + b) * 6144 + nn, s + A.in[I_ADAB][l * 6144 + nn], __ATOMIC_RELAXED, __HIP_MEMORY_SCOPE_AGENT); }
    }
    {
        const int gt = F.bid * 512 + F.tid;
        if (gt < 32 * 64) {
            const int g = gt >> 6;
            const float lr = A.in[I_LAMRE][gt], li = A.in[I_LAMIM][gt], dt = expf(A.in[I_LOGDT][g]);
            const float mag = expf(lr * dt); float sn, cs; sincosf(li * dt, &sn, &cs);
            const float are = mag * cs, aim = mag * sn, den = lr * lr + li * li, nre = are - 1.f, nim = aim;
            const float zre = (nre * lr + nim * li) / den, zim = (nim * lr - nre * li) / den;
            P_S5A[gt * 2] = are; P_S5A[gt * 2 + 1] = aim;
            for (int c = 0; c < 16; ++c) { const float br = A.in[I_BRE][gt * 16 + c], bi = A.in[I_BIM][gt * 16 + c];
                P_S5BB[gt * 32 + c] = zre * br - zim * bi; P_S5BB[gt * 32 + 16 + c] = zre * bi + zim * br; }
        }
        for (int i = gt; i < 32 * 16 * 128; i += F.G * 512) { const int k = i & 127, gc = i >> 7, pp = k >> 1; const float v = (k & 1) ? -A.in[I_CIM][gc * 64 + pp] : A.in[I_CRE][gc * 64 + pp]; P_S5CK[i] = (bf16_t)f2bf(v); }
        for (int i = gt; i < 24 * 1024; i += F.G * 512) { const int o = i >> 10, k = i & 1023; P_WSIDE[i] = o < 8 ? A.in[I_EVWIN][(size_t)k * 2056 + 2048 + o] : A.in[I_ODWIN][(size_t)k * 3600 + 3072 + (o - 8)]; }
        for (int i = gt; i < SEQ * 64; i += F.G * 512) { const int pos = i >> 6, j = i & 63;
            const float inv = exp2f(-(float)j * (13.287712379549449f / 64.f)); const float ang = (float)pos * inv; float sn, cs; sincosf(ang, &sn, &cs);
            P_ROPE[i] = cs; P_ROPE[SEQ * 64 + i] = sn; }
    }
}
__device__ __forceinline__ void p0_tiles(CArgs& A, const Frame& F, int k0, int k1) {
    float* scr = (float*)(F.lds) + F.wave * (128 * 33);
    const int gw = F.bid * 8 + F.wave, NGW = F.G * 8;
    TileD d0, d1; f32x4 R0[16], R1[16];
    d0.src = nullptr; d0.dst = nullptr; d0.pitch = 0; d0.rp = 0; d0.mode = 0; d0.scale = 1.f; d1 = d0;
    const int iend_ = (gw + k1 * NGW) < P0_NTILES ? (gw + k1 * NGW) : P0_NTILES;
    int i0 = gw + k0 * NGW, i1 = i0 + NGW;
    if (i0 < iend_) { tile_decode(A, i0, d0); tile_load(d0, R0, F.lane); }
    if (i1 < iend_) { tile_decode(A, i1, d1); tile_load(d1, R1, F.lane); }
#define P0_STEP(dd, RR, ii) do { const TileD cur_ = dd; tile_to_lds(cur_, RR, scr, F.lane); ii += 2 * NGW; \
        if (ii < iend_) { tile_decode(A, ii, dd); tile_load(dd, RR, F.lane); } \
        asm volatile("" ::: "memory");                   \
        LDS_WAIT(); tile_finish(cur_, scr, F.lane); LDS_WAIT(); } while (0)
#pragma unroll 1
    while (i0 < iend_) {
        P0_STEP(d0, R0, i0);
        if (i1 >= iend_) break;
        P0_STEP(d1, R1, i1);
    }
#undef P0_STEP
}

struct Row { f32x4 v[4]; };
__device__ __forceinline__ void row_load(Row& r, const float* p, int lane) {
#pragma unroll
    for (int j = 0; j < 4; ++j) r.v[j] = __builtin_nontemporal_load((const f32x4*)(p + 4 * lane + 256 * j));
}
__device__ __forceinline__ void row_load_bf16(Row& r, const bf16_t* p, int lane) {
#pragma unroll
    for (int j = 0; j < 4; ++j) { const u32x2 w = __builtin_nontemporal_load((const u32x2*)(p + 4 * lane + 256 * j)); r.v[j] = (f32x4){bflo(w.x), bfhi(w.x), bflo(w.y), bfhi(w.y)}; }
}
__device__ __forceinline__ void row_store(const Row& r, float* p, int lane) {
#pragma unroll
    for (int j = 0; j < 4; ++j) __builtin_nontemporal_store(r.v[j], (f32x4*)(p + 4 * lane + 256 * j));
}
__device__ __forceinline__ void row_store_bf16(const Row& r, bf16_t* p, int lane) {
#pragma unroll
    for (int j = 0; j < 4; ++j) { u32x2 w; w.x = pk2(r.v[j].x, r.v[j].y); w.y = pk2(r.v[j].z, r.v[j].w); *(u32x2*)(p + 4 * lane + 256 * j) = w; }
}
__device__ __forceinline__ void row_store_bf16_nt(const Row& r, bf16_t* p, int lane) {
#pragma unroll
    for (int j = 0; j < 4; ++j) { u32x2 w; w.x = pk2(r.v[j].x, r.v[j].y); w.y = pk2(r.v[j].z, r.v[j].w); __builtin_nontemporal_store(w, (u32x2*)(p + 4 * lane + 256 * j)); }
}
__device__ __forceinline__ float row_rstd(const Row& r) {
    float s = 0.f;
#pragma unroll
    for (int j = 0; j < 4; ++j) s += (r.v[j].x * r.v[j].x + r.v[j].y * r.v[j].y) + (r.v[j].z * r.v[j].z + r.v[j].w * r.v[j].w);
    return rsqrtf(wave_sum(s) * (1.f / DM) + EPS);
}
__device__ __forceinline__ void row_modnorm(Row& h, const Row& x, const float* gain, const float* sh, const float* sc, int lane) {
    const float r = row_rstd(x);
#pragma unroll
    for (int j = 0; j < 4; ++j) { const int k = 4 * lane + 256 * j; const f32x4 g = *(const f32x4*)(gain + k), a = *(const f32x4*)(sc + k), b = *(const f32x4*)(sh + k);
        h.v[j] = x.v[j] * r * g * (a + 1.f) + b; }
}
__device__ __forceinline__ void hprep_row(CArgs& A, const Frame& F, const Row& x, int l, int row, const float* wl) {
    const int b = row >> 11, lane = F.lane; const float* mod = P_MOD + (size_t)(l * 8 + b) * 6144;
    Row h; row_modnorm(h, x, A.in[I_NPM] + l * DM, mod, mod + 1024, lane);
    if (l == 0) row_store_bf16(h, (bf16_t*)P_HB + (size_t)row * DM, lane);
    else {
#pragma unroll
        for (int j = 0; j < 4; ++j) *(unsigned*)(P_HB + (size_t)row * DM + 4 * lane + 256 * j) = pk8(SC_H * h.v[j].x, SC_H * h.v[j].y, SC_H * h.v[j].z, SC_H * h.v[j].w);
    }
    if (l == 0) {
        float mine = 0.f;
#pragma unroll
        for (int i = 0; i < 8; ++i) { float p = 0.f;
#pragma unroll
            for (int j = 0; j < 4; ++j) { const f32x4 w = *(const f32x4*)(wl + i * 1024 + 4 * lane + 256 * j); p += (h.v[j].x * w.x + h.v[j].y * w.y) + (h.v[j].z * w.z + h.v[j].w * w.w); }
            const float s = wave_sum(p); if (lane == i) mine = s; if ((i & 3) == 3) asm volatile("" ::: "memory"); }
        if (lane < 8) P_LSIG[(size_t)row * 8 + lane] = log_sigmoidf_(mine + A.in[I_FOXB][lane]);
    } else {
        float p[16];
#pragma unroll
        for (int i = 0; i < 16; ++i) { float q = 0.f;
#pragma unroll
            for (int j = 0; j < 4; ++j) { const f32x4 w = *(const f32x4*)(wl + i * 1024 + 4 * lane + 256 * j); q += (h.v[j].x * w.x + h.v[j].y * w.y) + (h.v[j].z * w.z + h.v[j].w * w.w); }
            p[i] = wave_sum(q); if ((i & 1) == 1) asm volatile("" ::: "memory"); }
        const float* wup = wl + 16 * 1024;
#pragma unroll
        for (int q = 0; q < 4; ++q) { const int jcol = lane + 64 * q; float s = wup[16 * 256 + jcol];
#pragma unroll
            for (int i = 0; i < 16; ++i) s += p[i] * wup[i * 256 + jcol];
            P_LOGA[(size_t)row * 256 + jcol] = log_sigmoidf_(s) * (1.f / 16.f); }
    }
}
__device__ __forceinline__ void stage_side(CArgs& A, const Frame& F, int l, float* wl) {
    __syncthreads();
    if (l == 0) { for (int i = F.tid; i < 8 * 256; i += 512) *(f32x4*)(wl + 4 * i) = *(const f32x4*)(P_WSIDE + 4 * i); }
    else { for (int i = F.tid; i < 16 * 256; i += 512) *(f32x4*)(wl + 4 * i) = *(const f32x4*)(P_WSIDE + 8192 + 4 * i);
           for (int i = F.tid; i < 16 * 64; i += 512) *(f32x4*)(wl + 16384 + 4 * i) = *(const f32x4*)(A.in[I_GLAWUP] + 4 * i);
           if (F.tid < 64) *(f32x4*)(wl + 16384 + 4096 + 4 * F.tid) = *(const f32x4*)(A.in[I_GLABG] + 4 * F.tid); }
    __syncthreads();
}
__device__ __forceinline__ void p1_hprep0(CArgs& A, const Frame& F) {
    float* wl = (float*)F.lds; stage_side(A, F, 0, wl);
    const int gw = F.bid * 8 + F.wave, NGW = F.G * 8;
    Row xn; if (gw < NTOK) row_load(xn, A.in[I_X] + (size_t)gw * DM, F.lane);
#pragma unroll 1
    for (int row = gw; row < NTOK; row += NGW) { Row x;
#pragma unroll
        for (int j = 0; j < 4; ++j) x.v[j] = xn.v[j];
        if (row + NGW < NTOK) row_load(xn, A.in[I_X] + (size_t)(row + NGW) * DM, F.lane); hprep_row(A, F, x, 0, row, wl); }
}

__device__ __forceinline__ void p_postmix(CArgs& A, const Frame& F, int l) {
    float* h2s = (float*)F.lds;
    float* red = h2s + 16 * 1028;
    float* lg = red + 8 * 16 * 32;
    float* tv = lg + 16 * 32;
    int* lcnt = (int*)(tv + 64);
    int* ent = lcnt + 64;
    if (F.tid < 32) lcnt[F.tid] = 0;
    int nent = 0;
    const float* rw = A.in[I_RW] + (size_t)l * 1024 * 32;
    u32x2 pm[2][4]; f32x4 pxf[2][4]; u32x2 pxb[2][4];
#define PM_LOAD(tile_) do { const int r0_ = (tile_) * 16 + 2 * F.wave; _Pragma("unroll") for (int rr = 0; rr < 2; ++rr) _Pragma("unroll") for (int j = 0; j < 4; ++j) { \
        pm[rr][j] = __builtin_nontemporal_load((const u32x2*)((const bf16_t*)P_MBUF + (size_t)(r0_ + rr) * DM + 4 * F.lane + 256 * j)); \
        if (l == 0) pxf[rr][j] = __builtin_nontemporal_load((const f32x4*)(A.in[I_X] + (size_t)(r0_ + rr) * DM + 4 * F.lane + 256 * j)); \
        else pxb[rr][j] = __builtin_nontemporal_load((const u32x2*)(P_XB + (size_t)(r0_ + rr) * DM + 4 * F.lane + 256 * j)); } } while (0)
    if (F.bid < NTOK / 16) PM_LOAD(F.bid);
#pragma unroll 1
    for (int tile = F.bid; tile < NTOK / 16; tile += F.G) {
        const int row0 = tile * 16 + 2 * F.wave;
        Row m0, x0, m1, x1;
#pragma unroll
        for (int j = 0; j < 4; ++j) { m0.v[j] = (f32x4){bflo(pm[0][j].x), bfhi(pm[0][j].x), bflo(pm[0][j].y), bfhi(pm[0][j].y)}; m1.v[j] = (f32x4){bflo(pm[1][j].x), bfhi(pm[1][j].x), bflo(pm[1][j].y), bfhi(pm[1][j].y)};
            if (l == 0) { x0.v[j] = pxf[0][j]; x1.v[j] = pxf[1][j]; }
            else { x0.v[j] = (f32x4){bflo(pxb[0][j].x), bfhi(pxb[0][j].x), bflo(pxb[0][j].y), bfhi(pxb[0][j].y)}; x1.v[j] = (f32x4){bflo(pxb[1][j].x), bfhi(pxb[1][j].x), bflo(pxb[1][j].y), bfhi(pxb[1][j].y)}; } }
        if (tile + F.G < NTOK / 16) PM_LOAD(tile + F.G);
#pragma unroll
        for (int rr = 0; rr < 2; ++rr) {
            const int lr = 2 * F.wave + rr, row = row0 + rr, b = row >> 11; const float* mod = P_MOD + (size_t)(l * 8 + b) * 6144;
            const Row& m = rr ? m1 : m0; Row x = rr ? x1 : x0;
            const float r1 = row_rstd(m);
#pragma unroll
            for (int j = 0; j < 4; ++j) { const int k = 4 * F.lane + 256 * j; const f32x4 gp = *(const f32x4*)(A.in[I_NQM] + l * DM + k), g1 = *(const f32x4*)(mod + 2048 + k);
                x.v[j] = x.v[j] + g1 * (m.v[j] * r1 * gp); }
            row_store_bf16_nt(x, P_XB + (size_t)row * DM, F.lane);
            Row h; row_modnorm(h, x, A.in[I_NPF] + l * DM, mod + 3072, mod + 4096, F.lane);
#pragma unroll
            for (int j = 0; j < 4; ++j) *(unsigned*)(P_HB8 + (size_t)row * DM + 4 * F.lane + 256 * j) = pk8(SC_H * h.v[j].x, SC_H * h.v[j].y, SC_H * h.v[j].z, SC_H * h.v[j].w);
#pragma unroll
            for (int j = 0; j < 4; ++j) *(f32x4*)(h2s + lr * 1028 + 4 * F.lane + 256 * j) = h.v[j];
        }
        __syncthreads();
        {
            f32x4 d0 = {0.f, 0.f, 0.f, 0.f}, d1 = {0.f, 0.f, 0.f, 0.f};
            const int r16 = F.lane & 15, kq = F.lane >> 4;
#pragma unroll 8
            for (int ks = 0; ks < 32; ++ks) { const int k = 128 * F.wave + 4 * ks + kq;
                const float a = h2s[r16 * 1028 + k]; const float b0 = rw[k * 32 + r16], b1 = rw[k * 32 + 16 + r16];
                d0 = __builtin_amdgcn_mfma_f32_16x16x4f32(a, b0, d0, 0, 0, 0); d1 = __builtin_amdgcn_mfma_f32_16x16x4f32(a, b1, d1, 0, 0, 0); }
#pragma unroll
            for (int q = 0; q < 4; ++q) { red[(F.wave * 16 + 4 * kq + q) * 32 + r16] = d0[q]; red[(F.wave * 16 + 4 * kq + q) * 32 + 16 + r16] = d1[q]; }
        }
        __syncthreads();
        const int r = F.tid >> 5, e = F.tid & 31;
        { float s = A.in[I_RB][l * 32 + e];
#pragma unroll
          for (int w8 = 0; w8 < 8; ++w8) s += red[(w8 * 16 + r) * 32 + e];
          lg[r * 32 + e] = s; }
        __syncthreads();
        const float v = lg[r * 32 + e]; int rank = 0;
#pragma unroll 8
        for (int q = 0; q < 32; ++q) { const float u = lg[r * 32 + q]; rank += (u > v || (u == v && q < e)) ? 1 : 0; }
        if (rank < 4) tv[r * 4 + rank] = v;
        __syncthreads();
        if (rank < 4) { const f32x4 t4 = *(const f32x4*)(tv + r * 4);
            const float wsum = 1.f + __expf(t4.y - t4.x) + __expf(t4.z - t4.x) + __expf(t4.w - t4.x), wk = __expf(v - t4.x);
            const int token = tile * 16 + r, lpos = atomicAdd(lcnt + e, 1), slot = nent + r * 4 + rank;
            ent[slot * 4] = e; ent[slot * 4 + 1] = lpos; ent[slot * 4 + 2] = token * 4 + rank; ent[slot * 4 + 3] = __float_as_int(wk / wsum); }
        nent += 64;
        __syncthreads();
    }
#undef PM_LOAD
    unsigned* cntp = P_CNT; int* ltk = P_LTK; float* lgp = P_LG;
    if (F.tid < 32) { const int n = lcnt[F.tid]; lcnt[32 + F.tid] = n > 0 ? (int)atomicAdd(cntp + 64 * (l * 32 + F.tid), (unsigned)n) : 0; }
    __syncthreads();
    if (F.tid < nent) { const int e = ent[F.tid * 4], pos = lcnt[32 + e] + ent[F.tid * 4 + 1];
        ltk[(size_t)(l * 32 + e) * LISTCAP + pos] = ent[F.tid * 4 + 2]; lgp[(size_t)(l * 32 + e) * LISTCAP + pos] = __int_as_float(ent[F.tid * 4 + 3]); }
    __syncthreads();
}
__device__ __forceinline__ void p_combine(CArgs& A, const Frame& F, int l) {
    float* wl = (float*)F.lds; if (l == 0) stage_side(A, F, 1, wl);
    const int gw = F.bid * 8 + F.wave, NGW = F.G * 8;
    unsigned y[4][4]; Row xr;
#define COMB_LOAD(row_) do { _Pragma("unroll") for (int k = 0; k < 4; ++k) _Pragma("unroll") for (int j = 0; j < 4; ++j) y[k][j] = __builtin_nontemporal_load((const unsigned*)(P_Y + (size_t)((row_) * 4 + k) * DM + 4 * F.lane + 256 * j)); \
        row_load_bf16(xr, P_XB + (size_t)(row_) * DM, F.lane); } while (0)
    if (gw < NTOK) COMB_LOAD(gw);
#pragma unroll 1
    for (int row = gw; row < NTOK; row += NGW) {
        const int b = row >> 11; const float* mod = P_MOD + (size_t)(l * 8 + b) * 6144;
        Row f;
#pragma unroll
        for (int j = 0; j < 4; ++j) { f.v[j] = (f32x4){0.f, 0.f, 0.f, 0.f};
#pragma unroll
            for (int k = 0; k < 4; ++k) { const f32x2 lo = __builtin_amdgcn_cvt_pk_f32_fp8((int)y[k][j], false), hi = __builtin_amdgcn_cvt_pk_f32_fp8((int)y[k][j], true); f.v[j].x += lo.x; f.v[j].y += lo.y; f.v[j].z += hi.x; f.v[j].w += hi.y; }
            f.v[j] = f.v[j] * (1.f / SC_Y); }
        Row x = xr;
        if (row + NGW < NTOK) COMB_LOAD(row + NGW);
        const float r = row_rstd(f);
#pragma unroll
        for (int j = 0; j < 4; ++j) { const int k = 4 * F.lane + 256 * j; const f32x4 gp = *(const f32x4*)(A.in[I_NQF] + l * DM + k), g2 = *(const f32x4*)(mod + 5120 + k);
            x.v[j] = x.v[j] + g2 * (f.v[j] * r * gp); }
        if (l == 0) row_store_bf16_nt(x, P_XB + (size_t)row * DM, F.lane); else row_store(x, A.out + (size_t)row * DM, F.lane);
        if (l == 0) hprep_row(A, F, x, 1, row, wl);
    }
#undef COMB_LOAD
}
__device__ __forceinline__ int moe_tables(CArgs& A, const Frame& F, int l, LAS pg8::MoeTables* tb) {
    __syncthreads();
    if (F.tid < 32) tb->cnt[F.tid] = (int)__hip_atomic_load(P_CNT + 64 * (l * 32 + F.tid), __ATOMIC_RELAXED, __HIP_MEMORY_SCOPE_AGENT);
    __syncthreads();
    if (F.tid == 0) { int s = 0;
#pragma nounroll
        for (int e = 0; e < 32; ++e) { tb->mtstart[e] = s; s += (tb->cnt[e] + 255) >> 8; }
        tb->mtstart[32] = s; }
    __syncthreads();
    if (F.tid < 320) { int e = 0;
#pragma nounroll
        for (int q = 1; q < 32; ++q) if (tb->mtstart[q] <= F.tid) e = q;
        tb->tile_e[F.tid] = (unsigned char)e; }
    __syncthreads();
    return tb->mtstart[32];
}
__device__ __forceinline__ void fox_kbias(CArgs& A, const Frame& F, int b, int h, float* kb, float* wtot  ) {
    const int t0 = 4 * F.tid; float e[4];
#pragma unroll
    for (int i = 0; i < 4; ++i) e[i] = P_LSIG[(size_t)(b * SEQ + t0 + i) * 8 + h];
    const float s4 = (e[0] + e[1]) + (e[2] + e[3]); float v = s4;
#pragma unroll
    for (int o = 1; o < 64; o <<= 1) { const float tt = __shfl_up(v, o); if (F.lane >= o) v += tt; }
    if (F.lane == 63) wtot[F.wave] = v;
    __syncthreads();
    float off = 0.f;
#pragma unroll
    for (int w = 0; w < 8; ++w) if (w < F.wave) off += wtot[w];
    float c = off + v - s4;
#pragma unroll
    for (int i = 0; i < 4; ++i) { c += e[i]; kb[t0 + i] = -LOG2E * c; }
    __syncthreads();
}
#include <hip/hip_bf16.h>
namespace attn_body {
using bf16=__hip_bfloat16;
using bf16x8=__attribute__((ext_vector_type(8)))short;
using s16x4=__attribute__((ext_vector_type(4)))short;
using f32x16=__attribute__((ext_vector_type(16)))float;
using u32x4=__attribute__((ext_vector_type(4)))unsigned;
constexpr int BATCH=8,NHEAD=8,SEQ=2048,D=64,QP=2048,OP=1024;
constexpr int NW=8,QBLK=32,QB=QBLK*NW,KVBLK=64,NQB=SEQ/QB;
constexpr int ATTN_UNIT_ROWS=QB;
__device__ __forceinline__ int crow(int r,int hi){return (r&3)+8*(r>>2)+4*hi;}
#define SBAR() __builtin_amdgcn_sched_barrier(0)
__device__ __forceinline__ void cmask(f32x16&p0,f32x16&p1,int jb,int qrel,int hi){
  const float NEG=-INFINITY; int kb=64*jb+4*hi;
  #pragma unroll
  for(int r=0;r<16;++r){int kv=kb+(r&3)+8*(r>>2); if(kv>qrel)p0[r]=NEG; if(kv+32>qrel)p1[r]=NEG;}
}

constexpr int NSLOT=3, SLOTB=8192;
constexpr int LDS_K=0, LDS_V=NSLOT*SLOTB, LDS_WS=2*NSLOT*SLOTB, LDS_OST=LDS_WS+NW*64*4, LDS_BYTES=LDS_OST+NW*4096;
constexpr float C2=0.125f*1.4426950408889634f;
__device__ __forceinline__ void glds16(const void*gsrc,unsigned lds_dst){unsigned keep;
  asm volatile("s_mov_b32 %0, m0\n\ts_mov_b32 m0, %2\n\ts_nop 0\n\tglobal_load_lds_dwordx4 %1, off\n\ts_mov_b32 m0, %0":"=&s"(keep):"v"(gsrc),"s"(lds_dst):"memory");}
__device__ __forceinline__ float max3f(float a,float b,float c){float r;asm("v_max3_f32 %0, %1, %2, %3":"=v"(r):"v"(a),"v"(b),"v"(c));return r;}
__device__ __forceinline__ float max2f(float a,float b){float r;asm("v_max_f32_e32 %0, %1, %2":"=v"(r):"v"(a),"v"(b));return r;}
__device__ __forceinline__ float fadd_s(float a,float b){float r;asm("v_add_f32_e32 %0, %1, %2":"=v"(r):"v"(a),"v"(b));return r;}
__device__ __forceinline__ float fsub_s(float a,float b){float r;asm("v_sub_f32_e32 %0, %1, %2":"=v"(r):"v"(a),"v"(b));return r;}
typedef float f32x2_t __attribute__((ext_vector_type(2))); typedef float f32x4_t __attribute__((ext_vector_type(4))); typedef __bf16 bf16x2_t __attribute__((ext_vector_type(2)));
__device__ __forceinline__ unsigned cvtpk_s(float lo,float hi){f32x2_t v={lo,hi};bf16x2_t b=__builtin_convertvector(v,bf16x2_t);return __builtin_bit_cast(unsigned,b);}
#define WAIT_BAR(N) asm volatile("s_waitcnt vmcnt(" #N ") lgkmcnt(0)\n\ts_barrier":::"memory")

__device__ __forceinline__ void qkt(f32x16&p0,f32x16&p1,const char*Kslot,const bf16x8*qr,const f32x16&c0i,const f32x16&c1i,int r32,int hi){
  const char*kb=Kslot+hi*1024+r32*16;
  #pragma unroll
  for(int d0=0;d0<4;++d0){
    const bf16x8 b0=*reinterpret_cast<const bf16x8*>(kb+d0*2048);
    const bf16x8 b1=*reinterpret_cast<const bf16x8*>(kb+d0*2048+512);
    if(d0==0){p0=__builtin_amdgcn_mfma_f32_32x32x16_bf16(b0,qr[0],c0i,0,0,0);p1=__builtin_amdgcn_mfma_f32_32x32x16_bf16(b1,qr[0],c1i,0,0,0);}
    else{p0=__builtin_amdgcn_mfma_f32_32x32x16_bf16(b0,qr[d0],p0,0,0,0);p1=__builtin_amdgcn_mfma_f32_32x32x16_bf16(b1,qr[d0],p1,0,0,0);}}
}
typedef __attribute__((address_space(3))) const char* lds_cptr;
typedef short v4i16_t __attribute__((ext_vector_type(4)));
__device__ __forceinline__ void kload8(bf16x8*kf,lds_cptr kp){
  kf[0]=*(const __attribute__((address_space(3))) bf16x8*)(kp);      kf[1]=*(const __attribute__((address_space(3))) bf16x8*)(kp+512);
  kf[2]=*(const __attribute__((address_space(3))) bf16x8*)(kp+2048); kf[3]=*(const __attribute__((address_space(3))) bf16x8*)(kp+2560);
  kf[4]=*(const __attribute__((address_space(3))) bf16x8*)(kp+4096); kf[5]=*(const __attribute__((address_space(3))) bf16x8*)(kp+4608);
  kf[6]=*(const __attribute__((address_space(3))) bf16x8*)(kp+6144); kf[7]=*(const __attribute__((address_space(3))) bf16x8*)(kp+6656);
}
__device__ __forceinline__ void kload2(bf16x8*kf,lds_cptr kp,int j){ kf[2*j]=*(const __attribute__((address_space(3))) bf16x8*)(kp+j*2048); kf[2*j+1]=*(const __attribute__((address_space(3))) bf16x8*)(kp+j*2048+512); }
__device__ __forceinline__ s16x4 vtr(lds_cptr p){ return __builtin_bit_cast(s16x4,__builtin_amdgcn_ds_read_tr16_b64_v4i16((__attribute__((address_space(3))) v4i16_t*)p)); }
__device__ __forceinline__ float rowmax(const f32x16&p0,const f32x16&p1){
  float a=max3f(p0[0],p0[1],p1[0]),b=max3f(p0[2],p0[3],p1[1]);a=max3f(a,p1[2],p1[3]);
  #pragma unroll
  for(int r=4;r<16;r+=4){a=max3f(a,p0[r],p0[r+1]);b=max3f(b,p0[r+2],p0[r+3]);a=max3f(a,p1[r],p1[r+1]);b=max3f(b,p1[r+2],p1[r+3]);}
  const float m=max2f(a,b);
  auto rr=__builtin_amdgcn_permlane32_swap(__float_as_uint(m),__float_as_uint(m),false,false);
  return max2f(__uint_as_float(rr[0]),__uint_as_float(rr[1]));
}
__device__ __forceinline__ void pv(f32x16*o,int vb,bf16x8 pa0,bf16x8 pa1,bf16x8 pa2,bf16x8 pa3){
  #pragma unroll
  for(int d0=0;d0<2;++d0){s16x4 lo[4],hi[4];
    #pragma unroll
    for(int ks=0;ks<4;++ks){
      asm volatile("ds_read_b64_tr_b16 %0,%1 offset:%c2":"=&v"(lo[ks]):"v"(vb),"i"(d0*4096+ks*1024):"memory");
      asm volatile("ds_read_b64_tr_b16 %0,%1 offset:%c2":"=&v"(hi[ks]):"v"(vb),"i"(d0*4096+ks*1024+512):"memory");}
    asm volatile("s_waitcnt lgkmcnt(0)":::"memory");SBAR();
    #define PK(k) (bf16x8){lo[k][0],lo[k][1],lo[k][2],lo[k][3],hi[k][0],hi[k][1],hi[k][2],hi[k][3]}
    o[d0]=__builtin_amdgcn_mfma_f32_32x32x16_bf16(pa0,PK(0),o[d0],0,0,0);
    o[d0]=__builtin_amdgcn_mfma_f32_32x32x16_bf16(pa1,PK(1),o[d0],0,0,0);
    o[d0]=__builtin_amdgcn_mfma_f32_32x32x16_bf16(pa2,PK(2),o[d0],0,0,0);
    o[d0]=__builtin_amdgcn_mfma_f32_32x32x16_bf16(pa3,PK(3),o[d0],0,0,0);
    #undef PK
  }
}

#ifndef ATTN_STORE16
#define ATTN_STORE16(p,v) (*(u32x4*)(p)=(v))
#endif
typedef const __attribute__((address_space(3))) float* lds_fptr;
template<int THRL> __device__ __forceinline__ void attn_unit(int b,int h,int qb,const bf16*Q,const bf16*__restrict__ K,const bf16*__restrict__ V,bf16*O,char*shm,lds_fptr kb,int tid,int wid){
  const int lane=tid&63,r32=lane&31,hi=lane>>5;
  const long rowbase=(long)b*SEQ; const int q0=qb*QB;
  const bf16*Qw=Q+(rowbase+q0+wid*QBLK)*QP+h*D;
  const bf16*Kh=K+rowbase*QP+h*D,*Vh=V+rowbase*QP+h*D;
  const unsigned lds0=(unsigned)(uintptr_t)shm;
  float*wsf=(float*)(shm+LDS_WS)+wid*64;
  const bf16*ksrc=Kh+(long)lane*QP+wid*8;
  const bf16*vsrc=Vh+(long)(16*(wid&3)+(lane>>2))*QP+(wid>>2)*32+(lane&3)*8;
  const unsigned kdst=lds0+LDS_K+wid*1024, vdst=lds0+LDS_V+wid*1024;
  #define DMA_K(t,slot) glds16(ksrc+(long)(t)*KVBLK*QP,(unsigned)__builtin_amdgcn_readfirstlane(kdst+(slot)))
  #define DMA_V(t,slot) glds16(vsrc+(long)(t)*KVBLK*QP,(unsigned)__builtin_amdgcn_readfirstlane(vdst+(slot)))
  const int vb0=(int)(lds0+LDS_V)+((lane>>4)&1)*32+(lane&3)*8+(4*hi+((lane&15)>>2))*64;
  const char*Kbase=shm+LDS_K; bf16x8 kf[8];
  const lds_cptr shm3=(lds_cptr)shm; const lds_cptr kp0=shm3+LDS_K+hi*1024+r32*16; const lds_cptr vp0=shm3+LDS_V+((lane>>4)&1)*32+(lane&3)*8+(4*hi+((lane&15)>>2))*64;
  const int NT=(q0+QB)/KVBLK;
  DMA_K(0,0);DMA_V(0,0);DMA_K(1,SLOTB);
  bf16x8 qr[4];
  #pragma unroll
  for(int d0=0;d0<4;++d0)qr[d0]=*reinterpret_cast<const bf16x8*>(&Qw[(long)r32*QP+d0*16+hi*8]);
  float mhat=0.f,l_reg=0.f;f32x16 o[2];o[0]=f32x16{};o[1]=f32x16{};float nm=0.f;
  #define BIASFILL(C0,C1,t) do{ const lds_fptr kbt_=kb+64*(t)+4*hi; _Pragma("unroll") for(int g_=0;g_<4;++g_){ const f32x4_t v0_=*(const __attribute__((address_space(3))) f32x4_t*)(kbt_+8*g_), v1_=*(const __attribute__((address_space(3))) f32x4_t*)(kbt_+32+8*g_); \
      _Pragma("unroll") for(int i_=0;i_<4;++i_){ C0[4*g_+i_]=v0_[i_]+nm; C1[4*g_+i_]=v1_[i_]+nm; } } }while(0)
  const int qrel=wid*QBLK+r32;
  #define CMASK(P0,P1,t) do{int jb_=(t)-(NT-4); if(jb_>=0)cmask(P0,P1,jb_,qrel,hi);}while(0)
  bool resc=false;
  #define START(P0,P1) do{ const float rm=rowmax(P0,P1); resc=false; \
    { const float dl=rm; mhat=fadd_s(mhat,dl); \
      _Pragma("unroll") for(int r=0;r<16;++r){P0[r]=fsub_s(P0[r],dl);P1[r]=fsub_s(P1[r],dl);} \
      nm=-mhat; } \
    _Pragma("unroll") for(int r=0;r<16;++r)P0[r]=__builtin_amdgcn_exp2f(P0[r]); }while(0)
  #define RESC() do{ if(resc){ asm volatile("s_waitcnt lgkmcnt(0)":::"memory"); \
      _Pragma("unroll") for(int d_=0;d_<2;++d_) _Pragma("unroll") for(int r=0;r<16;++r)o[d_][r]*=wsf[crow(r,hi)]; } }while(0)
  f32x16 pA0,pA1,pB0,pB1;
  int sl_prev=0,sl_cur=0,sl_next=SLOTB;
  #define ROT() do{sl_prev=sl_cur;sl_cur=sl_next;sl_next=(sl_next==(NSLOT-1)*SLOTB)?0:sl_next+SLOTB;}while(0)
  DMA_K(2,2*SLOTB);
  WAIT_BAR(3);
  { f32x16 c0i,c1i; BIASFILL(c0i,c1i,0); qkt(pA0,pA1,Kbase,qr,c0i,c1i,r32,hi); }asm volatile("s_nop 15\n\ts_nop 7":"+v"(pA0),"+v"(pA1));CMASK(pA0,pA1,0);
  START(pA0,pA1);
  _Pragma("unroll") for(int r=0;r<16;++r)pA1[r]=__builtin_amdgcn_exp2f(pA1[r]);
  WAIT_BAR(0);
  DMA_K(3,0);DMA_V(1,SLOTB);
  ROT();
  kload8(kf,kp0+sl_cur);
  WAIT_BAR(2);
  s16x4 vlo[8],vhi[8]; u32x4 pw0,pw1,pw2,pw3;
  #define PKW(P,B) cvtpk_s(P[B],P[B+1])
  #define PAF(k) __builtin_bit_cast(bf16x8,pw##k)
  #define VFR(i) (bf16x8){vlo[i][0],vlo[i][1],vlo[i][2],vlo[i][3],vhi[i][0],vhi[i][1],vhi[i][2],vhi[i][3]}
  #define PIN(x) asm volatile("":"+v"(x))
  #define MX3(a,b,c) __builtin_fmaxf(__builtin_fmaxf((a),(b)),(c))
  #define GAPA(MF,A0,A1,A2,A3,W0,W1,PW) do{ MF; sacc+=A0; sacc+=A1; sacc+=A2; sacc+=A3; PIN(sacc); W0; W1; PIN(PW); SBAR(); }while(0)
  #define EX(v) __builtin_amdgcn_exp2f(v)
  #define GAPB(MF,X,B) do{ MF; X[B]=EX(X[B]); X[B+1]=EX(X[B+1]); X[B+2]=EX(X[B+2]); X[B+3]=EX(X[B+3]); PIN(X); SBAR(); }while(0)
  #define VRD(i) do{ vlo[i]=vtr(vp_+(((i)>>2)*4096+((i)&3)*1024)); vhi[i]=vtr(vp_+(((i)>>2)*4096+((i)&3)*1024+512)); }while(0)
  #define KRD(G,j) do{ if(G){ kload2(kf,kp0+sl_next,j); SBAR(); } }while(0)
  #define STEP(C0,C1,P0,P1,t,GK,GV,GL) do{ SBAR(); BIASFILL(C0,C1,t); SBAR(); \
    const lds_cptr vp_=vp0+sl_prev; \
    VRD(0); SBAR(); float sacc=(P0[0]+P0[1]); \
    GAPA(C0=__builtin_amdgcn_mfma_f32_32x32x16_bf16(kf[0],qr[0],C0,0,0,0), P0[2],P0[3],P0[4],P0[5],     pw0[0]=PKW(P0,0), pw0[1]=PKW(P0,2), pw0); \
    VRD(4); SBAR(); GAPA(C1=__builtin_amdgcn_mfma_f32_32x32x16_bf16(kf[1],qr[0],C1,0,0,0), P0[6],P0[7],P0[8],P0[9],     pw0[2]=PKW(P0,4), pw0[3]=PKW(P0,6), pw0); \
    VRD(1); SBAR(); GAPA(C0=__builtin_amdgcn_mfma_f32_32x32x16_bf16(kf[2],qr[1],C0,0,0,0),   P0[10],P0[11],P0[12],P0[13], pw1[0]=PKW(P0,8), pw1[1]=PKW(P0,10), pw1); \
    VRD(5); SBAR(); GAPA(C1=__builtin_amdgcn_mfma_f32_32x32x16_bf16(kf[3],qr[1],C1,0,0,0),   P0[14],P0[15],P1[0],P1[1],   pw1[2]=PKW(P0,12),pw1[3]=PKW(P0,14), pw1); \
    VRD(2); SBAR(); GAPA(C0=__builtin_amdgcn_mfma_f32_32x32x16_bf16(kf[4],qr[2],C0,0,0,0),   P1[2],P1[3],P1[4],P1[5],     pw2[0]=PKW(P1,0), pw2[1]=PKW(P1,2), pw2); \
    VRD(6); SBAR(); GAPA(C1=__builtin_amdgcn_mfma_f32_32x32x16_bf16(kf[5],qr[2],C1,0,0,0),   P1[6],P1[7],P1[8],P1[9],     pw2[2]=PKW(P1,4), pw2[3]=PKW(P1,6), pw2); \
    VRD(3); SBAR(); GAPA(C0=__builtin_amdgcn_mfma_f32_32x32x16_bf16(kf[6],qr[3],C0,0,0,0),   P1[10],P1[11],P1[12],P1[13], pw3[0]=PKW(P1,8), pw3[1]=PKW(P1,10), pw3); \
    VRD(7); SBAR(); GAPA(C1=__builtin_amdgcn_mfma_f32_32x32x16_bf16(kf[7],qr[3],C1,0,0,0),   P1[14],P1[15],0.f,0.f,       pw3[2]=PKW(P1,12),pw3[3]=PKW(P1,14), pw3); \
    l_reg+=sacc; \
    if(GK){DMA_K((t)+3,sl_cur);} if(GV){DMA_V((t)+1,sl_next);} \
    CMASK(C0,C1,t); \
    { float a=MX3(C0[0],C0[1],C1[0]),b=MX3(C0[2],C0[3],C1[1]); a=MX3(a,C1[2],C1[3]); \
      _Pragma("unroll") for(int r=4;r<16;r+=4){a=MX3(a,C0[r],C0[r+1]);b=MX3(b,C0[r+2],C0[r+3]);a=MX3(a,C1[r],C1[r+1]);b=MX3(b,C1[r+2],C1[r+3]);} \
      float rm=__builtin_fmaxf(a,b); { auto rr=__builtin_amdgcn_permlane32_swap(__float_as_uint(rm),__float_as_uint(rm),false,false); rm=__builtin_fmaxf(__uint_as_float(rr[0]),__uint_as_float(rr[1])); } \
      resc=false; \
      if(__builtin_expect(__any(rm>(float)THRL),0)){ const float dl=__builtin_fmaxf(rm,0.f); mhat+=dl; \
        _Pragma("unroll") for(int r=0;r<16;++r){C0[r]-=dl;C1[r]-=dl;} \
        nm=-mhat; \
        const float f=__builtin_amdgcn_exp2f(-dl); l_reg*=f; if(hi==0)wsf[r32]=f; resc=true; } } \
    SBAR(); \
    GAPB(o[0]=__builtin_amdgcn_mfma_f32_32x32x16_bf16(PAF(0),VFR(0),o[0],0,0,0), C0,0); \
    GAPB(o[1]=__builtin_amdgcn_mfma_f32_32x32x16_bf16(PAF(0),VFR(4),o[1],0,0,0), C0,4); \
    KRD(GL,0); GAPB(o[0]=__builtin_amdgcn_mfma_f32_32x32x16_bf16(PAF(1),VFR(1),o[0],0,0,0), C0,8); \
    KRD(GL,1); GAPB(o[1]=__builtin_amdgcn_mfma_f32_32x32x16_bf16(PAF(1),VFR(5),o[1],0,0,0), C0,12); \
    KRD(GL,2); GAPB(o[0]=__builtin_amdgcn_mfma_f32_32x32x16_bf16(PAF(2),VFR(2),o[0],0,0,0), C1,0); \
    KRD(GL,3); GAPB(o[1]=__builtin_amdgcn_mfma_f32_32x32x16_bf16(PAF(2),VFR(6),o[1],0,0,0), C1,4); \
    GAPB(o[0]=__builtin_amdgcn_mfma_f32_32x32x16_bf16(PAF(3),VFR(3),o[0],0,0,0), C1,8); \
    GAPB(o[1]=__builtin_amdgcn_mfma_f32_32x32x16_bf16(PAF(3),VFR(7),o[1],0,0,0), C1,12); \
    }while(0)
  int t=1;
  #undef CMASK
  #define CMASK(P0,P1,t) do{}while(0)
  for(;t+5<NT;t+=2){
    STEP(pB0,pB1,pA0,pA1,t,true,true,true);     WAIT_BAR(2); RESC(); ROT();
    STEP(pA0,pA1,pB0,pB1,t+1,true,true,true);   WAIT_BAR(2); RESC(); ROT();
  }
  #undef CMASK
  #define CMASK(P0,P1,t) do{int jb_=(t)-(NT-4); if(jb_>=0)cmask(P0,P1,jb_,qrel,hi);}while(0)
  #define ENDW(tt) do{ if((tt)+3<NT){WAIT_BAR(2);} else if((tt)+2<NT){WAIT_BAR(1);} else {WAIT_BAR(0);} }while(0)
  for(;t+1<NT;t+=2){
    STEP(pB0,pB1,pA0,pA1,t,(t+3<NT),(t+1<NT),(t+1<NT));       ENDW(t);   RESC(); ROT();
    STEP(pA0,pA1,pB0,pB1,t+1,(t+4<NT),(t+2<NT),(t+2<NT));     ENDW(t+1); RESC(); ROT();
  }
  STEP(pB0,pB1,pA0,pA1,NT-1,false,false,false); RESC();
  { float sacc=pB0[0]+pB0[1]; _Pragma("unroll") for(int r=2;r<16;++r)sacc+=pB0[r]; _Pragma("unroll") for(int r=0;r<16;++r)sacc+=pB1[r]; l_reg+=sacc;
    pw0=(u32x4){PKW(pB0,0),PKW(pB0,2),PKW(pB0,4),PKW(pB0,6)};pw1=(u32x4){PKW(pB0,8),PKW(pB0,10),PKW(pB0,12),PKW(pB0,14)};pw2=(u32x4){PKW(pB1,0),PKW(pB1,2),PKW(pB1,4),PKW(pB1,6)};pw3=(u32x4){PKW(pB1,8),PKW(pB1,10),PKW(pB1,12),PKW(pB1,14)};
    SBAR(); pv(o,vb0+sl_cur,PAF(0),PAF(1),PAF(2),PAF(3)); }
  #undef PKW
  #undef PAF
  #undef VFR
  #undef PIN
  #undef MX3
  #undef GAPA
  #undef GAPB
  #undef EX
  #undef VRD
  #undef KRD
  #undef STEP
  #undef ENDW
  {auto rr=__builtin_amdgcn_permlane32_swap(__float_as_uint(l_reg),__float_as_uint(l_reg),false,false);l_reg=__uint_as_float(rr[0])+__uint_as_float(rr[1]);}
  if(hi==0)wsf[32+r32]=l_reg;asm volatile("s_waitcnt lgkmcnt(0)":::"memory");
  float rli[16];
  #pragma unroll
  for(int r=0;r<16;++r)rli[r]=__builtin_amdgcn_rcpf(wsf[32+crow(r,hi)]);
  bf16*Ow=O+(rowbase+q0+wid*QBLK)*OP+h*D;
  { bf16*stg=(bf16*)(shm+LDS_OST)+wid*2048;
    #pragma unroll
    for(int r=0;r<16;++r){const int orow=crow(r,hi);
      #pragma unroll
      for(int d0=0;d0<2;++d0)stg[orow*64+d0*32+r32]=__float2bfloat16(o[d0][r]*rli[r]);}
    asm volatile("s_waitcnt lgkmcnt(0)":::"memory");
    #pragma unroll
    for(int i=0;i<4;++i){const int row=i*8+(lane>>3),ch=lane&7; const u32x4 v=*(const u32x4*)(stg+row*64+ch*8); ATTN_STORE16(Ow+(long)row*OP+ch*8,v);} }
  asm volatile("s_waitcnt lgkmcnt(0)\n\ts_barrier":::"memory");
  #undef DMA_K
  #undef DMA_V
  #undef CMASK
  #undef START
  #undef RESC
  #undef ROT
  #undef BIASFILL
}
constexpr int ATTN_LDS_BYTES=LDS_BYTES;
#undef SBAR
#undef WAIT_BAR
}
__device__ __forceinline__ void fox_fast(CArgs& A, const Frame& F) {
    float* kb = (float*)(F.lds + 86016); float* wtot = kb + 2048;
    const int v = (F.bid & 7) * 32 + (F.bid >> 3), bh = v >> 2, s = v & 3, b = bh >> 3, h = bh & 7;
    fox_kbias(A, F, b, h, kb, wtot);
    const attn_body::bf16* Zb = (const attn_body::bf16*)P_Z;
    const attn_body::lds_fptr kb3 = (attn_body::lds_fptr)(const __attribute__((address_space(3))) unsigned char*)((LAS unsigned char*)F.lds + 86016);
    attn_body::attn_unit<8>(b, h, 7 - s, Zb + 512, Zb + 1024, Zb + 1536, (attn_body::bf16*)P_YCAT + 512, (char*)F.lds, kb3, F.tid, F.wave);
    attn_body::attn_unit<8>(b, h, s, Zb + 512, Zb + 1024, Zb + 1536, (attn_body::bf16*)P_YCAT + 512, (char*)F.lds, kb3, F.tid, F.wave);
}
typedef float f32x16 __attribute__((ext_vector_type(16)));
__device__ __forceinline__ bf16x8 pack8(const f32x4& a, const f32x4& b) { u32x4 w; w.x = pk2(a.x, a.y); w.y = pk2(a.z, a.w); w.z = pk2(b.x, b.y); w.w = pk2(b.z, b.w); return __builtin_bit_cast(bf16x8, w); }
__device__ __forceinline__ void s5_fast(CArgs& A, const Frame& F, int item) {
    const int b = item >> 5, g = item & 31, lane = F.lane, w = F.wave, p = lane & 31, hh = lane >> 5, l15 = lane & 15, l4 = lane >> 4;
    float* Eseg = (float*)F.lds; float* Hin = Eseg + 2048;
    bf16_t* Hs = (bf16_t*)(F.lds + 16384) + w * 4352;
    bf16x8 bbr[2], bbi[2]; float are[2], aim[2];
#pragma unroll
    for (int nt = 0; nt < 2; ++nt) { const float* q = P_S5BB + (size_t)(g * 64 + 32 * nt + p) * 32 + 8 * hh;
        bbr[nt] = pack8(*(const f32x4*)q, *(const f32x4*)(q + 4)); bbi[nt] = pack8(*(const f32x4*)(q + 16), *(const f32x4*)(q + 20));
        are[nt] = P_S5A[(g * 64 + 32 * nt + p) * 2]; aim[nt] = P_S5A[(g * 64 + 32 * nt + p) * 2 + 1]; }
    const int rr = lane & 31, ahalf = (rr >> 2) & 1, atau = (rr & 3) + 4 * (rr >> 3);
    const bf16_t* usrc = P_Z + (size_t)(b * SEQ + 128 * (2 * w + ahalf) + atau) * ZP0 + g * 16 + 8 * hh;
    const f32x16 zero16 = {0.f, 0.f, 0.f, 0.f, 0.f, 0.f, 0.f, 0.f, 0.f, 0.f, 0.f, 0.f, 0.f, 0.f, 0.f, 0.f};
    float hr[2] = {0.f, 0.f}, hi[2] = {0.f, 0.f};
#define S5_ALOAD(blk_) (*(const bf16x8*)(usrc + (size_t)(blk_) * 16 * ZP0))
    { bf16x8 a0 = S5_ALOAD(0), a1 = S5_ALOAD(1), a2 = S5_ALOAD(2);
#pragma unroll 1
      for (int blk = 0; blk < 8; ++blk) {
        const bf16x8 a = a0; a0 = a1; a1 = a2; if (blk + 3 < 8) a2 = S5_ALOAD(blk + 3);
#pragma unroll
        for (int nt = 0; nt < 2; ++nt) {
            const f32x16 dre = __builtin_amdgcn_mfma_f32_32x32x16_bf16(a, bbr[nt], zero16, 0, 0, 0), dim = __builtin_amdgcn_mfma_f32_32x32x16_bf16(a, bbi[nt], zero16, 0, 0, 0);
#pragma unroll
            for (int i = 0; i < 16; ++i) { const float nr = are[nt] * hr[nt] - aim[nt] * hi[nt] + dre[i], ni = are[nt] * hi[nt] + aim[nt] * hr[nt] + dim[i]; hr[nt] = nr; hi[nt] = ni; }
        }
      } }
#pragma unroll
    for (int nt = 0; nt < 2; ++nt) { Eseg[((2 * w + hh) * 64 + 32 * nt + p) * 2] = hr[nt]; Eseg[((2 * w + hh) * 64 + 32 * nt + p) * 2 + 1] = hi[nt]; }
    __syncthreads();
    if (w == 0) {
        float xr = P_S5A[(g * 64 + lane) * 2], xi = P_S5A[(g * 64 + lane) * 2 + 1];
#pragma unroll
        for (int q = 0; q < 7; ++q) { const float nr = xr * xr - xi * xi, ni = 2.f * xr * xi; xr = nr; xi = ni; }
        float Hr = 0.f, Hi = 0.f;
#pragma unroll 1
        for (int s = 0; s < 16; ++s) { Hin[(s * 64 + lane) * 2] = Hr; Hin[(s * 64 + lane) * 2 + 1] = Hi;
            const float er = Eseg[(s * 64 + lane) * 2], ei = Eseg[(s * 64 + lane) * 2 + 1]; const float nr = xr * Hr - xi * Hi + er, ni = xr * Hi + xi * Hr + ei; Hr = nr; Hi = ni; }
    }
    __syncthreads();
#pragma unroll
    for (int nt = 0; nt < 2; ++nt) { hr[nt] = Hin[((2 * w + hh) * 64 + 32 * nt + p) * 2]; hi[nt] = Hin[((2 * w + hh) * 64 + 32 * nt + p) * 2 + 1]; }
    bf16x8 ck[4];
#pragma unroll
    for (int ks = 0; ks < 4; ++ks) ck[ks] = *(const bf16x8*)(P_S5CK + (size_t)(g * 16 + l15) * 128 + 32 * ks + 8 * l4);
    const int er = lane >> 1, eh = lane & 1;
    float* Ys = (float*)(F.lds + 86016) + w * 640;
    f32x4 dk0 = *(const f32x4*)(A.in[I_S5D] + g * 16 + 8 * eh), dk1 = *(const f32x4*)(A.in[I_S5D] + g * 16 + 8 * eh + 4);
#define S5_EROW(blk_) ((size_t)(b * SEQ + 128 * (2 * w + (er >> 4)) + 16 * (blk_) + (er & 15)))
    bf16x8 a0 = S5_ALOAD(0), a1 = S5_ALOAD(1), a2 = S5_ALOAD(2);
    u32x4 un = *(const u32x4*)(P_Z + S5_EROW(0) * ZP0 + g * 16 + 8 * eh);
#pragma unroll 1
    for (int blk = 0; blk < 8; ++blk) {
        const bf16x8 a = a0; a0 = a1; a1 = a2; if (blk + 3 < 8) a2 = S5_ALOAD(blk + 3);
        const u32x4 us = un; if (blk + 1 < 8) un = *(const u32x4*)(P_Z + S5_EROW(blk + 1) * ZP0 + g * 16 + 8 * eh);
#pragma unroll
        for (int nt = 0; nt < 2; ++nt) {
            const f32x16 dre = __builtin_amdgcn_mfma_f32_32x32x16_bf16(a, bbr[nt], zero16, 0, 0, 0), dim = __builtin_amdgcn_mfma_f32_32x32x16_bf16(a, bbi[nt], zero16, 0, 0, 0);
#pragma unroll
            for (int i = 0; i < 16; ++i) { const float nr = are[nt] * hr[nt] - aim[nt] * hi[nt] + dre[i], ni = are[nt] * hi[nt] + aim[nt] * hr[nt] + dim[i]; hr[nt] = nr; hi[nt] = ni;
                *(unsigned*)(Hs + (hh * 16 + i) * 136 + 2 * (32 * nt + p)) = pk2(nr, ni); }
        }
        LDS_WAIT();
#pragma unroll
        for (int sg = 0; sg < 2; ++sg) {
            f32x4 y = {0.f, 0.f, 0.f, 0.f};
#pragma unroll
            for (int ks = 0; ks < 4; ++ks) { const bf16x8 af = *(const bf16x8*)(Hs + (sg * 16 + l15) * 136 + 32 * ks + 8 * l4); y = __builtin_amdgcn_mfma_f32_16x16x32_bf16(af, ck[ks], y, 0, 0, 0); }
#pragma unroll
            for (int q = 0; q < 4; ++q) Ys[(sg * 16 + 4 * l4 + q) * 20 + l15] = y[q];
        }
        LDS_WAIT();
        { const f32x4 y0 = *(const f32x4*)(Ys + er * 20 + 8 * eh), y1 = *(const f32x4*)(Ys + er * 20 + 8 * eh + 4);
          float o[8]; o[0] = y0.x + dk0.x * bflo(us.x); o[1] = y0.y + dk0.y * bfhi(us.x); o[2] = y0.z + dk0.z * bflo(us.y); o[3] = y0.w + dk0.w * bfhi(us.y);
          o[4] = y1.x + dk1.x * bflo(us.z); o[5] = y1.y + dk1.y * bfhi(us.z); o[6] = y1.z + dk1.z * bflo(us.w); o[7] = y1.w + dk1.w * bfhi(us.w);
          u32x4 ov; ov.x = pk2(gelu_tanh(o[0]), gelu_tanh(o[1])); ov.y = pk2(gelu_tanh(o[2]), gelu_tanh(o[3])); ov.z = pk2(gelu_tanh(o[4]), gelu_tanh(o[5])); ov.w = pk2(gelu_tanh(o[6]), gelu_tanh(o[7]));
          *(u32x4*)(P_G5 + S5_EROW(blk) * 512 + g * 16 + 8 * eh) = ov; }
        LDS_WAIT();
    }
#undef S5_ALOAD
#undef S5_EROW
}
namespace lin {
typedef const LAS char* lptr;
typedef short s16x4 __attribute__((ext_vector_type(4)));
typedef short v4i16_t __attribute__((ext_vector_type(4)));
__device__ __forceinline__ s16x4 vtr(lptr p) { return __builtin_bit_cast(s16x4, __builtin_amdgcn_ds_read_tr16_b64_v4i16((LAS v4i16_t*)p)); }
__device__ __forceinline__ bf16x8 tr_frag(lptr sub, int ks, int lane) {
    const lptr p = sub + ((lane >> 4) & 1) * 32 + (lane & 3) * 8 + (4 * (lane >> 5) + ((lane & 15) >> 2)) * 64 + ks * 1024;
    const s16x4 lo = vtr(p), hi = vtr(p + 512);
    return (bf16x8){lo[0], lo[1], lo[2], lo[3], hi[0], hi[1], hi[2], hi[3]};
}
__device__ __forceinline__ bf16x8 nat_frag(lptr base, int ldb, int row0, int k0, int lane) { return *(const LAS bf16x8*)(base + (row0 + (lane & 31)) * ldb + (k0 + 8 * (lane >> 5)) * 2); }
__device__ __forceinline__ int crow(int r, int hh) { return (r & 3) + 8 * (r >> 2) + 4 * hh; }
__device__ __forceinline__ void unpack8(const u32x4& w, float (&f)[8]) { f[0] = bflo(w.x); f[1] = bfhi(w.x); f[2] = bflo(w.y); f[3] = bfhi(w.y); f[4] = bflo(w.z); f[5] = bfhi(w.z); f[6] = bflo(w.w); f[7] = bfhi(w.w); }
__device__ __forceinline__ u32x4 repack8(const float (&f)[8]) { u32x4 w; w.x = pk2(f[0], f[1]); w.y = pk2(f[2], f[3]); w.z = pk2(f[4], f[5]); w.w = pk2(f[6], f[7]); return w; }

__device__ __forceinline__ void gla_prefix(CArgs& A, const Frame& F, int item) {
    const int b = item >> 5, c = item & 31, half = F.tid >> 8, col = F.tid & 255;
    float* p = P_LOGA + (size_t)(b * SEQ + c * 64 + 32 * half) * 256 + col; float* tot = (float*)F.lds;
    float v[32];
#pragma unroll
    for (int i = 0; i < 32; ++i) v[i] = p[(size_t)i * 256];
#pragma unroll
    for (int i = 1; i < 32; ++i) v[i] += v[i - 1];
    if (half == 0) tot[col] = v[31];
    __syncthreads();
    const float off = half ? tot[col] : 0.f;
#pragma unroll
    for (int i = 0; i < 32; ++i) p[(size_t)i * 256] = v[i] + off;
    __syncthreads();
}
template <int KIND> __device__ __forceinline__ void r1_item(CArgs& A, const Frame& F, int bh, int vs) {
    constexpr int DK = KIND ? 64 : 128, ND = DK / 32;
    constexpr int KCOL = KIND ? 2304 : 512, VCOL = KIND ? 2560 : 1024;
    const int b = bh >> 2, h = bh & 3, tid = F.tid, lane = F.lane, w = F.wave, hh = lane >> 5;
    unsigned char* bufV = F.lds; unsigned char* bufK = F.lds + 4096;
    bf16_t* ST = (KIND ? P_GST : P_RST) + (size_t)bh * 32 * 128 * DK;
    const float log2g = KIND ? 0.f : log2f(1.f - exp2f(-5.f - (float)h));
    const float g64 = exp2f(64.f * log2g);
    f32x16 acc = {0.f, 0.f, 0.f, 0.f, 0.f, 0.f, 0.f, 0.f, 0.f, 0.f, 0.f, 0.f, 0.f, 0.f, 0.f, 0.f};
    const bf16_t* zb = P_Z + (size_t)(b * SEQ) * ZP1;
    const int vj = tid >> 2, vc = tid & 3;
    const int kj0 = KIND ? (tid >> 3) : (tid >> 4), kd0 = KIND ? (tid & 7) : (tid & 15);
#define R1_DECL(S) u32x4 rv##S = {0u, 0u, 0u, 0u}, rk0##S = {0u, 0u, 0u, 0u}, rk1##S = {0u, 0u, 0u, 0u}; f32x4 bj0##S = {0.f, 0.f, 0.f, 0.f}, bj1##S = bj0##S, bl0##S = bj0##S, bl1##S = bj0##S; float bd##S = 0.f;
#define R1_LOAD(S, c) do { const bf16_t* zc = zb + (size_t)((c) * 64) * ZP1; \
        if (tid < 256) rv##S = *(const u32x4*)(zc + (size_t)vj * ZP1 + VCOL + h * 128 + vs * 32 + vc * 8); \
        rk0##S = *(const u32x4*)(zc + (size_t)kj0 * ZP1 + KCOL + h * DK + kd0 * 8); \
        if (!KIND) rk1##S = *(const u32x4*)(zc + (size_t)(kj0 + 32) * ZP1 + KCOL + h * DK + kd0 * 8); \
        if (KIND) { const float* bp = P_LOGA + (size_t)(b * SEQ + (c) * 64) * 256 + h * 64; \
            bj0##S = *(const f32x4*)(bp + (size_t)kj0 * 256 + kd0 * 8); bj1##S = *(const f32x4*)(bp + (size_t)kj0 * 256 + kd0 * 8 + 4); \
            bl0##S = *(const f32x4*)(bp + 63 * 256 + kd0 * 8); bl1##S = *(const f32x4*)(bp + 63 * 256 + kd0 * 8 + 4); \
            if (w < ND) bd##S = bp[63 * 256 + 32 * w + (lane & 31)]; } } while (0)
#define R1_STEP(S, c) do { \
        if (tid < 256) { u32x4 o = rv##S; \
            if (!KIND) { float f[8]; unpack8(rv##S, f); const float z = exp2f((float)(63 - vj) * log2g); _Pragma("unroll") for (int e = 0; e < 8; ++e) f[e] *= z; o = repack8(f); } \
            *(u32x4*)(bufV + vj * 64 + vc * 16) = o; } \
        if (KIND) { float f[8]; unpack8(rk0##S, f); \
            f[0] *= __expf(bl0##S.x - bj0##S.x); f[1] *= __expf(bl0##S.y - bj0##S.y); f[2] *= __expf(bl0##S.z - bj0##S.z); f[3] *= __expf(bl0##S.w - bj0##S.w); \
            f[4] *= __expf(bl1##S.x - bj1##S.x); f[5] *= __expf(bl1##S.y - bj1##S.y); f[6] *= __expf(bl1##S.z - bj1##S.z); f[7] *= __expf(bl1##S.w - bj1##S.w); \
            *(u32x4*)(bufK + (kd0 >> 2) * 4096 + kj0 * 64 + (kd0 & 3) * 16) = repack8(f); \
        } else { \
            *(u32x4*)(bufK + (kd0 >> 2) * 4096 + kj0 * 64 + (kd0 & 3) * 16) = rk0##S; \
            *(u32x4*)(bufK + (kd0 >> 2) * 4096 + (kj0 + 32) * 64 + (kd0 & 3) * 16) = rk1##S; } \
        __syncthreads(); \
        const float decn = KIND ? __expf(bd##S) : 0.f; \
        if ((c) + 4 < 32) R1_LOAD(S, (c) + 4); \
        if (w < ND) { \
            bf16_t* sp = ST + ((size_t)(c) * 128 + vs * 32) * DK + 32 * w + (lane & 31); \
            const float dec = KIND ? decn : g64; \
            _Pragma("unroll") for (int r = 0; r < 16; ++r) { sp[(size_t)crow(r, hh) * DK] = (bf16_t)f2bf(acc[r]); acc[r] *= dec; } \
            _Pragma("unroll") for (int ks = 0; ks < 4; ++ks) acc = __builtin_amdgcn_mfma_f32_32x32x16_bf16(tr_frag((lptr)(LAS unsigned char*)bufV, ks, lane), tr_frag((lptr)(LAS unsigned char*)bufK + w * 4096, ks, lane), acc, 0, 0, 0); \
        } \
        __syncthreads(); } while (0)
    R1_DECL(0) R1_DECL(1) R1_DECL(2) R1_DECL(3)
    R1_LOAD(0, 0); R1_LOAD(1, 1); R1_LOAD(2, 2); R1_LOAD(3, 3);
#pragma unroll 1
    for (int c = 0; c < 32; c += 4) { R1_STEP(0, c); R1_STEP(1, c + 1); R1_STEP(2, c + 2); R1_STEP(3, c + 3); }
#undef R1_DECL
#undef R1_LOAD
#undef R1_STEP
}
__device__ __forceinline__ void p_lin_r1(CArgs& A, const Frame& F) {
    const int v = F.bid, r = v & 127;
    if (v < 128) r1_item<0>(A, F, r >> 2, r & 3); else r1_item<1>(A, F, r >> 2, r & 3);
}

template <int KIND> struct R2Regs {
    static constexpr int DK = KIND ? 64 : 128, NQP = 64 * DK / 8 / 512, NSP = 128 * DK / 8 / 512;
    u32x4 q[NQP], k[NQP], v[2], s[NSP], g[2]; f32x4 bq[NQP][2];
};
template <int KIND> __device__ __forceinline__ void r2_load(CArgs& A, const Frame& F, R2Regs<KIND>& R, int bh, int c) {
    constexpr int DK = KIND ? 64 : 128;
    constexpr int QCOL = KIND ? 2048 : 0, KCOL = KIND ? 2304 : 512, VCOL = KIND ? 2560 : 1024, GCOL = KIND ? 3072 : 1536;
    const int b = bh >> 2, h = bh & 3, tid = F.tid, lane = F.lane, w = F.wave, hh = lane >> 5, l31 = lane & 31, rb = w >> 2, cb = w & 3;
    const bf16_t* zc = P_Z + (size_t)(b * SEQ + c * 64) * ZP1;
    const bf16_t* ST = (KIND ? P_GST : P_RST) + ((size_t)bh * 32 + c) * 128 * DK;
#pragma unroll
    for (int r = 0; r < R2Regs<KIND>::NQP; ++r) { const int q = tid + 512 * r, i = q / (DK / 8), d8 = q % (DK / 8);
        R.q[r] = *(const u32x4*)(zc + (size_t)i * ZP1 + QCOL + h * DK + d8 * 8); R.k[r] = *(const u32x4*)(zc + (size_t)i * ZP1 + KCOL + h * DK + d8 * 8);
        if (KIND) { const float* bp = P_LOGA + (size_t)(b * SEQ + c * 64 + i) * 256 + h * 64 + d8 * 8; R.bq[r][0] = *(const f32x4*)bp; R.bq[r][1] = *(const f32x4*)(bp + 4); } }
#pragma unroll
    for (int r = 0; r < 2; ++r) { const int q = tid + 512 * r, j = q >> 4, v8 = q & 15; R.v[r] = *(const u32x4*)(zc + (size_t)j * ZP1 + VCOL + h * 128 + v8 * 8); }
#pragma unroll
    for (int r = 0; r < R2Regs<KIND>::NSP; ++r) { const int q = tid + 512 * r, vr = q / (DK / 8), d8 = q % (DK / 8); R.s[r] = *(const u32x4*)(ST + (size_t)vr * DK + d8 * 8); }
#pragma unroll
    for (int k2 = 0; k2 < 2; ++k2) { const int pp = lane + 64 * k2; R.g[k2] = *(const u32x4*)(zc + (size_t)(32 * rb + (pp >> 2)) * ZP1 + GCOL + h * 128 + 32 * cb + 8 * (pp & 3)); }
}
template <int KIND> struct R2Lds { static constexpr int DK = KIND ? 64 : 128, LDQ = (DK + 8) * 2, OFF_K = 64 * LDQ, OFF_V = 2 * 64 * LDQ, OFF_S = OFF_V + 16384, OFF_SSQ = OFF_S + 128 * LDQ, OFF_BC = OFF_SSQ + 1024; };
template <int KIND> __device__ __forceinline__ void r2_stage(const Frame& F, const R2Regs<KIND>& R, u32x4 (&gc)[2]) {
    typedef R2Lds<KIND> LL; constexpr int DK = LL::DK, LDQ = LL::LDQ;
    const int tid = F.tid; unsigned char* L = F.lds;
#pragma unroll
    for (int r = 0; r < R2Regs<KIND>::NQP; ++r) { const int q = tid + 512 * r, i = q / (DK / 8), d8 = q % (DK / 8);
        u32x4 qw = R.q[r], kw = R.k[r];
        if (KIND) { float fq[8], fk[8]; unpack8(qw, fq); unpack8(kw, fk);
#pragma unroll
            for (int e = 0; e < 8; ++e) { const float bb = R.bq[r][e >> 2][e & 3]; fq[e] *= __expf(bb); fk[e] *= __expf(-bb); }
            qw = repack8(fq); kw = repack8(fk); }
        *(u32x4*)(L + i * LDQ + d8 * 16) = qw; *(u32x4*)(L + LL::OFF_K + i * LDQ + d8 * 16) = kw; }
#pragma unroll
    for (int r = 0; r < 2; ++r) { const int q = tid + 512 * r, j = q >> 4, v8 = q & 15; *(u32x4*)(L + LL::OFF_V + (v8 >> 2) * 4096 + j * 64 + (v8 & 3) * 16) = R.v[r]; }
#pragma unroll
    for (int r = 0; r < R2Regs<KIND>::NSP; ++r) { const int q = tid + 512 * r, vr = q / (DK / 8), d8 = q % (DK / 8); *(u32x4*)(L + LL::OFF_S + vr * LDQ + d8 * 16) = R.s[r]; }
    gc[0] = R.g[0]; gc[1] = R.g[1];
    __syncthreads();
}
template <int KIND> __device__ __forceinline__ void r2_compute(CArgs& A, const Frame& F, int bh, int c, const u32x4 (&gc)[2]) {
    typedef R2Lds<KIND> LL; constexpr int DK = LL::DK, LDQ = LL::LDQ, OFF_K = LL::OFF_K, OFF_V = LL::OFF_V, OFF_S = LL::OFF_S;
    constexpr int OCOL = KIND ? 512 : 0;
    const int b = bh >> 2, h = bh & 3, lane = F.lane, w = F.wave, hh = lane >> 5, l31 = lane & 31, rb = w >> 2, cb = w & 3;
    unsigned char* L = F.lds; float* ssq = (float*)(L + LL::OFF_SSQ);
    const float log2g = KIND ? 0.f : log2f(1.f - exp2f(-5.f - (float)h));
    const lptr L3 = (lptr)(LAS unsigned char*)L;
    bf16x8 pa[2][2];
#pragma unroll
    for (int jt = 0; jt < 2; ++jt) {
        f32x16 p = {0.f, 0.f, 0.f, 0.f, 0.f, 0.f, 0.f, 0.f, 0.f, 0.f, 0.f, 0.f, 0.f, 0.f, 0.f, 0.f};
        if (jt <= rb) {
#pragma unroll
            for (int ks = 0; ks < DK / 16; ++ks) p = __builtin_amdgcn_mfma_f32_32x32x16_bf16(nat_frag(L3 + OFF_K, LDQ, 32 * jt, 16 * ks, lane), nat_frag(L3, LDQ, 32 * rb, 16 * ks, lane), p, 0, 0, 0);
        }
        const int i = 32 * rb + l31;
        float f[16];
#pragma unroll
        for (int r = 0; r < 16; ++r) { const int j = 32 * jt + crow(r, hh); float x = (i >= j) ? p[r] : 0.f; if (!KIND) x *= exp2f((float)(i - j) * log2g); f[r] = (i >= j) ? x : 0.f; }
#pragma unroll
        for (int s = 0; s < 2; ++s) { u32x4 wv; wv.x = pk2(f[8 * s], f[8 * s + 1]); wv.y = pk2(f[8 * s + 2], f[8 * s + 3]); wv.z = pk2(f[8 * s + 4], f[8 * s + 5]); wv.w = pk2(f[8 * s + 6], f[8 * s + 7]); pa[jt][s] = __builtin_bit_cast(bf16x8, wv); }
    }
    f32x16 o1 = {0.f, 0.f, 0.f, 0.f, 0.f, 0.f, 0.f, 0.f, 0.f, 0.f, 0.f, 0.f, 0.f, 0.f, 0.f, 0.f}, o2 = o1;
#pragma unroll
    for (int jt = 0; jt < 2; ++jt)
#pragma unroll
        for (int s = 0; s < 2; ++s) o1 = __builtin_amdgcn_mfma_f32_32x32x16_bf16(pa[jt][s], tr_frag(L3 + OFF_V + cb * 4096, 2 * jt + s, lane), o1, 0, 0, 0);
#pragma unroll
    for (int ks = 0; ks < DK / 16; ++ks) o2 = __builtin_amdgcn_mfma_f32_32x32x16_bf16(nat_frag(L3, LDQ, 32 * rb, 16 * ks, lane), nat_frag(L3 + OFF_S, LDQ, 32 * cb, 16 * ks, lane), o2, 0, 0, 0);
    float o[16];
#pragma unroll
    for (int r = 0; r < 16; ++r) { const int i = 32 * rb + crow(r, hh); const float xi = KIND ? 1.f : exp2f((float)(i + 1) * log2g); o[r] = o1[r] + xi * o2[r];
        const float sq = half_sum(o[r] * o[r]); if (l31 == 0) ssq[i * 4 + cb] = sq; }
    __syncthreads();
    float* Os = (float*)L + w * (32 * 33);
#pragma unroll
    for (int r = 0; r < 16; ++r) Os[crow(r, hh) * 33 + l31] = o[r];
    LDS_WAIT();
#pragma unroll
    for (int k2 = 0; k2 < 2; ++k2) { const int pp = lane + 64 * k2, rw = pp >> 2, ch = pp & 3, i = 32 * rb + rw;
        const f32x4 s4 = *(const f32x4*)(ssq + i * 4);
        const float rn = rsqrtf(((s4.x + s4.y) + (s4.z + s4.w)) * (1.f / 128.f) + EPS);
        float gv[8]; unpack8(gc[k2], gv); float y[8];
#pragma unroll
        for (int e = 0; e < 8; ++e) y[e] = siluf_(gv[e]) * Os[rw * 33 + 8 * ch + e] * rn;
        *(u32x4*)(P_YCAT + (size_t)(b * SEQ + c * 64 + i) * DM + OCOL + h * 128 + 32 * cb + 8 * ch) = repack8(y); }
    __syncthreads();
}
template <int KIND> __device__ __forceinline__ void r2_run(CArgs& A, const Frame& F0, int first, int n, int stride) {
    R2Regs<KIND> R; u32x4 gc[2];
    { Frame G2 = F0; int t_ = F0.tid; asm volatile("" : "+v"(t_)); G2.tid = t_; G2.lane = t_ & 63; r2_load<KIND>(A, G2, R, (first & 1023) >> 5, first & 31); }
#pragma unroll 1
    for (int i = 0; i < n; ++i) {
        Frame G2 = F0; { int t_ = F0.tid; asm volatile("" : "+v"(t_)); G2.tid = t_; G2.lane = t_ & 63; }
        const int r = (first + i * stride) & 1023;
        r2_stage<KIND>(G2, R, gc);
        if (i + 1 < n) { const int rn = (first + (i + 1) * stride) & 1023; r2_load<KIND>(A, G2, R, rn >> 5, rn & 31); }
        r2_compute<KIND>(A, G2, r >> 5, r & 31, gc);
    }
}
__device__ __forceinline__ void p_lin_r2(CArgs& A, const Frame& F) {
    r2_run<0>(A, F, F.bid, 4, F.G);
    r2_run<1>(A, F, 1024 + F.bid, 4, F.G);
}
}
#define XB_TMO      128
#define XB_XCNT(j)  (256  + 64 * (j))
#define XB_XSUB(j)  (1280 + 64 * (j))
#define XB_XGEN(j)  (2304 + 64 * (j))
#define XB_TOP      3328
#define XB_TOPGEN   3392
#define XCD_BAR_WORDS 3456
#define XB_SPIN_CAP (1u << 18)
__device__ __forceinline__ unsigned xb_ld(unsigned* p)              { return __hip_atomic_load(p, __ATOMIC_RELAXED, __HIP_MEMORY_SCOPE_AGENT); }
__device__ __forceinline__ unsigned xb_add(unsigned* p, unsigned v) { return __hip_atomic_fetch_add(p, v, __ATOMIC_RELAXED, __HIP_MEMORY_SCOPE_AGENT); }
__device__ __forceinline__ unsigned xb_xcc_id() { return (unsigned)__builtin_amdgcn_s_getreg((3 << 11) | 20) & 0xFu; }
#define XB_SPIN(cond, bar) do { unsigned _sp = 0; while (cond) { __builtin_amdgcn_s_sleep(1); \
    if ((++_sp & 255u) == 0u) { if (xb_ld(&(bar)[XB_TMO])) break; if (_sp > XB_SPIN_CAP) { atomicAdd(&(bar)[XB_TMO], 1u); break; } } } } while (0)
struct XcdBarrier { unsigned* bar; unsigned x; volatile LAS unsigned* st; };
__device__ __forceinline__ XcdBarrier xcd_barrier_post(unsigned* bar, volatile LAS unsigned* st, int tid) {
    XcdBarrier b; b.bar = bar; b.x = xb_xcc_id(); b.st = st;
    if (tid == 0) (void)xb_add(&bar[XB_XCNT(b.x)], 1u);
    return b;
}
__device__ __forceinline__ void xcd_barrier_complete(unsigned* bar, unsigned x, unsigned& nloc, unsigned& nx) {
    const unsigned G = gridDim.x * gridDim.y * gridDim.z;
    unsigned sum, cnt, mine, sp = 0u;
    for (;;) {
        sum = 0u; cnt = 0u; mine = 0u;
#pragma unroll
        for (unsigned j = 0; j < 16; ++j) { const unsigned c = xb_ld(&bar[XB_XCNT(j)]); sum += c; cnt += (c > 0u) ? 1u : 0u; mine = (j == x) ? c : mine; }
        if (sum == G) break;
        __builtin_amdgcn_s_sleep(1);
        if ((++sp & 255u) == 0u) { if (xb_ld(&bar[XB_TMO])) break; if (sp > XB_SPIN_CAP) { atomicAdd(&bar[XB_TMO], 1u); break; } }
    }
    nloc = mine > 0u ? mine : 1u; nx = cnt > 0u ? cnt : 1u;
}
__device__ __forceinline__ void xcd_barrier(const XcdBarrier& b, int tid) {
    asm volatile("s_waitcnt vmcnt(0)" ::: "memory");
    __syncthreads();
    if (tid == 0) {
        unsigned* bar = b.bar;
        __builtin_amdgcn_s_waitcnt(0);
        unsigned nloc = b.st[0], nx = b.st[1];
        if (nloc == 0u) { xcd_barrier_complete(bar, b.x, nloc, nx); b.st[0] = nloc; b.st[1] = nx; }
        const unsigned old = xb_add(&bar[XB_XSUB(b.x)], 1u);
        const unsigned gen = old / nloc;
        if (old + 1u == (gen + 1u) * nloc) {
            __builtin_amdgcn_fence(__ATOMIC_RELEASE, "agent");
            asm volatile("s_waitcnt vmcnt(0)" ::: "memory");
            const unsigned og = xb_add(&bar[XB_TOP], 1u);
            const unsigned tg = og / nx;
            if (og + 1u == (tg + 1u) * nx) xb_add(&bar[XB_TOPGEN], 1u);
            else XB_SPIN(xb_ld(&bar[XB_TOPGEN]) == tg, bar);
            __builtin_amdgcn_fence(__ATOMIC_ACQUIRE, "agent");
            xb_add(&bar[XB_XGEN(b.x)], 1u);
            asm volatile("s_waitcnt vmcnt(0)" ::: "memory");
        } else {
            XB_SPIN(xb_ld(&bar[XB_XGEN(b.x)]) == gen, bar);
            __builtin_amdgcn_fence(__ATOMIC_ACQUIRE, "agent");
            asm volatile("s_waitcnt vmcnt(0)" ::: "memory");
        }
    }
    __syncthreads();
}
#define REFRESH() do { int t_ = F.wave * 64 + lane_id(); asm volatile("" : "+v"(t_)); F.tid = t_; F.lane = t_ & 63; asm volatile("" : "+s"(ap)); int b_ = blockIdx.x; asm volatile("" : "+s"(b_)); F.bid = b_; } while (0)
#define A (*ap)
#define GSYNC() do { REFRESH(); xcd_barrier(xb, F.tid); } while (0)
template <int l> __device__ __forceinline__ void layer_fwd(CArgs*& ap, Frame& F, const XcdBarrier& xb, unsigned char* lds, LAS unsigned char* lds3, LAS pg8::MoeTables* tb) {
    if (l == 0) {
        { REFRESH(); pg8::DenseOrder S; S.init(P_HB, P_WINE, NTOK, 2048, 1024, F.G, F.bid); pg8::EpiZ0 E{P_Z};
          pg8::gemm_phase<pg8::EpiZ0, pg8::DenseOrder, true>(lds3, F.wave, 1024, S, E); }
        GSYNC();
        REFRESH(); fox_fast(A, F);
        __syncthreads();
        REFRESH(); s5_fast(A, F, F.bid);
        GSYNC();
        { REFRESH(); pg8::DenseOrder S; S.init(P_G5, P_WGLU, NTOK, 512, 512, F.G, F.bid); pg8::EpiGlu E{P_G5, A.in[I_GLUB], P_YCAT};
          pg8::gemm_phase<pg8::EpiGlu, pg8::DenseOrder, true>(lds3, F.wave, 512, S, E); }
        GSYNC();
    } else {
        REFRESH(); lin::gla_prefix(A, F, F.bid);
        { REFRESH(); pg8::DenseOrder S; S.init(P_HB, P_WINO, NTOK, 3584, 512, F.G, F.bid); pg8::EpiZ1 E{P_Z, P_ROPE};
          pg8::gemm_phase<pg8::EpiZ1, pg8::DenseOrder, true, true>(lds3, F.wave, 512, S, E); }
        GSYNC();
        REFRESH(); lin::p_lin_r1(A, F);
        GSYNC();
        REFRESH(); lin::p_lin_r2(A, F);
        GSYNC();
    }
    { REFRESH(); pg8::DenseOrder S; S.init(P_YCAT, l == 0 ? P_WOUTE : P_WOUTO, NTOK, 1024, 1024, F.G, F.bid); pg8::EpiBf16Plain E{(bf16_t*)P_MBUF, DM};
      pg8::gemm_phase<pg8::EpiBf16Plain, pg8::DenseOrder, true>(lds3, F.wave, 1024, S, E); }
    GSYNC();
    REFRESH(); p_postmix(A, F, l);
    GSYNC();
    REFRESH(); const int MT = moe_tables(A, F, l, tb);
    {
        const int mX = (MT >> 5) << 5, kk = MT - mX, rr = (64 - ((2 * kk) & 63)) & 63;
        const int mY = mX >= rr ? rr + (((mX - rr) >> 6) << 6) : 0;
        if (mX > 0) {
            { REFRESH(); pg8::MoeOrder<true> S; S.Ap = (const char*)P_HB8; S.Bt = (const char*)(P_W1 + (size_t)l * 32 * 2048 * 1024); S.estride = (size_t)2048 * 1024; S.K = 512; S.NP = 8; S.nwg = mX * 8; S.G = F.G; S.c = F.bid; S.mt0 = 0;
              S.list_tk = P_LTK + (size_t)l * 32 * LISTCAP; S.tb = tb;
              pg8::EpiSwiglu E{P_ACT, A.in[I_BGU] + (size_t)l * 32 * 2048};
              pg8::gemm_phase<pg8::EpiSwiglu, pg8::MoeOrder<true>, true, true>(lds3, F.wave, 512, S, E); }
            GSYNC();
        }
        if (8 * (MT - mX) + 4 * mY > 0) {
            { REFRESH(); pg8::MoeMixOrder S; S.ws = (const char*)A.ws; S.l = l;
              S.a0 = mX; S.nA = 8 * (MT - mX); S.b0 = 0; S.nB = 4 * mY; S.nwg = S.nA + S.nB; S.G = F.G; S.c = F.bid; S.tb = tb;
              pg8::EpiMoeMix E{ap, l};
              pg8::gemm_phase<pg8::EpiMoeMix, pg8::MoeMixOrder, true, true>(lds3, F.wave, 512, S, E); }
            GSYNC();
        }
        if (MT > mY) {
            { REFRESH(); pg8::MoeOrder<false> S; S.Ap = (const char*)P_ACT; S.Bt = (const char*)(P_W2 + (size_t)l * 32 * 1024 * 1024); S.estride = (size_t)1024 * 1024; S.K = 512; S.NP = 4; S.nwg = (MT - mY) * 4; S.G = F.G; S.c = F.bid; S.mt0 = mY;
              S.list_tk = P_LTK + (size_t)l * 32 * LISTCAP; S.tb = tb;
              pg8::EpiDown E{P_Y, A.in[I_BDN] + (size_t)l * 32 * 1024, P_LTK + (size_t)l * 32 * LISTCAP, P_LG + (size_t)l * 32 * LISTCAP};
              pg8::gemm_phase<pg8::EpiDown, pg8::MoeOrder<false>, true, true>(lds3, F.wave, 512, S, E); }
            GSYNC();
        }
    }
    REFRESH(); p_combine(A, F, l);
}

__global__ void __launch_bounds__(512, 2) mk_fwd(Args A_) {
    extern __shared__ __attribute__((aligned(16))) unsigned char lds[];
    cg::grid_group grid = cg::this_grid();
    CArgs* ap = (CArgs*)__builtin_amdgcn_kernarg_segment_ptr();
    Frame F;
    F.lds = lds; F.wave = __builtin_amdgcn_readfirstlane((int)threadIdx.x >> 6); F.tid = 0; F.lane = 0; F.bid = blockIdx.x; F.G = gridDim.x;
    LAS unsigned char* lds3 = (LAS unsigned char*)lds;
    LAS pg8::MoeTables* tb = (LAS pg8::MoeTables*)(lds3 + 133632);
    { volatile LAS unsigned* st = (volatile LAS unsigned*)(lds3 + (LDS_BYTES - 64)); REFRESH(); if (F.tid < 2) st[F.tid] = 0u; __syncthreads(); }
    XcdBarrier xb = xcd_barrier_post((unsigned*)(A.ws + WS_CTL) + 10240, (volatile LAS unsigned*)(lds3 + (LDS_BYTES - 64)), F.tid);
    REFRESH(); p0_tables(A, F);
    if (A.pad != 0) grid.sync();
    GSYNC();
    REFRESH(); p0_tiles(A, F, 0, 12);
    __syncthreads(); REFRESH(); p1_hprep0(A, F);
    __syncthreads(); REFRESH(); p0_tiles(A, F, 12, 26);
    GSYNC();
    layer_fwd<0>(ap, F, xb, lds, lds3, tb);
    GSYNC();
    layer_fwd<1>(ap, F, xb, lds, lds3, tb);
}
#undef A

extern "C" void kernel_launch(void* const* d_in, const int* in_sizes, int n_in, void* d_out, int out_size, void* d_ws, size_t ws_size, hipStream_t stream) {
    static int grid = 0;
    if (grid == 0) {
        if (n_in != 31 || out_size != NTOK * DM || ws_size < WS_END) { fprintf(stderr, "kernel_launch: unexpected problem (n_in %d out %d ws %zu)\n", n_in, out_size, ws_size); grid = -1; return; }
        int dev = 0, cus = 0, per_cu = 0;
        if (hipGetDevice(&dev) != hipSuccess || hipDeviceGetAttribute(&cus, hipDeviceAttributeMultiprocessorCount, dev) != hipSuccess) { grid = -1; return; }
        if (hipFuncSetAttribute((const void*)mk_fwd, hipFuncAttributeMaxDynamicSharedMemorySize, LDS_BYTES) != hipSuccess) { fprintf(stderr, "kernel_launch: hipFuncSetAttribute failed\n"); grid = -1; return; }
        if (hipOccupancyMaxActiveBlocksPerMultiprocessor(&per_cu, (const void*)mk_fwd, 512, LDS_BYTES) != hipSuccess || per_cu < 1) { fprintf(stderr, "kernel_launch: occupancy query says %d blocks per CU\n", per_cu); (void)hipGetLastError(); }
        grid = cus;
        if (grid != 256) fprintf(stderr, "kernel_launch: %d CUs; this kernel is built for a 256-CU grid\n", grid);
    }
    if (grid < 0) return;
    if (hipMemsetAsync((char*)d_ws + WS_CTL, 0, CTL_ZERO_BYTES, stream) != hipSuccess) { fprintf(stderr, "kernel_launch: memset failed\n"); return; }
    Args a{};
    for (int i = 0; i < 31; ++i) a.in[i] = (const float*)d_in[i];
    a.out = (float*)d_out; a.ws = (unsigned char*)d_ws;
    void* kargs[] = {&a};
    const hipError_t e = hipLaunchCooperativeKernel((const void*)mk_fwd, dim3(grid), dim3(512), kargs, LDS_BYTES, stream);
    if (e != hipSuccess) fprintf(stderr, "kernel_launch: cooperative launch failed: %s (grid %d)\n", hipGetErrorString(e), grid);
}
```

```cpp
#include <hip/hip_runtime.h>
#include <hip/hip_cooperative_groups.h>
#include <cstdio>
#include <cstdint>
namespace cg = cooperative_groups;

#define LAS __attribute__((address_space(3)))
typedef unsigned short bf16_t;
typedef short bf16x8 __attribute__((ext_vector_type(8)));
typedef float f32x4 __attribute__((ext_vector_type(4)));
typedef float f32x2 __attribute__((ext_vector_type(2)));
typedef unsigned u32x4 __attribute__((ext_vector_type(4)));
typedef unsigned u32x2 __attribute__((ext_vector_type(2)));
typedef int i32x4 __attribute__((ext_vector_type(4)));
typedef int i32x8 __attribute__((ext_vector_type(8)));

constexpr int NTOK = 16384, DM = 1024, SEQ = 2048, NB = 8;
constexpr int NEXP = 32, LISTCAP = 16384;
constexpr float EPS = 1e-6f;
constexpr float LOG2E = 1.4426950408889634f;
constexpr float C2 = 0.125f * LOG2E;
constexpr int ZP0 = 2048, ZP1 = 3584;

constexpr size_t MiB = 1u << 20;
constexpr size_t WS_CTL = 0, CTL_ZERO_BYTES = 65536;
constexpr size_t WS_MOD = 1 * MiB;
constexpr size_t WS_WSIDE = 1 * MiB + 512 * 1024;
constexpr size_t WS_S5A = 2 * MiB;
constexpr size_t WS_S5BB = 2 * MiB + 65536;
constexpr size_t WS_S5CK = 2 * MiB + 512 * 1024;
constexpr size_t WS_ROPE = 3 * MiB;
constexpr size_t WS_LTK = 4 * MiB;
constexpr size_t WS_LG = 8 * MiB;
constexpr size_t WS_WINE = 16 * MiB, WS_WGLU = 20 * MiB, WS_WOUTE = 21 * MiB, WS_WINO = 23 * MiB, WS_WOUTO = 30 * MiB;
constexpr size_t WS_W1 = 32 * MiB;
constexpr size_t WS_HB8 = 160 * MiB;
constexpr size_t WS_W2 = 288 * MiB;
constexpr size_t WS_HB = 416 * MiB;
constexpr size_t WS_Z = 448 * MiB;
constexpr size_t WS_LSIG = 560 * MiB;
constexpr size_t WS_LOGA = 562 * MiB;
constexpr size_t WS_G5 = 578 * MiB;
constexpr size_t WS_YCAT = 594 * MiB;
constexpr size_t WS_MBUF = 626 * MiB;
constexpr size_t WS_ACT = 690 * MiB;
constexpr size_t WS_Y = 834 * MiB;
constexpr size_t WS_RST = 962 * MiB;
constexpr size_t WS_GST = 994 * MiB;
constexpr size_t WS_XB = 1010 * MiB;
constexpr size_t WS_END = 1042 * MiB;
constexpr int CW_CNT = 1024;

constexpr int RING_BYTES = 131072;
constexpr int MISC_OFF = RING_BYTES;
constexpr int LDS_BYTES = 147456;
constexpr int EPI_OFF = 135168, EPI_SLOT = 3072;

__device__ __forceinline__ unsigned f2bf(float f) { unsigned u = __builtin_bit_cast(unsigned, f); return (u + 0x7fffu + ((u >> 16) & 1u)) >> 16; }
typedef __bf16 bf16x2_hw __attribute__((ext_vector_type(2)));
__device__ __forceinline__ unsigned pk2(float lo, float hi) { const f32x2 v = {lo, hi}; return __builtin_bit_cast(unsigned, __builtin_convertvector(v, bf16x2_hw)); }
__device__ __forceinline__ float bflo(unsigned w) { return __builtin_bit_cast(float, w << 16); }
__device__ __forceinline__ float bfhi(unsigned w) { return __builtin_bit_cast(float, w & 0xffff0000u); }
__device__ __forceinline__ float bf1(bf16_t b) { return __builtin_bit_cast(float, ((unsigned)b) << 16); }
__device__ __forceinline__ int lane_id() { int l; asm volatile("v_mbcnt_lo_u32_b32 %0, -1, 0\n\tv_mbcnt_hi_u32_b32 %0, -1, %0" : "=v"(l)); return l; }
template <int CTRL> __device__ __forceinline__ float dppf(float v) { return __builtin_bit_cast(float, __builtin_amdgcn_update_dpp(0, __builtin_bit_cast(int, v), CTRL, 0xf, 0xf, true)); }
__device__ __forceinline__ float row16_sum(float v) {
    v += dppf<0xB1>(v); v += dppf<0x4E>(v); v += dppf<0x141>(v); v += dppf<0x140>(v); return v;
}
__device__ __forceinline__ float rdlane(float v, int l) { return __builtin_bit_cast(float, __builtin_amdgcn_readlane(__builtin_bit_cast(int, v), l)); }
__device__ __forceinline__ float wave_sum(float v) {
    v = row16_sum(v); return (rdlane(v, 0) + rdlane(v, 16)) + (rdlane(v, 32) + rdlane(v, 48));
}
__device__ __forceinline__ float half_sum(float v) {
    v = row16_sum(v); const float a = rdlane(v, 0) + rdlane(v, 16), b = rdlane(v, 32) + rdlane(v, 48); return (lane_id() < 32) ? a : b;
}
__device__ __forceinline__ float sigmoidf_(float x) { return __builtin_amdgcn_rcpf(1.f + __expf(-x)); }
__device__ __forceinline__ float log_sigmoidf_(float x) { return fminf(x, 0.f) - log1pf(__expf(-fabsf(x))); }
__device__ __forceinline__ float siluf_(float x) { return x * sigmoidf_(x); }
__device__ __forceinline__ float gelu_tanh(float x) { const float u2 = 1.5957691216057308f * (x + 0.044715f * x * x * x); return x * sigmoidf_(u2); }
constexpr float SC_H = 16.f, SC_W1 = 512.f, SC_A = 8.f, SC_W2 = 512.f, SC_WIN = 512.f, SC_Y = 64.f;
__device__ __forceinline__ unsigned pk8(float a, float b, float c, float d) {
    a = __builtin_amdgcn_fmed3f(a, -448.f, 448.f); b = __builtin_amdgcn_fmed3f(b, -448.f, 448.f); c = __builtin_amdgcn_fmed3f(c, -448.f, 448.f); d = __builtin_amdgcn_fmed3f(d, -448.f, 448.f);
    int r = __builtin_amdgcn_cvt_pk_fp8_f32(a, b, 0, false); r = __builtin_amdgcn_cvt_pk_fp8_f32(c, d, r, true); return (unsigned)r;
}
#define LDS_WAIT() asm volatile("s_waitcnt lgkmcnt(0)" ::: "memory")

struct Args { const float* in[31]; float* out; unsigned char* ws; long long pad; };
typedef const __attribute__((address_space(4))) Args CArgs;
enum { I_X = 0, I_C, I_ADAW, I_ADAB, I_NPM, I_NQM, I_NPF, I_NQF, I_EVWIN, I_FOXB, I_LAMRE, I_LAMIM, I_LOGDT, I_BRE, I_BIM, I_CRE, I_CIM, I_S5D, I_GLUW, I_GLUB, I_EVWOUT,
       I_ODWIN, I_GLAWUP, I_GLABG, I_ODWOUT, I_RW, I_RB, I_WGU, I_BGU, I_WDN, I_BDN };

namespace pg8 {
constexpr int BM = 256, BK = 64, HALF = 128, HTB = HALF * BK * 2, STAGE_BYTES = 8 * HTB, NXCD = 8, WGM = 8;
__device__ __forceinline__ int lds_byte(int r, int c) { const int st = (r >> 4) * 2 + (c >> 5), rr = r & 15, cc = c & 31, ob = rr * 64 + cc * 2; return st * 1024 + (ob ^ (((ob >> 9) & 1) << 5)); }
__device__ __forceinline__ void stage_rc(int b, int& R, int& C) { const int st = b / 1024, sb = b % 1024, swz = sb ^ (((sb >> 9) & 1) << 5); R = (st >> 1) * 16 + swz / 64; C = (st & 1) * 32 + (swz % 64) / 2; }
__device__ __forceinline__ int perm32(int rho) { const int n = rho >> 4, i = rho & 15; return 8 * (i >> 2) + 4 * n + (i & 3); }
__device__ __forceinline__ unsigned cvt_pk_bf16(float lo, float hi) { unsigned r; asm volatile("v_cvt_pk_bf16_f32 %0, %1, %2" : "=v"(r) : "v"(lo), "v"(hi)); return r; }

struct Unit { int pm, pn, e, mb, nrows, kind; };
__device__ __forceinline__ int xcd_remap(int L, int nwg) { const int q = nwg / NXCD, r = nwg % NXCD, xcd = L % NXCD, off = L / NXCD; return (xcd < r ? xcd * (q + 1) : r * (q + 1) + (xcd - r) * q) + off; }

struct DenseOrder {
    const char* Ap; const char* Bt; int K, nM, nN, nwg, G, c;
    __device__ __forceinline__ void init(const void* A_, const void* Bt_, int M, int N, int K_, int G_, int c_) { Ap = (const char*)A_; Bt = (const char*)Bt_; K = K_; nM = M / BM; nN = N / BM; nwg = nM * nN; G = G_; c = c_; }
    __device__ __forceinline__ bool next(int i, Unit& u) const {
        const long L = (long)i * G + c; if (L >= nwg) return false;
        const int wgid = xcd_remap((int)L, nwg);
        const int nig = WGM * nN, gid = wgid / nig, fm = gid * WGM, gsz = (nM - fm) < WGM ? (nM - fm) : WGM;
        u.pm = fm + ((wgid % nig) % gsz); u.pn = (wgid % nig) / gsz; u.e = 0; u.mb = u.pm; u.nrows = BM; u.kind = 0; return true;
    }
    __device__ __forceinline__ const char* a_base(const Unit& u) const { return Ap + (size_t)u.pm * ((size_t)BM * K * 2); }
    __device__ __forceinline__ const char* b_base(const Unit& u) const { return Bt + (size_t)u.pn * ((size_t)BM * K * 2); }
    __device__ __forceinline__ void a_raw(const Unit&, const int (&)[2], int (&raw)[2][2]) const { raw[0][0] = raw[0][1] = raw[1][0] = raw[1][1] = 0; }
    __device__ __forceinline__ void a_offs(const Unit&, const int (&R)[2], const int (&C)[2], const int (&)[2][2], unsigned (&v)[2][2]) const {
#pragma unroll
        for (int h = 0; h < 2; ++h)
#pragma unroll
            for (int i = 0; i < 2; ++i) v[h][i] = (unsigned)((h * HALF + R[i]) * K + C[i]) * 2u;
    }
};
struct MoeTables { int cnt[NEXP]; int mtstart[NEXP + 1]; unsigned char tile_e[320]; };
template <bool GATHER> struct MoeOrder {
    const char* Ap; const char* Bt; size_t estride; int K, NP, nwg, G, c, mt0; const int* list_tk; const LAS MoeTables* tb;
    __device__ __forceinline__ bool next(int i, Unit& u) const {
        const long L = (long)i * G + c; if (L >= nwg) return false;
        const int w = xcd_remap((int)L, nwg);
        const int mq = w / NP, mt = mt0 + mq; u.pn = w - mq * NP; u.pm = mt; u.e = tb->tile_e[mt]; u.mb = mt - tb->mtstart[u.e];
        const int left = tb->cnt[u.e] - u.mb * BM; u.nrows = left < BM ? left : BM; u.kind = GATHER ? 0 : 1; return true;
    }
    __device__ __forceinline__ const char* a_base(const Unit& u) const { return GATHER ? Ap : Ap + (size_t)u.pm * ((size_t)BM * K * 2); }
    __device__ __forceinline__ const char* b_base(const Unit& u) const { return Bt + (size_t)u.e * estride + (size_t)u.pn * ((size_t)BM * K * 2); }
    __device__ __forceinline__ void a_raw(const Unit& u, const int (&R)[2], int (&raw)[2][2]) const {
#pragma unroll
        for (int h = 0; h < 2; ++h)
#pragma unroll
            for (int i = 0; i < 2; ++i) { if (GATHER) { const int r = h * HALF + R[i], rc = r < u.nrows ? r : 0; raw[h][i] = list_tk[u.e * LISTCAP + u.mb * BM + rc]; } else raw[h][i] = 0; }
    }
    __device__ __forceinline__ void a_offs(const Unit&, const int (&R)[2], const int (&C)[2], const int (&raw)[2][2], unsigned (&v)[2][2]) const {
#pragma unroll
        for (int h = 0; h < 2; ++h)
#pragma unroll
            for (int i = 0; i < 2; ++i) {
                if (GATHER) v[h][i] = (unsigned)((raw[h][i] >> 2) * K + C[i]) * 2u;
                else v[h][i] = (unsigned)((h * HALF + R[i]) * K + C[i]) * 2u;
            }
    }
};

struct MoeMixOrder {
    const char* ws; int l, a0, nA, b0, nB, nwg, G, c; const LAS MoeTables* tb;
    static constexpr int K = 512;
    __device__ __forceinline__ bool next(int i, Unit& u) const {
        const long L = (long)i * G + c; if (L >= nwg) return false;
        int w = xcd_remap((int)L, nwg), mt;
        if (w < nA) { u.kind = 0; mt = a0 + (w >> 3); u.pn = w & 7; } else { w -= nA; u.kind = 1; mt = b0 + (w >> 2); u.pn = w & 3; }
        u.pm = mt; u.e = tb->tile_e[mt]; u.mb = mt - tb->mtstart[u.e];
        const int left = tb->cnt[u.e] - u.mb * BM; u.nrows = left < BM ? left : BM; return true;
    }
    __device__ __forceinline__ const char* a_base(const Unit& u) const { return u.kind ? ws + WS_ACT : ws + WS_HB8; }
    __device__ __forceinline__ const char* b_base(const Unit& u) const { return u.kind ? ws + WS_W2 + (size_t)(l * 32 + u.e) * ((size_t)1024 * K * 2) + (size_t)u.pn * ((size_t)BM * K * 2) : ws + WS_W1 + (size_t)(l * 32 + u.e) * ((size_t)2048 * K * 2) + (size_t)u.pn * ((size_t)BM * K * 2); }
    __device__ __forceinline__ void a_raw(const Unit& u, const int (&R)[2], int (&raw)[2][2]) const {
#pragma unroll
        for (int h = 0; h < 2; ++h)
#pragma unroll
            for (int i = 0; i < 2; ++i) { const int r = h * HALF + R[i], rc = r < u.nrows ? r : 0; raw[h][i] = u.kind ? 4 * (u.pm * BM + r) : ((const int*)(ws + WS_LTK))[(l * 32 + u.e) * LISTCAP + u.mb * BM + rc]; }
    }
    __device__ __forceinline__ void a_offs(const Unit& u, const int (&R)[2], const int (&C)[2], const int (&raw)[2][2], unsigned (&v)[2][2]) const {
#pragma unroll
        for (int h = 0; h < 2; ++h)
#pragma unroll
            for (int i = 0; i < 2; ++i) v[h][i] = (unsigned)((raw[h][i] >> 2) * K + C[i]) * 2u;
    }
};

template <class Epi, class Sched, bool ALIGN_EPI, bool FP8 = false>
__device__ __forceinline__ void gemm_phase(LAS unsigned char* lds, const int wave_, const int K, const Sched& S, const Epi& E) {
    int tid_ = wave_ * 64 + lane_id(); asm volatile("" : "+v"(tid_));
    const int tid = tid_, wid = wave_, lane = tid & 63, wr = wid >> 2, wc = wid & 3, fr = lane & 15, fq = lane >> 4;
    int nt_ = K / BK; if constexpr (FP8) asm volatile("" : "+s"(nt_));
    const int nt = nt_;
    int Rr[2], Cc[2]; unsigned voffB[2];
#pragma unroll
    for (int i = 0; i < 2; ++i) { stage_rc(tid * 16 + i * 8192, Rr[i], Cc[i]); const int Rb = Epi::PERM ? ((Rr[i] & ~31) + perm32(Rr[i] & 31)) : Rr[i]; voffB[i] = (unsigned)(Rb * K + Cc[i]) * 2u; }
    const size_t kstep = (size_t)(BK * 2);
    const size_t hstep = (size_t)HALF * K * 2;
    const unsigned ldsw = (unsigned)wid * 1024u;
    const int aoff = lds_byte(wr * 64 + fr, fq * 8), boff = lds_byte(wc * 32 + fr, fq * 8);
#define PG8_SA(b, h) (((b) * 2 + (h)) * HTB)
#define PG8_SB(b, h) ((4 + (b) * 2 + (h)) * HTB)
#define PG8_STAGE(bufoff, gbase, voff) do { _Pragma("unroll") for (int _i = 0; _i < 2; ++_i) { unsigned vo_ = (voff)[_i]; if constexpr (FP8) asm volatile("" : "+v"(vo_));   \
        __builtin_amdgcn_global_load_lds((const unsigned*)((const char*)(gbase) + vo_), (LAS unsigned*)(lds + (bufoff) + ldsw + _i * 8192), 16, 0, 0); } } while (0)
#define PG8_LDA(dst, b, h) do { _Pragma("unroll") for (int m = 0; m < 4; ++m) { \
        if constexpr (FP8) { const i32x4 lo_ = *(const LAS i32x4*)(lds + PG8_SA(b, h) + aoff + m * 2048), hi_ = *(const LAS i32x4*)(lds + PG8_SA(b, h) + aoff + m * 2048 + 1024); dst##8[m] = __builtin_shufflevector(lo_, hi_, 0, 1, 2, 3, 4, 5, 6, 7); } \
        else { _Pragma("unroll") for (int k = 0; k < 2; ++k) dst[m][k] = *(const LAS bf16x8*)(lds + PG8_SA(b, h) + aoff + m * 2048 + k * 1024); } } } while (0)
#define PG8_LDB(dst, b, h) do { _Pragma("unroll") for (int n = 0; n < 2; ++n) { \
        if constexpr (FP8) { const i32x4 lo_ = *(const LAS i32x4*)(lds + PG8_SB(b, h) + boff + n * 2048), hi_ = *(const LAS i32x4*)(lds + PG8_SB(b, h) + boff + n * 2048 + 1024); dst##8[n] = __builtin_shufflevector(lo_, hi_, 0, 1, 2, 3, 4, 5, 6, 7); } \
        else { _Pragma("unroll") for (int k = 0; k < 2; ++k) dst[n][k] = *(const LAS bf16x8*)(lds + PG8_SB(b, h) + boff + n * 2048 + k * 1024); } } } while (0)
#define PG8_MMA(ai, bj, At, Bt) do { __builtin_amdgcn_s_setprio(1); _Pragma("unroll") for (int m = 0; m < 4; ++m) _Pragma("unroll") for (int n = 0; n < 2; ++n) { \
        if constexpr (FP8) asm volatile("v_mfma_f32_16x16x128_f8f6f4 %0, %1, %2, %0" : "+v"(acc[ai][bj][m][n]) : "v"(Bt##8[n]), "v"(At##8[m]));   \
        else { _Pragma("unroll") for (int k = 0; k < 2; ++k) acc[ai][bj][m][n] = __builtin_amdgcn_mfma_f32_16x16x32_bf16(Bt[n][k], At[m][k], acc[ai][bj][m][n], 0, 0, 0); } } \
        __builtin_amdgcn_s_setprio(0); } while (0)
#define PG8_WAIT_V(n) asm volatile("s_waitcnt vmcnt(" #n ")" ::: "memory")
#define PG8_WAIT_L(n) asm volatile("s_waitcnt lgkmcnt(" #n ")" ::: "memory")
#define PG8_BAR __builtin_amdgcn_s_barrier()
#define PG8_SCHED __builtin_amdgcn_sched_barrier(0)
    Unit cur, nxt; int ui = 0;
    if (!S.next(0, cur)) return;
    f32x4 acc[2][2][4][2];
#pragma unroll
    for (int a = 0; a < 2; ++a)
#pragma unroll
        for (int b = 0; b < 2; ++b)
#pragma unroll
            for (int m = 0; m < 4; ++m)
#pragma unroll
                for (int n = 0; n < 2; ++n) acc[a][b][m][n] = (f32x4){0.f, 0.f, 0.f, 0.f};
    bf16x8 At[4][2], B0[2][2], B1[2][2]; i32x8 At8[4], B08[2], B18[2];
    const char* cA = S.a_base(cur); const char* cB = S.b_base(cur);
    unsigned cv[2][2], nv[2][2]; int raw[2][2];
    S.a_raw(cur, Rr, raw); S.a_offs(cur, Rr, Cc, raw, cv);
    PG8_STAGE(PG8_SB(0, 0), cB, voffB); PG8_STAGE(PG8_SB(0, 1), cB + hstep, voffB); PG8_STAGE(PG8_SA(0, 0), cA, cv[0]); PG8_STAGE(PG8_SA(0, 1), cA, cv[1]);
    if (wr == 1) PG8_BAR;
    PG8_WAIT_V(2); PG8_BAR;
    PG8_STAGE(PG8_SB(1, 0), cB + kstep, voffB); PG8_STAGE(PG8_SA(1, 0), cA + kstep, cv[0]); PG8_STAGE(PG8_SB(1, 1), cB + hstep + kstep, voffB);
    PG8_WAIT_V(6); PG8_BAR;
    for (;;) {
        if constexpr (Epi::STAGED) { if (wid < 3) E.stage(cur, wid, lane, lds + EPI_OFF + (ui & 1) * EPI_SLOT); }
        const bool has_next = S.next(ui + 1, nxt);
        const char* nA = has_next ? S.a_base(nxt) : cA; const char* nB = has_next ? S.b_base(nxt) : cB;
        if (has_next) S.a_raw(nxt, Rr, raw);
#pragma unroll
        for (int h = 0; h < 2; ++h)
#pragma unroll
            for (int i = 0; i < 2; ++i) nv[h][i] = cv[h][i];
        for (int t = 0; t < nt; t += 2) {
            const bool last = (t == nt - 2);
            if (last && has_next) S.a_offs(nxt, Rr, Cc, raw, nv);
            const char* a1 = cA + (size_t)(t + 1) * kstep;
            const char* a2 = last ? nA : cA + (size_t)(t + 2) * kstep; const char* b2 = last ? nB : cB + (size_t)(t + 2) * kstep;
            const char* a3 = a2 + kstep; const char* b3 = b2 + kstep;
            unsigned v2[2][2];
#pragma unroll
            for (int h = 0; h < 2; ++h)
#pragma unroll
                for (int i = 0; i < 2; ++i) v2[h][i] = last ? nv[h][i] : cv[h][i];
            PG8_LDB(B0, 0, 0); PG8_LDB(B1, 0, 1); PG8_SCHED; PG8_LDA(At, 0, 0); PG8_STAGE(PG8_SA(1, 1), a1, cv[1]);
            PG8_WAIT_V(8); PG8_WAIT_L(0); PG8_BAR; PG8_MMA(0, 0, At, B0); PG8_MMA(0, 1, At, B1); PG8_BAR; PG8_SCHED;
            PG8_LDA(At, 0, 1); PG8_STAGE(PG8_SB(0, 0), b2, voffB); PG8_STAGE(PG8_SB(0, 1), b2 + hstep, voffB); PG8_STAGE(PG8_SA(0, 0), a2, v2[0]);
            PG8_WAIT_V(8); PG8_WAIT_L(0); PG8_BAR; PG8_MMA(1, 0, At, B0); PG8_MMA(1, 1, At, B1); PG8_BAR; PG8_SCHED;
            PG8_LDB(B0, 1, 0); PG8_LDB(B1, 1, 1); PG8_SCHED; PG8_LDA(At, 1, 0); PG8_STAGE(PG8_SA(0, 1), a2, v2[1]);
            PG8_WAIT_V(8); PG8_WAIT_L(0); PG8_BAR; PG8_MMA(0, 0, At, B0); PG8_MMA(0, 1, At, B1); PG8_BAR; PG8_SCHED;
            PG8_LDA(At, 1, 1); PG8_STAGE(PG8_SB(1, 0), b3, voffB); PG8_STAGE(PG8_SB(1, 1), b3 + hstep, voffB); PG8_STAGE(PG8_SA(1, 0), a3, v2[0]);
            PG8_WAIT_V(8); PG8_WAIT_L(0); PG8_BAR; PG8_MMA(1, 0, At, B0); PG8_MMA(1, 1, At, B1); PG8_BAR; PG8_SCHED;
        }
        if constexpr (ALIGN_EPI) { if (wr == 0) PG8_BAR; }
        if constexpr (FP8) asm volatile("s_nop 15\n\ts_nop 15" ::: "memory");
        E(acc, cur, wr, wc, fr, fq, lds + EPI_OFF + (ui & 1) * EPI_SLOT);
        if (!has_next) break;
#pragma unroll
        for (int a = 0; a < 2; ++a)
#pragma unroll
            for (int b = 0; b < 2; ++b)
#pragma unroll
                for (int m = 0; m < 4; ++m)
#pragma unroll
                    for (int n = 0; n < 2; ++n) acc[a][b][m][n] = (f32x4){0.f, 0.f, 0.f, 0.f};
        cur = nxt; cA = nA; cB = nB; ++ui;
#pragma unroll
        for (int h = 0; h < 2; ++h)
#pragma unroll
            for (int i = 0; i < 2; ++i) cv[h][i] = nv[h][i];
        if constexpr (ALIGN_EPI) { if (wr == 1) PG8_BAR; }
    }
    PG8_WAIT_V(0);
    if constexpr (!ALIGN_EPI) { if (wr == 0) PG8_BAR; }
    PG8_BAR;
#undef PG8_SA
#undef PG8_SB
#undef PG8_STAGE
#undef PG8_LDA
#undef PG8_LDB
#undef PG8_MMA
#undef PG8_WAIT_V
#undef PG8_WAIT_L
#undef PG8_BAR
#undef PG8_SCHED
}
}
namespace pg8 {
typedef f32x4 Acc[2][2][4][2];
struct EpiZ0 {
    static constexpr bool PERM = true; static constexpr bool STAGED = false;
    bf16_t* Z;
    __device__ __forceinline__ void operator()(const Acc& acc, const Unit& u, int wr, int wc, int fr, int fq, LAS const unsigned char* es) const {
        const float sc = (u.pn == 2 || u.pn == 3) ? C2 : 1.f;
        const int row0 = u.pm * BM + wr * 64 + fr, col0 = u.pn * BM + wc * 32 + 8 * fq;
#pragma unroll
        for (int ai = 0; ai < 2; ++ai)
#pragma unroll
            for (int m = 0; m < 4; ++m) { bf16_t* rowp = Z + (size_t)(row0 + ai * HALF + m * 16) * ZP0 + col0;
#pragma unroll
                for (int bj = 0; bj < 2; ++bj) { const f32x4 v0 = acc[ai][bj][m][0] * sc, v1 = acc[ai][bj][m][1] * sc;
                    u32x4 w; w.x = cvt_pk_bf16(v0[0], v0[1]); w.y = cvt_pk_bf16(v0[2], v0[3]); w.z = cvt_pk_bf16(v1[0], v1[1]); w.w = cvt_pk_bf16(v1[2], v1[3]);
                    *(u32x4*)(rowp + bj * HALF) = w; } }
    }
};
struct EpiZ1 {
    static constexpr bool PERM = true; static constexpr bool STAGED = false;
    bf16_t* Z; const float* rope;
    __device__ __forceinline__ void operator()(const Acc& acc, const Unit& u, int wr, int wc, int fr, int fq, LAS const unsigned char* es) const {
        constexpr float INV = 1.f / (SC_H * SC_WIN);
        const int row0 = u.pm * BM + wr * 64 + fr;
        if (u.pn < 4) {
            const float sc = (u.pn >= 2) ? 0.08838834764831845f * INV : INV;
            const int hl = wc >> 1, jj0 = 32 * (wc & 1) + 8 * fq;
#pragma unroll
            for (int ai = 0; ai < 2; ++ai)
#pragma unroll
                for (int m = 0; m < 4; ++m) { const int row = row0 + ai * HALF + m * 16, pos = row & (SEQ - 1);
                    const f32x4 c0 = *(const f32x4*)(rope + pos * 64 + jj0), c1 = *(const f32x4*)(rope + pos * 64 + jj0 + 4);
                    const f32x4 s0 = *(const f32x4*)(rope + SEQ * 64 + pos * 64 + jj0), s1 = *(const f32x4*)(rope + SEQ * 64 + pos * 64 + jj0 + 4);
                    const f32x4 x10 = acc[ai][0][m][0] * sc, x11 = acc[ai][0][m][1] * sc, x20 = acc[ai][1][m][0] * sc, x21 = acc[ai][1][m][1] * sc;
                    const f32x4 a0 = x10 * c0 - x20 * s0, a1 = x11 * c1 - x21 * s1, b0 = x10 * s0 + x20 * c0, b1 = x11 * s1 + x21 * c1;
                    bf16_t* rowp = Z + (size_t)row * ZP1 + u.pn * BM + 128 * hl + jj0;
                    u32x4 w; w.x = cvt_pk_bf16(a0[0], a0[1]); w.y = cvt_pk_bf16(a0[2], a0[3]); w.z = cvt_pk_bf16(a1[0], a1[1]); w.w = cvt_pk_bf16(a1[2], a1[3]);
                    *(u32x4*)(rowp) = w;
                    w.x = cvt_pk_bf16(b0[0], b0[1]); w.y = cvt_pk_bf16(b0[2], b0[3]); w.z = cvt_pk_bf16(b1[0], b1[1]); w.w = cvt_pk_bf16(b1[2], b1[3]);
                    *(u32x4*)(rowp + 64) = w; }
        } else {
            const float sc = (u.pn == 8) ? 0.125f * INV : INV;
            const int col0 = u.pn * BM + wc * 32 + 8 * fq;
#pragma unroll
            for (int ai = 0; ai < 2; ++ai)
#pragma unroll
                for (int m = 0; m < 4; ++m) { bf16_t* rowp = Z + (size_t)(row0 + ai * HALF + m * 16) * ZP1 + col0;
#pragma unroll
                    for (int bj = 0; bj < 2; ++bj) { const f32x4 v0 = acc[ai][bj][m][0] * sc, v1 = acc[ai][bj][m][1] * sc;
                        u32x4 w; w.x = cvt_pk_bf16(v0[0], v0[1]); w.y = cvt_pk_bf16(v0[2], v0[3]); w.z = cvt_pk_bf16(v1[0], v1[1]); w.w = cvt_pk_bf16(v1[2], v1[3]);
                        *(u32x4*)(rowp + bj * HALF) = w; } }
        }
    }
};
struct EpiGlu {
    static constexpr bool PERM = true; static constexpr bool STAGED = false;
    const bf16_t* G5; const float* bias; bf16_t* Y;
    __device__ __forceinline__ void operator()(const Acc& acc, const Unit& u, int wr, int wc, int fr, int fq, LAS const unsigned char* es) const {
        const int row0 = u.pm * BM + wr * 64 + fr, col0 = u.pn * BM + wc * 32 + 8 * fq;
        f32x4 bv[2][2];
#pragma unroll
        for (int bj = 0; bj < 2; ++bj)
#pragma unroll
            for (int n = 0; n < 2; ++n) bv[bj][n] = *(const f32x4*)(bias + col0 + bj * HALF + 4 * n);
#pragma unroll
        for (int ai = 0; ai < 2; ++ai)
#pragma unroll
            for (int m = 0; m < 4; ++m) { const size_t row = (size_t)(row0 + ai * HALF + m * 16);
#pragma unroll
                for (int bj = 0; bj < 2; ++bj) { const u32x4 gw = *(const u32x4*)(G5 + row * 512 + col0 + bj * HALF);
                    const f32x4 v0 = acc[ai][bj][m][0] + bv[bj][0], v1 = acc[ai][bj][m][1] + bv[bj][1];
                    float o[8]; o[0] = bflo(gw.x) * sigmoidf_(v0[0]); o[1] = bfhi(gw.x) * sigmoidf_(v0[1]); o[2] = bflo(gw.y) * sigmoidf_(v0[2]); o[3] = bfhi(gw.y) * sigmoidf_(v0[3]);
                    o[4] = bflo(gw.z) * sigmoidf_(v1[0]); o[5] = bfhi(gw.z) * sigmoidf_(v1[1]); o[6] = bflo(gw.w) * sigmoidf_(v1[2]); o[7] = bfhi(gw.w) * sigmoidf_(v1[3]);
                    u32x4 w; w.x = cvt_pk_bf16(o[0], o[1]); w.y = cvt_pk_bf16(o[2], o[3]); w.z = cvt_pk_bf16(o[4], o[5]); w.w = cvt_pk_bf16(o[6], o[7]);
                    *(u32x4*)(Y + row * DM + col0 + bj * HALF) = w; } }
    }
};
struct EpiF32 {
    static constexpr bool PERM = false; static constexpr bool STAGED = false;
    float* Cp; int ldc;
    __device__ __forceinline__ void operator()(const Acc& acc, const Unit& u, int wr, int wc, int fr, int fq, LAS const unsigned char* es) const {
        const int row0 = u.pm * BM + wr * 64 + fr, col0 = u.pn * BM + wc * 32 + 4 * fq;
#pragma unroll
        for (int ai = 0; ai < 2; ++ai)
#pragma unroll
            for (int m = 0; m < 4; ++m) { float* rowp = Cp + (size_t)(row0 + ai * HALF + m * 16) * ldc + col0;
#pragma unroll
                for (int bj = 0; bj < 2; ++bj)
#pragma unroll
                    for (int n = 0; n < 2; ++n) *(f32x4*)(rowp + bj * HALF + n * 16) = acc[ai][bj][m][n]; }
    }
};
struct EpiBf16Plain {
    static constexpr bool PERM = true; static constexpr bool STAGED = false;
    bf16_t* Cp; int ldc;
    __device__ __forceinline__ void operator()(const Acc& acc, const Unit& u, int wr, int wc, int fr, int fq, LAS const unsigned char* es) const {
        const int row0 = u.pm * BM + wr * 64 + fr, col0 = u.pn * BM + wc * 32 + 8 * fq;
#pragma unroll
        for (int ai = 0; ai < 2; ++ai)
#pragma unroll
            for (int m = 0; m < 4; ++m) { bf16_t* rowp = Cp + (size_t)(row0 + ai * HALF + m * 16) * ldc + col0;
#pragma unroll
                for (int bj = 0; bj < 2; ++bj) { const f32x4 v0 = acc[ai][bj][m][0], v1 = acc[ai][bj][m][1];
                    u32x4 w; w.x = cvt_pk_bf16(v0[0], v0[1]); w.y = cvt_pk_bf16(v0[2], v0[3]); w.z = cvt_pk_bf16(v1[0], v1[1]); w.w = cvt_pk_bf16(v1[2], v1[3]);
                    *(u32x4*)(rowp + bj * HALF) = w; } }
    }
};
struct EpiSwiglu {
    static constexpr bool PERM = true; static constexpr bool STAGED = true;
    unsigned char* ACT; const float* bgu;
    __device__ __forceinline__ void stage(const Unit& u, int wid, int lane, LAS unsigned char* dst) const {
        if (wid == 0) { const float* src = bgu + (size_t)u.e * 2048 + u.pn * 128 + (lane < 32 ? 4 * lane : 1024 + 4 * (lane - 32));
            __builtin_amdgcn_global_load_lds((const unsigned*)src, (LAS unsigned*)dst, 16, 0, 0); }
    }
    __device__ __forceinline__ void operator()(const Acc& acc, const Unit& u, int wr, int wc, int fr, int fq, LAS const unsigned char* es) const {
        constexpr float INV = 1.f / (SC_H * SC_W1), INVL = INV * SC_A, CE = -1.702f * LOG2E;
        const int row0 = u.pm * BM + wr * 64 + fr, j0 = wc * 32 + 8 * fq, colg = u.pn * 128 + j0;
        f32x2 bg[4], bl[4];
#pragma unroll
        for (int p = 0; p < 4; ++p) { bg[p] = *(const LAS f32x2*)(es + 4 * (j0 + 2 * p)); bl[p] = (*(const LAS f32x2*)(es + 512 + 4 * (j0 + 2 * p)) + 1.f) * SC_A; }
#pragma unroll
        for (int ai = 0; ai < 2; ++ai)
#pragma unroll
            for (int m = 0; m < 4; ++m) {
                f32x2 o[4];
#pragma unroll
                for (int p = 0; p < 4; ++p) {
                    const f32x4 ag = acc[ai][0][m][p >> 1], al = acc[ai][1][m][p >> 1];
                    const f32x2 g = (p & 1 ? (f32x2){ag[2], ag[3]} : (f32x2){ag[0], ag[1]}) * INV + bg[p], l = (p & 1 ? (f32x2){al[2], al[3]} : (f32x2){al[0], al[1]}) * INVL + bl[p];
                    const f32x2 a = {fminf(g.x, 7.f), fminf(g.y, 7.f)}, b = {__builtin_amdgcn_fmed3f(l.x, -6.f * SC_A, 8.f * SC_A), __builtin_amdgcn_fmed3f(l.y, -6.f * SC_A, 8.f * SC_A)};
                    const f32x2 t = a * CE; const f32x2 d = (f32x2){__builtin_amdgcn_exp2f(t.x), __builtin_amdgcn_exp2f(t.y)} + 1.f;
                    const f32x2 sg = {__builtin_amdgcn_rcpf(d.x), __builtin_amdgcn_rcpf(d.y)};
                    o[p] = (a * sg) * b; }
                u32x2 w; int r0 = __builtin_amdgcn_cvt_pk_fp8_f32(o[0].x, o[0].y, 0, false); r0 = __builtin_amdgcn_cvt_pk_fp8_f32(o[1].x, o[1].y, r0, true);
                int r1 = __builtin_amdgcn_cvt_pk_fp8_f32(o[2].x, o[2].y, 0, false); r1 = __builtin_amdgcn_cvt_pk_fp8_f32(o[3].x, o[3].y, r1, true);
                w.x = (unsigned)r0; w.y = (unsigned)r1;
                *(u32x2*)(ACT + (size_t)(row0 + ai * HALF + m * 16) * DM + colg) = w; }
    }
};
struct EpiDown {
    static constexpr bool PERM = true; static constexpr bool STAGED = true;
    unsigned char* Y; const float* bdn; const int* list_tk; const float* list_g;
    __device__ __forceinline__ void stage(const Unit& u, int wid, int lane, LAS unsigned char* dst) const {
        const size_t lbase = (size_t)u.e * LISTCAP + (size_t)u.mb * BM;
        const void* src = wid == 0 ? (const void*)(bdn + (size_t)u.e * DM + u.pn * BM + 4 * lane) : wid == 1 ? (const void*)(list_tk + lbase + 4 * lane) : (const void*)(list_g + lbase + 4 * lane);
        __builtin_amdgcn_global_load_lds((const unsigned*)src, (LAS unsigned*)(dst + 1024 * wid), 16, 0, 0);
    }
    __device__ __forceinline__ void operator()(const Acc& acc, const Unit& u, int wr, int wc, int fr, int fq, LAS const unsigned char* es) const {
        constexpr float INV = SC_Y / (SC_A * SC_W2);
        const int r0 = wr * 64 + fr, col0 = u.pn * BM + wc * 32 + 8 * fq;
        const int cl = wc * 32 + 8 * fq;
        f32x4 bv[2][2];
#pragma unroll
        for (int bj = 0; bj < 2; ++bj)
#pragma unroll
            for (int n = 0; n < 2; ++n) bv[bj][n] = *(const LAS f32x4*)(es + 4 * (cl + bj * HALF + 4 * n)) * SC_Y;
        int tkv[2][4]; float gtv[2][4];
#pragma unroll
        for (int ai = 0; ai < 2; ++ai)
#pragma unroll
            for (int m = 0; m < 4; ++m) { const int r = r0 + ai * HALF + m * 16; tkv[ai][m] = *(const LAS int*)(es + 1024 + 4 * r); gtv[ai][m] = *(const LAS float*)(es + 2048 + 4 * r); }
#pragma unroll
        for (int ai = 0; ai < 2; ++ai)
#pragma unroll
            for (int m = 0; m < 4; ++m) { const int r = r0 + ai * HALF + m * 16;
                if (r < u.nrows) { const float gt = gtv[ai][m];
                    unsigned char* rowp = Y + (size_t)tkv[ai][m] * DM + col0;
#pragma unroll
                    for (int bj = 0; bj < 2; ++bj) { const float gi = gt * INV; const f32x4 v0 = acc[ai][bj][m][0] * gi + bv[bj][0] * gt, v1 = acc[ai][bj][m][1] * gi + bv[bj][1] * gt;
                        u32x2 w; w.x = pk8(v0[0], v0[1], v0[2], v0[3]); w.y = pk8(v1[0], v1[1], v1[2], v1[3]);
                        *(u32x2*)(rowp + bj * HALF) = w; } } }
    }
};
struct EpiMoeMix {
    static constexpr bool PERM = true; static constexpr bool STAGED = true;
    CArgs* ap; int l;
    __device__ __forceinline__ void stage(const Unit& u, int wid, int lane, LAS unsigned char* dst) const {
        CArgs& A = *ap; unsigned char* ws = A.ws;
        if (u.kind == 0) { const EpiSwiglu sw{ws + WS_ACT, A.in[I_BGU] + (size_t)l * 32 * 2048}; sw.stage(u, wid, lane, dst); }
        else { const EpiDown dn{ws + WS_Y, A.in[I_BDN] + (size_t)l * 32 * 1024, (const int*)(ws + WS_LTK) + (size_t)l * 32 * LISTCAP, (const float*)(ws + WS_LG) + (size_t)l * 32 * LISTCAP}; dn.stage(u, wid, lane, dst); }
    }
    __device__ __forceinline__ void operator()(const Acc& acc, const Unit& u, int wr, int wc, int fr, int fq, LAS const unsigned char* es) const {
        CArgs& A = *ap; unsigned char* ws = A.ws;
        if (u.kind == 0) { const EpiSwiglu sw{ws + WS_ACT, A.in[I_BGU] + (size_t)l * 32 * 2048}; sw(acc, u, wr, wc, fr, fq, es); }
        else { const EpiDown dn{ws + WS_Y, A.in[I_BDN] + (size_t)l * 32 * 1024, (const int*)(ws + WS_LTK) + (size_t)l * 32 * LISTCAP, (const float*)(ws + WS_LG) + (size_t)l * 32 * LISTCAP}; dn(acc, u, wr, wc, fr, fq, es); }
    }
};
}
struct Frame { unsigned char* lds; int tid, lane, wave, bid, G; };
#define P_MOD   ((float*)(A.ws + WS_MOD))
#define P_S5A   ((float*)(A.ws + WS_S5A))
#define P_S5BB  ((float*)(A.ws + WS_S5BB))
#define P_ROPE  ((float*)(A.ws + WS_ROPE))
#define P_WSIDE ((float*)(A.ws + WS_WSIDE))
#define P_S5CK  ((bf16_t*)(A.ws + WS_S5CK))
#define P_LTK   ((int*)(A.ws + WS_LTK))
#define P_LG    ((float*)(A.ws + WS_LG))
#define P_CNT   ((unsigned*)(A.ws + WS_CTL) + CW_CNT)
#define P_WINE  (A.ws + WS_WINE)
#define P_WGLU  ((bf16_t*)(A.ws + WS_WGLU))
#define P_WOUTE ((bf16_t*)(A.ws + WS_WOUTE))
#define P_WINO  (A.ws + WS_WINO)
#define P_WOUTO ((bf16_t*)(A.ws + WS_WOUTO))
#define P_W1    (A.ws + WS_W1)
#define P_W2    (A.ws + WS_W2)
#define P_HB8   (A.ws + WS_HB8)
#define P_HB    (A.ws + WS_HB)
#define P_Z     ((bf16_t*)(A.ws + WS_Z))
#define P_G5    ((bf16_t*)(A.ws + WS_G5))
#define P_YCAT  ((bf16_t*)(A.ws + WS_YCAT))
#define P_ACT   (A.ws + WS_ACT)
#define P_Y     (A.ws + WS_Y)
#define P_LSIG  ((float*)(A.ws + WS_LSIG))
#define P_LOGA  ((float*)(A.ws + WS_LOGA))
#define P_MBUF  ((float*)(A.ws + WS_MBUF))
#define P_XB    ((bf16_t*)(A.ws + WS_XB))
#define P_RST   ((bf16_t*)(A.ws + WS_RST))
#define P_GST   ((bf16_t*)(A.ws + WS_GST))

__device__ __forceinline__ void tr_tile(const float* __restrict__ src, int pitch, int k0, int c0, bf16_t* dst, int Kd, int r0, float* scr, int lane) {
#pragma unroll
    for (int i = 0; i < 16; ++i) {
        const int kk = 4 * i + (lane >> 4), cc = 4 * (lane & 15);
        const f32x4 v = __builtin_nontemporal_load((const f32x4*)(src + (size_t)(k0 + kk) * pitch + c0 + cc));
        float* s = scr + kk * 65 + cc; s[0] = v.x; s[1] = v.y; s[2] = v.z; s[3] = v.w;
    }
    LDS_WAIT();
    const int c = lane & 7;
#pragma unroll
    for (int j = 0; j < 8; ++j) { const int n = (lane >> 3) + 8 * j; const float* s = scr + (8 * c) * 65 + n;
        u32x4 o; o.x = pk2(s[0], s[65]); o.y = pk2(s[130], s[195]); o.z = pk2(s[260], s[325]); o.w = pk2(s[390], s[455]);
        __builtin_nontemporal_store(o, (u32x4*)(dst + (size_t)(r0 + n) * Kd + k0 + 8 * c)); }
    LDS_WAIT();
}
__device__ __forceinline__ void tr_tile8(const float* __restrict__ src, int pitch, int k0, int c0, unsigned char* dst, int Kd, int r0, float* scr, int lane, float scale) {
#pragma unroll
    for (int i = 0; i < 16; ++i) {
        const int kk = 4 * i + (lane >> 4), cc = 4 * (lane & 15);
        const f32x4 v = __builtin_nontemporal_load((const f32x4*)(src + (size_t)(k0 + kk) * pitch + c0 + cc));
        float* s = scr + kk * 65 + cc; s[0] = v.x * scale; s[1] = v.y * scale; s[2] = v.z * scale; s[3] = v.w * scale;
    }
    LDS_WAIT();
    const int c = lane & 3;
#pragma unroll
    for (int j = 0; j < 4; ++j) { const int n = (lane >> 2) + 16 * j; const float* s = scr + (16 * c) * 65 + n;
        u32x4 o; o.x = pk8(s[0], s[65], s[130], s[195]); o.y = pk8(s[260], s[325], s[390], s[455]); o.z = pk8(s[520], s[585], s[650], s[715]); o.w = pk8(s[780], s[845], s[910], s[975]);
        __builtin_nontemporal_store(o, (u32x4*)(dst + (size_t)(r0 + n) * Kd + k0 + 16 * c)); }
    LDS_WAIT();
}
struct TileD { const float* src; unsigned char* dst; int pitch, rp, mode; float scale; };
constexpr int P0_T0 = 16 * 32, P0_T1 = 8 * 8, P0_T2 = 16 * 16, P0_T3 = 16 * 56, P0_T4 = 16 * 16, P0_T5 = 64 * 16 * 32, P0_T6 = 64 * 16 * 16;
constexpr int P0_NTILES = P0_T0 + P0_T1 + P0_T2 + P0_T3 + P0_T4 + P0_T5 + P0_T6;
__device__ __forceinline__ void tile_set(TileD& d, const float* src, int pitch, int k0, int c0, unsigned char* dst, int Kd, int r0, int mode, float scale) {
    d.src = src + (size_t)k0 * pitch + c0; d.pitch = pitch; d.mode = mode; d.scale = scale;
    d.rp = mode ? Kd : 2 * Kd; d.dst = dst + (size_t)r0 * d.rp + (mode ? k0 : 2 * k0);
}
__device__ __forceinline__ void tile_decode(CArgs& A, int it, TileD& d) {
    int r = it;
    if (r < P0_T0) { const int kb = r / 32, nb = r % 32; tile_set(d, A.in[I_EVWIN], 2056, kb * 64, nb * 64, P_WINE, 1024, nb * 64, 0, 1.f); return; } r -= P0_T0;
    if (r < P0_T1) { const int kb = r / 8, nb = r % 8; tile_set(d, A.in[I_GLUW], 512, kb * 64, nb * 64, (unsigned char*)P_WGLU, 512, nb * 64, 0, 1.f); return; } r -= P0_T1;
    if (r < P0_T2) { const int kb = r / 16, nb = r % 16; tile_set(d, A.in[I_EVWOUT], 1024, kb * 64, nb * 64, (unsigned char*)P_WOUTE, 1024, nb * 64, 0, 1.f); return; } r -= P0_T2;
    if (r < P0_T3) { const int kb = r / 112, nb = r % 112; const int n0 = nb * 32; int c0;
        if (n0 < 1024) { const int pn = n0 >> 8, rem = n0 & 255, bj = rem >> 7, hl = (rem & 127) >> 6; c0 = 256 * pn + 128 * hl + 64 * bj + (n0 & 63); }
        else if (n0 < 3072) c0 = n0; else c0 = n0 + 16;
        tile_set(d, A.in[I_ODWIN], 3600, kb * 128, c0, P_WINO, 1024, n0, 1, SC_WIN); return; } r -= P0_T3;
    if (r < P0_T4) { const int kb = r / 16, nb = r % 16; tile_set(d, A.in[I_ODWOUT], 1024, kb * 64, nb * 64, (unsigned char*)P_WOUTO, 1024, nb * 64, 0, 1.f); return; } r -= P0_T4;
    if (r < P0_T5) { const int mat = r / 512, q = r % 512, kb = q / 64, nb = q % 64; const int n0 = nb * 32, pn = n0 >> 8, half = (n0 & 255) >> 7, j0 = n0 & 127;
        tile_set(d, A.in[I_WGU] + (size_t)mat * 1024 * 2048, 2048, kb * 128, half * 1024 + 128 * pn + j0, P_W1 + (size_t)mat * 2048 * 1024, 1024, n0, 1, SC_W1); return; } r -= P0_T5;
    { const int mat = r / 256, q = r % 256, kb = q / 32, nb = q % 32;
        tile_set(d, A.in[I_WDN] + (size_t)mat * 1024 * 1024, 1024, kb * 128, nb * 32, P_W2 + (size_t)mat * 1024 * 1024, 1024, nb * 32, 1, SC_W2); }
}
__device__ __forceinline__ void tile_load(const TileD& d, f32x4 (&R)[16], int lane) {
    const int rs = d.mode ? 3 : 4, kr = lane >> rs, cc = 4 * (lane & ((1 << rs) - 1)), kstep = 64 >> rs;
#pragma unroll
    for (int i = 0; i < 16; ++i) R[i] = __builtin_nontemporal_load((const f32x4*)(d.src + (size_t)(kstep * i + kr) * d.pitch + cc));
}
__device__ __forceinline__ void tile_to_lds(const TileD& d, const f32x4 (&R)[16], float* scr, int lane) {
    const int rs = d.mode ? 3 : 4, kr = lane >> rs, cc = 4 * (lane & ((1 << rs) - 1)), kstep = 64 >> rs, P = d.mode ? 33 : 65;
#pragma unroll
    for (int i = 0; i < 16; ++i) { float* s = scr + (kstep * i + kr) * P + cc; s[0] = R[i].x * d.scale; s[1] = R[i].y * d.scale; s[2] = R[i].z * d.scale; s[3] = R[i].w * d.scale; }
}
__device__ __forceinline__ void tile_finish(const TileD& d, const float* scr, int lane) {
    if (d.mode == 0) {
        const int c = lane & 7;
#pragma unroll
        for (int j = 0; j < 8; ++j) { const int n = (lane >> 3) + 8 * j; const float* s = scr + (8 * c) * 65 + n;
            u32x4 o; o.x = pk2(s[0], s[65]); o.y = pk2(s[130], s[195]); o.z = pk2(s[260], s[325]); o.w = pk2(s[390], s[455]);
            __builtin_nontemporal_store(o, (u32x4*)(d.dst + (size_t)n * d.rp + 16 * c)); }
    } else {
        const int c = lane & 7; const float* s0 = scr + (16 * c) * 33 + (lane >> 3);
        float v[4][16];
#pragma unroll
        for (int j = 0; j < 4; ++j)
#pragma unroll
            for (int t = 0; t < 16; ++t) v[j][t] = s0[8 * j + 33 * t];
#pragma unroll
        for (int j = 0; j < 4; ++j) { const int n = (lane >> 3) + 8 * j;
            u32x4 o; o.x = pk8(v[j][0], v[j][1], v[j][2], v[j][3]); o.y = pk8(v[j][4], v[j][5], v[j][6], v[j][7]); o.z = pk8(v[j][8], v[j][9], v[j][10], v[j][11]); o.w = pk8(v[j][12], v[j][13], v[j][14], v[j][15]);
            __builtin_nontemporal_store(o, (u32x4*)(d.dst + (size_t)n * d.rp + 16 * c)); }
    }
}
__device__ __forceinline__ void p0_tables(CArgs& A, const Frame& F) {
    if (F.bid < 192) {
        float* sc = (float*)F.lds;
        float* red = sc + 8192;
        for (int i = F.tid; i < 8192; i += 512) sc[i] = siluf_(A.in[I_C][i]);
        __syncthreads();
        const int l = F.bid / 96;
        const float* wb = A.in[I_ADAW] + (size_t)l * 1024 * 6144 + (F.bid % 96) * 64;
        float a[8];
#pragma unroll
        for (int b = 0; b < 8; ++b) a[b] = 0.f;
#pragma unroll 1
        for (int kb = 128 * F.wave; kb < 128 * F.wave + 128; kb += 32) { float wv[32];
#pragma unroll
            for (int t = 0; t < 32; ++t) { unsigned vo_ = 4u * (unsigned)F.lane; asm volatile("" : "+v"(vo_));
                wv[t] = __builtin_nontemporal_load((const float*)((const char*)(wb + (size_t)(kb + t) * 6144) + vo_)); }
#pragma unroll
            for (int t = 0; t < 32; ++t)
#pragma unroll
                for (int b = 0; b < 8; ++b) a[b] += sc[b * 1024 + kb + t] * wv[t]; }
#pragma unroll
        for (int b = 0; b < 8; ++b) red[(F.wave * 8 + b) * 64 + F.lane] = a[b];
        __syncthreads();
        { const int b = F.tid >> 6, ln = F.tid & 63; float s = 0.f;
#pragma unroll
          for (int w8 = 0; w8 < 8; ++w8) s += red[(w8 * 8 + b) * 64 + ln];
          const int nn = (F.bid % 96) * 64 + ln; __hip_atomic_store(P_MOD + (size_t)(l * 8 + b) * 6144 + nn, s + A.in[I_ADAB][l * 6144 + nn], __ATOMIC_RELAXED, __HIP_MEMORY_SCOPE_AGENT); }
    }
    {
        const int gt = F.bid * 512 + F.tid;
        if (gt < 32 * 64) {
            const int g = gt >> 6;
            const float lr = A.in[I_LAMRE][gt], li = A.in[I_LAMIM][gt], dt = expf(A.in[I_LOGDT][g]);
            const float mag = expf(lr * dt); float sn, cs; sincosf(li * dt, &sn, &cs);
            const float are = mag * cs, aim = mag * sn, den = lr * lr + li * li, nre = are - 1.f, nim = aim;
            const float zre = (nre * lr + nim * li) / den, zim = (nim * lr - nre * li) / den;
            P_S5A[gt * 2] = are; P_S5A[gt * 2 + 1] = aim;
            for (int c = 0; c < 16; ++c) { const float br = A.in[I_BRE][gt * 16 + c], bi = A.in[I_BIM][gt * 16 + c];
                P_S5BB[gt * 32 + c] = zre * br - zim * bi; P_S5BB[gt * 32 + 16 + c] = zre * bi + zim * br; }
        }
        for (int i = gt; i < 32 * 16 * 128; i += F.G * 512) { const int k = i & 127, gc = i >> 7, pp = k >> 1; const float v = (k & 1) ? -A.in[I_CIM][gc * 64 + pp] : A.in[I_CRE][gc * 64 + pp]; P_S5CK[i] = (bf16_t)f2bf(v); }
        for (int i = gt; i < 24 * 1024; i += F.G * 512) { const int o = i >> 10, k = i & 1023; P_WSIDE[i] = o < 8 ? A.in[I_EVWIN][(size_t)k * 2056 + 2048 + o] : A.in[I_ODWIN][(size_t)k * 3600 + 3072 + (o - 8)]; }
        for (int i = gt; i < SEQ * 64; i += F.G * 512) { const int pos = i >> 6, j = i & 63;
            const float inv = exp2f(-(float)j * (13.287712379549449f / 64.f)); const float ang = (float)pos * inv; float sn, cs; sincosf(ang, &sn, &cs);
            P_ROPE[i] = cs; P_ROPE[SEQ * 64 + i] = sn; }
    }
}
__device__ __forceinline__ void p0_tiles(CArgs& A, const Frame& F, int k0, int k1) {
    float* scr = (float*)(F.lds) + F.wave * (128 * 33);
    const int gw = F.bid * 8 + F.wave, NGW = F.G * 8;
    TileD d0, d1; f32x4 R0[16], R1[16];
    d0.src = nullptr; d0.dst = nullptr; d0.pitch = 0; d0.rp = 0; d0.mode = 0; d0.scale = 1.f; d1 = d0;
    const int iend_ = (gw + k1 * NGW) < P0_NTILES ? (gw + k1 * NGW) : P0_NTILES;
    int i0 = gw + k0 * NGW, i1 = i0 + NGW;
    if (i0 < iend_) { tile_decode(A, i0, d0); tile_load(d0, R0, F.lane); }
    if (i1 < iend_) { tile_decode(A, i1, d1); tile_load(d1, R1, F.lane); }
#define P0_STEP(dd, RR, ii) do { const TileD cur_ = dd; tile_to_lds(cur_, RR, scr, F.lane); ii += 2 * NGW; \
        if (ii < iend_) { tile_decode(A, ii, dd); tile_load(dd, RR, F.lane); } \
        asm volatile("" ::: "memory");                   \
        LDS_WAIT(); tile_finish(cur_, scr, F.lane); LDS_WAIT(); } while (0)
#pragma unroll 1
    while (i0 < iend_) {
        P0_STEP(d0, R0, i0);
        if (i1 >= iend_) break;
        P0_STEP(d1, R1, i1);
    }
#undef P0_STEP
}

struct Row { f32x4 v[4]; };
__device__ __forceinline__ void row_load(Row& r, const float* p, int lane) {
#pragma unroll
    for (int j = 0; j < 4; ++j) r.v[j] = __builtin_nontemporal_load((const f32x4*)(p + 4 * lane + 256 * j));
}
__device__ __forceinline__ void row_load_bf16(Row& r, const bf16_t* p, int lane) {
#pragma unroll
    for (int j = 0; j < 4; ++j) { const u32x2 w = __builtin_nontemporal_load((const u32x2*)(p + 4 * lane + 256 * j)); r.v[j] = (f32x4){bflo(w.x), bfhi(w.x), bflo(w.y), bfhi(w.y)}; }
}
__device__ __forceinline__ void row_store(const Row& r, float* p, int lane) {
#pragma unroll
    for (int j = 0; j < 4; ++j) __builtin_nontemporal_store(r.v[j], (f32x4*)(p + 4 * lane + 256 * j));
}
__device__ __forceinline__ void row_store_bf16(const Row& r, bf16_t* p, int lane) {
#pragma unroll
    for (int j = 0; j < 4; ++j) { u32x2 w; w.x = pk2(r.v[j].x, r.v[j].y); w.y = pk2(r.v[j].z, r.v[j].w); *(u32x2*)(p + 4 * lane + 256 * j) = w; }
}
__device__ __forceinline__ void row_store_bf16_nt(const Row& r, bf16_t* p, int lane) {
#pragma unroll
    for (int j = 0; j < 4; ++j) { u32x2 w; w.x = pk2(r.v[j].x, r.v[j].y); w.y = pk2(r.v[j].z, r.v[j].w); __builtin_nontemporal_store(w, (u32x2*)(p + 4 * lane + 256 * j)); }
}
__device__ __forceinline__ float row_rstd(const Row& r) {
    float s = 0.f;
#pragma unroll
    for (int j = 0; j < 4; ++j) s += (r.v[j].x * r.v[j].x + r.v[j].y * r.v[j].y) + (r.v[j].z * r.v[j].z + r.v[j].w * r.v[j].w);
    return rsqrtf(wave_sum(s) * (1.f / DM) + EPS);
}
__device__ __forceinline__ void row_modnorm(Row& h, const Row& x, const float* gain, const float* sh, const float* sc, int lane) {
    const float r = row_rstd(x);
#pragma unroll
    for (int j = 0; j < 4; ++j) { const int k = 4 * lane + 256 * j; const f32x4 g = *(const f32x4*)(gain + k), a = *(const f32x4*)(sc + k), b = *(const f32x4*)(sh + k);
        h.v[j] = x.v[j] * r * g * (a + 1.f) + b; }
}
__device__ __forceinline__ void hprep_row(CArgs& A, const Frame& F, const Row& x, int l, int row, const float* wl) {
    const int b = row >> 11, lane = F.lane; const float* mod = P_MOD + (size_t)(l * 8 + b) * 6144;
    Row h; row_modnorm(h, x, A.in[I_NPM] + l * DM, mod, mod + 1024, lane);
    if (l == 0) row_store_bf16(h, (bf16_t*)P_HB + (size_t)row * DM, lane);
    else {
#pragma unroll
        for (int j = 0; j < 4; ++j) *(unsigned*)(P_HB + (size_t)row * DM + 4 * lane + 256 * j) = pk8(SC_H * h.v[j].x, SC_H * h.v[j].y, SC_H * h.v[j].z, SC_H * h.v[j].w);
    }
    if (l == 0) {
        float mine = 0.f;
#pragma unroll
        for (int i = 0; i < 8; ++i) { float p = 0.f;
#pragma unroll
            for (int j = 0; j < 4; ++j) { const f32x4 w = *(const f32x4*)(wl + i * 1024 + 4 * lane + 256 * j); p += (h.v[j].x * w.x + h.v[j].y * w.y) + (h.v[j].z * w.z + h.v[j].w * w.w); }
            const float s = wave_sum(p); if (lane == i) mine = s; if ((i & 3) == 3) asm volatile("" ::: "memory"); }
        if (lane < 8) P_LSIG[(size_t)row * 8 + lane] = log_sigmoidf_(mine + A.in[I_FOXB][lane]);
    } else {
        float p[16];
#pragma unroll
        for (int i = 0; i < 16; ++i) { float q = 0.f;
#pragma unroll
            for (int j = 0; j < 4; ++j) { const f32x4 w = *(const f32x4*)(wl + i * 1024 + 4 * lane + 256 * j); q += (h.v[j].x * w.x + h.v[j].y * w.y) + (h.v[j].z * w.z + h.v[j].w * w.w); }
            p[i] = wave_sum(q); if ((i & 1) == 1) asm volatile("" ::: "memory"); }
        const float* wup = wl + 16 * 1024;
#pragma unroll
        for (int q = 0; q < 4; ++q) { const int jcol = lane + 64 * q; float s = wup[16 * 256 + jcol];
#pragma unroll
            for (int i = 0; i < 16; ++i) s += p[i] * wup[i * 256 + jcol];
            P_LOGA[(size_t)row * 256 + jcol] = log_sigmoidf_(s) * (1.f / 16.f); }
    }
}
__device__ __forceinline__ void stage_side(CArgs& A, const Frame& F, int l, float* wl) {
    __syncthreads();
    if (l == 0) { for (int i = F.tid; i < 8 * 256; i += 512) *(f32x4*)(wl + 4 * i) = *(const f32x4*)(P_WSIDE + 4 * i); }
    else { for (int i = F.tid; i < 16 * 256; i += 512) *(f32x4*)(wl + 4 * i) = *(const f32x4*)(P_WSIDE + 8192 + 4 * i);
           for (int i = F.tid; i < 16 * 64; i += 512) *(f32x4*)(wl + 16384 + 4 * i) = *(const f32x4*)(A.in[I_GLAWUP] + 4 * i);
           if (F.tid < 64) *(f32x4*)(wl + 16384 + 4096 + 4 * F.tid) = *(const f32x4*)(A.in[I_GLABG] + 4 * F.tid); }
    __syncthreads();
}
__device__ __forceinline__ void p1_hprep0(CArgs& A, const Frame& F) {
    float* wl = (float*)F.lds; stage_side(A, F, 0, wl);
    const int gw = F.bid * 8 + F.wave, NGW = F.G * 8;
    Row xn; if (gw < NTOK) row_load(xn, A.in[I_X] + (size_t)gw * DM, F.lane);
#pragma unroll 1
    for (int row = gw; row < NTOK; row += NGW) { Row x;
#pragma unroll
        for (int j = 0; j < 4; ++j) x.v[j] = xn.v[j];
        if (row + NGW < NTOK) row_load(xn, A.in[I_X] + (size_t)(row + NGW) * DM, F.lane); hprep_row(A, F, x, 0, row, wl); }
}

__device__ __forceinline__ void p_postmix(CArgs& A, const Frame& F, int l) {
    float* h2s = (float*)F.lds;
    float* red = h2s + 16 * 1028;
    float* lg = red + 8 * 16 * 32;
    float* tv = lg + 16 * 32;
    int* lcnt = (int*)(tv + 64);
    int* ent = lcnt + 64;
    if (F.tid < 32) lcnt[F.tid] = 0;
    int nent = 0;
    const float* rw = A.in[I_RW] + (size_t)l * 1024 * 32;
    u32x2 pm[2][4]; f32x4 pxf[2][4]; u32x2 pxb[2][4];
#define PM_LOAD(tile_) do { const int r0_ = (tile_) * 16 + 2 * F.wave; _Pragma("unroll") for (int rr = 0; rr < 2; ++rr) _Pragma("unroll") for (int j = 0; j < 4; ++j) { \
        pm[rr][j] = __builtin_nontemporal_load((const u32x2*)((const bf16_t*)P_MBUF + (size_t)(r0_ + rr) * DM + 4 * F.lane + 256 * j)); \
        if (l == 0) pxf[rr][j] = __builtin_nontemporal_load((const f32x4*)(A.in[I_X] + (size_t)(r0_ + rr) * DM + 4 * F.lane + 256 * j)); \
        else pxb[rr][j] = __builtin_nontemporal_load((const u32x2*)(P_XB + (size_t)(r0_ + rr) * DM + 4 * F.lane + 256 * j)); } } while (0)
    if (F.bid < NTOK / 16) PM_LOAD(F.bid);
#pragma unroll 1
    for (int tile = F.bid; tile < NTOK / 16; tile += F.G) {
        const int row0 = tile * 16 + 2 * F.wave;
        Row m0, x0, m1, x1;
#pragma unroll
        for (int j = 0; j < 4; ++j) { m0.v[j] = (f32x4){bflo(pm[0][j].x), bfhi(pm[0][j].x), bflo(pm[0][j].y), bfhi(pm[0][j].y)}; m1.v[j] = (f32x4){bflo(pm[1][j].x), bfhi(pm[1][j].x), bflo(pm[1][j].y), bfhi(pm[1][j].y)};
            if (l == 0) { x0.v[j] = pxf[0][j]; x1.v[j] = pxf[1][j]; }
            else { x0.v[j] = (f32x4){bflo(pxb[0][j].x), bfhi(pxb[0][j].x), bflo(pxb[0][j].y), bfhi(pxb[0][j].y)}; x1.v[j] = (f32x4){bflo(pxb[1][j].x), bfhi(pxb[1][j].x), bflo(pxb[1][j].y), bfhi(pxb[1][j].y)}; } }
        if (tile + F.G < NTOK / 16) PM_LOAD(tile + F.G);
#pragma unroll
        for (int rr = 0; rr < 2; ++rr) {
            const int lr = 2 * F.wave + rr, row = row0 + rr, b = row >> 11; const float* mod = P_MOD + (size_t)(l * 8 + b) * 6144;
            const Row& m = rr ? m1 : m0; Row x = rr ? x1 : x0;
            const float r1 = row_rstd(m);
#pragma unroll
            for (int j = 0; j < 4; ++j) { const int k = 4 * F.lane + 256 * j; const f32x4 gp = *(const f32x4*)(A.in[I_NQM] + l * DM + k), g1 = *(const f32x4*)(mod + 2048 + k);
                x.v[j] = x.v[j] + g1 * (m.v[j] * r1 * gp); }
            row_store_bf16_nt(x, P_XB + (size_t)row * DM, F.lane);
            Row h; row_modnorm(h, x, A.in[I_NPF] + l * DM, mod + 3072, mod + 4096, F.lane);
#pragma unroll
            for (int j = 0; j < 4; ++j) *(unsigned*)(P_HB8 + (size_t)row * DM + 4 * F.lane + 256 * j) = pk8(SC_H * h.v[j].x, SC_H * h.v[j].y, SC_H * h.v[j].z, SC_H * h.v[j].w);
#pragma unroll
            for (int j = 0; j < 4; ++j) *(f32x4*)(h2s + lr * 1028 + 4 * F.lane + 256 * j) = h.v[j];
        }
        __syncthreads();
        {
            f32x4 d0 = {0.f, 0.f, 0.f, 0.f}, d1 = {0.f, 0.f, 0.f, 0.f};
            const int r16 = F.lane & 15, kq = F.lane >> 4;
#pragma unroll 8
            for (int ks = 0; ks < 32; ++ks) { const int k = 128 * F.wave + 4 * ks + kq;
                const float a = h2s[r16 * 1028 + k]; const float b0 = rw[k * 32 + r16], b1 = rw[k * 32 + 16 + r16];
                d0 = __builtin_amdgcn_mfma_f32_16x16x4f32(a, b0, d0, 0, 0, 0); d1 = __builtin_amdgcn_mfma_f32_16x16x4f32(a, b1, d1, 0, 0, 0); }
#pragma unroll
            for (int q = 0; q < 4; ++q) { red[(F.wave * 16 + 4 * kq + q) * 32 + r16] = d0[q]; red[(F.wave * 16 + 4 * kq + q) * 32 + 16 + r16] = d1[q]; }
        }
        __syncthreads();
        const int r = F.tid >> 5, e = F.tid & 31;
        { float s = A.in[I_RB][l * 32 + e];
#pragma unroll
          for (int w8 = 0; w8 < 8; ++w8) s += red[(w8 * 16 + r) * 32 + e];
          lg[r * 32 + e] = s; }
        __syncthreads();
        const float v = lg[r * 32 + e]; int rank = 0;
#pragma unroll 8
        for (int q = 0; q < 32; ++q) { const float u = lg[r * 32 + q]; rank += (u > v || (u == v && q < e)) ? 1 : 0; }
        if (rank < 4) tv[r * 4 + rank] = v;
        __syncthreads();
        if (rank < 4) { const f32x4 t4 = *(const f32x4*)(tv + r * 4);
            const float wsum = 1.f + __expf(t4.y - t4.x) + __expf(t4.z - t4.x) + __expf(t4.w - t4.x), wk = __expf(v - t4.x);
            const int token = tile * 16 + r, lpos = atomicAdd(lcnt + e, 1), slot = nent + r * 4 + rank;
            ent[slot * 4] = e; ent[slot * 4 + 1] = lpos; ent[slot * 4 + 2] = token * 4 + rank; ent[slot * 4 + 3] = __float_as_int(wk / wsum); }
        nent += 64;
        __syncthreads();
    }
#undef PM_LOAD
    unsigned* cntp = P_CNT; int* ltk = P_LTK; float* lgp = P_LG;
    if (F.tid < 32) { const int n = lcnt[F.tid]; lcnt[32 + F.tid] = n > 0 ? (int)atomicAdd(cntp + 64 * (l * 32 + F.tid), (unsigned)n) : 0; }
    __syncthreads();
    if (F.tid < nent) { const int e = ent[F.tid * 4], pos = lcnt[32 + e] + ent[F.tid * 4 + 1];
        ltk[(size_t)(l * 32 + e) * LISTCAP + pos] = ent[F.tid * 4 + 2]; lgp[(size_t)(l * 32 + e) * LISTCAP + pos] = __int_as_float(ent[F.tid * 4 + 3]); }
    __syncthreads();
}
__device__ __forceinline__ void p_combine(CArgs& A, const Frame& F, int l) {
    float* wl = (float*)F.lds; if (l == 0) stage_side(A, F, 1, wl);
    const int gw = F.bid * 8 + F.wave, NGW = F.G * 8;
    unsigned y[4][4]; Row xr;
#define COMB_LOAD(row_) do { _Pragma("unroll") for (int k = 0; k < 4; ++k) _Pragma("unroll") for (int j = 0; j < 4; ++j) y[k][j] = __builtin_nontemporal_load((const unsigned*)(P_Y + (size_t)((row_) * 4 + k) * DM + 4 * F.lane + 256 * j)); \
        row_load_bf16(xr, P_XB + (size_t)(row_) * DM, F.lane); } while (0)
    if (gw < NTOK) COMB_LOAD(gw);
#pragma unroll 1
    for (int row = gw; row < NTOK; row += NGW) {
        const int b = row >> 11; const float* mod = P_MOD + (size_t)(l * 8 + b) * 6144;
        Row f;
#pragma unroll
        for (int j = 0; j < 4; ++j) { f.v[j] = (f32x4){0.f, 0.f, 0.f, 0.f};
#pragma unroll
            for (int k = 0; k < 4; ++k) { const f32x2 lo = __builtin_amdgcn_cvt_pk_f32_fp8((int)y[k][j], false), hi = __builtin_amdgcn_cvt_pk_f32_fp8((int)y[k][j], true); f.v[j].x += lo.x; f.v[j].y += lo.y; f.v[j].z += hi.x; f.v[j].w += hi.y; }
            f.v[j] = f.v[j] * (1.f / SC_Y); }
        Row x = xr;
        if (row + NGW < NTOK) COMB_LOAD(row + NGW);
        const float r = row_rstd(f);
#pragma unroll
        for (int j = 0; j < 4; ++j) { const int k = 4 * F.lane + 256 * j; const f32x4 gp = *(const f32x4*)(A.in[I_NQF] + l * DM + k), g2 = *(const f32x4*)(mod + 5120 + k);
            x.v[j] = x.v[j] + g2 * (f.v[j] * r * gp); }
        if (l == 0) row_store_bf16_nt(x, P_XB + (size_t)row * DM, F.lane); else row_store(x, A.out + (size_t)row * DM, F.lane);
        if (l == 0) hprep_row(A, F, x, 1, row, wl);
    }
#undef COMB_LOAD
}
__device__ __forceinline__ int moe_tables(CArgs& A, const Frame& F, int l, LAS pg8::MoeTables* tb) {
    __syncthreads();
    if (F.tid < 32) tb->cnt[F.tid] = (int)__hip_atomic_load(P_CNT + 64 * (l * 32 + F.tid), __ATOMIC_RELAXED, __HIP_MEMORY_SCOPE_AGENT);
    __syncthreads();
    if (F.tid == 0) { int s = 0;
#pragma nounroll
        for (int e = 0; e < 32; ++e) { tb->mtstart[e] = s; s += (tb->cnt[e] + 255) >> 8; }
        tb->mtstart[32] = s; }
    __syncthreads();
    if (F.tid < 320) { int e = 0;
#pragma nounroll
        for (int q = 1; q < 32; ++q) if (tb->mtstart[q] <= F.tid) e = q;
        tb->tile_e[F.tid] = (unsigned char)e; }
    __syncthreads();
    return tb->mtstart[32];
}
__device__ __forceinline__ void fox_kbias(CArgs& A, const Frame& F, int b, int h, float* kb, float* wtot  ) {
    const int t0 = 4 * F.tid; float e[4];
#pragma unroll
    for (int i = 0; i < 4; ++i) e[i] = P_LSIG[(size_t)(b * SEQ + t0 + i) * 8 + h];
    const float s4 = (e[0] + e[1]) + (e[2] + e[3]); float v = s4;
#pragma unroll
    for (int o = 1; o < 64; o <<= 1) { const float tt = __shfl_up(v, o); if (F.lane >= o) v += tt; }
    if (F.lane == 63) wtot[F.wave] = v;
    __syncthreads();
    float off = 0.f;
#pragma unroll
    for (int w = 0; w < 8; ++w) if (w < F.wave) off += wtot[w];
    float c = off + v - s4;
#pragma unroll
    for (int i = 0; i < 4; ++i) { c += e[i]; kb[t0 + i] = -LOG2E * c; }
    __syncthreads();
}
#include <hip/hip_bf16.h>
namespace attn_body {
using bf16=__hip_bfloat16;
using bf16x8=__attribute__((ext_vector_type(8)))short;
using s16x4=__attribute__((ext_vector_type(4)))short;
using f32x16=__attribute__((ext_vector_type(16)))float;
using u32x4=__attribute__((ext_vector_type(4)))unsigned;
constexpr int BATCH=8,NHEAD=8,SEQ=2048,D=64,QP=2048,OP=1024;
constexpr int NW=8,QBLK=32,QB=QBLK*NW,KVBLK=64,NQB=SEQ/QB;
constexpr int ATTN_UNIT_ROWS=QB;
__device__ __forceinline__ int crow(int r,int hi){return (r&3)+8*(r>>2)+4*hi;}
#define SBAR() __builtin_amdgcn_sched_barrier(0)
__device__ __forceinline__ void cmask(f32x16&p0,f32x16&p1,int jb,int qrel,int hi){
  const float NEG=-INFINITY; int kb=64*jb+4*hi;
  #pragma unroll
  for(int r=0;r<16;++r){int kv=kb+(r&3)+8*(r>>2); if(kv>qrel)p0[r]=NEG; if(kv+32>qrel)p1[r]=NEG;}
}

constexpr int NSLOT=3, SLOTB=8192;
constexpr int LDS_K=0, LDS_V=NSLOT*SLOTB, LDS_WS=2*NSLOT*SLOTB, LDS_OST=LDS_WS+NW*64*4, LDS_BYTES=LDS_OST+NW*4096;
constexpr float C2=0.125f*1.4426950408889634f;
__device__ __forceinline__ void glds16(const void*gsrc,unsigned lds_dst){unsigned keep;
  asm volatile("s_mov_b32 %0, m0\n\ts_mov_b32 m0, %2\n\ts_nop 0\n\tglobal_load_lds_dwordx4 %1, off\n\ts_mov_b32 m0, %0":"=&s"(keep):"v"(gsrc),"s"(lds_dst):"memory");}
__device__ __forceinline__ float max3f(float a,float b,float c){float r;asm("v_max3_f32 %0, %1, %2, %3":"=v"(r):"v"(a),"v"(b),"v"(c));return r;}
__device__ __forceinline__ float max2f(float a,float b){float r;asm("v_max_f32_e32 %0, %1, %2":"=v"(r):"v"(a),"v"(b));return r;}
__device__ __forceinline__ float fadd_s(float a,float b){float r;asm("v_add_f32_e32 %0, %1, %2":"=v"(r):"v"(a),"v"(b));return r;}
__device__ __forceinline__ float fsub_s(float a,float b){float r;asm("v_sub_f32_e32 %0, %1, %2":"=v"(r):"v"(a),"v"(b));return r;}
typedef float f32x2_t __attribute__((ext_vector_type(2))); typedef float f32x4_t __attribute__((ext_vector_type(4))); typedef __bf16 bf16x2_t __attribute__((ext_vector_type(2)));
__device__ __forceinline__ unsigned cvtpk_s(float lo,float hi){f32x2_t v={lo,hi};bf16x2_t b=__builtin_convertvector(v,bf16x2_t);return __builtin_bit_cast(unsigned,b);}
#define WAIT_BAR(N) asm volatile("s_waitcnt vmcnt(" #N ") lgkmcnt(0)\n\ts_barrier":::"memory")

__device__ __forceinline__ void qkt(f32x16&p0,f32x16&p1,const char*Kslot,const bf16x8*qr,const f32x16&c0i,const f32x16&c1i,int r32,int hi){
  const char*kb=Kslot+hi*1024+r32*16;
  #pragma unroll
  for(int d0=0;d0<4;++d0){
    const bf16x8 b0=*reinterpret_cast<const bf16x8*>(kb+d0*2048);
    const bf16x8 b1=*reinterpret_cast<const bf16x8*>(kb+d0*2048+512);
    if(d0==0){p0=__builtin_amdgcn_mfma_f32_32x32x16_bf16(b0,qr[0],c0i,0,0,0);p1=__builtin_amdgcn_mfma_f32_32x32x16_bf16(b1,qr[0],c1i,0,0,0);}
    else{p0=__builtin_amdgcn_mfma_f32_32x32x16_bf16(b0,qr[d0],p0,0,0,0);p1=__builtin_amdgcn_mfma_f32_32x32x16_bf16(b1,qr[d0],p1,0,0,0);}}
}
typedef __attribute__((address_space(3))) const char* lds_cptr;
typedef short v4i16_t __attribute__((ext_vector_type(4)));
__device__ __forceinline__ void kload8(bf16x8*kf,lds_cptr kp){
  kf[0]=*(const __attribute__((address_space(3))) bf16x8*)(kp);      kf[1]=*(const __attribute__((address_space(3))) bf16x8*)(kp+512);
  kf[2]=*(const __attribute__((address_space(3))) bf16x8*)(kp+2048); kf[3]=*(const __attribute__((address_space(3))) bf16x8*)(kp+2560);
  kf[4]=*(const __attribute__((address_space(3))) bf16x8*)(kp+4096); kf[5]=*(const __attribute__((address_space(3))) bf16x8*)(kp+4608);
  kf[6]=*(const __attribute__((address_space(3))) bf16x8*)(kp+6144); kf[7]=*(const __attribute__((address_space(3))) bf16x8*)(kp+6656);
}
__device__ __forceinline__ void kload2(bf16x8*kf,lds_cptr kp,int j){ kf[2*j]=*(const __attribute__((address_space(3))) bf16x8*)(kp+j*2048); kf[2*j+1]=*(const __attribute__((address_space(3))) bf16x8*)(kp+j*2048+512); }
__device__ __forceinline__ s16x4 vtr(lds_cptr p){ return __builtin_bit_cast(s16x4,__builtin_amdgcn_ds_read_tr16_b64_v4i16((__attribute__((address_space(3))) v4i16_t*)p)); }
__device__ __forceinline__ float rowmax(const f32x16&p0,const f32x16&p1){
  float a=max3f(p0[0],p0[1],p1[0]),b=max3f(p0[2],p0[3],p1[1]);a=max3f(a,p1[2],p1[3]);
  #pragma unroll
  for(int r=4;r<16;r+=4){a=max3f(a,p0[r],p0[r+1]);b=max3f(b,p0[r+2],p0[r+3]);a=max3f(a,p1[r],p1[r+1]);b=max3f(b,p1[r+2],p1[r+3]);}
  const float m=max2f(a,b);
  auto rr=__builtin_amdgcn_permlane32_swap(__float_as_uint(m),__float_as_uint(m),false,false);
  return max2f(__uint_as_float(rr[0]),__uint_as_float(rr[1]));
}
__device__ __forceinline__ void pv(f32x16*o,int vb,bf16x8 pa0,bf16x8 pa1,bf16x8 pa2,bf16x8 pa3){
  #pragma unroll
  for(int d0=0;d0<2;++d0){s16x4 lo[4],hi[4];
    #pragma unroll
    for(int ks=0;ks<4;++ks){
      asm volatile("ds_read_b64_tr_b16 %0,%1 offset:%c2":"=&v"(lo[ks]):"v"(vb),"i"(d0*4096+ks*1024):"memory");
      asm volatile("ds_read_b64_tr_b16 %0,%1 offset:%c2":"=&v"(hi[ks]):"v"(vb),"i"(d0*4096+ks*1024+512):"memory");}
    asm volatile("s_waitcnt lgkmcnt(0)":::"memory");SBAR();
    #define PK(k) (bf16x8){lo[k][0],lo[k][1],lo[k][2],lo[k][3],hi[k][0],hi[k][1],hi[k][2],hi[k][3]}
    o[d0]=__builtin_amdgcn_mfma_f32_32x32x16_bf16(pa0,PK(0),o[d0],0,0,0);
    o[d0]=__builtin_amdgcn_mfma_f32_32x32x16_bf16(pa1,PK(1),o[d0],0,0,0);
    o[d0]=__builtin_amdgcn_mfma_f32_32x32x16_bf16(pa2,PK(2),o[d0],0,0,0);
    o[d0]=__builtin_amdgcn_mfma_f32_32x32x16_bf16(pa3,PK(3),o[d0],0,0,0);
    #undef PK
  }
}

#ifndef ATTN_STORE16
#define ATTN_STORE16(p,v) (*(u32x4*)(p)=(v))
#endif
typedef const __attribute__((address_space(3))) float* lds_fptr;
template<int THRL> __device__ __forceinline__ void attn_unit(int b,int h,int qb,const bf16*Q,const bf16*__restrict__ K,const bf16*__restrict__ V,bf16*O,char*shm,lds_fptr kb,int tid,int wid){
  const int lane=tid&63,r32=lane&31,hi=lane>>5;
  const long rowbase=(long)b*SEQ; const int q0=qb*QB;
  const bf16*Qw=Q+(rowbase+q0+wid*QBLK)*QP+h*D;
  const bf16*Kh=K+rowbase*QP+h*D,*Vh=V+rowbase*QP+h*D;
  const unsigned lds0=(unsigned)(uintptr_t)shm;
  float*wsf=(float*)(shm+LDS_WS)+wid*64;
  const bf16*ksrc=Kh+(long)lane*QP+wid*8;
  const bf16*vsrc=Vh+(long)(16*(wid&3)+(lane>>2))*QP+(wid>>2)*32+(lane&3)*8;
  const unsigned kdst=lds0+LDS_K+wid*1024, vdst=lds0+LDS_V+wid*1024;
  #define DMA_K(t,slot) glds16(ksrc+(long)(t)*KVBLK*QP,(unsigned)__builtin_amdgcn_readfirstlane(kdst+(slot)))
  #define DMA_V(t,slot) glds16(vsrc+(long)(t)*KVBLK*QP,(unsigned)__builtin_amdgcn_readfirstlane(vdst+(slot)))
  const int vb0=(int)(lds0+LDS_V)+((lane>>4)&1)*32+(lane&3)*8+(4*hi+((lane&15)>>2))*64;
  const char*Kbase=shm+LDS_K; bf16x8 kf[8];
  const lds_cptr shm3=(lds_cptr)shm; const lds_cptr kp0=shm3+LDS_K+hi*1024+r32*16; const lds_cptr vp0=shm3+LDS_V+((lane>>4)&1)*32+(lane&3)*8+(4*hi+((lane&15)>>2))*64;
  const int NT=(q0+QB)/KVBLK;
  DMA_K(0,0);DMA_V(0,0);DMA_K(1,SLOTB);
  bf16x8 qr[4];
  #pragma unroll
  for(int d0=0;d0<4;++d0)qr[d0]=*reinterpret_cast<const bf16x8*>(&Qw[(long)r32*QP+d0*16+hi*8]);
  float mhat=0.f,l_reg=0.f;f32x16 o[2];o[0]=f32x16{};o[1]=f32x16{};float nm=0.f;
  #define BIASFILL(C0,C1,t) do{ const lds_fptr kbt_=kb+64*(t)+4*hi; _Pragma("unroll") for(int g_=0;g_<4;++g_){ const f32x4_t v0_=*(const __attribute__((address_space(3))) f32x4_t*)(kbt_+8*g_), v1_=*(const __attribute__((address_space(3))) f32x4_t*)(kbt_+32+8*g_); \
      _Pragma("unroll") for(int i_=0;i_<4;++i_){ C0[4*g_+i_]=v0_[i_]+nm; C1[4*g_+i_]=v1_[i_]+nm; } } }while(0)
  const int qrel=wid*QBLK+r32;
  #define CMASK(P0,P1,t) do{int jb_=(t)-(NT-4); if(jb_>=0)cmask(P0,P1,jb_,qrel,hi);}while(0)
  bool resc=false;
  #define START(P0,P1) do{ const float rm=rowmax(P0,P1); resc=false; \
    { const float dl=rm; mhat=fadd_s(mhat,dl); \
      _Pragma("unroll") for(int r=0;r<16;++r){P0[r]=fsub_s(P0[r],dl);P1[r]=fsub_s(P1[r],dl);} \
      nm=-mhat; } \
    _Pragma("unroll") for(int r=0;r<16;++r)P0[r]=__builtin_amdgcn_exp2f(P0[r]); }while(0)
  #define RESC() do{ if(resc){ asm volatile("s_waitcnt lgkmcnt(0)":::"memory"); \
      _Pragma("unroll") for(int d_=0;d_<2;++d_) _Pragma("unroll") for(int r=0;r<16;++r)o[d_][r]*=wsf[crow(r,hi)]; } }while(0)
  f32x16 pA0,pA1,pB0,pB1;
  int sl_prev=0,sl_cur=0,sl_next=SLOTB;
  #define ROT() do{sl_prev=sl_cur;sl_cur=sl_next;sl_next=(sl_next==(NSLOT-1)*SLOTB)?0:sl_next+SLOTB;}while(0)
  DMA_K(2,2*SLOTB);
  WAIT_BAR(3);
  { f32x16 c0i,c1i; BIASFILL(c0i,c1i,0); qkt(pA0,pA1,Kbase,qr,c0i,c1i,r32,hi); }asm volatile("s_nop 15\n\ts_nop 7":"+v"(pA0),"+v"(pA1));CMASK(pA0,pA1,0);
  START(pA0,pA1);
  _Pragma("unroll") for(int r=0;r<16;++r)pA1[r]=__builtin_amdgcn_exp2f(pA1[r]);
  WAIT_BAR(0);
  DMA_K(3,0);DMA_V(1,SLOTB);
  ROT();
  kload8(kf,kp0+sl_cur);
  WAIT_BAR(2);
  s16x4 vlo[8],vhi[8]; u32x4 pw0,pw1,pw2,pw3;
  #define PKW(P,B) cvtpk_s(P[B],P[B+1])
  #define PAF(k) __builtin_bit_cast(bf16x8,pw##k)
  #define VFR(i) (bf16x8){vlo[i][0],vlo[i][1],vlo[i][2],vlo[i][3],vhi[i][0],vhi[i][1],vhi[i][2],vhi[i][3]}
  #define PIN(x) asm volatile("":"+v"(x))
  #define MX3(a,b,c) __builtin_fmaxf(__builtin_fmaxf((a),(b)),(c))
  #define GAPA(MF,A0,A1,A2,A3,W0,W1,PW) do{ MF; sacc+=A0; sacc+=A1; sacc+=A2; sacc+=A3; PIN(sacc); W0; W1; PIN(PW); SBAR(); }while(0)
  #define EX(v) __builtin_amdgcn_exp2f(v)
  #define GAPB(MF,X,B) do{ MF; X[B]=EX(X[B]); X[B+1]=EX(X[B+1]); X[B+2]=EX(X[B+2]); X[B+3]=EX(X[B+3]); PIN(X); SBAR(); }while(0)
  #define VRD(i) do{ vlo[i]=vtr(vp_+(((i)>>2)*4096+((i)&3)*1024)); vhi[i]=vtr(vp_+(((i)>>2)*4096+((i)&3)*1024+512)); }while(0)
  #define KRD(G,j) do{ if(G){ kload2(kf,kp0+sl_next,j); SBAR(); } }while(0)
  #define STEP(C0,C1,P0,P1,t,GK,GV,GL) do{ SBAR(); BIASFILL(C0,C1,t); SBAR(); \
    const lds_cptr vp_=vp0+sl_prev; \
    VRD(0); SBAR(); float sacc=(P0[0]+P0[1]); \
    GAPA(C0=__builtin_amdgcn_mfma_f32_32x32x16_bf16(kf[0],qr[0],C0,0,0,0), P0[2],P0[3],P0[4],P0[5],     pw0[0]=PKW(P0,0), pw0[1]=PKW(P0,2), pw0); \
    VRD(4); SBAR(); GAPA(C1=__builtin_amdgcn_mfma_f32_32x32x16_bf16(kf[1],qr[0],C1,0,0,0), P0[6],P0[7],P0[8],P0[9],     pw0[2]=PKW(P0,4), pw0[3]=PKW(P0,6), pw0); \
    VRD(1); SBAR(); GAPA(C0=__builtin_amdgcn_mfma_f32_32x32x16_bf16(kf[2],qr[1],C0,0,0,0),   P0[10],P0[11],P0[12],P0[13], pw1[0]=PKW(P0,8), pw1[1]=PKW(P0,10), pw1); \
    VRD(5); SBAR(); GAPA(C1=__builtin_amdgcn_mfma_f32_32x32x16_bf16(kf[3],qr[1],C1,0,0,0),   P0[14],P0[15],P1[0],P1[1],   pw1[2]=PKW(P0,12),pw1[3]=PKW(P0,14), pw1); \
    VRD(2); SBAR(); GAPA(C0=__builtin_amdgcn_mfma_f32_32x32x16_bf16(kf[4],qr[2],C0,0,0,0),   P1[2],P1[3],P1[4],P1[5],     pw2[0]=PKW(P1,0), pw2[1]=PKW(P1,2), pw2); \
    VRD(6); SBAR(); GAPA(C1=__builtin_amdgcn_mfma_f32_32x32x16_bf16(kf[5],qr[2],C1,0,0,0),   P1[6],P1[7],P1[8],P1[9],     pw2[2]=PKW(P1,4), pw2[3]=PKW(P1,6), pw2); \
    VRD(3); SBAR(); GAPA(C0=__builtin_amdgcn_mfma_f32_32x32x16_bf16(kf[6],qr[3],C0,0,0,0),   P1[10],P1[11],P1[12],P1[13], pw3[0]=PKW(P1,8), pw3[1]=PKW(P1,10), pw3); \
    VRD(7); SBAR(); GAPA(C1=__builtin_amdgcn_mfma_f32_32x32x16_bf16(kf[7],qr[3],C1,0,0,0),   P1[14],P1[15],0.f,0.f,       pw3[2]=PKW(P1,12),pw3[3]=PKW(P1,14), pw3); \
    l_reg+=sacc; \
    if(GK){DMA_K((t)+3,sl_cur);} if(GV){DMA_V((t)+1,sl_next);} \
    CMASK(C0,C1,t); \
    { float a=MX3(C0[0],C0[1],C1[0]),b=MX3(C0[2],C0[3],C1[1]); a=MX3(a,C1[2],C1[3]); \
      _Pragma("unroll") for(int r=4;r<16;r+=4){a=MX3(a,C0[r],C0[r+1]);b=MX3(b,C0[r+2],C0[r+3]);a=MX3(a,C1[r],C1[r+1]);b=MX3(b,C1[r+2],C1[r+3]);} \
      float rm=__builtin_fmaxf(a,b); { auto rr=__builtin_amdgcn_permlane32_swap(__float_as_uint(rm),__float_as_uint(rm),false,false); rm=__builtin_fmaxf(__uint_as_float(rr[0]),__uint_as_float(rr[1])); } \
      resc=false; \
      if(__builtin_expect(__any(rm>(float)THRL),0)){ const float dl=__builtin_fmaxf(rm,0.f); mhat+=dl; \
        _Pragma("unroll") for(int r=0;r<16;++r){C0[r]-=dl;C1[r]-=dl;} \
        nm=-mhat; \
        const float f=__builtin_amdgcn_exp2f(-dl); l_reg*=f; if(hi==0)wsf[r32]=f; resc=true; } } \
    SBAR(); \
    GAPB(o[0]=__builtin_amdgcn_mfma_f32_32x32x16_bf16(PAF(0),VFR(0),o[0],0,0,0), C0,0); \
    GAPB(o[1]=__builtin_amdgcn_mfma_f32_32x32x16_bf16(PAF(0),VFR(4),o[1],0,0,0), C0,4); \
    KRD(GL,0); GAPB(o[0]=__builtin_amdgcn_mfma_f32_32x32x16_bf16(PAF(1),VFR(1),o[0],0,0,0), C0,8); \
    KRD(GL,1); GAPB(o[1]=__builtin_amdgcn_mfma_f32_32x32x16_bf16(PAF(1),VFR(5),o[1],0,0,0), C0,12); \
    KRD(GL,2); GAPB(o[0]=__builtin_amdgcn_mfma_f32_32x32x16_bf16(PAF(2),VFR(2),o[0],0,0,0), C1,0); \
    KRD(GL,3); GAPB(o[1]=__builtin_amdgcn_mfma_f32_32x32x16_bf16(PAF(2),VFR(6),o[1],0,0,0), C1,4); \
    GAPB(o[0]=__builtin_amdgcn_mfma_f32_32x32x16_bf16(PAF(3),VFR(3),o[0],0,0,0), C1,8); \
    GAPB(o[1]=__builtin_amdgcn_mfma_f32_32x32x16_bf16(PAF(3),VFR(7),o[1],0,0,0), C1,12); \
    }while(0)
  int t=1;
  #undef CMASK
  #define CMASK(P0,P1,t) do{}while(0)
  for(;t+5<NT;t+=2){
    STEP(pB0,pB1,pA0,pA1,t,true,true,true);     WAIT_BAR(2); RESC(); ROT();
    STEP(pA0,pA1,pB0,pB1,t+1,true,true,true);   WAIT_BAR(2); RESC(); ROT();
  }
  #undef CMASK
  #define CMASK(P0,P1,t) do{int jb_=(t)-(NT-4); if(jb_>=0)cmask(P0,P1,jb_,qrel,hi);}while(0)
  #define ENDW(tt) do{ if((tt)+3<NT){WAIT_BAR(2);} else if((tt)+2<NT){WAIT_BAR(1);} else {WAIT_BAR(0);} }while(0)
  for(;t+1<NT;t+=2){
    STEP(pB0,pB1,pA0,pA1,t,(t+3<NT),(t+1<NT),(t+1<NT));       ENDW(t);   RESC(); ROT();
    STEP(pA0,pA1,pB0,pB1,t+1,(t+4<NT),(t+2<NT),(t+2<NT));     ENDW(t+1); RESC(); ROT();
  }
  STEP(pB0,pB1,pA0,pA1,NT-1,false,false,false); RESC();
  { float sacc=pB0[0]+pB0[1]; _Pragma("unroll") for(int r=2;r<16;++r)sacc+=pB0[r]; _Pragma("unroll") for(int r=0;r<16;++r)sacc+=pB1[r]; l_reg+=sacc;
    pw0=(u32x4){PKW(pB0,0),PKW(pB0,2),PKW(pB0,4),PKW(pB0,6)};pw1=(u32x4){PKW(pB0,8),PKW(pB0,10),PKW(pB0,12),PKW(pB0,14)};pw2=(u32x4){PKW(pB1,0),PKW(pB1,2),PKW(pB1,4),PKW(pB1,6)};pw3=(u32x4){PKW(pB1,8),PKW(pB1,10),PKW(pB1,12),PKW(pB1,14)};
    SBAR(); pv(o,vb0+sl_cur,PAF(0),PAF(1),PAF(2),PAF(3)); }
  #undef PKW
  #undef PAF
  #undef VFR
  #undef PIN
  #undef MX3
  #undef GAPA
  #undef GAPB
  #undef EX
  #undef VRD
  #undef KRD
  #undef STEP
  #undef ENDW
  {auto rr=__builtin_amdgcn_permlane32_swap(__float_as_uint(l_reg),__float_as_uint(l_reg),false,false);l_reg=__uint_as_float(rr[0])+__uint_as_float(rr[1]);}
  if(hi==0)wsf[32+r32]=l_reg;asm volatile("s_waitcnt lgkmcnt(0)":::"memory");
  float rli[16];
  #pragma unroll
  for(int r=0;r<16;++r)rli[r]=__builtin_amdgcn_rcpf(wsf[32+crow(r,hi)]);
  bf16*Ow=O+(rowbase+q0+wid*QBLK)*OP+h*D;
  { bf16*stg=(bf16*)(shm+LDS_OST)+wid*2048;
    #pragma unroll
    for(int r=0;r<16;++r){const int orow=crow(r,hi);
      #pragma unroll
      for(int d0=0;d0<2;++d0)stg[orow*64+d0*32+r32]=__float2bfloat16(o[d0][r]*rli[r]);}
    asm volatile("s_waitcnt lgkmcnt(0)":::"memory");
    #pragma unroll
    for(int i=0;i<4;++i){const int row=i*8+(lane>>3),ch=lane&7; const u32x4 v=*(const u32x4*)(stg+row*64+ch*8); ATTN_STORE16(Ow+(long)row*OP+ch*8,v);} }
  asm volatile("s_waitcnt lgkmcnt(0)\n\ts_barrier":::"memory");
  #undef DMA_K
  #undef DMA_V
  #undef CMASK
  #undef START
  #undef RESC
  #undef ROT
  #undef BIASFILL
}
constexpr int ATTN_LDS_BYTES=LDS_BYTES;
#undef SBAR
#undef WAIT_BAR
}
__device__ __forceinline__ void fox_fast(CArgs& A, const Frame& F) {
    float* kb = (float*)(F.lds + 86016); float* wtot = kb + 2048;
    const int v = (F.bid & 7) * 32 + (F.bid >> 3), bh = v >> 2, s = v & 3, b = bh >> 3, h = bh & 7;
    fox_kbias(A, F, b, h, kb, wtot);
    const attn_body::bf16* Zb = (const attn_body::bf16*)P_Z;
    const attn_body::lds_fptr kb3 = (attn_body::lds_fptr)(const __attribute__((address_space(3))) unsigned char*)((LAS unsigned char*)F.lds + 86016);
    attn_body::attn_unit<8>(b, h, 7 - s, Zb + 512, Zb + 1024, Zb + 1536, (attn_body::bf16*)P_YCAT + 512, (char*)F.lds, kb3, F.tid, F.wave);
    attn_body::attn_unit<8>(b, h, s, Zb + 512, Zb + 1024, Zb + 1536, (attn_body::bf16*)P_YCAT + 512, (char*)F.lds, kb3, F.tid, F.wave);
}
typedef float f32x16 __attribute__((ext_vector_type(16)));
__device__ __forceinline__ bf16x8 pack8(const f32x4& a, const f32x4& b) { u32x4 w; w.x = pk2(a.x, a.y); w.y = pk2(a.z, a.w); w.z = pk2(b.x, b.y); w.w = pk2(b.z, b.w); return __builtin_bit_cast(bf16x8, w); }
__device__ __forceinline__ void s5_fast(CArgs& A, const Frame& F, int item) {
    const int b = item >> 5, g = item & 31, lane = F.lane, w = F.wave, p = lane & 31, hh = lane >> 5, l15 = lane & 15, l4 = lane >> 4;
    float* Eseg = (float*)F.lds; float* Hin = Eseg + 2048;
    bf16_t* Hs = (bf16_t*)(F.lds + 16384) + w * 4352;
    bf16x8 bbr[2], bbi[2]; float are[2], aim[2];
#pragma unroll
    for (int nt = 0; nt < 2; ++nt) { const float* q = P_S5BB + (size_t)(g * 64 + 32 * nt + p) * 32 + 8 * hh;
        bbr[nt] = pack8(*(const f32x4*)q, *(const f32x4*)(q + 4)); bbi[nt] = pack8(*(const f32x4*)(q + 16), *(const f32x4*)(q + 20));
        are[nt] = P_S5A[(g * 64 + 32 * nt + p) * 2]; aim[nt] = P_S5A[(g * 64 + 32 * nt + p) * 2 + 1]; }
    const int rr = lane & 31, ahalf = (rr >> 2) & 1, atau = (rr & 3) + 4 * (rr >> 3);
    const bf16_t* usrc = P_Z + (size_t)(b * SEQ + 128 * (2 * w + ahalf) + atau) * ZP0 + g * 16 + 8 * hh;
    const f32x16 zero16 = {0.f, 0.f, 0.f, 0.f, 0.f, 0.f, 0.f, 0.f, 0.f, 0.f, 0.f, 0.f, 0.f, 0.f, 0.f, 0.f};
    float hr[2] = {0.f, 0.f}, hi[2] = {0.f, 0.f};
#define S5_ALOAD(blk_) (*(const bf16x8*)(usrc + (size_t)(blk_) * 16 * ZP0))
    { bf16x8 a0 = S5_ALOAD(0), a1 = S5_ALOAD(1), a2 = S5_ALOAD(2);
#pragma unroll 1
      for (int blk = 0; blk < 8; ++blk) {
        const bf16x8 a = a0; a0 = a1; a1 = a2; if (blk + 3 < 8) a2 = S5_ALOAD(blk + 3);
#pragma unroll
        for (int nt = 0; nt < 2; ++nt) {
            const f32x16 dre = __builtin_amdgcn_mfma_f32_32x32x16_bf16(a, bbr[nt], zero16, 0, 0, 0), dim = __builtin_amdgcn_mfma_f32_32x32x16_bf16(a, bbi[nt], zero16, 0, 0, 0);
#pragma unroll
            for (int i = 0; i < 16; ++i) { const float nr = are[nt] * hr[nt] - aim[nt] * hi[nt] + dre[i], ni = are[nt] * hi[nt] + aim[nt] * hr[nt] + dim[i]; hr[nt] = nr; hi[nt] = ni; }
        }
      } }
#pragma unroll
    for (int nt = 0; nt < 2; ++nt) { Eseg[((2 * w + hh) * 64 + 32 * nt + p) * 2] = hr[nt]; Eseg[((2 * w + hh) * 64 + 32 * nt + p) * 2 + 1] = hi[nt]; }
    __syncthreads();
    if (w == 0) {
        float xr = P_S5A[(g * 64 + lane) * 2], xi = P_S5A[(g * 64 + lane) * 2 + 1];
#pragma unroll
        for (int q = 0; q < 7; ++q) { const float nr = xr * xr - xi * xi, ni = 2.f * xr * xi; xr = nr; xi = ni; }
        float Hr = 0.f, Hi = 0.f;
#pragma unroll 1
        for (int s = 0; s < 16; ++s) { Hin[(s * 64 + lane) * 2] = Hr; Hin[(s * 64 + lane) * 2 + 1] = Hi;
            const float er = Eseg[(s * 64 + lane) * 2], ei = Eseg[(s * 64 + lane) * 2 + 1]; const float nr = xr * Hr - xi * Hi + er, ni = xr * Hi + xi * Hr + ei; Hr = nr; Hi = ni; }
    }
    __syncthreads();
#pragma unroll
    for (int nt = 0; nt < 2; ++nt) { hr[nt] = Hin[((2 * w + hh) * 64 + 32 * nt + p) * 2]; hi[nt] = Hin[((2 * w + hh) * 64 + 32 * nt + p) * 2 + 1]; }
    bf16x8 ck[4];
#pragma unroll
    for (int ks = 0; ks < 4; ++ks) ck[ks] = *(const bf16x8*)(P_S5CK + (size_t)(g * 16 + l15) * 128 + 32 * ks + 8 * l4);
    const int er = lane >> 1, eh = lane & 1;
    float* Ys = (float*)(F.lds + 86016) + w * 640;
    f32x4 dk0 = *(const f32x4*)(A.in[I_S5D] + g * 16 + 8 * eh), dk1 = *(const f32x4*)(A.in[I_S5D] + g * 16 + 8 * eh + 4);
#define S5_EROW(blk_) ((size_t)(b * SEQ + 128 * (2 * w + (er >> 4)) + 16 * (blk_) + (er & 15)))
    bf16x8 a0 = S5_ALOAD(0), a1 = S5_ALOAD(1), a2 = S5_ALOAD(2);
    u32x4 un = *(const u32x4*)(P_Z + S5_EROW(0) * ZP0 + g * 16 + 8 * eh);
#pragma unroll 1
    for (int blk = 0; blk < 8; ++blk) {
        const bf16x8 a = a0; a0 = a1; a1 = a2; if (blk + 3 < 8) a2 = S5_ALOAD(blk + 3);
        const u32x4 us = un; if (blk + 1 < 8) un = *(const u32x4*)(P_Z + S5_EROW(blk + 1) * ZP0 + g * 16 + 8 * eh);
#pragma unroll
        for (int nt = 0; nt < 2; ++nt) {
            const f32x16 dre = __builtin_amdgcn_mfma_f32_32x32x16_bf16(a, bbr[nt], zero16, 0, 0, 0), dim = __builtin_amdgcn_mfma_f32_32x32x16_bf16(a, bbi[nt], zero16, 0, 0, 0);
#pragma unroll
            for (int i = 0; i < 16; ++i) { const float nr = are[nt] * hr[nt] - aim[nt] * hi[nt] + dre[i], ni = are[nt] * hi[nt] + aim[nt] * hr[nt] + dim[i]; hr[nt] = nr; hi[nt] = ni;
                *(unsigned*)(Hs + (hh * 16 + i) * 136 + 2 * (32 * nt + p)) = pk2(nr, ni); }
        }
        LDS_WAIT();
#pragma unroll
        for (int sg = 0; sg < 2; ++sg) {
            f32x4 y = {0.f, 0.f, 0.f, 0.f};
#pragma unroll
            for (int ks = 0; ks < 4; ++ks) { const bf16x8 af = *(const bf16x8*)(Hs + (sg * 16 + l15) * 136 + 32 * ks + 8 * l4); y = __builtin_amdgcn_mfma_f32_16x16x32_bf16(af, ck[ks], y, 0, 0, 0); }
#pragma unroll
            for (int q = 0; q < 4; ++q) Ys[(sg * 16 + 4 * l4 + q) * 20 + l15] = y[q];
        }
        LDS_WAIT();
        { const f32x4 y0 = *(const f32x4*)(Ys + er * 20 + 8 * eh), y1 = *(const f32x4*)(Ys + er * 20 + 8 * eh + 4);
          float o[8]; o[0] = y0.x + dk0.x * bflo(us.x); o[1] = y0.y + dk0.y * bfhi(us.x); o[2] = y0.z + dk0.z * bflo(us.y); o[3] = y0.w + dk0.w * bfhi(us.y);
          o[4] = y1.x + dk1.x * bflo(us.z); o[5] = y1.y + dk1.y * bfhi(us.z); o[6] = y1.z + dk1.z * bflo(us.w); o[7] = y1.w + dk1.w * bfhi(us.w);
          u32x4 ov; ov.x = pk2(gelu_tanh(o[0]), gelu_tanh(o[1])); ov.y = pk2(gelu_tanh(o[2]), gelu_tanh(o[3])); ov.z = pk2(gelu_tanh(o[4]), gelu_tanh(o[5])); ov.w = pk2(gelu_tanh(o[6]), gelu_tanh(o[7]));
          *(u32x4*)(P_G5 + S5_EROW(blk) * 512 + g * 16 + 8 * eh) = ov; }
        LDS_WAIT();
    }
#undef S5_ALOAD
#undef S5_EROW
}
namespace lin {
typedef const LAS char* lptr;
typedef short s16x4 __attribute__((ext_vector_type(4)));
typedef short v4i16_t __attribute__((ext_vector_type(4)));
__device__ __forceinline__ s16x4 vtr(lptr p) { return __builtin_bit_cast(s16x4, __builtin_amdgcn_ds_read_tr16_b64_v4i16((LAS v4i16_t*)p)); }
__device__ __forceinline__ bf16x8 tr_frag(lptr sub, int ks, int lane) {
    const lptr p = sub + ((lane >> 4) & 1) * 32 + (lane & 3) * 8 + (4 * (lane >> 5) + ((lane & 15) >> 2)) * 64 + ks * 1024;
    const s16x4 lo = vtr(p), hi = vtr(p + 512);
    return (bf16x8){lo[0], lo[1], lo[2], lo[3], hi[0], hi[1], hi[2], hi[3]};
}
__device__ __forceinline__ bf16x8 nat_frag(lptr base, int ldb, int row0, int k0, int lane) { return *(const LAS bf16x8*)(base + (row0 + (lane & 31)) * ldb + (k0 + 8 * (lane >> 5)) * 2); }
__device__ __forceinline__ int crow(int r, int hh) { return (r & 3) + 8 * (r >> 2) + 4 * hh; }
__device__ __forceinline__ void unpack8(const u32x4& w, float (&f)[8]) { f[0] = bflo(w.x); f[1] = bfhi(w.x); f[2] = bflo(w.y); f[3] = bfhi(w.y); f[4] = bflo(w.z); f[5] = bfhi(w.z); f[6] = bflo(w.w); f[7] = bfhi(w.w); }
__device__ __forceinline__ u32x4 repack8(const float (&f)[8]) { u32x4 w; w.x = pk2(f[0], f[1]); w.y = pk2(f[2], f[3]); w.z = pk2(f[4], f[5]); w.w = pk2(f[6], f[7]); return w; }

__device__ __forceinline__ void gla_prefix(CArgs& A, const Frame& F, int item) {
    const int b = item >> 5, c = item & 31, half = F.tid >> 8, col = F.tid & 255;
    float* p = P_LOGA + (size_t)(b * SEQ + c * 64 + 32 * half) * 256 + col; float* tot = (float*)F.lds;
    float v[32];
#pragma unroll
    for (int i = 0; i < 32; ++i) v[i] = p[(size_t)i * 256];
#pragma unroll
    for (int i = 1; i < 32; ++i) v[i] += v[i - 1];
    if (half == 0) tot[col] = v[31];
    __syncthreads();
    const float off = half ? tot[col] : 0.f;
#pragma unroll
    for (int i = 0; i < 32; ++i) p[(size_t)i * 256] = v[i] + off;
    __syncthreads();
}
template <int KIND> __device__ __forceinline__ void r1_item(CArgs& A, const Frame& F, int bh, int vs) {
    constexpr int DK = KIND ? 64 : 128, ND = DK / 32;
    constexpr int KCOL = KIND ? 2304 : 512, VCOL = KIND ? 2560 : 1024;
    const int b = bh >> 2, h = bh & 3, tid = F.tid, lane = F.lane, w = F.wave, hh = lane >> 5;
    unsigned char* bufV = F.lds; unsigned char* bufK = F.lds + 4096;
    bf16_t* ST = (KIND ? P_GST : P_RST) + (size_t)bh * 32 * 128 * DK;
    const float log2g = KIND ? 0.f : log2f(1.f - exp2f(-5.f - (float)h));
    const float g64 = exp2f(64.f * log2g);
    f32x16 acc = {0.f, 0.f, 0.f, 0.f, 0.f, 0.f, 0.f, 0.f, 0.f, 0.f, 0.f, 0.f, 0.f, 0.f, 0.f, 0.f};
    const bf16_t* zb = P_Z + (size_t)(b * SEQ) * ZP1;
    const int vj = tid >> 2, vc = tid & 3;
    const int kj0 = KIND ? (tid >> 3) : (tid >> 4), kd0 = KIND ? (tid & 7) : (tid & 15);
#define R1_DECL(S) u32x4 rv##S = {0u, 0u, 0u, 0u}, rk0##S = {0u, 0u, 0u, 0u}, rk1##S = {0u, 0u, 0u, 0u}; f32x4 bj0##S = {0.f, 0.f, 0.f, 0.f}, bj1##S = bj0##S, bl0##S = bj0##S, bl1##S = bj0##S; float bd##S = 0.f;
#define R1_LOAD(S, c) do { const bf16_t* zc = zb + (size_t)((c) * 64) * ZP1; \
        if (tid < 256) rv##S = *(const u32x4*)(zc + (size_t)vj * ZP1 + VCOL + h * 128 + vs * 32 + vc * 8); \
        rk0##S = *(const u32x4*)(zc + (size_t)kj0 * ZP1 + KCOL + h * DK + kd0 * 8); \
        if (!KIND) rk1##S = *(const u32x4*)(zc + (size_t)(kj0 + 32) * ZP1 + KCOL + h * DK + kd0 * 8); \
        if (KIND) { const float* bp = P_LOGA + (size_t)(b * SEQ + (c) * 64) * 256 + h * 64; \
            bj0##S = *(const f32x4*)(bp + (size_t)kj0 * 256 + kd0 * 8); bj1##S = *(const f32x4*)(bp + (size_t)kj0 * 256 + kd0 * 8 + 4); \
            bl0##S = *(const f32x4*)(bp + 63 * 256 + kd0 * 8); bl1##S = *(const f32x4*)(bp + 63 * 256 + kd0 * 8 + 4); \
            if (w < ND) bd##S = bp[63 * 256 + 32 * w + (lane & 31)]; } } while (0)
#define R1_STEP(S, c) do { \
        if (tid < 256) { u32x4 o = rv##S; \
            if (!KIND) { float f[8]; unpack8(rv##S, f); const float z = exp2f((float)(63 - vj) * log2g); _Pragma("unroll") for (int e = 0; e < 8; ++e) f[e] *= z; o = repack8(f); } \
            *(u32x4*)(bufV + vj * 64 + vc * 16) = o; } \
        if (KIND) { float f[8]; unpack8(rk0##S, f); \
            f[0] *= __expf(bl0##S.x - bj0##S.x); f[1] *= __expf(bl0##S.y - bj0##S.y); f[2] *= __expf(bl0##S.z - bj0##S.z); f[3] *= __expf(bl0##S.w - bj0##S.w); \
            f[4] *= __expf(bl1##S.x - bj1##S.x); f[5] *= __expf(bl1##S.y - bj1##S.y); f[6] *= __expf(bl1##S.z - bj1##S.z); f[7] *= __expf(bl1##S.w - bj1##S.w); \
            *(u32x4*)(bufK + (kd0 >> 2) * 4096 + kj0 * 64 + (kd0 & 3) * 16) = repack8(f); \
        } else { \
            *(u32x4*)(bufK + (kd0 >> 2) * 4096 + kj0 * 64 + (kd0 & 3) * 16) = rk0##S; \
            *(u32x4*)(bufK + (kd0 >> 2) * 4096 + (kj0 + 32) * 64 + (kd0 & 3) * 16) = rk1##S; } \
        __syncthreads(); \
        const float decn = KIND ? __expf(bd##S) : 0.f; \
        if ((c) + 4 < 32) R1_LOAD(S, (c) + 4); \
        if (w < ND) { \
            bf16_t* sp = ST + ((size_t)(c) * 128 + vs * 32) * DK + 32 * w + (lane & 31); \
            const float dec = KIND ? decn : g64; \
            _Pragma("unroll") for (int r = 0; r < 16; ++r) { sp[(size_t)crow(r, hh) * DK] = (bf16_t)f2bf(acc[r]); acc[r] *= dec; } \
            _Pragma("unroll") for (int ks = 0; ks < 4; ++ks) acc = __builtin_amdgcn_mfma_f32_32x32x16_bf16(tr_frag((lptr)(LAS unsigned char*)bufV, ks, lane), tr_frag((lptr)(LAS unsigned char*)bufK + w * 4096, ks, lane), acc, 0, 0, 0); \
        } \
        __syncthreads(); } while (0)
    R1_DECL(0) R1_DECL(1) R1_DECL(2) R1_DECL(3)
    R1_LOAD(0, 0); R1_LOAD(1, 1); R1_LOAD(2, 2); R1_LOAD(3, 3);
#pragma unroll 1
    for (int c = 0; c < 32; c += 4) { R1_STEP(0, c); R1_STEP(1, c + 1); R1_STEP(2, c + 2); R1_STEP(3, c + 3); }
#undef R1_DECL
#undef R1_LOAD
#undef R1_STEP
}
__device__ __forceinline__ void p_lin_r1(CArgs& A, const Frame& F) {
    const int v = F.bid, r = v & 127;
    if (v < 128) r1_item<0>(A, F, r >> 2, r & 3); else r1_item<1>(A, F, r >> 2, r & 3);
}

template <int KIND> struct R2Regs {
    static constexpr int DK = KIND ? 64 : 128, NQP = 64 * DK / 8 / 512, NSP = 128 * DK / 8 / 512;
    u32x4 q[NQP], k[NQP], v[2], s[NSP], g[2]; f32x4 bq[NQP][2];
};
template <int KIND> __device__ __forceinline__ void r2_load(CArgs& A, const Frame& F, R2Regs<KIND>& R, int bh, int c) {
    constexpr int DK = KIND ? 64 : 128;
    constexpr int QCOL = KIND ? 2048 : 0, KCOL = KIND ? 2304 : 512, VCOL = KIND ? 2560 : 1024, GCOL = KIND ? 3072 : 1536;
    const int b = bh >> 2, h = bh & 3, tid = F.tid, lane = F.lane, w = F.wave, hh = lane >> 5, l31 = lane & 31, rb = w >> 2, cb = w & 3;
    const bf16_t* zc = P_Z + (size_t)(b * SEQ + c * 64) * ZP1;
    const bf16_t* ST = (KIND ? P_GST : P_RST) + ((size_t)bh * 32 + c) * 128 * DK;
#pragma unroll
    for (int r = 0; r < R2Regs<KIND>::NQP; ++r) { const int q = tid + 512 * r, i = q / (DK / 8), d8 = q % (DK / 8);
        R.q[r] = *(const u32x4*)(zc + (size_t)i * ZP1 + QCOL + h * DK + d8 * 8); R.k[r] = *(const u32x4*)(zc + (size_t)i * ZP1 + KCOL + h * DK + d8 * 8);
        if (KIND) { const float* bp = P_LOGA + (size_t)(b * SEQ + c * 64 + i) * 256 + h * 64 + d8 * 8; R.bq[r][0] = *(const f32x4*)bp; R.bq[r][1] = *(const f32x4*)(bp + 4); } }
#pragma unroll
    for (int r = 0; r < 2; ++r) { const int q = tid + 512 * r, j = q >> 4, v8 = q & 15; R.v[r] = *(const u32x4*)(zc + (size_t)j * ZP1 + VCOL + h * 128 + v8 * 8); }
#pragma unroll
    for (int r = 0; r < R2Regs<KIND>::NSP; ++r) { const int q = tid + 512 * r, vr = q / (DK / 8), d8 = q % (DK / 8); R.s[r] = *(const u32x4*)(ST + (size_t)vr * DK + d8 * 8); }
#pragma unroll
    for (int k2 = 0; k2 < 2; ++k2) { const int pp = lane + 64 * k2; R.g[k2] = *(const u32x4*)(zc + (size_t)(32 * rb + (pp >> 2)) * ZP1 + GCOL + h * 128 + 32 * cb + 8 * (pp & 3)); }
}
template <int KIND> struct R2Lds { static constexpr int DK = KIND ? 64 : 128, LDQ = (DK + 8) * 2, OFF_K = 64 * LDQ, OFF_V = 2 * 64 * LDQ, OFF_S = OFF_V + 16384, OFF_SSQ = OFF_S + 128 * LDQ, OFF_BC = OFF_SSQ + 1024; };
template <int KIND> __device__ __forceinline__ void r2_stage(const Frame& F, const R2Regs<KIND>& R, u32x4 (&gc)[2]) {
    typedef R2Lds<KIND> LL; constexpr int DK = LL::DK, LDQ = LL::LDQ;
    const int tid = F.tid; unsigned char* L = F.lds;
#pragma unroll
    for (int r = 0; r < R2Regs<KIND>::NQP; ++r) { const int q = tid + 512 * r, i = q / (DK / 8), d8 = q % (DK / 8);
        u32x4 qw = R.q[r], kw = R.k[r];
        if (KIND) { float fq[8], fk[8]; unpack8(qw, fq); unpack8(kw, fk);
#pragma unroll
            for (int e = 0; e < 8; ++e) { const float bb = R.bq[r][e >> 2][e & 3]; fq[e] *= __expf(bb); fk[e] *= __expf(-bb); }
            qw = repack8(fq); kw = repack8(fk); }
        *(u32x4*)(L + i * LDQ + d8 * 16) = qw; *(u32x4*)(L + LL::OFF_K + i * LDQ + d8 * 16) = kw; }
#pragma unroll
    for (int r = 0; r < 2; ++r) { const int q = tid + 512 * r, j = q >> 4, v8 = q & 15; *(u32x4*)(L + LL::OFF_V + (v8 >> 2) * 4096 + j * 64 + (v8 & 3) * 16) = R.v[r]; }
#pragma unroll
    for (int r = 0; r < R2Regs<KIND>::NSP; ++r) { const int q = tid + 512 * r, vr = q / (DK / 8), d8 = q % (DK / 8); *(u32x4*)(L + LL::OFF_S + vr * LDQ + d8 * 16) = R.s[r]; }
    gc[0] = R.g[0]; gc[1] = R.g[1];
    __syncthreads();
}
template <int KIND> __device__ __forceinline__ void r2_compute(CArgs& A, const Frame& F, int bh, int c, const u32x4 (&gc)[2]) {
    typedef R2Lds<KIND> LL; constexpr int DK = LL::DK, LDQ = LL::LDQ, OFF_K = LL::OFF_K, OFF_V = LL::OFF_V, OFF_S = LL::OFF_S;
    constexpr int OCOL = KIND ? 512 : 0;
    const int b = bh >> 2, h = bh & 3, lane = F.lane, w = F.wave, hh = lane >> 5, l31 = lane & 31, rb = w >> 2, cb = w & 3;
    unsigned char* L = F.lds; float* ssq = (float*)(L + LL::OFF_SSQ);
    const float log2g = KIND ? 0.f : log2f(1.f - exp2f(-5.f - (float)h));
    const lptr L3 = (lptr)(LAS unsigned char*)L;
    bf16x8 pa[2][2];
#pragma unroll
    for (int jt = 0; jt < 2; ++jt) {
        f32x16 p = {0.f, 0.f, 0.f, 0.f, 0.f, 0.f, 0.f, 0.f, 0.f, 0.f, 0.f, 0.f, 0.f, 0.f, 0.f, 0.f};
        if (jt <= rb) {
#pragma unroll
            for (int ks = 0; ks < DK / 16; ++ks) p = __builtin_amdgcn_mfma_f32_32x32x16_bf16(nat_frag(L3 + OFF_K, LDQ, 32 * jt, 16 * ks, lane), nat_frag(L3, LDQ, 32 * rb, 16 * ks, lane), p, 0, 0, 0);
        }
        const int i = 32 * rb + l31;
        float f[16];
#pragma unroll
        for (int r = 0; r < 16; ++r) { const int j = 32 * jt + crow(r, hh); float x = (i >= j) ? p[r] : 0.f; if (!KIND) x *= exp2f((float)(i - j) * log2g); f[r] = (i >= j) ? x : 0.f; }
#pragma unroll
        for (int s = 0; s < 2; ++s) { u32x4 wv; wv.x = pk2(f[8 * s], f[8 * s + 1]); wv.y = pk2(f[8 * s + 2], f[8 * s + 3]); wv.z = pk2(f[8 * s + 4], f[8 * s + 5]); wv.w = pk2(f[8 * s + 6], f[8 * s + 7]); pa[jt][s] = __builtin_bit_cast(bf16x8, wv); }
    }
    f32x16 o1 = {0.f, 0.f, 0.f, 0.f, 0.f, 0.f, 0.f, 0.f, 0.f, 0.f, 0.f, 0.f, 0.f, 0.f, 0.f, 0.f}, o2 = o1;
#pragma unroll
    for (int jt = 0; jt < 2; ++jt)
#pragma unroll
        for (int s = 0; s < 2; ++s) o1 = __builtin_amdgcn_mfma_f32_32x32x16_bf16(pa[jt][s], tr_frag(L3 + OFF_V + cb * 4096, 2 * jt + s, lane), o1, 0, 0, 0);
#pragma unroll
    for (int ks = 0; ks < DK / 16; ++ks) o2 = __builtin_amdgcn_mfma_f32_32x32x16_bf16(nat_frag(L3, LDQ, 32 * rb, 16 * ks, lane), nat_frag(L3 + OFF_S, LDQ, 32 * cb, 16 * ks, lane), o2, 0, 0, 0);
    float o[16];
#pragma unroll
    for (int r = 0; r < 16; ++r) { const int i = 32 * rb + crow(r, hh); const float xi = KIND ? 1.f : exp2f((float)(i + 1) * log2g); o[r] = o1[r] + xi * o2[r];
        const float sq = half_sum(o[r] * o[r]); if (l31 == 0) ssq[i * 4 + cb] = sq; }
    __syncthreads();
    float* Os = (float*)L + w * (32 * 33);
#pragma unroll
    for (int r = 0; r < 16; ++r) Os[crow(r, hh) * 33 + l31] = o[r];
    LDS_WAIT();
#pragma unroll
    for (int k2 = 0; k2 < 2; ++k2) { const int pp = lane + 64 * k2, rw = pp >> 2, ch = pp & 3, i = 32 * rb + rw;
        const f32x4 s4 = *(const f32x4*)(ssq + i * 4);
        const float rn = rsqrtf(((s4.x + s4.y) + (s4.z + s4.w)) * (1.f / 128.f) + EPS);
        float gv[8]; unpack8(gc[k2], gv); float y[8];
#pragma unroll
        for (int e = 0; e < 8; ++e) y[e] = siluf_(gv[e]) * Os[rw * 33 + 8 * ch + e] * rn;
        *(u32x4*)(P_YCAT + (size_t)(b * SEQ + c * 64 + i) * DM + OCOL + h * 128 + 32 * cb + 8 * ch) = repack8(y); }
    __syncthreads();
}
template <int KIND> __device__ __forceinline__ void r2_run(CArgs& A, const Frame& F0, int first, int n, int stride) {
    R2Regs<KIND> R; u32x4 gc[2];
    { Frame G2 = F0; int t_ = F0.tid; asm volatile("" : "+v"(t_)); G2.tid = t_; G2.lane = t_ & 63; r2_load<KIND>(A, G2, R, (first & 1023) >> 5, first & 31); }
#pragma unroll 1
    for (int i = 0; i < n; ++i) {
        Frame G2 = F0; { int t_ = F0.tid; asm volatile("" : "+v"(t_)); G2.tid = t_; G2.lane = t_ & 63; }
        const int r = (first + i * stride) & 1023;
        r2_stage<KIND>(G2, R, gc);
        if (i + 1 < n) { const int rn = (first + (i + 1) * stride) & 1023; r2_load<KIND>(A, G2, R, rn >> 5, rn & 31); }
        r2_compute<KIND>(A, G2, r >> 5, r & 31, gc);
    }
}
__device__ __forceinline__ void p_lin_r2(CArgs& A, const Frame& F) {
    r2_run<0>(A, F, F.bid, 4, F.G);
    r2_run<1>(A, F, 1024 + F.bid, 4, F.G);
}
}
#define XB_TMO      128
#define XB_XCNT(j)  (256  + 64 * (j))
#define XB_XSUB(j)  (1280 + 64 * (j))
#define XB_XGEN(j)  (2304 + 64 * (j))
#define XB_TOP      3328
#define XB_TOPGEN   3392
#define XCD_BAR_WORDS 3456
#define XB_SPIN_CAP (1u << 18)
__device__ __forceinline__ unsigned xb_ld(unsigned* p)              { return __hip_atomic_load(p, __ATOMIC_RELAXED, __HIP_MEMORY_SCOPE_AGENT); }
__device__ __forceinline__ unsigned xb_add(unsigned* p, unsigned v) { return __hip_atomic_fetch_add(p, v, __ATOMIC_RELAXED, __HIP_MEMORY_SCOPE_AGENT); }
__device__ __forceinline__ unsigned xb_xcc_id() { return (unsigned)__builtin_amdgcn_s_getreg((3 << 11) | 20) & 0xFu; }
#define XB_SPIN(cond, bar) do { unsigned _sp = 0; while (cond) { __builtin_amdgcn_s_sleep(1); \
    if ((++_sp & 255u) == 0u) { if (xb_ld(&(bar)[XB_TMO])) break; if (_sp > XB_SPIN_CAP) { atomicAdd(&(bar)[XB_TMO], 1u); break; } } } } while (0)
struct XcdBarrier { unsigned* bar; unsigned x; volatile LAS unsigned* st; };
__device__ __forceinline__ XcdBarrier xcd_barrier_post(unsigned* bar, volatile LAS unsigned* st, int tid) {
    XcdBarrier b; b.bar = bar; b.x = xb_xcc_id(); b.st = st;
    if (tid == 0) (void)xb_add(&bar[XB_XCNT(b.x)], 1u);
    return b;
}
__device__ __forceinline__ void xcd_barrier_complete(unsigned* bar, unsigned x, unsigned& nloc, unsigned& nx) {
    const unsigned G = gridDim.x * gridDim.y * gridDim.z;
    unsigned sum, cnt, mine, sp = 0u;
    for (;;) {
        sum = 0u; cnt = 0u; mine = 0u;
#pragma unroll
        for (unsigned j = 0; j < 16; ++j) { const unsigned c = xb_ld(&bar[XB_XCNT(j)]); sum += c; cnt += (c > 0u) ? 1u : 0u; mine = (j == x) ? c : mine; }
        if (sum == G) break;
        __builtin_amdgcn_s_sleep(1);
        if ((++sp & 255u) == 0u) { if (xb_ld(&bar[XB_TMO])) break; if (sp > XB_SPIN_CAP) { atomicAdd(&bar[XB_TMO], 1u); break; } }
    }
    nloc = mine > 0u ? mine : 1u; nx = cnt > 0u ? cnt : 1u;
}
__device__ __forceinline__ void xcd_barrier(const XcdBarrier& b, int tid) {
    asm volatile("s_waitcnt vmcnt(0)" ::: "memory");
    __syncthreads();
    if (tid == 0) {
        unsigned* bar = b.bar;
        __builtin_amdgcn_s_waitcnt(0);
        unsigned nloc = b.st[0], nx = b.st[1];
        if (nloc == 0u) { xcd_barrier_complete(bar, b.x, nloc, nx); b.st[0] = nloc; b.st[1] = nx; }
        const unsigned old = xb_add(&bar[XB_XSUB(b.x)], 1u);
        const unsigned gen = old / nloc;
        if (old + 1u == (gen + 1u) * nloc) {
            __builtin_amdgcn_fence(__ATOMIC_RELEASE, "agent");
            asm volatile("s_waitcnt vmcnt(0)" ::: "memory");
            const unsigned og = xb_add(&bar[XB_TOP], 1u);
            const unsigned tg = og / nx;
            if (og + 1u == (tg + 1u) * nx) xb_add(&bar[XB_TOPGEN], 1u);
            else XB_SPIN(xb_ld(&bar[XB_TOPGEN]) == tg, bar);
            __builtin_amdgcn_fence(__ATOMIC_ACQUIRE, "agent");
            xb_add(&bar[XB_XGEN(b.x)], 1u);
            asm volatile("s_waitcnt vmcnt(0)" ::: "memory");
        } else {
            XB_SPIN(xb_ld(&bar[XB_XGEN(b.x)]) == gen, bar);
            __builtin_amdgcn_fence(__ATOMIC_ACQUIRE, "agent");
            asm volatile("s_waitcnt vmcnt(0)" ::: "memory");
        }
    }
    __syncthreads();
}
#define REFRESH() do { int t_ = F.wave * 64 + lane_id(); asm volatile("" : "+v"(t_)); F.tid = t_; F.lane = t_ & 63; asm volatile("" : "+s"(ap)); int b_ = blockIdx.x; asm volatile("" : "+s"(b_)); F.bid = b_; } while (0)
#define A (*ap)
#define GSYNC() do { REFRESH(); xcd_barrier(xb, F.tid); } while (0)
template <int l> __device__ __forceinline__ void layer_fwd(CArgs*& ap, Frame& F, const XcdBarrier& xb, unsigned char* lds, LAS unsigned char* lds3, LAS pg8::MoeTables* tb) {
    if (l == 0) {
        { REFRESH(); pg8::DenseOrder S; S.init(P_HB, P_WINE, NTOK, 2048, 1024, F.G, F.bid); pg8::EpiZ0 E{P_Z};
          pg8::gemm_phase<pg8::EpiZ0, pg8::DenseOrder, true>(lds3, F.wave, 1024, S, E); }
        GSYNC();
        REFRESH(); fox_fast(A, F);
        __syncthreads();
        REFRESH(); s5_fast(A, F, F.bid);
        GSYNC();
        { REFRESH(); pg8::DenseOrder S; S.init(P_G5, P_WGLU, NTOK, 512, 512, F.G, F.bid); pg8::EpiGlu E{P_G5, A.in[I_GLUB], P_YCAT};
          pg8::gemm_phase<pg8::EpiGlu, pg8::DenseOrder, true>(lds3, F.wave, 512, S, E); }
        GSYNC();
    } else {
        REFRESH(); lin::gla_prefix(A, F, F.bid);
        { REFRESH(); pg8::DenseOrder S; S.init(P_HB, P_WINO, NTOK, 3584, 512, F.G, F.bid); pg8::EpiZ1 E{P_Z, P_ROPE};
          pg8::gemm_phase<pg8::EpiZ1, pg8::DenseOrder, true, true>(lds3, F.wave, 512, S, E); }
        GSYNC();
        REFRESH(); lin::p_lin_r1(A, F);
        GSYNC();
        REFRESH(); lin::p_lin_r2(A, F);
        GSYNC();
    }
    { REFRESH(); pg8::DenseOrder S; S.init(P_YCAT, l == 0 ? P_WOUTE : P_WOUTO, NTOK, 1024, 1024, F.G, F.bid); pg8::EpiBf16Plain E{(bf16_t*)P_MBUF, DM};
      pg8::gemm_phase<pg8::EpiBf16Plain, pg8::DenseOrder, true>(lds3, F.wave, 1024, S, E); }
    GSYNC();
    REFRESH(); p_postmix(A, F, l);
    GSYNC();
    REFRESH(); const int MT = moe_tables(A, F, l, tb);
    {
        const int mX = (MT >> 5) << 5, kk = MT - mX, rr = (64 - ((2 * kk) & 63)) & 63;
        const int mY = mX >= rr ? rr + (((mX - rr) >> 6) << 6) : 0;
        if (mX > 0) {
            { REFRESH(); pg8::MoeOrder<true> S; S.Ap = (const char*)P_HB8; S.Bt = (const char*)(P_W1 + (size_t)l * 32 * 2048 * 1024); S.estride = (size_t)2048 * 1024; S.K = 512; S.NP = 8; S.nwg = mX * 8; S.G = F.G; S.c = F.bid; S.mt0 = 0;
              S.list_tk = P_LTK + (size_t)l * 32 * LISTCAP; S.tb = tb;
              pg8::EpiSwiglu E{P_ACT, A.in[I_BGU] + (size_t)l * 32 * 2048};
              pg8::gemm_phase<pg8::EpiSwiglu, pg8::MoeOrder<true>, true, true>(lds3, F.wave, 512, S, E); }
            GSYNC();
        }
        if (8 * (MT - mX) + 4 * mY > 0) {
            { REFRESH(); pg8::MoeMixOrder S; S.ws = (const char*)A.ws; S.l = l;
              S.a0 = mX; S.nA = 8 * (MT - mX); S.b0 = 0; S.nB = 4 * mY; S.nwg = S.nA + S.nB; S.G = F.G; S.c = F.bid; S.tb = tb;
              pg8::EpiMoeMix E{ap, l};
              pg8::gemm_phase<pg8::EpiMoeMix, pg8::MoeMixOrder, true, true>(lds3, F.wave, 512, S, E); }
            GSYNC();
        }
        if (MT > mY) {
            { REFRESH(); pg8::MoeOrder<false> S; S.Ap = (const char*)P_ACT; S.Bt = (const char*)(P_W2 + (size_t)l * 32 * 1024 * 1024); S.estride = (size_t)1024 * 1024; S.K = 512; S.NP = 4; S.nwg = (MT - mY) * 4; S.G = F.G; S.c = F.bid; S.mt0 = mY;
              S.list_tk = P_LTK + (size_t)l * 32 * LISTCAP; S.tb = tb;
              pg8::EpiDown E{P_Y, A.in[I_BDN] + (size_t)l * 32 * 1024, P_LTK + (size_t)l * 32 * LISTCAP, P_LG + (size_t)l * 32 * LISTCAP};
              pg8::gemm_phase<pg8::EpiDown, pg8::MoeOrder<false>, true, true>(lds3, F.wave, 512, S, E); }
            GSYNC();
        }
    }
    REFRESH(); p_combine(A, F, l);
}

__global__ void __launch_bounds__(512, 2) mk_fwd(Args A_) {
    extern __shared__ __attribute__((aligned(16))) unsigned char lds[];
    cg::grid_group grid = cg::this_grid();
    CArgs* ap = (CArgs*)__builtin_amdgcn_kernarg_segment_ptr();
    Frame F;
    F.lds = lds; F.wave = __builtin_amdgcn_readfirstlane((int)threadIdx.x >> 6); F.tid = 0; F.lane = 0; F.bid = blockIdx.x; F.G = gridDim.x;
    LAS unsigned char* lds3 = (LAS unsigned char*)lds;
    LAS pg8::MoeTables* tb = (LAS pg8::MoeTables*)(lds3 + 133632);
    { volatile LAS unsigned* st = (volatile LAS unsigned*)(lds3 + (LDS_BYTES - 64)); REFRESH(); if (F.tid < 2) st[F.tid] = 0u; __syncthreads(); }
    XcdBarrier xb = xcd_barrier_post((unsigned*)(A.ws + WS_CTL) + 10240, (volatile LAS unsigned*)(lds3 + (LDS_BYTES - 64)), F.tid);
    REFRESH(); p0_tables(A, F);
    if (A.pad != 0) grid.sync();
    GSYNC();
    REFRESH(); p0_tiles(A, F, 0, 12);
    __syncthreads(); REFRESH(); p1_hprep0(A, F);
    __syncthreads(); REFRESH(); p0_tiles(A, F, 12, 26);
    GSYNC();
    layer_fwd<0>(ap, F, xb, lds, lds3, tb);
    GSYNC();
    layer_fwd<1>(ap, F, xb, lds, lds3, tb);
}
#undef A

extern "C" void kernel_launch(void* const* d_in, const int* in_sizes, int n_in, void* d_out, int out_size, void* d_ws, size_t ws_size, hipStream_t stream) {
    static int grid = 0;
    if (grid == 0) {
        if (n_in != 31 || out_size != NTOK * DM || ws_size < WS_END) { fprintf(stderr, "kernel_launch: unexpected problem (n_in %d out %d ws %zu)\n", n_in, out_size, ws_size); grid = -1; return; }
        int dev = 0, cus = 0, per_cu = 0;
        if (hipGetDevice(&dev) != hipSuccess || hipDeviceGetAttribute(&cus, hipDeviceAttributeMultiprocessorCount, dev) != hipSuccess) { grid = -1; return; }
        if (hipFuncSetAttribute((const void*)mk_fwd, hipFuncAttributeMaxDynamicSharedMemorySize, LDS_BYTES) != hipSuccess) { fprintf(stderr, "kernel_launch: hipFuncSetAttribute failed\n"); grid = -1; return; }
        if (hipOccupancyMaxActiveBlocksPerMultiprocessor(&per_cu, (const void*)mk_fwd, 512, LDS_BYTES) != hipSuccess || per_cu < 1) { fprintf(stderr, "kernel_launch: occupancy query says %d blocks per CU\n", per_cu); (void)hipGetLastError(); }
        grid = cus;
        if (grid != 256) fprintf(stderr, "kernel_launch: %d CUs; this kernel is built for a 256-CU grid\n", grid);
    }
    if (grid < 0) return;
    if (hipMemsetAsync((char*)d_ws + WS_CTL, 0, CTL_ZERO_BYTES, stream) != hipSuccess) { fprintf(stderr, "kernel_launch: memset failed\n"); return; }
    Args a{};
    for (int i = 0; i < 31; ++i) a.in[i] = (const float*)d_in[i];
    a.out = (float*)d_out; a.ws = (unsigned char*)d_ws;
    void* kargs[] = {&a};
    const hipError_t e = hipLaunchCooperativeKernel((const void*)mk_fwd, dim3(grid), dim3(512), kargs, LDS_BYTES, stream);
    if (e != hipSuccess) fprintf(stderr, "kernel_launch: cooperative launch failed: %s (grid %d)\n", hipGetErrorString(e), grid);
}
```

```cpp
#include <hip/hip_runtime.h>
#include <hip/hip_cooperative_groups.h>
#include <cstdio>
#include <cstdint>
namespace cg = cooperative_groups;

#define LAS __attribute__((address_space(3)))
typedef unsigned short bf16_t;
typedef short bf16x8 __attribute__((ext_vector_type(8)));
typedef float f32x4 __attribute__((ext_vector_type(4)));
typedef float f32x2 __attribute__((ext_vector_type(2)));
typedef unsigned u32x4 __attribute__((ext_vector_type(4)));
typedef unsigned u32x2 __attribute__((ext_vector_type(2)));
typedef int i32x4 __attribute__((ext_vector_type(4)));
typedef int i32x8 __attribute__((ext_vector_type(8)));

constexpr int NTOK = 16384, DM = 1024, SEQ = 2048, NB = 8;
constexpr int NEXP = 32, LISTCAP = 16384;
constexpr float EPS = 1e-6f;
constexpr float LOG2E = 1.4426950408889634f;
constexpr float C2 = 0.125f * LOG2E;
constexpr int ZP0 = 2048, ZP1 = 3584;

constexpr size_t MiB = 1u << 20;
constexpr size_t WS_CTL = 0, CTL_ZERO_BYTES = 65536;
constexpr size_t WS_MOD = 1 * MiB;
constexpr size_t WS_WSIDE = 1 * MiB + 512 * 1024;
constexpr size_t WS_S5A = 2 * MiB;
constexpr size_t WS_S5BB = 2 * MiB + 65536;
constexpr size_t WS_S5CK = 2 * MiB + 512 * 1024;
constexpr size_t WS_ROPE = 3 * MiB;
constexpr size_t WS_LTK = 4 * MiB;
constexpr size_t WS_LG = 8 * MiB;
constexpr size_t WS_WINE = 16 * MiB, WS_WGLU = 20 * MiB, WS_WOUTE = 21 * MiB, WS_WINO = 23 * MiB, WS_WOUTO = 30 * MiB;
constexpr size_t WS_W1 = 32 * MiB;
constexpr size_t WS_HB8 = 160 * MiB;
constexpr size_t WS_W2 = 288 * MiB;
constexpr size_t WS_HB = 416 * MiB;
constexpr size_t WS_Z = 448 * MiB;
constexpr size_t WS_LSIG = 560 * MiB;
constexpr size_t WS_LOGA = 562 * MiB;
constexpr size_t WS_G5 = 578 * MiB;
constexpr size_t WS_YCAT = 594 * MiB;
constexpr size_t WS_MBUF = 626 * MiB;
constexpr size_t WS_ACT = 690 * MiB;
constexpr size_t WS_Y = 834 * MiB;
constexpr size_t WS_RST = 962 * MiB;
constexpr size_t WS_GST = 994 * MiB;
constexpr size_t WS_XB = 1010 * MiB;
constexpr size_t WS_END = 1042 * MiB;
constexpr int CW_CNT = 1024;

constexpr int RING_BYTES = 131072;
constexpr int MISC_OFF = RING_BYTES;
constexpr int LDS_BYTES = 147456;
constexpr int EPI_OFF = 135168, EPI_SLOT = 3072;

__device__ __forceinline__ unsigned f2bf(float f) { unsigned u = __builtin_bit_cast(unsigned, f); return (u + 0x7fffu + ((u >> 16) & 1u)) >> 16; }
typedef __bf16 bf16x2_hw __attribute__((ext_vector_type(2)));
__device__ __forceinline__ unsigned pk2(float lo, float hi) { const f32x2 v = {lo, hi}; return __builtin_bit_cast(unsigned, __builtin_convertvector(v, bf16x2_hw)); }
__device__ __forceinline__ float bflo(unsigned w) { return __builtin_bit_cast(float, w << 16); }
__device__ __forceinline__ float bfhi(unsigned w) { return __builtin_bit_cast(float, w & 0xffff0000u); }
__device__ __forceinline__ float bf1(bf16_t b) { return __builtin_bit_cast(float, ((unsigned)b) << 16); }
__device__ __forceinline__ int lane_id() { int l; asm volatile("v_mbcnt_lo_u32_b32 %0, -1, 0\n\tv_mbcnt_hi_u32_b32 %0, -1, %0" : "=v"(l)); return l; }
template <int CTRL> __device__ __forceinline__ float dppf(float v) { return __builtin_bit_cast(float, __builtin_amdgcn_update_dpp(0, __builtin_bit_cast(int, v), CTRL, 0xf, 0xf, true)); }
__device__ __forceinline__ float row16_sum(float v) {
    v += dppf<0xB1>(v); v += dppf<0x4E>(v); v += dppf<0x141>(v); v += dppf<0x140>(v); return v;
}
__device__ __forceinline__ float rdlane(float v, int l) { return __builtin_bit_cast(float, __builtin_amdgcn_readlane(__builtin_bit_cast(int, v), l)); }
__device__ __forceinline__ float wave_sum(float v) {
    v = row16_sum(v); return (rdlane(v, 0) + rdlane(v, 16)) + (rdlane(v, 32) + rdlane(v, 48));
}
__device__ __forceinline__ float half_sum(float v) {
    v = row16_sum(v); const float a = rdlane(v, 0) + rdlane(v, 16), b = rdlane(v, 32) + rdlane(v, 48); return (lane_id() < 32) ? a : b;
}
__device__ __forceinline__ float sigmoidf_(float x) { return __builtin_amdgcn_rcpf(1.f + __expf(-x)); }
__device__ __forceinline__ float log_sigmoidf_(float x) { return fminf(x, 0.f) - log1pf(__expf(-fabsf(x))); }
__device__ __forceinline__ float siluf_(float x) { return x * sigmoidf_(x); }
__device__ __forceinline__ float gelu_tanh(float x) { const float u2 = 1.5957691216057308f * (x + 0.044715f * x * x * x); return x * sigmoidf_(u2); }
constexpr float SC_H = 16.f, SC_W1 = 512.f, SC_A = 8.f, SC_W2 = 512.f, SC_WIN = 512.f, SC_Y = 64.f;
__device__ __forceinline__ unsigned pk8(float a, float b, float c, float d) {
    a = __builtin_amdgcn_fmed3f(a, -448.f, 448.f); b = __builtin_amdgcn_fmed3f(b, -448.f, 448.f); c = __builtin_amdgcn_fmed3f(c, -448.f, 448.f); d = __builtin_amdgcn_fmed3f(d, -448.f, 448.f);
    int r = __builtin_amdgcn_cvt_pk_fp8_f32(a, b, 0, false); r = __builtin_amdgcn_cvt_pk_fp8_f32(c, d, r, true); return (unsigned)r;
}
#define LDS_WAIT() asm volatile("s_waitcnt lgkmcnt(0)" ::: "memory")

struct Args { const float* in[31]; float* out; unsigned char* ws; long long pad; };
typedef const __attribute__((address_space(4))) Args CArgs;
enum { I_X = 0, I_C, I_ADAW, I_ADAB, I_NPM, I_NQM, I_NPF, I_NQF, I_EVWIN, I_FOXB, I_LAMRE, I_LAMIM, I_LOGDT, I_BRE, I_BIM, I_CRE, I_CIM, I_S5D, I_GLUW, I_GLUB, I_EVWOUT,
       I_ODWIN, I_GLAWUP, I_GLABG, I_ODWOUT, I_RW, I_RB, I_WGU, I_BGU, I_WDN, I_BDN };

namespace pg8 {
constexpr int BM = 256, BK = 64, HALF = 128, HTB = HALF * BK * 2, STAGE_BYTES = 8 * HTB, NXCD = 8, WGM = 8;
__device__ __forceinline__ int lds_byte(int r, int c) { const int st = (r >> 4) * 2 + (c >> 5), rr = r & 15, cc = c & 31, ob = rr * 64 + cc * 2; return st * 1024 + (ob ^ (((ob >> 9) & 1) << 5)); }
__device__ __forceinline__ void stage_rc(int b, int& R, int& C) { const int st = b / 1024, sb = b % 1024, swz = sb ^ (((sb >> 9) & 1) << 5); R = (st >> 1) * 16 + swz / 64; C = (st & 1) * 32 + (swz % 64) / 2; }
__device__ __forceinline__ int perm32(int rho) { const int n = rho >> 4, i = rho & 15; return 8 * (i >> 2) + 4 * n + (i & 3); }
__device__ __forceinline__ unsigned cvt_pk_bf16(float lo, float hi) { unsigned r; asm volatile("v_cvt_pk_bf16_f32 %0, %1, %2" : "=v"(r) : "v"(lo), "v"(hi)); return r; }

struct Unit { int pm, pn, e, mb, nrows, kind; };
__device__ __forceinline__ int xcd_remap(int L, int nwg) { const int q = nwg / NXCD, r = nwg % NXCD, xcd = L % NXCD, off = L / NXCD; return (xcd < r ? xcd * (q + 1) : r * (q + 1) + (xcd - r) * q) + off; }

struct DenseOrder {
    const char* Ap; const char* Bt; int K, nM, nN, nwg, G, c;
    __device__ __forceinline__ void init(const void* A_, const void* Bt_, int M, int N, int K_, int G_, int c_) { Ap = (const char*)A_; Bt = (const char*)Bt_; K = K_; nM = M / BM; nN = N / BM; nwg = nM * nN; G = G_; c = c_; }
    __device__ __forceinline__ bool next(int i, Unit& u) const {
        const long L = (long)i * G + c; if (L >= nwg) return false;
        const int wgid = xcd_remap((int)L, nwg);
        const int nig = WGM * nN, gid = wgid / nig, fm = gid * WGM, gsz = (nM - fm) < WGM ? (nM - fm) : WGM;
        u.pm = fm + ((wgid % nig) % gsz); u.pn = (wgid % nig) / gsz; u.e = 0; u.mb = u.pm; u.nrows = BM; u.kind = 0; return true;
    }
    __device__ __forceinline__ const char* a_base(const Unit& u) const { return Ap + (size_t)u.pm * ((size_t)BM * K * 2); }
    __device__ __forceinline__ const char* b_base(const Unit& u) const { return Bt + (size_t)u.pn * ((size_t)BM * K * 2); }
    __device__ __forceinline__ void a_raw(const Unit&, const int (&)[2], int (&raw)[2][2]) const { raw[0][0] = raw[0][1] = raw[1][0] = raw[1][1] = 0; }
    __device__ __forceinline__ void a_offs(const Unit&, const int (&R)[2], const int (&C)[2], const int (&)[2][2], unsigned (&v)[2][2]) const {
#pragma unroll
        for (int h = 0; h < 2; ++h)
#pragma unroll
            for (int i = 0; i < 2; ++i) v[h][i] = (unsigned)((h * HALF + R[i]) * K + C[i]) * 2u;
    }
};
struct MoeTables { int cnt[NEXP]; int mtstart[NEXP + 1]; unsigned char tile_e[320]; };
template <bool GATHER> struct MoeOrder {
    const char* Ap; const char* Bt; size_t estride; int K, NP, nwg, G, c, mt0; const int* list_tk; const LAS MoeTables* tb;
    __device__ __forceinline__ bool next(int i, Unit& u) const {
        const long L = (long)i * G + c; if (L >= nwg) return false;
        const int w = xcd_remap((int)L, nwg);
        const int mq = w / NP, mt = mt0 + mq; u.pn = w - mq * NP; u.pm = mt; u.e = tb->tile_e[mt]; u.mb = mt - tb->mtstart[u.e];
        const int left = tb->cnt[u.e] - u.mb * BM; u.nrows = left < BM ? left : BM; u.kind = GATHER ? 0 : 1; return true;
    }
    __device__ __forceinline__ const char* a_base(const Unit& u) const { return GATHER ? Ap : Ap + (size_t)u.pm * ((size_t)BM * K * 2); }
    __device__ __forceinline__ const char* b_base(const Unit& u) const { return Bt + (size_t)u.e * estride + (size_t)u.pn * ((size_t)BM * K * 2); }
    __device__ __forceinline__ void a_raw(const Unit& u, const int (&R)[2], int (&raw)[2][2]) const {
#pragma unroll
        for (int h = 0; h < 2; ++h)
#pragma unroll
            for (int i = 0; i < 2; ++i) { if (GATHER) { const int r = h * HALF + R[i], rc = r < u.nrows ? r : 0; raw[h][i] = list_tk[u.e * LISTCAP + u.mb * BM + rc]; } else raw[h][i] = 0; }
    }
    __device__ __forceinline__ void a_offs(const Unit&, const int (&R)[2], const int (&C)[2], const int (&raw)[2][2], unsigned (&v)[2][2]) const {
#pragma unroll
        for (int h = 0; h < 2; ++h)
#pragma unroll
            for (int i = 0; i < 2; ++i) {
                if (GATHER) v[h][i] = (unsigned)((raw[h][i] >> 2) * K + C[i]) * 2u;
                else v[h][i] = (unsigned)((h * HALF + R[i]) * K + C[i]) * 2u;
            }
    }
};

struct MoeMixOrder {
    const char* ws; int l, a0, nA, b0, nB, nwg, G, c; const LAS MoeTables* tb;
    static constexpr int K = 512;
    __device__ __forceinline__ bool next(int i, Unit& u) const {
        const long L = (long)i * G + c; if (L >= nwg) return false;
        int w = xcd_remap((int)L, nwg), mt;
        if (w < nA) { u.kind = 0; mt = a0 + (w >> 3); u.pn = w & 7; } else { w -= nA; u.kind = 1; mt = b0 + (w >> 2); u.pn = w & 3; }
        u.pm = mt; u.e = tb->tile_e[mt]; u.mb = mt - tb->mtstart[u.e];
        const int left = tb->cnt[u.e] - u.mb * BM; u.nrows = left < BM ? left : BM; return true;
    }
    __device__ __forceinline__ const char* a_base(const Unit& u) const { return u.kind ? ws + WS_ACT : ws + WS_HB8; }
    __device__ __forceinline__ const char* b_base(const Unit& u) const { return u.kind ? ws + WS_W2 + (size_t)(l * 32 + u.e) * ((size_t)1024 * K * 2) + (size_t)u.pn * ((size_t)BM * K * 2) : ws + WS_W1 + (size_t)(l * 32 + u.e) * ((size_t)2048 * K * 2) + (size_t)u.pn * ((size_t)BM * K * 2); }
    __device__ __forceinline__ void a_raw(const Unit& u, const int (&R)[2], int (&raw)[2][2]) const {
#pragma unroll
        for (int h = 0; h < 2; ++h)
#pragma unroll
            for (int i = 0; i < 2; ++i) { const int r = h * HALF + R[i], rc = r < u.nrows ? r : 0; raw[h][i] = u.kind ? 4 * (u.pm * BM + r) : ((const int*)(ws + WS_LTK))[(l * 32 + u.e) * LISTCAP + u.mb * BM + rc]; }
    }
    __device__ __forceinline__ void a_offs(const Unit& u, const int (&R)[2], const int (&C)[2], const int (&raw)[2][2], unsigned (&v)[2][2]) const {
#pragma unroll
        for (int h = 0; h < 2; ++h)
#pragma unroll
            for (int i = 0; i < 2; ++i) v[h][i] = (unsigned)((raw[h][i] >> 2) * K + C[i]) * 2u;
    }
};

template <class Epi, class Sched, bool ALIGN_EPI, bool FP8 = false>
__device__ __forceinline__ void gemm_phase(LAS unsigned char* lds, const int wave_, const int K, const Sched& S, const Epi& E) {
    int tid_ = wave_ * 64 + lane_id(); asm volatile("" : "+v"(tid_));
    const int tid = tid_, wid = wave_, lane = tid & 63, wr = wid >> 2, wc = wid & 3, fr = lane & 15, fq = lane >> 4;
    int nt_ = K / BK; if constexpr (FP8) asm volatile("" : "+s"(nt_));
    const int nt = nt_;
    int Rr[2], Cc[2]; unsigned voffB[2];
#pragma unroll
    for (int i = 0; i < 2; ++i) { stage_rc(tid * 16 + i * 8192, Rr[i], Cc[i]); const int Rb = Epi::PERM ? ((Rr[i] & ~31) + perm32(Rr[i] & 31)) : Rr[i]; voffB[i] = (unsigned)(Rb * K + Cc[i]) * 2u; }
    const size_t kstep = (size_t)(BK * 2);
    const size_t hstep = (size_t)HALF * K * 2;
    const unsigned ldsw = (unsigned)wid * 1024u;
    const int aoff = lds_byte(wr * 64 + fr, fq * 8), boff = lds_byte(wc * 32 + fr, fq * 8);
#define PG8_SA(b, h) (((b) * 2 + (h)) * HTB)
#define PG8_SB(b, h) ((4 + (b) * 2 + (h)) * HTB)
#define PG8_STAGE(bufoff, gbase, voff) do { _Pragma("unroll") for (int _i = 0; _i < 2; ++_i) { unsigned vo_ = (voff)[_i]; if constexpr (FP8) asm volatile("" : "+v"(vo_));   \
        __builtin_amdgcn_global_load_lds((const unsigned*)((const char*)(gbase) + vo_), (LAS unsigned*)(lds + (bufoff) + ldsw + _i * 8192), 16, 0, 0); } } while (0)
#define PG8_LDA(dst, b, h) do { _Pragma("unroll") for (int m = 0; m < 4; ++m) { \
        if constexpr (FP8) { const i32x4 lo_ = *(const LAS i32x4*)(lds + PG8_SA(b, h) + aoff + m * 2048), hi_ = *(const LAS i32x4*)(lds + PG8_SA(b, h) + aoff + m * 2048 + 1024); dst##8[m] = __builtin_shufflevector(lo_, hi_, 0, 1, 2, 3, 4, 5, 6, 7); } \
        else { _Pragma("unroll") for (int k = 0; k < 2; ++k) dst[m][k] = *(const LAS bf16x8*)(lds + PG8_SA(b, h) + aoff + m * 2048 + k * 1024); } } } while (0)
#define PG8_LDB(dst, b, h) do { _Pragma("unroll") for (int n = 0; n < 2; ++n) { \
        if constexpr (FP8) { const i32x4 lo_ = *(const LAS i32x4*)(lds + PG8_SB(b, h) + boff + n * 2048), hi_ = *(const LAS i32x4*)(lds + PG8_SB(b, h) + boff + n * 2048 + 1024); dst##8[n] = __builtin_shufflevector(lo_, hi_, 0, 1, 2, 3, 4, 5, 6, 7); } \
        else { _Pragma("unroll") for (int k = 0; k < 2; ++k) dst[n][k] = *(const LAS bf16x8*)(lds + PG8_SB(b, h) + boff + n * 2048 + k * 1024); } } } while (0)
#define PG8_MMA(ai, bj, At, Bt) do { __builtin_amdgcn_s_setprio(1); _Pragma("unroll") for (int m = 0; m < 4; ++m) _Pragma("unroll") for (int n = 0; n < 2; ++n) { \
        if constexpr (FP8) asm volatile("v_mfma_f32_16x16x128_f8f6f4 %0, %1, %2, %0" : "+v"(acc[ai][bj][m][n]) : "v"(Bt##8[n]), "v"(At##8[m]));   \
        else { _Pragma("unroll") for (int k = 0; k < 2; ++k) acc[ai][bj][m][n] = __builtin_amdgcn_mfma_f32_16x16x32_bf16(Bt[n][k], At[m][k], acc[ai][bj][m][n], 0, 0, 0); } } \
        __builtin_amdgcn_s_setprio(0); } while (0)
#define PG8_WAIT_V(n) asm volatile("s_waitcnt vmcnt(" #n ")" ::: "memory")
#define PG8_WAIT_L(n) asm volatile("s_waitcnt lgkmcnt(" #n ")" ::: "memory")
#define PG8_BAR __builtin_amdgcn_s_barrier()
#define PG8_SCHED __builtin_amdgcn_sched_barrier(0)
    Unit cur, nxt; int ui = 0;
    if (!S.next(0, cur)) return;
    f32x4 acc[2][2][4][2];
#pragma unroll
    for (int a = 0; a < 2; ++a)
#pragma unroll
        for (int b = 0; b < 2; ++b)
#pragma unroll
            for (int m = 0; m < 4; ++m)
#pragma unroll
                for (int n = 0; n < 2; ++n) acc[a][b][m][n] = (f32x4){0.f, 0.f, 0.f, 0.f};
    bf16x8 At[4][2], B0[2][2], B1[2][2]; i32x8 At8[4], B08[2], B18[2];
    const char* cA = S.a_base(cur); const char* cB = S.b_base(cur);
    unsigned cv[2][2], nv[2][2]; int raw[2][2];
    S.a_raw(cur, Rr, raw); S.a_offs(cur, Rr, Cc, raw, cv);
    PG8_STAGE(PG8_SB(0, 0), cB, voffB); PG8_STAGE(PG8_SB(0, 1), cB + hstep, voffB); PG8_STAGE(PG8_SA(0, 0), cA, cv[0]); PG8_STAGE(PG8_SA(0, 1), cA, cv[1]);
    if (wr == 1) PG8_BAR;
    PG8_WAIT_V(2); PG8_BAR;
    PG8_STAGE(PG8_SB(1, 0), cB + kstep, voffB); PG8_STAGE(PG8_SA(1, 0), cA + kstep, cv[0]); PG8_STAGE(PG8_SB(1, 1), cB + hstep + kstep, voffB);
    PG8_WAIT_V(6); PG8_BAR;
    for (;;) {
        if constexpr (Epi::STAGED) { if (wid < 3) E.stage(cur, wid, lane, lds + EPI_OFF + (ui & 1) * EPI_SLOT); }
        const bool has_next = S.next(ui + 1, nxt);
        const char* nA = has_next ? S.a_base(nxt) : cA; const char* nB = has_next ? S.b_base(nxt) : cB;
        if (has_next) S.a_raw(nxt, Rr, raw);
#pragma unroll
        for (int h = 0; h < 2; ++h)
#pragma unroll
            for (int i = 0; i < 2; ++i) nv[h][i] = cv[h][i];
        for (int t = 0; t < nt; t += 2) {
            const bool last = (t == nt - 2);
            if (last && has_next) S.a_offs(nxt, Rr, Cc, raw, nv);
            const char* a1 = cA + (size_t)(t + 1) * kstep;
            const char* a2 = last ? nA : cA + (size_t)(t + 2) * kstep; const char* b2 = last ? nB : cB + (size_t)(t + 2) * kstep;
            const char* a3 = a2 + kstep; const char* b3 = b2 + kstep;
            unsigned v2[2][2];
#pragma unroll
            for (int h = 0; h < 2; ++h)
#pragma unroll
                for (int i = 0; i < 2; ++i) v2[h][i] = last ? nv[h][i] : cv[h][i];
            PG8_LDB(B0, 0, 0); PG8_LDB(B1, 0, 1); PG8_SCHED; PG8_LDA(At, 0, 0); PG8_STAGE(PG8_SA(1, 1), a1, cv[1]);
            PG8_WAIT_V(8); PG8_WAIT_L(0); PG8_BAR; PG8_MMA(0, 0, At, B0); PG8_MMA(0, 1, At, B1); PG8_BAR; PG8_SCHED;
            PG8_LDA(At, 0, 1); PG8_STAGE(PG8_SB(0, 0), b2, voffB); PG8_STAGE(PG8_SB(0, 1), b2 + hstep, voffB); PG8_STAGE(PG8_SA(0, 0), a2, v2[0]);
            PG8_WAIT_V(8); PG8_WAIT_L(0); PG8_BAR; PG8_MMA(1, 0, At, B0); PG8_MMA(1, 1, At, B1); PG8_BAR; PG8_SCHED;
            PG8_LDB(B0, 1, 0); PG8_LDB(B1, 1, 1); PG8_SCHED; PG8_LDA(At, 1, 0); PG8_STAGE(PG8_SA(0, 1), a2, v2[1]);
            PG8_WAIT_V(8); PG8_WAIT_L(0); PG8_BAR; PG8_MMA(0, 0, At, B0); PG8_MMA(0, 1, At, B1); PG8_BAR; PG8_SCHED;
            PG8_LDA(At, 1, 1); PG8_STAGE(PG8_SB(1, 0), b3, voffB); PG8_STAGE(PG8_SB(1, 1), b3 + hstep, voffB); PG8_STAGE(PG8_SA(1, 0), a3, v2[0]);
            PG8_WAIT_V(8); PG8_WAIT_L(0); PG8_BAR; PG8_MMA(1, 0, At, B0); PG8_MMA(1, 1, At, B1); PG8_BAR; PG8_SCHED;
        }
        if constexpr (ALIGN_EPI) { if (wr == 0) PG8_BAR; }
        if constexpr (FP8) asm volatile("s_nop 15\n\ts_nop 15" ::: "memory");
        E(acc, cur, wr, wc, fr, fq, lds + EPI_OFF + (ui & 1) * EPI_SLOT);
        if (!has_next) break;
#pragma unroll
        for (int a = 0; a < 2; ++a)
#pragma unroll
            for (int b = 0; b < 2; ++b)
#pragma unroll
                for (int m = 0; m < 4; ++m)
#pragma unroll
                    for (int n = 0; n < 2; ++n) acc[a][b][m][n] = (f32x4){0.f, 0.f, 0.f, 0.f};
        cur = nxt; cA = nA; cB = nB; ++ui;
#pragma unroll
        for (int h = 0; h < 2; ++h)
#pragma unroll
            for (int i = 0; i < 2; ++i) cv[h][i] = nv[h][i];
        if constexpr (ALIGN_EPI) { if (wr == 1) PG8_BAR; }
    }
    PG8_WAIT_V(0);
    if constexpr (!ALIGN_EPI) { if (wr == 0) PG8_BAR; }
    PG8_BAR;
#undef PG8_SA
#undef PG8_SB
#undef PG8_STAGE
#undef PG8_LDA
#undef PG8_LDB
#undef PG8_MMA
#undef PG8_WAIT_V
#undef PG8_WAIT_L
#undef PG8_BAR
#undef PG8_SCHED
}
}
namespace pg8 {
typedef f32x4 Acc[2][2][4][2];
struct EpiZ0 {
    static constexpr bool PERM = true; static constexpr bool STAGED = false;
    bf16_t* Z;
    __device__ __forceinline__ void operator()(const Acc& acc, const Unit& u, int wr, int wc, int fr, int fq, LAS const unsigned char* es) const {
        const float sc = (u.pn == 2 || u.pn == 3) ? C2 : 1.f;
        const int row0 = u.pm * BM + wr * 64 + fr, col0 = u.pn * BM + wc * 32 + 8 * fq;
#pragma unroll
        for (int ai = 0; ai < 2; ++ai)
#pragma unroll
            for (int m = 0; m < 4; ++m) { bf16_t* rowp = Z + (size_t)(row0 + ai * HALF + m * 16) * ZP0 + col0;
#pragma unroll
                for (int bj = 0; bj < 2; ++bj) { const f32x4 v0 = acc[ai][bj][m][0] * sc, v1 = acc[ai][bj][m][1] * sc;
                    u32x4 w; w.x = cvt_pk_bf16(v0[0], v0[1]); w.y = cvt_pk_bf16(v0[2], v0[3]); w.z = cvt_pk_bf16(v1[0], v1[1]); w.w = cvt_pk_bf16(v1[2], v1[3]);
                    *(u32x4*)(rowp + bj * HALF) = w; } }
    }
};
struct EpiZ1 {
    static constexpr bool PERM = true; static constexpr bool STAGED = false;
    bf16_t* Z; const float* rope;
    __device__ __forceinline__ void operator()(const Acc& acc, const Unit& u, int wr, int wc, int fr, int fq, LAS const unsigned char* es) const {
        constexpr float INV = 1.f / (SC_H * SC_WIN);
        const int row0 = u.pm * BM + wr * 64 + fr;
        if (u.pn < 4) {
            const float sc = (u.pn >= 2) ? 0.08838834764831845f * INV : INV;
            const int hl = wc >> 1, jj0 = 32 * (wc & 1) + 8 * fq;
#pragma unroll
            for (int ai = 0; ai < 2; ++ai)
#pragma unroll
                for (int m = 0; m < 4; ++m) { const int row = row0 + ai * HALF + m * 16, pos = row & (SEQ - 1);
                    const f32x4 c0 = *(const f32x4*)(rope + pos * 64 + jj0), c1 = *(const f32x4*)(rope + pos * 64 + jj0 + 4);
                    const f32x4 s0 = *(const f32x4*)(rope + SEQ * 64 + pos * 64 + jj0), s1 = *(const f32x4*)(rope + SEQ * 64 + pos * 64 + jj0 + 4);
                    const f32x4 x10 = acc[ai][0][m][0] * sc, x11 = acc[ai][0][m][1] * sc, x20 = acc[ai][1][m][0] * sc, x21 = acc[ai][1][m][1] * sc;
                    const f32x4 a0 = x10 * c0 - x20 * s0, a1 = x11 * c1 - x21 * s1, b0 = x10 * s0 + x20 * c0, b1 = x11 * s1 + x21 * c1;
                    bf16_t* rowp = Z + (size_t)row * ZP1 + u.pn * BM + 128 * hl + jj0;
                    u32x4 w; w.x = cvt_pk_bf16(a0[0], a0[1]); w.y = cvt_pk_bf16(a0[2], a0[3]); w.z = cvt_pk_bf16(a1[0], a1[1]); w.w = cvt_pk_bf16(a1[2], a1[3]);
                    *(u32x4*)(rowp) = w;
                    w.x = cvt_pk_bf16(b0[0], b0[1]); w.y = cvt_pk_bf16(b0[2], b0[3]); w.z = cvt_pk_bf16(b1[0], b1[1]); w.w = cvt_pk_bf16(b1[2], b1[3]);
                    *(u32x4*)(rowp + 64) = w; }
        } else {
            const float sc = (u.pn == 8) ? 0.125f * INV : INV;
            const int col0 = u.pn * BM + wc * 32 + 8 * fq;
#pragma unroll
            for (int ai = 0; ai < 2; ++ai)
#pragma unroll
                for (int m = 0; m < 4; ++m) { bf16_t* rowp = Z + (size_t)(row0 + ai * HALF + m * 16) * ZP1 + col0;
#pragma unroll
                    for (int bj = 0; bj < 2; ++bj) { const f32x4 v0 = acc[ai][bj][m][0] * sc, v1 = acc[ai][bj][m][1] * sc;
                        u32x4 w; w.x = cvt_pk_bf16(v0[0], v0[1]); w.y = cvt_pk_bf16(v0[2], v0[3]); w.z = cvt_pk_bf16(v1[0], v1[1]); w.w = cvt_pk_bf16(v1[2], v1[3]);
                        *(u32x4*)(rowp + bj * HALF) = w; } }
        }
    }
};
struct EpiGlu {
    static constexpr bool PERM = true; static constexpr bool STAGED = false;
    const bf16_t* G5; const float* bias; bf16_t* Y;
    __device__ __forceinline__ void operator()(const Acc& acc, const Unit& u, int wr, int wc, int fr, int fq, LAS const unsigned char* es) const {
        const int row0 = u.pm * BM + wr * 64 + fr, col0 = u.pn * BM + wc * 32 + 8 * fq;
        f32x4 bv[2][2];
#pragma unroll
        for (int bj = 0; bj < 2; ++bj)
#pragma unroll
            for (int n = 0; n < 2; ++n) bv[bj][n] = *(const f32x4*)(bias + col0 + bj * HALF + 4 * n);
#pragma unroll
        for (int ai = 0; ai < 2; ++ai)
#pragma unroll
            for (int m = 0; m < 4; ++m) { const size_t row = (size_t)(row0 + ai * HALF + m * 16);
#pragma unroll
                for (int bj = 0; bj < 2; ++bj) { const u32x4 gw = *(const u32x4*)(G5 + row * 512 + col0 + bj * HALF);
                    const f32x4 v0 = acc[ai][bj][m][0] + bv[bj][0], v1 = acc[ai][bj][m][1] + bv[bj][1];
                    float o[8]; o[0] = bflo(gw.x) * sigmoidf_(v0[0]); o[1] = bfhi(gw.x) * sigmoidf_(v0[1]); o[2] = bflo(gw.y) * sigmoidf_(v0[2]); o[3] = bfhi(gw.y) * sigmoidf_(v0[3]);
                    o[4] = bflo(gw.z) * sigmoidf_(v1[0]); o[5] = bfhi(gw.z) * sigmoidf_(v1[1]); o[6] = bflo(gw.w) * sigmoidf_(v1[2]); o[7] = bfhi(gw.w) * sigmoidf_(v1[3]);
                    u32x4 w; w.x = cvt_pk_bf16(o[0], o[1]); w.y = cvt_pk_bf16(o[2], o[3]); w.z = cvt_pk_bf16(o[4], o[5]); w.w = cvt_pk_bf16(o[6], o[7]);
                    *(u32x4*)(Y + row * DM + col0 + bj * HALF) = w; } }
    }
};
struct EpiF32 {
    static constexpr bool PERM = false; static constexpr bool STAGED = false;
    float* Cp; int ldc;
    __device__ __forceinline__ void operator()(const Acc& acc, const Unit& u, int wr, int wc, int fr, int fq, LAS const unsigned char* es) const {
        const int row0 = u.pm * BM + wr * 64 + fr, col0 = u.pn * BM + wc * 32 + 4 * fq;
#pragma unroll
        for (int ai = 0; ai < 2; ++ai)
#pragma unroll
            for (int m = 0; m < 4; ++m) { float* rowp = Cp + (size_t)(row0 + ai * HALF + m * 16) * ldc + col0;
#pragma unroll
                for (int bj = 0; bj < 2; ++bj)
#pragma unroll
                    for (int n = 0; n < 2; ++n) *(f32x4*)(rowp + bj * HALF + n * 16) = acc[ai][bj][m][n]; }
    }
};
struct EpiBf16Plain {
    static constexpr bool PERM = true; static constexpr bool STAGED = false;
    bf16_t* Cp; int ldc;
    __device__ __forceinline__ void operator()(const Acc& acc, const Unit& u, int wr, int wc, int fr, int fq, LAS const unsigned char* es) const {
        const int row0 = u.pm * BM + wr * 64 + fr, col0 = u.pn * BM + wc * 32 + 8 * fq;
#pragma unroll
        for (int ai = 0; ai < 2; ++ai)
#pragma unroll
            for (int m = 0; m < 4; ++m) { bf16_t* rowp = Cp + (size_t)(row0 + ai * HALF + m * 16) * ldc + col0;
#pragma unroll
                for (int bj = 0; bj < 2; ++bj) { const f32x4 v0 = acc[ai][bj][m][0], v1 = acc[ai][bj][m][1];
                    u32x4 w; w.x = cvt_pk_bf16(v0[0], v0[1]); w.y = cvt_pk_bf16(v0[2], v0[3]); w.z = cvt_pk_bf16(v1[0], v1[1]); w.w = cvt_pk_bf16(v1[2], v1[3]);
                    *(u32x4*)(rowp + bj * HALF) = w; } }
    }
};
struct EpiSwiglu {
    static constexpr bool PERM = true; static constexpr bool STAGED = true;
    unsigned char* ACT; const float* bgu;
    __device__ __forceinline__ void stage(const Unit& u, int wid, int lane, LAS unsigned char* dst) const {
        if (wid == 0) { const float* src = bgu + (size_t)u.e * 2048 + u.pn * 128 + (lane < 32 ? 4 * lane : 1024 + 4 * (lane - 32));
            __builtin_amdgcn_global_load_lds((const unsigned*)src, (LAS unsigned*)dst, 16, 0, 0); }
    }
    __device__ __forceinline__ void operator()(const Acc& acc, const Unit& u, int wr, int wc, int fr, int fq, LAS const unsigned char* es) const {
        constexpr float INV = 1.f / (SC_H * SC_W1), INVL = INV * SC_A, CE = -1.702f * LOG2E;
        const int row0 = u.pm * BM + wr * 64 + fr, j0 = wc * 32 + 8 * fq, colg = u.pn * 128 + j0;
        f32x2 bg[4], bl[4];
#pragma unroll
        for (int p = 0; p < 4; ++p) { bg[p] = *(const LAS f32x2*)(es + 4 * (j0 + 2 * p)); bl[p] = (*(const LAS f32x2*)(es + 512 + 4 * (j0 + 2 * p)) + 1.f) * SC_A; }
#pragma unroll
        for (int ai = 0; ai < 2; ++ai)
#pragma unroll
            for (int m = 0; m < 4; ++m) {
                f32x2 o[4];
#pragma unroll
                for (int p = 0; p < 4; ++p) {
                    const f32x4 ag = acc[ai][0][m][p >> 1], al = acc[ai][1][m][p >> 1];
                    const f32x2 g = (p & 1 ? (f32x2){ag[2], ag[3]} : (f32x2){ag[0], ag[1]}) * INV + bg[p], l = (p & 1 ? (f32x2){al[2], al[3]} : (f32x2){al[0], al[1]}) * INVL + bl[p];
                    const f32x2 a = {fminf(g.x, 7.f), fminf(g.y, 7.f)}, b = {__builtin_amdgcn_fmed3f(l.x, -6.f * SC_A, 8.f * SC_A), __builtin_amdgcn_fmed3f(l.y, -6.f * SC_A, 8.f * SC_A)};
                    const f32x2 t = a * CE; const f32x2 d = (f32x2){__builtin_amdgcn_exp2f(t.x), __builtin_amdgcn_exp2f(t.y)} + 1.f;
                    const f32x2 sg = {__builtin_amdgcn_rcpf(d.x), __builtin_amdgcn_rcpf(d.y)};
                    o[p] = (a * sg) * b; }
                u32x2 w; int r0 = __builtin_amdgcn_cvt_pk_fp8_f32(o[0].x, o[0].y, 0, false); r0 = __builtin_amdgcn_cvt_pk_fp8_f32(o[1].x, o[1].y, r0, true);
                int r1 = __builtin_amdgcn_cvt_pk_fp8_f32(o[2].x, o[2].y, 0, false); r1 = __builtin_amdgcn_cvt_pk_fp8_f32(o[3].x, o[3].y, r1, true);
                w.x = (unsigned)r0; w.y = (unsigned)r1;
                *(u32x2*)(ACT + (size_t)(row0 + ai * HALF + m * 16) * DM + colg) = w; }
    }
};
struct EpiDown {
    static constexpr bool PERM = true; static constexpr bool STAGED = true;
    unsigned char* Y; const float* bdn; const int* list_tk; const float* list_g;
    __device__ __forceinline__ void stage(const Unit& u, int wid, int lane, LAS unsigned char* dst) const {
        const size_t lbase = (size_t)u.e * LISTCAP + (size_t)u.mb * BM;
        const void* src = wid == 0 ? (const void*)(bdn + (size_t)u.e * DM + u.pn * BM + 4 * lane) : wid == 1 ? (const void*)(list_tk + lbase + 4 * lane) : (const void*)(list_g + lbase + 4 * lane);
        __builtin_amdgcn_global_load_lds((const unsigned*)src, (LAS unsigned*)(dst + 1024 * wid), 16, 0, 0);
    }
    __device__ __forceinline__ void operator()(const Acc& acc, const Unit& u, int wr, int wc, int fr, int fq, LAS const unsigned char* es) const {
        constexpr float INV = SC_Y / (SC_A * SC_W2);
        const int r0 = wr * 64 + fr, col0 = u.pn * BM + wc * 32 + 8 * fq;
        const int cl = wc * 32 + 8 * fq;
        f32x4 bv[2][2];
#pragma unroll
        for (int bj = 0; bj < 2; ++bj)
#pragma unroll
            for (int n = 0; n < 2; ++n) bv[bj][n] = *(const LAS f32x4*)(es + 4 * (cl + bj * HALF + 4 * n)) * SC_Y;
        int tkv[2][4]; float gtv[2][4];
#pragma unroll
        for (int ai = 0; ai < 2; ++ai)
#pragma unroll
            for (int m = 0; m < 4; ++m) { const int r = r0 + ai * HALF + m * 16; tkv[ai][m] = *(const LAS int*)(es + 1024 + 4 * r); gtv[ai][m] = *(const LAS float*)(es + 2048 + 4 * r); }
#pragma unroll
        for (int ai = 0; ai < 2; ++ai)
#pragma unroll
            for (int m = 0; m < 4; ++m) { const int r = r0 + ai * HALF + m * 16;
                if (r < u.nrows) { const float gt = gtv[ai][m];
                    unsigned char* rowp = Y + (size_t)tkv[ai][m] * DM + col0;
#pragma unroll
                    for (int bj = 0; bj < 2; ++bj) { const float gi = gt * INV; const f32x4 v0 = acc[ai][bj][m][0] * gi + bv[bj][0] * gt, v1 = acc[ai][bj][m][1] * gi + bv[bj][1] * gt;
                        u32x2 w; w.x = pk8(v0[0], v0[1], v0[2], v0[3]); w.y = pk8(v1[0], v1[1], v1[2], v1[3]);
                        *(u32x2*)(rowp + bj * HALF) = w; } } }
    }
};
struct EpiMoeMix {
    static constexpr bool PERM = true; static constexpr bool STAGED = true;
    CArgs* ap; int l;
    __device__ __forceinline__ void stage(const Unit& u, int wid, int lane, LAS unsigned char* dst) const {
        CArgs& A = *ap; unsigned char* ws = A.ws;
        if (u.kind == 0) { const EpiSwiglu sw{ws + WS_ACT, A.in[I_BGU] + (size_t)l * 32 * 2048}; sw.stage(u, wid, lane, dst); }
        else { const EpiDown dn{ws + WS_Y, A.in[I_BDN] + (size_t)l * 32 * 1024, (const int*)(ws + WS_LTK) + (size_t)l * 32 * LISTCAP, (const float*)(ws + WS_LG) + (size_t)l * 32 * LISTCAP}; dn.stage(u, wid, lane, dst); }
    }
    __device__ __forceinline__ void operator()(const Acc& acc, const Unit& u, int wr, int wc, int fr, int fq, LAS const unsigned char* es) const {
        CArgs& A = *ap; unsigned char* ws = A.ws;
        if (u.kind == 0) { const EpiSwiglu sw{ws + WS_ACT, A.in[I_BGU] + (size_t)l * 32 * 2048}; sw(acc, u, wr, wc, fr, fq, es); }
        else { const EpiDown dn{ws + WS_Y, A.in[I_BDN] + (size_t)l * 32 * 1024, (const int*)(ws + WS_LTK) + (size_t)l * 32 * LISTCAP, (const float*)(ws + WS_LG) + (size_t)l * 32 * LISTCAP}; dn(acc, u, wr, wc, fr, fq, es); }
    }
};
}
struct Frame { unsigned char* lds; int tid, lane, wave, bid, G; };
#define P_MOD   ((float*)(A.ws + WS_MOD))
#define P_S5A   ((float*)(A.ws + WS_S5A))
#define P_S5BB  ((float*)(A.ws + WS_S5BB))
#define P_ROPE  ((float*)(A.ws + WS_ROPE))
#define P_WSIDE ((float*)(A.ws + WS_WSIDE))
#define P_S5CK  ((bf16_t*)(A.ws + WS_S5CK))
#define P_LTK   ((int*)(A.ws + WS_LTK))
#define P_LG    ((float*)(A.ws + WS_LG))
#define P_CNT   ((unsigned*)(A.ws + WS_CTL) + CW_CNT)
#define P_WINE  (A.ws + WS_WINE)
#define P_WGLU  ((bf16_t*)(A.ws + WS_WGLU))
#define P_WOUTE ((bf16_t*)(A.ws + WS_WOUTE))
#define P_WINO  (A.ws + WS_WINO)
#define P_WOUTO ((bf16_t*)(A.ws + WS_WOUTO))
#define P_W1    (A.ws + WS_W1)
#define P_W2    (A.ws + WS_W2)
#define P_HB8   (A.ws + WS_HB8)
#define P_HB    (A.ws + WS_HB)
#define P_Z     ((bf16_t*)(A.ws + WS_Z))
#define P_G5    ((bf16_t*)(A.ws + WS_G5))
#define P_YCAT  ((bf16_t*)(A.ws + WS_YCAT))
#define P_ACT   (A.ws + WS_ACT)
#define P_Y     (A.ws + WS_Y)
#define P_LSIG  ((float*)(A.ws + WS_LSIG))
#define P_LOGA  ((float*)(A.ws + WS_LOGA))
#define P_MBUF  ((float*)(A.ws + WS_MBUF))
#define P_XB    ((bf16_t*)(A.ws + WS_XB))
#define P_RST   ((bf16_t*)(A.ws + WS_RST))
#define P_GST   ((bf16_t*)(A.ws + WS_GST))

__device__ __forceinline__ void tr_tile(const float* __restrict__ src, int pitch, int k0, int c0, bf16_t* dst, int Kd, int r0, float* scr, int lane) {
#pragma unroll
    for (int i = 0; i < 16; ++i) {
        const int kk = 4 * i + (lane >> 4), cc = 4 * (lane & 15);
        const f32x4 v = __builtin_nontemporal_load((const f32x4*)(src + (size_t)(k0 + kk) * pitch + c0 + cc));
        float* s = scr + kk * 65 + cc; s[0] = v.x; s[1] = v.y; s[2] = v.z; s[3] = v.w;
    }
    LDS_WAIT();
    const int c = lane & 7;
#pragma unroll
    for (int j = 0; j < 8; ++j) { const int n = (lane >> 3) + 8 * j; const float* s = scr + (8 * c) * 65 + n;
        u32x4 o; o.x = pk2(s[0], s[65]); o.y = pk2(s[130], s[195]); o.z = pk2(s[260], s[325]); o.w = pk2(s[390], s[455]);
        __builtin_nontemporal_store(o, (u32x4*)(dst + (size_t)(r0 + n) * Kd + k0 + 8 * c)); }
    LDS_WAIT();
}
__device__ __forceinline__ void tr_tile8(const float* __restrict__ src, int pitch, int k0, int c0, unsigned char* dst, int Kd, int r0, float* scr, int lane, float scale) {
#pragma unroll
    for (int i = 0; i < 16; ++i) {
        const int kk = 4 * i + (lane >> 4), cc = 4 * (lane & 15);
        const f32x4 v = __builtin_nontemporal_load((const f32x4*)(src + (size_t)(k0 + kk) * pitch + c0 + cc));
        float* s = scr + kk * 65 + cc; s[0] = v.x * scale; s[1] = v.y * scale; s[2] = v.z * scale; s[3] = v.w * scale;
    }
    LDS_WAIT();
    const int c = lane & 3;
#pragma unroll
    for (int j = 0; j < 4; ++j) { const int n = (lane >> 2) + 16 * j; const float* s = scr + (16 * c) * 65 + n;
        u32x4 o; o.x = pk8(s[0], s[65], s[130], s[195]); o.y = pk8(s[260], s[325], s[390], s[455]); o.z = pk8(s[520], s[585], s[650], s[715]); o.w = pk8(s[780], s[845], s[910], s[975]);
        __builtin_nontemporal_store(o, (u32x4*)(dst + (size_t)(r0 + n) * Kd + k0 + 16 * c)); }
    LDS_WAIT();
}
struct TileD { const float* src; unsigned char* dst; int pitch, rp, mode; float scale; };
constexpr int P0_T0 = 16 * 32, P0_T1 = 8 * 8, P0_T2 = 16 * 16, P0_T3 = 16 * 56, P0_T4 = 16 * 16, P0_T5 = 64 * 16 * 32, P0_T6 = 64 * 16 * 16;
constexpr int P0_NTILES = P0_T0 + P0_T1 + P0_T2 + P0_T3 + P0_T4 + P0_T5 + P0_T6;
__device__ __forceinline__ void tile_set(TileD& d, const float* src, int pitch, int k0, int c0, unsigned char* dst, int Kd, int r0, int mode, float scale) {
    d.src = src + (size_t)k0 * pitch + c0; d.pitch = pitch; d.mode = mode; d.scale = scale;
    d.rp = mode ? Kd : 2 * Kd; d.dst = dst + (size_t)r0 * d.rp + (mode ? k0 : 2 * k0);
}
__device__ __forceinline__ void tile_decode(CArgs& A, int it, TileD& d) {
    int r = it;
    if (r < P0_T0) { const int kb = r / 32, nb = r % 32; tile_set(d, A.in[I_EVWIN], 2056, kb * 64, nb * 64, P_WINE, 1024, nb * 64, 0, 1.f); return; } r -= P0_T0;
    if (r < P0_T1) { const int kb = r / 8, nb = r % 8; tile_set(d, A.in[I_GLUW], 512, kb * 64, nb * 64, (unsigned char*)P_WGLU, 512, nb * 64, 0, 1.f); return; } r -= P0_T1;
    if (r < P0_T2) { const int kb = r / 16, nb = r % 16; tile_set(d, A.in[I_EVWOUT], 1024, kb * 64, nb * 64, (unsigned char*)P_WOUTE, 1024, nb * 64, 0, 1.f); return; } r -= P0_T2;
    if (r < P0_T3) { const int kb = r / 112, nb = r % 112; const int n0 = nb * 32; int c0;
        if (n0 < 1024) { const int pn = n0 >> 8, rem = n0 & 255, bj = rem >> 7, hl = (rem & 127) >> 6; c0 = 256 * pn + 128 * hl + 64 * bj + (n0 & 63); }
        else if (n0 < 3072) c0 = n0; else c0 = n0 + 16;
        tile_set(d, A.in[I_ODWIN], 3600, kb * 128, c0, P_WINO, 1024, n0, 1, SC_WIN); return; } r -= P0_T3;
    if (r < P0_T4) { const int kb = r / 16, nb = r % 16; tile_set(d, A.in[I_ODWOUT], 1024, kb * 64, nb * 64, (unsigned char*)P_WOUTO, 1024, nb * 64, 0, 1.f); return; } r -= P0_T4;
    if (r < P0_T5) { const int mat = r / 512, q = r % 512, kb = q / 64, nb = q % 64; const int n0 = nb * 32, pn = n0 >> 8, half = (n0 & 255) >> 7, j0 = n0 & 127;
        tile_set(d, A.in[I_WGU] + (size_t)mat * 1024 * 2048, 2048, kb * 128, half * 1024 + 128 * pn + j0, P_W1 + (size_t)mat * 2048 * 1024, 1024, n0, 1, SC_W1); return; } r -= P0_T5;
    { const int mat = r / 256, q = r % 256, kb = q / 32, nb = q % 32;
        tile_set(d, A.in[I_WDN] + (size_t)mat * 1024 * 1024, 1024, kb * 128, nb * 32, P_W2 + (size_t)mat * 1024 * 1024, 1024, nb * 32, 1, SC_W2); }
}
__device__ __forceinline__ void tile_load(const TileD& d, f32x4 (&R)[16], int lane) {
    const int rs = d.mode ? 3 : 4, kr = lane >> rs, cc = 4 * (lane & ((1 << rs) - 1)), kstep = 64 >> rs;
#pragma unroll
    for (int i = 0; i < 16; ++i) R[i] = __builtin_nontemporal_load((const f32x4*)(d.src + (size_t)(kstep * i + kr) * d.pitch + cc));
}
__device__ __forceinline__ void tile_to_lds(const TileD& d, const f32x4 (&R)[16], float* scr, int lane) {
    const int rs = d.mode ? 3 : 4, kr = lane >> rs, cc = 4 * (lane & ((1 << rs) - 1)), kstep = 64 >> rs, P = d.mode ? 33 : 65;
#pragma unroll
    for (int i = 0; i < 16; ++i) { float* s = scr + (kstep * i + kr) * P + cc; s[0] = R[i].x * d.scale; s[1] = R[i].y * d.scale; s[2] = R[i].z * d.scale; s[3] = R[i].w * d.scale; }
}
__device__ __forceinline__ void tile_finish(const TileD& d, const float* scr, int lane) {
    if (d.mode == 0) {
        const int c = lane & 7;
#pragma unroll
        for (int j = 0; j < 8; ++j) { const int n = (lane >> 3) + 8 * j; const float* s = scr + (8 * c) * 65 + n;
            u32x4 o; o.x = pk2(s[0], s[65]); o.y = pk2(s[130], s[195]); o.z = pk2(s[260], s[325]); o.w = pk2(s[390], s[455]);
            __builtin_nontemporal_store(o, (u32x4*)(d.dst + (size_t)n * d.rp + 16 * c)); }
    } else {
        const int c = lane & 7; const float* s0 = scr + (16 * c) * 33 + (lane >> 3);
        float v[4][16];
#pragma unroll
        for (int j = 0; j < 4; ++j)
#pragma unroll
            for (int t = 0; t < 16; ++t) v[j][t] = s0[8 * j + 33 * t];
#pragma unroll
        for (int j = 0; j < 4; ++j) { const int n = (lane >> 3) + 8 * j;
            u32x4 o; o.x = pk8(v[j][0], v[j][1], v[j][2], v[j][3]); o.y = pk8(v[j][4], v[j][5], v[j][6], v[j][7]); o.z = pk8(v[j][8], v[j][9], v[j][10], v[j][11]); o.w = pk8(v[j][12], v[j][13], v[j][14], v[j][15]);
            __builtin_nontemporal_store(o, (u32x4*)(d.dst + (size_t)n * d.rp + 16 * c)); }
    }
}
__device__ __forceinline__ void p0_tables(CArgs& A, const Frame& F) {
    if (F.bid < 192) {
        float* sc = (float*)F.lds;
        float* red = sc + 8192;
        for (int i = F.tid; i < 8192; i += 512) sc[i] = siluf_(A.in[I_C][i]);
        __syncthreads();
        const int l = F.bid / 96;
        const float* wb = A.in[I_ADAW] + (size_t)l * 1024 * 6144 + (F.bid % 96) * 64;
        float a[8];
#pragma unroll
        for (int b = 0; b < 8; ++b) a[b] = 0.f;
#pragma unroll 1
        for (int kb = 128 * F.wave; kb < 128 * F.wave + 128; kb += 32) { float wv[32];
#pragma unroll
            for (int t = 0; t < 32; ++t) { unsigned vo_ = 4u * (unsigned)F.lane; asm volatile("" : "+v"(vo_));
                wv[t] = __builtin_nontemporal_load((const float*)((const char*)(wb + (size_t)(kb + t) * 6144) + vo_)); }
#pragma unroll
            for (int t = 0; t < 32; ++t)
#pragma unroll
                for (int b = 0; b < 8; ++b) a[b] += sc[b * 1024 + kb + t] * wv[t]; }
#pragma unroll
        for (int b = 0; b < 8; ++b) red[(F.wave * 8 + b) * 64 + F.lane] = a[b];
        __syncthreads();
        { const int b = F.tid >> 6, ln = F.tid & 63; float s = 0.f;
#pragma unroll
          for (int w8 = 0; w8 < 8; ++w8) s += red[(w8 * 8 + b) * 64 + ln];
          const int nn = (F.bid % 96) * 64 + ln; __hip_atomic_store(P_MOD + (size_t)(l * 8 + b) * 6144 + nn, s + A.in[I_ADAB][l * 6144 + nn], __ATOMIC_RELAXED, __HIP_MEMORY_SCOPE_AGENT); }
    }
    {
        const int gt = F.bid * 512 + F.tid;
        if (gt < 32 * 64) {
            const int g = gt >> 6;
            const float lr = A.in[I_LAMRE][gt], li = A.in[I_LAMIM][gt], dt = expf(A.in[I_LOGDT][g]);
            const float mag = expf(lr * dt); float sn, cs; sincosf(li * dt, &sn, &cs);
            const float are = mag * cs, aim = mag * sn, den = lr * lr + li * li, nre = are - 1.f, nim = aim;
            const float zre = (nre * lr + nim * li) / den, zim = (nim * lr - nre * li) / den;
            P_S5A[gt * 2] = are; P_S5A[gt * 2 + 1] = aim;
            for (int c = 0; c < 16; ++c) { const float br = A.in[I_BRE][gt * 16 + c], bi = A.in[I_BIM][gt * 16 + c];
                P_S5BB[gt * 32 + c] = zre * br - zim * bi; P_S5BB[gt * 32 + 16 + c] = zre * bi + zim * br; }
        }
        for (int i = gt; i < 32 * 16 * 128; i += F.G * 512) { const int k = i & 127, gc = i >> 7, pp = k >> 1; const float v = (k & 1) ? -A.in[I_CIM][gc * 64 + pp] : A.in[I_CRE][gc * 64 + pp]; P_S5CK[i] = (bf16_t)f2bf(v); }
        for (int i = gt; i < 24 * 1024; i += F.G * 512) { const int o = i >> 10, k = i & 1023; P_WSIDE[i] = o < 8 ? A.in[I_EVWIN][(size_t)k * 2056 + 2048 + o] : A.in[I_ODWIN][(size_t)k * 3600 + 3072 + (o - 8)]; }
        for (int i = gt; i < SEQ * 64; i += F.G * 512) { const int pos = i >> 6, j = i & 63;
            const float inv = exp2f(-(float)j * (13.287712379549449f / 64.f)); const float ang = (float)pos * inv; float sn, cs; sincosf(ang, &sn, &cs);
            P_ROPE[i] = cs; P_ROPE[SEQ * 64 + i] = sn; }
    }
}
__device__ __forceinline__ void p0_tiles(CArgs& A, const Frame& F, int k0, int k1) {
    float* scr = (float*)(F.lds) + F.wave * (128 * 33);
    const int gw = F.bid * 8 + F.wave, NGW = F.G * 8;
    TileD d0, d1; f32x4 R0[16], R1[16];
    d0.src = nullptr; d0.dst = nullptr; d0.pitch = 0; d0.rp = 0; d0.mode = 0; d0.scale = 1.f; d1 = d0;
    const int iend_ = (gw + k1 * NGW) < P0_NTILES ? (gw + k1 * NGW) : P0_NTILES;
    int i0 = gw + k0 * NGW, i1 = i0 + NGW;
    if (i0 < iend_) { tile_decode(A, i0, d0); tile_load(d0, R0, F.lane); }
    if (i1 < iend_) { tile_decode(A, i1, d1); tile_load(d1, R1, F.lane); }
#define P0_STEP(dd, RR, ii) do { const TileD cur_ = dd; tile_to_lds(cur_, RR, scr, F.lane); ii += 2 * NGW; \
        if (ii < iend_) { tile_decode(A, ii, dd); tile_load(dd, RR, F.lane); } \
        asm volatile("" ::: "memory");                   \
        LDS_WAIT(); tile_finish(cur_, scr, F.lane); LDS_WAIT(); } while (0)
#pragma unroll 1
    while (i0 < iend_) {
        P0_STEP(d0, R0, i0);
        if (i1 >= iend_) break;
        P0_STEP(d1, R1, i1);
    }
#undef P0_STEP
}

struct Row { f32x4 v[4]; };
__device__ __forceinline__ void row_load(Row& r, const float* p, int lane) {
#pragma unroll
    for (int j = 0; j < 4; ++j) r.v[j] = __builtin_nontemporal_load((const f32x4*)(p + 4 * lane + 256 * j));
}
__device__ __forceinline__ void row_load_bf16(Row& r, const bf16_t* p, int lane) {
#pragma unroll
    for (int j = 0; j < 4; ++j) { const u32x2 w = __builtin_nontemporal_load((const u32x2*)(p + 4 * lane + 256 * j)); r.v[j] = (f32x4){bflo(w.x), bfhi(w.x), bflo(w.y), bfhi(w.y)}; }
}
__device__ __forceinline__ void row_store(const Row& r, float* p, int lane) {
#pragma unroll
    for (int j = 0; j < 4; ++j) __builtin_nontemporal_store(r.v[j], (f32x4*)(p + 4 * lane + 256 * j));
}
__device__ __forceinline__ void row_store_bf16(const Row& r, bf16_t* p, int lane) {
#pragma unroll
    for (int j = 0; j < 4; ++j) { u32x2 w; w.x = pk2(r.v[j].x, r.v[j].y); w.y = pk2(r.v[j].z, r.v[j].w); *(u32x2*)(p + 4 * lane + 256 * j) = w; }
}
__device__ __forceinline__ void row_store_bf16_nt(const Row& r, bf16_t* p, int lane) {
#pragma unroll
    for (int j = 0; j < 4; ++j) { u32x2 w; w.x = pk2(r.v[j].x, r.v[j].y); w.y = pk2(r.v[j].z, r.v[j].w); __builtin_nontemporal_store(w, (u32x2*)(p + 4 * lane + 256 * j)); }
}
__device__ __forceinline__ float row_rstd(const Row& r) {
    float s = 0.f;
#pragma unroll
    for (int j = 0; j < 4; ++j) s += (r.v[j].x * r.v[j].x + r.v[j].y * r.v[j].y) + (r.v[j].z * r.v[j].z + r.v[j].w * r.v[j].w);
    return rsqrtf(wave_sum(s) * (1.f / DM) + EPS);
}
__device__ __forceinline__ void row_modnorm(Row& h, const Row& x, const float* gain, const float* sh, const float* sc, int lane) {
    const float r = row_rstd(x);
#pragma unroll
    for (int j = 0; j < 4; ++j) { const int k = 4 * lane + 256 * j; const f32x4 g = *(const f32x4*)(gain + k), a = *(const f32x4*)(sc + k), b = *(const f32x4*)(sh + k);
        h.v[j] = x.v[j] * r * g * (a + 1.f) + b; }
}
__device__ __forceinline__ void hprep_row(CArgs& A, const Frame& F, const Row& x, int l, int row, const float* wl) {
    const int b = row >> 11, lane = F.lane; const float* mod = P_MOD + (size_t)(l * 8 + b) * 6144;
    Row h; row_modnorm(h, x, A.in[I_NPM] + l * DM, mod, mod + 1024, lane);
    if (l == 0) row_store_bf16(h, (bf16_t*)P_HB + (size_t)row * DM, lane);
    else {
#pragma unroll
        for (int j = 0; j < 4; ++j) *(unsigned*)(P_HB + (size_t)row * DM + 4 * lane + 256 * j) = pk8(SC_H * h.v[j].x, SC_H * h.v[j].y, SC_H * h.v[j].z, SC_H * h.v[j].w);
    }
    if (l == 0) {
        float mine = 0.f;
#pragma unroll
        for (int i = 0; i < 8; ++i) { float p = 0.f;
#pragma unroll
            for (int j = 0; j < 4; ++j) { const f32x4 w = *(const f32x4*)(wl + i * 1024 + 4 * lane + 256 * j); p += (h.v[j].x * w.x + h.v[j].y * w.y) + (h.v[j].z * w.z + h.v[j].w * w.w); }
            const float s = wave_sum(p); if (lane == i) mine = s; if ((i & 3) == 3) asm volatile("" ::: "memory"); }
        if (lane < 8) P_LSIG[(size_t)row * 8 + lane] = log_sigmoidf_(mine + A.in[I_FOXB][lane]);
    } else {
        float p[16];
#pragma unroll
        for (int i = 0; i < 16; ++i) { float q = 0.f;
#pragma unroll
            for (int j = 0; j < 4; ++j) { const f32x4 w = *(const f32x4*)(wl + i * 1024 + 4 * lane + 256 * j); q += (h.v[j].x * w.x + h.v[j].y * w.y) + (h.v[j].z * w.z + h.v[j].w * w.w); }
            p[i] = wave_sum(q); if ((i & 1) == 1) asm volatile("" ::: "memory"); }
        const float* wup = wl + 16 * 1024;
#pragma unroll
        for (int q = 0; q < 4; ++q) { const int jcol = lane + 64 * q; float s = wup[16 * 256 + jcol];
#pragma unroll
            for (int i = 0; i < 16; ++i) s += p[i] * wup[i * 256 + jcol];
            P_LOGA[(size_t)row * 256 + jcol] = log_sigmoidf_(s) * (1.f / 16.f); }
    }
}
__device__ __forceinline__ void stage_side(CArgs& A, const Frame& F, int l, float* wl) {
    __syncthreads();
    if (l == 0) { for (int i = F.tid; i < 8 * 256; i += 512) *(f32x4*)(wl + 4 * i) = *(const f32x4*)(P_WSIDE + 4 * i); }
    else { for (int i = F.tid; i < 16 * 256; i += 512) *(f32x4*)(wl + 4 * i) = *(const f32x4*)(P_WSIDE + 8192 + 4 * i);
           for (int i = F.tid; i < 16 * 64; i += 512) *(f32x4*)(wl + 16384 + 4 * i) = *(const f32x4*)(A.in[I_GLAWUP] + 4 * i);
           if (F.tid < 64) *(f32x4*)(wl + 16384 + 4096 + 4 * F.tid) = *(const f32x4*)(A.in[I_GLABG] + 4 * F.tid); }
    __syncthreads();
}
__device__ __forceinline__ void p1_hprep0(CArgs& A, const Frame& F) {
    float* wl = (float*)F.lds; stage_side(A, F, 0, wl);
    const int gw = F.bid * 8 + F.wave, NGW = F.G * 8;
    Row xn; if (gw < NTOK) row_load(xn, A.in[I_X] + (size_t)gw * DM, F.lane);
#pragma unroll 1
    for (int row = gw; row < NTOK; row += NGW) { Row x;
#pragma unroll
        for (int j = 0; j < 4; ++j) x.v[j] = xn.v[j];
        if (row + NGW < NTOK) row_load(xn, A.in[I_X] + (size_t)(row + NGW) * DM, F.lane); hprep_row(A, F, x, 0, row, wl); }
}

__device__ __forceinline__ void p_postmix(CArgs& A, const Frame& F, int l) {
    float* h2s = (float*)F.lds;
    float* red = h2s + 16 * 1028;
    float* lg = red + 8 * 16 * 32;
    float* tv = lg + 16 * 32;
    int* lcnt = (int*)(tv + 64);
    int* ent = lcnt + 64;
    if (F.tid < 32) lcnt[F.tid] = 0;
    int nent = 0;
    const float* rw = A.in[I_RW] + (size_t)l * 1024 * 32;
    u32x2 pm[2][4]; f32x4 pxf[2][4]; u32x2 pxb[2][4];
#define PM_LOAD(tile_) do { const int r0_ = (tile_) * 16 + 2 * F.wave; _Pragma("unroll") for (int rr = 0; rr < 2; ++rr) _Pragma("unroll") for (int j = 0; j < 4; ++j) { \
        pm[rr][j] = __builtin_nontemporal_load((const u32x2*)((const bf16_t*)P_MBUF + (size_t)(r0_ + rr) * DM + 4 * F.lane + 256 * j)); \
        if (l == 0) pxf[rr][j] = __builtin_nontemporal_load((const f32x4*)(A.in[I_X] + (size_t)(r0_ + rr) * DM + 4 * F.lane + 256 * j)); \
        else pxb[rr][j] = __builtin_nontemporal_load((const u32x2*)(P_XB + (size_t)(r0_ + rr) * DM + 4 * F.lane + 256 * j)); } } while (0)
    if (F.bid < NTOK / 16) PM_LOAD(F.bid);
#pragma unroll 1
    for (int tile = F.bid; tile < NTOK / 16; tile += F.G) {
        const int row0 = tile * 16 + 2 * F.wave;
        Row m0, x0, m1, x1;
#pragma unroll
        for (int j = 0; j < 4; ++j) { m0.v[j] = (f32x4){bflo(pm[0][j].x), bfhi(pm[0][j].x), bflo(pm[0][j].y), bfhi(pm[0][j].y)}; m1.v[j] = (f32x4){bflo(pm[1][j].x), bfhi(pm[1][j].x), bflo(pm[1][j].y), bfhi(pm[1][j].y)};
            if (l == 0) { x0.v[j] = pxf[0][j]; x1.v[j] = pxf[1][j]; }
            else { x0.v[j] = (f32x4){bflo(pxb[0][j].x), bfhi(pxb[0][j].x), bflo(pxb[0][j].y), bfhi(pxb[0][j].y)}; x1.v[j] = (f32x4){bflo(pxb[1][j].x), bfhi(pxb[1][j].x), bflo(pxb[1][j].y), bfhi(pxb[1][j].y)}; } }
        if (tile + F.G < NTOK / 16) PM_LOAD(tile + F.G);
#pragma unroll
        for (int rr = 0; rr < 2; ++rr) {
            const int lr = 2 * F.wave + rr, row = row0 + rr, b = row >> 11; const float* mod = P_MOD + (size_t)(l * 8 + b) * 6144;
            const Row& m = rr ? m1 : m0; Row x = rr ? x1 : x0;
            const float r1 = row_rstd(m);
#pragma unroll
            for (int j = 0; j < 4; ++j) { const int k = 4 * F.lane + 256 * j; const f32x4 gp = *(const f32x4*)(A.in[I_NQM] + l * DM + k), g1 = *(const f32x4*)(mod + 2048 + k);
                x.v[j] = x.v[j] + g1 * (m.v[j] * r1 * gp); }
            row_store_bf16_nt(x, P_XB + (size_t)row * DM, F.lane);
            Row h; row_modnorm(h, x, A.in[I_NPF] + l * DM, mod + 3072, mod + 4096, F.lane);
#pragma unroll
            for (int j = 0; j < 4; ++j) *(unsigned*)(P_HB8 + (size_t)row * DM + 4 * F.lane + 256 * j) = pk8(SC_H * h.v[j].x, SC_H * h.v[j].y, SC_H * h.v[j].z, SC_H * h.v[j].w);
#pragma unroll
            for (int j = 0; j < 4; ++j) *(f32x4*)(h2s + lr * 1028 + 4 * F.lane + 256 * j) = h.v[j];
        }
        __syncthreads();
        {
            f32x4 d0 = {0.f, 0.f, 0.f, 0.f}, d1 = {0.f, 0.f, 0.f, 0.f};
            const int r16 = F.lane & 15, kq = F.lane >> 4;
#pragma unroll 8
            for (int ks = 0; ks < 32; ++ks) { const int k = 128 * F.wave + 4 * ks + kq;
                const float a = h2s[r16 * 1028 + k]; const float b0 = rw[k * 32 + r16], b1 = rw[k * 32 + 16 + r16];
                d0 = __builtin_amdgcn_mfma_f32_16x16x4f32(a, b0, d0, 0, 0, 0); d1 = __builtin_amdgcn_mfma_f32_16x16x4f32(a, b1, d1, 0, 0, 0); }
#pragma unroll
            for (int q = 0; q < 4; ++q) { red[(F.wave * 16 + 4 * kq + q) * 32 + r16] = d0[q]; red[(F.wave * 16 + 4 * kq + q) * 32 + 16 + r16] = d1[q]; }
        }
        __syncthreads();
        const int r = F.tid >> 5, e = F.tid & 31;
        { float s = A.in[I_RB][l * 32 + e];
#pragma unroll
          for (int w8 = 0; w8 < 8; ++w8) s += red[(w8 * 16 + r) * 32 + e];
          lg[r * 32 + e] = s; }
        __syncthreads();
        const float v = lg[r * 32 + e]; int rank = 0;
#pragma unroll 8
        for (int q = 0; q < 32; ++q) { const float u = lg[r * 32 + q]; rank += (u > v || (u == v && q < e)) ? 1 : 0; }
        if (rank < 4) tv[r * 4 + rank] = v;
        __syncthreads();
        if (rank < 4) { const f32x4 t4 = *(const f32x4*)(tv + r * 4);
            const float wsum = 1.f + __expf(t4.y - t4.x) + __expf(t4.z - t4.x) + __expf(t4.w - t4.x), wk = __expf(v - t4.x);
            const int token = tile * 16 + r, lpos = atomicAdd(lcnt + e, 1), slot = nent + r * 4 + rank;
            ent[slot * 4] = e; ent[slot * 4 + 1] = lpos; ent[slot * 4 + 2] = token * 4 + rank; ent[slot * 4 + 3] = __float_as_int(wk / wsum); }
        nent += 64;
        __syncthreads();
    }
#undef PM_LOAD
    unsigned* cntp = P_CNT; int* ltk = P_LTK; float* lgp = P_LG;
    if (F.tid < 32) { const int n = lcnt[F.tid]; lcnt[32 + F.tid] = n > 0 ? (int)atomicAdd(cntp + 64 * (l * 32 + F.tid), (unsigned)n) : 0; }
    __syncthreads();
    if (F.tid < nent) { const int e = ent[F.tid * 4], pos = lcnt[32 + e] + ent[F.tid * 4 + 1];
        ltk[(size_t)(l * 32 + e) * LISTCAP + pos] = ent[F.tid * 4 + 2]; lgp[(size_t)(l * 32 + e) * LISTCAP + pos] = __int_as_float(ent[F.tid * 4 + 3]); }
    __syncthreads();
}
__device__ __forceinline__ void p_combine(CArgs& A, const Frame& F, int l) {
    float* wl = (float*)F.lds; if (l == 0) stage_side(A, F, 1, wl);
    const int gw = F.bid * 8 + F.wave, NGW = F.G * 8;
    unsigned yA[4][4], yB[4][4]; u32x2 xA[4], xB[4];
#define COMB_LOAD(Y, X, row_) do { _Pragma("unroll") for (int k = 0; k < 4; ++k) _Pragma("unroll") for (int j = 0; j < 4; ++j) Y[k][j] = __builtin_nontemporal_load((const unsigned*)(P_Y + (size_t)((row_) * 4 + k) * DM + 4 * F.lane + 256 * j)); \
        _Pragma("unroll") for (int j = 0; j < 4; ++j) X[j] = __builtin_nontemporal_load((const u32x2*)(P_XB + (size_t)(row_) * DM + 4 * F.lane + 256 * j)); } while (0)
#define COMB_ROW(Y, X, row_, next_) do { const int row = (row_); const int b = row >> 11; const float* mod = P_MOD + (size_t)(l * 8 + b) * 6144; \
        Row f, x; \
        _Pragma("unroll") for (int j = 0; j < 4; ++j) { f.v[j] = (f32x4){0.f, 0.f, 0.f, 0.f}; \
            _Pragma("unroll") for (int k = 0; k < 4; ++k) { const f32x2 lo = __builtin_amdgcn_cvt_pk_f32_fp8((int)Y[k][j], false), hi = __builtin_amdgcn_cvt_pk_f32_fp8((int)Y[k][j], true); f.v[j].x += lo.x; f.v[j].y += lo.y; f.v[j].z += hi.x; f.v[j].w += hi.y; } \
            f.v[j] = f.v[j] * (1.f / SC_Y); x.v[j] = (f32x4){bflo(X[j].x), bfhi(X[j].x), bflo(X[j].y), bfhi(X[j].y)}; } \
        if ((next_) < NTOK) COMB_LOAD(Y, X, (next_));             \
        const float r = row_rstd(f); \
        _Pragma("unroll") for (int j = 0; j < 4; ++j) { const int k = 4 * F.lane + 256 * j; const f32x4 gp = *(const f32x4*)(A.in[I_NQF] + l * DM + k), g2 = *(const f32x4*)(mod + 5120 + k); \
            x.v[j] = x.v[j] + g2 * (f.v[j] * r * gp); } \
        if (l == 0) row_store_bf16_nt(x, P_XB + (size_t)row * DM, F.lane); else row_store(x, A.out + (size_t)row * DM, F.lane); \
        if (l == 0) hprep_row(A, F, x, 1, row, wl); } while (0)
    if (gw < NTOK) COMB_LOAD(yA, xA, gw);
    if (gw + NGW < NTOK) COMB_LOAD(yB, xB, gw + NGW);
#pragma unroll 1
    for (int r0 = gw; r0 < NTOK; r0 += 2 * NGW) {
        COMB_ROW(yA, xA, r0, r0 + 2 * NGW);
        if (r0 + NGW < NTOK) COMB_ROW(yB, xB, r0 + NGW, r0 + 3 * NGW);
    }
#undef COMB_ROW
#undef COMB_LOAD
}
__device__ __forceinline__ int moe_tables(CArgs& A, const Frame& F, int l, LAS pg8::MoeTables* tb) {
    __syncthreads();
    if (F.tid < 32) tb->cnt[F.tid] = (int)__hip_atomic_load(P_CNT + 64 * (l * 32 + F.tid), __ATOMIC_RELAXED, __HIP_MEMORY_SCOPE_AGENT);
    __syncthreads();
    if (F.tid == 0) { int s = 0;
#pragma nounroll
        for (int e = 0; e < 32; ++e) { tb->mtstart[e] = s; s += (tb->cnt[e] + 255) >> 8; }
        tb->mtstart[32] = s; }
    __syncthreads();
    if (F.tid < 320) { int e = 0;
#pragma nounroll
        for (int q = 1; q < 32; ++q) if (tb->mtstart[q] <= F.tid) e = q;
        tb->tile_e[F.tid] = (unsigned char)e; }
    __syncthreads();
    return tb->mtstart[32];
}
__device__ __forceinline__ void fox_kbias(CArgs& A, const Frame& F, int b, int h, float* kb, float* wtot  ) {
    const int t0 = 4 * F.tid; float e[4];
#pragma unroll
    for (int i = 0; i < 4; ++i) e[i] = P_LSIG[(size_t)(b * SEQ + t0 + i) * 8 + h];
    const float s4 = (e[0] + e[1]) + (e[2] + e[3]); float v = s4;
#pragma unroll
    for (int o = 1; o < 64; o <<= 1) { const float tt = __shfl_up(v, o); if (F.lane >= o) v += tt; }
    if (F.lane == 63) wtot[F.wave] = v;
    __syncthreads();
    float off = 0.f;
#pragma unroll
    for (int w = 0; w < 8; ++w) if (w < F.wave) off += wtot[w];
    float c = off + v - s4;
#pragma unroll
    for (int i = 0; i < 4; ++i) { c += e[i]; kb[t0 + i] = -LOG2E * c; }
    __syncthreads();
}
#include <hip/hip_bf16.h>
namespace attn_body {
using bf16=__hip_bfloat16;
using bf16x8=__attribute__((ext_vector_type(8)))short;
using s16x4=__attribute__((ext_vector_type(4)))short;
using f32x16=__attribute__((ext_vector_type(16)))float;
using u32x4=__attribute__((ext_vector_type(4)))unsigned;
constexpr int BATCH=8,NHEAD=8,SEQ=2048,D=64,QP=2048,OP=1024;
constexpr int NW=8,QBLK=32,QB=QBLK*NW,KVBLK=64,NQB=SEQ/QB;
constexpr int ATTN_UNIT_ROWS=QB;
__device__ __forceinline__ int crow(int r,int hi){return (r&3)+8*(r>>2)+4*hi;}
#define SBAR() __builtin_amdgcn_sched_barrier(0)
__device__ __forceinline__ void cmask(f32x16&p0,f32x16&p1,int jb,int qrel,int hi){
  const float NEG=-INFINITY; int kb=64*jb+4*hi;
  #pragma unroll
  for(int r=0;r<16;++r){int kv=kb+(r&3)+8*(r>>2); if(kv>qrel)p0[r]=NEG; if(kv+32>qrel)p1[r]=NEG;}
}

constexpr int NSLOT=3, SLOTB=8192;
constexpr int LDS_K=0, LDS_V=NSLOT*SLOTB, LDS_WS=2*NSLOT*SLOTB, LDS_OST=LDS_WS+NW*64*4, LDS_BYTES=LDS_OST+NW*4096;
constexpr float C2=0.125f*1.4426950408889634f;
__device__ __forceinline__ void glds16(const void*gsrc,unsigned lds_dst){unsigned keep;
  asm volatile("s_mov_b32 %0, m0\n\ts_mov_b32 m0, %2\n\ts_nop 0\n\tglobal_load_lds_dwordx4 %1, off\n\ts_mov_b32 m0, %0":"=&s"(keep):"v"(gsrc),"s"(lds_dst):"memory");}
__device__ __forceinline__ float max3f(float a,float b,float c){float r;asm("v_max3_f32 %0, %1, %2, %3":"=v"(r):"v"(a),"v"(b),"v"(c));return r;}
__device__ __forceinline__ float max2f(float a,float b){float r;asm("v_max_f32_e32 %0, %1, %2":"=v"(r):"v"(a),"v"(b));return r;}
__device__ __forceinline__ float fadd_s(float a,float b){float r;asm("v_add_f32_e32 %0, %1, %2":"=v"(r):"v"(a),"v"(b));return r;}
__device__ __forceinline__ float fsub_s(float a,float b){float r;asm("v_sub_f32_e32 %0, %1, %2":"=v"(r):"v"(a),"v"(b));return r;}
typedef float f32x2_t __attribute__((ext_vector_type(2))); typedef float f32x4_t __attribute__((ext_vector_type(4))); typedef __bf16 bf16x2_t __attribute__((ext_vector_type(2)));
__device__ __forceinline__ unsigned cvtpk_s(float lo,float hi){f32x2_t v={lo,hi};bf16x2_t b=__builtin_convertvector(v,bf16x2_t);return __builtin_bit_cast(unsigned,b);}
#define WAIT_BAR(N) asm volatile("s_waitcnt vmcnt(" #N ") lgkmcnt(0)\n\ts_barrier":::"memory")

__device__ __forceinline__ void qkt(f32x16&p0,f32x16&p1,const char*Kslot,const bf16x8*qr,const f32x16&c0i,const f32x16&c1i,int r32,int hi){
  const char*kb=Kslot+hi*1024+r32*16;
  #pragma unroll
  for(int d0=0;d0<4;++d0){
    const bf16x8 b0=*reinterpret_cast<const bf16x8*>(kb+d0*2048);
    const bf16x8 b1=*reinterpret_cast<const bf16x8*>(kb+d0*2048+512);
    if(d0==0){p0=__builtin_amdgcn_mfma_f32_32x32x16_bf16(b0,qr[0],c0i,0,0,0);p1=__builtin_amdgcn_mfma_f32_32x32x16_bf16(b1,qr[0],c1i,0,0,0);}
    else{p0=__builtin_amdgcn_mfma_f32_32x32x16_bf16(b0,qr[d0],p0,0,0,0);p1=__builtin_amdgcn_mfma_f32_32x32x16_bf16(b1,qr[d0],p1,0,0,0);}}
}
typedef __attribute__((address_space(3))) const char* lds_cptr;
typedef short v4i16_t __attribute__((ext_vector_type(4)));
__device__ __forceinline__ void kload8(bf16x8*kf,lds_cptr kp){
  kf[0]=*(const __attribute__((address_space(3))) bf16x8*)(kp);      kf[1]=*(const __attribute__((address_space(3))) bf16x8*)(kp+512);
  kf[2]=*(const __attribute__((address_space(3))) bf16x8*)(kp+2048); kf[3]=*(const __attribute__((address_space(3))) bf16x8*)(kp+2560);
  kf[4]=*(const __attribute__((address_space(3))) bf16x8*)(kp+4096); kf[5]=*(const __attribute__((address_space(3))) bf16x8*)(kp+4608);
  kf[6]=*(const __attribute__((address_space(3))) bf16x8*)(kp+6144); kf[7]=*(const __attribute__((address_space(3))) bf16x8*)(kp+6656);
}
__device__ __forceinline__ void kload2(bf16x8*kf,lds_cptr kp,int j){ kf[2*j]=*(const __attribute__((address_space(3))) bf16x8*)(kp+j*2048); kf[2*j+1]=*(const __attribute__((address_space(3))) bf16x8*)(kp+j*2048+512); }
__device__ __forceinline__ s16x4 vtr(lds_cptr p){ return __builtin_bit_cast(s16x4,__builtin_amdgcn_ds_read_tr16_b64_v4i16((__attribute__((address_space(3))) v4i16_t*)p)); }
__device__ __forceinline__ float rowmax(const f32x16&p0,const f32x16&p1){
  float a=max3f(p0[0],p0[1],p1[0]),b=max3f(p0[2],p0[3],p1[1]);a=max3f(a,p1[2],p1[3]);
  #pragma unroll
  for(int r=4;r<16;r+=4){a=max3f(a,p0[r],p0[r+1]);b=max3f(b,p0[r+2],p0[r+3]);a=max3f(a,p1[r],p1[r+1]);b=max3f(b,p1[r+2],p1[r+3]);}
  const float m=max2f(a,b);
  auto rr=__builtin_amdgcn_permlane32_swap(__float_as_uint(m),__float_as_uint(m),false,false);
  return max2f(__uint_as_float(rr[0]),__uint_as_float(rr[1]));
}
__device__ __forceinline__ void pv(f32x16*o,int vb,bf16x8 pa0,bf16x8 pa1,bf16x8 pa2,bf16x8 pa3){
  #pragma unroll
  for(int d0=0;d0<2;++d0){s16x4 lo[4],hi[4];
    #pragma unroll
    for(int ks=0;ks<4;++ks){
      asm volatile("ds_read_b64_tr_b16 %0,%1 offset:%c2":"=&v"(lo[ks]):"v"(vb),"i"(d0*4096+ks*1024):"memory");
      asm volatile("ds_read_b64_tr_b16 %0,%1 offset:%c2":"=&v"(hi[ks]):"v"(vb),"i"(d0*4096+ks*1024+512):"memory");}
    asm volatile("s_waitcnt lgkmcnt(0)":::"memory");SBAR();
    #define PK(k) (bf16x8){lo[k][0],lo[k][1],lo[k][2],lo[k][3],hi[k][0],hi[k][1],hi[k][2],hi[k][3]}
    o[d0]=__builtin_amdgcn_mfma_f32_32x32x16_bf16(pa0,PK(0),o[d0],0,0,0);
    o[d0]=__builtin_amdgcn_mfma_f32_32x32x16_bf16(pa1,PK(1),o[d0],0,0,0);
    o[d0]=__builtin_amdgcn_mfma_f32_32x32x16_bf16(pa2,PK(2),o[d0],0,0,0);
    o[d0]=__builtin_amdgcn_mfma_f32_32x32x16_bf16(pa3,PK(3),o[d0],0,0,0);
    #undef PK
  }
}

#ifndef ATTN_STORE16
#define ATTN_STORE16(p,v) (*(u32x4*)(p)=(v))
#endif
typedef const __attribute__((address_space(3))) float* lds_fptr;
template<int THRL> __device__ __forceinline__ void attn_unit(int b,int h,int qb,const bf16*Q,const bf16*__restrict__ K,const bf16*__restrict__ V,bf16*O,char*shm,lds_fptr kb,int tid,int wid){
  const int lane=tid&63,r32=lane&31,hi=lane>>5;
  const long rowbase=(long)b*SEQ; const int q0=qb*QB;
  const bf16*Qw=Q+(rowbase+q0+wid*QBLK)*QP+h*D;
  const bf16*Kh=K+rowbase*QP+h*D,*Vh=V+rowbase*QP+h*D;
  const unsigned lds0=(unsigned)(uintptr_t)shm;
  float*wsf=(float*)(shm+LDS_WS)+wid*64;
  const bf16*ksrc=Kh+(long)lane*QP+wid*8;
  const bf16*vsrc=Vh+(long)(16*(wid&3)+(lane>>2))*QP+(wid>>2)*32+(lane&3)*8;
  const unsigned kdst=lds0+LDS_K+wid*1024, vdst=lds0+LDS_V+wid*1024;
  #define DMA_K(t,slot) glds16(ksrc+(long)(t)*KVBLK*QP,(unsigned)__builtin_amdgcn_readfirstlane(kdst+(slot)))
  #define DMA_V(t,slot) glds16(vsrc+(long)(t)*KVBLK*QP,(unsigned)__builtin_amdgcn_readfirstlane(vdst+(slot)))
  const int vb0=(int)(lds0+LDS_V)+((lane>>4)&1)*32+(lane&3)*8+(4*hi+((lane&15)>>2))*64;
  const char*Kbase=shm+LDS_K; bf16x8 kf[8];
  const lds_cptr shm3=(lds_cptr)shm; const lds_cptr kp0=shm3+LDS_K+hi*1024+r32*16; const lds_cptr vp0=shm3+LDS_V+((lane>>4)&1)*32+(lane&3)*8+(4*hi+((lane&15)>>2))*64;
  const int NT=(q0+QB)/KVBLK;
  DMA_K(0,0);DMA_V(0,0);DMA_K(1,SLOTB);
  bf16x8 qr[4];
  #pragma unroll
  for(int d0=0;d0<4;++d0)qr[d0]=*reinterpret_cast<const bf16x8*>(&Qw[(long)r32*QP+d0*16+hi*8]);
  float mhat=0.f,l_reg=0.f;f32x16 o[2];o[0]=f32x16{};o[1]=f32x16{};float nm=0.f;
  #define BIASFILL(C0,C1,t) do{ const lds_fptr kbt_=kb+64*(t)+4*hi; _Pragma("unroll") for(int g_=0;g_<4;++g_){ const f32x4_t v0_=*(const __attribute__((address_space(3))) f32x4_t*)(kbt_+8*g_), v1_=*(const __attribute__((address_space(3))) f32x4_t*)(kbt_+32+8*g_); \
      _Pragma("unroll") for(int i_=0;i_<4;++i_){ C0[4*g_+i_]=v0_[i_]+nm; C1[4*g_+i_]=v1_[i_]+nm; } } }while(0)
  const int qrel=wid*QBLK+r32;
  #define CMASK(P0,P1,t) do{int jb_=(t)-(NT-4); if(jb_>=0)cmask(P0,P1,jb_,qrel,hi);}while(0)
  bool resc=false;
  #define START(P0,P1) do{ const float rm=rowmax(P0,P1); resc=false; \
    { const float dl=rm; mhat=fadd_s(mhat,dl); \
      _Pragma("unroll") for(int r=0;r<16;++r){P0[r]=fsub_s(P0[r],dl);P1[r]=fsub_s(P1[r],dl);} \
      nm=-mhat; } \
    _Pragma("unroll") for(int r=0;r<16;++r)P0[r]=__builtin_amdgcn_exp2f(P0[r]); }while(0)
  #define RESC() do{ if(resc){ asm volatile("s_waitcnt lgkmcnt(0)":::"memory"); \
      _Pragma("unroll") for(int d_=0;d_<2;++d_) _Pragma("unroll") for(int r=0;r<16;++r)o[d_][r]*=wsf[crow(r,hi)]; } }while(0)
  f32x16 pA0,pA1,pB0,pB1;
  int sl_prev=0,sl_cur=0,sl_next=SLOTB;
  #define ROT() do{sl_prev=sl_cur;sl_cur=sl_next;sl_next=(sl_next==(NSLOT-1)*SLOTB)?0:sl_next+SLOTB;}while(0)
  DMA_K(2,2*SLOTB);
  WAIT_BAR(3);
  { f32x16 c0i,c1i; BIASFILL(c0i,c1i,0); qkt(pA0,pA1,Kbase,qr,c0i,c1i,r32,hi); }asm volatile("s_nop 15\n\ts_nop 7":"+v"(pA0),"+v"(pA1));CMASK(pA0,pA1,0);
  START(pA0,pA1);
  _Pragma("unroll") for(int r=0;r<16;++r)pA1[r]=__builtin_amdgcn_exp2f(pA1[r]);
  WAIT_BAR(0);
  DMA_K(3,0);DMA_V(1,SLOTB);
  ROT();
  kload8(kf,kp0+sl_cur);
  WAIT_BAR(2);
  s16x4 vlo[8],vhi[8]; u32x4 pw0,pw1,pw2,pw3;
  #define PKW(P,B) cvtpk_s(P[B],P[B+1])
  #define PAF(k) __builtin_bit_cast(bf16x8,pw##k)
  #define VFR(i) (bf16x8){vlo[i][0],vlo[i][1],vlo[i][2],vlo[i][3],vhi[i][0],vhi[i][1],vhi[i][2],vhi[i][3]}
  #define PIN(x) asm volatile("":"+v"(x))
  #define MX3(a,b,c) __builtin_fmaxf(__builtin_fmaxf((a),(b)),(c))
  #define GAPA(MF,A0,A1,A2,A3,W0,W1,PW) do{ MF; sacc+=A0; sacc+=A1; sacc+=A2; sacc+=A3; PIN(sacc); W0; W1; PIN(PW); SBAR(); }while(0)
  #define EX(v) __builtin_amdgcn_exp2f(v)
  #define GAPB(MF,X,B) do{ MF; X[B]=EX(X[B]); X[B+1]=EX(X[B+1]); X[B+2]=EX(X[B+2]); X[B+3]=EX(X[B+3]); PIN(X); SBAR(); }while(0)
  #define VRD(i) do{ vlo[i]=vtr(vp_+(((i)>>2)*4096+((i)&3)*1024)); vhi[i]=vtr(vp_+(((i)>>2)*4096+((i)&3)*1024+512)); }while(0)
  #define KRD(G,j) do{ if(G){ kload2(kf,kp0+sl_next,j); SBAR(); } }while(0)
  #define STEP(C0,C1,P0,P1,t,GK,GV,GL) do{ SBAR(); BIASFILL(C0,C1,t); SBAR(); \
    const lds_cptr vp_=vp0+sl_prev; \
    VRD(0); SBAR(); float sacc=(P0[0]+P0[1]); \
    GAPA(C0=__builtin_amdgcn_mfma_f32_32x32x16_bf16(kf[0],qr[0],C0,0,0,0), P0[2],P0[3],P0[4],P0[5],     pw0[0]=PKW(P0,0), pw0[1]=PKW(P0,2), pw0); \
    VRD(4); SBAR(); GAPA(C1=__builtin_amdgcn_mfma_f32_32x32x16_bf16(kf[1],qr[0],C1,0,0,0), P0[6],P0[7],P0[8],P0[9],     pw0[2]=PKW(P0,4), pw0[3]=PKW(P0,6), pw0); \
    VRD(1); SBAR(); GAPA(C0=__builtin_amdgcn_mfma_f32_32x32x16_bf16(kf[2],qr[1],C0,0,0,0),   P0[10],P0[11],P0[12],P0[13], pw1[0]=PKW(P0,8), pw1[1]=PKW(P0,10), pw1); \
    VRD(5); SBAR(); GAPA(C1=__builtin_amdgcn_mfma_f32_32x32x16_bf16(kf[3],qr[1],C1,0,0,0),   P0[14],P0[15],P1[0],P1[1],   pw1[2]=PKW(P0,12),pw1[3]=PKW(P0,14), pw1); \
    VRD(2); SBAR(); GAPA(C0=__builtin_amdgcn_mfma_f32_32x32x16_bf16(kf[4],qr[2],C0,0,0,0),   P1[2],P1[3],P1[4],P1[5],     pw2[0]=PKW(P1,0), pw2[1]=PKW(P1,2), pw2); \
    VRD(6); SBAR(); GAPA(C1=__builtin_amdgcn_mfma_f32_32x32x16_bf16(kf[5],qr[2],C1,0,0,0),   P1[6],P1[7],P1[8],P1[9],     pw2[2]=PKW(P1,4), pw2[3]=PKW(P1,6), pw2); \
    VRD(3); SBAR(); GAPA(C0=__builtin_amdgcn_mfma_f32_32x32x16_bf16(kf[6],qr[3],C0,0,0,0),   P1[10],P1[11],P1[12],P1[13], pw3[0]=PKW(P1,8), pw3[1]=PKW(P1,10), pw3); \
    VRD(7); SBAR(); GAPA(C1=__builtin_amdgcn_mfma_f32_32x32x16_bf16(kf[7],qr[3],C1,0,0,0),   P1[14],P1[15],0.f,0.f,       pw3[2]=PKW(P1,12),pw3[3]=PKW(P1,14), pw3); \
    l_reg+=sacc; \
    if(GK){DMA_K((t)+3,sl_cur);} if(GV){DMA_V((t)+1,sl_next);} \
    CMASK(C0,C1,t); \
    { float a=MX3(C0[0],C0[1],C1[0]),b=MX3(C0[2],C0[3],C1[1]); a=MX3(a,C1[2],C1[3]); \
      _Pragma("unroll") for(int r=4;r<16;r+=4){a=MX3(a,C0[r],C0[r+1]);b=MX3(b,C0[r+2],C0[r+3]);a=MX3(a,C1[r],C1[r+1]);b=MX3(b,C1[r+2],C1[r+3]);} \
      float rm=__builtin_fmaxf(a,b); { auto rr=__builtin_amdgcn_permlane32_swap(__float_as_uint(rm),__float_as_uint(rm),false,false); rm=__builtin_fmaxf(__uint_as_float(rr[0]),__uint_as_float(rr[1])); } \
      resc=false; \
      if(__builtin_expect(__any(rm>(float)THRL),0)){ const float dl=__builtin_fmaxf(rm,0.f); mhat+=dl; \
        _Pragma("unroll") for(int r=0;r<16;++r){C0[r]-=dl;C1[r]-=dl;} \
        nm=-mhat; \
        const float f=__builtin_amdgcn_exp2f(-dl); l_reg*=f; if(hi==0)wsf[r32]=f; resc=true; } } \
    SBAR(); \
    GAPB(o[0]=__builtin_amdgcn_mfma_f32_32x32x16_bf16(PAF(0),VFR(0),o[0],0,0,0), C0,0); \
    GAPB(o[1]=__builtin_amdgcn_mfma_f32_32x32x16_bf16(PAF(0),VFR(4),o[1],0,0,0), C0,4); \
    KRD(GL,0); GAPB(o[0]=__builtin_amdgcn_mfma_f32_32x32x16_bf16(PAF(1),VFR(1),o[0],0,0,0), C0,8); \
    KRD(GL,1); GAPB(o[1]=__builtin_amdgcn_mfma_f32_32x32x16_bf16(PAF(1),VFR(5),o[1],0,0,0), C0,12); \
    KRD(GL,2); GAPB(o[0]=__builtin_amdgcn_mfma_f32_32x32x16_bf16(PAF(2),VFR(2),o[0],0,0,0), C1,0); \
    KRD(GL,3); GAPB(o[1]=__builtin_amdgcn_mfma_f32_32x32x16_bf16(PAF(2),VFR(6),o[1],0,0,0), C1,4); \
    GAPB(o[0]=__builtin_amdgcn_mfma_f32_32x32x16_bf16(PAF(3),VFR(3),o[0],0,0,0), C1,8); \
    GAPB(o[1]=__builtin_amdgcn_mfma_f32_32x32x16_bf16(PAF(3),VFR(7),o[1],0,0,0), C1,12); \
    }while(0)
  int t=1;
  #undef CMASK
  #define CMASK(P0,P1,t) do{}while(0)
  for(;t+5<NT;t+=2){
    STEP(pB0,pB1,pA0,pA1,t,true,true,true);     WAIT_BAR(2); RESC(); ROT();
    STEP(pA0,pA1,pB0,pB1,t+1,true,true,true);   WAIT_BAR(2); RESC(); ROT();
  }
  #undef CMASK
  #define CMASK(P0,P1,t) do{int jb_=(t)-(NT-4); if(jb_>=0)cmask(P0,P1,jb_,qrel,hi);}while(0)
  #define ENDW(tt) do{ if((tt)+3<NT){WAIT_BAR(2);} else if((tt)+2<NT){WAIT_BAR(1);} else {WAIT_BAR(0);} }while(0)
  for(;t+1<NT;t+=2){
    STEP(pB0,pB1,pA0,pA1,t,(t+3<NT),(t+1<NT),(t+1<NT));       ENDW(t);   RESC(); ROT();
    STEP(pA0,pA1,pB0,pB1,t+1,(t+4<NT),(t+2<NT),(t+2<NT));     ENDW(t+1); RESC(); ROT();
  }
  STEP(pB0,pB1,pA0,pA1,NT-1,false,false,false); RESC();
  { float sacc=pB0[0]+pB0[1]; _Pragma("unroll") for(int r=2;r<16;++r)sacc+=pB0[r]; _Pragma("unroll") for(int r=0;r<16;++r)sacc+=pB1[r]; l_reg+=sacc;
    pw0=(u32x4){PKW(pB0,0),PKW(pB0,2),PKW(pB0,4),PKW(pB0,6)};pw1=(u32x4){PKW(pB0,8),PKW(pB0,10),PKW(pB0,12),PKW(pB0,14)};pw2=(u32x4){PKW(pB1,0),PKW(pB1,2),PKW(pB1,4),PKW(pB1,6)};pw3=(u32x4){PKW(pB1,8),PKW(pB1,10),PKW(pB1,12),PKW(pB1,14)};
    SBAR(); pv(o,vb0+sl_cur,PAF(0),PAF(1),PAF(2),PAF(3)); }
  #undef PKW
  #undef PAF
  #undef VFR
  #undef PIN
  #undef MX3
  #undef GAPA
  #undef GAPB
  #undef EX
  #undef VRD
  #undef KRD
  #undef STEP
  #undef ENDW
  {auto rr=__builtin_amdgcn_permlane32_swap(__float_as_uint(l_reg),__float_as_uint(l_reg),false,false);l_reg=__uint_as_float(rr[0])+__uint_as_float(rr[1]);}
  if(hi==0)wsf[32+r32]=l_reg;asm volatile("s_waitcnt lgkmcnt(0)":::"memory");
  float rli[16];
  #pragma unroll
  for(int r=0;r<16;++r)rli[r]=__builtin_amdgcn_rcpf(wsf[32+crow(r,hi)]);
  bf16*Ow=O+(rowbase+q0+wid*QBLK)*OP+h*D;
  { bf16*stg=(bf16*)(shm+LDS_OST)+wid*2048;
    #pragma unroll
    for(int r=0;r<16;++r){const int orow=crow(r,hi);
      #pragma unroll
      for(int d0=0;d0<2;++d0)stg[orow*64+d0*32+r32]=__float2bfloat16(o[d0][r]*rli[r]);}
    asm volatile("s_waitcnt lgkmcnt(0)":::"memory");
    #pragma unroll
    for(int i=0;i<4;++i){const int row=i*8+(lane>>3),ch=lane&7; const u32x4 v=*(const u32x4*)(stg+row*64+ch*8); ATTN_STORE16(Ow+(long)row*OP+ch*8,v);} }
  asm volatile("s_waitcnt lgkmcnt(0)\n\ts_barrier":::"memory");
  #undef DMA_K
  #undef DMA_V
  #undef CMASK
  #undef START
  #undef RESC
  #undef ROT
  #undef BIASFILL
}
constexpr int ATTN_LDS_BYTES=LDS_BYTES;
#undef SBAR
#undef WAIT_BAR
}
__device__ __forceinline__ void fox_fast(CArgs& A, const Frame& F) {
    float* kb = (float*)(F.lds + 86016); float* wtot = kb + 2048;
    const int v = (F.bid & 7) * 32 + (F.bid >> 3), bh = v >> 2, s = v & 3, b = bh >> 3, h = bh & 7;
    fox_kbias(A, F, b, h, kb, wtot);
    const attn_body::bf16* Zb = (const attn_body::bf16*)P_Z;
    const attn_body::lds_fptr kb3 = (attn_body::lds_fptr)(const __attribute__((address_space(3))) unsigned char*)((LAS unsigned char*)F.lds + 86016);
    attn_body::attn_unit<8>(b, h, 7 - s, Zb + 512, Zb + 1024, Zb + 1536, (attn_body::bf16*)P_YCAT + 512, (char*)F.lds, kb3, F.tid, F.wave);
    attn_body::attn_unit<8>(b, h, s, Zb + 512, Zb + 1024, Zb + 1536, (attn_body::bf16*)P_YCAT + 512, (char*)F.lds, kb3, F.tid, F.wave);
}
typedef float f32x16 __attribute__((ext_vector_type(16)));
__device__ __forceinline__ bf16x8 pack8(const f32x4& a, const f32x4& b) { u32x4 w; w.x = pk2(a.x, a.y); w.y = pk2(a.z, a.w); w.z = pk2(b.x, b.y); w.w = pk2(b.z, b.w); return __builtin_bit_cast(bf16x8, w); }
__device__ __forceinline__ void s5_fast(CArgs& A, const Frame& F, int item) {
    const int b = item >> 5, g = item & 31, lane = F.lane, w = F.wave, p = lane & 31, hh = lane >> 5, l15 = lane & 15, l4 = lane >> 4;
    float* Eseg = (float*)F.lds; float* Hin = Eseg + 2048;
    bf16_t* Hs = (bf16_t*)(F.lds + 16384) + w * 4352;
    bf16x8 bbr[2], bbi[2]; float are[2], aim[2];
#pragma unroll
    for (int nt = 0; nt < 2; ++nt) { const float* q = P_S5BB + (size_t)(g * 64 + 32 * nt + p) * 32 + 8 * hh;
        bbr[nt] = pack8(*(const f32x4*)q, *(const f32x4*)(q + 4)); bbi[nt] = pack8(*(const f32x4*)(q + 16), *(const f32x4*)(q + 20));
        are[nt] = P_S5A[(g * 64 + 32 * nt + p) * 2]; aim[nt] = P_S5A[(g * 64 + 32 * nt + p) * 2 + 1]; }
    const int rr = lane & 31, ahalf = (rr >> 2) & 1, atau = (rr & 3) + 4 * (rr >> 3);
    const bf16_t* usrc = P_Z + (size_t)(b * SEQ + 128 * (2 * w + ahalf) + atau) * ZP0 + g * 16 + 8 * hh;
    const f32x16 zero16 = {0.f, 0.f, 0.f, 0.f, 0.f, 0.f, 0.f, 0.f, 0.f, 0.f, 0.f, 0.f, 0.f, 0.f, 0.f, 0.f};
    float hr[2] = {0.f, 0.f}, hi[2] = {0.f, 0.f};
#define S5_ALOAD(blk_) (*(const bf16x8*)(usrc + (size_t)(blk_) * 16 * ZP0))
    { bf16x8 a0 = S5_ALOAD(0), a1 = S5_ALOAD(1), a2 = S5_ALOAD(2);
#pragma unroll 1
      for (int blk = 0; blk < 8; ++blk) {
        const bf16x8 a = a0; a0 = a1; a1 = a2; if (blk + 3 < 8) a2 = S5_ALOAD(blk + 3);
#pragma unroll
        for (int nt = 0; nt < 2; ++nt) {
            const f32x16 dre = __builtin_amdgcn_mfma_f32_32x32x16_bf16(a, bbr[nt], zero16, 0, 0, 0), dim = __builtin_amdgcn_mfma_f32_32x32x16_bf16(a, bbi[nt], zero16, 0, 0, 0);
#pragma unroll
            for (int i = 0; i < 16; ++i) { const float nr = are[nt] * hr[nt] - aim[nt] * hi[nt] + dre[i], ni = are[nt] * hi[nt] + aim[nt] * hr[nt] + dim[i]; hr[nt] = nr; hi[nt] = ni; }
        }
      } }
#pragma unroll
    for (int nt = 0; nt < 2; ++nt) { Eseg[((2 * w + hh) * 64 + 32 * nt + p) * 2] = hr[nt]; Eseg[((2 * w + hh) * 64 + 32 * nt + p) * 2 + 1] = hi[nt]; }
    __syncthreads();
    if (w == 0) {
        float xr = P_S5A[(g * 64 + lane) * 2], xi = P_S5A[(g * 64 + lane) * 2 + 1];
#pragma unroll
        for (int q = 0; q < 7; ++q) { const float nr = xr * xr - xi * xi, ni = 2.f * xr * xi; xr = nr; xi = ni; }
        float Hr = 0.f, Hi = 0.f;
#pragma unroll 1
        for (int s = 0; s < 16; ++s) { Hin[(s * 64 + lane) * 2] = Hr; Hin[(s * 64 + lane) * 2 + 1] = Hi;
            const float er = Eseg[(s * 64 + lane) * 2], ei = Eseg[(s * 64 + lane) * 2 + 1]; const float nr = xr * Hr - xi * Hi + er, ni = xr * Hi + xi * Hr + ei; Hr = nr; Hi = ni; }
    }
    __syncthreads();
#pragma unroll
    for (int nt = 0; nt < 2; ++nt) { hr[nt] = Hin[((2 * w + hh) * 64 + 32 * nt + p) * 2]; hi[nt] = Hin[((2 * w + hh) * 64 + 32 * nt + p) * 2 + 1]; }
    bf16x8 ck[4];
#pragma unroll
    for (int ks = 0; ks < 4; ++ks) ck[ks] = *(const bf16x8*)(P_S5CK + (size_t)(g * 16 + l15) * 128 + 32 * ks + 8 * l4);
    const int er = lane >> 1, eh = lane & 1;
    float* Ys = (float*)(F.lds + 86016) + w * 640;
    f32x4 dk0 = *(const f32x4*)(A.in[I_S5D] + g * 16 + 8 * eh), dk1 = *(const f32x4*)(A.in[I_S5D] + g * 16 + 8 * eh + 4);
#define S5_EROW(blk_) ((size_t)(b * SEQ + 128 * (2 * w + (er >> 4)) + 16 * (blk_) + (er & 15)))
    bf16x8 a0 = S5_ALOAD(0), a1 = S5_ALOAD(1), a2 = S5_ALOAD(2);
    u32x4 un = *(const u32x4*)(P_Z + S5_EROW(0) * ZP0 + g * 16 + 8 * eh);
#pragma unroll 1
    for (int blk = 0; blk < 8; ++blk) {
        const bf16x8 a = a0; a0 = a1; a1 = a2; if (blk + 3 < 8) a2 = S5_ALOAD(blk + 3);
        const u32x4 us = un; if (blk + 1 < 8) un = *(const u32x4*)(P_Z + S5_EROW(blk + 1) * ZP0 + g * 16 + 8 * eh);
#pragma unroll
        for (int nt = 0; nt < 2; ++nt) {
            const f32x16 dre = __builtin_amdgcn_mfma_f32_32x32x16_bf16(a, bbr[nt], zero16, 0, 0, 0), dim = __builtin_amdgcn_mfma_f32_32x32x16_bf16(a, bbi[nt], zero16, 0, 0, 0);
#pragma unroll
            for (int i = 0; i < 16; ++i) { const float nr = are[nt] * hr[nt] - aim[nt] * hi[nt] + dre[i], ni = are[nt] * hi[nt] + aim[nt] * hr[nt] + dim[i]; hr[nt] = nr; hi[nt] = ni;
                *(unsigned*)(Hs + (hh * 16 + i) * 136 + 2 * (32 * nt + p)) = pk2(nr, ni); }
        }
        LDS_WAIT();
#pragma unroll
        for (int sg = 0; sg < 2; ++sg) {
            f32x4 y = {0.f, 0.f, 0.f, 0.f};
#pragma unroll
            for (int ks = 0; ks < 4; ++ks) { const bf16x8 af = *(const bf16x8*)(Hs + (sg * 16 + l15) * 136 + 32 * ks + 8 * l4); y = __builtin_amdgcn_mfma_f32_16x16x32_bf16(af, ck[ks], y, 0, 0, 0); }
#pragma unroll
            for (int q = 0; q < 4; ++q) Ys[(sg * 16 + 4 * l4 + q) * 20 + l15] = y[q];
        }
        LDS_WAIT();
        { const f32x4 y0 = *(const f32x4*)(Ys + er * 20 + 8 * eh), y1 = *(const f32x4*)(Ys + er * 20 + 8 * eh + 4);
          float o[8]; o[0] = y0.x + dk0.x * bflo(us.x); o[1] = y0.y + dk0.y * bfhi(us.x); o[2] = y0.z + dk0.z * bflo(us.y); o[3] = y0.w + dk0.w * bfhi(us.y);
          o[4] = y1.x + dk1.x * bflo(us.z); o[5] = y1.y + dk1.y * bfhi(us.z); o[6] = y1.z + dk1.z * bflo(us.w); o[7] = y1.w + dk1.w * bfhi(us.w);
          u32x4 ov; ov.x = pk2(gelu_tanh(o[0]), gelu_tanh(o[1])); ov.y = pk2(gelu_tanh(o[2]), gelu_tanh(o[3])); ov.z = pk2(gelu_tanh(o[4]), gelu_tanh(o[5])); ov.w = pk2(gelu_tanh(o[6]), gelu_tanh(o[7]));
          *(u32x4*)(P_G5 + S5_EROW(blk) * 512 + g * 16 + 8 * eh) = ov; }
        LDS_WAIT();
    }
#undef S5_ALOAD
#undef S5_EROW
}
namespace lin {
typedef const LAS char* lptr;
typedef short s16x4 __attribute__((ext_vector_type(4)));
typedef short v4i16_t __attribute__((ext_vector_type(4)));
__device__ __forceinline__ s16x4 vtr(lptr p) { return __builtin_bit_cast(s16x4, __builtin_amdgcn_ds_read_tr16_b64_v4i16((LAS v4i16_t*)p)); }
__device__ __forceinline__ bf16x8 tr_frag(lptr sub, int ks, int lane) {
    const lptr p = sub + ((lane >> 4) & 1) * 32 + (lane & 3) * 8 + (4 * (lane >> 5) + ((lane & 15) >> 2)) * 64 + ks * 1024;
    const s16x4 lo = vtr(p), hi = vtr(p + 512);
    return (bf16x8){lo[0], lo[1], lo[2], lo[3], hi[0], hi[1], hi[2], hi[3]};
}
__device__ __forceinline__ bf16x8 nat_frag(lptr base, int ldb, int row0, int k0, int lane) { return *(const LAS bf16x8*)(base + (row0 + (lane & 31)) * ldb + (k0 + 8 * (lane >> 5)) * 2); }
__device__ __forceinline__ int crow(int r, int hh) { return (r & 3) + 8 * (r >> 2) + 4 * hh; }
__device__ __forceinline__ void unpack8(const u32x4& w, float (&f)[8]) { f[0] = bflo(w.x); f[1] = bfhi(w.x); f[2] = bflo(w.y); f[3] = bfhi(w.y); f[4] = bflo(w.z); f[5] = bfhi(w.z); f[6] = bflo(w.w); f[7] = bfhi(w.w); }
__device__ __forceinline__ u32x4 repack8(const float (&f)[8]) { u32x4 w; w.x = pk2(f[0], f[1]); w.y = pk2(f[2], f[3]); w.z = pk2(f[4], f[5]); w.w = pk2(f[6], f[7]); return w; }

__device__ __forceinline__ void gla_prefix(CArgs& A, const Frame& F, int item) {
    const int b = item >> 5, c = item & 31, half = F.tid >> 8, col = F.tid & 255;
    float* p = P_LOGA + (size_t)(b * SEQ + c * 64 + 32 * half) * 256 + col; float* tot = (float*)F.lds;
    float v[32];
#pragma unroll
    for (int i = 0; i < 32; ++i) v[i] = p[(size_t)i * 256];
#pragma unroll
    for (int i = 1; i < 32; ++i) v[i] += v[i - 1];
    if (half == 0) tot[col] = v[31];
    __syncthreads();
    const float off = half ? tot[col] : 0.f;
#pragma unroll
    for (int i = 0; i < 32; ++i) p[(size_t)i * 256] = v[i] + off;
    __syncthreads();
}
template <int KIND> __device__ __forceinline__ void r1_item(CArgs& A, const Frame& F, int bh, int vs) {
    constexpr int DK = KIND ? 64 : 128, ND = DK / 32;
    constexpr int KCOL = KIND ? 2304 : 512, VCOL = KIND ? 2560 : 1024;
    const int b = bh >> 2, h = bh & 3, tid = F.tid, lane = F.lane, w = F.wave, hh = lane >> 5;
    unsigned char* bufV = F.lds; unsigned char* bufK = F.lds + 4096;
    bf16_t* ST = (KIND ? P_GST : P_RST) + (size_t)bh * 32 * 128 * DK;
    const float log2g = KIND ? 0.f : log2f(1.f - exp2f(-5.f - (float)h));
    const float g64 = exp2f(64.f * log2g);
    f32x16 acc = {0.f, 0.f, 0.f, 0.f, 0.f, 0.f, 0.f, 0.f, 0.f, 0.f, 0.f, 0.f, 0.f, 0.f, 0.f, 0.f};
    const bf16_t* zb = P_Z + (size_t)(b * SEQ) * ZP1;
    const int vj = tid >> 2, vc = tid & 3;
    const int kj0 = KIND ? (tid >> 3) : (tid >> 4), kd0 = KIND ? (tid & 7) : (tid & 15);
#define R1_DECL(S) u32x4 rv##S = {0u, 0u, 0u, 0u}, rk0##S = {0u, 0u, 0u, 0u}, rk1##S = {0u, 0u, 0u, 0u}; f32x4 bj0##S = {0.f, 0.f, 0.f, 0.f}, bj1##S = bj0##S, bl0##S = bj0##S, bl1##S = bj0##S; float bd##S = 0.f;
#define R1_LOAD(S, c) do { const bf16_t* zc = zb + (size_t)((c) * 64) * ZP1; \
        if (tid < 256) rv##S = *(const u32x4*)(zc + (size_t)vj * ZP1 + VCOL + h * 128 + vs * 32 + vc * 8); \
        rk0##S = *(const u32x4*)(zc + (size_t)kj0 * ZP1 + KCOL + h * DK + kd0 * 8); \
        if (!KIND) rk1##S = *(const u32x4*)(zc + (size_t)(kj0 + 32) * ZP1 + KCOL + h * DK + kd0 * 8); \
        if (KIND) { const float* bp = P_LOGA + (size_t)(b * SEQ + (c) * 64) * 256 + h * 64; \
            bj0##S = *(const f32x4*)(bp + (size_t)kj0 * 256 + kd0 * 8); bj1##S = *(const f32x4*)(bp + (size_t)kj0 * 256 + kd0 * 8 + 4); \
            bl0##S = *(const f32x4*)(bp + 63 * 256 + kd0 * 8); bl1##S = *(const f32x4*)(bp + 63 * 256 + kd0 * 8 + 4); \
            if (w < ND) bd##S = bp[63 * 256 + 32 * w + (lane & 31)]; } } while (0)
#define R1_STEP(S, c) do { \
        if (tid < 256) { u32x4 o = rv##S; \
            if (!KIND) { float f[8]; unpack8(rv##S, f); const float z = exp2f((float)(63 - vj) * log2g); _Pragma("unroll") for (int e = 0; e < 8; ++e) f[e] *= z; o = repack8(f); } \
            *(u32x4*)(bufV + vj * 64 + vc * 16) = o; } \
        if (KIND) { float f[8]; unpack8(rk0##S, f); \
            f[0] *= __expf(bl0##S.x - bj0##S.x); f[1] *= __expf(bl0##S.y - bj0##S.y); f[2] *= __expf(bl0##S.z - bj0##S.z); f[3] *= __expf(bl0##S.w - bj0##S.w); \
            f[4] *= __expf(bl1##S.x - bj1##S.x); f[5] *= __expf(bl1##S.y - bj1##S.y); f[6] *= __expf(bl1##S.z - bj1##S.z); f[7] *= __expf(bl1##S.w - bj1##S.w); \
            *(u32x4*)(bufK + (kd0 >> 2) * 4096 + kj0 * 64 + (kd0 & 3) * 16) = repack8(f); \
        } else { \
            *(u32x4*)(bufK + (kd0 >> 2) * 4096 + kj0 * 64 + (kd0 & 3) * 16) = rk0##S; \
            *(u32x4*)(bufK + (kd0 >> 2) * 4096 + (kj0 + 32) * 64 + (kd0 & 3) * 16) = rk1##S; } \
        __syncthreads(); \
        const float decn = KIND ? __expf(bd##S) : 0.f; \
        if ((c) + 4 < 32) R1_LOAD(S, (c) + 4); \
        if (w < ND) { \
            bf16_t* sp = ST + ((size_t)(c) * 128 + vs * 32) * DK + 32 * w + (lane & 31); \
            const float dec = KIND ? decn : g64; \
            _Pragma("unroll") for (int r = 0; r < 16; ++r) { sp[(size_t)crow(r, hh) * DK] = (bf16_t)f2bf(acc[r]); acc[r] *= dec; } \
            _Pragma("unroll") for (int ks = 0; ks < 4; ++ks) acc = __builtin_amdgcn_mfma_f32_32x32x16_bf16(tr_frag((lptr)(LAS unsigned char*)bufV, ks, lane), tr_frag((lptr)(LAS unsigned char*)bufK + w * 4096, ks, lane), acc, 0, 0, 0); \
        } \
        __syncthreads(); } while (0)
    R1_DECL(0) R1_DECL(1) R1_DECL(2) R1_DECL(3)
    R1_LOAD(0, 0); R1_LOAD(1, 1); R1_LOAD(2, 2); R1_LOAD(3, 3);
#pragma unroll 1
    for (int c = 0; c < 32; c += 4) { R1_STEP(0, c); R1_STEP(1, c + 1); R1_STEP(2, c + 2); R1_STEP(3, c + 3); }
#undef R1_DECL
#undef R1_LOAD
#undef R1_STEP
}
__device__ __forceinline__ void p_lin_r1(CArgs& A, const Frame& F) {
    const int v = F.bid, r = v & 127;
    if (v < 128) r1_item<0>(A, F, r >> 2, r & 3); else r1_item<1>(A, F, r >> 2, r & 3);
}

template <int KIND> struct R2Regs {
    static constexpr int DK = KIND ? 64 : 128, NQP = 64 * DK / 8 / 512, NSP = 128 * DK / 8 / 512;
    u32x4 q[NQP], k[NQP], v[2], s[NSP], g[2]; f32x4 bq[NQP][2];
};
template <int KIND> __device__ __forceinline__ void r2_load(CArgs& A, const Frame& F, R2Regs<KIND>& R, int bh, int c) {
    constexpr int DK = KIND ? 64 : 128;
    constexpr int QCOL = KIND ? 2048 : 0, KCOL = KIND ? 2304 : 512, VCOL = KIND ? 2560 : 1024, GCOL = KIND ? 3072 : 1536;
    const int b = bh >> 2, h = bh & 3, tid = F.tid, lane = F.lane, w = F.wave, hh = lane >> 5, l31 = lane & 31, rb = w >> 2, cb = w & 3;
    const bf16_t* zc = P_Z + (size_t)(b * SEQ + c * 64) * ZP1;
    const bf16_t* ST = (KIND ? P_GST : P_RST) + ((size_t)bh * 32 + c) * 128 * DK;
#pragma unroll
    for (int r = 0; r < R2Regs<KIND>::NQP; ++r) { const int q = tid + 512 * r, i = q / (DK / 8), d8 = q % (DK / 8);
        R.q[r] = *(const u32x4*)(zc + (size_t)i * ZP1 + QCOL + h * DK + d8 * 8); R.k[r] = *(const u32x4*)(zc + (size_t)i * ZP1 + KCOL + h * DK + d8 * 8);
        if (KIND) { const float* bp = P_LOGA + (size_t)(b * SEQ + c * 64 + i) * 256 + h * 64 + d8 * 8; R.bq[r][0] = *(const f32x4*)bp; R.bq[r][1] = *(const f32x4*)(bp + 4); } }
#pragma unroll
    for (int r = 0; r < 2; ++r) { const int q = tid + 512 * r, j = q >> 4, v8 = q & 15; R.v[r] = *(const u32x4*)(zc + (size_t)j * ZP1 + VCOL + h * 128 + v8 * 8); }
#pragma unroll
    for (int r = 0; r < R2Regs<KIND>::NSP; ++r) { const int q = tid + 512 * r, vr = q / (DK / 8), d8 = q % (DK / 8); R.s[r] = *(const u32x4*)(ST + (size_t)vr * DK + d8 * 8); }
#pragma unroll
    for (int k2 = 0; k2 < 2; ++k2) { const int pp = lane + 64 * k2; R.g[k2] = *(const u32x4*)(zc + (size_t)(32 * rb + (pp >> 2)) * ZP1 + GCOL + h * 128 + 32 * cb + 8 * (pp & 3)); }
}
template <int KIND> struct R2Lds { static constexpr int DK = KIND ? 64 : 128, LDQ = (DK + 8) * 2, OFF_K = 64 * LDQ, OFF_V = 2 * 64 * LDQ, OFF_S = OFF_V + 16384, OFF_SSQ = OFF_S + 128 * LDQ, OFF_BC = OFF_SSQ + 1024; };
template <int KIND> __device__ __forceinline__ void r2_stage(const Frame& F, const R2Regs<KIND>& R, u32x4 (&gc)[2]) {
    typedef R2Lds<KIND> LL; constexpr int DK = LL::DK, LDQ = LL::LDQ;
    const int tid = F.tid; unsigned char* L = F.lds;
#pragma unroll
    for (int r = 0; r < R2Regs<KIND>::NQP; ++r) { const int q = tid + 512 * r, i = q / (DK / 8), d8 = q % (DK / 8);
        u32x4 qw = R.q[r], kw = R.k[r];
        if (KIND) { float fq[8], fk[8]; unpack8(qw, fq); unpack8(kw, fk);
#pragma unroll
            for (int e = 0; e < 8; ++e) { const float bb = R.bq[r][e >> 2][e & 3]; fq[e] *= __expf(bb); fk[e] *= __expf(-bb); }
            qw = repack8(fq); kw = repack8(fk); }
        *(u32x4*)(L + i * LDQ + d8 * 16) = qw; *(u32x4*)(L + LL::OFF_K + i * LDQ + d8 * 16) = kw; }
#pragma unroll
    for (int r = 0; r < 2; ++r) { const int q = tid + 512 * r, j = q >> 4, v8 = q & 15; *(u32x4*)(L + LL::OFF_V + (v8 >> 2) * 4096 + j * 64 + (v8 & 3) * 16) = R.v[r]; }
#pragma unroll
    for (int r = 0; r < R2Regs<KIND>::NSP; ++r) { const int q = tid + 512 * r, vr = q / (DK / 8), d8 = q % (DK / 8); *(u32x4*)(L + LL::OFF_S + vr * LDQ + d8 * 16) = R.s[r]; }
    gc[0] = R.g[0]; gc[1] = R.g[1];
    __syncthreads();
}
template <int KIND> __device__ __forceinline__ void r2_compute(CArgs& A, const Frame& F, int bh, int c, const u32x4 (&gc)[2]) {
    typedef R2Lds<KIND> LL; constexpr int DK = LL::DK, LDQ = LL::LDQ, OFF_K = LL::OFF_K, OFF_V = LL::OFF_V, OFF_S = LL::OFF_S;
    constexpr int OCOL = KIND ? 512 : 0;
    const int b = bh >> 2, h = bh & 3, lane = F.lane, w = F.wave, hh = lane >> 5, l31 = lane & 31, rb = w >> 2, cb = w & 3;
    unsigned char* L = F.lds; float* ssq = (float*)(L + LL::OFF_SSQ);
    const float log2g = KIND ? 0.f : log2f(1.f - exp2f(-5.f - (float)h));
    const lptr L3 = (lptr)(LAS unsigned char*)L;
    bf16x8 pa[2][2];
#pragma unroll
    for (int jt = 0; jt < 2; ++jt) {
        f32x16 p = {0.f, 0.f, 0.f, 0.f, 0.f, 0.f, 0.f, 0.f, 0.f, 0.f, 0.f, 0.f, 0.f, 0.f, 0.f, 0.f};
        if (jt <= rb) {
#pragma unroll
            for (int ks = 0; ks < DK / 16; ++ks) p = __builtin_amdgcn_mfma_f32_32x32x16_bf16(nat_frag(L3 + OFF_K, LDQ, 32 * jt, 16 * ks, lane), nat_frag(L3, LDQ, 32 * rb, 16 * ks, lane), p, 0, 0, 0);
        }
        const int i = 32 * rb + l31;
        float f[16];
#pragma unroll
        for (int r = 0; r < 16; ++r) { const int j = 32 * jt + crow(r, hh); float x = (i >= j) ? p[r] : 0.f; if (!KIND) x *= exp2f((float)(i - j) * log2g); f[r] = (i >= j) ? x : 0.f; }
#pragma unroll
        for (int s = 0; s < 2; ++s) { u32x4 wv; wv.x = pk2(f[8 * s], f[8 * s + 1]); wv.y = pk2(f[8 * s + 2], f[8 * s + 3]); wv.z = pk2(f[8 * s + 4], f[8 * s + 5]); wv.w = pk2(f[8 * s + 6], f[8 * s + 7]); pa[jt][s] = __builtin_bit_cast(bf16x8, wv); }
    }
    f32x16 o1 = {0.f, 0.f, 0.f, 0.f, 0.f, 0.f, 0.f, 0.f, 0.f, 0.f, 0.f, 0.f, 0.f, 0.f, 0.f, 0.f}, o2 = o1;
#pragma unroll
    for (int jt = 0; jt < 2; ++jt)
#pragma unroll
        for (int s = 0; s < 2; ++s) o1 = __builtin_amdgcn_mfma_f32_32x32x16_bf16(pa[jt][s], tr_frag(L3 + OFF_V + cb * 4096, 2 * jt + s, lane), o1, 0, 0, 0);
#pragma unroll
    for (int ks = 0; ks < DK / 16; ++ks) o2 = __builtin_amdgcn_mfma_f32_32x32x16_bf16(nat_frag(L3, LDQ, 32 * rb, 16 * ks, lane), nat_frag(L3 + OFF_S, LDQ, 32 * cb, 16 * ks, lane), o2, 0, 0, 0);
    float o[16];
#pragma unroll
    for (int r = 0; r < 16; ++r) { const int i = 32 * rb + crow(r, hh); const float xi = KIND ? 1.f : exp2f((float)(i + 1) * log2g); o[r] = o1[r] + xi * o2[r];
        const float sq = half_sum(o[r] * o[r]); if (l31 == 0) ssq[i * 4 + cb] = sq; }
    __syncthreads();
    float* Os = (float*)L + w * (32 * 33);
#pragma unroll
    for (int r = 0; r < 16; ++r) Os[crow(r, hh) * 33 + l31] = o[r];
    LDS_WAIT();
#pragma unroll
    for (int k2 = 0; k2 < 2; ++k2) { const int pp = lane + 64 * k2, rw = pp >> 2, ch = pp & 3, i = 32 * rb + rw;
        const f32x4 s4 = *(const f32x4*)(ssq + i * 4);
        const float rn = rsqrtf(((s4.x + s4.y) + (s4.z + s4.w)) * (1.f / 128.f) + EPS);
        float gv[8]; unpack8(gc[k2], gv); float y[8];
#pragma unroll
        for (int e = 0; e < 8; ++e) y[e] = siluf_(gv[e]) * Os[rw * 33 + 8 * ch + e] * rn;
        *(u32x4*)(P_YCAT + (size_t)(b * SEQ + c * 64 + i) * DM + OCOL + h * 128 + 32 * cb + 8 * ch) = repack8(y); }
    __syncthreads();
}
template <int KIND> __device__ __forceinline__ void r2_run(CArgs& A, const Frame& F0, int first, int n, int stride) {
    R2Regs<KIND> R; u32x4 gc[2];
    { Frame G2 = F0; int t_ = F0.tid; asm volatile("" : "+v"(t_)); G2.tid = t_; G2.lane = t_ & 63; r2_load<KIND>(A, G2, R, (first & 1023) >> 5, first & 31); }
#pragma unroll 1
    for (int i = 0; i < n; ++i) {
        Frame G2 = F0; { int t_ = F0.tid; asm volatile("" : "+v"(t_)); G2.tid = t_; G2.lane = t_ & 63; }
        const int r = (first + i * stride) & 1023;
        r2_stage<KIND>(G2, R, gc);
        if (i + 1 < n) { const int rn = (first + (i + 1) * stride) & 1023; r2_load<KIND>(A, G2, R, rn >> 5, rn & 31); }
        r2_compute<KIND>(A, G2, r >> 5, r & 31, gc);
    }
}
__device__ __forceinline__ void p_lin_r2(CArgs& A, const Frame& F) {
    r2_run<0>(A, F, F.bid, 4, F.G);
    r2_run<1>(A, F, 1024 + F.bid, 4, F.G);
}
}
#define XB_TMO      128
#define XB_XCNT(j)  (256  + 64 * (j))
#define XB_XSUB(j)  (1280 + 64 * (j))
#define XB_XGEN(j)  (2304 + 64 * (j))
#define XB_TOP      3328
#define XB_TOPGEN   3392
#define XCD_BAR_WORDS 3456
#define XB_SPIN_CAP (1u << 18)
__device__ __forceinline__ unsigned xb_ld(unsigned* p)              { return __hip_atomic_load(p, __ATOMIC_RELAXED, __HIP_MEMORY_SCOPE_AGENT); }
__device__ __forceinline__ unsigned xb_add(unsigned* p, unsigned v) { return __hip_atomic_fetch_add(p, v, __ATOMIC_RELAXED, __HIP_MEMORY_SCOPE_AGENT); }
__device__ __forceinline__ unsigned xb_xcc_id() { return (unsigned)__builtin_amdgcn_s_getreg((3 << 11) | 20) & 0xFu; }
#define XB_SPIN(cond, bar) do { unsigned _sp = 0; while (cond) { __builtin_amdgcn_s_sleep(1); \
    if ((++_sp & 255u) == 0u) { if (xb_ld(&(bar)[XB_TMO])) break; if (_sp > XB_SPIN_CAP) { atomicAdd(&(bar)[XB_TMO], 1u); break; } } } } while (0)
struct XcdBarrier { unsigned* bar; unsigned x; volatile LAS unsigned* st; };
__device__ __forceinline__ XcdBarrier xcd_barrier_post(unsigned* bar, volatile LAS unsigned* st, int tid) {
    XcdBarrier b; b.bar = bar; b.x = xb_xcc_id(); b.st = st;
    if (tid == 0) (void)xb_add(&bar[XB_XCNT(b.x)], 1u);
    return b;
}
__device__ __forceinline__ void xcd_barrier_complete(unsigned* bar, unsigned x, unsigned& nloc, unsigned& nx) {
    const unsigned G = gridDim.x * gridDim.y * gridDim.z;
    unsigned sum, cnt, mine, sp = 0u;
    for (;;) {
        sum = 0u; cnt = 0u; mine = 0u;
#pragma unroll
        for (unsigned j = 0; j < 16; ++j) { const unsigned c = xb_ld(&bar[XB_XCNT(j)]); sum += c; cnt += (c > 0u) ? 1u : 0u; mine = (j == x) ? c : mine; }
        if (sum == G) break;
        __builtin_amdgcn_s_sleep(1);
        if ((++sp & 255u) == 0u) { if (xb_ld(&bar[XB_TMO])) break; if (sp > XB_SPIN_CAP) { atomicAdd(&bar[XB_TMO], 1u); break; } }
    }
    nloc = mine > 0u ? mine : 1u; nx = cnt > 0u ? cnt : 1u;
}
__device__ __forceinline__ void xcd_barrier(const XcdBarrier& b, int tid) {
    asm volatile("s_waitcnt vmcnt(0)" ::: "memory");
    __syncthreads();
    if (tid == 0) {
        unsigned* bar = b.bar;
        __builtin_amdgcn_s_waitcnt(0);
        unsigned nloc = b.st[0], nx = b.st[1];
        if (nloc == 0u) { xcd_barrier_complete(bar, b.x, nloc, nx); b.st[0] = nloc; b.st[1] = nx; }
        const unsigned old = xb_add(&bar[XB_XSUB(b.x)], 1u);
        const unsigned gen = old / nloc;
        if (old + 1u == (gen + 1u) * nloc) {
            __builtin_amdgcn_fence(__ATOMIC_RELEASE, "agent");
            asm volatile("s_waitcnt vmcnt(0)" ::: "memory");
            const unsigned og = xb_add(&bar[XB_TOP], 1u);
            const unsigned tg = og / nx;
            if (og + 1u == (tg + 1u) * nx) xb_add(&bar[XB_TOPGEN], 1u);
            else XB_SPIN(xb_ld(&bar[XB_TOPGEN]) == tg, bar);
            __builtin_amdgcn_fence(__ATOMIC_ACQUIRE, "agent");
            xb_add(&bar[XB_XGEN(b.x)], 1u);
            asm volatile("s_waitcnt vmcnt(0)" ::: "memory");
        } else {
            XB_SPIN(xb_ld(&bar[XB_XGEN(b.x)]) == gen, bar);
            __builtin_amdgcn_fence(__ATOMIC_ACQUIRE, "agent");
            asm volatile("s_waitcnt vmcnt(0)" ::: "memory");
        }
    }
    __syncthreads();
}
#define REFRESH() do { int t_ = F.wave * 64 + lane_id(); asm volatile("" : "+v"(t_)); F.tid = t_; F.lane = t_ & 63; asm volatile("" : "+s"(ap)); int b_ = blockIdx.x; asm volatile("" : "+s"(b_)); F.bid = b_; } while (0)
#define A (*ap)
#define GSYNC() do { REFRESH(); xcd_barrier(xb, F.tid); } while (0)
template <int l> __device__ __forceinline__ void layer_fwd(CArgs*& ap, Frame& F, const XcdBarrier& xb, unsigned char* lds, LAS unsigned char* lds3, LAS pg8::MoeTables* tb) {
    if (l == 0) {
        { REFRESH(); pg8::DenseOrder S; S.init(P_HB, P_WINE, NTOK, 2048, 1024, F.G, F.bid); pg8::EpiZ0 E{P_Z};
          pg8::gemm_phase<pg8::EpiZ0, pg8::DenseOrder, true>(lds3, F.wave, 1024, S, E); }
        GSYNC();
        REFRESH(); fox_fast(A, F);
        __syncthreads();
        REFRESH(); s5_fast(A, F, F.bid);
        GSYNC();
        { REFRESH(); pg8::DenseOrder S; S.init(P_G5, P_WGLU, NTOK, 512, 512, F.G, F.bid); pg8::EpiGlu E{P_G5, A.in[I_GLUB], P_YCAT};
          pg8::gemm_phase<pg8::EpiGlu, pg8::DenseOrder, true>(lds3, F.wave, 512, S, E); }
        GSYNC();
    } else {
        REFRESH(); lin::gla_prefix(A, F, F.bid);
        { REFRESH(); pg8::DenseOrder S; S.init(P_HB, P_WINO, NTOK, 3584, 512, F.G, F.bid); pg8::EpiZ1 E{P_Z, P_ROPE};
          pg8::gemm_phase<pg8::EpiZ1, pg8::DenseOrder, true, true>(lds3, F.wave, 512, S, E); }
        GSYNC();
        REFRESH(); lin::p_lin_r1(A, F);
        GSYNC();
        REFRESH(); lin::p_lin_r2(A, F);
        GSYNC();
    }
    { REFRESH(); pg8::DenseOrder S; S.init(P_YCAT, l == 0 ? P_WOUTE : P_WOUTO, NTOK, 1024, 1024, F.G, F.bid); pg8::EpiBf16Plain E{(bf16_t*)P_MBUF, DM};
      pg8::gemm_phase<pg8::EpiBf16Plain, pg8::DenseOrder, true>(lds3, F.wave, 1024, S, E); }
    GSYNC();
    REFRESH(); p_postmix(A, F, l);
    GSYNC();
    REFRESH(); const int MT = moe_tables(A, F, l, tb);
    {
        const int mX = (MT >> 5) << 5, kk = MT - mX, rr = (64 - ((2 * kk) & 63)) & 63;
        const int mY = mX >= rr ? rr + (((mX - rr) >> 6) << 6) : 0;
        if (mX > 0) {
            { REFRESH(); pg8::MoeOrder<true> S; S.Ap = (const char*)P_HB8; S.Bt = (const char*)(P_W1 + (size_t)l * 32 * 2048 * 1024); S.estride = (size_t)2048 * 1024; S.K = 512; S.NP = 8; S.nwg = mX * 8; S.G = F.G; S.c = F.bid; S.mt0 = 0;
              S.list_tk = P_LTK + (size_t)l * 32 * LISTCAP; S.tb = tb;
              pg8::EpiSwiglu E{P_ACT, A.in[I_BGU] + (size_t)l * 32 * 2048};
              pg8::gemm_phase<pg8::EpiSwiglu, pg8::MoeOrder<true>, true, true>(lds3, F.wave, 512, S, E); }
            GSYNC();
        }
        if (8 * (MT - mX) + 4 * mY > 0) {
            { REFRESH(); pg8::MoeMixOrder S; S.ws = (const char*)A.ws; S.l = l;
              S.a0 = mX; S.nA = 8 * (MT - mX); S.b0 = 0; S.nB = 4 * mY; S.nwg = S.nA + S.nB; S.G = F.G; S.c = F.bid; S.tb = tb;
              pg8::EpiMoeMix E{ap, l};
              pg8::gemm_phase<pg8::EpiMoeMix, pg8::MoeMixOrder, true, true>(lds3, F.wave, 512, S, E); }
            GSYNC();
        }
        if (MT > mY) {
            { REFRESH(); pg8::MoeOrder<false> S; S.Ap = (const char*)P_ACT; S.Bt = (const char*)(P_W2 + (size_t)l * 32 * 1024 * 1024); S.estride = (size_t)1024 * 1024; S.K = 512; S.NP = 4; S.nwg = (MT - mY) * 4; S.G = F.G; S.c = F.bid; S.mt0 = mY;
              S.list_tk = P_LTK + (size_t)l * 32 * LISTCAP; S.tb = tb;
              pg8::EpiDown E{P_Y, A.in[I_BDN] + (size_t)l * 32 * 1024, P_LTK + (size_t)l * 32 * LISTCAP, P_LG + (size_t)l * 32 * LISTCAP};
              pg8::gemm_phase<pg8::EpiDown, pg8::MoeOrder<false>, true, true>(lds3, F.wave, 512, S, E); }
            GSYNC();
        }
    }
    REFRESH(); p_combine(A, F, l);
}

__global__ void __launch_bounds__(512, 2) mk_fwd(Args A_) {
    extern __shared__ __attribute__((aligned(16))) unsigned char lds[];
    cg::grid_group grid = cg::this_grid();
    CArgs* ap = (CArgs*)__builtin_amdgcn_kernarg_segment_ptr();
    Frame F;
    F.lds = lds; F.wave = __builtin_amdgcn_readfirstlane((int)threadIdx.x >> 6); F.tid = 0; F.lane = 0; F.bid = blockIdx.x; F.G = gridDim.x;
    LAS unsigned char* lds3 = (LAS unsigned char*)lds;
    LAS pg8::MoeTables* tb = (LAS pg8::MoeTables*)(lds3 + 133632);
    { volatile LAS unsigned* st = (volatile LAS unsigned*)(lds3 + (LDS_BYTES - 64)); REFRESH(); if (F.tid < 2) st[F.tid] = 0u; __syncthreads(); }
    XcdBarrier xb = xcd_barrier_post((unsigned*)(A.ws + WS_CTL) + 10240, (volatile LAS unsigned*)(lds3 + (LDS_BYTES - 64)), F.tid);
    REFRESH(); p0_tables(A, F);
    if (A.pad != 0) grid.sync();
    GSYNC();
    REFRESH(); p0_tiles(A, F, 0, 12);
    __syncthreads(); REFRESH(); p1_hprep0(A, F);
    __syncthreads(); REFRESH(); p0_tiles(A, F, 12, 26);
    GSYNC();
    layer_fwd<0>(ap, F, xb, lds, lds3, tb);
    GSYNC();
    layer_fwd<1>(ap, F, xb, lds, lds3, tb);
}
#undef A

extern "C" void kernel_launch(void* const* d_in, const int* in_sizes, int n_in, void* d_out, int out_size, void* d_ws, size_t ws_size, hipStream_t stream) {
    static int grid = 0;
    if (grid == 0) {
        if (n_in != 31 || out_size != NTOK * DM || ws_size < WS_END) { fprintf(stderr, "kernel_launch: unexpected problem (n_in %d out %d ws %zu)\n", n_in, out_size, ws_size); grid = -1; return; }
        int dev = 0, cus = 0, per_cu = 0;
        if (hipGetDevice(&dev) != hipSuccess || hipDeviceGetAttribute(&cus, hipDeviceAttributeMultiprocessorCount, dev) != hipSuccess) { grid = -1; return; }
        if (hipFuncSetAttribute((const void*)mk_fwd, hipFuncAttributeMaxDynamicSharedMemorySize, LDS_BYTES) != hipSuccess) { fprintf(stderr, "kernel_launch: hipFuncSetAttribute failed\n"); grid = -1; return; }
        if (hipOccupancyMaxActiveBlocksPerMultiprocessor(&per_cu, (const void*)mk_fwd, 512, LDS_BYTES) != hipSuccess || per_cu < 1) { fprintf(stderr, "kernel_launch: occupancy query says %d blocks per CU\n", per_cu); (void)hipGetLastError(); }
        grid = cus;
        if (grid != 256) fprintf(stderr, "kernel_launch: %d CUs; this kernel is built for a 256-CU grid\n", grid);
    }
    if (grid < 0) return;
    if (hipMemsetAsync((char*)d_ws + WS_CTL, 0, CTL_ZERO_BYTES, stream) != hipSuccess) { fprintf(stderr, "kernel_launch: memset failed\n"); return; }
    Args a{};
    for (int i = 0; i < 31; ++i) a.in[i] = (const float*)d_in[i];
    a.out = (float*)d_out; a.ws = (unsigned char*)d_ws;
    void* kargs[] = {&a};
    const hipError_t e = hipLaunchCooperativeKernel((const void*)mk_fwd, dim3(grid), dim3(512), kargs, LDS_BYTES, stream);
    if (e != hipSuccess) fprintf(stderr, "kernel_launch: cooperative launch failed: %s (grid %d)\n", hipGetErrorString(e), grid);
}
```
